# Optimizing an MI355X kernel written in HIP

```python
import math
import jax
import jax.numpy as jnp
from jax import lax
import numpy as np

D_MODEL = 1024
BATCH = 16
SEQ = 4096
DEPTH = 2

NORM_EPS = 1e-6
N_BUCKETS = 32
MAX_DISTANCE = 128
N_ATTN_HEADS = 8

SSM_HEADS = 8
SSM_HEAD_DIM = 64
SSM_D_INNER = SSM_HEADS * SSM_HEAD_DIM
SSM_GROUPS = 2
SSM_STATE = 128
SSM_CONV = 4
SSM_CHUNK = 128
SSM_CONV_CH = SSM_D_INNER + 2 * SSM_GROUPS * SSM_STATE

DSA_HEADS = N_ATTN_HEADS
DSA_HEAD_DIM = 64
IDX_HEADS = 4
IDX_DIM = 64
DSA_TOPK = 256
DSA_Q_BLOCK = 128

EVEN_SPLITS = (SSM_D_INNER, SSM_CONV_CH, SSM_HEADS, DSA_HEADS * DSA_HEAD_DIM, DSA_HEAD_DIM, DSA_HEAD_DIM, IDX_HEADS * IDX_DIM, IDX_DIM, IDX_HEADS)
EVEN_COLS = sum(EVEN_SPLITS)
EVEN_MIX = SSM_D_INNER + DSA_HEADS * DSA_HEAD_DIM

NSA_HEADS = N_ATTN_HEADS
NSA_KV_GROUPS = 2
NSA_HEAD_DIM = 128
NSA_KV_DIM = NSA_KV_GROUPS * NSA_HEAD_DIM
CMP_BLOCK = 32
CMP_STRIDE = 16
SEL_BLOCK = 64
SEL_TOPN = 16
WINDOW = 512
NSA_Q_BLOCK = 32
ODD_SPLITS = (NSA_HEADS * NSA_HEAD_DIM,) + (NSA_KV_DIM,) * 6 + (3 * NSA_HEADS,)
ODD_COLS = sum(ODD_SPLITS)
ODD_MIX = NSA_HEADS * NSA_HEAD_DIM

MOE_GROUPS = 4
EXPERTS_PER_GROUP = 8
N_EXPERTS = MOE_GROUPS * EXPERTS_PER_GROUP
EXPERT_FF = 512
TOP_K_INNER = 2
MOE_BLOCK = 256

N_EVEN = (DEPTH + 1) // 2
N_ODD = DEPTH // 2

kernel_name = 'hybrid_ssd_dsa_nsa_hmoe'


def rms_norm(x, gain):
    xf = x.astype(jnp.float32)
    y = xf * lax.rsqrt(jnp.mean(xf * xf, axis=-1, keepdims=True) + NORM_EPS)
    return (y * gain.astype(jnp.float32)).astype(x.dtype)


def split_cols(u, sizes):
    out, start = [], 0
    for s in sizes:
        out.append(u[..., start:start + s])
        start += s
    return out


def t5_bucket(dist):
    dist = jnp.maximum(dist, 0)
    max_exact = N_BUCKETS // 2
    large = max_exact + (jnp.log(jnp.maximum(dist, 1).astype(jnp.float32) / max_exact)
                         / math.log(MAX_DISTANCE / max_exact) * (N_BUCKETS - max_exact)).astype(jnp.int32)
    large = jnp.minimum(large, N_BUCKETS - 1)
    return jnp.where(dist < max_exact, dist, large)


def masked_softmax(logits, mask):
    l = jnp.where(mask, logits.astype(jnp.float32), -jnp.inf)
    m = jnp.max(l, axis=-1, keepdims=True)
    m = jnp.where(jnp.isfinite(m), m, 0.0)
    e = jnp.where(mask, jnp.exp(l - m), 0.0)
    return e / jnp.maximum(jnp.sum(e, axis=-1, keepdims=True), 1e-30)


def causal_dwconv(x, w, b):
    ch = x.shape[-1]
    y = lax.conv_general_dilated(x, w[:, None, :].astype(x.dtype), window_strides=(1,),
                                 padding=[(SSM_CONV - 1, 0)], dimension_numbers=('NWC', 'WIO', 'NWC'),
                                 feature_group_count=ch)
    return y + b.astype(x.dtype)


def ssd_chunked(xh, dt, a, bm, cm):
    bsz, seq, n_heads, hd = xh.shape
    g, n = bm.shape[2], bm.shape[3]
    hpg = n_heads // g
    l = SSM_CHUNK
    nc = seq // l
    x = (xh * dt[..., None]).reshape(bsz, nc, l, g, hpg, hd)
    acum = jnp.cumsum((dt * a).reshape(bsz, nc, l, g, hpg), axis=2)
    bm = bm.reshape(bsz, nc, l, g, n)
    cm = cm.reshape(bsz, nc, l, g, n)
    causal = jnp.tril(jnp.ones((l, l), dtype=bool))[:, :, None, None]
    seg = acum[:, :, :, None] - acum[:, :, None]
    decay = jnp.exp(jnp.where(causal, seg, -jnp.inf))
    cb = jnp.einsum('bctgn,bcsgn->bctsg', cm, bm)
    y_diag = jnp.einsum('bctsgh,bcsghp->bctghp', cb[..., None] * decay, x)
    to_end = jnp.exp(acum[:, :, -1:] - acum)
    chunk_states = jnp.einsum('bclgn,bclghp->bcghpn', bm, x * to_end[..., None])
    chunk_decay = jnp.exp(acum[:, :, -1])

    def step(state, inp):
        st, dc, c_c, a_c = inp
        y_off = jnp.einsum('blgn,bghpn->blghp', c_c, state) * jnp.exp(a_c)[..., None]
        return state * dc[..., None, None] + st, y_off

    init = jnp.zeros((bsz, g, hpg, hd, n), jnp.float32)
    mv = lambda t: jnp.moveaxis(t, 1, 0)
    _, y_off = lax.scan(step, init, (mv(chunk_states), mv(chunk_decay), mv(cm), mv(acum)))
    return (y_diag + jnp.moveaxis(y_off, 0, 1)).reshape(bsz, seq, n_heads, hd)


def mamba2_mixer(z, xbc, dt_raw, conv_w, conv_b, dt_bias, a_log, d_skip, norm_g):
    f32 = jnp.float32
    bsz, seq, _ = z.shape
    xbc = jax.nn.silu(causal_dwconv(xbc, conv_w, conv_b))
    xs, bm, cm = split_cols(xbc, (SSM_D_INNER, SSM_GROUPS * SSM_STATE, SSM_GROUPS * SSM_STATE))
    xh = xs.reshape(bsz, seq, SSM_HEADS, SSM_HEAD_DIM).astype(f32)
    dt = jax.nn.softplus(dt_raw.astype(f32) + dt_bias.astype(f32))
    a = -jnp.exp(a_log.astype(f32))
    y = ssd_chunked(xh, dt, a, bm.reshape(bsz, seq, SSM_GROUPS, SSM_STATE).astype(f32),
                    cm.reshape(bsz, seq, SSM_GROUPS, SSM_STATE).astype(f32))
    y = y + d_skip.astype(f32)[:, None] * xh
    y = y.reshape(bsz, seq, SSM_GROUPS, -1) * jax.nn.silu(z.astype(f32)).reshape(bsz, seq, SSM_GROUPS, -1)
    y = y * lax.rsqrt(jnp.mean(y * y, axis=-1, keepdims=True) + NORM_EPS)
    return (y.reshape(bsz, seq, SSM_D_INNER) * norm_g.astype(f32)).astype(z.dtype)


def dsa_attention(q, k, v, iq, ik, iw, rel_bias):
    f32 = jnp.float32
    bsz, seq, n_heads, hd = q.shape
    top_k = min(DSA_TOPK, seq // 4)
    scale = hd ** -0.5
    idx_scale = (IDX_DIM * IDX_HEADS) ** -0.5
    key_pos = jnp.arange(seq)
    gather = jax.vmap(lambda kk, ii: kk[ii])

    def block(q0):
        t = q0 + jnp.arange(DSA_Q_BLOCK)
        qb = lax.dynamic_slice_in_dim(q, q0, DSA_Q_BLOCK, axis=1)
        iqb = lax.dynamic_slice_in_dim(iq, q0, DSA_Q_BLOCK, axis=1)
        iwb = lax.dynamic_slice_in_dim(iw, q0, DSA_Q_BLOCK, axis=1)
        rel = jax.nn.relu(jnp.einsum('bqhd,bsd->bqhs', iqb, ik).astype(f32))
        score = jnp.einsum('bqhs,bqh->bqs', rel, iwb.astype(f32)) * idx_scale
        score = jnp.where((key_pos[None, :] <= t[:, None])[None], score, -jnp.inf)
        _, sel = lax.top_k(score, top_k)
        k_sel = gather(k, sel)
        v_sel = gather(v, sel)
        dist = t[None, :, None] - sel
        logits = jnp.einsum('bqhd,bqkd->bqhk', qb, k_sel).astype(f32) * scale
        logits = logits + jnp.moveaxis(rel_bias[t5_bucket(dist)], -1, 2).astype(f32)
        p = masked_softmax(logits, (dist >= 0)[:, :, None, :])
        return jnp.einsum('bqhk,bqkd->bqhd', p.astype(v.dtype), v_sel)

    out = lax.map(block, jnp.arange(seq // DSA_Q_BLOCK) * DSA_Q_BLOCK)
    return jnp.moveaxis(out, 0, 1).reshape(bsz, seq, n_heads * hd)


def compress_blocks(kv, pos_emb, w1, w2):
    bsz, seq, g, hd = kv.shape
    nc = (seq - CMP_BLOCK) // CMP_STRIDE + 1
    idx = np.arange(nc)[:, None] * CMP_STRIDE + np.arange(CMP_BLOCK)[None, :]
    blk = kv[:, idx] + pos_emb[:, None, :].astype(kv.dtype)
    blk = jnp.moveaxis(blk, 2, 3).reshape(bsz, nc, g, CMP_BLOCK * hd)
    return jax.nn.silu(blk @ w1) @ w2


def nsa_attention(q, kc, vc, ks, vs, kw, vw, gates, rel_bias):
    f32 = jnp.float32
    bsz, seq, n_heads, hd = q.shape
    g = NSA_KV_GROUPS
    hpg = n_heads // g
    nc = kc.shape[1]
    nsel = seq // SEL_BLOCK
    n_top = min(SEL_TOPN, nsel)
    scale = hd ** -0.5
    cmp_start = jnp.arange(nc) * CMP_STRIDE
    cmp_end = cmp_start + CMP_BLOCK - 1
    sel_start = jnp.arange(nsel) * SEL_BLOCK
    overlap = ((cmp_start[:, None] < sel_start[None, :] + SEL_BLOCK)
               & (cmp_end[:, None] >= sel_start[None, :])).astype(f32)
    ks_blk = jnp.moveaxis(ks.reshape(bsz, nsel, SEL_BLOCK, g, hd), 3, 1)
    vs_blk = jnp.moveaxis(vs.reshape(bsz, nsel, SEL_BLOCK, g, hd), 3, 1)
    kw_pad = jnp.concatenate([jnp.zeros((bsz, WINDOW, g, hd), kw.dtype), kw], axis=1)
    vw_pad = jnp.concatenate([jnp.zeros((bsz, WINDOW, g, hd), vw.dtype), vw], axis=1)
    bias_g = rel_bias.reshape(N_BUCKETS, g, hpg)
    qg = q.reshape(bsz, seq, g, hpg, hd)
    gg = gates.reshape(bsz, seq, 3, g, hpg)
    gather = jax.vmap(jax.vmap(lambda kk, ii: kk[ii]))
    bias_per_group = jax.vmap(lambda bk, tb: tb[bk], in_axes=(1, 1), out_axes=1)
    j = jnp.arange(nsel)

    def block(q0):
        t = q0 + jnp.arange(NSA_Q_BLOCK)
        qb = lax.dynamic_slice_in_dim(qg, q0, NSA_Q_BLOCK, axis=1)
        gb = lax.dynamic_slice_in_dim(gg, q0, NSA_Q_BLOCK, axis=1)[..., None]
        dist_c = t[:, None] - cmp_end[None, :]
        lc = jnp.einsum('bqghd,bcgd->bqghc', qb, kc).astype(f32) * scale
        lc = lc + bias_g[t5_bucket(dist_c)].transpose(0, 2, 3, 1).astype(f32)
        p_c = masked_softmax(lc, (dist_c >= 0)[:, None, None, :])
        o_c = jnp.einsum('bqghc,bcgd->bqghd', p_c.astype(vc.dtype), vc)
        imp = jnp.einsum('bqghc,cn->bqgn', p_c, overlap)
        cur = t // SEL_BLOCK
        forced = (j[None] == 0) | (j[None] == cur[:, None]) | (j[None] == cur[:, None] - 1)
        imp = jnp.where(forced[:, None, :], jnp.inf, imp)
        imp = jnp.where((sel_start[None, :] <= t[:, None])[:, None, :], imp, -jnp.inf)
        _, top_blk = lax.top_k(imp, n_top)
        sel_idx = jnp.moveaxis(top_blk, 2, 1)
        n_keys = n_top * SEL_BLOCK
        k_sel = gather(ks_blk, sel_idx).reshape(bsz, g, NSA_Q_BLOCK, n_keys, hd)
        v_sel = gather(vs_blk, sel_idx).reshape(bsz, g, NSA_Q_BLOCK, n_keys, hd)
        s_pos = (sel_idx[..., None] * SEL_BLOCK + jnp.arange(SEL_BLOCK)).reshape(bsz, g, NSA_Q_BLOCK, n_keys)
        dist_s = t[None, None, :, None] - s_pos
        bias_s = bias_per_group(t5_bucket(dist_s), bias_g)
        ls = jnp.einsum('bqghd,bgqkd->bgqhk', qb, k_sel).astype(f32) * scale
        ls = ls + jnp.moveaxis(bias_s, -1, 3).astype(f32)
        p_s = masked_softmax(ls, (dist_s >= 0)[:, :, :, None, :])
        o_s = jnp.einsum('bgqhk,bgqkd->bqghd', p_s.astype(v_sel.dtype), v_sel)
        kwb = lax.dynamic_slice_in_dim(kw_pad, q0, WINDOW + NSA_Q_BLOCK, axis=1)
        vwb = lax.dynamic_slice_in_dim(vw_pad, q0, WINDOW + NSA_Q_BLOCK, axis=1)
        w_pos = q0 - WINDOW + jnp.arange(WINDOW + NSA_Q_BLOCK)
        dist_w = t[:, None] - w_pos[None, :]
        mask_w = (dist_w >= 0) & (dist_w < WINDOW) & (w_pos[None, :] >= 0)
        lw = jnp.einsum('bqghd,bkgd->bqghk', qb, kwb).astype(f32) * scale
        lw = lw + bias_g[t5_bucket(dist_w)].transpose(0, 2, 3, 1).astype(f32)
        p_w = masked_softmax(lw, mask_w[:, None, None, :])
        o_w = jnp.einsum('bqghk,bkgd->bqghd', p_w.astype(vwb.dtype), vwb)
        return gb[:, :, 0] * o_c + gb[:, :, 1] * o_s + gb[:, :, 2] * o_w

    out = lax.map(block, jnp.arange(seq // NSA_Q_BLOCK) * NSA_Q_BLOCK)
    return jnp.moveaxis(out, 0, 1).reshape(bsz, seq, n_heads * hd)


def even_mixer(h, rel_bias, w_in, conv_w, conv_b, dt_bias, a_log, d_skip, ssm_norm, q_norm, k_norm, w_out):
    bsz, seq, _ = h.shape
    u = h @ w_in
    z, xbc, dt_raw, q, k, v, iq, ik, iw = split_cols(u, EVEN_SPLITS)
    y_ssm = mamba2_mixer(z, xbc, dt_raw, conv_w, conv_b, dt_bias, a_log, d_skip, ssm_norm)
    q = rms_norm(q.reshape(bsz, seq, DSA_HEADS, DSA_HEAD_DIM), q_norm)
    k = rms_norm(k, k_norm)
    y_att = dsa_attention(q, k, v, iq.reshape(bsz, seq, IDX_HEADS, IDX_DIM), ik, iw, rel_bias)
    return jnp.concatenate([y_ssm.astype(h.dtype), y_att.astype(h.dtype)], axis=-1) @ w_out


def odd_mixer(h, rel_bias, w_in, q_norm, kc_norm, ks_norm, kw_norm, pos_k, pos_v, ck_w1, ck_w2, cv_w1, cv_w2, w_out):
    bsz, seq, _ = h.shape
    u = h @ w_in
    q, kc, vc, ks, vs, kw, vw, gl = split_cols(u, ODD_SPLITS)
    grp = lambda a: a.reshape(bsz, seq, NSA_KV_GROUPS, NSA_HEAD_DIM)
    q = rms_norm(q.reshape(bsz, seq, NSA_HEADS, NSA_HEAD_DIM), q_norm)
    kc = rms_norm(compress_blocks(grp(kc), pos_k, ck_w1, ck_w2), kc_norm)
    vc = compress_blocks(grp(vc), pos_v, cv_w1, cv_w2)
    ks = rms_norm(grp(ks), ks_norm)
    kw = rms_norm(grp(kw), kw_norm)
    gates = jax.nn.sigmoid(gl.reshape(bsz, seq, 3, NSA_HEADS))
    o = nsa_attention(q, kc, vc, ks, grp(vs), kw, grp(vw), gates, rel_bias)
    return o.astype(h.dtype) @ w_out


def hier_moe(x, w_group, w_router, w_gate, w_up, w_down):
    f32 = jnp.float32
    bsz, seq, dm = x.shape
    xt = x.reshape(-1, dm)
    n_tok = xt.shape[0]
    g_logits = (xt @ w_group).astype(f32)
    g_sel = jnp.argmax(g_logits, axis=-1)
    g_w = jnp.take_along_axis(jax.nn.softmax(g_logits, axis=-1), g_sel[:, None], axis=-1)
    e_logits = jnp.einsum('nd,gde->nge', xt, w_router).astype(f32)
    e_logits = jnp.take_along_axis(e_logits, g_sel[:, None, None], axis=1)[:, 0]
    e_top, e_idx = lax.top_k(e_logits, TOP_K_INNER)
    e_w = jax.nn.softmax(e_top, axis=-1) * g_w
    expert_id = (g_sel[:, None] * EXPERTS_PER_GROUP + e_idx).reshape(-1)
    token_id = jnp.repeat(jnp.arange(n_tok), TOP_K_INNER)
    weight = e_w.reshape(-1)
    n_assign = n_tok * TOP_K_INNER
    order = jnp.argsort(expert_id)
    se = expert_id[order]
    counts = jnp.zeros(N_EXPERTS, jnp.int32).at[expert_id].add(1)
    padded = (counts + MOE_BLOCK - 1) // MOE_BLOCK * MOE_BLOCK
    pad_end = jnp.cumsum(padded)
    pad_start = pad_end - padded
    start = jnp.cumsum(counts) - counts
    dest = pad_start[se] + (jnp.arange(n_assign) - start[se])
    n_rows = (n_assign + MOE_BLOCK - 1) // MOE_BLOCK * MOE_BLOCK + N_EXPERTS * MOE_BLOCK
    n_blocks = n_rows // MOE_BLOCK
    row_token = jnp.zeros(n_rows, jnp.int32).at[dest].set(token_id[order])
    row_weight = jnp.zeros(n_rows, f32).at[dest].set(weight[order])
    blk_expert = jnp.minimum(jnp.searchsorted(pad_end, jnp.arange(n_blocks) * MOE_BLOCK, side='right'), N_EXPERTS - 1)
    xb = xt[row_token].reshape(n_blocks, MOE_BLOCK, dm)

    def expert_block(args):
        xblk, e = args
        hid = jax.nn.silu(xblk @ w_gate[e]) * (xblk @ w_up[e])
        return hid @ w_down[e]

    yb = lax.map(expert_block, (xb, blk_expert)).reshape(n_rows, dm)
    y = jnp.zeros_like(xt).at[row_token].add(yb * row_weight[:, None].astype(yb.dtype))
    return y.reshape(bsz, seq, dm)


def setup_inputs(seed: int = 0) -> dict:
    key = jax.random.key(seed)
    keys = iter(jax.random.split(key, 40))
    f32 = jnp.float32
    nrm = lambda shape, s: jax.random.normal(next(keys), shape, f32) * s
    gain = lambda shape: 1.0 + 0.02 * jax.random.normal(next(keys), shape, f32)
    dt = jnp.exp(jax.random.uniform(next(keys), (N_EVEN, SSM_HEADS), f32, math.log(1e-3), math.log(1e-1)))
    return {
        'x': nrm((BATCH, SEQ, D_MODEL), 1.0),
        'rel_bias': nrm((N_BUCKETS, N_ATTN_HEADS), 0.3),
        'attn_norm': gain((DEPTH, D_MODEL)),
        'ffn_norm': gain((DEPTH, D_MODEL)),
        'even_w_in': nrm((N_EVEN, D_MODEL, EVEN_COLS), D_MODEL ** -0.5),
        'even_conv_w': nrm((N_EVEN, SSM_CONV, SSM_CONV_CH), SSM_CONV ** -0.5),
        'even_conv_b': nrm((N_EVEN, SSM_CONV_CH), 0.02),
        'even_dt_bias': dt + jnp.log(-jnp.expm1(-dt)),
        'even_a_log': jnp.log(jax.random.uniform(next(keys), (N_EVEN, SSM_HEADS), f32, 1.0, 16.0)),
        'even_d_skip': gain((N_EVEN, SSM_HEADS)),
        'even_ssm_norm': gain((N_EVEN, SSM_D_INNER)),
        'even_q_norm': gain((N_EVEN, DSA_HEAD_DIM)),
        'even_k_norm': gain((N_EVEN, DSA_HEAD_DIM)),
        'even_w_out': nrm((N_EVEN, EVEN_MIX, D_MODEL), EVEN_MIX ** -0.5),
        'odd_w_in': nrm((N_ODD, D_MODEL, ODD_COLS), D_MODEL ** -0.5),
        'odd_q_norm': gain((N_ODD, NSA_HEAD_DIM)),
        'odd_kc_norm': gain((N_ODD, NSA_HEAD_DIM)),
        'odd_ks_norm': gain((N_ODD, NSA_HEAD_DIM)),
        'odd_kw_norm': gain((N_ODD, NSA_HEAD_DIM)),
        'odd_cmp_pos_k': nrm((N_ODD, CMP_BLOCK, NSA_HEAD_DIM), 0.1),
        'odd_cmp_pos_v': nrm((N_ODD, CMP_BLOCK, NSA_HEAD_DIM), 0.1),
        'odd_cmp_k_w1': nrm((N_ODD, CMP_BLOCK * NSA_HEAD_DIM, NSA_HEAD_DIM), (CMP_BLOCK * NSA_HEAD_DIM) ** -0.5),
        'odd_cmp_k_w2': nrm((N_ODD, NSA_HEAD_DIM, NSA_HEAD_DIM), NSA_HEAD_DIM ** -0.5),
        'odd_cmp_v_w1': nrm((N_ODD, CMP_BLOCK * NSA_HEAD_DIM, NSA_HEAD_DIM), (CMP_BLOCK * NSA_HEAD_DIM) ** -0.5),
        'odd_cmp_v_w2': nrm((N_ODD, NSA_HEAD_DIM, NSA_HEAD_DIM), NSA_HEAD_DIM ** -0.5),
        'odd_w_out': nrm((N_ODD, ODD_MIX, D_MODEL), ODD_MIX ** -0.5),
        'moe_router_group': nrm((DEPTH, D_MODEL, MOE_GROUPS), D_MODEL ** -0.5),
        'moe_router_expert': nrm((DEPTH, MOE_GROUPS, D_MODEL, EXPERTS_PER_GROUP), D_MODEL ** -0.5),
        'moe_w_gate': nrm((DEPTH, N_EXPERTS, D_MODEL, EXPERT_FF), D_MODEL ** -0.5),
        'moe_w_up': nrm((DEPTH, N_EXPERTS, D_MODEL, EXPERT_FF), D_MODEL ** -0.5),
        'moe_w_down': nrm((DEPTH, N_EXPERTS, EXPERT_FF, D_MODEL), EXPERT_FF ** -0.5),
    }


def reference(x, rel_bias, attn_norm, ffn_norm,
              even_w_in, even_conv_w, even_conv_b, even_dt_bias, even_a_log, even_d_skip,
              even_ssm_norm, even_q_norm, even_k_norm, even_w_out,
              odd_w_in, odd_q_norm, odd_kc_norm, odd_ks_norm, odd_kw_norm, odd_cmp_pos_k, odd_cmp_pos_v,
              odd_cmp_k_w1, odd_cmp_k_w2, odd_cmp_v_w1, odd_cmp_v_w2, odd_w_out,
              moe_router_group, moe_router_expert, moe_w_gate, moe_w_up, moe_w_down):
    for i in range(DEPTH):
        h = rms_norm(x, attn_norm[i])
        if i % 2 == 0:
            e = i // 2
            x = x + even_mixer(h, rel_bias, even_w_in[e], even_conv_w[e], even_conv_b[e], even_dt_bias[e],
                               even_a_log[e], even_d_skip[e], even_ssm_norm[e], even_q_norm[e], even_k_norm[e],
                               even_w_out[e])
        else:
            o = i // 2
            x = x + odd_mixer(h, rel_bias, odd_w_in[o], odd_q_norm[o], odd_kc_norm[o], odd_ks_norm[o], odd_kw_norm[o],
                              odd_cmp_pos_k[o], odd_cmp_pos_v[o], odd_cmp_k_w1[o], odd_cmp_k_w2[o],
                              odd_cmp_v_w1[o], odd_cmp_v_w2[o], odd_w_out[o])
        h = rms_norm(x, ffn_norm[i])
        x = x + hier_moe(h, moe_router_group[i], moe_router_expert[i], moe_w_gate[i], moe_w_up[i], moe_w_down[i])
    return x
```

```cpp
#include <hip/hip_runtime.h>
#include <cstdio>
#include <cstdint>

#define GAS __attribute__((address_space(1)))
#define LAS __attribute__((address_space(3)))
typedef unsigned short bf16;
typedef short bf16x8 __attribute__((ext_vector_type(8)));
typedef float f32x4 __attribute__((ext_vector_type(4)));
typedef float f32x2 __attribute__((ext_vector_type(2)));
typedef float f32x16 __attribute__((ext_vector_type(16)));
typedef unsigned u32x4 __attribute__((ext_vector_type(4)));
typedef unsigned u32x2 __attribute__((ext_vector_type(2)));
typedef GAS unsigned gu32;
#define RLX_AGENT __ATOMIC_RELAXED, __HIP_MEMORY_SCOPE_AGENT
#define LDS_WAIT() asm volatile("s_waitcnt lgkmcnt(0)" ::: "memory")
#define VM_WAIT() asm volatile("s_waitcnt vmcnt(0)" ::: "memory")

constexpr int NB = 16, SEQ = 4096, DM = 1024, MTOK = NB * SEQ;
constexpr float NORM_EPS = 1e-6f;
constexpr int LDE = 2560;
constexpr int EZ = 0, EXS = 512, EBB = 1024, ECC = 1280, EQ = 1536, EK = 2048, EV = 2112, EIQ = 2176, EIK = 2432, EDT = 2496, EIW = 2504;
constexpr int LDO = 2560;
constexpr int OQ = 0, OKC = 1024, OVC = 1280, OKS = 1536, OVS = 1792, OKW = 2048, OVW = 2304;
constexpr int NWAVES = 8, NTHR = 512;

constexpr size_t MiB = 1u << 20;
constexpr size_t WS_CTL = 0, CTL_ZERO_BYTES = 1 * MiB;
constexpr size_t WS_WIE = 1 * MiB, WS_WOE = 6 * MiB, WS_WIO = 8 * MiB, WS_WOO = 13 * MiB;
constexpr size_t WS_W1K = 15 * MiB, WS_W1V = 16 * MiB, WS_W2 = 17 * MiB, WS_WR = 18 * MiB;
constexpr size_t WS_WGL = WS_WR + 256 * 1024;
constexpr size_t WS_TOK = 19 * MiB;
constexpr size_t WS_GL = 20 * MiB;
constexpr size_t WS_KCMP = 26 * MiB, WS_VCMP = 28 * MiB;
constexpr size_t WS_LIST = 32 * MiB;
constexpr size_t WS_WGU = 48 * MiB;
constexpr size_t WS_WD = 176 * MiB;
constexpr size_t WS_HB = 240 * MiB;
constexpr size_t WS_U = 368 * MiB;
constexpr size_t WS_LISTW = 720 * MiB;
constexpr size_t WS_END = 736 * MiB;
constexpr int CW_TMO = 0, CW_CODE = 1, CW_BAR = 4096, CW_CNT = 8192;

constexpr int RING_BYTES = 131072;
constexpr int LDS_BYTES = 147456;
constexpr int MISC_OFF = LDS_BYTES - 256;
constexpr int MOE_OFF = LDS_BYTES - 2048;

__device__ __forceinline__ unsigned f2bf(float f) { unsigned u = __builtin_bit_cast(unsigned, f); return (u + 0x7fffu + ((u >> 16) & 1u)) >> 16; }
__device__ __forceinline__ unsigned pk2(float lo, float hi) { return f2bf(lo) | (f2bf(hi) << 16); }
__device__ __forceinline__ float bf2f(unsigned short b) { return __builtin_bit_cast(float, ((unsigned)b) << 16); }
__device__ __forceinline__ float bflo(unsigned w) { return __builtin_bit_cast(float, w << 16); }
__device__ __forceinline__ float bfhi(unsigned w) { return __builtin_bit_cast(float, w & 0xffff0000u); }
__device__ __forceinline__ float siluf(float v) { return v / (1.f + __expf(-v)); }

#define XB_TMO      128
#define XB_XCNT(j)  (256  + 64 * (j))
#define XB_XSUB(j)  (1280 + 64 * (j))
#define XB_XGEN(j)  (2304 + 64 * (j))
#define XB_TOP      3328
#define XB_TOPGEN   3392
#define XCD_BAR_WORDS 3456
#define XB_SPIN_CAP (1u << 20)
__device__ __forceinline__ unsigned xb_ld(unsigned* p)              { return __hip_atomic_load(p, __ATOMIC_RELAXED, __HIP_MEMORY_SCOPE_AGENT); }
__device__ __forceinline__ unsigned xb_add(unsigned* p, unsigned v) { return __hip_atomic_fetch_add(p, v, __ATOMIC_RELAXED, __HIP_MEMORY_SCOPE_AGENT); }
__device__ __forceinline__ unsigned xb_xcc_id() { return (unsigned)__builtin_amdgcn_s_getreg((3 << 11) | 20) & 0xFu; }
#define XB_SPIN(cond, bar) do { unsigned _sp = 0; while (cond) { __builtin_amdgcn_s_sleep(1); \
    if ((++_sp & 255u) == 0u) { if (xb_ld(&(bar)[XB_TMO])) break; if (_sp > XB_SPIN_CAP) { atomicAdd(&(bar)[XB_TMO], 1u); break; } } } } while (0)
struct XcdBarrier { unsigned* bar; unsigned x; volatile LAS unsigned* st; };
__device__ __forceinline__ XcdBarrier xcd_barrier_post(unsigned* bar, volatile LAS unsigned* st) {
    XcdBarrier b; b.bar = bar; b.x = xb_xcc_id(); b.st = st;
    if (threadIdx.x == 0) (void)xb_add(&bar[XB_XCNT(b.x)], 1u);
    return b;
}
__device__ __forceinline__ void xcd_barrier_complete(unsigned* bar, unsigned x, unsigned& nloc, unsigned& nx) {
    const unsigned G = gridDim.x * gridDim.y * gridDim.z;
    unsigned sum, cnt, mine, sp = 0u;
    for (;;) {
        sum = 0u; cnt = 0u; mine = 0u;
#pragma unroll
        for (unsigned j = 0; j < 16; ++j) { const unsigned c = xb_ld(&bar[XB_XCNT(j)]); sum += c; cnt += (c > 0u) ? 1u : 0u; mine = (j == x) ? c : mine; }
        if (sum == G) break;
        __builtin_amdgcn_s_sleep(1);
        if ((++sp & 255u) == 0u) { if (xb_ld(&bar[XB_TMO])) break; if (sp > XB_SPIN_CAP) { atomicAdd(&bar[XB_TMO], 1u); break; } }
    }
    nloc = mine > 0u ? mine : 1u; nx = cnt > 0u ? cnt : 1u;
}
__device__ __forceinline__ void xcd_barrier(const XcdBarrier& b) {
    asm volatile("s_waitcnt vmcnt(0)" ::: "memory");
    __syncthreads();
    if (threadIdx.x == 0) {
        unsigned* bar = b.bar;
        __builtin_amdgcn_s_waitcnt(0);
        unsigned nloc = b.st[0], nx = b.st[1];
        if (nloc == 0u) { xcd_barrier_complete(bar, b.x, nloc, nx); b.st[0] = nloc; b.st[1] = nx; }
        const unsigned old = xb_add(&bar[XB_XSUB(b.x)], 1u);
        const unsigned gen = old / nloc;
        if (old + 1u == (gen + 1u) * nloc) {
            __builtin_amdgcn_fence(__ATOMIC_RELEASE, "agent");
            asm volatile("s_waitcnt vmcnt(0)" ::: "memory");
            const unsigned og = xb_add(&bar[XB_TOP], 1u);
            const unsigned tg = og / nx;
            if (og + 1u == (tg + 1u) * nx) xb_add(&bar[XB_TOPGEN], 1u);
            else XB_SPIN(xb_ld(&bar[XB_TOPGEN]) == tg, bar);
            __builtin_amdgcn_fence(__ATOMIC_ACQUIRE, "agent");
            xb_add(&bar[XB_XGEN(b.x)], 1u);
            asm volatile("s_waitcnt vmcnt(0)" ::: "memory");
        } else {
            XB_SPIN(xb_ld(&bar[XB_XGEN(b.x)]) == gen, bar);
            __builtin_amdgcn_fence(__ATOMIC_ACQUIRE, "agent");
            asm volatile("s_waitcnt vmcnt(0)" ::: "memory");
        }
    }
    __syncthreads();
}

namespace pg8 {
constexpr int BM = 256, BK = 64, HALF = 128, HTB = HALF * BK * 2, STAGE_BYTES = 8 * HTB, NXCD = 8, WGM = 8;
__host__ __device__ __forceinline__ int lds_byte(int r, int c) { const int st = (r >> 4) * 2 + (c >> 5), rr = r & 15, cc = c & 31, ob = rr * 64 + cc * 2; return st * 1024 + (ob ^ (((ob >> 9) & 1) << 5)); }
__host__ __device__ __forceinline__ void stage_rc(int b, int& R, int& C) { const int st = b / 1024, sb = b % 1024, swz = sb ^ (((sb >> 9) & 1) << 5); R = (st >> 1) * 16 + swz / 64; C = (st & 1) * 32 + (swz % 64) / 2; }
__host__ __device__ __forceinline__ int perm32(int rho) { const int n = rho >> 4, i = rho & 15; return 8 * (i >> 2) + 4 * n + (i & 3); }
__device__ __forceinline__ unsigned cvt_pk_bf16(float lo, float hi) { unsigned r; asm volatile("v_cvt_pk_bf16_f32 %0, %1, %2" : "=v"(r) : "v"(lo), "v"(hi)); return r; }

struct Unit { const char* A; const char* B; int pm, pn, aux; };

struct StaticOrder {
    const char* A; const char* Bt; int K, nM, nN, nwg, G, c;
    __device__ void init(const void* A_, const void* Bt_, int M, int N, int K_, int G_, int c_) { A = (const char*)A_; Bt = (const char*)Bt_; K = K_; nM = M / BM; nN = N / BM; nwg = nM * nN; G = G_; c = c_; }
    __device__ __forceinline__ bool next(int i, Unit& u) const {
        const long L = (long)i * G + c; if (L >= nwg) return false;
        int wgid = (int)L; { const int q = nwg / NXCD, r = nwg % NXCD, xcd = wgid % NXCD, off = wgid / NXCD; wgid = (xcd < r ? xcd * (q + 1) : r * (q + 1) + (xcd - r) * q) + off; }
        const int nig = WGM * nN, gid = wgid / nig, fm = gid * WGM, gsz = (nM - fm) < WGM ? (nM - fm) : WGM;
        u.pm = fm + ((wgid % nig) % gsz); u.pn = (wgid % nig) / gsz; u.aux = 0;
        u.A = A + (size_t)u.pm * BM * K * 2; u.B = Bt + (size_t)u.pn * BM * K * 2; return true;
    }
    __device__ __forceinline__ unsigned arow(const Unit&, int r) const { return (unsigned)(r * K) * 2u; }
};

template <class Epi, class Sched, bool ALIGN_EPI>
__device__ __forceinline__ void gemm_phase(LAS unsigned char* lds, const int K, const Sched& S, const Epi& E) {
    const int tid = threadIdx.x, wid = __builtin_amdgcn_readfirstlane(tid >> 6), lane = tid & 63, wr = wid >> 2, wc = wid & 3, fr = lane & 15, fq = lane >> 4;
    const int nt = K / BK;
    int RA[2], CA[2]; unsigned voffB[2];
#pragma unroll
    for (int i = 0; i < 2; ++i) { int R, C; stage_rc(tid * 16 + i * 8192, R, C); const int Rb = Epi::PERM ? ((R & ~31) + perm32(R & 31)) : R;
        RA[i] = R; CA[i] = C; voffB[i] = (unsigned)(Rb * K + C) * 2u; }
    const size_t kstep = (size_t)(BK * 2);
    const size_t hstep = (size_t)HALF * K * 2;
    const unsigned ldsw = (unsigned)wid * 1024u;
    const int aoff = lds_byte(wr * 64 + fr, fq * 8), boff = lds_byte(wc * 32 + fr, fq * 8);
#define PG8_SA(b, h) (((b) * 2 + (h)) * HTB)
#define PG8_SB(b, h) ((4 + (b) * 2 + (h)) * HTB)
#define PG8_STAGE(bufoff, gbase, voff) do { _Pragma("unroll") for (int _i = 0; _i < 2; ++_i) \
        __builtin_amdgcn_global_load_lds((const unsigned*)((const char*)(gbase) + (voff)[_i]), (LAS unsigned*)(lds + (bufoff) + ldsw + _i * 8192), 16, 0, 0); } while (0)
#define PG8_LDA(dst, b, h) do { _Pragma("unroll") for (int m = 0; m < 4; ++m) _Pragma("unroll") for (int k = 0; k < 2; ++k) dst[m][k] = *(const LAS bf16x8*)(lds + PG8_SA(b, h) + aoff + m * 2048 + k * 1024); } while (0)
#define PG8_LDB(dst, b, h) do { _Pragma("unroll") for (int n = 0; n < 2; ++n) _Pragma("unroll") for (int k = 0; k < 2; ++k) dst[n][k] = *(const LAS bf16x8*)(lds + PG8_SB(b, h) + boff + n * 2048 + k * 1024); } while (0)
#define PG8_MMA(ai, bj, At, Bt) do { __builtin_amdgcn_s_setprio(1); _Pragma("unroll") for (int m = 0; m < 4; ++m) _Pragma("unroll") for (int n = 0; n < 2; ++n) _Pragma("unroll") for (int k = 0; k < 2; ++k) \
        acc[ai][bj][m][n] = __builtin_amdgcn_mfma_f32_16x16x32_bf16(Bt[n][k], At[m][k], acc[ai][bj][m][n], 0, 0, 0); __builtin_amdgcn_s_setprio(0); } while (0)
#define PG8_WAIT_V(n) asm volatile("s_waitcnt vmcnt(" #n ")" ::: "memory")
#define PG8_WAIT_L(n) asm volatile("s_waitcnt lgkmcnt(" #n ")" ::: "memory")
#define PG8_BAR __builtin_amdgcn_s_barrier()
#define PG8_SCHED __builtin_amdgcn_sched_barrier(0)
    Unit cur, nxt; int ui = 0;
    if (!S.next(0, cur)) return;
    f32x4 acc[2][2][4][2];
#pragma unroll
    for (int a = 0; a < 2; ++a)
#pragma unroll
        for (int b = 0; b < 2; ++b)
#pragma unroll
            for (int m = 0; m < 4; ++m)
#pragma unroll
                for (int n = 0; n < 2; ++n) acc[a][b][m][n] = (f32x4){0.f, 0.f, 0.f, 0.f};
    bf16x8 At[4][2], B0[2][2], B1[2][2];
    unsigned vA0[2], vA1[2], nA0[2], nA1[2];
#pragma unroll
    for (int i = 0; i < 2; ++i) { vA0[i] = S.arow(cur, RA[i]) + CA[i] * 2u; vA1[i] = S.arow(cur, HALF + RA[i]) + CA[i] * 2u; nA0[i] = vA0[i]; nA1[i] = vA1[i]; }
    const char* cA = cur.A; const char* cB = cur.B;
    PG8_STAGE(PG8_SB(0, 0), cB, voffB); PG8_STAGE(PG8_SB(0, 1), cB + hstep, voffB); PG8_STAGE(PG8_SA(0, 0), cA, vA0); PG8_STAGE(PG8_SA(0, 1), cA, vA1);
    if (wr == 1) PG8_BAR;
    PG8_WAIT_V(2); PG8_BAR;
    PG8_STAGE(PG8_SB(1, 0), cB + kstep, voffB); PG8_STAGE(PG8_SA(1, 0), cA + kstep, vA0); PG8_STAGE(PG8_SB(1, 1), cB + hstep + kstep, voffB);
    PG8_WAIT_V(6); PG8_BAR;
    for (;;) {
        const bool has_next = S.next(ui + 1, nxt);
        const char* nA = has_next ? nxt.A : cA; const char* nB = has_next ? nxt.B : cB;
        if (has_next) {
#pragma unroll
            for (int i = 0; i < 2; ++i) { nA0[i] = S.arow(nxt, RA[i]) + CA[i] * 2u; nA1[i] = S.arow(nxt, HALF + RA[i]) + CA[i] * 2u; }
        }
        for (int t = 0; t < nt; t += 2) {
            const bool last = (t == nt - 2);
            const char* a1 = cA + (size_t)(t + 1) * kstep;
            const char* a2 = last ? nA : cA + (size_t)(t + 2) * kstep; const char* b2 = last ? nB : cB + (size_t)(t + 2) * kstep;
            const char* a3 = a2 + kstep; const char* b3 = b2 + kstep;
            unsigned w0[2], w1[2];
#pragma unroll
            for (int i = 0; i < 2; ++i) { w0[i] = last ? nA0[i] : vA0[i]; w1[i] = last ? nA1[i] : vA1[i]; }
            PG8_LDB(B0, 0, 0); PG8_LDB(B1, 0, 1); PG8_SCHED; PG8_LDA(At, 0, 0); PG8_STAGE(PG8_SA(1, 1), a1, vA1);
            PG8_WAIT_V(8); PG8_WAIT_L(0); PG8_BAR; PG8_MMA(0, 0, At, B0); PG8_MMA(0, 1, At, B1); PG8_BAR; PG8_SCHED;
            PG8_LDA(At, 0, 1); PG8_STAGE(PG8_SB(0, 0), b2, voffB); PG8_STAGE(PG8_SB(0, 1), b2 + hstep, voffB); PG8_STAGE(PG8_SA(0, 0), a2, w0);
            PG8_WAIT_V(8); PG8_WAIT_L(0); PG8_BAR; PG8_MMA(1, 0, At, B0); PG8_MMA(1, 1, At, B1); PG8_BAR; PG8_SCHED;
            PG8_LDB(B0, 1, 0); PG8_LDB(B1, 1, 1); PG8_SCHED; PG8_LDA(At, 1, 0); PG8_STAGE(PG8_SA(0, 1), a2, w1);
            PG8_WAIT_V(8); PG8_WAIT_L(0); PG8_BAR; PG8_MMA(0, 0, At, B0); PG8_MMA(0, 1, At, B1); PG8_BAR; PG8_SCHED;
            PG8_LDA(At, 1, 1); PG8_STAGE(PG8_SB(1, 0), b3, voffB); PG8_STAGE(PG8_SB(1, 1), b3 + hstep, voffB); PG8_STAGE(PG8_SA(1, 0), a3, w0);
            PG8_WAIT_V(8); PG8_WAIT_L(0); PG8_BAR; PG8_MMA(1, 0, At, B0); PG8_MMA(1, 1, At, B1); PG8_BAR; PG8_SCHED;
        }
        if constexpr (ALIGN_EPI) { if (wr == 0) PG8_BAR; }
        E(acc, cur, wr, wc, fr, fq);
        if (!has_next) break;
#pragma unroll
        for (int a = 0; a < 2; ++a)
#pragma unroll
            for (int b = 0; b < 2; ++b)
#pragma unroll
                for (int m = 0; m < 4; ++m)
#pragma unroll
                    for (int n = 0; n < 2; ++n) acc[a][b][m][n] = (f32x4){0.f, 0.f, 0.f, 0.f};
        cur = nxt; cA = nA; cB = nB; ++ui;
#pragma unroll
        for (int i = 0; i < 2; ++i) { vA0[i] = nA0[i]; vA1[i] = nA1[i]; }
        if constexpr (ALIGN_EPI) { if (wr == 1) PG8_BAR; }
    }
    PG8_WAIT_V(0);
    if constexpr (!ALIGN_EPI) { if (wr == 0) PG8_BAR; }
    PG8_BAR;
#undef PG8_SA
#undef PG8_SB
#undef PG8_STAGE
#undef PG8_LDA
#undef PG8_LDB
#undef PG8_MMA
#undef PG8_WAIT_V
#undef PG8_WAIT_L
#undef PG8_BAR
#undef PG8_SCHED
}

struct EpiBf16 {
    static constexpr bool PERM = true;
    bf16* O; int ldc;
    __device__ __forceinline__ void operator()(const f32x4 (&acc)[2][2][4][2], const Unit& u, int wr, int wc, int fr, int fq) const {
        const int row0 = u.pm * BM + wr * 64 + fr; const int col0 = u.pn * BM + wc * 32 + 8 * fq;
#pragma unroll
        for (int ai = 0; ai < 2; ++ai)
#pragma unroll
            for (int m = 0; m < 4; ++m) { bf16* rowp = O + (size_t)(row0 + ai * HALF + m * 16) * ldc + col0;
#pragma unroll
                for (int bj = 0; bj < 2; ++bj) { const f32x4 v0 = acc[ai][bj][m][0], v1 = acc[ai][bj][m][1];
                    u32x4 w; w.x = cvt_pk_bf16(v0[0], v0[1]); w.y = cvt_pk_bf16(v0[2], v0[3]); w.z = cvt_pk_bf16(v1[0], v1[1]); w.w = cvt_pk_bf16(v1[2], v1[3]);
                    *(u32x4*)(rowp + bj * HALF) = w; } }
    }
};
struct EpiResF32 {
    static constexpr bool PERM = false;
    const float* base; float* out; int ldc;
    __device__ __forceinline__ void operator()(const f32x4 (&acc)[2][2][4][2], const Unit& u, int wr, int wc, int fr, int fq) const {
        const int row0 = u.pm * BM + wr * 64 + fr, col0 = u.pn * BM + wc * 32 + 4 * fq;
#pragma unroll
        for (int ai = 0; ai < 2; ++ai)
#pragma unroll
            for (int m = 0; m < 4; ++m) { const size_t off = (size_t)(row0 + ai * HALF + m * 16) * ldc + col0;
#pragma unroll
                for (int bj = 0; bj < 2; ++bj)
#pragma unroll
                    for (int n = 0; n < 2; ++n) { const f32x4 bs = *(const f32x4*)(base + off + bj * HALF + n * 16); *(f32x4*)(out + off + bj * HALF + n * 16) = bs + acc[ai][bj][m][n]; } }
    }
};

struct MoeOrder {
    const char* Abase; const char* Bbase; size_t bstride; int K, G, c, tile_lo, tile_hi; const LAS int* ptile; const LAS int* cntv; const int* list; bool gather;
    __device__ __forceinline__ bool next(int i, Unit& u) const {
        const long L = (long)i * G + c; const int nun = (tile_hi - tile_lo) * 4; if (L >= nun) return false;
        const int tile = tile_lo + (int)(L >> 2), pn = (int)(L & 3);
        int e = 0;
        for (int k = 1; k < 64; ++k) e += (tile >= __builtin_amdgcn_readfirstlane(ptile[k])) ? 1 : 0;
        const int j = tile - __builtin_amdgcn_readfirstlane(ptile[e]);
        u.pm = tile; u.pn = pn; u.aux = e | (j << 6);
        u.A = gather ? Abase : Abase + (size_t)tile * BM * K * 2; u.B = Bbase + (size_t)(e & 31) * bstride + (size_t)pn * BM * K * 2; return true;
    }
    __device__ __forceinline__ unsigned arow(const Unit& u, int r) const {
        if (!gather) return (unsigned)(r * K) * 2u;
        const int e = u.aux & 63, pos = (u.aux >> 6) * 256 + r; const int cn = cntv[e];
        const int tok = pos < cn ? list[(size_t)e * 65536 + pos] : 0;
        return (unsigned)tok * (unsigned)(K * 2);
    }
};
struct EpiSwiGLU {
    static constexpr bool PERM = true;
    bf16* H;
    __device__ __forceinline__ void operator()(const f32x4 (&acc)[2][2][4][2], const Unit& u, int wr, int wc, int fr, int fq) const {
        const int row0 = u.pm * BM + wr * 64 + fr; const int col0 = u.pn * 128 + wc * 32 + 8 * fq;
#pragma unroll
        for (int ai = 0; ai < 2; ++ai)
#pragma unroll
            for (int m = 0; m < 4; ++m) { bf16* rowp = H + (size_t)(row0 + ai * HALF + m * 16) * 512 + col0;
                const f32x4 g0 = acc[ai][0][m][0], g1 = acc[ai][0][m][1], u0 = acc[ai][1][m][0], u1 = acc[ai][1][m][1];
                float h[8];
#pragma unroll
                for (int q = 0; q < 4; ++q) { h[q] = g0[q] / (1.f + __expf(-g0[q])) * u0[q]; h[4 + q] = g1[q] / (1.f + __expf(-g1[q])) * u1[q]; }
                u32x4 w; w.x = cvt_pk_bf16(h[0], h[1]); w.y = cvt_pk_bf16(h[2], h[3]); w.z = cvt_pk_bf16(h[4], h[5]); w.w = cvt_pk_bf16(h[6], h[7]);
                *(u32x4*)rowp = w; }
    }
};
struct EpiScatter {
    static constexpr bool PERM = false;
    float* out; const int* list; const float* wl; const LAS int* cntv;
    __device__ __forceinline__ void operator()(const f32x4 (&acc)[2][2][4][2], const Unit& u, int wr, int wc, int fr, int fq) const {
        const int e = u.aux & 63, j = u.aux >> 6; const int cn = cntv[e];
        const int col0 = u.pn * BM + wc * 32 + 4 * fq;
#pragma unroll
        for (int ai = 0; ai < 2; ++ai)
#pragma unroll
            for (int m = 0; m < 4; ++m) { const int pos = j * 256 + ai * HALF + wr * 64 + m * 16 + fr;
                if (pos < cn) { const int tok = list[(size_t)e * 65536 + pos]; const float wg = wl[(size_t)e * 65536 + pos];
                    float* rowp = out + (size_t)tok * DM + col0;
#pragma unroll
                    for (int bj = 0; bj < 2; ++bj)
#pragma unroll
                        for (int n = 0; n < 2; ++n) { f32x4* p = (f32x4*)(rowp + bj * HALF + n * 16); *p = *p + wg * acc[ai][bj][m][n]; } } }
    }
};
}

struct Frame {
    LAS unsigned char* lds;
    volatile LAS unsigned* MISC;
    gu32* ctl;
    int tid, lane, wave, G, bid;
    float* out; unsigned char* ws;
};
struct Args { const float* in[31]; float* out; unsigned char* ws; int ph_lo, ph_hi; };
__device__ __forceinline__ float wave_sum(float v) {
#pragma unroll
    for (int o = 1; o < 64; o <<= 1) v += __shfl_xor(v, o);
    return v;
}

template <class Map>
__device__ __forceinline__ void transpose_item(const float* W, int K, int pitch, int col0, int ncols, bf16* WT, LAS float* scr, int item, int lane, Map dmap) {
    const int nblk = (ncols + 31) / 32, kb = item / nblk, nb = item % nblk, k0 = 64 * kb, n0 = 32 * nb;
    const int nn = n0 + (lane & 31);
#pragma unroll 8
    for (int i = 0; i < 32; ++i) { const int kk = 2 * i + (lane >> 5); scr[kk * 33 + (lane & 31)] = (nn < ncols) ? W[(size_t)(k0 + kk) * pitch + col0 + nn] : 0.f; }
    LDS_WAIT(); asm volatile("" ::: "memory");
    const int c = lane & 7;
#pragma unroll
    for (int j = 0; j < 4; ++j) { const int n = (lane >> 3) + 8 * j; const LAS float* s = scr + (8 * c) * 33 + n;
        u32x4 o; o.x = pk2(s[0 * 33], s[1 * 33]); o.y = pk2(s[2 * 33], s[3 * 33]); o.z = pk2(s[4 * 33], s[5 * 33]); o.w = pk2(s[6 * 33], s[7 * 33]);
        if (n0 + n < ncols) *(u32x4*)(WT + (size_t)dmap(n0 + n) * K + k0 + 8 * c) = o; }
    LDS_WAIT(); asm volatile("" ::: "memory");
}
struct MapId { int off; __device__ int operator()(int n) const { return n + off; } };
struct MapEven { __device__ int operator()(int c) const {
    if (c < 1536) return c; if (c < 1544) return EDT + (c - 1536); if (c < 2056) return EQ + (c - 1544); if (c < 2120) return EK + (c - 2056);
    if (c < 2184) return EV + (c - 2120); if (c < 2440) return EIQ + (c - 2184); if (c < 2504) return EIK + (c - 2440); return EIW + (c - 2504); } };
struct MapGU { int half; __device__ int operator()(int n) const { return 256 * (n >> 7) + 128 * half + (n & 127); } };

__device__ __forceinline__ void rms_row_to_bf16(const float* xrow, const float* gain, bf16* orow, int lane) {
    const f32x4* xr = (const f32x4*)xrow + lane; const f32x4* gr = (const f32x4*)gain + lane;
    f32x4 v[4]; float s = 0.f;
#pragma unroll
    for (int j = 0; j < 4; ++j) { v[j] = xr[64 * j]; s += (v[j].x * v[j].x + v[j].y * v[j].y) + (v[j].z * v[j].z + v[j].w * v[j].w); }
    const float rs = 1.f / sqrtf(wave_sum(s) * (1.f / DM) + NORM_EPS);
    unsigned long long* o8 = (unsigned long long*)orow + lane;
#pragma unroll
    for (int j = 0; j < 4; ++j) { const f32x4 g = gr[64 * j]; o8[64 * j] = (unsigned long long)pk2(v[j].x * rs * g.x, v[j].y * rs * g.y) | ((unsigned long long)pk2(v[j].z * rs * g.z, v[j].w * rs * g.w) << 32); }
}

__device__ __forceinline__ void p_prologue(Frame& F, const Args& A) {
    LAS float* scr = (LAS float*)(F.lds + F.wave * 16384);
    const int gw = F.bid * NWAVES + F.wave, NGW = F.G * NWAVES;
    bf16* Wie = (bf16*)(F.ws + WS_WIE); bf16* Woe = (bf16*)(F.ws + WS_WOE);
    constexpr int I_IE = 16 * 79, I_OE = 16 * 32;
    for (int it = gw; it < I_IE + I_OE; it += NGW) {
        if (it < I_IE) transpose_item(A.in[4], 1024, 2508, 0, 2508, Wie, scr, it, F.lane, MapEven());
        else transpose_item(A.in[13], 1024, 1024, 0, 1024, Woe, scr, it - I_IE, F.lane, MapId{0});
    }
    {
        bf16* Wgu = (bf16*)(F.ws + WS_WGU); bf16* Wd = (bf16*)(F.ws + WS_WD); bf16* WR = (bf16*)(F.ws + WS_WR);
        for (int it = gw; it < 64 * 768; it += NGW) { const int le = it / 768, r = it % 768;
            if (r < 256) transpose_item(A.in[28] + (size_t)le * 1024 * 512, 1024, 512, 0, 512, Wgu + (size_t)le * 1024 * 1024, scr, r, F.lane, MapGU{0});
            else if (r < 512) transpose_item(A.in[29] + (size_t)le * 1024 * 512, 1024, 512, 0, 512, Wgu + (size_t)le * 1024 * 1024, scr, r - 256, F.lane, MapGU{1});
            else transpose_item(A.in[30] + (size_t)le * 512 * 1024, 512, 1024, 0, 1024, Wd + (size_t)le * 1024 * 512, scr, r - 512, F.lane, MapId{0}); }
        for (int it = gw; it < 2 * 5 * 16; it += NGW) { const int l = it / 80, r = it % 80, q = r / 16, kb = r % 16;
            if (q == 0) transpose_item(A.in[26] + (size_t)l * 1024 * 4, 1024, 4, 0, 4, WR + (size_t)l * 48 * 1024, scr, kb, F.lane, MapId{0});
            else transpose_item(A.in[27] + (size_t)(l * 4 + q - 1) * 1024 * 8, 1024, 8, 0, 8, WR + (size_t)l * 48 * 1024, scr, kb, F.lane, MapId{4 + 8 * (q - 1)}); }
        for (int i = gw * 64 + F.lane; i < 2 * 12 * 1024 / 8; i += NGW * 64) { const int l = i / (12 * 128), o = i % (12 * 128); *(u32x4*)(WR + (size_t)l * 48 * 1024 + 36 * 1024 + (size_t)o * 8) = (u32x4){0u, 0u, 0u, 0u}; }
    }
    {
        bf16* Wio = (bf16*)(F.ws + WS_WIO); bf16* Woo = (bf16*)(F.ws + WS_WOO); bf16* WGL = (bf16*)(F.ws + WS_WGL);
        bf16* W1K = (bf16*)(F.ws + WS_W1K); bf16* W1V = (bf16*)(F.ws + WS_W1V); bf16* W2 = (bf16*)(F.ws + WS_W2);
        constexpr int J0 = 16 * 80, J1 = J0 + 16, J2 = J1 + 16 * 32, J3 = J2 + 64 * 4, J4 = J3 + 64 * 4, J5 = J4 + 2 * 4, J6 = J5 + 2 * 4;
        for (int it = gw; it < J6; it += NGW) {
            if (it < J0) transpose_item(A.in[14], 1024, 2584, 0, 2560, Wio, scr, it, F.lane, MapId{0});
            else if (it < J1) transpose_item(A.in[14], 1024, 2584, 2560, 24, WGL, scr, it - J0, F.lane, MapId{0});
            else if (it < J2) transpose_item(A.in[25], 1024, 1024, 0, 1024, Woo, scr, it - J1, F.lane, MapId{0});
            else if (it < J3) transpose_item(A.in[21], 4096, 128, 0, 128, W1K, scr, it - J2, F.lane, MapId{0});
            else if (it < J4) transpose_item(A.in[23], 4096, 128, 0, 128, W1V, scr, it - J3, F.lane, MapId{0});
            else if (it < J5) transpose_item(A.in[22], 128, 128, 0, 128, W2, scr, it - J4, F.lane, MapId{0});
            else transpose_item(A.in[24], 128, 128, 0, 128, W2 + 128 * 128, scr, it - J5, F.lane, MapId{0});
        }
        for (int i = gw * 64 + F.lane; i < 8 * 1024 / 8; i += NGW * 64) *(u32x4*)(WGL + 24 * 1024 + (size_t)i * 8) = (u32x4){0u, 0u, 0u, 0u};
    }
    for (int i = gw * 64 + F.lane; i < 52 * 1024 / 8; i += NGW * 64) *(u32x4*)(Wie + (size_t)2508 * 1024 + (size_t)i * 8) = (u32x4){0u, 0u, 0u, 0u};
    bf16* HB = (bf16*)(F.ws + WS_HB);
    for (int m = gw; m < MTOK; m += NGW) rms_row_to_bf16(A.in[0] + (size_t)m * DM, A.in[2], HB + (size_t)m * DM, F.lane);
}

constexpr int SP = 136;
constexpr int L_CS = 0, L_BS = 34816, L_BT = 69632, L_XT = 104448, L_XS = 113152, L_ST = 121856, L_AC = 139264, L_DT = 139776, L_CW = 140288;
__device__ __forceinline__ bf16x8 lds_frag(LAS unsigned char* base, int row, int col) { return *(const LAS bf16x8*)(base + (row * SP + col) * 2); }

__device__ __forceinline__ void p_ssd(Frame& F, const Args& A) {
    bf16* U = (bf16*)(F.ws + WS_U);
    const int w = F.wave;
    { const int tid = F.tid;
    for (int r0 = F.bid * 64; r0 < MTOK; r0 += F.G * 64) {
        const int row = r0 + (tid >> 3), c8 = (tid & 7) * 8;
        bf16* p = U + (size_t)row * LDE + EK + c8;
        const u32x4 v = *(const u32x4*)p; float f[8] = {bflo(v.x), bfhi(v.x), bflo(v.y), bfhi(v.y), bflo(v.z), bfhi(v.z), bflo(v.w), bfhi(v.w)};
        float s = 0.f;
#pragma unroll
        for (int j = 0; j < 8; ++j) s += f[j] * f[j];
        s += __shfl_xor(s, 1); s += __shfl_xor(s, 2); s += __shfl_xor(s, 4);
        const float rs = 1.f / sqrtf(s * (1.f / 64.f) + NORM_EPS); const float* g = A.in[12] + c8;
        u32x4 o; o.x = pk2(f[0] * rs * g[0], f[1] * rs * g[1]); o.y = pk2(f[2] * rs * g[2], f[3] * rs * g[3]); o.z = pk2(f[4] * rs * g[4], f[5] * rs * g[5]); o.w = pk2(f[6] * rs * g[6], f[7] * rs * g[7]);
        *(u32x4*)p = o;
    } }
    LAS unsigned char* L = F.lds;
    LAS float* acum = (LAS float*)(L + L_AC); LAS float* dtv = (LAS float*)(L + L_DT); LAS float* cw = (LAS float*)(L + L_CW);
    const float* conv_w = A.in[5]; const float* conv_b = A.in[6];
    for (int st = F.bid; st < 256; st += F.G) {
        const int b = st >> 4, h = (st >> 1) & 7, ph = st & 1, g = h >> 2;
        { const int tid = F.tid;
        __syncthreads();
        for (int i = tid; i < 5 * 288; i += NTHR) { const int j = i / 288, lc = i % 288;
            const int ch = lc < 128 ? 512 + g * 128 + lc : (lc < 256 ? 768 + g * 128 + (lc - 128) : h * 64 + ph * 32 + (lc - 256));
            cw[i] = j < 4 ? conv_w[j * 1024 + ch] : conv_b[ch]; }
        for (int i = tid; i < 2 * 32 * SP / 2; i += NTHR) ((LAS unsigned*)(L + L_ST))[i] = 0u; }
        const float a_h = -__expf(A.in[8][h]), dtb = A.in[7][h], dsk = A.in[9][h];
        f32x16 state = {0.f, 0.f, 0.f, 0.f, 0.f, 0.f, 0.f, 0.f, 0.f, 0.f, 0.f, 0.f, 0.f, 0.f, 0.f, 0.f};
        __syncthreads();
        for (int c = 0; c < 32; ++c) {
            const size_t rowbase = (size_t)b * SEQ + (size_t)c * 128;
            int tid = F.tid, lane = F.lane; asm volatile("" : "+v"(tid), "+v"(lane));
            if (tid < 128) {
                const float dr = bf2f(U[(rowbase + tid) * LDE + EDT + h]) + dtb;
                const float dt = dr > 20.f ? dr : log1pf(__expf(dr));
                float s = dt * a_h;
#pragma unroll
                for (int o = 1; o < 64; o <<= 1) { const float t = __shfl_up(s, o); if (lane >= o) s += t; }
                dtv[tid] = dt; acum[tid] = s;
            }
            {
                const int cg = tid & 15, rr = tid >> 4;
#pragma unroll 1
                for (int T = 0; T < 2; ++T) {
                    const int gcol = (T == 0 ? EBB : ECC) + g * 128 + 8 * cg;
                    u32x4 raw[7];
#pragma unroll
                    for (int j = 0; j < 7; ++j) { const int tl = 4 * rr - 3 + j;
                        raw[j] = (u32x4){0u, 0u, 0u, 0u};
                        if (c > 0 || tl >= 0) raw[j] = *(const u32x4*)(U + (size_t)((long)rowbase + tl) * LDE + gcol); }
                    LAS unsigned char* dst = L + (T == 0 ? L_BS : L_CS);
                    unsigned opk[4][4];
#pragma unroll
                    for (int e2 = 0; e2 < 4; ++e2) {
                        const int lc = T * 128 + 8 * cg + 2 * e2;
                        const f32x2 w0 = *(const LAS f32x2*)(cw + lc), w1 = *(const LAS f32x2*)(cw + 288 + lc), w2 = *(const LAS f32x2*)(cw + 576 + lc), w3 = *(const LAS f32x2*)(cw + 864 + lc), bb = *(const LAS f32x2*)(cw + 1152 + lc);
                        float lo[7], hi[7];
#pragma unroll
                        for (int j = 0; j < 7; ++j) { lo[j] = bflo(raw[j][e2]); hi[j] = bfhi(raw[j][e2]); }
                        float ol[4], oh[4];
#pragma unroll
                        for (int q = 0; q < 4; ++q) { ol[q] = siluf(bb.x + w0.x * lo[q] + w1.x * lo[q + 1] + w2.x * lo[q + 2] + w3.x * lo[q + 3]);
                                                      oh[q] = siluf(bb.y + w0.y * hi[q] + w1.y * hi[q + 1] + w2.y * hi[q + 2] + w3.y * hi[q + 3]); opk[q][e2] = pk2(ol[q], oh[q]); }
                        if (T == 0) {
                            *(LAS u32x2*)(L + L_BT + ((8 * cg + 2 * e2) * SP + 4 * rr) * 2) = (u32x2){pk2(ol[0], ol[1]), pk2(ol[2], ol[3])};
                            *(LAS u32x2*)(L + L_BT + ((8 * cg + 2 * e2 + 1) * SP + 4 * rr) * 2) = (u32x2){pk2(oh[0], oh[1]), pk2(oh[2], oh[3])};
                        }
                    }
#pragma unroll
                    for (int q = 0; q < 4; ++q) *(LAS u32x4*)(dst + ((4 * rr + q) * SP + 8 * cg) * 2) = (u32x4){opk[q][0], opk[q][1], opk[q][2], opk[q][3]};
                }
            }
            __syncthreads();
            if (tid >= 64 && tid < 128) acum[tid] += acum[63];
            __syncthreads();
            {
                const int cg = tid & 3, t = tid >> 2;
                const int gcol = EXS + h * 64 + ph * 32 + 8 * cg;
                u32x4 raw[4];
#pragma unroll
                for (int j = 0; j < 4; ++j) { const int tl = t - 3 + j; raw[j] = (u32x4){0u, 0u, 0u, 0u};
                    if (c > 0 || tl >= 0) raw[j] = *(const u32x4*)(U + (size_t)((long)rowbase + tl) * LDE + gcol); }
                const float sc = dtv[t] * __expf(acum[127] - acum[t]);
#pragma unroll
                for (int e = 0; e < 8; ++e) { const int lc = 256 + 8 * cg + e;
                    float rv[4];
#pragma unroll
                    for (int j = 0; j < 4; ++j) rv[j] = (e & 1) ? bfhi(raw[j][e >> 1]) : bflo(raw[j][e >> 1]);
                    const float xv = siluf(cw[1152 + lc] + cw[lc] * rv[0] + cw[288 + lc] * rv[1] + cw[576 + lc] * rv[2] + cw[864 + lc] * rv[3]);
                    *(LAS bf16*)(L + L_XT + ((8 * cg + e) * SP + t) * 2) = (bf16)f2bf(xv);
                    *(LAS bf16*)(L + L_XS + ((8 * cg + e) * SP + t) * 2) = (bf16)f2bf(xv * sc); }
            }
            const int mt = w >> 1, nh = w & 1, r = lane & 31, hh = lane >> 5;
            f32x16 cb[2];
#pragma unroll
            for (int j = 0; j < 2; ++j) {
                cb[j] = (f32x16){0.f, 0.f, 0.f, 0.f, 0.f, 0.f, 0.f, 0.f, 0.f, 0.f, 0.f, 0.f, 0.f, 0.f, 0.f, 0.f};
                const int s0 = 64 * nh + 32 * j;
                if (s0 <= 32 * mt + 31) {
#pragma unroll
                    for (int ks = 0; ks < 8; ++ks) {
                        const bf16x8 af = lds_frag(L + L_CS, 32 * mt + r, 16 * ks + 8 * hh), bfg = lds_frag(L + L_BS, s0 + r, 16 * ks + 8 * hh);
                        cb[j] = __builtin_amdgcn_mfma_f32_32x32x16_bf16(af, bfg, cb[j], 0, 0, 0);
                    }
                }
            }
            __syncthreads();
#pragma unroll
            for (int j = 0; j < 2; ++j) {
                const int s = 64 * nh + 32 * j + r; const float as = acum[s], ds = dtv[s];
#pragma unroll
                for (int i = 0; i < 16; ++i) { const int t = 32 * mt + 8 * (i >> 2) + 4 * hh + (i & 3);
                    const float v = (s <= t) ? cb[j][i] * __expf(acum[t] - as) * ds : 0.f;
                    *(LAS bf16*)(L + L_BS + (t * SP + s) * 2) = (bf16)f2bf(v); }
            }
            __syncthreads();
            if (w < 4) {
                f32x16 yd = {0.f, 0.f, 0.f, 0.f, 0.f, 0.f, 0.f, 0.f, 0.f, 0.f, 0.f, 0.f, 0.f, 0.f, 0.f, 0.f}, yo = yd;
                for (int ks = 0; ks < 2 * (w + 1); ++ks) {
                    const bf16x8 af = lds_frag(L + L_BS, 32 * w + r, 16 * ks + 8 * hh), bfg = lds_frag(L + L_XT, r, 16 * ks + 8 * hh);
                    yd = __builtin_amdgcn_mfma_f32_32x32x16_bf16(af, bfg, yd, 0, 0, 0);
                }
                LAS unsigned char* stc = L + L_ST + (c & 1) * (32 * SP * 2);
#pragma unroll
                for (int ks = 0; ks < 8; ++ks) {
                    const bf16x8 af = lds_frag(L + L_CS, 32 * w + r, 16 * ks + 8 * hh), bfg = lds_frag(stc, r, 16 * ks + 8 * hh);
                    yo = __builtin_amdgcn_mfma_f32_32x32x16_bf16(af, bfg, yo, 0, 0, 0);
                }
#pragma unroll
                for (int q = 0; q < 4; ++q) {
                    const int t0 = 32 * w + 8 * q + 4 * hh;
                    const u32x2 xx = *(const LAS u32x2*)(L + L_XT + (r * SP + t0) * 2);
                    const float xv[4] = {bflo(xx.x), bfhi(xx.x), bflo(xx.y), bfhi(xx.y)};
#pragma unroll
                    for (int e = 0; e < 4; ++e) { const int t = t0 + e, i = 4 * q + e;
                        bf16* zp = U + (rowbase + t) * LDE + EZ + h * 64 + ph * 32 + r;
                        const float z = bf2f(*zp);
                        const float y = yd[i] + __expf(acum[t]) * yo[i] + dsk * xv[e];
                        *zp = (bf16)f2bf(y * siluf(z)); }
                }
            } else {
                const int n0 = 32 * (w - 4); const float dec = __expf(acum[127]);
#pragma unroll
                for (int i = 0; i < 16; ++i) state[i] *= dec;
#pragma unroll
                for (int ks = 0; ks < 8; ++ks) {
                    const bf16x8 af = lds_frag(L + L_XS, r, 16 * ks + 8 * hh), bfg = lds_frag(L + L_BT, n0 + r, 16 * ks + 8 * hh);
                    state = __builtin_amdgcn_mfma_f32_32x32x16_bf16(af, bfg, state, 0, 0, 0);
                }
                LAS unsigned char* stn = L + L_ST + ((c + 1) & 1) * (32 * SP * 2);
#pragma unroll
                for (int i = 0; i < 16; ++i) { const int p = 8 * (i >> 2) + 4 * hh + (i & 3);
                    *(LAS bf16*)(stn + (p * SP + n0 + r) * 2) = (bf16)f2bf(state[i]); }
            }
            __syncthreads();
        }
    }
}

typedef short s16x4 __attribute__((ext_vector_type(4)));
__device__ __forceinline__ s16x4 lds_tr16(LAS unsigned char* p) { return __builtin_bit_cast(s16x4, __builtin_amdgcn_ds_read_tr16_b64_v4i16((LAS s16x4*)p)); }
__device__ __forceinline__ int t5_bucket_dev(int d) {
    if (d < 16) return d;
    const int v = 16 + (int)(log((double)d / 16.0) / log(8.0) * 16.0);
    return v < 31 ? v : 31;
}
constexpr int D_SEL = 131072, D_LUT = 135168, VP = 72;
__device__ __forceinline__ int okey(float f) { const int iv = __builtin_bit_cast(int, f); return iv ^ ((iv >> 31) & 0x7fffffff); }

__device__ __forceinline__ void p_dsa(Frame& F, const Args& A) {
    bf16* U = (bf16*)(F.ws + WS_U); bf16* HB = (bf16*)(F.ws + WS_HB);
    const int w = F.wave;
    const float* ng = A.in[10];
    LAS unsigned char* L = F.lds;
    LAS float* LUT = (LAS float*)(L + D_LUT);
    for (int i = F.tid; i < 1024; i += NTHR) LUT[i] = A.in[1][t5_bucket_dev(i >> 3) * 8 + (i & 7)];
    __syncthreads();
    for (int blk = F.bid; blk < MTOK / 8; blk += F.G) {
        int lane = F.lane; asm volatile("" : "+v"(lane));
        const int kr = blk >> 8, cc = blk & 255, b = kr >> 1, tb = (kr & 1) ? 511 - cc : cc, t0 = tb * 8;
        const size_t bat = (size_t)b * SEQ, rowb = bat + t0;
        {
            const size_t row = rowb + w;
            const u32x4 v = *(const u32x4*)(U + row * LDE + EZ + 8 * lane);
            float f[8] = {bflo(v.x), bfhi(v.x), bflo(v.y), bfhi(v.y), bflo(v.z), bfhi(v.z), bflo(v.w), bfhi(v.w)};
            float s = 0.f;
#pragma unroll
            for (int j = 0; j < 8; ++j) s += f[j] * f[j];
#pragma unroll
            for (int o = 1; o < 32; o <<= 1) s += __shfl_xor(s, o);
            const float rs = 1.f / sqrtf(s * (1.f / 256.f) + NORM_EPS); const float* g = ng + 8 * lane;
            u32x4 o; o.x = pk2(f[0] * rs * g[0], f[1] * rs * g[1]); o.y = pk2(f[2] * rs * g[2], f[3] * rs * g[3]); o.z = pk2(f[4] * rs * g[4], f[5] * rs * g[5]); o.w = pk2(f[6] * rs * g[6], f[7] * rs * g[7]);
            *(u32x4*)(HB + row * DM + 8 * lane) = o;
        }
        {
            const int r = lane & 31, hh = lane >> 5;
            bf16x8 qa[4];
#pragma unroll
            for (int ks = 0; ks < 4; ++ks) qa[ks] = *(const bf16x8*)(U + (rowb + (r >> 2)) * LDE + EIQ + (r & 3) * 64 + 16 * ks + 8 * hh);
            float wv[4][4];
#pragma unroll
            for (int q = 0; q < 4; ++q) { const u32x2 ww = *(const u32x2*)(U + (rowb + 2 * q + hh) * LDE + EIW); wv[q][0] = bflo(ww.x); wv[q][1] = bfhi(ww.x); wv[q][2] = bflo(ww.y); wv[q][3] = bfhi(ww.y); }
            const int ntile = (t0 + 8 + 31) >> 5;
            for (int tile = w; tile < ntile; tile += NWAVES) {
                const int key = 32 * tile + r;
                bf16x8 kf[4];
#pragma unroll
                for (int ks = 0; ks < 4; ++ks) kf[ks] = *(const bf16x8*)(U + (bat + key) * LDE + EIK + 16 * ks + 8 * hh);
                f32x16 acc = {0.f, 0.f, 0.f, 0.f, 0.f, 0.f, 0.f, 0.f, 0.f, 0.f, 0.f, 0.f, 0.f, 0.f, 0.f, 0.f};
#pragma unroll
                for (int ks = 0; ks < 4; ++ks) acc = __builtin_amdgcn_mfma_f32_32x32x16_bf16(qa[ks], kf[ks], acc, 0, 0, 0);
#pragma unroll
                for (int q = 0; q < 4; ++q) {
                    const float sc = wv[q][0] * fmaxf(acc[4 * q], 0.f) + wv[q][1] * fmaxf(acc[4 * q + 1], 0.f) + wv[q][2] * fmaxf(acc[4 * q + 2], 0.f) + wv[q][3] * fmaxf(acc[4 * q + 3], 0.f);
                    *(LAS float*)(L + ((2 * q + hh) * 4096 + key) * 4) = sc;
                }
            }
        }
        __syncthreads();
        const int t = t0 + w, n = t + 1;
        LAS unsigned short* sel = (LAS unsigned short*)(L + D_SEL) + w * 256;
        const int cnt = n < 256 ? n : 256;
        if (n <= 256) {
#pragma unroll
            for (int i = 0; i < 4; ++i) { const int s = lane + 64 * i; sel[s] = (unsigned short)(s < n ? s : 0); }
        } else {
            const int nj = (t0 + 8 + 63) >> 6;
            const LAS float* myrow = (const LAS float*)(L + w * 16384);
            int v[64]; int vmax = (int)0x80000000;
#pragma unroll
            for (int j = 0; j < 64; ++j) { v[j] = (int)0x80000000;
                if (j < nj) { const int idx = lane + 64 * j; const int kv = okey(myrow[idx]); v[j] = idx <= t ? kv : (int)0x80000000; vmax = v[j] > vmax ? v[j] : vmax; } }
#pragma unroll
            for (int o = 1; o < 64; o <<= 1) { const int x = __shfl_xor(vmax, o); vmax = x > vmax ? x : vmax; }
            vmax = __builtin_amdgcn_readfirstlane(vmax);
            int lo = (int)0x80000001, hi = vmax;
            while (lo < hi) {
                const int mid = lo + (int)(((long long)hi - (long long)lo + 1) >> 1);
                int c = 0;
#pragma unroll
                for (int j = 0; j < 64; ++j) if (j < nj) c += (v[j] >= mid) ? 1 : 0;
#pragma unroll
                for (int o = 1; o < 64; o <<= 1) c += __shfl_xor(c, o);
                c = __builtin_amdgcn_readfirstlane(c);
                if (c == 256) { lo = mid; break; }
                if (c > 256) lo = mid; else hi = mid - 1;
            }
            const int T = lo;
            int cgt = 0;
#pragma unroll
            for (int j = 0; j < 64; ++j) if (j < nj) cgt += (v[j] > T) ? 1 : 0;
#pragma unroll
            for (int o = 1; o < 64; o <<= 1) cgt += __shfl_xor(cgt, o);
            const int need_eq = 256 - cgt;
            int obase = 0, ebase = 0;
#pragma unroll
            for (int j = 0; j < 64; ++j) if (j < nj) {
                const bool gt = v[j] > T, eq = v[j] == T;
                const unsigned long long be = __ballot(eq);
                const int erank = ebase + (int)__builtin_amdgcn_mbcnt_hi((unsigned)(be >> 32), __builtin_amdgcn_mbcnt_lo((unsigned)be, 0u));
                const bool take = gt || (eq && erank < need_eq);
                const unsigned long long bt = __ballot(take);
                const int pos = obase + (int)__builtin_amdgcn_mbcnt_hi((unsigned)(bt >> 32), __builtin_amdgcn_mbcnt_lo((unsigned)bt, 0u));
                if (take && pos < 256) sel[pos] = (unsigned short)(lane + 64 * j);
                obase += __popcll(bt); ebase += __popcll(be);
            }
        }
        __syncthreads();
        {
            const int hd = lane & 15, g4 = lane >> 4;
            const size_t row = rowb + w;
            bf16x8 qb[2];
            {
                float qf[2][8]; float ss = 0.f;
#pragma unroll
                for (int ks = 0; ks < 2; ++ks) { u32x4 qq = (u32x4){0u, 0u, 0u, 0u};
                    if (hd < 8) qq = *(const u32x4*)(U + row * LDE + EQ + hd * 64 + 32 * ks + 8 * g4);
                    qf[ks][0] = bflo(qq.x); qf[ks][1] = bfhi(qq.x); qf[ks][2] = bflo(qq.y); qf[ks][3] = bfhi(qq.y); qf[ks][4] = bflo(qq.z); qf[ks][5] = bfhi(qq.z); qf[ks][6] = bflo(qq.w); qf[ks][7] = bfhi(qq.w);
#pragma unroll
                    for (int j = 0; j < 8; ++j) ss += qf[ks][j] * qf[ks][j]; }
                ss += __shfl_xor(ss, 16); ss += __shfl_xor(ss, 32);
                const float rs = 0.125f / sqrtf(ss * (1.f / 64.f) + NORM_EPS);
#pragma unroll
                for (int ks = 0; ks < 2; ++ks) { const float* gq = A.in[11] + 32 * ks + 8 * g4;
                    u32x4 pk; pk.x = pk2(qf[ks][0] * rs * gq[0], qf[ks][1] * rs * gq[1]); pk.y = pk2(qf[ks][2] * rs * gq[2], qf[ks][3] * rs * gq[3]);
                    pk.z = pk2(qf[ks][4] * rs * gq[4], qf[ks][5] * rs * gq[5]); pk.w = pk2(qf[ks][6] * rs * gq[6], qf[ks][7] * rs * gq[7]);
                    qb[ks] = __builtin_bit_cast(bf16x8, pk); }
            }
            float lg[16][4]; float mx = -3.0e38f;
#pragma unroll
            for (int T = 0; T < 16; ++T) {
                const int sm = sel[16 * T + hd];
                const bf16* kp = U + (bat + sm) * LDE + EK + 8 * g4;
                const bf16x8 ka0 = *(const bf16x8*)kp, ka1 = *(const bf16x8*)(kp + 32);
                f32x4 acc = {0.f, 0.f, 0.f, 0.f};
                acc = __builtin_amdgcn_mfma_f32_16x16x32_bf16(ka0, qb[0], acc, 0, 0, 0);
                acc = __builtin_amdgcn_mfma_f32_16x16x32_bf16(ka1, qb[1], acc, 0, 0, 0);
                const u32x2 sl = *(const LAS u32x2*)(sel + 16 * T + 4 * g4);
                const int s4[4] = {(int)(sl.x & 0xffffu), (int)(sl.x >> 16), (int)(sl.y & 0xffffu), (int)(sl.y >> 16)};
#pragma unroll
                for (int i = 0; i < 4; ++i) { int dist = t - s4[i]; dist = dist < 0 ? 0 : (dist > 127 ? 127 : dist);
                    const bool valid = (16 * T + 4 * g4 + i) < cnt;
                    lg[T][i] = valid ? acc[i] + LUT[dist * 8 + (hd & 7)] : -3.0e38f; mx = fmaxf(mx, lg[T][i]); }
            }
            mx = fmaxf(mx, __shfl_xor(mx, 16)); mx = fmaxf(mx, __shfl_xor(mx, 32));
            float sum = 0.f;
#pragma unroll
            for (int T = 0; T < 16; ++T)
#pragma unroll
                for (int i = 0; i < 4; ++i) { const float p = lg[T][i] > -1.0e38f ? __expf(lg[T][i] - mx) : 0.f; lg[T][i] = p; sum += p; }
            sum += __shfl_xor(sum, 16); sum += __shfl_xor(sum, 32);
            const float inv = 1.f / fmaxf(sum, 1e-30f);
            f32x4 oacc[4];
#pragma unroll
            for (int dt = 0; dt < 4; ++dt) oacc[dt] = (f32x4){0.f, 0.f, 0.f, 0.f};
            LAS unsigned char* Vl = L + w * 16384;
#pragma unroll
            for (int ch = 0; ch < 4; ++ch) {
                LDS_WAIT();
#pragma unroll
                for (int e = 0; e < 8; ++e) { const int q = lane + 64 * e, sl = q >> 3, part = q & 7;
                    const int sm = sel[64 * ch + sl];
                    const u32x4 vv = *(const u32x4*)(U + (bat + sm) * LDE + EV + 8 * part);
                    *(LAS u32x4*)(Vl + (sl * VP + 8 * part) * 2) = vv; }
                LDS_WAIT();
#pragma unroll
                for (int kk = 0; kk < 2; ++kk) {
                    const int T0 = 2 * (2 * ch + kk);
                    u32x4 pp; pp.x = pk2(lg[T0][0] * inv, lg[T0][1] * inv); pp.y = pk2(lg[T0][2] * inv, lg[T0][3] * inv); pp.z = pk2(lg[T0 + 1][0] * inv, lg[T0 + 1][1] * inv); pp.w = pk2(lg[T0 + 1][2] * inv, lg[T0 + 1][3] * inv);
                    const bf16x8 pf = __builtin_bit_cast(bf16x8, pp);
                    const int qq = (lane & 15) >> 2, p4 = lane & 3;
#pragma unroll
                    for (int dt = 0; dt < 4; ++dt) {
                        const s16x4 b0 = lds_tr16(Vl + ((32 * kk + 4 * g4 + qq) * VP + 16 * dt + 4 * p4) * 2);
                        const s16x4 b1 = lds_tr16(Vl + ((32 * kk + 16 + 4 * g4 + qq) * VP + 16 * dt + 4 * p4) * 2);
                        bf16x8 bfg; bfg[0] = b0[0]; bfg[1] = b0[1]; bfg[2] = b0[2]; bfg[3] = b0[3]; bfg[4] = b1[0]; bfg[5] = b1[1]; bfg[6] = b1[2]; bfg[7] = b1[3];
                        oacc[dt] = __builtin_amdgcn_mfma_f32_16x16x32_bf16(pf, bfg, oacc[dt], 0, 0, 0);
                    }
                }
            }
            if (g4 < 2) {
#pragma unroll
                for (int i = 0; i < 4; ++i)
#pragma unroll
                    for (int dt = 0; dt < 4; ++dt) HB[row * DM + 512 + (4 * g4 + i) * 64 + 16 * dt + hd] = (bf16)f2bf(oacc[dt][i]);
            }
        }
        __syncthreads();
    }
}

template <int MODE> __device__ __forceinline__ void p_norm_route(Frame& F, const float* xin, const float* gain, int layer) {
    constexpr int NT = MODE == 0 ? 3 : 2;
    bf16* HB = (bf16*)(F.ws + WS_HB); const bf16* WR = MODE == 0 ? (const bf16*)(F.ws + WS_WR) + (size_t)layer * 48 * 1024 : (const bf16*)(F.ws + WS_WGL);
    float* GL = (float*)(F.ws + WS_GL);
    int* list = (int*)(F.ws + WS_LIST); float* wl = (float*)(F.ws + WS_LISTW);
    LAS unsigned char* L = F.lds;
    LAS float* lgt = (LAS float*)L + F.wave * (16 * 48);
    LAS int* cntl = (LAS int*)(L + 32768); LAS int* basel = (LAS int*)(L + 33024);
    LAS int* ri_e = (LAS int*)(L + 34816); LAS int* ri_p = (LAS int*)(L + 36864); LAS float* ri_w = (LAS float*)(L + 38912);
    const int w = F.wave;
    for (int base = F.bid * 256; base < MTOK; base += F.G * 256) {
        int lane = F.lane; asm volatile("" : "+v"(lane));
        if (F.tid < 64) cntl[F.tid] = 0;
        __syncthreads();
#pragma unroll 1
        for (int half = 0; half < 2; ++half) {
            const int R0 = base + w * 32 + half * 16;
#pragma unroll 1
            for (int i = 0; i < 16; ++i) rms_row_to_bf16(xin + (size_t)(R0 + i) * DM, gain, HB + (size_t)(R0 + i) * DM, lane);
            VM_WAIT();
            const int n16 = lane & 15, g4 = lane >> 4;
            f32x4 acc[NT];
#pragma unroll
            for (int nt = 0; nt < NT; ++nt) acc[nt] = (f32x4){0.f, 0.f, 0.f, 0.f};
#pragma unroll 4
            for (int kk = 0; kk < 32; ++kk) {
                const bf16x8 a = *(const bf16x8*)(HB + (size_t)(R0 + n16) * DM + 32 * kk + 8 * g4);
#pragma unroll
                for (int nt = 0; nt < NT; ++nt) { const bf16x8 bb = *(const bf16x8*)(WR + (size_t)(16 * nt + n16) * DM + 32 * kk + 8 * g4);
                    acc[nt] = __builtin_amdgcn_mfma_f32_16x16x32_bf16(a, bb, acc[nt], 0, 0, 0); }
            }
            if constexpr (MODE == 1) {
#pragma unroll
                for (int nt = 0; nt < NT; ++nt)
#pragma unroll
                    for (int i = 0; i < 4; ++i) if (16 * nt + n16 < 24) GL[(size_t)(R0 + 4 * g4 + i) * 24 + 16 * nt + n16] = acc[nt][i];
            } else {
#pragma unroll
            for (int nt = 0; nt < NT; ++nt)
#pragma unroll
                for (int i = 0; i < 4; ++i) lgt[(4 * g4 + i) * 48 + 16 * nt + n16] = acc[nt][i];
            LDS_WAIT();
            if (lane < 16) {
                const LAS float* lr = lgt + lane * 48;
                int gs = 0; float gm = lr[0];
#pragma unroll
                for (int j = 1; j < 4; ++j) if (lr[j] > gm) { gm = lr[j]; gs = j; }
                float gsum = 0.f;
#pragma unroll
                for (int j = 0; j < 4; ++j) gsum += __expf(lr[j] - gm);
                const float gw = 1.f / gsum;
                const LAS float* er = lr + 4 + 8 * gs;
                int i0 = 0; float m0 = er[0];
#pragma unroll
                for (int j = 1; j < 8; ++j) if (er[j] > m0) { m0 = er[j]; i0 = j; }
                int i1 = -1; float m1 = -3.0e38f;
#pragma unroll
                for (int j = 0; j < 8; ++j) if (j != i0 && er[j] > m1) { m1 = er[j]; i1 = j; }
                const float w0 = 1.f / (1.f + __expf(m1 - m0));
                const int e0 = gs * 8 + i0, e1 = 32 + gs * 8 + i1;
                const int rs = (w * 32 + half * 16 + lane) * 2;
                ri_e[rs] = e0; ri_p[rs] = __hip_atomic_fetch_add(cntl + e0, 1, __ATOMIC_RELAXED, __HIP_MEMORY_SCOPE_WORKGROUP); ri_w[rs] = w0 * gw;
                ri_e[rs + 1] = e1; ri_p[rs + 1] = __hip_atomic_fetch_add(cntl + e1, 1, __ATOMIC_RELAXED, __HIP_MEMORY_SCOPE_WORKGROUP); ri_w[rs + 1] = (1.f - w0) * gw;
            }
            LDS_WAIT();
            }
        }
        if constexpr (MODE == 1) continue;
        __syncthreads();
        if (F.tid < 64) { const int c = cntl[F.tid]; basel[F.tid] = c ? (int)__hip_atomic_fetch_add((unsigned*)(F.ctl + CW_CNT + layer * 4096 + 64 * F.tid), (unsigned)c, RLX_AGENT) : 0; }
        __syncthreads();
        { const int rs = F.tid, e = ri_e[rs], pos = basel[e] + ri_p[rs];
          list[(size_t)e * 65536 + pos] = base + (rs >> 1); wl[(size_t)e * 65536 + pos] = ri_w[rs]; }
        __syncthreads();
    }
}
__device__ __forceinline__ void moe_tables(Frame& F, int layer) {
    LAS int* ptile = (LAS int*)(F.lds + MOE_OFF); LAS int* cntv = ptile + 128;
    __syncthreads();
    if (F.tid < 64) {
        const int c = (int)__hip_atomic_load((unsigned*)(F.ctl + CW_CNT + layer * 4096 + 64 * F.tid), RLX_AGENT);
        cntv[F.tid] = c;
        int nt = (c + 255) >> 8, incl = nt;
#pragma unroll
        for (int o = 1; o < 64; o <<= 1) { const int t = __shfl_up(incl, o); if (F.lane >= o) incl += t; }
        ptile[F.tid] = incl - nt; if (F.tid == 63) ptile[64] = incl;
    }
    __syncthreads();
}
__device__ __forceinline__ void p_moe_gu(Frame& F, int layer) {
    moe_tables(F, layer);
    const LAS int* ptile = (const LAS int*)(F.lds + MOE_OFF); const LAS int* cntv = ptile + 128;
    pg8::MoeOrder S{(const char*)(F.ws + WS_HB), (const char*)(F.ws + WS_WGU) + (size_t)layer * 32 * 1024 * 1024 * 2, (size_t)1024 * 1024 * 2, 1024, F.G, F.bid, 0, ptile[64], ptile, cntv, (const int*)(F.ws + WS_LIST), true};
    pg8::EpiSwiGLU E{(bf16*)(F.ws + WS_U)};
    pg8::gemm_phase<pg8::EpiSwiGLU, pg8::MoeOrder, true>(F.lds, 1024, S, E);
}
__device__ __forceinline__ void p_moe_down(Frame& F, int layer, int slot) {
    moe_tables(F, layer);
    const LAS int* ptile = (const LAS int*)(F.lds + MOE_OFF); const LAS int* cntv = ptile + 128;
    pg8::MoeOrder S{(const char*)(F.ws + WS_U), (const char*)(F.ws + WS_WD) + (size_t)layer * 32 * 1024 * 512 * 2, (size_t)1024 * 512 * 2, 512, F.G, F.bid, ptile[32 * slot], ptile[32 * slot + 32], ptile, cntv, (const int*)(F.ws + WS_LIST), false};
    pg8::EpiScatter E{F.out, (const int*)(F.ws + WS_LIST), (const float*)(F.ws + WS_LISTW), cntv};
    pg8::gemm_phase<pg8::EpiScatter, pg8::MoeOrder, true>(F.lds, 512, S, E);
}

__device__ __forceinline__ void p_compress(Frame& F, const Args& A) {
    bf16* U = (bf16*)(F.ws + WS_U);
    LAS unsigned char* L = F.lds;
    const int w = F.wave;
    {
        const int tid = F.tid, sub = tid & 15;
        for (int v0 = F.bid * 32; v0 < MTOK * 4; v0 += F.G * 32) {
            const int vec = v0 + (tid >> 4), row = vec >> 2, wh = vec & 3;
            bf16* p = U + (size_t)row * LDO + ((wh >> 1) ? OKW : OKS) + (wh & 1) * 128 + 8 * sub;
            const float* g = ((wh >> 1) ? A.in[18] : A.in[17]) + 8 * sub;
            const u32x4 v = *(const u32x4*)p; float f[8] = {bflo(v.x), bfhi(v.x), bflo(v.y), bfhi(v.y), bflo(v.z), bfhi(v.z), bflo(v.w), bfhi(v.w)};
            float s = 0.f;
#pragma unroll
            for (int j = 0; j < 8; ++j) s += f[j] * f[j];
            s += __shfl_xor(s, 1); s += __shfl_xor(s, 2); s += __shfl_xor(s, 4); s += __shfl_xor(s, 8);
            const float rs = 1.f / sqrtf(s * (1.f / 128.f) + NORM_EPS);
            u32x4 o; o.x = pk2(f[0] * rs * g[0], f[1] * rs * g[1]); o.y = pk2(f[2] * rs * g[2], f[3] * rs * g[3]); o.z = pk2(f[4] * rs * g[4], f[5] * rs * g[5]); o.w = pk2(f[6] * rs * g[6], f[7] * rs * g[7]);
            *(u32x4*)p = o;
        }
    }
    constexpr int C_A = 0, C_B = 17408, C_H = 52224, C_S = 69632;
    for (int unit = F.bid; unit < 256; unit += F.G) {
        int tid = F.tid, lane = F.lane; asm volatile("" : "+v"(tid), "+v"(lane));
        const int T = unit >> 7, b = (unit >> 3) & 15, g = (unit >> 2) & 1, cb = unit & 3;
        const int col = (T ? OVC : OKC) + g * 128;
        const float* pos = T ? A.in[20] : A.in[19];
        const bf16* w1t = (const bf16*)(F.ws + (T ? WS_W1V : WS_W1K)); const bf16* w2t = (const bf16*)(F.ws + WS_W2) + T * 128 * 128;
        const int wm = w >> 2, wn = w & 3, r = lane & 31, hh = lane >> 5;
        f32x16 acc = {0.f, 0.f, 0.f, 0.f, 0.f, 0.f, 0.f, 0.f, 0.f, 0.f, 0.f, 0.f, 0.f, 0.f, 0.f, 0.f};
#pragma unroll 1
        for (int l = 0; l < 32; ++l) {
            __syncthreads();
#pragma unroll
            for (int e = 0; e < 2; ++e) { const int q = tid + 512 * e, c = q >> 4, part = q & 15; const int tok = 16 * (64 * cb + c) + l;
                u32x4 v = (u32x4){0u, 0u, 0u, 0u};
                if (tok < SEQ) v = *(const u32x4*)(U + ((size_t)b * SEQ + tok) * LDO + col + 8 * part);
                const f32x4 p0 = *(const f32x4*)(pos + l * 128 + 8 * part), p1 = *(const f32x4*)(pos + l * 128 + 8 * part + 4);
                u32x4 o; o.x = pk2(bflo(v.x) + p0.x, bfhi(v.x) + p0.y); o.y = pk2(bflo(v.y) + p0.z, bfhi(v.y) + p0.w); o.z = pk2(bflo(v.z) + p1.x, bfhi(v.z) + p1.y); o.w = pk2(bflo(v.w) + p1.z, bfhi(v.w) + p1.w);
                *(LAS u32x4*)(L + C_A + (c * SP + 8 * part) * 2) = o; }
#pragma unroll
            for (int e = 0; e < 4; ++e) { const int q = tid + 512 * e, j = q >> 4, part = q & 15;
                *(LAS u32x4*)(L + C_B + (j * SP + 8 * part) * 2) = *(const u32x4*)(w1t + (size_t)j * 4096 + l * 128 + 8 * part); }
            __syncthreads();
#pragma unroll
            for (int ks = 0; ks < 8; ++ks) {
                const bf16x8 af = lds_frag(L + C_A, 32 * wm + r, 16 * ks + 8 * hh), bfg = lds_frag(L + C_B, 32 * wn + r, 16 * ks + 8 * hh);
                acc = __builtin_amdgcn_mfma_f32_32x32x16_bf16(af, bfg, acc, 0, 0, 0);
            }
        }
#pragma unroll
        for (int i = 0; i < 16; ++i) { const int c = 32 * wm + 8 * (i >> 2) + 4 * hh + (i & 3);
            *(LAS bf16*)(L + C_H + (c * SP + 32 * wn + r) * 2) = (bf16)f2bf(siluf(acc[i])); }
        __syncthreads();
        f32x16 a2 = {0.f, 0.f, 0.f, 0.f, 0.f, 0.f, 0.f, 0.f, 0.f, 0.f, 0.f, 0.f, 0.f, 0.f, 0.f, 0.f};
#pragma unroll
        for (int ks = 0; ks < 8; ++ks) {
            const bf16x8 af = lds_frag(L + C_H, 32 * wm + r, 16 * ks + 8 * hh), bfg = *(const bf16x8*)(w2t + (size_t)(32 * wn + r) * 128 + 16 * ks + 8 * hh);
            a2 = __builtin_amdgcn_mfma_f32_32x32x16_bf16(af, bfg, a2, 0, 0, 0);
        }
        float rsv[16];
        if (T == 0) {
            LAS float* st = (LAS float*)(L + C_S);
#pragma unroll
            for (int i = 0; i < 16; ++i) { float q = a2[i] * a2[i];
                q += __shfl_xor(q, 1); q += __shfl_xor(q, 2); q += __shfl_xor(q, 4); q += __shfl_xor(q, 8); q += __shfl_xor(q, 16);
                if (r == 0) st[(32 * wm + 8 * (i >> 2) + 4 * hh + (i & 3)) * 4 + wn] = q; }
            __syncthreads();
#pragma unroll
            for (int i = 0; i < 16; ++i) { const f32x4 q = *(const LAS f32x4*)(st + (32 * wm + 8 * (i >> 2) + 4 * hh + (i & 3)) * 4);
                rsv[i] = A.in[16][32 * wn + r] / sqrtf((q.x + q.y + q.z + q.w) * (1.f / 128.f) + NORM_EPS); }
        } else {
#pragma unroll
            for (int i = 0; i < 16; ++i) rsv[i] = 1.f;
        }
        bf16* dst = (bf16*)(F.ws + (T ? WS_VCMP : WS_KCMP));
#pragma unroll
        for (int i = 0; i < 16; ++i) { const int c = 64 * cb + 32 * wm + 8 * (i >> 2) + 4 * hh + (i & 3);
            dst[(((size_t)b * 256 + c) * 2 + g) * 128 + 32 * wn + r] = (bf16)f2bf(a2[i] * rsv[i]); }
    }
}

constexpr int N_K = 0, N_V = 17408, N_LUT = 37888, N_PCS = 41984, N_FAC = 107520, N_MSK = 108544, N_UNI = 109056, N_CST = 109120;
constexpr int VPN = 160;
enum { BR_CMP = 0, BR_SEL = 1, BR_WIN = 2 };
struct NsaCtx {
    LAS unsigned char* L; const bf16* U; const bf16* KC; const bf16* VC;
    int tid, lane, w, r, hh, b, g, qblk, t0, t, head; size_t bat;
    float mrow; unsigned mlo, mhi;
};
template <int BR, bool SUM, bool PV, bool IMP>
__device__ __forceinline__ void nsa_pass(const NsaCtx& X, const bf16x8 (&qf)[8], f32x16 (&oacc)[4], float& lsum, const float colfac, const int tlo, const int thi, const unsigned long long tmask) {
    LAS unsigned char* L = X.L; const int tid = X.tid, r = X.r, hh = X.hh;
    const LAS float* LUT = (const LAS float*)(L + N_LUT);
    const int rr0 = tid >> 4, part = tid & 15;
    int tile = tlo; while (tile <= thi && !((tmask >> tile) & 1ull)) ++tile;
    u32x4 kreg[2], vreg[2];
    auto issue = [&](int tl) {
#pragma unroll
        for (int e = 0; e < 2; ++e) { const int rr = rr0 + 32 * e;
            const bf16* kp; const bf16* vp;
            if (BR == BR_CMP) { const size_t o = (((size_t)X.b * 256 + 64 * tl + rr) * 2 + X.g) * 128 + 8 * part; kp = X.KC + o; vp = X.VC + o; }
            else { const size_t o = (X.bat + 64 * tl + rr) * LDO + X.g * 128 + 8 * part; kp = X.U + o + (BR == BR_SEL ? OKS : OKW); vp = X.U + o + (BR == BR_SEL ? OVS : OVW); }
            kreg[e] = *(const u32x4*)kp; if (PV) vreg[e] = *(const u32x4*)vp; }
    };
    if (tile <= thi) issue(tile);
    while (tile <= thi) {
        __syncthreads();
#pragma unroll
        for (int e = 0; e < 2; ++e) { const int rr = rr0 + 32 * e;
            *(LAS u32x4*)(L + N_K + (rr * SP + 8 * part) * 2) = kreg[e]; if (PV) *(LAS u32x4*)(L + N_V + (rr * VPN + 8 * part) * 2) = vreg[e]; }
        int nxt = tile + 1; while (nxt <= thi && !((tmask >> nxt) & 1ull)) ++nxt;
        if (nxt <= thi) issue(nxt);
        __syncthreads();
        f32x16 sacc[2];
#pragma unroll
        for (int mt = 0; mt < 2; ++mt) { sacc[mt] = (f32x16){0.f, 0.f, 0.f, 0.f, 0.f, 0.f, 0.f, 0.f, 0.f, 0.f, 0.f, 0.f, 0.f, 0.f, 0.f, 0.f};
#pragma unroll
            for (int ks = 0; ks < 8; ++ks) sacc[mt] = __builtin_amdgcn_mfma_f32_32x32x16_bf16(lds_frag(L + N_K, 32 * mt + r, 16 * ks + 8 * hh), qf[ks], sacc[mt], 0, 0, 0); }
        bool selb = true; if (BR == BR_SEL) selb = (tile < 32 ? (X.mlo >> tile) : (X.mhi >> (tile - 32))) & 1u;
#pragma unroll
        for (int mt = 0; mt < 2; ++mt)
#pragma unroll
            for (int i = 0; i < 16; ++i) { const int kidx = 32 * mt + 8 * (i >> 2) + 4 * hh + (i & 3);
                int dist; bool ok;
                if (BR == BR_CMP) { dist = X.t - (16 * (64 * tile + kidx) + 31); ok = dist >= 0; }
                else { dist = X.t - (64 * tile + kidx); ok = BR == BR_SEL ? (selb && dist >= 0) : (dist >= 0 && dist < 512); }
                const int dc = dist < 0 ? 0 : (dist > 127 ? 127 : dist);
                const float p = ok ? __expf(sacc[mt][i] + LUT[dc * 8 + X.head] - X.mrow) : 0.f;
                if (SUM) lsum += p;
                sacc[mt][i] = p * colfac; }
        if (IMP) {
            LAS float* pcs = (LAS float*)(L + N_PCS) + (X.w * 8 + (r >> 2)) * 256 + 64 * tile;
#pragma unroll
            for (int mt = 0; mt < 2; ++mt)
#pragma unroll
                for (int i = 0; i < 16; ++i) { float v = sacc[mt][i]; v += __shfl_xor(v, 1); v += __shfl_xor(v, 2);
                    if ((r & 3) == 0) pcs[32 * mt + 8 * (i >> 2) + 4 * hh + (i & 3)] = v; }
        }
        if (PV) {
            const int cb16 = (X.lane >> 4) & 1, q4 = (X.lane & 15) >> 2, p4 = X.lane & 3;
#pragma unroll
            for (int mt = 0; mt < 2; ++mt)
#pragma unroll
                for (int sI = 0; sI < 2; ++sI) {
                    u32x4 pp; pp.x = pk2(sacc[mt][8 * sI], sacc[mt][8 * sI + 1]); pp.y = pk2(sacc[mt][8 * sI + 2], sacc[mt][8 * sI + 3]); pp.z = pk2(sacc[mt][8 * sI + 4], sacc[mt][8 * sI + 5]); pp.w = pk2(sacc[mt][8 * sI + 6], sacc[mt][8 * sI + 7]);
                    const bf16x8 pa = __builtin_bit_cast(bf16x8, pp);
                    const int row0 = 32 * mt + 16 * sI + 4 * hh + q4;
#pragma unroll
                    for (int nt = 0; nt < 4; ++nt) {
                        const s16x4 b0 = lds_tr16(L + N_V + (row0 * VPN + 32 * nt + 16 * cb16 + 4 * p4) * 2);
                        const s16x4 b1 = lds_tr16(L + N_V + ((row0 + 8) * VPN + 32 * nt + 16 * cb16 + 4 * p4) * 2);
                        bf16x8 bfg; bfg[0] = b0[0]; bfg[1] = b0[1]; bfg[2] = b0[2]; bfg[3] = b0[3]; bfg[4] = b1[0]; bfg[5] = b1[1]; bfg[6] = b1[2]; bfg[7] = b1[3];
                        oacc[nt] = __builtin_amdgcn_mfma_f32_32x32x16_bf16(pa, bfg, oacc[nt], 0, 0, 0);
                    }
                }
        }
        tile = nxt;
    }
    __syncthreads();
}

__device__ __forceinline__ void p_nsa(Frame& F, const Args& A) {
    const bf16* U = (const bf16*)(F.ws + WS_U); bf16* HB = (bf16*)(F.ws + WS_HB); const float* GL = (const float*)(F.ws + WS_GL);
    LAS unsigned char* L = F.lds;
    LAS float* LUT = (LAS float*)(L + N_LUT); LAS float* cst = (LAS float*)(L + N_CST);
    for (int i = F.tid; i < 1024; i += NTHR) LUT[i] = A.in[1][t5_bucket_dev(i >> 3) * 8 + (i & 7)];
    if (F.wave == 0) {
        float gm = 0.f, bm = 0.f;
        for (int i = F.lane; i < 128; i += 64) gm = fmaxf(gm, fmaxf(fabsf(A.in[16][i]), fmaxf(fabsf(A.in[17][i]), fabsf(A.in[18][i]))));
        for (int i = F.lane; i < 256; i += 64) bm = fmaxf(bm, fabsf(A.in[1][i]));
#pragma unroll
        for (int o = 1; o < 64; o <<= 1) { gm = fmaxf(gm, __shfl_xor(gm, o)); bm = fmaxf(bm, __shfl_xor(bm, o)); }
        if (F.lane == 0) { cst[0] = gm * 11.3137085f; cst[1] = bm; }
    }
    __syncthreads();
    const float kmax = cst[0], bmax = cst[1];
    for (int ui = F.bid; ui < 2048; ui += F.G) {
        NsaCtx X; X.L = L; X.U = U; X.KC = (const bf16*)(F.ws + WS_KCMP); X.VC = (const bf16*)(F.ws + WS_VCMP);
        int tid = F.tid, lane = F.lane; asm volatile("" : "+v"(tid), "+v"(lane));
        X.tid = tid; X.lane = lane; X.w = F.wave; X.r = lane & 31; X.hh = lane >> 5;
        const int kr = ui >> 8, cc = ui & 255, bg = kr * 4 + (cc >> 6);
        X.b = bg >> 1; X.g = bg & 1; X.qblk = (kr & 1) ? 63 - (cc & 63) : (cc & 63); X.t0 = 64 * X.qblk; X.bat = (size_t)X.b * SEQ;
        const int tq = X.r >> 2, hd = X.r & 3; X.t = X.t0 + 8 * X.w + tq; X.head = 4 * X.g + hd;
        const size_t row = X.bat + X.t;
        if (tid == 0) *(LAS unsigned long long*)(L + N_UNI) = 0ull;
        bf16x8 qf[8]; float qn2 = 0.f;
        {
            u32x4 qr[8]; float ss = 0.f;
#pragma unroll
            for (int ks = 0; ks < 8; ++ks) { qr[ks] = *(const u32x4*)(U + row * LDO + OQ + X.head * 128 + 16 * ks + 8 * X.hh);
#pragma unroll
                for (int e = 0; e < 4; ++e) { const float a = bflo(qr[ks][e]), c = bfhi(qr[ks][e]); ss += a * a + c * c; } }
            ss += __shfl_xor(ss, 32);
            const float rs = 1.f / sqrtf(ss * (1.f / 128.f) + NORM_EPS);
#pragma unroll
            for (int ks = 0; ks < 8; ++ks) { const float* gq = A.in[15] + 16 * ks + 8 * X.hh; u32x4 pk;
#pragma unroll
                for (int e = 0; e < 4; ++e) { const float a = bflo(qr[ks][e]) * rs * gq[2 * e], c = bfhi(qr[ks][e]) * rs * gq[2 * e + 1]; qn2 += a * a + c * c; pk[e] = pk2(a * 0.0883883476f, c * 0.0883883476f); }
                qf[ks] = __builtin_bit_cast(bf16x8, pk); }
            qn2 += __shfl_xor(qn2, 32);
        }
        X.mrow = sqrtf(qn2) * 0.0883883476f * kmax + bmax;
        X.mlo = 0u; X.mhi = 0u;
        const float g_c = 1.f / (1.f + __expf(-GL[row * 24 + X.head])), g_s = 1.f / (1.f + __expf(-GL[row * 24 + 8 + X.head])), g_w = 1.f / (1.f + __expf(-GL[row * 24 + 16 + X.head]));
        f32x16 oacc[4];
#pragma unroll
        for (int nt = 0; nt < 4; ++nt) oacc[nt] = (f32x16){0.f, 0.f, 0.f, 0.f, 0.f, 0.f, 0.f, 0.f, 0.f, 0.f, 0.f, 0.f, 0.f, 0.f, 0.f, 0.f};
        const int ntc = ((4 * X.qblk + 2) >> 6) + 1;
        float l_c = 0.f;
        nsa_pass<BR_CMP, true, false, false>(X, qf, oacc, l_c, 1.f, 0, ntc - 1, ~0ull);
        l_c += __shfl_xor(l_c, 32);
        const float il_c = l_c > 0.f ? 1.f / l_c : 0.f;
        { float dummy = 0.f; nsa_pass<BR_CMP, false, false, true>(X, qf, oacc, dummy, il_c, 0, ntc - 1, ~0ull); }
        {
            LDS_WAIT();
            const LAS float* pcs = (const LAS float*)(L + N_PCS) + X.w * 8 * 256;
            const int n = lane, cur = X.qblk;
            unsigned long long wor = 0ull;
#pragma unroll 1
            for (int q = 0; q < 8; ++q) {
                float imp = 0.f;
#pragma unroll
                for (int c = 4 * n - 1; c <= 4 * n + 3; ++c) if (c >= 0 && c < 64 * ntc) imp += pcs[q * 256 + c];
                const bool forced = (n == 0) || (n == cur) || (n == cur - 1);
                float val = forced ? 3.0e38f : imp; if (n > cur) val = -3.0e38f;
                int rank = 0;
#pragma unroll 8
                for (int m = 0; m < 64; ++m) { const float vm = __shfl(val, m); rank += (vm > val || (vm == val && m < n)) ? 1 : 0; }
                const unsigned long long mk = __ballot(n <= cur && rank < 16);
                wor |= mk;
                if ((X.r >> 2) == q) { X.mlo = (unsigned)mk; X.mhi = (unsigned)(mk >> 32); }
            }
            if (lane == 0) __hip_atomic_fetch_or((LAS unsigned long long*)(L + N_UNI), wor, __ATOMIC_RELAXED, __HIP_MEMORY_SCOPE_WORKGROUP);
        }
        __syncthreads();
        const unsigned long long uni = *(const LAS unsigned long long*)(L + N_UNI);
        float l_s = 0.f;
        nsa_pass<BR_SEL, true, true, false>(X, qf, oacc, l_s, 1.f, 0, X.qblk, uni);
        l_s += __shfl_xor(l_s, 32);
        {
            LAS float* fac = (LAS float*)(L + N_FAC) + X.w * 32;
            if (lane < 32) fac[lane] = l_s > 0.f ? g_s / l_s : 0.f;
            LDS_WAIT();
#pragma unroll
            for (int q = 0; q < 4; ++q) { const f32x4 fr = *(const LAS f32x4*)(fac + 8 * q + 4 * X.hh);
#pragma unroll
                for (int nt = 0; nt < 4; ++nt) { oacc[nt][4 * q] *= fr.x; oacc[nt][4 * q + 1] *= fr.y; oacc[nt][4 * q + 2] *= fr.z; oacc[nt][4 * q + 3] *= fr.w; } }
        }
        { float dummy = 0.f; nsa_pass<BR_CMP, false, true, false>(X, qf, oacc, dummy, g_c * il_c, 0, ntc - 1, ~0ull); }
        const int wlo = X.qblk >= 8 ? X.qblk - 8 : 0;
        float l_w = 0.f;
        nsa_pass<BR_WIN, true, false, false>(X, qf, oacc, l_w, 1.f, wlo, X.qblk, ~0ull);
        l_w += __shfl_xor(l_w, 32);
        { float dummy = 0.f; nsa_pass<BR_WIN, false, true, false>(X, qf, oacc, dummy, l_w > 0.f ? g_w / l_w : 0.f, wlo, X.qblk, ~0ull); }
#pragma unroll
        for (int i = 0; i < 16; ++i) { const int c32 = 8 * (i >> 2) + 4 * X.hh + (i & 3);
            bf16* op = HB + (X.bat + X.t0 + 8 * X.w + (c32 >> 2)) * DM + (4 * X.g + (c32 & 3)) * 128 + X.r;
#pragma unroll
            for (int nt = 0; nt < 4; ++nt) op[32 * nt] = (bf16)f2bf(oacc[nt][i]); }
    }
}

constexpr int N_PHASES = 18;
__global__ void __launch_bounds__(NTHR, 2) mk_fwd(Args args) {
    extern __shared__ __attribute__((aligned(16))) unsigned char lds[];
    Frame F;
    F.lds = (LAS unsigned char*)lds;
    F.MISC = (volatile LAS unsigned*)(F.lds + MISC_OFF);
    F.tid = threadIdx.x; F.lane = F.tid & 63; F.wave = __builtin_amdgcn_readfirstlane(F.tid >> 6);
    F.G = gridDim.x; F.bid = blockIdx.x;
    F.ws = args.ws; F.out = args.out; F.ctl = (gu32*)(args.ws + WS_CTL);
    if (F.tid < 64) F.MISC[F.tid] = 0u;
    __syncthreads();
    const int lo = args.ph_lo, hi = args.ph_hi;
    XcdBarrier bar; bar.bar = (unsigned*)(F.ctl + CW_BAR); bar.x = 0; bar.st = nullptr;
    if (hi - lo > 1) bar = xcd_barrier_post((unsigned*)(F.ctl + CW_BAR), F.MISC + 8);
#ifndef PHMASK
#define PHMASK 0xffffffffu
#endif
#define IN(k) (((PHMASK >> (k)) & 1u) && lo <= (k) && (k) < hi)
#define SEAM(k) do { if (IN(k) && IN((k) + 1)) xcd_barrier(bar); } while (0)
    if (IN(0)) { p_prologue(F, args); } SEAM(0);
    if (IN(1)) {
        pg8::StaticOrder S; S.init(F.ws + WS_HB, F.ws + WS_WIE, MTOK, LDE, DM, F.G, F.bid);
        pg8::EpiBf16 E{(bf16*)(F.ws + WS_U), LDE};
        pg8::gemm_phase<pg8::EpiBf16, pg8::StaticOrder, true>(F.lds, DM, S, E);
    } SEAM(1);
    if (IN(2)) { p_ssd(F, args); } SEAM(2);
    if (IN(3)) { p_dsa(F, args); } SEAM(3);
    if (IN(4)) {
        pg8::StaticOrder S; S.init(F.ws + WS_HB, F.ws + WS_WOE, MTOK, DM, DM, F.G, F.bid);
        pg8::EpiResF32 E{args.in[0], F.out, DM};
        pg8::gemm_phase<pg8::EpiResF32, pg8::StaticOrder, true>(F.lds, DM, S, E);
    } SEAM(4);
    if (IN(5)) { p_norm_route<0>(F, F.out, args.in[3], 0); } SEAM(5);
    if (IN(6)) { p_moe_gu(F, 0); } SEAM(6);
    if (IN(7)) { p_moe_down(F, 0, 0); } SEAM(7);
    if (IN(8)) { p_moe_down(F, 0, 1); } SEAM(8);
    if (IN(9)) { p_norm_route<1>(F, F.out, args.in[2] + DM, 0); } SEAM(9);
    if (IN(10)) {
        pg8::StaticOrder S; S.init(F.ws + WS_HB, F.ws + WS_WIO, MTOK, LDO, DM, F.G, F.bid);
        pg8::EpiBf16 E{(bf16*)(F.ws + WS_U), LDO};
        pg8::gemm_phase<pg8::EpiBf16, pg8::StaticOrder, true>(F.lds, DM, S, E);
    } SEAM(10);
    if (IN(11)) { p_compress(F, args); } SEAM(11);
    if (IN(12)) { p_nsa(F, args); } SEAM(12);
    if (IN(13)) {
        pg8::StaticOrder S; S.init(F.ws + WS_HB, F.ws + WS_WOO, MTOK, DM, DM, F.G, F.bid);
        pg8::EpiResF32 E{F.out, F.out, DM};
        pg8::gemm_phase<pg8::EpiResF32, pg8::StaticOrder, true>(F.lds, DM, S, E);
    } SEAM(13);
    if (IN(14)) { p_norm_route<0>(F, F.out, args.in[3] + DM, 1); } SEAM(14);
    if (IN(15)) { p_moe_gu(F, 1); } SEAM(15);
    if (IN(16)) { p_moe_down(F, 1, 0); } SEAM(16);
    if (IN(17)) { p_moe_down(F, 1, 1); }
#undef IN
#undef SEAM
}

extern "C" void kernel_launch(void* const* d_in, const int* in_sizes, int n_in, void* d_out, int out_size, void* d_ws, size_t ws_size, hipStream_t stream) {
    static int grid = 0;
    if (grid == 0) {
        if (n_in != 31 || ws_size < WS_END) { fprintf(stderr, "kernel_launch: unexpected n_in %d / ws %zu\n", n_in, ws_size); grid = -1; return; }
        int dev = 0, cus = 0;
        if (hipGetDevice(&dev) != hipSuccess || hipDeviceGetAttribute(&cus, hipDeviceAttributeMultiprocessorCount, dev) != hipSuccess) { grid = -1; return; }
        if (hipFuncSetAttribute((const void*)mk_fwd, hipFuncAttributeMaxDynamicSharedMemorySize, LDS_BYTES) != hipSuccess) { fprintf(stderr, "kernel_launch: hipFuncSetAttribute failed\n"); grid = -1; return; }
        grid = cus;
    }
    if (grid < 0) return;
    (void)hipMemsetAsync((char*)d_ws + WS_CTL, 0, CTL_ZERO_BYTES, stream);
    Args a{};
    for (int i = 0; i < 31; ++i) a.in[i] = (const float*)d_in[i];
    a.out = (float*)d_out; a.ws = (unsigned char*)d_ws;
    for (int p = 0; p < N_PHASES; ++p) { a.ph_lo = p; a.ph_hi = p + 1; hipLaunchKernelGGL(mk_fwd, dim3(grid), dim3(NTHR), LDS_BYTES, stream, a); }
}
```

```cpp
#include <hip/hip_runtime.h>
#include <cstdio>
#include <cstdint>

#define GAS __attribute__((address_space(1)))
#define LAS __attribute__((address_space(3)))
typedef unsigned short bf16;
typedef short bf16x8 __attribute__((ext_vector_type(8)));
typedef float f32x4 __attribute__((ext_vector_type(4)));
typedef float f32x2 __attribute__((ext_vector_type(2)));
typedef float f32x16 __attribute__((ext_vector_type(16)));
typedef unsigned u32x4 __attribute__((ext_vector_type(4)));
typedef unsigned u32x2 __attribute__((ext_vector_type(2)));
typedef GAS unsigned gu32;
#define RLX_AGENT __ATOMIC_RELAXED, __HIP_MEMORY_SCOPE_AGENT
#define LDS_WAIT() asm volatile("s_waitcnt lgkmcnt(0)" ::: "memory")
#define VM_WAIT() asm volatile("s_waitcnt vmcnt(0)" ::: "memory")

constexpr int NB = 16, SEQ = 4096, DM = 1024, MTOK = NB * SEQ;
constexpr float NORM_EPS = 1e-6f;
constexpr int LDE = 2560;
constexpr int EZ = 0, EXS = 512, EBB = 1024, ECC = 1280, EQ = 1536, EK = 2048, EV = 2112, EIQ = 2176, EIK = 2432, EDT = 2496, EIW = 2504;
constexpr int LDO = 2560;
constexpr int OQ = 0, OKC = 1024, OVC = 1280, OKS = 1536, OVS = 1792, OKW = 2048, OVW = 2304;
constexpr int NWAVES = 8, NTHR = 512;

constexpr size_t MiB = 1u << 20;
constexpr size_t WS_CTL = 0, CTL_ZERO_BYTES = 1 * MiB;
constexpr size_t WS_WIE = 1 * MiB, WS_WOE = 6 * MiB, WS_WIO = 8 * MiB, WS_WOO = 13 * MiB;
constexpr size_t WS_W1K = 15 * MiB, WS_W1V = 16 * MiB, WS_W2 = 17 * MiB, WS_WR = 18 * MiB;
constexpr size_t WS_WGL = WS_WR + 256 * 1024;
constexpr size_t WS_TOK = 19 * MiB;
constexpr size_t WS_GL = 20 * MiB;
constexpr size_t WS_KCMP = 26 * MiB, WS_VCMP = 28 * MiB;
constexpr size_t WS_LIST = 32 * MiB;
constexpr size_t WS_WGU = 48 * MiB;
constexpr size_t WS_WD = 176 * MiB;
constexpr size_t WS_HB = 240 * MiB;
constexpr size_t WS_U = 368 * MiB;
constexpr size_t WS_LISTW = 720 * MiB;
constexpr size_t WS_END = 736 * MiB;
constexpr int CW_TMO = 0, CW_CODE = 1, CW_BAR = 4096, CW_CNT = 8192;

constexpr int RING_BYTES = 131072;
constexpr int LDS_BYTES = 147456;
constexpr int MISC_OFF = LDS_BYTES - 256;
constexpr int MOE_OFF = LDS_BYTES - 2048;

__device__ __forceinline__ unsigned f2bf(float f) { unsigned u = __builtin_bit_cast(unsigned, f); return (u + 0x7fffu + ((u >> 16) & 1u)) >> 16; }
__device__ __forceinline__ unsigned pk2(float lo, float hi) { return f2bf(lo) | (f2bf(hi) << 16); }
__device__ __forceinline__ float bf2f(unsigned short b) { return __builtin_bit_cast(float, ((unsigned)b) << 16); }
__device__ __forceinline__ float bflo(unsigned w) { return __builtin_bit_cast(float, w << 16); }
__device__ __forceinline__ float bfhi(unsigned w) { return __builtin_bit_cast(float, w & 0xffff0000u); }
__device__ __forceinline__ float siluf(float v) { return v / (1.f + __expf(-v)); }

#define XB_TMO      128
#define XB_XCNT(j)  (256  + 64 * (j))
#define XB_XSUB(j)  (1280 + 64 * (j))
#define XB_XGEN(j)  (2304 + 64 * (j))
#define XB_TOP      3328
#define XB_TOPGEN   3392
#define XCD_BAR_WORDS 3456
#define XB_SPIN_CAP (1u << 20)
__device__ __forceinline__ unsigned xb_ld(unsigned* p)              { return __hip_atomic_load(p, __ATOMIC_RELAXED, __HIP_MEMORY_SCOPE_AGENT); }
__device__ __forceinline__ unsigned xb_add(unsigned* p, unsigned v) { return __hip_atomic_fetch_add(p, v, __ATOMIC_RELAXED, __HIP_MEMORY_SCOPE_AGENT); }
__device__ __forceinline__ unsigned xb_xcc_id() { return (unsigned)__builtin_amdgcn_s_getreg((3 << 11) | 20) & 0xFu; }
#define XB_SPIN(cond, bar) do { unsigned _sp = 0; while (cond) { __builtin_amdgcn_s_sleep(1); \
    if ((++_sp & 255u) == 0u) { if (xb_ld(&(bar)[XB_TMO])) break; if (_sp > XB_SPIN_CAP) { atomicAdd(&(bar)[XB_TMO], 1u); break; } } } } while (0)
struct XcdBarrier { unsigned* bar; unsigned x; volatile LAS unsigned* st; };
__device__ __forceinline__ XcdBarrier xcd_barrier_post(unsigned* bar, volatile LAS unsigned* st) {
    XcdBarrier b; b.bar = bar; b.x = xb_xcc_id(); b.st = st;
    if (threadIdx.x == 0) (void)xb_add(&bar[XB_XCNT(b.x)], 1u);
    return b;
}
__device__ __forceinline__ void xcd_barrier_complete(unsigned* bar, unsigned x, unsigned& nloc, unsigned& nx) {
    const unsigned G = gridDim.x * gridDim.y * gridDim.z;
    unsigned sum, cnt, mine, sp = 0u;
    for (;;) {
        sum = 0u; cnt = 0u; mine = 0u;
#pragma unroll
        for (unsigned j = 0; j < 16; ++j) { const unsigned c = xb_ld(&bar[XB_XCNT(j)]); sum += c; cnt += (c > 0u) ? 1u : 0u; mine = (j == x) ? c : mine; }
        if (sum == G) break;
        __builtin_amdgcn_s_sleep(1);
        if ((++sp & 255u) == 0u) { if (xb_ld(&bar[XB_TMO])) break; if (sp > XB_SPIN_CAP) { atomicAdd(&bar[XB_TMO], 1u); break; } }
    }
    nloc = mine > 0u ? mine : 1u; nx = cnt > 0u ? cnt : 1u;
}
__device__ __forceinline__ void xcd_barrier(const XcdBarrier& b) {
    asm volatile("s_waitcnt vmcnt(0)" ::: "memory");
    __syncthreads();
    if (threadIdx.x == 0) {
        unsigned* bar = b.bar;
        __builtin_amdgcn_s_waitcnt(0);
        unsigned nloc = b.st[0], nx = b.st[1];
        if (nloc == 0u) { xcd_barrier_complete(bar, b.x, nloc, nx); b.st[0] = nloc; b.st[1] = nx; }
        const unsigned old = xb_add(&bar[XB_XSUB(b.x)], 1u);
        const unsigned gen = old / nloc;
        if (old + 1u == (gen + 1u) * nloc) {
            __builtin_amdgcn_fence(__ATOMIC_RELEASE, "agent");
            asm volatile("s_waitcnt vmcnt(0)" ::: "memory");
            const unsigned og = xb_add(&bar[XB_TOP], 1u);
            const unsigned tg = og / nx;
            if (og + 1u == (tg + 1u) * nx) xb_add(&bar[XB_TOPGEN], 1u);
            else XB_SPIN(xb_ld(&bar[XB_TOPGEN]) == tg, bar);
            __builtin_amdgcn_fence(__ATOMIC_ACQUIRE, "agent");
            xb_add(&bar[XB_XGEN(b.x)], 1u);
            asm volatile("s_waitcnt vmcnt(0)" ::: "memory");
        } else {
            XB_SPIN(xb_ld(&bar[XB_XGEN(b.x)]) == gen, bar);
            __builtin_amdgcn_fence(__ATOMIC_ACQUIRE, "agent");
            asm volatile("s_waitcnt vmcnt(0)" ::: "memory");
        }
    }
    __syncthreads();
}

namespace pg8 {
constexpr int BM = 256, BK = 64, HALF = 128, HTB = HALF * BK * 2, STAGE_BYTES = 8 * HTB, NXCD = 8, WGM = 8;
__host__ __device__ __forceinline__ int lds_byte(int r, int c) { const int st = (r >> 4) * 2 + (c >> 5), rr = r & 15, cc = c & 31, ob = rr * 64 + cc * 2; return st * 1024 + (ob ^ (((ob >> 9) & 1) << 5)); }
__host__ __device__ __forceinline__ void stage_rc(int b, int& R, int& C) { const int st = b / 1024, sb = b % 1024, swz = sb ^ (((sb >> 9) & 1) << 5); R = (st >> 1) * 16 + swz / 64; C = (st & 1) * 32 + (swz % 64) / 2; }
__host__ __device__ __forceinline__ int perm32(int rho) { const int n = rho >> 4, i = rho & 15; return 8 * (i >> 2) + 4 * n + (i & 3); }
__device__ __forceinline__ unsigned cvt_pk_bf16(float lo, float hi) { unsigned r; asm volatile("v_cvt_pk_bf16_f32 %0, %1, %2" : "=v"(r) : "v"(lo), "v"(hi)); return r; }

struct Unit { const char* A; const char* B; int pm, pn, aux; };

struct StaticOrder {
    const char* A; const char* Bt; int K, nM, nN, nwg, G, c;
    __device__ void init(const void* A_, const void* Bt_, int M, int N, int K_, int G_, int c_) { A = (const char*)A_; Bt = (const char*)Bt_; K = K_; nM = M / BM; nN = N / BM; nwg = nM * nN; G = G_; c = c_; }
    __device__ __forceinline__ bool next(int i, Unit& u) const {
        const long L = (long)i * G + c; if (L >= nwg) return false;
        int wgid = (int)L; { const int q = nwg / NXCD, r = nwg % NXCD, xcd = wgid % NXCD, off = wgid / NXCD; wgid = (xcd < r ? xcd * (q + 1) : r * (q + 1) + (xcd - r) * q) + off; }
        const int nig = WGM * nN, gid = wgid / nig, fm = gid * WGM, gsz = (nM - fm) < WGM ? (nM - fm) : WGM;
        u.pm = fm + ((wgid % nig) % gsz); u.pn = (wgid % nig) / gsz; u.aux = 0;
        u.A = A + (size_t)u.pm * BM * K * 2; u.B = Bt + (size_t)u.pn * BM * K * 2; return true;
    }
    __device__ __forceinline__ unsigned arow(const Unit&, int r) const { return (unsigned)(r * K) * 2u; }
};

template <class Epi, class Sched, bool ALIGN_EPI>
__device__ __forceinline__ void gemm_phase(LAS unsigned char* lds, const int K, const Sched& S, const Epi& E) {
    const int tid = threadIdx.x, wid = __builtin_amdgcn_readfirstlane(tid >> 6), lane = tid & 63, wr = wid >> 2, wc = wid & 3, fr = lane & 15, fq = lane >> 4;
    const int nt = K / BK;
    int RA[2], CA[2]; unsigned voffB[2];
#pragma unroll
    for (int i = 0; i < 2; ++i) { int R, C; stage_rc(tid * 16 + i * 8192, R, C); const int Rb = Epi::PERM ? ((R & ~31) + perm32(R & 31)) : R;
        RA[i] = R; CA[i] = C; voffB[i] = (unsigned)(Rb * K + C) * 2u; }
    const size_t kstep = (size_t)(BK * 2);
    const size_t hstep = (size_t)HALF * K * 2;
    const unsigned ldsw = (unsigned)wid * 1024u;
    const int aoff = lds_byte(wr * 64 + fr, fq * 8), boff = lds_byte(wc * 32 + fr, fq * 8);
#define PG8_SA(b, h) (((b) * 2 + (h)) * HTB)
#define PG8_SB(b, h) ((4 + (b) * 2 + (h)) * HTB)
#define PG8_STAGE(bufoff, gbase, voff) do { _Pragma("unroll") for (int _i = 0; _i < 2; ++_i) \
        __builtin_amdgcn_global_load_lds((const unsigned*)((const char*)(gbase) + (voff)[_i]), (LAS unsigned*)(lds + (bufoff) + ldsw + _i * 8192), 16, 0, 0); } while (0)
#define PG8_LDA(dst, b, h) do { _Pragma("unroll") for (int m = 0; m < 4; ++m) _Pragma("unroll") for (int k = 0; k < 2; ++k) dst[m][k] = *(const LAS bf16x8*)(lds + PG8_SA(b, h) + aoff + m * 2048 + k * 1024); } while (0)
#define PG8_LDB(dst, b, h) do { _Pragma("unroll") for (int n = 0; n < 2; ++n) _Pragma("unroll") for (int k = 0; k < 2; ++k) dst[n][k] = *(const LAS bf16x8*)(lds + PG8_SB(b, h) + boff + n * 2048 + k * 1024); } while (0)
#define PG8_MMA(ai, bj, At, Bt) do { __builtin_amdgcn_s_setprio(1); _Pragma("unroll") for (int m = 0; m < 4; ++m) _Pragma("unroll") for (int n = 0; n < 2; ++n) _Pragma("unroll") for (int k = 0; k < 2; ++k) \
        acc[ai][bj][m][n] = __builtin_amdgcn_mfma_f32_16x16x32_bf16(Bt[n][k], At[m][k], acc[ai][bj][m][n], 0, 0, 0); __builtin_amdgcn_s_setprio(0); } while (0)
#define PG8_WAIT_V(n) asm volatile("s_waitcnt vmcnt(" #n ")" ::: "memory")
#define PG8_WAIT_L(n) asm volatile("s_waitcnt lgkmcnt(" #n ")" ::: "memory")
#define PG8_BAR __builtin_amdgcn_s_barrier()
#define PG8_SCHED __builtin_amdgcn_sched_barrier(0)
    Unit cur, nxt; int ui = 0;
    if (!S.next(0, cur)) return;
    f32x4 acc[2][2][4][2];
#pragma unroll
    for (int a = 0; a < 2; ++a)
#pragma unroll
        for (int b = 0; b < 2; ++b)
#pragma unroll
            for (int m = 0; m < 4; ++m)
#pragma unroll
                for (int n = 0; n < 2; ++n) acc[a][b][m][n] = (f32x4){0.f, 0.f, 0.f, 0.f};
    bf16x8 At[4][2], B0[2][2], B1[2][2];
    unsigned vA0[2], vA1[2], nA0[2], nA1[2];
#pragma unroll
    for (int i = 0; i < 2; ++i) { vA0[i] = S.arow(cur, RA[i]) + CA[i] * 2u; vA1[i] = S.arow(cur, HALF + RA[i]) + CA[i] * 2u; nA0[i] = vA0[i]; nA1[i] = vA1[i]; }
    const char* cA = cur.A; const char* cB = cur.B;
    PG8_STAGE(PG8_SB(0, 0), cB, voffB); PG8_STAGE(PG8_SB(0, 1), cB + hstep, voffB); PG8_STAGE(PG8_SA(0, 0), cA, vA0); PG8_STAGE(PG8_SA(0, 1), cA, vA1);
    if (wr == 1) PG8_BAR;
    PG8_WAIT_V(2); PG8_BAR;
    PG8_STAGE(PG8_SB(1, 0), cB + kstep, voffB); PG8_STAGE(PG8_SA(1, 0), cA + kstep, vA0); PG8_STAGE(PG8_SB(1, 1), cB + hstep + kstep, voffB);
    PG8_WAIT_V(6); PG8_BAR;
    for (;;) {
        const bool has_next = S.next(ui + 1, nxt);
        const char* nA = has_next ? nxt.A : cA; const char* nB = has_next ? nxt.B : cB;
        if (has_next) {
#pragma unroll
            for (int i = 0; i < 2; ++i) { nA0[i] = S.arow(nxt, RA[i]) + CA[i] * 2u; nA1[i] = S.arow(nxt, HALF + RA[i]) + CA[i] * 2u; }
        }
        for (int t = 0; t < nt; t += 2) {
            const bool last = (t == nt - 2);
            const char* a1 = cA + (size_t)(t + 1) * kstep;
            const char* a2 = last ? nA : cA + (size_t)(t + 2) * kstep; const char* b2 = last ? nB : cB + (size_t)(t + 2) * kstep;
            const char* a3 = a2 + kstep; const char* b3 = b2 + kstep;
            unsigned w0[2], w1[2];
#pragma unroll
            for (int i = 0; i < 2; ++i) { w0[i] = last ? nA0[i] : vA0[i]; w1[i] = last ? nA1[i] : vA1[i]; }
            PG8_LDB(B0, 0, 0); PG8_LDB(B1, 0, 1); PG8_SCHED; PG8_LDA(At, 0, 0); PG8_STAGE(PG8_SA(1, 1), a1, vA1);
            PG8_WAIT_V(8); PG8_WAIT_L(0); PG8_BAR; PG8_MMA(0, 0, At, B0); PG8_MMA(0, 1, At, B1); PG8_BAR; PG8_SCHED;
            PG8_LDA(At, 0, 1); PG8_STAGE(PG8_SB(0, 0), b2, voffB); PG8_STAGE(PG8_SB(0, 1), b2 + hstep, voffB); PG8_STAGE(PG8_SA(0, 0), a2, w0);
            PG8_WAIT_V(8); PG8_WAIT_L(0); PG8_BAR; PG8_MMA(1, 0, At, B0); PG8_MMA(1, 1, At, B1); PG8_BAR; PG8_SCHED;
            PG8_LDB(B0, 1, 0); PG8_LDB(B1, 1, 1); PG8_SCHED; PG8_LDA(At, 1, 0); PG8_STAGE(PG8_SA(0, 1), a2, w1);
            PG8_WAIT_V(8); PG8_WAIT_L(0); PG8_BAR; PG8_MMA(0, 0, At, B0); PG8_MMA(0, 1, At, B1); PG8_BAR; PG8_SCHED;
            PG8_LDA(At, 1, 1); PG8_STAGE(PG8_SB(1, 0), b3, voffB); PG8_STAGE(PG8_SB(1, 1), b3 + hstep, voffB); PG8_STAGE(PG8_SA(1, 0), a3, w0);
            PG8_WAIT_V(8); PG8_WAIT_L(0); PG8_BAR; PG8_MMA(1, 0, At, B0); PG8_MMA(1, 1, At, B1); PG8_BAR; PG8_SCHED;
        }
        if constexpr (ALIGN_EPI) { if (wr == 0) PG8_BAR; }
        E(acc, cur, wr, wc, fr, fq);
        if (!has_next) break;
#pragma unroll
        for (int a = 0; a < 2; ++a)
#pragma unroll
            for (int b = 0; b < 2; ++b)
#pragma unroll
                for (int m = 0; m < 4; ++m)
#pragma unroll
                    for (int n = 0; n < 2; ++n) acc[a][b][m][n] = (f32x4){0.f, 0.f, 0.f, 0.f};
        cur = nxt; cA = nA; cB = nB; ++ui;
#pragma unroll
        for (int i = 0; i < 2; ++i) { vA0[i] = nA0[i]; vA1[i] = nA1[i]; }
        if constexpr (ALIGN_EPI) { if (wr == 1) PG8_BAR; }
    }
    PG8_WAIT_V(0);
    if constexpr (!ALIGN_EPI) { if (wr == 0) PG8_BAR; }
    PG8_BAR;
#undef PG8_SA
#undef PG8_SB
#undef PG8_STAGE
#undef PG8_LDA
#undef PG8_LDB
#undef PG8_MMA
#undef PG8_WAIT_V
#undef PG8_WAIT_L
#undef PG8_BAR
#undef PG8_SCHED
}

struct EpiBf16 {
    static constexpr bool PERM = true;
    bf16* O; int ldc;
    __device__ __forceinline__ void operator()(const f32x4 (&acc)[2][2][4][2], const Unit& u, int wr, int wc, int fr, int fq) const {
        const int row0 = u.pm * BM + wr * 64 + fr; const int col0 = u.pn * BM + wc * 32 + 8 * fq;
#pragma unroll
        for (int ai = 0; ai < 2; ++ai)
#pragma unroll
            for (int m = 0; m < 4; ++m) { bf16* rowp = O + (size_t)(row0 + ai * HALF + m * 16) * ldc + col0;
#pragma unroll
                for (int bj = 0; bj < 2; ++bj) { const f32x4 v0 = acc[ai][bj][m][0], v1 = acc[ai][bj][m][1];
                    u32x4 w; w.x = cvt_pk_bf16(v0[0], v0[1]); w.y = cvt_pk_bf16(v0[2], v0[3]); w.z = cvt_pk_bf16(v1[0], v1[1]); w.w = cvt_pk_bf16(v1[2], v1[3]);
                    *(u32x4*)(rowp + bj * HALF) = w; } }
    }
};
struct EpiResF32 {
    static constexpr bool PERM = false;
    const float* base; float* out; int ldc;
    __device__ __forceinline__ void operator()(const f32x4 (&acc)[2][2][4][2], const Unit& u, int wr, int wc, int fr, int fq) const {
        const int row0 = u.pm * BM + wr * 64 + fr, col0 = u.pn * BM + wc * 32 + 4 * fq;
#pragma unroll
        for (int ai = 0; ai < 2; ++ai)
#pragma unroll
            for (int m = 0; m < 4; ++m) { const size_t off = (size_t)(row0 + ai * HALF + m * 16) * ldc + col0;
#pragma unroll
                for (int bj = 0; bj < 2; ++bj)
#pragma unroll
                    for (int n = 0; n < 2; ++n) { const f32x4 bs = *(const f32x4*)(base + off + bj * HALF + n * 16); *(f32x4*)(out + off + bj * HALF + n * 16) = bs + acc[ai][bj][m][n]; } }
    }
};

struct MoeOrder {
    const char* Abase; const char* Bbase; size_t bstride; int K, G, c, tile_lo, tile_hi; const LAS int* ptile; const LAS int* cntv; const int* list; bool gather;
    __device__ __forceinline__ bool next(int i, Unit& u) const {
        const long L = (long)i * G + c; const int nun = (tile_hi - tile_lo) * 4; if (L >= nun) return false;
        const int tile = tile_lo + (int)(L >> 2), pn = (int)(L & 3);
        int e = 0;
        for (int k = 1; k < 64; ++k) e += (tile >= __builtin_amdgcn_readfirstlane(ptile[k])) ? 1 : 0;
        const int j = tile - __builtin_amdgcn_readfirstlane(ptile[e]);
        u.pm = tile; u.pn = pn; u.aux = e | (j << 6);
        u.A = gather ? Abase : Abase + (size_t)tile * BM * K * 2; u.B = Bbase + (size_t)(e & 31) * bstride + (size_t)pn * BM * K * 2; return true;
    }
    __device__ __forceinline__ unsigned arow(const Unit& u, int r) const {
        if (!gather) return (unsigned)(r * K) * 2u;
        const int e = u.aux & 63, pos = (u.aux >> 6) * 256 + r; const int cn = cntv[e];
        const int tok = pos < cn ? list[(size_t)e * 65536 + pos] : 0;
        return (unsigned)tok * (unsigned)(K * 2);
    }
};
struct EpiSwiGLU {
    static constexpr bool PERM = true;
    bf16* H;
    __device__ __forceinline__ void operator()(const f32x4 (&acc)[2][2][4][2], const Unit& u, int wr, int wc, int fr, int fq) const {
        const int row0 = u.pm * BM + wr * 64 + fr; const int col0 = u.pn * 128 + wc * 32 + 8 * fq;
#pragma unroll
        for (int ai = 0; ai < 2; ++ai)
#pragma unroll
            for (int m = 0; m < 4; ++m) { bf16* rowp = H + (size_t)(row0 + ai * HALF + m * 16) * 512 + col0;
                const f32x4 g0 = acc[ai][0][m][0], g1 = acc[ai][0][m][1], u0 = acc[ai][1][m][0], u1 = acc[ai][1][m][1];
                float h[8];
#pragma unroll
                for (int q = 0; q < 4; ++q) { h[q] = g0[q] / (1.f + __expf(-g0[q])) * u0[q]; h[4 + q] = g1[q] / (1.f + __expf(-g1[q])) * u1[q]; }
                u32x4 w; w.x = cvt_pk_bf16(h[0], h[1]); w.y = cvt_pk_bf16(h[2], h[3]); w.z = cvt_pk_bf16(h[4], h[5]); w.w = cvt_pk_bf16(h[6], h[7]);
                *(u32x4*)rowp = w; }
    }
};
struct EpiScatter {
    static constexpr bool PERM = false;
    float* out; const int* list; const float* wl; const LAS int* cntv;
    __device__ __forceinline__ void operator()(const f32x4 (&acc)[2][2][4][2], const Unit& u, int wr, int wc, int fr, int fq) const {
        const int e = u.aux & 63, j = u.aux >> 6; const int cn = cntv[e];
        const int col0 = u.pn * BM + wc * 32 + 4 * fq;
#pragma unroll
        for (int ai = 0; ai < 2; ++ai)
#pragma unroll
            for (int m = 0; m < 4; ++m) { const int pos = j * 256 + ai * HALF + wr * 64 + m * 16 + fr;
                if (pos < cn) { const int tok = list[(size_t)e * 65536 + pos]; const float wg = wl[(size_t)e * 65536 + pos];
                    float* rowp = out + (size_t)tok * DM + col0;
#pragma unroll
                    for (int bj = 0; bj < 2; ++bj)
#pragma unroll
                        for (int n = 0; n < 2; ++n) { f32x4* p = (f32x4*)(rowp + bj * HALF + n * 16); *p = *p + wg * acc[ai][bj][m][n]; } } }
    }
};
}

struct Frame {
    LAS unsigned char* lds;
    volatile LAS unsigned* MISC;
    gu32* ctl;
    int tid, lane, wave, G, bid;
    float* out; unsigned char* ws;
};
struct Args { const float* in[31]; float* out; unsigned char* ws; int ph_lo, ph_hi; };
__device__ __forceinline__ float wave_sum(float v) {
#pragma unroll
    for (int o = 1; o < 64; o <<= 1) v += __shfl_xor(v, o);
    return v;
}

template <class Map>
__device__ __forceinline__ void transpose_item(const float* W, int K, int pitch, int col0, int ncols, bf16* WT, LAS float* scr, int item, int lane, Map dmap) {
    const int nblk = (ncols + 31) / 32, kb = item / nblk, nb = item % nblk, k0 = 64 * kb, n0 = 32 * nb;
    const int nn = n0 + (lane & 31);
#pragma unroll 8
    for (int i = 0; i < 32; ++i) { const int kk = 2 * i + (lane >> 5); scr[kk * 33 + (lane & 31)] = (nn < ncols) ? W[(size_t)(k0 + kk) * pitch + col0 + nn] : 0.f; }
    LDS_WAIT(); asm volatile("" ::: "memory");
    const int c = lane & 7;
#pragma unroll
    for (int j = 0; j < 4; ++j) { const int n = (lane >> 3) + 8 * j; const LAS float* s = scr + (8 * c) * 33 + n;
        u32x4 o; o.x = pk2(s[0 * 33], s[1 * 33]); o.y = pk2(s[2 * 33], s[3 * 33]); o.z = pk2(s[4 * 33], s[5 * 33]); o.w = pk2(s[6 * 33], s[7 * 33]);
        if (n0 + n < ncols) *(u32x4*)(WT + (size_t)dmap(n0 + n) * K + k0 + 8 * c) = o; }
    LDS_WAIT(); asm volatile("" ::: "memory");
}
struct MapId { int off; __device__ int operator()(int n) const { return n + off; } };
struct MapEven { __device__ int operator()(int c) const {
    if (c < 1536) return c; if (c < 1544) return EDT + (c - 1536); if (c < 2056) return EQ + (c - 1544); if (c < 2120) return EK + (c - 2056);
    if (c < 2184) return EV + (c - 2120); if (c < 2440) return EIQ + (c - 2184); if (c < 2504) return EIK + (c - 2440); return EIW + (c - 2504); } };
struct MapGU { int half; __device__ int operator()(int n) const { return 256 * (n >> 7) + 128 * half + (n & 127); } };

__device__ __forceinline__ void rms_row_to_bf16(const float* xrow, const float* gain, bf16* orow, int lane) {
    const f32x4* xr = (const f32x4*)xrow + lane; const f32x4* gr = (const f32x4*)gain + lane;
    f32x4 v[4]; float s = 0.f;
#pragma unroll
    for (int j = 0; j < 4; ++j) { v[j] = xr[64 * j]; s += (v[j].x * v[j].x + v[j].y * v[j].y) + (v[j].z * v[j].z + v[j].w * v[j].w); }
    const float rs = 1.f / sqrtf(wave_sum(s) * (1.f / DM) + NORM_EPS);
    unsigned long long* o8 = (unsigned long long*)orow + lane;
#pragma unroll
    for (int j = 0; j < 4; ++j) { const f32x4 g = gr[64 * j]; o8[64 * j] = (unsigned long long)pk2(v[j].x * rs * g.x, v[j].y * rs * g.y) | ((unsigned long long)pk2(v[j].z * rs * g.z, v[j].w * rs * g.w) << 32); }
}

__device__ __forceinline__ void p_prologue(Frame& F, const Args& A) {
    LAS float* scr = (LAS float*)(F.lds + F.wave * 16384);
    const int gw = F.bid * NWAVES + F.wave, NGW = F.G * NWAVES;
    bf16* Wie = (bf16*)(F.ws + WS_WIE); bf16* Woe = (bf16*)(F.ws + WS_WOE);
    constexpr int I_IE = 16 * 79, I_OE = 16 * 32;
    for (int it = gw; it < I_IE + I_OE; it += NGW) {
        if (it < I_IE) transpose_item(A.in[4], 1024, 2508, 0, 2508, Wie, scr, it, F.lane, MapEven());
        else transpose_item(A.in[13], 1024, 1024, 0, 1024, Woe, scr, it - I_IE, F.lane, MapId{0});
    }
    {
        bf16* Wgu = (bf16*)(F.ws + WS_WGU); bf16* Wd = (bf16*)(F.ws + WS_WD); bf16* WR = (bf16*)(F.ws + WS_WR);
        for (int it = gw; it < 64 * 768; it += NGW) { const int le = it / 768, r = it % 768;
            if (r < 256) transpose_item(A.in[28] + (size_t)le * 1024 * 512, 1024, 512, 0, 512, Wgu + (size_t)le * 1024 * 1024, scr, r, F.lane, MapGU{0});
            else if (r < 512) transpose_item(A.in[29] + (size_t)le * 1024 * 512, 1024, 512, 0, 512, Wgu + (size_t)le * 1024 * 1024, scr, r - 256, F.lane, MapGU{1});
            else transpose_item(A.in[30] + (size_t)le * 512 * 1024, 512, 1024, 0, 1024, Wd + (size_t)le * 1024 * 512, scr, r - 512, F.lane, MapId{0}); }
        for (int it = gw; it < 2 * 5 * 16; it += NGW) { const int l = it / 80, r = it % 80, q = r / 16, kb = r % 16;
            if (q == 0) transpose_item(A.in[26] + (size_t)l * 1024 * 4, 1024, 4, 0, 4, WR + (size_t)l * 48 * 1024, scr, kb, F.lane, MapId{0});
            else transpose_item(A.in[27] + (size_t)(l * 4 + q - 1) * 1024 * 8, 1024, 8, 0, 8, WR + (size_t)l * 48 * 1024, scr, kb, F.lane, MapId{4 + 8 * (q - 1)}); }
        for (int i = gw * 64 + F.lane; i < 2 * 12 * 1024 / 8; i += NGW * 64) { const int l = i / (12 * 128), o = i % (12 * 128); *(u32x4*)(WR + (size_t)l * 48 * 1024 + 36 * 1024 + (size_t)o * 8) = (u32x4){0u, 0u, 0u, 0u}; }
    }
    {
        bf16* Wio = (bf16*)(F.ws + WS_WIO); bf16* Woo = (bf16*)(F.ws + WS_WOO); bf16* WGL = (bf16*)(F.ws + WS_WGL);
        bf16* W1K = (bf16*)(F.ws + WS_W1K); bf16* W1V = (bf16*)(F.ws + WS_W1V); bf16* W2 = (bf16*)(F.ws + WS_W2);
        constexpr int J0 = 16 * 80, J1 = J0 + 16, J2 = J1 + 16 * 32, J3 = J2 + 64 * 4, J4 = J3 + 64 * 4, J5 = J4 + 2 * 4, J6 = J5 + 2 * 4;
        for (int it = gw; it < J6; it += NGW) {
            if (it < J0) transpose_item(A.in[14], 1024, 2584, 0, 2560, Wio, scr, it, F.lane, MapId{0});
            else if (it < J1) transpose_item(A.in[14], 1024, 2584, 2560, 24, WGL, scr, it - J0, F.lane, MapId{0});
            else if (it < J2) transpose_item(A.in[25], 1024, 1024, 0, 1024, Woo, scr, it - J1, F.lane, MapId{0});
            else if (it < J3) transpose_item(A.in[21], 4096, 128, 0, 128, W1K, scr, it - J2, F.lane, MapId{0});
            else if (it < J4) transpose_item(A.in[23], 4096, 128, 0, 128, W1V, scr, it - J3, F.lane, MapId{0});
            else if (it < J5) transpose_item(A.in[22], 128, 128, 0, 128, W2, scr, it - J4, F.lane, MapId{0});
            else transpose_item(A.in[24], 128, 128, 0, 128, W2 + 128 * 128, scr, it - J5, F.lane, MapId{0});
        }
        for (int i = gw * 64 + F.lane; i < 8 * 1024 / 8; i += NGW * 64) *(u32x4*)(WGL + 24 * 1024 + (size_t)i * 8) = (u32x4){0u, 0u, 0u, 0u};
    }
    for (int i = gw * 64 + F.lane; i < 52 * 1024 / 8; i += NGW * 64) *(u32x4*)(Wie + (size_t)2508 * 1024 + (size_t)i * 8) = (u32x4){0u, 0u, 0u, 0u};
    bf16* HB = (bf16*)(F.ws + WS_HB);
    for (int m = gw; m < MTOK; m += NGW) rms_row_to_bf16(A.in[0] + (size_t)m * DM, A.in[2], HB + (size_t)m * DM, F.lane);
}

constexpr int SP = 136;
constexpr int L_CS = 0, L_BS = 34816, L_BT = 69632, L_XT = 104448, L_XS = 113152, L_ST = 121856, L_AC = 139264, L_DT = 139776, L_CW = 140288;
__device__ __forceinline__ bf16x8 lds_frag(LAS unsigned char* base, int row, int col) { return *(const LAS bf16x8*)(base + (row * SP + col) * 2); }

__device__ __forceinline__ void p_ssd(Frame& F, const Args& A) {
    bf16* U = (bf16*)(F.ws + WS_U);
    const int w = F.wave;
    { const int tid = F.tid;
    for (int r0 = F.bid * 64; r0 < MTOK; r0 += F.G * 64) {
        const int row = r0 + (tid >> 3), c8 = (tid & 7) * 8;
        bf16* p = U + (size_t)row * LDE + EK + c8;
        const u32x4 v = *(const u32x4*)p; float f[8] = {bflo(v.x), bfhi(v.x), bflo(v.y), bfhi(v.y), bflo(v.z), bfhi(v.z), bflo(v.w), bfhi(v.w)};
        float s = 0.f;
#pragma unroll
        for (int j = 0; j < 8; ++j) s += f[j] * f[j];
        s += __shfl_xor(s, 1); s += __shfl_xor(s, 2); s += __shfl_xor(s, 4);
        const float rs = 1.f / sqrtf(s * (1.f / 64.f) + NORM_EPS); const float* g = A.in[12] + c8;
        u32x4 o; o.x = pk2(f[0] * rs * g[0], f[1] * rs * g[1]); o.y = pk2(f[2] * rs * g[2], f[3] * rs * g[3]); o.z = pk2(f[4] * rs * g[4], f[5] * rs * g[5]); o.w = pk2(f[6] * rs * g[6], f[7] * rs * g[7]);
        *(u32x4*)p = o;
    } }
    LAS unsigned char* L = F.lds;
    LAS float* acum = (LAS float*)(L + L_AC); LAS float* dtv = (LAS float*)(L + L_DT); LAS float* cw = (LAS float*)(L + L_CW);
    const float* conv_w = A.in[5]; const float* conv_b = A.in[6];
    for (int st = F.bid; st < 256; st += F.G) {
        const int b = st >> 4, h = (st >> 1) & 7, ph = st & 1, g = h >> 2;
        { const int tid = F.tid;
        __syncthreads();
        for (int i = tid; i < 5 * 288; i += NTHR) { const int j = i / 288, lc = i % 288;
            const int ch = lc < 128 ? 512 + g * 128 + lc : (lc < 256 ? 768 + g * 128 + (lc - 128) : h * 64 + ph * 32 + (lc - 256));
            cw[i] = j < 4 ? conv_w[j * 1024 + ch] : conv_b[ch]; }
        for (int i = tid; i < 2 * 32 * SP / 2; i += NTHR) ((LAS unsigned*)(L + L_ST))[i] = 0u; }
        const float a_h = -__expf(A.in[8][h]), dtb = A.in[7][h], dsk = A.in[9][h];
        f32x16 state = {0.f, 0.f, 0.f, 0.f, 0.f, 0.f, 0.f, 0.f, 0.f, 0.f, 0.f, 0.f, 0.f, 0.f, 0.f, 0.f};
        __syncthreads();
        for (int c = 0; c < 32; ++c) {
            const size_t rowbase = (size_t)b * SEQ + (size_t)c * 128;
            int tid = F.tid, lane = F.lane; asm volatile("" : "+v"(tid), "+v"(lane));
            if (tid < 128) {
                const float dr = bf2f(U[(rowbase + tid) * LDE + EDT + h]) + dtb;
                const float dt = dr > 20.f ? dr : log1pf(__expf(dr));
                float s = dt * a_h;
#pragma unroll
                for (int o = 1; o < 64; o <<= 1) { const float t = __shfl_up(s, o); if (lane >= o) s += t; }
                dtv[tid] = dt; acum[tid] = s;
            }
            {
                const int cg = tid & 15, rr = tid >> 4;
#pragma unroll 1
                for (int T = 0; T < 2; ++T) {
                    const int gcol = (T == 0 ? EBB : ECC) + g * 128 + 8 * cg;
                    u32x4 raw[7];
#pragma unroll
                    for (int j = 0; j < 7; ++j) { const int tl = 4 * rr - 3 + j;
                        raw[j] = (u32x4){0u, 0u, 0u, 0u};
                        if (c > 0 || tl >= 0) raw[j] = *(const u32x4*)(U + (size_t)((long)rowbase + tl) * LDE + gcol); }
                    LAS unsigned char* dst = L + (T == 0 ? L_BS : L_CS);
                    unsigned opk[4][4];
#pragma unroll
                    for (int e2 = 0; e2 < 4; ++e2) {
                        const int lc = T * 128 + 8 * cg + 2 * e2;
                        const f32x2 w0 = *(const LAS f32x2*)(cw + lc), w1 = *(const LAS f32x2*)(cw + 288 + lc), w2 = *(const LAS f32x2*)(cw + 576 + lc), w3 = *(const LAS f32x2*)(cw + 864 + lc), bb = *(const LAS f32x2*)(cw + 1152 + lc);
                        float lo[7], hi[7];
#pragma unroll
                        for (int j = 0; j < 7; ++j) { lo[j] = bflo(raw[j][e2]); hi[j] = bfhi(raw[j][e2]); }
                        float ol[4], oh[4];
#pragma unroll
                        for (int q = 0; q < 4; ++q) { ol[q] = siluf(bb.x + w0.x * lo[q] + w1.x * lo[q + 1] + w2.x * lo[q + 2] + w3.x * lo[q + 3]);
                                                      oh[q] = siluf(bb.y + w0.y * hi[q] + w1.y * hi[q + 1] + w2.y * hi[q + 2] + w3.y * hi[q + 3]); opk[q][e2] = pk2(ol[q], oh[q]); }
                        if (T == 0) {
                            *(LAS u32x2*)(L + L_BT + ((8 * cg + 2 * e2) * SP + 4 * rr) * 2) = (u32x2){pk2(ol[0], ol[1]), pk2(ol[2], ol[3])};
                            *(LAS u32x2*)(L + L_BT + ((8 * cg + 2 * e2 + 1) * SP + 4 * rr) * 2) = (u32x2){pk2(oh[0], oh[1]), pk2(oh[2], oh[3])};
                        }
                    }
#pragma unroll
                    for (int q = 0; q < 4; ++q) *(LAS u32x4*)(dst + ((4 * rr + q) * SP + 8 * cg) * 2) = (u32x4){opk[q][0], opk[q][1], opk[q][2], opk[q][3]};
                }
            }
            __syncthreads();
            if (tid >= 64 && tid < 128) acum[tid] += acum[63];
            __syncthreads();
            {
                const int cg = tid & 3, t = tid >> 2;
                const int gcol = EXS + h * 64 + ph * 32 + 8 * cg;
                u32x4 raw[4];
#pragma unroll
                for (int j = 0; j < 4; ++j) { const int tl = t - 3 + j; raw[j] = (u32x4){0u, 0u, 0u, 0u};
                    if (c > 0 || tl >= 0) raw[j] = *(const u32x4*)(U + (size_t)((long)rowbase + tl) * LDE + gcol); }
                const float sc = dtv[t] * __expf(acum[127] - acum[t]);
#pragma unroll
                for (int e = 0; e < 8; ++e) { const int lc = 256 + 8 * cg + e;
                    float rv[4];
#pragma unroll
                    for (int j = 0; j < 4; ++j) rv[j] = (e & 1) ? bfhi(raw[j][e >> 1]) : bflo(raw[j][e >> 1]);
                    const float xv = siluf(cw[1152 + lc] + cw[lc] * rv[0] + cw[288 + lc] * rv[1] + cw[576 + lc] * rv[2] + cw[864 + lc] * rv[3]);
                    *(LAS bf16*)(L + L_XT + ((8 * cg + e) * SP + t) * 2) = (bf16)f2bf(xv);
                    *(LAS bf16*)(L + L_XS + ((8 * cg + e) * SP + t) * 2) = (bf16)f2bf(xv * sc); }
            }
            const int mt = w >> 1, nh = w & 1, r = lane & 31, hh = lane >> 5;
            f32x16 cb[2];
#pragma unroll
            for (int j = 0; j < 2; ++j) {
                cb[j] = (f32x16){0.f, 0.f, 0.f, 0.f, 0.f, 0.f, 0.f, 0.f, 0.f, 0.f, 0.f, 0.f, 0.f, 0.f, 0.f, 0.f};
                const int s0 = 64 * nh + 32 * j;
                if (s0 <= 32 * mt + 31) {
#pragma unroll
                    for (int ks = 0; ks < 8; ++ks) {
                        const bf16x8 af = lds_frag(L + L_CS, 32 * mt + r, 16 * ks + 8 * hh), bfg = lds_frag(L + L_BS, s0 + r, 16 * ks + 8 * hh);
                        cb[j] = __builtin_amdgcn_mfma_f32_32x32x16_bf16(af, bfg, cb[j], 0, 0, 0);
                    }
                }
            }
            __syncthreads();
#pragma unroll
            for (int j = 0; j < 2; ++j) {
                const int s = 64 * nh + 32 * j + r; const float as = acum[s], ds = dtv[s];
#pragma unroll
                for (int i = 0; i < 16; ++i) { const int t = 32 * mt + 8 * (i >> 2) + 4 * hh + (i & 3);
                    const float v = (s <= t) ? cb[j][i] * __expf(acum[t] - as) * ds : 0.f;
                    *(LAS bf16*)(L + L_BS + (t * SP + s) * 2) = (bf16)f2bf(v); }
            }
            __syncthreads();
            if (w < 4) {
                f32x16 yd = {0.f, 0.f, 0.f, 0.f, 0.f, 0.f, 0.f, 0.f, 0.f, 0.f, 0.f, 0.f, 0.f, 0.f, 0.f, 0.f}, yo = yd;
                for (int ks = 0; ks < 2 * (w + 1); ++ks) {
                    const bf16x8 af = lds_frag(L + L_BS, 32 * w + r, 16 * ks + 8 * hh), bfg = lds_frag(L + L_XT, r, 16 * ks + 8 * hh);
                    yd = __builtin_amdgcn_mfma_f32_32x32x16_bf16(af, bfg, yd, 0, 0, 0);
                }
                LAS unsigned char* stc = L + L_ST + (c & 1) * (32 * SP * 2);
#pragma unroll
                for (int ks = 0; ks < 8; ++ks) {
                    const bf16x8 af = lds_frag(L + L_CS, 32 * w + r, 16 * ks + 8 * hh), bfg = lds_frag(stc, r, 16 * ks + 8 * hh);
                    yo = __builtin_amdgcn_mfma_f32_32x32x16_bf16(af, bfg, yo, 0, 0, 0);
                }
#pragma unroll
                for (int q = 0; q < 4; ++q) {
                    const int t0 = 32 * w + 8 * q + 4 * hh;
                    const u32x2 xx = *(const LAS u32x2*)(L + L_XT + (r * SP + t0) * 2);
                    const float xv[4] = {bflo(xx.x), bfhi(xx.x), bflo(xx.y), bfhi(xx.y)};
#pragma unroll
                    for (int e = 0; e < 4; ++e) { const int t = t0 + e, i = 4 * q + e;
                        bf16* zp = U + (rowbase + t) * LDE + EZ + h * 64 + ph * 32 + r;
                        const float z = bf2f(*zp);
                        const float y = yd[i] + __expf(acum[t]) * yo[i] + dsk * xv[e];
                        *zp = (bf16)f2bf(y * siluf(z)); }
                }
            } else {
                const int n0 = 32 * (w - 4); const float dec = __expf(acum[127]);
#pragma unroll
                for (int i = 0; i < 16; ++i) state[i] *= dec;
#pragma unroll
                for (int ks = 0; ks < 8; ++ks) {
                    const bf16x8 af = lds_frag(L + L_XS, r, 16 * ks + 8 * hh), bfg = lds_frag(L + L_BT, n0 + r, 16 * ks + 8 * hh);
                    state = __builtin_amdgcn_mfma_f32_32x32x16_bf16(af, bfg, state, 0, 0, 0);
                }
                LAS unsigned char* stn = L + L_ST + ((c + 1) & 1) * (32 * SP * 2);
#pragma unroll
                for (int i = 0; i < 16; ++i) { const int p = 8 * (i >> 2) + 4 * hh + (i & 3);
                    *(LAS bf16*)(stn + (p * SP + n0 + r) * 2) = (bf16)f2bf(state[i]); }
            }
            __syncthreads();
        }
    }
}

typedef short s16x4 __attribute__((ext_vector_type(4)));
__device__ __forceinline__ s16x4 lds_tr16(LAS unsigned char* p) { return __builtin_bit_cast(s16x4, __builtin_amdgcn_ds_read_tr16_b64_v4i16((LAS s16x4*)p)); }
__device__ __forceinline__ int t5_bucket_dev(int d) {
    if (d < 16) return d;
    const int v = 16 + (int)(log((double)d / 16.0) / log(8.0) * 16.0);
    return v < 31 ? v : 31;
}
constexpr int D_SEL = 131072, D_LUT = 135168, VP = 72;
__device__ __forceinline__ int okey(float f) { const int iv = __builtin_bit_cast(int, f); return iv ^ ((iv >> 31) & 0x7fffffff); }

__device__ __forceinline__ void p_dsa(Frame& F, const Args& A) {
    bf16* U = (bf16*)(F.ws + WS_U); bf16* HB = (bf16*)(F.ws + WS_HB);
    const int w = F.wave;
    const float* ng = A.in[10];
    LAS unsigned char* L = F.lds;
    LAS float* LUT = (LAS float*)(L + D_LUT);
    for (int i = F.tid; i < 1024; i += NTHR) LUT[i] = A.in[1][t5_bucket_dev(i >> 3) * 8 + (i & 7)];
    __syncthreads();
    for (int blk = F.bid; blk < MTOK / 8; blk += F.G) {
        int lane = F.lane; asm volatile("" : "+v"(lane));
        const int kr = blk >> 8, cc = blk & 255, b = kr >> 1, tb = (kr & 1) ? 511 - cc : cc, t0 = tb * 8;
        const size_t bat = (size_t)b * SEQ, rowb = bat + t0;
        {
            const size_t row = rowb + w;
            const u32x4 v = *(const u32x4*)(U + row * LDE + EZ + 8 * lane);
            float f[8] = {bflo(v.x), bfhi(v.x), bflo(v.y), bfhi(v.y), bflo(v.z), bfhi(v.z), bflo(v.w), bfhi(v.w)};
            float s = 0.f;
#pragma unroll
            for (int j = 0; j < 8; ++j) s += f[j] * f[j];
#pragma unroll
            for (int o = 1; o < 32; o <<= 1) s += __shfl_xor(s, o);
            const float rs = 1.f / sqrtf(s * (1.f / 256.f) + NORM_EPS); const float* g = ng + 8 * lane;
            u32x4 o; o.x = pk2(f[0] * rs * g[0], f[1] * rs * g[1]); o.y = pk2(f[2] * rs * g[2], f[3] * rs * g[3]); o.z = pk2(f[4] * rs * g[4], f[5] * rs * g[5]); o.w = pk2(f[6] * rs * g[6], f[7] * rs * g[7]);
            *(u32x4*)(HB + row * DM + 8 * lane) = o;
        }
        {
            const int r = lane & 31, hh = lane >> 5;
            bf16x8 qa[4];
#pragma unroll
            for (int ks = 0; ks < 4; ++ks) qa[ks] = *(const bf16x8*)(U + (rowb + (r >> 2)) * LDE + EIQ + (r & 3) * 64 + 16 * ks + 8 * hh);
            float wv[4][4];
#pragma unroll
            for (int q = 0; q < 4; ++q) { const u32x2 ww = *(const u32x2*)(U + (rowb + 2 * q + hh) * LDE + EIW); wv[q][0] = bflo(ww.x); wv[q][1] = bfhi(ww.x); wv[q][2] = bflo(ww.y); wv[q][3] = bfhi(ww.y); }
            const int ntile = (t0 + 8 + 31) >> 5;
            for (int tile = w; tile < ntile; tile += NWAVES) {
                const int key = 32 * tile + r;
                bf16x8 kf[4];
#pragma unroll
                for (int ks = 0; ks < 4; ++ks) kf[ks] = *(const bf16x8*)(U + (bat + key) * LDE + EIK + 16 * ks + 8 * hh);
                f32x16 acc = {0.f, 0.f, 0.f, 0.f, 0.f, 0.f, 0.f, 0.f, 0.f, 0.f, 0.f, 0.f, 0.f, 0.f, 0.f, 0.f};
#pragma unroll
                for (int ks = 0; ks < 4; ++ks) acc = __builtin_amdgcn_mfma_f32_32x32x16_bf16(qa[ks], kf[ks], acc, 0, 0, 0);
#pragma unroll
                for (int q = 0; q < 4; ++q) {
                    const float sc = wv[q][0] * fmaxf(acc[4 * q], 0.f) + wv[q][1] * fmaxf(acc[4 * q + 1], 0.f) + wv[q][2] * fmaxf(acc[4 * q + 2], 0.f) + wv[q][3] * fmaxf(acc[4 * q + 3], 0.f);
                    *(LAS float*)(L + ((2 * q + hh) * 4096 + key) * 4) = sc;
                }
            }
        }
        __syncthreads();
        const int t = t0 + w, n = t + 1;
        LAS unsigned short* sel = (LAS unsigned short*)(L + D_SEL) + w * 256;
        const int cnt = n < 256 ? n : 256;
        if (n <= 256) {
#pragma unroll
            for (int i = 0; i < 4; ++i) { const int s = lane + 64 * i; sel[s] = (unsigned short)(s < n ? s : 0); }
        } else {
            const int nj = (t0 + 8 + 63) >> 6;
            const LAS float* myrow = (const LAS float*)(L + w * 16384);
            int v[64]; int vmax = (int)0x80000000;
#pragma unroll
            for (int j = 0; j < 64; ++j) { v[j] = (int)0x80000000;
                if (j < nj) { const int idx = lane + 64 * j; const int kv = okey(myrow[idx]); v[j] = idx <= t ? kv : (int)0x80000000; vmax = v[j] > vmax ? v[j] : vmax; } }
#pragma unroll
            for (int o = 1; o < 64; o <<= 1) { const int x = __shfl_xor(vmax, o); vmax = x > vmax ? x : vmax; }
            vmax = __builtin_amdgcn_readfirstlane(vmax);
            int lo = (int)0x80000001, hi = vmax;
            while (lo < hi) {
                const int mid = lo + (int)(((long long)hi - (long long)lo + 1) >> 1);
                int c = 0;
#pragma unroll
                for (int j = 0; j < 64; ++j) if (j < nj) c += (v[j] >= mid) ? 1 : 0;
#pragma unroll
                for (int o = 1; o < 64; o <<= 1) c += __shfl_xor(c, o);
                c = __builtin_amdgcn_readfirstlane(c);
                if (c == 256) { lo = mid; break; }
                if (c > 256) lo = mid; else hi = mid - 1;
            }
            const int T = lo;
            int cgt = 0;
#pragma unroll
            for (int j = 0; j < 64; ++j) if (j < nj) cgt += (v[j] > T) ? 1 : 0;
#pragma unroll
            for (int o = 1; o < 64; o <<= 1) cgt += __shfl_xor(cgt, o);
            const int need_eq = 256 - cgt;
            int obase = 0, ebase = 0;
#pragma unroll
            for (int j = 0; j < 64; ++j) if (j < nj) {
                const bool gt = v[j] > T, eq = v[j] == T;
                const unsigned long long be = __ballot(eq);
                const int erank = ebase + (int)__builtin_amdgcn_mbcnt_hi((unsigned)(be >> 32), __builtin_amdgcn_mbcnt_lo((unsigned)be, 0u));
                const bool take = gt || (eq && erank < need_eq);
                const unsigned long long bt = __ballot(take);
                const int pos = obase + (int)__builtin_amdgcn_mbcnt_hi((unsigned)(bt >> 32), __builtin_amdgcn_mbcnt_lo((unsigned)bt, 0u));
                if (take && pos < 256) sel[pos] = (unsigned short)(lane + 64 * j);
                obase += __popcll(bt); ebase += __popcll(be);
            }
        }
        __syncthreads();
        {
            const int hd = lane & 15, g4 = lane >> 4;
            const size_t row = rowb + w;
            bf16x8 qb[2];
            {
                float qf[2][8]; float ss = 0.f;
#pragma unroll
                for (int ks = 0; ks < 2; ++ks) { u32x4 qq = (u32x4){0u, 0u, 0u, 0u};
                    if (hd < 8) qq = *(const u32x4*)(U + row * LDE + EQ + hd * 64 + 32 * ks + 8 * g4);
                    qf[ks][0] = bflo(qq.x); qf[ks][1] = bfhi(qq.x); qf[ks][2] = bflo(qq.y); qf[ks][3] = bfhi(qq.y); qf[ks][4] = bflo(qq.z); qf[ks][5] = bfhi(qq.z); qf[ks][6] = bflo(qq.w); qf[ks][7] = bfhi(qq.w);
#pragma unroll
                    for (int j = 0; j < 8; ++j) ss += qf[ks][j] * qf[ks][j]; }
                ss += __shfl_xor(ss, 16); ss += __shfl_xor(ss, 32);
                const float rs = 0.125f / sqrtf(ss * (1.f / 64.f) + NORM_EPS);
#pragma unroll
                for (int ks = 0; ks < 2; ++ks) { const float* gq = A.in[11] + 32 * ks + 8 * g4;
                    u32x4 pk; pk.x = pk2(qf[ks][0] * rs * gq[0], qf[ks][1] * rs * gq[1]); pk.y = pk2(qf[ks][2] * rs * gq[2], qf[ks][3] * rs * gq[3]);
                    pk.z = pk2(qf[ks][4] * rs * gq[4], qf[ks][5] * rs * gq[5]); pk.w = pk2(qf[ks][6] * rs * gq[6], qf[ks][7] * rs * gq[7]);
                    qb[ks] = __builtin_bit_cast(bf16x8, pk); }
            }
            float lg[16][4]; float mx = -3.0e38f;
#pragma unroll
            for (int T = 0; T < 16; ++T) {
                const int sm = sel[16 * T + hd];
                const bf16* kp = U + (bat + sm) * LDE + EK + 8 * g4;
                const bf16x8 ka0 = *(const bf16x8*)kp, ka1 = *(const bf16x8*)(kp + 32);
                f32x4 acc = {0.f, 0.f, 0.f, 0.f};
                acc = __builtin_amdgcn_mfma_f32_16x16x32_bf16(ka0, qb[0], acc, 0, 0, 0);
                acc = __builtin_amdgcn_mfma_f32_16x16x32_bf16(ka1, qb[1], acc, 0, 0, 0);
                const u32x2 sl = *(const LAS u32x2*)(sel + 16 * T + 4 * g4);
                const int s4[4] = {(int)(sl.x & 0xffffu), (int)(sl.x >> 16), (int)(sl.y & 0xffffu), (int)(sl.y >> 16)};
#pragma unroll
                for (int i = 0; i < 4; ++i) { int dist = t - s4[i]; dist = dist < 0 ? 0 : (dist > 127 ? 127 : dist);
                    const bool valid = (16 * T + 4 * g4 + i) < cnt;
                    lg[T][i] = valid ? acc[i] + LUT[dist * 8 + (hd & 7)] : -3.0e38f; mx = fmaxf(mx, lg[T][i]); }
            }
            mx = fmaxf(mx, __shfl_xor(mx, 16)); mx = fmaxf(mx, __shfl_xor(mx, 32));
            float sum = 0.f;
#pragma unroll
            for (int T = 0; T < 16; ++T)
#pragma unroll
                for (int i = 0; i < 4; ++i) { const float p = lg[T][i] > -1.0e38f ? __expf(lg[T][i] - mx) : 0.f; lg[T][i] = p; sum += p; }
            sum += __shfl_xor(sum, 16); sum += __shfl_xor(sum, 32);
            const float inv = 1.f / fmaxf(sum, 1e-30f);
            f32x4 oacc[4];
#pragma unroll
            for (int dt = 0; dt < 4; ++dt) oacc[dt] = (f32x4){0.f, 0.f, 0.f, 0.f};
            LAS unsigned char* Vl = L + w * 16384;
#pragma unroll
            for (int ch = 0; ch < 4; ++ch) {
                LDS_WAIT();
#pragma unroll
                for (int e = 0; e < 8; ++e) { const int q = lane + 64 * e, sl = q >> 3, part = q & 7;
                    const int sm = sel[64 * ch + sl];
                    const u32x4 vv = *(const u32x4*)(U + (bat + sm) * LDE + EV + 8 * part);
                    *(LAS u32x4*)(Vl + (sl * VP + 8 * part) * 2) = vv; }
                LDS_WAIT();
#pragma unroll
                for (int kk = 0; kk < 2; ++kk) {
                    const int T0 = 2 * (2 * ch + kk);
                    u32x4 pp; pp.x = pk2(lg[T0][0] * inv, lg[T0][1] * inv); pp.y = pk2(lg[T0][2] * inv, lg[T0][3] * inv); pp.z = pk2(lg[T0 + 1][0] * inv, lg[T0 + 1][1] * inv); pp.w = pk2(lg[T0 + 1][2] * inv, lg[T0 + 1][3] * inv);
                    const bf16x8 pf = __builtin_bit_cast(bf16x8, pp);
                    const int qq = (lane & 15) >> 2, p4 = lane & 3;
#pragma unroll
                    for (int dt = 0; dt < 4; ++dt) {
                        const s16x4 b0 = lds_tr16(Vl + ((32 * kk + 4 * g4 + qq) * VP + 16 * dt + 4 * p4) * 2);
                        const s16x4 b1 = lds_tr16(Vl + ((32 * kk + 16 + 4 * g4 + qq) * VP + 16 * dt + 4 * p4) * 2);
                        bf16x8 bfg; bfg[0] = b0[0]; bfg[1] = b0[1]; bfg[2] = b0[2]; bfg[3] = b0[3]; bfg[4] = b1[0]; bfg[5] = b1[1]; bfg[6] = b1[2]; bfg[7] = b1[3];
                        oacc[dt] = __builtin_amdgcn_mfma_f32_16x16x32_bf16(pf, bfg, oacc[dt], 0, 0, 0);
                    }
                }
            }
            if (g4 < 2) {
#pragma unroll
                for (int i = 0; i < 4; ++i)
#pragma unroll
                    for (int dt = 0; dt < 4; ++dt) HB[row * DM + 512 + (4 * g4 + i) * 64 + 16 * dt + hd] = (bf16)f2bf(oacc[dt][i]);
            }
        }
        __syncthreads();
    }
}

template <int MODE> __device__ __forceinline__ void p_norm_route(Frame& F, const float* xin, const float* gain, int layer) {
    constexpr int NT = MODE == 0 ? 3 : 2;
    bf16* HB = (bf16*)(F.ws + WS_HB); const bf16* WR = MODE == 0 ? (const bf16*)(F.ws + WS_WR) + (size_t)layer * 48 * 1024 : (const bf16*)(F.ws + WS_WGL);
    float* GL = (float*)(F.ws + WS_GL);
    int* list = (int*)(F.ws + WS_LIST); float* wl = (float*)(F.ws + WS_LISTW);
    LAS unsigned char* L = F.lds;
    LAS float* lgt = (LAS float*)L + F.wave * (16 * 48);
    LAS int* cntl = (LAS int*)(L + 32768); LAS int* basel = (LAS int*)(L + 33024);
    LAS int* ri_e = (LAS int*)(L + 34816); LAS int* ri_p = (LAS int*)(L + 36864); LAS float* ri_w = (LAS float*)(L + 38912);
    const int w = F.wave;
    for (int base = F.bid * 256; base < MTOK; base += F.G * 256) {
        int lane = F.lane; asm volatile("" : "+v"(lane));
        if (F.tid < 64) cntl[F.tid] = 0;
        __syncthreads();
#pragma unroll 1
        for (int half = 0; half < 2; ++half) {
            const int R0 = base + w * 32 + half * 16;
#pragma unroll 1
            for (int i = 0; i < 16; ++i) rms_row_to_bf16(xin + (size_t)(R0 + i) * DM, gain, HB + (size_t)(R0 + i) * DM, lane);
            VM_WAIT();
            const int n16 = lane & 15, g4 = lane >> 4;
            f32x4 acc[NT];
#pragma unroll
            for (int nt = 0; nt < NT; ++nt) acc[nt] = (f32x4){0.f, 0.f, 0.f, 0.f};
#pragma unroll 4
            for (int kk = 0; kk < 32; ++kk) {
                const bf16x8 a = *(const bf16x8*)(HB + (size_t)(R0 + n16) * DM + 32 * kk + 8 * g4);
#pragma unroll
                for (int nt = 0; nt < NT; ++nt) { const bf16x8 bb = *(const bf16x8*)(WR + (size_t)(16 * nt + n16) * DM + 32 * kk + 8 * g4);
                    acc[nt] = __builtin_amdgcn_mfma_f32_16x16x32_bf16(a, bb, acc[nt], 0, 0, 0); }
            }
            if constexpr (MODE == 1) {
#pragma unroll
                for (int nt = 0; nt < NT; ++nt)
#pragma unroll
                    for (int i = 0; i < 4; ++i) if (16 * nt + n16 < 24) GL[(size_t)(R0 + 4 * g4 + i) * 24 + 16 * nt + n16] = acc[nt][i];
            } else {
#pragma unroll
            for (int nt = 0; nt < NT; ++nt)
#pragma unroll
                for (int i = 0; i < 4; ++i) lgt[(4 * g4 + i) * 48 + 16 * nt + n16] = acc[nt][i];
            LDS_WAIT();
            if (lane < 16) {
                const LAS float* lr = lgt + lane * 48;
                int gs = 0; float gm = lr[0];
#pragma unroll
                for (int j = 1; j < 4; ++j) if (lr[j] > gm) { gm = lr[j]; gs = j; }
                float gsum = 0.f;
#pragma unroll
                for (int j = 0; j < 4; ++j) gsum += __expf(lr[j] - gm);
                const float gw = 1.f / gsum;
                const LAS float* er = lr + 4 + 8 * gs;
                int i0 = 0; float m0 = er[0];
#pragma unroll
                for (int j = 1; j < 8; ++j) if (er[j] > m0) { m0 = er[j]; i0 = j; }
                int i1 = -1; float m1 = -3.0e38f;
#pragma unroll
                for (int j = 0; j < 8; ++j) if (j != i0 && er[j] > m1) { m1 = er[j]; i1 = j; }
                const float w0 = 1.f / (1.f + __expf(m1 - m0));
                const int e0 = gs * 8 + i0, e1 = 32 + gs * 8 + i1;
                const int rs = (w * 32 + half * 16 + lane) * 2;
                ri_e[rs] = e0; ri_p[rs] = __hip_atomic_fetch_add(cntl + e0, 1, __ATOMIC_RELAXED, __HIP_MEMORY_SCOPE_WORKGROUP); ri_w[rs] = w0 * gw;
                ri_e[rs + 1] = e1; ri_p[rs + 1] = __hip_atomic_fetch_add(cntl + e1, 1, __ATOMIC_RELAXED, __HIP_MEMORY_SCOPE_WORKGROUP); ri_w[rs + 1] = (1.f - w0) * gw;
            }
            LDS_WAIT();
            }
        }
        if constexpr (MODE == 1) continue;
        __syncthreads();
        if (F.tid < 64) { const int c = cntl[F.tid]; basel[F.tid] = c ? (int)__hip_atomic_fetch_add((unsigned*)(F.ctl + CW_CNT + layer * 4096 + 64 * F.tid), (unsigned)c, RLX_AGENT) : 0; }
        __syncthreads();
        { const int rs = F.tid, e = ri_e[rs], pos = basel[e] + ri_p[rs];
          list[(size_t)e * 65536 + pos] = base + (rs >> 1); wl[(size_t)e * 65536 + pos] = ri_w[rs]; }
        __syncthreads();
    }
}
__device__ __forceinline__ void moe_tables(Frame& F, int layer) {
    LAS int* ptile = (LAS int*)(F.lds + MOE_OFF); LAS int* cntv = ptile + 128;
    __syncthreads();
    if (F.tid < 64) {
        const int c = (int)__hip_atomic_load((unsigned*)(F.ctl + CW_CNT + layer * 4096 + 64 * F.tid), RLX_AGENT);
        cntv[F.tid] = c;
        int nt = (c + 255) >> 8, incl = nt;
#pragma unroll
        for (int o = 1; o < 64; o <<= 1) { const int t = __shfl_up(incl, o); if (F.lane >= o) incl += t; }
        ptile[F.tid] = incl - nt; if (F.tid == 63) ptile[64] = incl;
    }
    __syncthreads();
}
__device__ __forceinline__ void p_moe_gu(Frame& F, int layer) {
    moe_tables(F, layer);
    const LAS int* ptile = (const LAS int*)(F.lds + MOE_OFF); const LAS int* cntv = ptile + 128;
    pg8::MoeOrder S{(const char*)(F.ws + WS_HB), (const char*)(F.ws + WS_WGU) + (size_t)layer * 32 * 1024 * 1024 * 2, (size_t)1024 * 1024 * 2, 1024, F.G, F.bid, 0, ptile[64], ptile, cntv, (const int*)(F.ws + WS_LIST), true};
    pg8::EpiSwiGLU E{(bf16*)(F.ws + WS_U)};
    pg8::gemm_phase<pg8::EpiSwiGLU, pg8::MoeOrder, true>(F.lds, 1024, S, E);
}
__device__ __forceinline__ void p_moe_down(Frame& F, int layer, int slot) {
    moe_tables(F, layer);
    const LAS int* ptile = (const LAS int*)(F.lds + MOE_OFF); const LAS int* cntv = ptile + 128;
    pg8::MoeOrder S{(const char*)(F.ws + WS_U), (const char*)(F.ws + WS_WD) + (size_t)layer * 32 * 1024 * 512 * 2, (size_t)1024 * 512 * 2, 512, F.G, F.bid, ptile[32 * slot], ptile[32 * slot + 32], ptile, cntv, (const int*)(F.ws + WS_LIST), false};
    pg8::EpiScatter E{F.out, (const int*)(F.ws + WS_LIST), (const float*)(F.ws + WS_LISTW), cntv};
    pg8::gemm_phase<pg8::EpiScatter, pg8::MoeOrder, true>(F.lds, 512, S, E);
}

__device__ __forceinline__ void p_compress(Frame& F, const Args& A) {
    bf16* U = (bf16*)(F.ws + WS_U);
    LAS unsigned char* L = F.lds;
    const int w = F.wave;
    {
        const int tid = F.tid, sub = tid & 15;
        for (int v0 = F.bid * 32; v0 < MTOK * 4; v0 += F.G * 32) {
            const int vec = v0 + (tid >> 4), row = vec >> 2, wh = vec & 3;
            bf16* p = U + (size_t)row * LDO + ((wh >> 1) ? OKW : OKS) + (wh & 1) * 128 + 8 * sub;
            const float* g = ((wh >> 1) ? A.in[18] : A.in[17]) + 8 * sub;
            const u32x4 v = *(const u32x4*)p; float f[8] = {bflo(v.x), bfhi(v.x), bflo(v.y), bfhi(v.y), bflo(v.z), bfhi(v.z), bflo(v.w), bfhi(v.w)};
            float s = 0.f;
#pragma unroll
            for (int j = 0; j < 8; ++j) s += f[j] * f[j];
            s += __shfl_xor(s, 1); s += __shfl_xor(s, 2); s += __shfl_xor(s, 4); s += __shfl_xor(s, 8);
            const float rs = 1.f / sqrtf(s * (1.f / 128.f) + NORM_EPS);
            u32x4 o; o.x = pk2(f[0] * rs * g[0], f[1] * rs * g[1]); o.y = pk2(f[2] * rs * g[2], f[3] * rs * g[3]); o.z = pk2(f[4] * rs * g[4], f[5] * rs * g[5]); o.w = pk2(f[6] * rs * g[6], f[7] * rs * g[7]);
            *(u32x4*)p = o;
        }
    }
    constexpr int C_A = 0, C_B = 17408, C_H = 52224, C_S = 69632;
    for (int unit = F.bid; unit < 256; unit += F.G) {
        int tid = F.tid, lane = F.lane; asm volatile("" : "+v"(tid), "+v"(lane));
        const int T = unit >> 7, b = (unit >> 3) & 15, g = (unit >> 2) & 1, cb = unit & 3;
        const int col = (T ? OVC : OKC) + g * 128;
        const float* pos = T ? A.in[20] : A.in[19];
        const bf16* w1t = (const bf16*)(F.ws + (T ? WS_W1V : WS_W1K)); const bf16* w2t = (const bf16*)(F.ws + WS_W2) + T * 128 * 128;
        const int wm = w >> 2, wn = w & 3, r = lane & 31, hh = lane >> 5;
        f32x16 acc = {0.f, 0.f, 0.f, 0.f, 0.f, 0.f, 0.f, 0.f, 0.f, 0.f, 0.f, 0.f, 0.f, 0.f, 0.f, 0.f};
#pragma unroll 1
        for (int l = 0; l < 32; ++l) {
            __syncthreads();
#pragma unroll
            for (int e = 0; e < 2; ++e) { const int q = tid + 512 * e, c = q >> 4, part = q & 15; const int tok = 16 * (64 * cb + c) + l;
                u32x4 v = (u32x4){0u, 0u, 0u, 0u};
                if (tok < SEQ) v = *(const u32x4*)(U + ((size_t)b * SEQ + tok) * LDO + col + 8 * part);
                const f32x4 p0 = *(const f32x4*)(pos + l * 128 + 8 * part), p1 = *(const f32x4*)(pos + l * 128 + 8 * part + 4);
                u32x4 o; o.x = pk2(bflo(v.x) + p0.x, bfhi(v.x) + p0.y); o.y = pk2(bflo(v.y) + p0.z, bfhi(v.y) + p0.w); o.z = pk2(bflo(v.z) + p1.x, bfhi(v.z) + p1.y); o.w = pk2(bflo(v.w) + p1.z, bfhi(v.w) + p1.w);
                *(LAS u32x4*)(L + C_A + (c * SP + 8 * part) * 2) = o; }
#pragma unroll
            for (int e = 0; e < 4; ++e) { const int q = tid + 512 * e, j = q >> 4, part = q & 15;
                *(LAS u32x4*)(L + C_B + (j * SP + 8 * part) * 2) = *(const u32x4*)(w1t + (size_t)j * 4096 + l * 128 + 8 * part); }
            __syncthreads();
#pragma unroll
            for (int ks = 0; ks < 8; ++ks) {
                const bf16x8 af = lds_frag(L + C_A, 32 * wm + r, 16 * ks + 8 * hh), bfg = lds_frag(L + C_B, 32 * wn + r, 16 * ks + 8 * hh);
                acc = __builtin_amdgcn_mfma_f32_32x32x16_bf16(af, bfg, acc, 0, 0, 0);
            }
        }
#pragma unroll
        for (int i = 0; i < 16; ++i) { const int c = 32 * wm + 8 * (i >> 2) + 4 * hh + (i & 3);
            *(LAS bf16*)(L + C_H + (c * SP + 32 * wn + r) * 2) = (bf16)f2bf(siluf(acc[i])); }
        __syncthreads();
        f32x16 a2 = {0.f, 0.f, 0.f, 0.f, 0.f, 0.f, 0.f, 0.f, 0.f, 0.f, 0.f, 0.f, 0.f, 0.f, 0.f, 0.f};
#pragma unroll
        for (int ks = 0; ks < 8; ++ks) {
            const bf16x8 af = lds_frag(L + C_H, 32 * wm + r, 16 * ks + 8 * hh), bfg = *(const bf16x8*)(w2t + (size_t)(32 * wn + r) * 128 + 16 * ks + 8 * hh);
            a2 = __builtin_amdgcn_mfma_f32_32x32x16_bf16(af, bfg, a2, 0, 0, 0);
        }
        float rsv[16];
        if (T == 0) {
            LAS float* st = (LAS float*)(L + C_S);
#pragma unroll
            for (int i = 0; i < 16; ++i) { float q = a2[i] * a2[i];
                q += __shfl_xor(q, 1); q += __shfl_xor(q, 2); q += __shfl_xor(q, 4); q += __shfl_xor(q, 8); q += __shfl_xor(q, 16);
                if (r == 0) st[(32 * wm + 8 * (i >> 2) + 4 * hh + (i & 3)) * 4 + wn] = q; }
            __syncthreads();
#pragma unroll
            for (int i = 0; i < 16; ++i) { const f32x4 q = *(const LAS f32x4*)(st + (32 * wm + 8 * (i >> 2) + 4 * hh + (i & 3)) * 4);
                rsv[i] = A.in[16][32 * wn + r] / sqrtf((q.x + q.y + q.z + q.w) * (1.f / 128.f) + NORM_EPS); }
        } else {
#pragma unroll
            for (int i = 0; i < 16; ++i) rsv[i] = 1.f;
        }
        bf16* dst = (bf16*)(F.ws + (T ? WS_VCMP : WS_KCMP));
#pragma unroll
        for (int i = 0; i < 16; ++i) { const int c = 64 * cb + 32 * wm + 8 * (i >> 2) + 4 * hh + (i & 3);
            dst[(((size_t)b * 256 + c) * 2 + g) * 128 + 32 * wn + r] = (bf16)f2bf(a2[i] * rsv[i]); }
    }
}

constexpr int N_K = 0, N_V = 17408, N_LUT = 37888, N_PCS = 41984, N_FAC = 107520, N_MSK = 108544, N_UNI = 109056, N_CST = 109120;
constexpr int VPN = 160;
enum { BR_CMP = 0, BR_SEL = 1, BR_WIN = 2 };
struct NsaCtx {
    LAS unsigned char* L; const bf16* U; const bf16* KC; const bf16* VC;
    int tid, lane, w, r, hh, b, g, qblk, t0, t, head; size_t bat;
    float mrow; unsigned mlo, mhi;
};
template <int BR, bool SUM, bool PV, bool IMP>
__device__ __forceinline__ void nsa_pass(const NsaCtx& X, const bf16x8 (&qf)[8], f32x16 (&oacc)[4], float& lsum, const float colfac, const int tlo, const int thi, const unsigned long long tmask) {
    LAS unsigned char* L = X.L; const int tid = X.tid, r = X.r, hh = X.hh;
    const LAS float* LUT = (const LAS float*)(L + N_LUT);
    const int rr0 = tid >> 4, part = tid & 15;
    int tile = tlo; while (tile <= thi && !((tmask >> tile) & 1ull)) ++tile;
    u32x4 kreg[2], vreg[2];
    auto issue = [&](int tl) {
#pragma unroll
        for (int e = 0; e < 2; ++e) { const int rr = rr0 + 32 * e;
            const bf16* kp; const bf16* vp;
            if (BR == BR_CMP) { const size_t o = (((size_t)X.b * 256 + 64 * tl + rr) * 2 + X.g) * 128 + 8 * part; kp = X.KC + o; vp = X.VC + o; }
            else { const size_t o = (X.bat + 64 * tl + rr) * LDO + X.g * 128 + 8 * part; kp = X.U + o + (BR == BR_SEL ? OKS : OKW); vp = X.U + o + (BR == BR_SEL ? OVS : OVW); }
            kreg[e] = *(const u32x4*)kp; if (PV) vreg[e] = *(const u32x4*)vp; }
    };
    if (tile <= thi) issue(tile);
    while (tile <= thi) {
        __syncthreads();
#pragma unroll
        for (int e = 0; e < 2; ++e) { const int rr = rr0 + 32 * e;
            *(LAS u32x4*)(L + N_K + (rr * SP + 8 * part) * 2) = kreg[e]; if (PV) *(LAS u32x4*)(L + N_V + (rr * VPN + 8 * part) * 2) = vreg[e]; }
        int nxt = tile + 1; while (nxt <= thi && !((tmask >> nxt) & 1ull)) ++nxt;
        if (nxt <= thi) issue(nxt);
        __syncthreads();
        f32x16 sacc[2];
#pragma unroll
        for (int mt = 0; mt < 2; ++mt) { sacc[mt] = (f32x16){0.f, 0.f, 0.f, 0.f, 0.f, 0.f, 0.f, 0.f, 0.f, 0.f, 0.f, 0.f, 0.f, 0.f, 0.f, 0.f};
#pragma unroll
            for (int ks = 0; ks < 8; ++ks) sacc[mt] = __builtin_amdgcn_mfma_f32_32x32x16_bf16(lds_frag(L + N_K, 32 * mt + r, 16 * ks + 8 * hh), qf[ks], sacc[mt], 0, 0, 0); }
        bool selb = true; if (BR == BR_SEL) selb = (tile < 32 ? (X.mlo >> tile) : (X.mhi >> (tile - 32))) & 1u;
#pragma unroll
        for (int mt = 0; mt < 2; ++mt)
#pragma unroll
            for (int i = 0; i < 16; ++i) { const int kidx = 32 * mt + 8 * (i >> 2) + 4 * hh + (i & 3);
                int dist; bool ok;
                if (BR == BR_CMP) { dist = X.t - (16 * (64 * tile + kidx) + 31); ok = dist >= 0; }
                else { dist = X.t - (64 * tile + kidx); ok = BR == BR_SEL ? (selb && dist >= 0) : (dist >= 0 && dist < 512); }
                const int dc = dist < 0 ? 0 : (dist > 127 ? 127 : dist);
                const float p = ok ? __expf(sacc[mt][i] + LUT[dc * 8 + X.head] - X.mrow) : 0.f;
                if (SUM) lsum += p;
                sacc[mt][i] = p * colfac; }
        if (IMP) {
            LAS float* pcs = (LAS float*)(L + N_PCS) + (X.w * 8 + (r >> 2)) * 256 + 64 * tile;
#pragma unroll
            for (int mt = 0; mt < 2; ++mt)
#pragma unroll
                for (int i = 0; i < 16; ++i) { float v = sacc[mt][i]; v += __shfl_xor(v, 1); v += __shfl_xor(v, 2);
                    if ((r & 3) == 0) pcs[32 * mt + 8 * (i >> 2) + 4 * hh + (i & 3)] = v; }
        }
        if (PV) {
            const int cb16 = (X.lane >> 4) & 1, q4 = (X.lane & 15) >> 2, p4 = X.lane & 3;
#pragma unroll
            for (int mt = 0; mt < 2; ++mt)
#pragma unroll
                for (int sI = 0; sI < 2; ++sI) {
                    u32x4 pp; pp.x = pk2(sacc[mt][8 * sI], sacc[mt][8 * sI + 1]); pp.y = pk2(sacc[mt][8 * sI + 2], sacc[mt][8 * sI + 3]); pp.z = pk2(sacc[mt][8 * sI + 4], sacc[mt][8 * sI + 5]); pp.w = pk2(sacc[mt][8 * sI + 6], sacc[mt][8 * sI + 7]);
                    const bf16x8 pa = __builtin_bit_cast(bf16x8, pp);
                    const int row0 = 32 * mt + 16 * sI + 4 * hh + q4;
#pragma unroll
                    for (int nt = 0; nt < 4; ++nt) {
                        const s16x4 b0 = lds_tr16(L + N_V + (row0 * VPN + 32 * nt + 16 * cb16 + 4 * p4) * 2);
                        const s16x4 b1 = lds_tr16(L + N_V + ((row0 + 8) * VPN + 32 * nt + 16 * cb16 + 4 * p4) * 2);
                        bf16x8 bfg; bfg[0] = b0[0]; bfg[1] = b0[1]; bfg[2] = b0[2]; bfg[3] = b0[3]; bfg[4] = b1[0]; bfg[5] = b1[1]; bfg[6] = b1[2]; bfg[7] = b1[3];
                        oacc[nt] = __builtin_amdgcn_mfma_f32_32x32x16_bf16(pa, bfg, oacc[nt], 0, 0, 0);
                    }
                }
        }
        tile = nxt;
    }
    __syncthreads();
}

__device__ __forceinline__ void p_nsa(Frame& F, const Args& A) {
    const bf16* U = (const bf16*)(F.ws + WS_U); bf16* HB = (bf16*)(F.ws + WS_HB); const float* GL = (const float*)(F.ws + WS_GL);
    LAS unsigned char* L = F.lds;
    LAS float* LUT = (LAS float*)(L + N_LUT); LAS float* cst = (LAS float*)(L + N_CST);
    for (int i = F.tid; i < 1024; i += NTHR) LUT[i] = A.in[1][t5_bucket_dev(i >> 3) * 8 + (i & 7)];
    if (F.wave == 0) {
        float gm = 0.f, bm = 0.f;
        for (int i = F.lane; i < 128; i += 64) gm = fmaxf(gm, fmaxf(fabsf(A.in[16][i]), fmaxf(fabsf(A.in[17][i]), fabsf(A.in[18][i]))));
        for (int i = F.lane; i < 256; i += 64) bm = fmaxf(bm, fabsf(A.in[1][i]));
#pragma unroll
        for (int o = 1; o < 64; o <<= 1) { gm = fmaxf(gm, __shfl_xor(gm, o)); bm = fmaxf(bm, __shfl_xor(bm, o)); }
        if (F.lane == 0) { cst[0] = gm * 11.3137085f; cst[1] = bm; }
    }
    __syncthreads();
    const float kmax = cst[0], bmax = cst[1];
    for (int ui = F.bid; ui < 2048; ui += F.G) {
        NsaCtx X; X.L = L; X.U = U; X.KC = (const bf16*)(F.ws + WS_KCMP); X.VC = (const bf16*)(F.ws + WS_VCMP);
        int tid = F.tid, lane = F.lane; asm volatile("" : "+v"(tid), "+v"(lane));
        X.tid = tid; X.lane = lane; X.w = F.wave; X.r = lane & 31; X.hh = lane >> 5;
        const int kr = ui >> 8, cc = ui & 255, bg = kr * 4 + (cc >> 6);
        X.b = bg >> 1; X.g = bg & 1; X.qblk = (kr & 1) ? 63 - (cc & 63) : (cc & 63); X.t0 = 64 * X.qblk; X.bat = (size_t)X.b * SEQ;
        const int tq = X.r >> 2, hd = X.r & 3; X.t = X.t0 + 8 * X.w + tq; X.head = 4 * X.g + hd;
        const size_t row = X.bat + X.t;
        if (tid == 0) *(LAS unsigned long long*)(L + N_UNI) = 0ull;
        bf16x8 qf[8]; float qn2 = 0.f;
        {
            u32x4 qr[8]; float ss = 0.f;
#pragma unroll
            for (int ks = 0; ks < 8; ++ks) { qr[ks] = *(const u32x4*)(U + row * LDO + OQ + X.head * 128 + 16 * ks + 8 * X.hh);
#pragma unroll
                for (int e = 0; e < 4; ++e) { const float a = bflo(qr[ks][e]), c = bfhi(qr[ks][e]); ss += a * a + c * c; } }
            ss += __shfl_xor(ss, 32);
            const float rs = 1.f / sqrtf(ss * (1.f / 128.f) + NORM_EPS);
#pragma unroll
            for (int ks = 0; ks < 8; ++ks) { const float* gq = A.in[15] + 16 * ks + 8 * X.hh; u32x4 pk;
#pragma unroll
                for (int e = 0; e < 4; ++e) { const float a = bflo(qr[ks][e]) * rs * gq[2 * e], c = bfhi(qr[ks][e]) * rs * gq[2 * e + 1]; qn2 += a * a + c * c; pk[e] = pk2(a * 0.0883883476f, c * 0.0883883476f); }
                qf[ks] = __builtin_bit_cast(bf16x8, pk); }
            qn2 += __shfl_xor(qn2, 32);
        }
        X.mrow = sqrtf(qn2) * 0.0883883476f * kmax + bmax;
        X.mlo = 0u; X.mhi = 0u;
        const float g_c = 1.f / (1.f + __expf(-GL[row * 24 + X.head])), g_s = 1.f / (1.f + __expf(-GL[row * 24 + 8 + X.head])), g_w = 1.f / (1.f + __expf(-GL[row * 24 + 16 + X.head]));
        f32x16 oacc[4];
#pragma unroll
        for (int nt = 0; nt < 4; ++nt) oacc[nt] = (f32x16){0.f, 0.f, 0.f, 0.f, 0.f, 0.f, 0.f, 0.f, 0.f, 0.f, 0.f, 0.f, 0.f, 0.f, 0.f, 0.f};
        const int ntc = ((4 * X.qblk + 2) >> 6) + 1;
        float l_c = 0.f;
        nsa_pass<BR_CMP, true, false, false>(X, qf, oacc, l_c, 1.f, 0, ntc - 1, ~0ull);
        l_c += __shfl_xor(l_c, 32);
        const float il_c = l_c > 0.f ? 1.f / l_c : 0.f;
        { float dummy = 0.f; nsa_pass<BR_CMP, false, false, true>(X, qf, oacc, dummy, il_c, 0, ntc - 1, ~0ull); }
        {
            LDS_WAIT();
            const LAS float* pcs = (const LAS float*)(L + N_PCS) + X.w * 8 * 256;
            const int n = lane, cur = X.qblk;
            unsigned long long wor = 0ull;
#pragma unroll 1
            for (int q = 0; q < 8; ++q) {
                float imp = 0.f;
#pragma unroll
                for (int c = 4 * n - 1; c <= 4 * n + 3; ++c) if (c >= 0 && c < 64 * ntc) imp += pcs[q * 256 + c];
                const bool forced = (n == 0) || (n == cur) || (n == cur - 1);
                float val = forced ? 3.0e38f : imp; if (n > cur) val = -3.0e38f;
                int rank = 0;
#pragma unroll 8
                for (int m = 0; m < 64; ++m) { const float vm = __shfl(val, m); rank += (vm > val || (vm == val && m < n)) ? 1 : 0; }
                const unsigned long long mk = __ballot(n <= cur && rank < 16);
                wor |= mk;
                if ((X.r >> 2) == q) { X.mlo = (unsigned)mk; X.mhi = (unsigned)(mk >> 32); }
            }
            if (lane == 0) __hip_atomic_fetch_or((LAS unsigned long long*)(L + N_UNI), wor, __ATOMIC_RELAXED, __HIP_MEMORY_SCOPE_WORKGROUP);
        }
        __syncthreads();
        const unsigned long long uni = *(const LAS unsigned long long*)(L + N_UNI);
        float l_s = 0.f;
        nsa_pass<BR_SEL, true, true, false>(X, qf, oacc, l_s, 1.f, 0, X.qblk, uni);
        l_s += __shfl_xor(l_s, 32);
        {
            LAS float* fac = (LAS float*)(L + N_FAC) + X.w * 32;
            if (lane < 32) fac[lane] = l_s > 0.f ? g_s / l_s : 0.f;
            LDS_WAIT();
#pragma unroll
            for (int q = 0; q < 4; ++q) { const f32x4 fr = *(const LAS f32x4*)(fac + 8 * q + 4 * X.hh);
#pragma unroll
                for (int nt = 0; nt < 4; ++nt) { oacc[nt][4 * q] *= fr.x; oacc[nt][4 * q + 1] *= fr.y; oacc[nt][4 * q + 2] *= fr.z; oacc[nt][4 * q + 3] *= fr.w; } }
        }
        { float dummy = 0.f; nsa_pass<BR_CMP, false, true, false>(X, qf, oacc, dummy, g_c * il_c, 0, ntc - 1, ~0ull); }
        const int wlo = X.qblk >= 8 ? X.qblk - 8 : 0;
        float l_w = 0.f;
        nsa_pass<BR_WIN, true, false, false>(X, qf, oacc, l_w, 1.f, wlo, X.qblk, ~0ull);
        l_w += __shfl_xor(l_w, 32);
        { float dummy = 0.f; nsa_pass<BR_WIN, false, true, false>(X, qf, oacc, dummy, l_w > 0.f ? g_w / l_w : 0.f, wlo, X.qblk, ~0ull); }
#pragma unroll
        for (int i = 0; i < 16; ++i) { const int c32 = 8 * (i >> 2) + 4 * X.hh + (i & 3);
            bf16* op = HB + (X.bat + X.t0 + 8 * X.w + (c32 >> 2)) * DM + (4 * X.g + (c32 & 3)) * 128 + X.r;
#pragma unroll
            for (int nt = 0; nt < 4; ++nt) op[32 * nt] = (bf16)f2bf(oacc[nt][i]); }
    }
}

constexpr int N_PHASES = 18;
__global__ void __launch_bounds__(NTHR, 2) mk_fwd(Args args) {
    extern __shared__ __attribute__((aligned(16))) unsigned char lds[];
    Frame F;
    F.lds = (LAS unsigned char*)lds;
    F.MISC = (volatile LAS unsigned*)(F.lds + MISC_OFF);
    F.tid = threadIdx.x; F.lane = F.tid & 63; F.wave = __builtin_amdgcn_readfirstlane(F.tid >> 6);
    F.G = gridDim.x; F.bid = blockIdx.x;
    F.ws = args.ws; F.out = args.out; F.ctl = (gu32*)(args.ws + WS_CTL);
    if (F.tid < 64) F.MISC[F.tid] = 0u;
    __syncthreads();
    const int lo = args.ph_lo, hi = args.ph_hi;
    XcdBarrier bar; bar.bar = (unsigned*)(F.ctl + CW_BAR); bar.x = 0; bar.st = nullptr;
    if (hi - lo > 1) bar = xcd_barrier_post((unsigned*)(F.ctl + CW_BAR), F.MISC + 8);
#ifndef PHMASK
#define PHMASK 0xffffffffu
#endif
#define IN(k) (((PHMASK >> (k)) & 1u) && lo <= (k) && (k) < hi)
#define SEAM(k) do { if (IN(k) && IN((k) + 1)) xcd_barrier(bar); } while (0)
    if (IN(0)) { p_prologue(F, args); } SEAM(0);
    if (IN(1)) {
        pg8::StaticOrder S; S.init(F.ws + WS_HB, F.ws + WS_WIE, MTOK, LDE, DM, F.G, F.bid);
        pg8::EpiBf16 E{(bf16*)(F.ws + WS_U), LDE};
        pg8::gemm_phase<pg8::EpiBf16, pg8::StaticOrder, true>(F.lds, DM, S, E);
    } SEAM(1);
    if (IN(2)) { p_ssd(F, args); } SEAM(2);
    if (IN(3)) { p_dsa(F, args); } SEAM(3);
    if (IN(4)) {
        pg8::StaticOrder S; S.init(F.ws + WS_HB, F.ws + WS_WOE, MTOK, DM, DM, F.G, F.bid);
        pg8::EpiResF32 E{args.in[0], F.out, DM};
        pg8::gemm_phase<pg8::EpiResF32, pg8::StaticOrder, true>(F.lds, DM, S, E);
    } SEAM(4);
    if (IN(5)) { p_norm_route<0>(F, F.out, args.in[3], 0); } SEAM(5);
    if (IN(6)) { p_moe_gu(F, 0); } SEAM(6);
    if (IN(7)) { p_moe_down(F, 0, 0); } SEAM(7);
    if (IN(8)) { p_moe_down(F, 0, 1); } SEAM(8);
    if (IN(9)) { p_norm_route<1>(F, F.out, args.in[2] + DM, 0); } SEAM(9);
    if (IN(10)) {
        pg8::StaticOrder S; S.init(F.ws + WS_HB, F.ws + WS_WIO, MTOK, LDO, DM, F.G, F.bid);
        pg8::EpiBf16 E{(bf16*)(F.ws + WS_U), LDO};
        pg8::gemm_phase<pg8::EpiBf16, pg8::StaticOrder, true>(F.lds, DM, S, E);
    } SEAM(10);
    if (IN(11)) { p_compress(F, args); } SEAM(11);
    if (IN(12)) { p_nsa(F, args); } SEAM(12);
    if (IN(13)) {
        pg8::StaticOrder S; S.init(F.ws + WS_HB, F.ws + WS_WOO, MTOK, DM, DM, F.G, F.bid);
        pg8::EpiResF32 E{F.out, F.out, DM};
        pg8::gemm_phase<pg8::EpiResF32, pg8::StaticOrder, true>(F.lds, DM, S, E);
    } SEAM(13);
    if (IN(14)) { p_norm_route<0>(F, F.out, args.in[3] + DM, 1); } SEAM(14);
    if (IN(15)) { p_moe_gu(F, 1); } SEAM(15);
    if (IN(16)) { p_moe_down(F, 1, 0); } SEAM(16);
    if (IN(17)) { p_moe_down(F, 1, 1); }
#undef IN
#undef SEAM
}

extern "C" void kernel_launch(void* const* d_in, const int* in_sizes, int n_in, void* d_out, int out_size, void* d_ws, size_t ws_size, hipStream_t stream) {
    static int grid = 0;
    if (grid == 0) {
        if (n_in != 31 || ws_size < WS_END) { fprintf(stderr, "kernel_launch: unexpected n_in %d / ws %zu\n", n_in, ws_size); grid = -1; return; }
        int dev = 0, cus = 0;
        if (hipGetDevice(&dev) != hipSuccess || hipDeviceGetAttribute(&cus, hipDeviceAttributeMultiprocessorCount, dev) != hipSuccess) { grid = -1; return; }
        if (hipFuncSetAttribute((const void*)mk_fwd, hipFuncAttributeMaxDynamicSharedMemorySize, LDS_BYTES) != hipSuccess) { fprintf(stderr, "kernel_launch: hipFuncSetAttribute failed\n"); grid = -1; return; }
        grid = cus;
    }
    if (grid < 0) return;
    (void)hipMemsetAsync((char*)d_ws + WS_CTL, 0, CTL_ZERO_BYTES, stream);
    Args a{};
    for (int i = 0; i < 31; ++i) a.in[i] = (const float*)d_in[i];
    a.out = (float*)d_out; a.ws = (unsigned char*)d_ws;
#if defined(MK_PER_PHASE)
    for (int p = 0; p < N_PHASES; ++p) { a.ph_lo = p; a.ph_hi = p + 1; hipLaunchKernelGGL(mk_fwd, dim3(grid), dim3(NTHR), LDS_BYTES, stream, a); }
#else
    a.ph_lo = 0; a.ph_hi = N_PHASES; hipLaunchKernelGGL(mk_fwd, dim3(grid), dim3(NTHR), LDS_BYTES, stream, a);
#endif
}
```

```cpp
#include <hip/hip_runtime.h>
#include <cstdio>
#include <cstdint>

#define GAS __attribute__((address_space(1)))
#define LAS __attribute__((address_space(3)))
typedef unsigned short bf16;
typedef short bf16x8 __attribute__((ext_vector_type(8)));
typedef float f32x4 __attribute__((ext_vector_type(4)));
typedef float f32x2 __attribute__((ext_vector_type(2)));
typedef float f32x16 __attribute__((ext_vector_type(16)));
typedef unsigned u32x4 __attribute__((ext_vector_type(4)));
typedef unsigned u32x2 __attribute__((ext_vector_type(2)));
typedef GAS unsigned gu32;
#define RLX_AGENT __ATOMIC_RELAXED, __HIP_MEMORY_SCOPE_AGENT
#define LDS_WAIT() asm volatile("s_waitcnt lgkmcnt(0)" ::: "memory")
#define VM_WAIT() asm volatile("s_waitcnt vmcnt(0)" ::: "memory")

constexpr int NB = 16, SEQ = 4096, DM = 1024, MTOK = NB * SEQ;
constexpr float NORM_EPS = 1e-6f;
constexpr int LDE = 2560;
constexpr int EZ = 0, EXS = 512, EBB = 1024, ECC = 1280, EQ = 1536, EK = 2048, EV = 2112, EIQ = 2176, EIK = 2432, EDT = 2496, EIW = 2504;
constexpr int LDO = 2560;
constexpr int OQ = 0, OKC = 1024, OVC = 1280, OKS = 1536, OVS = 1792, OKW = 2048, OVW = 2304;
constexpr int NWAVES = 8, NTHR = 512;

constexpr size_t MiB = 1u << 20;
constexpr size_t WS_CTL = 0, CTL_ZERO_BYTES = 1 * MiB;
constexpr size_t WS_WIE = 1 * MiB, WS_WOE = 6 * MiB, WS_WIO = 8 * MiB, WS_WOO = 13 * MiB;
constexpr size_t WS_W1K = 15 * MiB, WS_W1V = 16 * MiB, WS_W2 = 17 * MiB, WS_WR = 18 * MiB;
constexpr size_t WS_WGL = WS_WR + 256 * 1024;
constexpr size_t WS_TOK = 19 * MiB;
constexpr size_t WS_GL = 20 * MiB;
constexpr size_t WS_KCMP = 26 * MiB, WS_VCMP = 28 * MiB;
constexpr size_t WS_LIST = 32 * MiB;
constexpr size_t WS_WGU = 48 * MiB;
constexpr size_t WS_WD = 176 * MiB;
constexpr size_t WS_HB = 240 * MiB;
constexpr size_t WS_U = 368 * MiB;
constexpr size_t WS_LISTW = 720 * MiB;
constexpr size_t WS_END = 736 * MiB;
constexpr int CW_TMO = 0, CW_CODE = 1, CW_BAR = 4096, CW_CNT = 8192;

constexpr int RING_BYTES = 131072;
constexpr int LDS_BYTES = 147456;
constexpr int MISC_OFF = LDS_BYTES - 256;
constexpr int MOE_OFF = LDS_BYTES - 2048;

__device__ __forceinline__ unsigned f2bf(float f) { unsigned u = __builtin_bit_cast(unsigned, f); return (u + 0x7fffu + ((u >> 16) & 1u)) >> 16; }
typedef __bf16 bf16x2_t __attribute__((ext_vector_type(2)));
__device__ __forceinline__ unsigned pk2(float lo, float hi) { const f32x2 v = {lo, hi}; const bf16x2_t b = __builtin_convertvector(v, bf16x2_t); return __builtin_bit_cast(unsigned, b); }
__device__ __forceinline__ unsigned short f2bfh(float f) { return (unsigned short)(pk2(f, f) & 0xffffu); }
__device__ __forceinline__ float bf2f(unsigned short b) { return __builtin_bit_cast(float, ((unsigned)b) << 16); }
__device__ __forceinline__ float bflo(unsigned w) { return __builtin_bit_cast(float, w << 16); }
__device__ __forceinline__ float bfhi(unsigned w) { return __builtin_bit_cast(float, w & 0xffff0000u); }
__device__ __forceinline__ float siluf(float v) { return v / (1.f + __expf(-v)); }

#define XB_TMO      128
#define XB_XCNT(j)  (256  + 64 * (j))
#define XB_XSUB(j)  (1280 + 64 * (j))
#define XB_XGEN(j)  (2304 + 64 * (j))
#define XB_TOP      3328
#define XB_TOPGEN   3392
#define XCD_BAR_WORDS 3456
#define XB_SPIN_CAP (1u << 20)
__device__ __forceinline__ unsigned xb_ld(unsigned* p)              { return __hip_atomic_load(p, __ATOMIC_RELAXED, __HIP_MEMORY_SCOPE_AGENT); }
__device__ __forceinline__ unsigned xb_add(unsigned* p, unsigned v) { return __hip_atomic_fetch_add(p, v, __ATOMIC_RELAXED, __HIP_MEMORY_SCOPE_AGENT); }
__device__ __forceinline__ unsigned xb_xcc_id() { return (unsigned)__builtin_amdgcn_s_getreg((3 << 11) | 20) & 0xFu; }
#define XB_SPIN(cond, bar) do { unsigned _sp = 0; while (cond) { __builtin_amdgcn_s_sleep(1); \
    if ((++_sp & 255u) == 0u) { if (xb_ld(&(bar)[XB_TMO])) break; if (_sp > XB_SPIN_CAP) { atomicAdd(&(bar)[XB_TMO], 1u); break; } } } } while (0)
struct XcdBarrier { unsigned* bar; unsigned x; volatile LAS unsigned* st; };
__device__ __forceinline__ XcdBarrier xcd_barrier_post(unsigned* bar, volatile LAS unsigned* st) {
    XcdBarrier b; b.bar = bar; b.x = xb_xcc_id(); b.st = st;
    if (threadIdx.x == 0) (void)xb_add(&bar[XB_XCNT(b.x)], 1u);
    return b;
}
__device__ __forceinline__ void xcd_barrier_complete(unsigned* bar, unsigned x, unsigned& nloc, unsigned& nx) {
    const unsigned G = gridDim.x * gridDim.y * gridDim.z;
    unsigned sum, cnt, mine, sp = 0u;
    for (;;) {
        sum = 0u; cnt = 0u; mine = 0u;
#pragma unroll
        for (unsigned j = 0; j < 16; ++j) { const unsigned c = xb_ld(&bar[XB_XCNT(j)]); sum += c; cnt += (c > 0u) ? 1u : 0u; mine = (j == x) ? c : mine; }
        if (sum == G) break;
        __builtin_amdgcn_s_sleep(1);
        if ((++sp & 255u) == 0u) { if (xb_ld(&bar[XB_TMO])) break; if (sp > XB_SPIN_CAP) { atomicAdd(&bar[XB_TMO], 1u); break; } }
    }
    nloc = mine > 0u ? mine : 1u; nx = cnt > 0u ? cnt : 1u;
}
__device__ __forceinline__ void xcd_barrier(const XcdBarrier& b) {
    asm volatile("s_waitcnt vmcnt(0)" ::: "memory");
    __syncthreads();
    if (threadIdx.x == 0) {
        unsigned* bar = b.bar;
        __builtin_amdgcn_s_waitcnt(0);
        unsigned nloc = b.st[0], nx = b.st[1];
        if (nloc == 0u) { xcd_barrier_complete(bar, b.x, nloc, nx); b.st[0] = nloc; b.st[1] = nx; }
        const unsigned old = xb_add(&bar[XB_XSUB(b.x)], 1u);
        const unsigned gen = old / nloc;
        if (old + 1u == (gen + 1u) * nloc) {
            __builtin_amdgcn_fence(__ATOMIC_RELEASE, "agent");
            asm volatile("s_waitcnt vmcnt(0)" ::: "memory");
            const unsigned og = xb_add(&bar[XB_TOP], 1u);
            const unsigned tg = og / nx;
            if (og + 1u == (tg + 1u) * nx) xb_add(&bar[XB_TOPGEN], 1u);
            else XB_SPIN(xb_ld(&bar[XB_TOPGEN]) == tg, bar);
            __builtin_amdgcn_fence(__ATOMIC_ACQUIRE, "agent");
            xb_add(&bar[XB_XGEN(b.x)], 1u);
            asm volatile("s_waitcnt vmcnt(0)" ::: "memory");
        } else {
            XB_SPIN(xb_ld(&bar[XB_XGEN(b.x)]) == gen, bar);
            __builtin_amdgcn_fence(__ATOMIC_ACQUIRE, "agent");
            asm volatile("s_waitcnt vmcnt(0)" ::: "memory");
        }
    }
    __syncthreads();
}

namespace pg8 {
constexpr int BM = 256, BK = 64, HALF = 128, HTB = HALF * BK * 2, STAGE_BYTES = 8 * HTB, NXCD = 8, WGM = 8;
__host__ __device__ __forceinline__ int lds_byte(int r, int c) { const int st = (r >> 4) * 2 + (c >> 5), rr = r & 15, cc = c & 31, ob = rr * 64 + cc * 2; return st * 1024 + (ob ^ (((ob >> 9) & 1) << 5)); }
__host__ __device__ __forceinline__ void stage_rc(int b, int& R, int& C) { const int st = b / 1024, sb = b % 1024, swz = sb ^ (((sb >> 9) & 1) << 5); R = (st >> 1) * 16 + swz / 64; C = (st & 1) * 32 + (swz % 64) / 2; }
__host__ __device__ __forceinline__ int perm32(int rho) { const int n = rho >> 4, i = rho & 15; return 8 * (i >> 2) + 4 * n + (i & 3); }
__device__ __forceinline__ unsigned cvt_pk_bf16(float lo, float hi) { unsigned r; asm volatile("v_cvt_pk_bf16_f32 %0, %1, %2" : "=v"(r) : "v"(lo), "v"(hi)); return r; }

struct Unit { const char* A; const char* B; int pm, pn, aux; };

struct StaticOrder {
    const char* A; const char* Bt; int K, nM, nN, nwg, G, c;
    __device__ void init(const void* A_, const void* Bt_, int M, int N, int K_, int G_, int c_) { A = (const char*)A_; Bt = (const char*)Bt_; K = K_; nM = M / BM; nN = N / BM; nwg = nM * nN; G = G_; c = c_; }
    __device__ __forceinline__ bool next(int i, Unit& u) const {
        const long L = (long)i * G + c; if (L >= nwg) return false;
        int wgid = (int)L; { const int q = nwg / NXCD, r = nwg % NXCD, xcd = wgid % NXCD, off = wgid / NXCD; wgid = (xcd < r ? xcd * (q + 1) : r * (q + 1) + (xcd - r) * q) + off; }
        const int nig = WGM * nN, gid = wgid / nig, fm = gid * WGM, gsz = (nM - fm) < WGM ? (nM - fm) : WGM;
        u.pm = fm + ((wgid % nig) % gsz); u.pn = (wgid % nig) / gsz; u.aux = 0;
        u.A = A + (size_t)u.pm * BM * K * 2; u.B = Bt + (size_t)u.pn * BM * K * 2; return true;
    }
    __device__ __forceinline__ unsigned arow(const Unit&, int r) const { return (unsigned)(r * K) * 2u; }
};

template <class Epi, class Sched, bool ALIGN_EPI>
__device__ __forceinline__ void gemm_phase(LAS unsigned char* lds, const int K, const Sched& S, const Epi& E) {
    const int tid = threadIdx.x, wid = __builtin_amdgcn_readfirstlane(tid >> 6), lane = tid & 63, wr = wid >> 2, wc = wid & 3, fr = lane & 15, fq = lane >> 4;
    const int nt = K / BK;
    int RA[2], CA[2]; unsigned voffB[2];
#pragma unroll
    for (int i = 0; i < 2; ++i) { int R, C; stage_rc(tid * 16 + i * 8192, R, C); const int Rb = Epi::PERM ? ((R & ~31) + perm32(R & 31)) : R;
        RA[i] = R; CA[i] = C; voffB[i] = (unsigned)(Rb * K + C) * 2u; }
    const size_t kstep = (size_t)(BK * 2);
    const size_t hstep = (size_t)HALF * K * 2;
    const unsigned ldsw = (unsigned)wid * 1024u;
    const int aoff = lds_byte(wr * 64 + fr, fq * 8), boff = lds_byte(wc * 32 + fr, fq * 8);
#define PG8_SA(b, h) (((b) * 2 + (h)) * HTB)
#define PG8_SB(b, h) ((4 + (b) * 2 + (h)) * HTB)
#define PG8_STAGE(bufoff, gbase, voff) do { _Pragma("unroll") for (int _i = 0; _i < 2; ++_i) \
        __builtin_amdgcn_global_load_lds((const unsigned*)((const char*)(gbase) + (voff)[_i]), (LAS unsigned*)(lds + (bufoff) + ldsw + _i * 8192), 16, 0, 0); } while (0)
#define PG8_LDA(dst, b, h) do { _Pragma("unroll") for (int m = 0; m < 4; ++m) _Pragma("unroll") for (int k = 0; k < 2; ++k) dst[m][k] = *(const LAS bf16x8*)(lds + PG8_SA(b, h) + aoff + m * 2048 + k * 1024); } while (0)
#define PG8_LDB(dst, b, h) do { _Pragma("unroll") for (int n = 0; n < 2; ++n) _Pragma("unroll") for (int k = 0; k < 2; ++k) dst[n][k] = *(const LAS bf16x8*)(lds + PG8_SB(b, h) + boff + n * 2048 + k * 1024); } while (0)
#define PG8_MMA(ai, bj, At, Bt) do { __builtin_amdgcn_s_setprio(1); _Pragma("unroll") for (int m = 0; m < 4; ++m) _Pragma("unroll") for (int n = 0; n < 2; ++n) _Pragma("unroll") for (int k = 0; k < 2; ++k) \
        acc[ai][bj][m][n] = __builtin_amdgcn_mfma_f32_16x16x32_bf16(Bt[n][k], At[m][k], acc[ai][bj][m][n], 0, 0, 0); __builtin_amdgcn_s_setprio(0); } while (0)
#define PG8_WAIT_V(n) asm volatile("s_waitcnt vmcnt(" #n ")" ::: "memory")
#define PG8_WAIT_L(n) asm volatile("s_waitcnt lgkmcnt(" #n ")" ::: "memory")
#define PG8_BAR __builtin_amdgcn_s_barrier()
#define PG8_SCHED __builtin_amdgcn_sched_barrier(0)
    Unit cur, nxt; int ui = 0;
    if (!S.next(0, cur)) return;
    f32x4 acc[2][2][4][2];
#pragma unroll
    for (int a = 0; a < 2; ++a)
#pragma unroll
        for (int b = 0; b < 2; ++b)
#pragma unroll
            for (int m = 0; m < 4; ++m)
#pragma unroll
                for (int n = 0; n < 2; ++n) acc[a][b][m][n] = (f32x4){0.f, 0.f, 0.f, 0.f};
    bf16x8 At[4][2], B0[2][2], B1[2][2];
    unsigned vA0[2], vA1[2], nA0[2], nA1[2];
#pragma unroll
    for (int i = 0; i < 2; ++i) { vA0[i] = S.arow(cur, RA[i]) + CA[i] * 2u; vA1[i] = S.arow(cur, HALF + RA[i]) + CA[i] * 2u; nA0[i] = vA0[i]; nA1[i] = vA1[i]; }
    const char* cA = cur.A; const char* cB = cur.B;
    PG8_STAGE(PG8_SB(0, 0), cB, voffB); PG8_STAGE(PG8_SB(0, 1), cB + hstep, voffB); PG8_STAGE(PG8_SA(0, 0), cA, vA0); PG8_STAGE(PG8_SA(0, 1), cA, vA1);
    if (wr == 1) PG8_BAR;
    PG8_WAIT_V(2); PG8_BAR;
    PG8_STAGE(PG8_SB(1, 0), cB + kstep, voffB); PG8_STAGE(PG8_SA(1, 0), cA + kstep, vA0); PG8_STAGE(PG8_SB(1, 1), cB + hstep + kstep, voffB);
    PG8_WAIT_V(6); PG8_BAR;
    for (;;) {
        const bool has_next = S.next(ui + 1, nxt);
        const char* nA = has_next ? nxt.A : cA; const char* nB = has_next ? nxt.B : cB;
        if (has_next) {
#pragma unroll
            for (int i = 0; i < 2; ++i) { nA0[i] = S.arow(nxt, RA[i]) + CA[i] * 2u; nA1[i] = S.arow(nxt, HALF + RA[i]) + CA[i] * 2u; }
        }
        for (int t = 0; t < nt; t += 2) {
            const bool last = (t == nt - 2);
            const char* a1 = cA + (size_t)(t + 1) * kstep;
            const char* a2 = last ? nA : cA + (size_t)(t + 2) * kstep; const char* b2 = last ? nB : cB + (size_t)(t + 2) * kstep;
            const char* a3 = a2 + kstep; const char* b3 = b2 + kstep;
            unsigned w0[2], w1[2];
#pragma unroll
            for (int i = 0; i < 2; ++i) { w0[i] = last ? nA0[i] : vA0[i]; w1[i] = last ? nA1[i] : vA1[i]; }
            PG8_LDB(B0, 0, 0); PG8_LDB(B1, 0, 1); PG8_SCHED; PG8_LDA(At, 0, 0); PG8_STAGE(PG8_SA(1, 1), a1, vA1);
            PG8_WAIT_V(8); PG8_WAIT_L(0); PG8_BAR; PG8_MMA(0, 0, At, B0); PG8_MMA(0, 1, At, B1); PG8_BAR; PG8_SCHED;
            PG8_LDA(At, 0, 1); PG8_STAGE(PG8_SB(0, 0), b2, voffB); PG8_STAGE(PG8_SB(0, 1), b2 + hstep, voffB); PG8_STAGE(PG8_SA(0, 0), a2, w0);
            PG8_WAIT_V(8); PG8_WAIT_L(0); PG8_BAR; PG8_MMA(1, 0, At, B0); PG8_MMA(1, 1, At, B1); PG8_BAR; PG8_SCHED;
            PG8_LDB(B0, 1, 0); PG8_LDB(B1, 1, 1); PG8_SCHED; PG8_LDA(At, 1, 0); PG8_STAGE(PG8_SA(0, 1), a2, w1);
            PG8_WAIT_V(8); PG8_WAIT_L(0); PG8_BAR; PG8_MMA(0, 0, At, B0); PG8_MMA(0, 1, At, B1); PG8_BAR; PG8_SCHED;
            PG8_LDA(At, 1, 1); PG8_STAGE(PG8_SB(1, 0), b3, voffB); PG8_STAGE(PG8_SB(1, 1), b3 + hstep, voffB); PG8_STAGE(PG8_SA(1, 0), a3, w0);
            PG8_WAIT_V(8); PG8_WAIT_L(0); PG8_BAR; PG8_MMA(1, 0, At, B0); PG8_MMA(1, 1, At, B1); PG8_BAR; PG8_SCHED;
        }
        if constexpr (ALIGN_EPI) { if (wr == 0) PG8_BAR; }
        E(acc, cur, wr, wc, fr, fq);
        if (!has_next) break;
#pragma unroll
        for (int a = 0; a < 2; ++a)
#pragma unroll
            for (int b = 0; b < 2; ++b)
#pragma unroll
                for (int m = 0; m < 4; ++m)
#pragma unroll
                    for (int n = 0; n < 2; ++n) acc[a][b][m][n] = (f32x4){0.f, 0.f, 0.f, 0.f};
        cur = nxt; cA = nA; cB = nB; ++ui;
#pragma unroll
        for (int i = 0; i < 2; ++i) { vA0[i] = nA0[i]; vA1[i] = nA1[i]; }
        if constexpr (ALIGN_EPI) { if (wr == 1) PG8_BAR; }
    }
    PG8_WAIT_V(0);
    if constexpr (!ALIGN_EPI) { if (wr == 0) PG8_BAR; }
    PG8_BAR;
#undef PG8_SA
#undef PG8_SB
#undef PG8_STAGE
#undef PG8_LDA
#undef PG8_LDB
#undef PG8_MMA
#undef PG8_WAIT_V
#undef PG8_WAIT_L
#undef PG8_BAR
#undef PG8_SCHED
}

struct EpiBf16 {
    static constexpr bool PERM = true;
    bf16* O; int ldc;
    __device__ __forceinline__ void operator()(const f32x4 (&acc)[2][2][4][2], const Unit& u, int wr, int wc, int fr, int fq) const {
        const int row0 = u.pm * BM + wr * 64 + fr; const int col0 = u.pn * BM + wc * 32 + 8 * fq;
#pragma unroll
        for (int ai = 0; ai < 2; ++ai)
#pragma unroll
            for (int m = 0; m < 4; ++m) { bf16* rowp = O + (size_t)(row0 + ai * HALF + m * 16) * ldc + col0;
#pragma unroll
                for (int bj = 0; bj < 2; ++bj) { const f32x4 v0 = acc[ai][bj][m][0], v1 = acc[ai][bj][m][1];
                    u32x4 w; w.x = cvt_pk_bf16(v0[0], v0[1]); w.y = cvt_pk_bf16(v0[2], v0[3]); w.z = cvt_pk_bf16(v1[0], v1[1]); w.w = cvt_pk_bf16(v1[2], v1[3]);
                    *(u32x4*)(rowp + bj * HALF) = w; } }
    }
};
struct EpiResF32 {
    static constexpr bool PERM = false;
    const float* base; float* out; int ldc;
    __device__ __forceinline__ void operator()(const f32x4 (&acc)[2][2][4][2], const Unit& u, int wr, int wc, int fr, int fq) const {
        const int row0 = u.pm * BM + wr * 64 + fr, col0 = u.pn * BM + wc * 32 + 4 * fq;
#pragma unroll
        for (int ai = 0; ai < 2; ++ai)
#pragma unroll
            for (int m = 0; m < 4; ++m) { const size_t off = (size_t)(row0 + ai * HALF + m * 16) * ldc + col0;
#pragma unroll
                for (int bj = 0; bj < 2; ++bj)
#pragma unroll
                    for (int n = 0; n < 2; ++n) { const f32x4 bs = *(const f32x4*)(base + off + bj * HALF + n * 16); *(f32x4*)(out + off + bj * HALF + n * 16) = bs + acc[ai][bj][m][n]; } }
    }
};

struct MoeOrder {
    const char* Abase; const char* Bbase; size_t bstride; int K, G, c, tile_lo, tile_hi; const LAS int* ptile; const LAS int* cntv; const int* list; bool gather;
    __device__ __forceinline__ bool next(int i, Unit& u) const {
        const long L = (long)i * G + c; const int nun = (tile_hi - tile_lo) * 4; if (L >= nun) return false;
        const int tile = tile_lo + (int)(L >> 2), pn = (int)(L & 3);
        int e = 0;
        for (int k = 1; k < 64; ++k) e += (tile >= __builtin_amdgcn_readfirstlane(ptile[k])) ? 1 : 0;
        const int j = tile - __builtin_amdgcn_readfirstlane(ptile[e]);
        u.pm = tile; u.pn = pn; u.aux = e | (j << 6);
        u.A = gather ? Abase : Abase + (size_t)tile * BM * K * 2; u.B = Bbase + (size_t)(e & 31) * bstride + (size_t)pn * BM * K * 2; return true;
    }
    __device__ __forceinline__ unsigned arow(const Unit& u, int r) const {
        if (!gather) return (unsigned)(r * K) * 2u;
        const int e = u.aux & 63, pos = (u.aux >> 6) * 256 + r; const int cn = cntv[e];
        const int tok = pos < cn ? list[(size_t)e * 65536 + pos] : 0;
        return (unsigned)tok * (unsigned)(K * 2);
    }
};
struct EpiSwiGLU {
    static constexpr bool PERM = true;
    bf16* H;
    __device__ __forceinline__ void operator()(const f32x4 (&acc)[2][2][4][2], const Unit& u, int wr, int wc, int fr, int fq) const {
        const int row0 = u.pm * BM + wr * 64 + fr; const int col0 = u.pn * 128 + wc * 32 + 8 * fq;
#pragma unroll
        for (int ai = 0; ai < 2; ++ai)
#pragma unroll
            for (int m = 0; m < 4; ++m) { bf16* rowp = H + (size_t)(row0 + ai * HALF + m * 16) * 512 + col0;
                const f32x4 g0 = acc[ai][0][m][0], g1 = acc[ai][0][m][1], u0 = acc[ai][1][m][0], u1 = acc[ai][1][m][1];
                float h[8];
#pragma unroll
                for (int q = 0; q < 4; ++q) { h[q] = g0[q] / (1.f + __expf(-g0[q])) * u0[q]; h[4 + q] = g1[q] / (1.f + __expf(-g1[q])) * u1[q]; }
                u32x4 w; w.x = cvt_pk_bf16(h[0], h[1]); w.y = cvt_pk_bf16(h[2], h[3]); w.z = cvt_pk_bf16(h[4], h[5]); w.w = cvt_pk_bf16(h[6], h[7]);
                *(u32x4*)rowp = w; }
    }
};
struct EpiScatter {
    static constexpr bool PERM = false;
    float* out; const int* list; const float* wl; const LAS int* cntv;
    __device__ __forceinline__ void operator()(const f32x4 (&acc)[2][2][4][2], const Unit& u, int wr, int wc, int fr, int fq) const {
        const int e = u.aux & 63, j = u.aux >> 6; const int cn = cntv[e];
        const int col0 = u.pn * BM + wc * 32 + 4 * fq;
#pragma unroll
        for (int ai = 0; ai < 2; ++ai)
#pragma unroll
            for (int m = 0; m < 4; ++m) { const int pos = j * 256 + ai * HALF + wr * 64 + m * 16 + fr;
                if (pos < cn) { const int tok = list[(size_t)e * 65536 + pos]; const float wg = wl[(size_t)e * 65536 + pos];
                    float* rowp = out + (size_t)tok * DM + col0;
#pragma unroll
                    for (int bj = 0; bj < 2; ++bj)
#pragma unroll
                        for (int n = 0; n < 2; ++n) { f32x4* p = (f32x4*)(rowp + bj * HALF + n * 16); *p = *p + wg * acc[ai][bj][m][n]; } } }
    }
};
}

struct Frame {
    LAS unsigned char* lds;
    volatile LAS unsigned* MISC;
    gu32* ctl;
    int tid, lane, wave, G, bid;
    float* out; unsigned char* ws;
};
struct Args { const float* in[31]; float* out; unsigned char* ws; int ph_lo, ph_hi, rep, pad; };
#ifndef REP_PART
#define REP_PART 0
#endif
__device__ __forceinline__ float wave_sum(float v) {
#pragma unroll
    for (int o = 1; o < 64; o <<= 1) v += __shfl_xor(v, o);
    return v;
}

template <class Map>
__device__ __forceinline__ void transpose_item(const float* W, int K, int pitch, int col0, int ncols, bf16* WT, LAS float* scr, int item, int lane, Map dmap) {
    const int nblk = (ncols + 31) / 32, kb = item / nblk, nb = item % nblk, k0 = 64 * kb, n0 = 32 * nb;
    const int nn = n0 + (lane & 31);
#pragma unroll 8
    for (int i = 0; i < 32; ++i) { const int kk = 2 * i + (lane >> 5); scr[kk * 33 + (lane & 31)] = (nn < ncols) ? W[(size_t)(k0 + kk) * pitch + col0 + nn] : 0.f; }
    LDS_WAIT(); asm volatile("" ::: "memory");
    const int c = lane & 7;
#pragma unroll
    for (int j = 0; j < 4; ++j) { const int n = (lane >> 3) + 8 * j; const LAS float* s = scr + (8 * c) * 33 + n;
        u32x4 o; o.x = pk2(s[0 * 33], s[1 * 33]); o.y = pk2(s[2 * 33], s[3 * 33]); o.z = pk2(s[4 * 33], s[5 * 33]); o.w = pk2(s[6 * 33], s[7 * 33]);
        if (n0 + n < ncols) *(u32x4*)(WT + (size_t)dmap(n0 + n) * K + k0 + 8 * c) = o; }
    LDS_WAIT(); asm volatile("" ::: "memory");
}
struct MapId { int off; __device__ int operator()(int n) const { return n + off; } };
struct MapEven { __device__ int operator()(int c) const {
    if (c < 1536) return c; if (c < 1544) return EDT + (c - 1536); if (c < 2056) return EQ + (c - 1544); if (c < 2120) return EK + (c - 2056);
    if (c < 2184) return EV + (c - 2120); if (c < 2440) return EIQ + (c - 2184); if (c < 2504) return EIK + (c - 2440); return EIW + (c - 2504); } };
struct MapGU { int half; __device__ int operator()(int n) const { return 256 * (n >> 7) + 128 * half + (n & 127); } };

__device__ __forceinline__ void rms_row_to_bf16(const float* xrow, const float* gain, bf16* orow, int lane) {
    const f32x4* xr = (const f32x4*)xrow + lane; const f32x4* gr = (const f32x4*)gain + lane;
    f32x4 v[4]; float s = 0.f;
#pragma unroll
    for (int j = 0; j < 4; ++j) { v[j] = xr[64 * j]; s += (v[j].x * v[j].x + v[j].y * v[j].y) + (v[j].z * v[j].z + v[j].w * v[j].w); }
    const float rs = 1.f / sqrtf(wave_sum(s) * (1.f / DM) + NORM_EPS);
    unsigned long long* o8 = (unsigned long long*)orow + lane;
#pragma unroll
    for (int j = 0; j < 4; ++j) { const f32x4 g = gr[64 * j]; o8[64 * j] = (unsigned long long)pk2(v[j].x * rs * g.x, v[j].y * rs * g.y) | ((unsigned long long)pk2(v[j].z * rs * g.z, v[j].w * rs * g.w) << 32); }
}

__device__ __forceinline__ void p_prologue(Frame& F, const Args& A) {
    LAS float* scr = (LAS float*)(F.lds + F.wave * 16384);
    const int gw = F.bid * NWAVES + F.wave, NGW = F.G * NWAVES;
    bf16* Wie = (bf16*)(F.ws + WS_WIE); bf16* Woe = (bf16*)(F.ws + WS_WOE);
    constexpr int I_IE = 16 * 79, I_OE = 16 * 32;
    for (int it = gw; it < I_IE + I_OE; it += NGW) {
        if (it < I_IE) transpose_item(A.in[4], 1024, 2508, 0, 2508, Wie, scr, it, F.lane, MapEven());
        else transpose_item(A.in[13], 1024, 1024, 0, 1024, Woe, scr, it - I_IE, F.lane, MapId{0});
    }
    {
        bf16* Wgu = (bf16*)(F.ws + WS_WGU); bf16* Wd = (bf16*)(F.ws + WS_WD); bf16* WR = (bf16*)(F.ws + WS_WR);
        for (int it = gw; it < 64 * 768; it += NGW) { const int le = it / 768, r = it % 768;
            if (r < 256) transpose_item(A.in[28] + (size_t)le * 1024 * 512, 1024, 512, 0, 512, Wgu + (size_t)le * 1024 * 1024, scr, r, F.lane, MapGU{0});
            else if (r < 512) transpose_item(A.in[29] + (size_t)le * 1024 * 512, 1024, 512, 0, 512, Wgu + (size_t)le * 1024 * 1024, scr, r - 256, F.lane, MapGU{1});
            else transpose_item(A.in[30] + (size_t)le * 512 * 1024, 512, 1024, 0, 1024, Wd + (size_t)le * 1024 * 512, scr, r - 512, F.lane, MapId{0}); }
        for (int it = gw; it < 2 * 5 * 16; it += NGW) { const int l = it / 80, r = it % 80, q = r / 16, kb = r % 16;
            if (q == 0) transpose_item(A.in[26] + (size_t)l * 1024 * 4, 1024, 4, 0, 4, WR + (size_t)l * 48 * 1024, scr, kb, F.lane, MapId{0});
            else transpose_item(A.in[27] + (size_t)(l * 4 + q - 1) * 1024 * 8, 1024, 8, 0, 8, WR + (size_t)l * 48 * 1024, scr, kb, F.lane, MapId{4 + 8 * (q - 1)}); }
        for (int i = gw * 64 + F.lane; i < 2 * 12 * 1024 / 8; i += NGW * 64) { const int l = i / (12 * 128), o = i % (12 * 128); *(u32x4*)(WR + (size_t)l * 48 * 1024 + 36 * 1024 + (size_t)o * 8) = (u32x4){0u, 0u, 0u, 0u}; }
    }
    {
        bf16* Wio = (bf16*)(F.ws + WS_WIO); bf16* Woo = (bf16*)(F.ws + WS_WOO); bf16* WGL = (bf16*)(F.ws + WS_WGL);
        bf16* W1K = (bf16*)(F.ws + WS_W1K); bf16* W1V = (bf16*)(F.ws + WS_W1V); bf16* W2 = (bf16*)(F.ws + WS_W2);
        constexpr int J0 = 16 * 80, J1 = J0 + 16, J2 = J1 + 16 * 32, J3 = J2 + 64 * 4, J4 = J3 + 64 * 4, J5 = J4 + 2 * 4, J6 = J5 + 2 * 4;
        for (int it = gw; it < J6; it += NGW) {
            if (it < J0) transpose_item(A.in[14], 1024, 2584, 0, 2560, Wio, scr, it, F.lane, MapId{0});
            else if (it < J1) transpose_item(A.in[14], 1024, 2584, 2560, 24, WGL, scr, it - J0, F.lane, MapId{0});
            else if (it < J2) transpose_item(A.in[25], 1024, 1024, 0, 1024, Woo, scr, it - J1, F.lane, MapId{0});
            else if (it < J3) transpose_item(A.in[21], 4096, 128, 0, 128, W1K, scr, it - J2, F.lane, MapId{0});
            else if (it < J4) transpose_item(A.in[23], 4096, 128, 0, 128, W1V, scr, it - J3, F.lane, MapId{0});
            else if (it < J5) transpose_item(A.in[22], 128, 128, 0, 128, W2, scr, it - J4, F.lane, MapId{0});
            else transpose_item(A.in[24], 128, 128, 0, 128, W2 + 128 * 128, scr, it - J5, F.lane, MapId{0});
        }
        for (int i = gw * 64 + F.lane; i < 8 * 1024 / 8; i += NGW * 64) *(u32x4*)(WGL + 24 * 1024 + (size_t)i * 8) = (u32x4){0u, 0u, 0u, 0u};
    }
    for (int i = gw * 64 + F.lane; i < 52 * 1024 / 8; i += NGW * 64) *(u32x4*)(Wie + (size_t)2508 * 1024 + (size_t)i * 8) = (u32x4){0u, 0u, 0u, 0u};
    bf16* HB = (bf16*)(F.ws + WS_HB);
    for (int m = gw; m < MTOK; m += NGW) rms_row_to_bf16(A.in[0] + (size_t)m * DM, A.in[2], HB + (size_t)m * DM, F.lane);
}

constexpr int SP = 136;
constexpr int L_CS = 0, L_BS = 34816, L_BT = 69632, L_XT = 104448, L_XS = 113152, L_ST = 121856, L_AC = 139264, L_DT = 139776, L_CW = 140288;
__device__ __forceinline__ bf16x8 lds_frag(LAS unsigned char* base, int row, int col) { return *(const LAS bf16x8*)(base + (row * SP + col) * 2); }

__device__ __forceinline__ void p_ssd(Frame& F, const Args& A) {
    bf16* U = (bf16*)(F.ws + WS_U);
    const int w = F.wave;
    { const int tid = F.tid;
    for (int r0 = F.bid * 64; r0 < MTOK; r0 += F.G * 64) {
        const int row = r0 + (tid >> 3), c8 = (tid & 7) * 8;
        bf16* p = U + (size_t)row * LDE + EK + c8;
        const u32x4 v = *(const u32x4*)p; float f[8] = {bflo(v.x), bfhi(v.x), bflo(v.y), bfhi(v.y), bflo(v.z), bfhi(v.z), bflo(v.w), bfhi(v.w)};
        float s = 0.f;
#pragma unroll
        for (int j = 0; j < 8; ++j) s += f[j] * f[j];
        s += __shfl_xor(s, 1); s += __shfl_xor(s, 2); s += __shfl_xor(s, 4);
        const float rs = 1.f / sqrtf(s * (1.f / 64.f) + NORM_EPS); const float* g = A.in[12] + c8;
        u32x4 o; o.x = pk2(f[0] * rs * g[0], f[1] * rs * g[1]); o.y = pk2(f[2] * rs * g[2], f[3] * rs * g[3]); o.z = pk2(f[4] * rs * g[4], f[5] * rs * g[5]); o.w = pk2(f[6] * rs * g[6], f[7] * rs * g[7]);
        *(u32x4*)p = o;
    } }
    LAS unsigned char* L = F.lds;
    LAS float* acum = (LAS float*)(L + L_AC); LAS float* dtv = (LAS float*)(L + L_DT); LAS float* cw = (LAS float*)(L + L_CW);
    const float* conv_w = A.in[5]; const float* conv_b = A.in[6];
    for (int st = F.bid; st < 256; st += F.G) {
        const int b = st >> 4, h = (st >> 1) & 7, ph = st & 1, g = h >> 2;
        { const int tid = F.tid;
        __syncthreads();
        for (int i = tid; i < 5 * 288; i += NTHR) { const int j = i / 288, lc = i % 288;
            const int ch = lc < 128 ? 512 + g * 128 + lc : (lc < 256 ? 768 + g * 128 + (lc - 128) : h * 64 + ph * 32 + (lc - 256));
            cw[i] = j < 4 ? conv_w[j * 1024 + ch] : conv_b[ch]; }
        for (int i = tid; i < 2 * 32 * SP / 2; i += NTHR) ((LAS unsigned*)(L + L_ST))[i] = 0u; }
        const float a_h = -__expf(A.in[8][h]), dtb = A.in[7][h], dsk = A.in[9][h];
        f32x16 state = {0.f, 0.f, 0.f, 0.f, 0.f, 0.f, 0.f, 0.f, 0.f, 0.f, 0.f, 0.f, 0.f, 0.f, 0.f, 0.f};
        __syncthreads();
        for (int c = 0; c < 32; ++c) {
            const size_t rowbase = (size_t)b * SEQ + (size_t)c * 128;
            int tid = F.tid, lane = F.lane; asm volatile("" : "+v"(tid), "+v"(lane));
            if (tid < 128) {
                const float dr = bf2f(U[(rowbase + tid) * LDE + EDT + h]) + dtb;
                const float dt = dr > 20.f ? dr : log1pf(__expf(dr));
                float s = dt * a_h;
#pragma unroll
                for (int o = 1; o < 64; o <<= 1) { const float t = __shfl_up(s, o); if (lane >= o) s += t; }
                dtv[tid] = dt; acum[tid] = s;
            }
            {
                const int cg = tid & 15, rr = tid >> 4;
#pragma unroll 1
                for (int T = 0; T < 2; ++T) {
                    const int gcol = (T == 0 ? EBB : ECC) + g * 128 + 8 * cg;
                    u32x4 raw[7];
#pragma unroll
                    for (int j = 0; j < 7; ++j) { const int tl = 4 * rr - 3 + j;
                        raw[j] = (u32x4){0u, 0u, 0u, 0u};
                        if (c > 0 || tl >= 0) raw[j] = *(const u32x4*)(U + (size_t)((long)rowbase + tl) * LDE + gcol); }
                    LAS unsigned char* dst = L + (T == 0 ? L_BS : L_CS);
                    unsigned opk[4][4];
#pragma unroll
                    for (int e2 = 0; e2 < 4; ++e2) {
                        const int lc = T * 128 + 8 * cg + 2 * e2;
                        const f32x2 w0 = *(const LAS f32x2*)(cw + lc), w1 = *(const LAS f32x2*)(cw + 288 + lc), w2 = *(const LAS f32x2*)(cw + 576 + lc), w3 = *(const LAS f32x2*)(cw + 864 + lc), bb = *(const LAS f32x2*)(cw + 1152 + lc);
                        float lo[7], hi[7];
#pragma unroll
                        for (int j = 0; j < 7; ++j) { lo[j] = bflo(raw[j][e2]); hi[j] = bfhi(raw[j][e2]); }
                        float ol[4], oh[4];
#pragma unroll
                        for (int q = 0; q < 4; ++q) { ol[q] = siluf(bb.x + w0.x * lo[q] + w1.x * lo[q + 1] + w2.x * lo[q + 2] + w3.x * lo[q + 3]);
                                                      oh[q] = siluf(bb.y + w0.y * hi[q] + w1.y * hi[q + 1] + w2.y * hi[q + 2] + w3.y * hi[q + 3]); opk[q][e2] = pk2(ol[q], oh[q]); }
                        if (T == 0) {
                            *(LAS u32x2*)(L + L_BT + ((8 * cg + 2 * e2) * SP + 4 * rr) * 2) = (u32x2){pk2(ol[0], ol[1]), pk2(ol[2], ol[3])};
                            *(LAS u32x2*)(L + L_BT + ((8 * cg + 2 * e2 + 1) * SP + 4 * rr) * 2) = (u32x2){pk2(oh[0], oh[1]), pk2(oh[2], oh[3])};
                        }
                    }
#pragma unroll
                    for (int q = 0; q < 4; ++q) *(LAS u32x4*)(dst + ((4 * rr + q) * SP + 8 * cg) * 2) = (u32x4){opk[q][0], opk[q][1], opk[q][2], opk[q][3]};
                }
            }
            __syncthreads();
            if (tid >= 64 && tid < 128) acum[tid] += acum[63];
            __syncthreads();
            {
                const int cg = tid & 3, t = tid >> 2;
                const int gcol = EXS + h * 64 + ph * 32 + 8 * cg;
                u32x4 raw[4];
#pragma unroll
                for (int j = 0; j < 4; ++j) { const int tl = t - 3 + j; raw[j] = (u32x4){0u, 0u, 0u, 0u};
                    if (c > 0 || tl >= 0) raw[j] = *(const u32x4*)(U + (size_t)((long)rowbase + tl) * LDE + gcol); }
                const float sc = dtv[t] * __expf(acum[127] - acum[t]);
#pragma unroll
                for (int e = 0; e < 8; ++e) { const int lc = 256 + 8 * cg + e;
                    float rv[4];
#pragma unroll
                    for (int j = 0; j < 4; ++j) rv[j] = (e & 1) ? bfhi(raw[j][e >> 1]) : bflo(raw[j][e >> 1]);
                    const float xv = siluf(cw[1152 + lc] + cw[lc] * rv[0] + cw[288 + lc] * rv[1] + cw[576 + lc] * rv[2] + cw[864 + lc] * rv[3]);
                    *(LAS bf16*)(L + L_XT + ((8 * cg + e) * SP + t) * 2) = (bf16)f2bfh(xv);
                    *(LAS bf16*)(L + L_XS + ((8 * cg + e) * SP + t) * 2) = (bf16)f2bfh(xv * sc); }
            }
            const int mt = w >> 1, nh = w & 1, r = lane & 31, hh = lane >> 5;
            f32x16 cb[2];
#pragma unroll
            for (int j = 0; j < 2; ++j) {
                cb[j] = (f32x16){0.f, 0.f, 0.f, 0.f, 0.f, 0.f, 0.f, 0.f, 0.f, 0.f, 0.f, 0.f, 0.f, 0.f, 0.f, 0.f};
                const int s0 = 64 * nh + 32 * j;
                if (s0 <= 32 * mt + 31) {
#pragma unroll
                    for (int ks = 0; ks < 8; ++ks) {
                        const bf16x8 af = lds_frag(L + L_CS, 32 * mt + r, 16 * ks + 8 * hh), bfg = lds_frag(L + L_BS, s0 + r, 16 * ks + 8 * hh);
                        cb[j] = __builtin_amdgcn_mfma_f32_32x32x16_bf16(af, bfg, cb[j], 0, 0, 0);
                    }
                }
            }
            __syncthreads();
#pragma unroll
            for (int j = 0; j < 2; ++j) {
                const int s = 64 * nh + 32 * j + r; const float as = acum[s], ds = dtv[s];
#pragma unroll
                for (int i = 0; i < 16; ++i) { const int t = 32 * mt + 8 * (i >> 2) + 4 * hh + (i & 3);
                    const float v = (s <= t) ? cb[j][i] * __expf(acum[t] - as) * ds : 0.f;
                    *(LAS bf16*)(L + L_BS + (t * SP + s) * 2) = (bf16)f2bfh(v); }
            }
            __syncthreads();
            if (w < 4) {
                f32x16 yd = {0.f, 0.f, 0.f, 0.f, 0.f, 0.f, 0.f, 0.f, 0.f, 0.f, 0.f, 0.f, 0.f, 0.f, 0.f, 0.f}, yo = yd;
                for (int ks = 0; ks < 2 * (w + 1); ++ks) {
                    const bf16x8 af = lds_frag(L + L_BS, 32 * w + r, 16 * ks + 8 * hh), bfg = lds_frag(L + L_XT, r, 16 * ks + 8 * hh);
                    yd = __builtin_amdgcn_mfma_f32_32x32x16_bf16(af, bfg, yd, 0, 0, 0);
                }
                LAS unsigned char* stc = L + L_ST + (c & 1) * (32 * SP * 2);
#pragma unroll
                for (int ks = 0; ks < 8; ++ks) {
                    const bf16x8 af = lds_frag(L + L_CS, 32 * w + r, 16 * ks + 8 * hh), bfg = lds_frag(stc, r, 16 * ks + 8 * hh);
                    yo = __builtin_amdgcn_mfma_f32_32x32x16_bf16(af, bfg, yo, 0, 0, 0);
                }
#pragma unroll
                for (int q = 0; q < 4; ++q) {
                    const int t0 = 32 * w + 8 * q + 4 * hh;
                    const u32x2 xx = *(const LAS u32x2*)(L + L_XT + (r * SP + t0) * 2);
                    const float xv[4] = {bflo(xx.x), bfhi(xx.x), bflo(xx.y), bfhi(xx.y)};
#pragma unroll
                    for (int e = 0; e < 4; ++e) { const int t = t0 + e, i = 4 * q + e;
                        bf16* zp = U + (rowbase + t) * LDE + EZ + h * 64 + ph * 32 + r;
                        const float z = bf2f(*zp);
                        const float y = yd[i] + __expf(acum[t]) * yo[i] + dsk * xv[e];
                        *zp = (bf16)f2bfh(y * siluf(z)); }
                }
            } else {
                const int n0 = 32 * (w - 4); const float dec = __expf(acum[127]);
#pragma unroll
                for (int i = 0; i < 16; ++i) state[i] *= dec;
#pragma unroll
                for (int ks = 0; ks < 8; ++ks) {
                    const bf16x8 af = lds_frag(L + L_XS, r, 16 * ks + 8 * hh), bfg = lds_frag(L + L_BT, n0 + r, 16 * ks + 8 * hh);
                    state = __builtin_amdgcn_mfma_f32_32x32x16_bf16(af, bfg, state, 0, 0, 0);
                }
                LAS unsigned char* stn = L + L_ST + ((c + 1) & 1) * (32 * SP * 2);
#pragma unroll
                for (int i = 0; i < 16; ++i) { const int p = 8 * (i >> 2) + 4 * hh + (i & 3);
                    *(LAS bf16*)(stn + (p * SP + n0 + r) * 2) = (bf16)f2bfh(state[i]); }
            }
            __syncthreads();
        }
    }
}

typedef short s16x4 __attribute__((ext_vector_type(4)));
__device__ __forceinline__ s16x4 lds_tr16(LAS unsigned char* p) { return __builtin_bit_cast(s16x4, __builtin_amdgcn_ds_read_tr16_b64_v4i16((LAS s16x4*)p)); }
__device__ __forceinline__ int t5_bucket_dev(int d) {
    if (d < 16) return d;
    const int v = 16 + (int)(log((double)d / 16.0) / log(8.0) * 16.0);
    return v < 31 ? v : 31;
}
constexpr int D_SEL = 131072, D_LUT = 135168, VP = 72;
__device__ __forceinline__ int okey(float f) { const int iv = __builtin_bit_cast(int, f); return iv ^ ((iv >> 31) & 0x7fffffff); }

__device__ __forceinline__ void p_dsa(Frame& F, const Args& A) {
    bf16* U = (bf16*)(F.ws + WS_U); bf16* HB = (bf16*)(F.ws + WS_HB);
    const int w = F.wave;
    const float* ng = A.in[10];
    LAS unsigned char* L = F.lds;
    LAS float* LUT = (LAS float*)(L + D_LUT);
    for (int i = F.tid; i < 1024; i += NTHR) LUT[i] = A.in[1][t5_bucket_dev(i >> 3) * 8 + (i & 7)];
    __syncthreads();
    for (int blk = F.bid; blk < MTOK / 8; blk += F.G) {
        int lane = F.lane; asm volatile("" : "+v"(lane));
        const int kr = blk >> 8, cc = blk & 255, b = kr >> 1, tb = (kr & 1) ? 511 - cc : cc, t0 = tb * 8;
        const size_t bat = (size_t)b * SEQ, rowb = bat + t0;
        {
            const size_t row = rowb + w;
            const u32x4 v = *(const u32x4*)(U + row * LDE + EZ + 8 * lane);
            float f[8] = {bflo(v.x), bfhi(v.x), bflo(v.y), bfhi(v.y), bflo(v.z), bfhi(v.z), bflo(v.w), bfhi(v.w)};
            float s = 0.f;
#pragma unroll
            for (int j = 0; j < 8; ++j) s += f[j] * f[j];
#pragma unroll
            for (int o = 1; o < 32; o <<= 1) s += __shfl_xor(s, o);
            const float rs = 1.f / sqrtf(s * (1.f / 256.f) + NORM_EPS); const float* g = ng + 8 * lane;
            u32x4 o; o.x = pk2(f[0] * rs * g[0], f[1] * rs * g[1]); o.y = pk2(f[2] * rs * g[2], f[3] * rs * g[3]); o.z = pk2(f[4] * rs * g[4], f[5] * rs * g[5]); o.w = pk2(f[6] * rs * g[6], f[7] * rs * g[7]);
            *(u32x4*)(HB + row * DM + 8 * lane) = o;
        }
        {
            const int r = lane & 31, hh = lane >> 5;
            bf16x8 qa[4];
#pragma unroll
            for (int ks = 0; ks < 4; ++ks) qa[ks] = *(const bf16x8*)(U + (rowb + (r >> 2)) * LDE + EIQ + (r & 3) * 64 + 16 * ks + 8 * hh);
            float wv[4][4];
#pragma unroll
            for (int q = 0; q < 4; ++q) { const u32x2 ww = *(const u32x2*)(U + (rowb + 2 * q + hh) * LDE + EIW); wv[q][0] = bflo(ww.x); wv[q][1] = bfhi(ww.x); wv[q][2] = bflo(ww.y); wv[q][3] = bfhi(ww.y); }
            const int ntile = (t0 + 8 + 31) >> 5;
            for (int tb = w; tb < ntile; tb += 4 * NWAVES) {
                bf16x8 kf[4][4];
#pragma unroll
                for (int u4 = 0; u4 < 4; ++u4) { const int tl = tb + 8 * u4 < 128 ? tb + 8 * u4 : 127; const int key = 32 * tl + r;
#pragma unroll
                    for (int ks = 0; ks < 4; ++ks) kf[u4][ks] = *(const bf16x8*)(U + (bat + key) * LDE + EIK + 16 * ks + 8 * hh); }
#pragma unroll
                for (int u4 = 0; u4 < 4; ++u4) {
                    const int tile = tb + 8 * u4;
                    f32x16 acc = {0.f, 0.f, 0.f, 0.f, 0.f, 0.f, 0.f, 0.f, 0.f, 0.f, 0.f, 0.f, 0.f, 0.f, 0.f, 0.f};
#pragma unroll
                    for (int ks = 0; ks < 4; ++ks) acc = __builtin_amdgcn_mfma_f32_32x32x16_bf16(qa[ks], kf[u4][ks], acc, 0, 0, 0);
                    if (tile < ntile) {
#pragma unroll
                        for (int q = 0; q < 4; ++q) {
                            const float sc = wv[q][0] * fmaxf(acc[4 * q], 0.f) + wv[q][1] * fmaxf(acc[4 * q + 1], 0.f) + wv[q][2] * fmaxf(acc[4 * q + 2], 0.f) + wv[q][3] * fmaxf(acc[4 * q + 3], 0.f);
                            *(LAS float*)(L + ((2 * q + hh) * 4096 + 32 * tile + r) * 4) = sc + 0.f;
                        }
                    }
                }
            }
        }
        __syncthreads();
        const int t = t0 + w, n = t + 1;
        LAS unsigned short* sel = (LAS unsigned short*)(L + D_SEL) + w * 256;
        const int cnt = n < 256 ? n : 256;
        if (n <= 256) {
#pragma unroll
            for (int i = 0; i < 4; ++i) { const int s = lane + 64 * i; sel[s] = (unsigned short)(s < n ? s : 0); }
        } else {
            const int nj = (t0 + 8 + 63) >> 6;
            const LAS float* myrow = (const LAS float*)(L + w * 16384);
            int v[64]; int vmax = (int)0x80000000, vmin = 0x7fffffff;
#pragma unroll
            for (int jb = 0; jb < 4; ++jb) {
                if (16 * jb < nj) {
#pragma unroll
                    for (int jj = 0; jj < 16; ++jj) { const int j = 16 * jb + jj; const int idx = lane + 64 * j; const int kv = okey(myrow[idx]);
                        const bool ok = idx <= t; v[j] = ok ? kv : (int)0x80000000; vmax = v[j] > vmax ? v[j] : vmax; const int x = ok ? kv : 0x7fffffff; vmin = x < vmin ? x : vmin; }
                } else {
#pragma unroll
                    for (int jj = 0; jj < 16; ++jj) v[16 * jb + jj] = (int)0x80000000;
                }
            }
#pragma unroll
            for (int o = 1; o < 64; o <<= 1) { const int x = __shfl_xor(vmax, o); vmax = x > vmax ? x : vmax; const int y = __shfl_xor(vmin, o); vmin = y < vmin ? y : vmin; }
            vmax = __builtin_amdgcn_readfirstlane(vmax); vmin = __builtin_amdgcn_readfirstlane(vmin);
            int lo = vmin, hi = vmax, clo = n, chi = 0, it = 0;
            for (int rps = 0; rps < (REP_PART == 4 ? A.rep : 1); ++rps) { lo = vmin; hi = vmax; clo = n; chi = 0; it = 0;
            while (lo < hi) {
                int mid;
                const int ph3 = it % 3;
                if (ph3 == 2) mid = lo + (int)(((long long)hi - (long long)lo + 1) >> 1);
                else {
                    const float lof = __builtin_bit_cast(float, lo >= 0 ? lo : lo ^ 0x7fffffff), hif = __builtin_bit_cast(float, hi >= 0 ? hi : hi ^ 0x7fffffff);
                    const float fr = ph3 == 0 ? ((float)(clo - 256) + 0.5f) / (float)(clo - chi) : 0.5f;
                    mid = okey(lof + (hif - lof) * fr);
                    mid = mid > hi ? hi : mid; mid = mid <= lo ? lo + 1 : mid;
                }
                int c = 0;
#pragma unroll
                for (int jb = 0; jb < 4; ++jb) if (16 * jb < nj) {
#pragma unroll
                    for (int jj = 0; jj < 16; ++jj) c += __popcll(__ballot(v[16 * jb + jj] >= mid)); }
                ++it;
                if (c == 256) { lo = mid; break; }
                if (c > 256) { lo = mid; clo = c; } else { hi = mid - 1; chi = c; }
            } }
            const int T = lo;
            int cgt = 0;
#pragma unroll
            for (int jb = 0; jb < 4; ++jb) if (16 * jb < nj) {
#pragma unroll
                for (int jj = 0; jj < 16; ++jj) cgt += __popcll(__ballot(v[16 * jb + jj] > T)); }
            const int need_eq = 256 - cgt;
            int obase = 0, ebase = 0;
            for (int rpf = 0; rpf < (REP_PART == 5 ? A.rep : 1); ++rpf) { obase = 0; ebase = 0;
#pragma unroll
            for (int jb = 0; jb < 4; ++jb) if (16 * jb < nj) {
#pragma unroll
                for (int jj = 0; jj < 16; ++jj) { const int j = 16 * jb + jj;
                    const bool gt = v[j] > T, eq = v[j] == T;
                    const unsigned long long be = __ballot(eq);
                    const int erank = ebase + (int)__builtin_amdgcn_mbcnt_hi((unsigned)(be >> 32), __builtin_amdgcn_mbcnt_lo((unsigned)be, 0u));
                    const bool take = gt || (eq && erank < need_eq);
                    const unsigned long long bt = __ballot(take);
                    const int pos = obase + (int)__builtin_amdgcn_mbcnt_hi((unsigned)(bt >> 32), __builtin_amdgcn_mbcnt_lo((unsigned)bt, 0u));
                    if (take && pos < 256) sel[pos] = (unsigned short)(lane + 64 * j);
                    obase += __popcll(bt); ebase += __popcll(be); } } }
        }
        __syncthreads();
        {
            const int hd = lane & 15, g4 = lane >> 4;
            const size_t row = rowb + w;
            bf16x8 qb[2];
            {
                float qf[2][8]; float ss = 0.f;
#pragma unroll
                for (int ks = 0; ks < 2; ++ks) { u32x4 qq = (u32x4){0u, 0u, 0u, 0u};
                    if (hd < 8) qq = *(const u32x4*)(U + row * LDE + EQ + hd * 64 + 32 * ks + 8 * g4);
                    qf[ks][0] = bflo(qq.x); qf[ks][1] = bfhi(qq.x); qf[ks][2] = bflo(qq.y); qf[ks][3] = bfhi(qq.y); qf[ks][4] = bflo(qq.z); qf[ks][5] = bfhi(qq.z); qf[ks][6] = bflo(qq.w); qf[ks][7] = bfhi(qq.w);
#pragma unroll
                    for (int j = 0; j < 8; ++j) ss += qf[ks][j] * qf[ks][j]; }
                ss += __shfl_xor(ss, 16); ss += __shfl_xor(ss, 32);
                const float rs = 0.125f / sqrtf(ss * (1.f / 64.f) + NORM_EPS);
#pragma unroll
                for (int ks = 0; ks < 2; ++ks) { const float* gq = A.in[11] + 32 * ks + 8 * g4;
                    u32x4 pk; pk.x = pk2(qf[ks][0] * rs * gq[0], qf[ks][1] * rs * gq[1]); pk.y = pk2(qf[ks][2] * rs * gq[2], qf[ks][3] * rs * gq[3]);
                    pk.z = pk2(qf[ks][4] * rs * gq[4], qf[ks][5] * rs * gq[5]); pk.w = pk2(qf[ks][6] * rs * gq[6], qf[ks][7] * rs * gq[7]);
                    qb[ks] = __builtin_bit_cast(bf16x8, pk); }
            }
            float lg[16][4]; float mx = -3.0e38f;
            const int vsl = lane >> 3, vpart = lane & 7;
            u32x4 vr[2][8];
            bf16x8 ka[16][2];
#pragma unroll
            for (int T = 0; T < 16; ++T) { const int sm = sel[16 * T + hd]; const bf16* kp = U + (bat + sm) * LDE + EK + 8 * g4;
                ka[T][0] = *(const bf16x8*)kp; ka[T][1] = *(const bf16x8*)(kp + 32); }
#pragma unroll
            for (int e = 0; e < 8; ++e) { const int sm = sel[8 * e + vsl]; vr[0][e] = *(const u32x4*)(U + (bat + sm) * LDE + EV + 8 * vpart); }
#pragma unroll
            for (int T = 0; T < 16; ++T) {
                f32x4 acc = {0.f, 0.f, 0.f, 0.f};
                acc = __builtin_amdgcn_mfma_f32_16x16x32_bf16(ka[T][0], qb[0], acc, 0, 0, 0);
                acc = __builtin_amdgcn_mfma_f32_16x16x32_bf16(ka[T][1], qb[1], acc, 0, 0, 0);
                const u32x2 sl = *(const LAS u32x2*)(sel + 16 * T + 4 * g4);
                const int s4[4] = {(int)(sl.x & 0xffffu), (int)(sl.x >> 16), (int)(sl.y & 0xffffu), (int)(sl.y >> 16)};
#pragma unroll
                for (int i = 0; i < 4; ++i) { int dist = t - s4[i]; dist = dist < 0 ? 0 : (dist > 127 ? 127 : dist);
                    const float bia = LUT[dist * 8 + (hd & 7)];
                    const bool valid = (16 * T + 4 * g4 + i) < cnt;
                    lg[T][i] = valid ? acc[i] + bia : -3.0e38f; mx = fmaxf(mx, lg[T][i]); }
            }
#pragma unroll
            for (int e = 0; e < 8; ++e) { const int sm = sel[64 + 8 * e + vsl]; vr[1][e] = *(const u32x4*)(U + (bat + sm) * LDE + EV + 8 * vpart); }
            mx = fmaxf(mx, __shfl_xor(mx, 16)); mx = fmaxf(mx, __shfl_xor(mx, 32));
            float sum = 0.f;
#pragma unroll
            for (int T = 0; T < 16; ++T)
#pragma unroll
                for (int i = 0; i < 4; ++i) { const float p = lg[T][i] > -1.0e38f ? __expf(lg[T][i] - mx) : 0.f; lg[T][i] = p; sum += p; }
            sum += __shfl_xor(sum, 16); sum += __shfl_xor(sum, 32);
            const float inv = 1.f / fmaxf(sum, 1e-30f);
            f32x4 oacc[4];
#pragma unroll
            for (int dt = 0; dt < 4; ++dt) oacc[dt] = (f32x4){0.f, 0.f, 0.f, 0.f};
            LAS unsigned char* Vl = L + w * 16384;
#pragma unroll
            for (int ch = 0; ch < 4; ++ch) {
                LDS_WAIT();
#pragma unroll
                for (int e = 0; e < 8; ++e) *(LAS u32x4*)(Vl + ((8 * e + vsl) * VP + 8 * vpart) * 2) = vr[ch & 1][e];
                if (ch + 2 < 4) {
#pragma unroll
                    for (int e = 0; e < 8; ++e) { const int sm = sel[64 * (ch + 2) + 8 * e + vsl]; vr[ch & 1][e] = *(const u32x4*)(U + (bat + sm) * LDE + EV + 8 * vpart); }
                }
                LDS_WAIT();
#pragma unroll
                for (int kk = 0; kk < 2; ++kk) {
                    const int T0 = 2 * (2 * ch + kk);
                    u32x4 pp; pp.x = pk2(lg[T0][0] * inv, lg[T0][1] * inv); pp.y = pk2(lg[T0][2] * inv, lg[T0][3] * inv); pp.z = pk2(lg[T0 + 1][0] * inv, lg[T0 + 1][1] * inv); pp.w = pk2(lg[T0 + 1][2] * inv, lg[T0 + 1][3] * inv);
                    const bf16x8 pf = __builtin_bit_cast(bf16x8, pp);
                    const int qq = (lane & 15) >> 2, p4 = lane & 3;
#pragma unroll
                    for (int dt = 0; dt < 4; ++dt) {
                        const s16x4 b0 = lds_tr16(Vl + ((32 * kk + 4 * g4 + qq) * VP + 16 * dt + 4 * p4) * 2);
                        const s16x4 b1 = lds_tr16(Vl + ((32 * kk + 16 + 4 * g4 + qq) * VP + 16 * dt + 4 * p4) * 2);
                        bf16x8 bfg; bfg[0] = b0[0]; bfg[1] = b0[1]; bfg[2] = b0[2]; bfg[3] = b0[3]; bfg[4] = b1[0]; bfg[5] = b1[1]; bfg[6] = b1[2]; bfg[7] = b1[3];
                        oacc[dt] = __builtin_amdgcn_mfma_f32_16x16x32_bf16(pf, bfg, oacc[dt], 0, 0, 0);
                    }
                }
            }
            if (g4 < 2) {
#pragma unroll
                for (int i = 0; i < 4; ++i)
#pragma unroll
                    for (int dt = 0; dt < 4; ++dt) HB[row * DM + 512 + (4 * g4 + i) * 64 + 16 * dt + hd] = (bf16)f2bfh(oacc[dt][i]);
            }
        }
        __syncthreads();
    }
}

template <int MODE> __device__ __forceinline__ void p_norm_route(Frame& F, const float* xin, const float* gain, int layer) {
    constexpr int NT = MODE == 0 ? 3 : 2;
    bf16* HB = (bf16*)(F.ws + WS_HB); const bf16* WR = MODE == 0 ? (const bf16*)(F.ws + WS_WR) + (size_t)layer * 48 * 1024 : (const bf16*)(F.ws + WS_WGL);
    float* GL = (float*)(F.ws + WS_GL);
    int* list = (int*)(F.ws + WS_LIST); float* wl = (float*)(F.ws + WS_LISTW);
    LAS unsigned char* L = F.lds;
    LAS float* lgt = (LAS float*)L + F.wave * (16 * 48);
    LAS int* cntl = (LAS int*)(L + 32768); LAS int* basel = (LAS int*)(L + 33024);
    LAS int* ri_e = (LAS int*)(L + 34816); LAS int* ri_p = (LAS int*)(L + 36864); LAS float* ri_w = (LAS float*)(L + 38912);
    const int w = F.wave;
    for (int base = F.bid * 256; base < MTOK; base += F.G * 256) {
        int lane = F.lane; asm volatile("" : "+v"(lane));
        if (F.tid < 64) cntl[F.tid] = 0;
        __syncthreads();
#pragma unroll 1
        for (int half = 0; half < 2; ++half) {
            const int R0 = base + w * 32 + half * 16;
#pragma unroll 1
            for (int i = 0; i < 16; ++i) rms_row_to_bf16(xin + (size_t)(R0 + i) * DM, gain, HB + (size_t)(R0 + i) * DM, lane);
            VM_WAIT();
            const int n16 = lane & 15, g4 = lane >> 4;
            f32x4 acc[NT];
#pragma unroll
            for (int nt = 0; nt < NT; ++nt) acc[nt] = (f32x4){0.f, 0.f, 0.f, 0.f};
#pragma unroll 4
            for (int kk = 0; kk < 32; ++kk) {
                const bf16x8 a = *(const bf16x8*)(HB + (size_t)(R0 + n16) * DM + 32 * kk + 8 * g4);
#pragma unroll
                for (int nt = 0; nt < NT; ++nt) { const bf16x8 bb = *(const bf16x8*)(WR + (size_t)(16 * nt + n16) * DM + 32 * kk + 8 * g4);
                    acc[nt] = __builtin_amdgcn_mfma_f32_16x16x32_bf16(a, bb, acc[nt], 0, 0, 0); }
            }
            if constexpr (MODE == 1) {
#pragma unroll
                for (int nt = 0; nt < NT; ++nt)
#pragma unroll
                    for (int i = 0; i < 4; ++i) if (16 * nt + n16 < 24) GL[(size_t)(R0 + 4 * g4 + i) * 24 + 16 * nt + n16] = acc[nt][i];
            } else {
#pragma unroll
            for (int nt = 0; nt < NT; ++nt)
#pragma unroll
                for (int i = 0; i < 4; ++i) lgt[(4 * g4 + i) * 48 + 16 * nt + n16] = acc[nt][i];
            LDS_WAIT();
            if (lane < 16) {
                const LAS float* lr = lgt + lane * 48;
                int gs = 0; float gm = lr[0];
#pragma unroll
                for (int j = 1; j < 4; ++j) if (lr[j] > gm) { gm = lr[j]; gs = j; }
                float gsum = 0.f;
#pragma unroll
                for (int j = 0; j < 4; ++j) gsum += __expf(lr[j] - gm);
                const float gw = 1.f / gsum;
                const LAS float* er = lr + 4 + 8 * gs;
                int i0 = 0; float m0 = er[0];
#pragma unroll
                for (int j = 1; j < 8; ++j) if (er[j] > m0) { m0 = er[j]; i0 = j; }
                int i1 = -1; float m1 = -3.0e38f;
#pragma unroll
                for (int j = 0; j < 8; ++j) if (j != i0 && er[j] > m1) { m1 = er[j]; i1 = j; }
                const float w0 = 1.f / (1.f + __expf(m1 - m0));
                const int e0 = gs * 8 + i0, e1 = 32 + gs * 8 + i1;
                const int rs = (w * 32 + half * 16 + lane) * 2;
                ri_e[rs] = e0; ri_p[rs] = __hip_atomic_fetch_add(cntl + e0, 1, __ATOMIC_RELAXED, __HIP_MEMORY_SCOPE_WORKGROUP); ri_w[rs] = w0 * gw;
                ri_e[rs + 1] = e1; ri_p[rs + 1] = __hip_atomic_fetch_add(cntl + e1, 1, __ATOMIC_RELAXED, __HIP_MEMORY_SCOPE_WORKGROUP); ri_w[rs + 1] = (1.f - w0) * gw;
            }
            LDS_WAIT();
            }
        }
        if constexpr (MODE == 1) continue;
        __syncthreads();
        if (F.tid < 64) { const int c = cntl[F.tid]; basel[F.tid] = c ? (int)__hip_atomic_fetch_add((unsigned*)(F.ctl + CW_CNT + layer * 4096 + 64 * F.tid), (unsigned)c, RLX_AGENT) : 0; }
        __syncthreads();
        { const int rs = F.tid, e = ri_e[rs], pos = basel[e] + ri_p[rs];
          list[(size_t)e * 65536 + pos] = base + (rs >> 1); wl[(size_t)e * 65536 + pos] = ri_w[rs]; }
        __syncthreads();
    }
}
__device__ __forceinline__ void moe_tables(Frame& F, int layer) {
    LAS int* ptile = (LAS int*)(F.lds + MOE_OFF); LAS int* cntv = ptile + 128;
    __syncthreads();
    if (F.tid < 64) {
        const int c = (int)__hip_atomic_load((unsigned*)(F.ctl + CW_CNT + layer * 4096 + 64 * F.tid), RLX_AGENT);
        cntv[F.tid] = c;
        int nt = (c + 255) >> 8, incl = nt;
#pragma unroll
        for (int o = 1; o < 64; o <<= 1) { const int t = __shfl_up(incl, o); if (F.lane >= o) incl += t; }
        ptile[F.tid] = incl - nt; if (F.tid == 63) ptile[64] = incl;
    }
    __syncthreads();
}
__device__ __forceinline__ void p_moe_gu(Frame& F, int layer) {
    moe_tables(F, layer);
    const LAS int* ptile = (const LAS int*)(F.lds + MOE_OFF); const LAS int* cntv = ptile + 128;
    pg8::MoeOrder S{(const char*)(F.ws + WS_HB), (const char*)(F.ws + WS_WGU) + (size_t)layer * 32 * 1024 * 1024 * 2, (size_t)1024 * 1024 * 2, 1024, F.G, F.bid, 0, ptile[64], ptile, cntv, (const int*)(F.ws + WS_LIST), true};
    pg8::EpiSwiGLU E{(bf16*)(F.ws + WS_U)};
    pg8::gemm_phase<pg8::EpiSwiGLU, pg8::MoeOrder, true>(F.lds, 1024, S, E);
}
__device__ __forceinline__ void p_moe_down(Frame& F, int layer, int slot) {
    moe_tables(F, layer);
    const LAS int* ptile = (const LAS int*)(F.lds + MOE_OFF); const LAS int* cntv = ptile + 128;
    pg8::MoeOrder S{(const char*)(F.ws + WS_U), (const char*)(F.ws + WS_WD) + (size_t)layer * 32 * 1024 * 512 * 2, (size_t)1024 * 512 * 2, 512, F.G, F.bid, ptile[32 * slot], ptile[32 * slot + 32], ptile, cntv, (const int*)(F.ws + WS_LIST), false};
    pg8::EpiScatter E{F.out, (const int*)(F.ws + WS_LIST), (const float*)(F.ws + WS_LISTW), cntv};
    pg8::gemm_phase<pg8::EpiScatter, pg8::MoeOrder, true>(F.lds, 512, S, E);
}

__device__ __forceinline__ void p_compress(Frame& F, const Args& A) {
    bf16* U = (bf16*)(F.ws + WS_U);
    LAS unsigned char* L = F.lds;
    const int w = F.wave;
    {
        const int tid = F.tid, sub = tid & 15;
        for (int v0 = F.bid * 32; v0 < MTOK * 4; v0 += F.G * 32) {
            const int vec = v0 + (tid >> 4), row = vec >> 2, wh = vec & 3;
            bf16* p = U + (size_t)row * LDO + ((wh >> 1) ? OKW : OKS) + (wh & 1) * 128 + 8 * sub;
            const float* g = ((wh >> 1) ? A.in[18] : A.in[17]) + 8 * sub;
            const u32x4 v = *(const u32x4*)p; float f[8] = {bflo(v.x), bfhi(v.x), bflo(v.y), bfhi(v.y), bflo(v.z), bfhi(v.z), bflo(v.w), bfhi(v.w)};
            float s = 0.f;
#pragma unroll
            for (int j = 0; j < 8; ++j) s += f[j] * f[j];
            s += __shfl_xor(s, 1); s += __shfl_xor(s, 2); s += __shfl_xor(s, 4); s += __shfl_xor(s, 8);
            const float rs = 1.f / sqrtf(s * (1.f / 128.f) + NORM_EPS);
            u32x4 o; o.x = pk2(f[0] * rs * g[0], f[1] * rs * g[1]); o.y = pk2(f[2] * rs * g[2], f[3] * rs * g[3]); o.z = pk2(f[4] * rs * g[4], f[5] * rs * g[5]); o.w = pk2(f[6] * rs * g[6], f[7] * rs * g[7]);
            *(u32x4*)p = o;
        }
    }
    constexpr int C_A = 0, C_B = 17408, C_H = 52224, C_S = 69632;
    for (int unit = F.bid; unit < 256; unit += F.G) {
        int tid = F.tid, lane = F.lane; asm volatile("" : "+v"(tid), "+v"(lane));
        const int T = unit >> 7, b = (unit >> 3) & 15, g = (unit >> 2) & 1, cb = unit & 3;
        const int col = (T ? OVC : OKC) + g * 128;
        const float* pos = T ? A.in[20] : A.in[19];
        const bf16* w1t = (const bf16*)(F.ws + (T ? WS_W1V : WS_W1K)); const bf16* w2t = (const bf16*)(F.ws + WS_W2) + T * 128 * 128;
        const int wm = w >> 2, wn = w & 3, r = lane & 31, hh = lane >> 5;
        f32x16 acc = {0.f, 0.f, 0.f, 0.f, 0.f, 0.f, 0.f, 0.f, 0.f, 0.f, 0.f, 0.f, 0.f, 0.f, 0.f, 0.f};
#pragma unroll 1
        for (int l = 0; l < 32; ++l) {
            __syncthreads();
#pragma unroll
            for (int e = 0; e < 2; ++e) { const int q = tid + 512 * e, c = q >> 4, part = q & 15; const int tok = 16 * (64 * cb + c) + l;
                u32x4 v = (u32x4){0u, 0u, 0u, 0u};
                if (tok < SEQ) v = *(const u32x4*)(U + ((size_t)b * SEQ + tok) * LDO + col + 8 * part);
                const f32x4 p0 = *(const f32x4*)(pos + l * 128 + 8 * part), p1 = *(const f32x4*)(pos + l * 128 + 8 * part + 4);
                u32x4 o; o.x = pk2(bflo(v.x) + p0.x, bfhi(v.x) + p0.y); o.y = pk2(bflo(v.y) + p0.z, bfhi(v.y) + p0.w); o.z = pk2(bflo(v.z) + p1.x, bfhi(v.z) + p1.y); o.w = pk2(bflo(v.w) + p1.z, bfhi(v.w) + p1.w);
                *(LAS u32x4*)(L + C_A + (c * SP + 8 * part) * 2) = o; }
#pragma unroll
            for (int e = 0; e < 4; ++e) { const int q = tid + 512 * e, j = q >> 4, part = q & 15;
                *(LAS u32x4*)(L + C_B + (j * SP + 8 * part) * 2) = *(const u32x4*)(w1t + (size_t)j * 4096 + l * 128 + 8 * part); }
            __syncthreads();
#pragma unroll
            for (int ks = 0; ks < 8; ++ks) {
                const bf16x8 af = lds_frag(L + C_A, 32 * wm + r, 16 * ks + 8 * hh), bfg = lds_frag(L + C_B, 32 * wn + r, 16 * ks + 8 * hh);
                acc = __builtin_amdgcn_mfma_f32_32x32x16_bf16(af, bfg, acc, 0, 0, 0);
            }
        }
#pragma unroll
        for (int i = 0; i < 16; ++i) { const int c = 32 * wm + 8 * (i >> 2) + 4 * hh + (i & 3);
            *(LAS bf16*)(L + C_H + (c * SP + 32 * wn + r) * 2) = (bf16)f2bfh(siluf(acc[i])); }
        __syncthreads();
        f32x16 a2 = {0.f, 0.f, 0.f, 0.f, 0.f, 0.f, 0.f, 0.f, 0.f, 0.f, 0.f, 0.f, 0.f, 0.f, 0.f, 0.f};
#pragma unroll
        for (int ks = 0; ks < 8; ++ks) {
            const bf16x8 af = lds_frag(L + C_H, 32 * wm + r, 16 * ks + 8 * hh), bfg = *(const bf16x8*)(w2t + (size_t)(32 * wn + r) * 128 + 16 * ks + 8 * hh);
            a2 = __builtin_amdgcn_mfma_f32_32x32x16_bf16(af, bfg, a2, 0, 0, 0);
        }
        float rsv[16];
        if (T == 0) {
            LAS float* st = (LAS float*)(L + C_S);
#pragma unroll
            for (int i = 0; i < 16; ++i) { float q = a2[i] * a2[i];
                q += __shfl_xor(q, 1); q += __shfl_xor(q, 2); q += __shfl_xor(q, 4); q += __shfl_xor(q, 8); q += __shfl_xor(q, 16);
                if (r == 0) st[(32 * wm + 8 * (i >> 2) + 4 * hh + (i & 3)) * 4 + wn] = q; }
            __syncthreads();
#pragma unroll
            for (int i = 0; i < 16; ++i) { const f32x4 q = *(const LAS f32x4*)(st + (32 * wm + 8 * (i >> 2) + 4 * hh + (i & 3)) * 4);
                rsv[i] = A.in[16][32 * wn + r] / sqrtf((q.x + q.y + q.z + q.w) * (1.f / 128.f) + NORM_EPS); }
        } else {
#pragma unroll
            for (int i = 0; i < 16; ++i) rsv[i] = 1.f;
        }
        bf16* dst = (bf16*)(F.ws + (T ? WS_VCMP : WS_KCMP));
#pragma unroll
        for (int i = 0; i < 16; ++i) { const int c = 64 * cb + 32 * wm + 8 * (i >> 2) + 4 * hh + (i & 3);
            dst[(((size_t)b * 256 + c) * 2 + g) * 128 + 32 * wn + r] = (bf16)f2bfh(a2[i] * rsv[i]); }
    }
}

constexpr int N_STG = 37888;
constexpr int N_K = 0, N_V = 17408, N_LUT = 2 * N_STG, N_IMP = N_LUT + 4096, N_FAC = N_IMP + 16384, N_MSK = N_FAC + 1024, N_UNI = N_MSK + 512, N_CST = N_UNI + 64;
constexpr int VPN = 160;
constexpr float LOG2E = 1.44269504f;
enum { BR_CMP = 0, BR_SEL = 1, BR_WIN = 2 };
struct NsaCtx {
    LAS unsigned char* L; const bf16* U; const bf16* KC; const bf16* VC;
    int tid, lane, w, r, hh, b, g, qblk, t0, t, head; size_t bat;
    float mrow, cfar; unsigned mlo, mhi;
};
template <int BR, bool SUM, bool PV, bool IMP>
__device__ __forceinline__ void nsa_pass(const NsaCtx& X, const bf16x8 (&qf)[8], f32x16 (&oacc)[4], float& lsum, const float colfac, const int tlo, const int thi, const unsigned long long tmask) {
    LAS unsigned char* L = X.L; const int tid = X.tid, r = X.r, hh = X.hh;
    const LAS float* LUT = (const LAS float*)(L + N_LUT);
    const int rr0 = tid >> 4, part = tid & 15;
    u32x4 kreg[2], vreg[2];
    auto issue = [&](int tl) {
#pragma unroll
        for (int e = 0; e < 2; ++e) { const int rr = rr0 + 32 * e;
            const bf16* kp; const bf16* vp;
            if (BR == BR_CMP) { const size_t o = (((size_t)X.b * 256 + 64 * tl + rr) * 2 + X.g) * 128 + 8 * part; kp = X.KC + o; vp = X.VC + o; }
            else { const size_t o = (X.bat + 64 * tl + rr) * LDO + X.g * 128 + 8 * part; kp = X.U + o + (BR == BR_SEL ? OKS : OKW); vp = X.U + o + (BR == BR_SEL ? OVS : OVW); }
            kreg[e] = *(const u32x4*)kp; if (PV) vreg[e] = *(const u32x4*)vp; }
    };
    auto put = [&](int st) {
#pragma unroll
        for (int e = 0; e < 2; ++e) { const int rr = rr0 + 32 * e;
            *(LAS u32x4*)(L + st * N_STG + N_K + (rr * SP + 8 * part) * 2) = kreg[e]; if (PV) *(LAS u32x4*)(L + st * N_STG + N_V + (rr * VPN + 8 * part) * 2) = vreg[e]; }
    };
    auto nextt = [&](int tl) { ++tl; while (tl <= thi && !((tmask >> tl) & 1ull)) ++tl; return tl; };
    int tile = nextt(tlo - 1);
    if (tile > thi) return;
    issue(tile); put(0);
    int nxt = nextt(tile); if (nxt <= thi) issue(nxt);
    int cur = 0;
    while (tile <= thi) {
        __syncthreads();
        LAS unsigned char* Ls = L + cur * N_STG;
        f32x16 sacc[2];
#pragma unroll
        for (int mt = 0; mt < 2; ++mt) { sacc[mt] = (f32x16){0.f, 0.f, 0.f, 0.f, 0.f, 0.f, 0.f, 0.f, 0.f, 0.f, 0.f, 0.f, 0.f, 0.f, 0.f, 0.f};
#pragma unroll
            for (int ks = 0; ks < 8; ++ks) sacc[mt] = __builtin_amdgcn_mfma_f32_32x32x16_bf16(lds_frag(Ls + N_K, 32 * mt + r, 16 * ks + 8 * hh), qf[ks], sacc[mt], 0, 0, 0); }
        const int maxpos = BR == BR_CMP ? 16 * (64 * tile + 63) + 31 : 64 * tile + 63, minpos = BR == BR_CMP ? 16 * (64 * tile) + 31 : 64 * tile;
        const bool far = (X.t0 - maxpos >= 113) && (BR != BR_WIN || (X.t0 + 63 - minpos < 512));
        bool selb = true; if (BR == BR_SEL) selb = (tile < 32 ? (X.mlo >> tile) : (X.mhi >> (tile - 32))) & 1u;
        if (far) {
#pragma unroll
            for (int mt = 0; mt < 2; ++mt)
#pragma unroll
                for (int i = 0; i < 16; ++i) { float p = __builtin_amdgcn_exp2f(sacc[mt][i] + X.cfar); if (BR == BR_SEL) p = selb ? p : 0.f;
                    if (SUM) lsum += p; sacc[mt][i] = p * colfac; }
        } else {
#pragma unroll
            for (int mt = 0; mt < 2; ++mt)
#pragma unroll
                for (int i = 0; i < 16; ++i) { const int kidx = 32 * mt + 8 * (i >> 2) + 4 * hh + (i & 3);
                    int dist; bool ok;
                    if (BR == BR_CMP) { dist = X.t - (16 * (64 * tile + kidx) + 31); ok = dist >= 0; }
                    else { dist = X.t - (64 * tile + kidx); ok = BR == BR_SEL ? (selb && dist >= 0) : (dist >= 0 && dist < 512); }
                    const int dc = dist < 0 ? 0 : (dist > 127 ? 127 : dist);
                    const float bia = LUT[dc * 8 + X.head];
                    const float p = ok ? __builtin_amdgcn_exp2f(sacc[mt][i] + bia - X.mrow) : 0.f;
                    if (SUM) lsum += p;
                    sacc[mt][i] = p * colfac; }
        }
        if (IMP) {
            LAS float* imp = (LAS float*)(L + N_IMP) + (X.w * 8 + (r >> 2)) * 64;
#pragma unroll
            for (int mt = 0; mt < 2; ++mt)
#pragma unroll
                for (int q = 0; q < 4; ++q) { float s4 = (sacc[mt][4 * q] + sacc[mt][4 * q + 1]) + (sacc[mt][4 * q + 2] + sacc[mt][4 * q + 3]), s3 = sacc[mt][4 * q + 3];
                    s4 += __shfl_xor(s4, 1); s4 += __shfl_xor(s4, 2); s3 += __shfl_xor(s3, 1); s3 += __shfl_xor(s3, 2);
                    const int n = 16 * tile + 8 * mt + 2 * q + hh;
                    if ((r & 3) == 0) { __hip_atomic_fetch_add(imp + n, s4, __ATOMIC_RELAXED, __HIP_MEMORY_SCOPE_WORKGROUP); if (n < 63) __hip_atomic_fetch_add(imp + n + 1, s3, __ATOMIC_RELAXED, __HIP_MEMORY_SCOPE_WORKGROUP); } }
        }
        if (PV) {
            const int cb16 = (X.lane >> 4) & 1, q4 = (X.lane & 15) >> 2, p4 = X.lane & 3;
#pragma unroll
            for (int mt = 0; mt < 2; ++mt)
#pragma unroll
                for (int sI = 0; sI < 2; ++sI) {
                    u32x4 pp; pp.x = pk2(sacc[mt][8 * sI], sacc[mt][8 * sI + 1]); pp.y = pk2(sacc[mt][8 * sI + 2], sacc[mt][8 * sI + 3]); pp.z = pk2(sacc[mt][8 * sI + 4], sacc[mt][8 * sI + 5]); pp.w = pk2(sacc[mt][8 * sI + 6], sacc[mt][8 * sI + 7]);
                    const bf16x8 pa = __builtin_bit_cast(bf16x8, pp);
                    const int row0 = 32 * mt + 16 * sI + 4 * hh + q4;
#pragma unroll
                    for (int nt = 0; nt < 4; ++nt) {
                        const s16x4 b0 = lds_tr16(Ls + N_V + (row0 * VPN + 32 * nt + 16 * cb16 + 4 * p4) * 2);
                        const s16x4 b1 = lds_tr16(Ls + N_V + ((row0 + 8) * VPN + 32 * nt + 16 * cb16 + 4 * p4) * 2);
                        bf16x8 bfg; bfg[0] = b0[0]; bfg[1] = b0[1]; bfg[2] = b0[2]; bfg[3] = b0[3]; bfg[4] = b1[0]; bfg[5] = b1[1]; bfg[6] = b1[2]; bfg[7] = b1[3];
                        oacc[nt] = __builtin_amdgcn_mfma_f32_32x32x16_bf16(pa, bfg, oacc[nt], 0, 0, 0);
                    }
                }
        }
        if (nxt <= thi) { put(cur ^ 1); const int nn = nextt(nxt); if (nn <= thi) issue(nn); tile = nxt; nxt = nn; }
        else tile = nxt;
        cur ^= 1;
    }
    __syncthreads();
}

__device__ __forceinline__ void p_nsa(Frame& F, const Args& A) {
    const bf16* U = (const bf16*)(F.ws + WS_U); bf16* HB = (bf16*)(F.ws + WS_HB); const float* GL = (const float*)(F.ws + WS_GL);
    LAS unsigned char* L = F.lds;
    LAS float* LUT = (LAS float*)(L + N_LUT); LAS float* cst = (LAS float*)(L + N_CST);
    for (int i = F.tid; i < 1024; i += NTHR) LUT[i] = A.in[1][t5_bucket_dev(i >> 3) * 8 + (i & 7)] * LOG2E;
    if (F.wave == 0) {
        float gm = 0.f, bm = 0.f;
        for (int i = F.lane; i < 128; i += 64) gm = fmaxf(gm, fmaxf(fabsf(A.in[16][i]), fmaxf(fabsf(A.in[17][i]), fabsf(A.in[18][i]))));
        for (int i = F.lane; i < 256; i += 64) bm = fmaxf(bm, fabsf(A.in[1][i]));
#pragma unroll
        for (int o = 1; o < 64; o <<= 1) { gm = fmaxf(gm, __shfl_xor(gm, o)); bm = fmaxf(bm, __shfl_xor(bm, o)); }
        if (F.lane == 0) { cst[0] = gm * 11.3137085f; cst[1] = bm * LOG2E; }
    }
    __syncthreads();
    const float kmax = cst[0], bmax = cst[1];
    for (int ui = F.bid; ui < 2048; ui += F.G) {
        NsaCtx X; X.L = L; X.U = U; X.KC = (const bf16*)(F.ws + WS_KCMP); X.VC = (const bf16*)(F.ws + WS_VCMP);
        int tid = F.tid, lane = F.lane; asm volatile("" : "+v"(tid), "+v"(lane));
        X.tid = tid; X.lane = lane; X.w = F.wave; X.r = lane & 31; X.hh = lane >> 5;
        const int kr = ui >> 8, cc = ui & 255, bg = kr * 4 + (cc >> 6);
        X.b = bg >> 1; X.g = bg & 1; X.qblk = (kr & 1) ? 63 - (cc & 63) : (cc & 63); X.t0 = 64 * X.qblk; X.bat = (size_t)X.b * SEQ;
        const int tq = X.r >> 2, hd = X.r & 3; X.t = X.t0 + 8 * X.w + tq; X.head = 4 * X.g + hd;
        const size_t row = X.bat + X.t;
        if (tid == 0) *(LAS unsigned long long*)(L + N_UNI) = 0ull;
        for (int i = tid; i < 4096; i += NTHR) ((LAS float*)(L + N_IMP))[i] = 0.f;
        bf16x8 qf[8]; float qn2 = 0.f;
        {
            u32x4 qr[8]; float ss = 0.f;
#pragma unroll
            for (int ks = 0; ks < 8; ++ks) { qr[ks] = *(const u32x4*)(U + row * LDO + OQ + X.head * 128 + 16 * ks + 8 * X.hh);
#pragma unroll
                for (int e = 0; e < 4; ++e) { const float a = bflo(qr[ks][e]), c = bfhi(qr[ks][e]); ss += a * a + c * c; } }
            ss += __shfl_xor(ss, 32);
            const float rs = 1.f / sqrtf(ss * (1.f / 128.f) + NORM_EPS);
#pragma unroll
            for (int ks = 0; ks < 8; ++ks) { const float* gq = A.in[15] + 16 * ks + 8 * X.hh; u32x4 pk;
#pragma unroll
                for (int e = 0; e < 4; ++e) { const float a = bflo(qr[ks][e]) * rs * gq[2 * e], c = bfhi(qr[ks][e]) * rs * gq[2 * e + 1]; qn2 += a * a + c * c; pk[e] = pk2(a * (0.0883883476f * LOG2E), c * (0.0883883476f * LOG2E)); }
                qf[ks] = __builtin_bit_cast(bf16x8, pk); }
            qn2 += __shfl_xor(qn2, 32);
        }
        X.mrow = sqrtf(qn2) * (0.0883883476f * LOG2E) * kmax + bmax;
        X.cfar = LUT[127 * 8 + X.head] - X.mrow;
        X.mlo = 0u; X.mhi = 0u;
        const float g_c = 1.f / (1.f + __expf(-GL[row * 24 + X.head])), g_s = 1.f / (1.f + __expf(-GL[row * 24 + 8 + X.head])), g_w = 1.f / (1.f + __expf(-GL[row * 24 + 16 + X.head]));
        f32x16 oacc[4];
#pragma unroll
        for (int nt = 0; nt < 4; ++nt) oacc[nt] = (f32x16){0.f, 0.f, 0.f, 0.f, 0.f, 0.f, 0.f, 0.f, 0.f, 0.f, 0.f, 0.f, 0.f, 0.f, 0.f, 0.f};
        const int ntc = ((4 * X.qblk + 2) >> 6) + 1;
        float l_c = 0.f;
        nsa_pass<BR_CMP, true, false, false>(X, qf, oacc, l_c, 1.f, 0, ntc - 1, ~0ull);
        l_c += __shfl_xor(l_c, 32);
        const float il_c = l_c > 0.f ? 1.f / l_c : 0.f;
        { float dummy = 0.f; nsa_pass<BR_CMP, false, false, true>(X, qf, oacc, dummy, il_c, 0, ntc - 1, ~0ull); }
        {
            LDS_WAIT();
            const LAS float* impw = (const LAS float*)(L + N_IMP) + X.w * 8 * 64;
            const int n = lane, cur = X.qblk;
            unsigned long long wor = 0ull;
#pragma unroll 1
            for (int q = 0; q < 8; ++q) {
                const float imp = impw[q * 64 + n];
                const bool forced = (n == 0) || (n == cur) || (n == cur - 1);
                float val = forced ? 3.0e38f : imp; if (n > cur) val = -3.0e38f;
                int rank = 0;
#pragma unroll 8
                for (int m = 0; m < 64; ++m) { const float vm = __shfl(val, m); rank += (vm > val || (vm == val && m < n)) ? 1 : 0; }
                const unsigned long long mk = __ballot(n <= cur && rank < 16);
                wor |= mk;
                if ((X.r >> 2) == q) { X.mlo = (unsigned)mk; X.mhi = (unsigned)(mk >> 32); }
            }
            if (lane == 0) __hip_atomic_fetch_or((LAS unsigned long long*)(L + N_UNI), wor, __ATOMIC_RELAXED, __HIP_MEMORY_SCOPE_WORKGROUP);
        }
        __syncthreads();
        const unsigned long long uni = *(const LAS unsigned long long*)(L + N_UNI);
        float l_s = 0.f;
        nsa_pass<BR_SEL, true, true, false>(X, qf, oacc, l_s, 1.f, 0, X.qblk, uni);
        l_s += __shfl_xor(l_s, 32);
        {
            LAS float* fac = (LAS float*)(L + N_FAC) + X.w * 32;
            if (lane < 32) fac[lane] = l_s > 0.f ? g_s / l_s : 0.f;
            LDS_WAIT();
#pragma unroll
            for (int q = 0; q < 4; ++q) { const f32x4 fr = *(const LAS f32x4*)(fac + 8 * q + 4 * X.hh);
#pragma unroll
                for (int nt = 0; nt < 4; ++nt) { oacc[nt][4 * q] *= fr.x; oacc[nt][4 * q + 1] *= fr.y; oacc[nt][4 * q + 2] *= fr.z; oacc[nt][4 * q + 3] *= fr.w; } }
        }
        { float dummy = 0.f; nsa_pass<BR_CMP, false, true, false>(X, qf, oacc, dummy, g_c * il_c, 0, ntc - 1, ~0ull); }
        const int wlo = X.qblk >= 8 ? X.qblk - 8 : 0;
        float l_w = 0.f;
        nsa_pass<BR_WIN, true, false, false>(X, qf, oacc, l_w, 1.f, wlo, X.qblk, ~0ull);
        l_w += __shfl_xor(l_w, 32);
        { float dummy = 0.f; nsa_pass<BR_WIN, false, true, false>(X, qf, oacc, dummy, l_w > 0.f ? g_w / l_w : 0.f, wlo, X.qblk, ~0ull); }
#pragma unroll
        for (int i = 0; i < 16; ++i) { const int c32 = 8 * (i >> 2) + 4 * X.hh + (i & 3);
            bf16* op = HB + (X.bat + X.t0 + 8 * X.w + (c32 >> 2)) * DM + (4 * X.g + (c32 & 3)) * 128 + X.r;
#pragma unroll
            for (int nt = 0; nt < 4; ++nt) op[32 * nt] = (bf16)f2bfh(oacc[nt][i]); }
    }
}

constexpr int N_PHASES = 18;
__global__ void __launch_bounds__(NTHR, 2) mk_fwd(Args args) {
    extern __shared__ __attribute__((aligned(16))) unsigned char lds[];
    Frame F;
    F.lds = (LAS unsigned char*)lds;
    F.MISC = (volatile LAS unsigned*)(F.lds + MISC_OFF);
    F.tid = threadIdx.x; F.lane = F.tid & 63; F.wave = __builtin_amdgcn_readfirstlane(F.tid >> 6);
    F.G = gridDim.x; F.bid = blockIdx.x;
    F.ws = args.ws; F.out = args.out; F.ctl = (gu32*)(args.ws + WS_CTL);
    if (F.tid < 64) F.MISC[F.tid] = 0u;
    __syncthreads();
    const int lo = args.ph_lo, hi = args.ph_hi;
    XcdBarrier bar; bar.bar = (unsigned*)(F.ctl + CW_BAR); bar.x = 0; bar.st = nullptr;
    if (hi - lo > 1) bar = xcd_barrier_post((unsigned*)(F.ctl + CW_BAR), F.MISC + 8);
#ifndef PHMASK
#define PHMASK 0xffffffffu
#endif
#define IN(k) (((PHMASK >> (k)) & 1u) && lo <= (k) && (k) < hi)
#ifndef REPMASK
#define REPMASK 0u
#endif
#define RUNS(k) (1 + (int)((REPMASK >> (k)) & 1u))
#define SEAM(k) do { if (IN(k) && IN((k) + 1)) xcd_barrier(bar); } while (0)
    if (IN(0)) { for (int rp = 0; rp < RUNS(0); ++rp) p_prologue(F, args); } SEAM(0);
    if (IN(1)) {
        pg8::StaticOrder S; S.init(F.ws + WS_HB, F.ws + WS_WIE, MTOK, LDE, DM, F.G, F.bid);
        pg8::EpiBf16 E{(bf16*)(F.ws + WS_U), LDE};
        pg8::gemm_phase<pg8::EpiBf16, pg8::StaticOrder, true>(F.lds, DM, S, E);
    } SEAM(1);
    if (IN(2)) { p_ssd(F, args); } SEAM(2);
    if (IN(3)) { for (int rp = 0; rp < RUNS(3); ++rp) p_dsa(F, args); } SEAM(3);
    if (IN(4)) {
        pg8::StaticOrder S; S.init(F.ws + WS_HB, F.ws + WS_WOE, MTOK, DM, DM, F.G, F.bid);
        pg8::EpiResF32 E{args.in[0], F.out, DM};
        pg8::gemm_phase<pg8::EpiResF32, pg8::StaticOrder, true>(F.lds, DM, S, E);
    } SEAM(4);
    if (IN(5)) { p_norm_route<0>(F, F.out, args.in[3], 0); } SEAM(5);
    if (IN(6)) { for (int rp = 0; rp < RUNS(6); ++rp) p_moe_gu(F, 0); } SEAM(6);
    if (IN(7)) { p_moe_down(F, 0, 0); } SEAM(7);
    if (IN(8)) { p_moe_down(F, 0, 1); } SEAM(8);
    if (IN(9)) { for (int rp = 0; rp < RUNS(9); ++rp) p_norm_route<1>(F, F.out, args.in[2] + DM, 0); } SEAM(9);
    if (IN(10)) {
        pg8::StaticOrder S; S.init(F.ws + WS_HB, F.ws + WS_WIO, MTOK, LDO, DM, F.G, F.bid);
        pg8::EpiBf16 E{(bf16*)(F.ws + WS_U), LDO};
        pg8::gemm_phase<pg8::EpiBf16, pg8::StaticOrder, true>(F.lds, DM, S, E);
    } SEAM(10);
    if (IN(11)) { p_compress(F, args); } SEAM(11);
    if (IN(12)) { for (int rp = 0; rp < RUNS(12); ++rp) p_nsa(F, args); } SEAM(12);
    if (IN(13)) {
        pg8::StaticOrder S; S.init(F.ws + WS_HB, F.ws + WS_WOO, MTOK, DM, DM, F.G, F.bid);
        pg8::EpiResF32 E{F.out, F.out, DM};
        pg8::gemm_phase<pg8::EpiResF32, pg8::StaticOrder, true>(F.lds, DM, S, E);
    } SEAM(13);
    if (IN(14)) { p_norm_route<0>(F, F.out, args.in[3] + DM, 1); } SEAM(14);
    if (IN(15)) { p_moe_gu(F, 1); } SEAM(15);
    if (IN(16)) { p_moe_down(F, 1, 0); } SEAM(16);
    if (IN(17)) { p_moe_down(F, 1, 1); }
#undef IN
#undef SEAM
}

extern "C" void kernel_launch(void* const* d_in, const int* in_sizes, int n_in, void* d_out, int out_size, void* d_ws, size_t ws_size, hipStream_t stream) {
    static int grid = 0;
    if (grid == 0) {
        if (n_in != 31 || ws_size < WS_END) { fprintf(stderr, "kernel_launch: unexpected n_in %d / ws %zu\n", n_in, ws_size); grid = -1; return; }
        int dev = 0, cus = 0;
        if (hipGetDevice(&dev) != hipSuccess || hipDeviceGetAttribute(&cus, hipDeviceAttributeMultiprocessorCount, dev) != hipSuccess) { grid = -1; return; }
        if (hipFuncSetAttribute((const void*)mk_fwd, hipFuncAttributeMaxDynamicSharedMemorySize, LDS_BYTES) != hipSuccess) { fprintf(stderr, "kernel_launch: hipFuncSetAttribute failed\n"); grid = -1; return; }
        grid = cus;
    }
    if (grid < 0) return;
    (void)hipMemsetAsync((char*)d_ws + WS_CTL, 0, CTL_ZERO_BYTES, stream);
    Args a{};
    for (int i = 0; i < 31; ++i) a.in[i] = (const float*)d_in[i];
    a.out = (float*)d_out; a.ws = (unsigned char*)d_ws; a.rep = 2; a.pad = 0;
#if defined(MK_PER_PHASE)
    for (int p = 0; p < N_PHASES; ++p) { a.ph_lo = p; a.ph_hi = p + 1; hipLaunchKernelGGL(mk_fwd, dim3(grid), dim3(NTHR), LDS_BYTES, stream, a); }
#else
    a.ph_lo = 0; a.ph_hi = N_PHASES; hipLaunchKernelGGL(mk_fwd, dim3(grid), dim3(NTHR), LDS_BYTES, stream, a);
#endif
}
```

```cpp
#include <hip/hip_runtime.h>
#include <cstdio>
#include <cstdint>

#define GAS __attribute__((address_space(1)))
#define LAS __attribute__((address_space(3)))
typedef unsigned short bf16;
typedef short bf16x8 __attribute__((ext_vector_type(8)));
typedef float f32x4 __attribute__((ext_vector_type(4)));
typedef float f32x2 __attribute__((ext_vector_type(2)));
typedef float f32x16 __attribute__((ext_vector_type(16)));
typedef unsigned u32x4 __attribute__((ext_vector_type(4)));
typedef unsigned u32x2 __attribute__((ext_vector_type(2)));
typedef GAS unsigned gu32;
#define RLX_AGENT __ATOMIC_RELAXED, __HIP_MEMORY_SCOPE_AGENT
#define LDS_WAIT() asm volatile("s_waitcnt lgkmcnt(0)" ::: "memory")
#define VM_WAIT() asm volatile("s_waitcnt vmcnt(0)" ::: "memory")

constexpr int NB = 16, SEQ = 4096, DM = 1024, MTOK = NB * SEQ;
constexpr float NORM_EPS = 1e-6f;
constexpr int LDE = 2560;
constexpr int EZ = 0, EXS = 512, EBB = 1024, ECC = 1280, EQ = 1536, EK = 2048, EV = 2112, EIQ = 2176, EIK = 2432, EDT = 2496, EIW = 2504;
constexpr int LDO = 2560;
constexpr int OQ = 0, OKC = 1024, OVC = 1280, OKS = 1536, OVS = 1792, OKW = 2048, OVW = 2304;
constexpr int NWAVES = 8, NTHR = 512;

constexpr size_t MiB = 1u << 20;
constexpr size_t WS_CTL = 0, CTL_ZERO_BYTES = 1 * MiB;
constexpr size_t WS_WIE = 1 * MiB, WS_WOE = 6 * MiB, WS_WIO = 8 * MiB, WS_WOO = 13 * MiB;
constexpr size_t WS_W1K = 15 * MiB, WS_W1V = 16 * MiB, WS_W2 = 17 * MiB, WS_WR = 18 * MiB;
constexpr size_t WS_WGL = WS_WR + 256 * 1024;
constexpr size_t WS_TOK = 19 * MiB;
constexpr size_t WS_GL = 20 * MiB;
constexpr size_t WS_KCMP = 26 * MiB, WS_VCMP = 28 * MiB;
constexpr size_t WS_LIST = 32 * MiB;
constexpr size_t WS_WGU = 48 * MiB;
constexpr size_t WS_WD = 176 * MiB;
constexpr size_t WS_HB = 240 * MiB;
constexpr size_t WS_U = 368 * MiB;
constexpr size_t WS_LISTW = 720 * MiB;
constexpr size_t WS_END = 736 * MiB;
constexpr int CW_TMO = 0, CW_CODE = 1, CW_BAR = 4096, CW_CNT = 8192;

constexpr int RING_BYTES = 131072;
constexpr int LDS_BYTES = 147456;
constexpr int MISC_OFF = LDS_BYTES - 256;
constexpr int MOE_OFF = LDS_BYTES - 2048;

__device__ __forceinline__ unsigned f2bf(float f) { unsigned u = __builtin_bit_cast(unsigned, f); return (u + 0x7fffu + ((u >> 16) & 1u)) >> 16; }
typedef __bf16 bf16x2_t __attribute__((ext_vector_type(2)));
__device__ __forceinline__ unsigned pk2(float lo, float hi) { const f32x2 v = {lo, hi}; const bf16x2_t b = __builtin_convertvector(v, bf16x2_t); return __builtin_bit_cast(unsigned, b); }
__device__ __forceinline__ unsigned short f2bfh(float f) { return (unsigned short)(pk2(f, f) & 0xffffu); }
__device__ __forceinline__ float bf2f(unsigned short b) { return __builtin_bit_cast(float, ((unsigned)b) << 16); }
__device__ __forceinline__ float bflo(unsigned w) { return __builtin_bit_cast(float, w << 16); }
__device__ __forceinline__ float bfhi(unsigned w) { return __builtin_bit_cast(float, w & 0xffff0000u); }
__device__ __forceinline__ float siluf(float v) { return v * __builtin_amdgcn_rcpf(1.f + __builtin_amdgcn_exp2f(-1.44269504f * v)); }

#define XB_TMO      128
#define XB_XCNT(j)  (256  + 64 * (j))
#define XB_XSUB(j)  (1280 + 64 * (j))
#define XB_XGEN(j)  (2304 + 64 * (j))
#define XB_TOP      3328
#define XB_TOPGEN   3392
#define XCD_BAR_WORDS 3456
#define XB_SPIN_CAP (1u << 20)
__device__ __forceinline__ unsigned xb_ld(unsigned* p)              { return __hip_atomic_load(p, __ATOMIC_RELAXED, __HIP_MEMORY_SCOPE_AGENT); }
__device__ __forceinline__ unsigned xb_add(unsigned* p, unsigned v) { return __hip_atomic_fetch_add(p, v, __ATOMIC_RELAXED, __HIP_MEMORY_SCOPE_AGENT); }
__device__ __forceinline__ unsigned xb_xcc_id() { return (unsigned)__builtin_amdgcn_s_getreg((3 << 11) | 20) & 0xFu; }
#define XB_SPIN(cond, bar) do { unsigned _sp = 0; while (cond) { __builtin_amdgcn_s_sleep(1); \
    if ((++_sp & 255u) == 0u) { if (xb_ld(&(bar)[XB_TMO])) break; if (_sp > XB_SPIN_CAP) { atomicAdd(&(bar)[XB_TMO], 1u); break; } } } } while (0)
struct XcdBarrier { unsigned* bar; unsigned x; volatile LAS unsigned* st; };
__device__ __forceinline__ XcdBarrier xcd_barrier_post(unsigned* bar, volatile LAS unsigned* st) {
    XcdBarrier b; b.bar = bar; b.x = xb_xcc_id(); b.st = st;
    if (threadIdx.x == 0) (void)xb_add(&bar[XB_XCNT(b.x)], 1u);
    return b;
}
__device__ __forceinline__ void xcd_barrier_complete(unsigned* bar, unsigned x, unsigned& nloc, unsigned& nx) {
    const unsigned G = gridDim.x * gridDim.y * gridDim.z;
    unsigned sum, cnt, mine, sp = 0u;
    for (;;) {
        sum = 0u; cnt = 0u; mine = 0u;
#pragma unroll
        for (unsigned j = 0; j < 16; ++j) { const unsigned c = xb_ld(&bar[XB_XCNT(j)]); sum += c; cnt += (c > 0u) ? 1u : 0u; mine = (j == x) ? c : mine; }
        if (sum == G) break;
        __builtin_amdgcn_s_sleep(1);
        if ((++sp & 255u) == 0u) { if (xb_ld(&bar[XB_TMO])) break; if (sp > XB_SPIN_CAP) { atomicAdd(&bar[XB_TMO], 1u); break; } }
    }
    nloc = mine > 0u ? mine : 1u; nx = cnt > 0u ? cnt : 1u;
}
__device__ __forceinline__ void xcd_barrier(const XcdBarrier& b) {
    asm volatile("s_waitcnt vmcnt(0)" ::: "memory");
    __syncthreads();
    if (threadIdx.x == 0) {
        unsigned* bar = b.bar;
        __builtin_amdgcn_s_waitcnt(0);
        unsigned nloc = b.st[0], nx = b.st[1];
        if (nloc == 0u) { xcd_barrier_complete(bar, b.x, nloc, nx); b.st[0] = nloc; b.st[1] = nx; }
        const unsigned old = xb_add(&bar[XB_XSUB(b.x)], 1u);
        const unsigned gen = old / nloc;
        if (old + 1u == (gen + 1u) * nloc) {
            __builtin_amdgcn_fence(__ATOMIC_RELEASE, "agent");
            asm volatile("s_waitcnt vmcnt(0)" ::: "memory");
            const unsigned og = xb_add(&bar[XB_TOP], 1u);
            const unsigned tg = og / nx;
            if (og + 1u == (tg + 1u) * nx) xb_add(&bar[XB_TOPGEN], 1u);
            else XB_SPIN(xb_ld(&bar[XB_TOPGEN]) == tg, bar);
            __builtin_amdgcn_fence(__ATOMIC_ACQUIRE, "agent");
            xb_add(&bar[XB_XGEN(b.x)], 1u);
            asm volatile("s_waitcnt vmcnt(0)" ::: "memory");
        } else {
            XB_SPIN(xb_ld(&bar[XB_XGEN(b.x)]) == gen, bar);
            __builtin_amdgcn_fence(__ATOMIC_ACQUIRE, "agent");
            asm volatile("s_waitcnt vmcnt(0)" ::: "memory");
        }
    }
    __syncthreads();
}

namespace pg8 {
constexpr int BM = 256, BK = 64, HALF = 128, HTB = HALF * BK * 2, STAGE_BYTES = 8 * HTB, NXCD = 8, WGM = 8;
__host__ __device__ __forceinline__ int lds_byte(int r, int c) { const int st = (r >> 4) * 2 + (c >> 5), rr = r & 15, cc = c & 31, ob = rr * 64 + cc * 2; return st * 1024 + (ob ^ (((ob >> 9) & 1) << 5)); }
__host__ __device__ __forceinline__ void stage_rc(int b, int& R, int& C) { const int st = b / 1024, sb = b % 1024, swz = sb ^ (((sb >> 9) & 1) << 5); R = (st >> 1) * 16 + swz / 64; C = (st & 1) * 32 + (swz % 64) / 2; }
__host__ __device__ __forceinline__ int perm32(int rho) { const int n = rho >> 4, i = rho & 15; return 8 * (i >> 2) + 4 * n + (i & 3); }
__device__ __forceinline__ unsigned cvt_pk_bf16(float lo, float hi) { unsigned r; asm volatile("v_cvt_pk_bf16_f32 %0, %1, %2" : "=v"(r) : "v"(lo), "v"(hi)); return r; }

struct Unit { const char* A; const char* B; int pm, pn, aux; };

struct StaticOrder {
    const char* A; const char* Bt; int K, nM, nN, nwg, G, c;
    __device__ void init(const void* A_, const void* Bt_, int M, int N, int K_, int G_, int c_) { A = (const char*)A_; Bt = (const char*)Bt_; K = K_; nM = M / BM; nN = N / BM; nwg = nM * nN; G = G_; c = c_; }
    __device__ __forceinline__ bool next(int i, Unit& u) const {
        const long L = (long)i * G + c; if (L >= nwg) return false;
        int wgid = (int)L; { const int q = nwg / NXCD, r = nwg % NXCD, xcd = wgid % NXCD, off = wgid / NXCD; wgid = (xcd < r ? xcd * (q + 1) : r * (q + 1) + (xcd - r) * q) + off; }
        const int nig = WGM * nN, gid = wgid / nig, fm = gid * WGM, gsz = (nM - fm) < WGM ? (nM - fm) : WGM;
        u.pm = fm + ((wgid % nig) % gsz); u.pn = (wgid % nig) / gsz; u.aux = 0;
        u.A = A + (size_t)u.pm * BM * K * 2; u.B = Bt + (size_t)u.pn * BM * K * 2; return true;
    }
    __device__ __forceinline__ unsigned arow(const Unit&, int r) const { return (unsigned)(r * K) * 2u; }
};

template <class Epi, class Sched, bool ALIGN_EPI>
__device__ __forceinline__ void gemm_phase(LAS unsigned char* lds, const int K, const Sched& S, const Epi& E) {
    const int tid = threadIdx.x, wid = __builtin_amdgcn_readfirstlane(tid >> 6), lane = tid & 63, wr = wid >> 2, wc = wid & 3, fr = lane & 15, fq = lane >> 4;
    const int nt = K / BK;
    int RA[2], CA[2]; unsigned voffB[2];
#pragma unroll
    for (int i = 0; i < 2; ++i) { int R, C; stage_rc(tid * 16 + i * 8192, R, C); const int Rb = Epi::PERM ? ((R & ~31) + perm32(R & 31)) : R;
        RA[i] = R; CA[i] = C; voffB[i] = (unsigned)(Rb * K + C) * 2u; }
    const size_t kstep = (size_t)(BK * 2);
    const size_t hstep = (size_t)HALF * K * 2;
    const unsigned ldsw = (unsigned)wid * 1024u;
    const int aoff = lds_byte(wr * 64 + fr, fq * 8), boff = lds_byte(wc * 32 + fr, fq * 8);
#define PG8_SA(b, h) (((b) * 2 + (h)) * HTB)
#define PG8_SB(b, h) ((4 + (b) * 2 + (h)) * HTB)
#define PG8_STAGE(bufoff, gbase, voff) do { _Pragma("unroll") for (int _i = 0; _i < 2; ++_i) \
        __builtin_amdgcn_global_load_lds((const unsigned*)((const char*)(gbase) + (voff)[_i]), (LAS unsigned*)(lds + (bufoff) + ldsw + _i * 8192), 16, 0, 0); } while (0)
#define PG8_LDA(dst, b, h) do { _Pragma("unroll") for (int m = 0; m < 4; ++m) _Pragma("unroll") for (int k = 0; k < 2; ++k) dst[m][k] = *(const LAS bf16x8*)(lds + PG8_SA(b, h) + aoff + m * 2048 + k * 1024); } while (0)
#define PG8_LDB(dst, b, h) do { _Pragma("unroll") for (int n = 0; n < 2; ++n) _Pragma("unroll") for (int k = 0; k < 2; ++k) dst[n][k] = *(const LAS bf16x8*)(lds + PG8_SB(b, h) + boff + n * 2048 + k * 1024); } while (0)
#define PG8_MMA(ai, bj, At, Bt) do { __builtin_amdgcn_s_setprio(1); _Pragma("unroll") for (int m = 0; m < 4; ++m) _Pragma("unroll") for (int n = 0; n < 2; ++n) _Pragma("unroll") for (int k = 0; k < 2; ++k) \
        acc[ai][bj][m][n] = __builtin_amdgcn_mfma_f32_16x16x32_bf16(Bt[n][k], At[m][k], acc[ai][bj][m][n], 0, 0, 0); __builtin_amdgcn_s_setprio(0); } while (0)
#define PG8_WAIT_V(n) asm volatile("s_waitcnt vmcnt(" #n ")" ::: "memory")
#define PG8_WAIT_L(n) asm volatile("s_waitcnt lgkmcnt(" #n ")" ::: "memory")
#define PG8_BAR __builtin_amdgcn_s_barrier()
#define PG8_SCHED __builtin_amdgcn_sched_barrier(0)
    Unit cur, nxt; int ui = 0;
    if (!S.next(0, cur)) return;
    f32x4 acc[2][2][4][2];
#pragma unroll
    for (int a = 0; a < 2; ++a)
#pragma unroll
        for (int b = 0; b < 2; ++b)
#pragma unroll
            for (int m = 0; m < 4; ++m)
#pragma unroll
                for (int n = 0; n < 2; ++n) acc[a][b][m][n] = (f32x4){0.f, 0.f, 0.f, 0.f};
    bf16x8 At[4][2], B0[2][2], B1[2][2];
    unsigned vA0[2], vA1[2], nA0[2], nA1[2];
#pragma unroll
    for (int i = 0; i < 2; ++i) { vA0[i] = S.arow(cur, RA[i]) + CA[i] * 2u; vA1[i] = S.arow(cur, HALF + RA[i]) + CA[i] * 2u; nA0[i] = vA0[i]; nA1[i] = vA1[i]; }
    const char* cA = cur.A; const char* cB = cur.B;
    PG8_STAGE(PG8_SB(0, 0), cB, voffB); PG8_STAGE(PG8_SB(0, 1), cB + hstep, voffB); PG8_STAGE(PG8_SA(0, 0), cA, vA0); PG8_STAGE(PG8_SA(0, 1), cA, vA1);
    if (wr == 1) PG8_BAR;
    PG8_WAIT_V(2); PG8_BAR;
    PG8_STAGE(PG8_SB(1, 0), cB + kstep, voffB); PG8_STAGE(PG8_SA(1, 0), cA + kstep, vA0); PG8_STAGE(PG8_SB(1, 1), cB + hstep + kstep, voffB);
    PG8_WAIT_V(6); PG8_BAR;
    for (;;) {
        const bool has_next = S.next(ui + 1, nxt);
        const char* nA = has_next ? nxt.A : cA; const char* nB = has_next ? nxt.B : cB;
        if (has_next) {
#pragma unroll
            for (int i = 0; i < 2; ++i) { nA0[i] = S.arow(nxt, RA[i]) + CA[i] * 2u; nA1[i] = S.arow(nxt, HALF + RA[i]) + CA[i] * 2u; }
        }
        for (int t = 0; t < nt; t += 2) {
            const bool last = (t == nt - 2);
            const char* a1 = cA + (size_t)(t + 1) * kstep;
            const char* a2 = last ? nA : cA + (size_t)(t + 2) * kstep; const char* b2 = last ? nB : cB + (size_t)(t + 2) * kstep;
            const char* a3 = a2 + kstep; const char* b3 = b2 + kstep;
            unsigned w0[2], w1[2];
#pragma unroll
            for (int i = 0; i < 2; ++i) { w0[i] = last ? nA0[i] : vA0[i]; w1[i] = last ? nA1[i] : vA1[i]; }
            PG8_LDB(B0, 0, 0); PG8_LDB(B1, 0, 1); PG8_SCHED; PG8_LDA(At, 0, 0); PG8_STAGE(PG8_SA(1, 1), a1, vA1);
            PG8_WAIT_V(8); PG8_WAIT_L(0); PG8_BAR; PG8_MMA(0, 0, At, B0); PG8_MMA(0, 1, At, B1); PG8_BAR; PG8_SCHED;
            PG8_LDA(At, 0, 1); PG8_STAGE(PG8_SB(0, 0), b2, voffB); PG8_STAGE(PG8_SB(0, 1), b2 + hstep, voffB); PG8_STAGE(PG8_SA(0, 0), a2, w0);
            PG8_WAIT_V(8); PG8_WAIT_L(0); PG8_BAR; PG8_MMA(1, 0, At, B0); PG8_MMA(1, 1, At, B1); PG8_BAR; PG8_SCHED;
            PG8_LDB(B0, 1, 0); PG8_LDB(B1, 1, 1); PG8_SCHED; PG8_LDA(At, 1, 0); PG8_STAGE(PG8_SA(0, 1), a2, w1);
            PG8_WAIT_V(8); PG8_WAIT_L(0); PG8_BAR; PG8_MMA(0, 0, At, B0); PG8_MMA(0, 1, At, B1); PG8_BAR; PG8_SCHED;
            PG8_LDA(At, 1, 1); PG8_STAGE(PG8_SB(1, 0), b3, voffB); PG8_STAGE(PG8_SB(1, 1), b3 + hstep, voffB); PG8_STAGE(PG8_SA(1, 0), a3, w0);
            PG8_WAIT_V(8); PG8_WAIT_L(0); PG8_BAR; PG8_MMA(1, 0, At, B0); PG8_MMA(1, 1, At, B1); PG8_BAR; PG8_SCHED;
        }
        if constexpr (ALIGN_EPI) { if (wr == 0) PG8_BAR; }
        E(acc, cur, wr, wc, fr, fq);
        if (!has_next) break;
#pragma unroll
        for (int a = 0; a < 2; ++a)
#pragma unroll
            for (int b = 0; b < 2; ++b)
#pragma unroll
                for (int m = 0; m < 4; ++m)
#pragma unroll
                    for (int n = 0; n < 2; ++n) acc[a][b][m][n] = (f32x4){0.f, 0.f, 0.f, 0.f};
        cur = nxt; cA = nA; cB = nB; ++ui;
#pragma unroll
        for (int i = 0; i < 2; ++i) { vA0[i] = nA0[i]; vA1[i] = nA1[i]; }
        if constexpr (ALIGN_EPI) { if (wr == 1) PG8_BAR; }
    }
    PG8_WAIT_V(0);
    if constexpr (!ALIGN_EPI) { if (wr == 0) PG8_BAR; }
    PG8_BAR;
#undef PG8_SA
#undef PG8_SB
#undef PG8_STAGE
#undef PG8_LDA
#undef PG8_LDB
#undef PG8_MMA
#undef PG8_WAIT_V
#undef PG8_WAIT_L
#undef PG8_BAR
#undef PG8_SCHED
}

struct EpiBf16 {
    static constexpr bool PERM = true;
    bf16* O; int ldc;
    __device__ __forceinline__ void operator()(const f32x4 (&acc)[2][2][4][2], const Unit& u, int wr, int wc, int fr, int fq) const {
        const int row0 = u.pm * BM + wr * 64 + fr; const int col0 = u.pn * BM + wc * 32 + 8 * fq;
#pragma unroll
        for (int ai = 0; ai < 2; ++ai)
#pragma unroll
            for (int m = 0; m < 4; ++m) { bf16* rowp = O + (size_t)(row0 + ai * HALF + m * 16) * ldc + col0;
#pragma unroll
                for (int bj = 0; bj < 2; ++bj) { const f32x4 v0 = acc[ai][bj][m][0], v1 = acc[ai][bj][m][1];
                    u32x4 w; w.x = cvt_pk_bf16(v0[0], v0[1]); w.y = cvt_pk_bf16(v0[2], v0[3]); w.z = cvt_pk_bf16(v1[0], v1[1]); w.w = cvt_pk_bf16(v1[2], v1[3]);
                    *(u32x4*)(rowp + bj * HALF) = w; } }
    }
};
struct EpiResF32 {
    static constexpr bool PERM = false;
    const float* base; float* out; int ldc;
    __device__ __forceinline__ void operator()(const f32x4 (&acc)[2][2][4][2], const Unit& u, int wr, int wc, int fr, int fq) const {
        const int row0 = u.pm * BM + wr * 64 + fr, col0 = u.pn * BM + wc * 32 + 4 * fq;
#pragma unroll
        for (int ai = 0; ai < 2; ++ai)
#pragma unroll
            for (int m = 0; m < 4; ++m) { const size_t off = (size_t)(row0 + ai * HALF + m * 16) * ldc + col0;
#pragma unroll
                for (int bj = 0; bj < 2; ++bj)
#pragma unroll
                    for (int n = 0; n < 2; ++n) { const f32x4 bs = *(const f32x4*)(base + off + bj * HALF + n * 16); *(f32x4*)(out + off + bj * HALF + n * 16) = bs + acc[ai][bj][m][n]; } }
    }
};

struct MoeOrder {
    const char* Abase; const char* Bbase; size_t bstride; int K, G, c, tile_lo, tile_hi; const LAS int* ptile; const LAS int* cntv; const int* list; bool gather;
    __device__ __forceinline__ bool next(int i, Unit& u) const {
        const long L = (long)i * G + c; const int nun = (tile_hi - tile_lo) * 4; if (L >= nun) return false;
        const int tile = tile_lo + (int)(L >> 2), pn = (int)(L & 3);
        int e = 0;
        for (int k = 1; k < 64; ++k) e += (tile >= __builtin_amdgcn_readfirstlane(ptile[k])) ? 1 : 0;
        const int j = tile - __builtin_amdgcn_readfirstlane(ptile[e]);
        u.pm = tile; u.pn = pn; u.aux = e | (j << 6);
        u.A = gather ? Abase : Abase + (size_t)tile * BM * K * 2; u.B = Bbase + (size_t)(e & 31) * bstride + (size_t)pn * BM * K * 2; return true;
    }
    __device__ __forceinline__ unsigned arow(const Unit& u, int r) const {
        if (!gather) return (unsigned)(r * K) * 2u;
        const int e = u.aux & 63, pos = (u.aux >> 6) * 256 + r; const int cn = cntv[e];
        const int tok = pos < cn ? list[(size_t)e * 65536 + pos] : 0;
        return (unsigned)tok * (unsigned)(K * 2);
    }
};
struct EpiSwiGLU {
    static constexpr bool PERM = true;
    bf16* H;
    __device__ __forceinline__ void operator()(const f32x4 (&acc)[2][2][4][2], const Unit& u, int wr, int wc, int fr, int fq) const {
        const int row0 = u.pm * BM + wr * 64 + fr; const int col0 = u.pn * 128 + wc * 32 + 8 * fq;
#pragma unroll
        for (int ai = 0; ai < 2; ++ai)
#pragma unroll
            for (int m = 0; m < 4; ++m) { bf16* rowp = H + (size_t)(row0 + ai * HALF + m * 16) * 512 + col0;
                const f32x4 g0 = acc[ai][0][m][0], g1 = acc[ai][0][m][1], u0 = acc[ai][1][m][0], u1 = acc[ai][1][m][1];
                float h[8];
#pragma unroll
                for (int q = 0; q < 4; ++q) { h[q] = g0[q] * __builtin_amdgcn_rcpf(1.f + __builtin_amdgcn_exp2f(-1.44269504f * g0[q])) * u0[q]; h[4 + q] = g1[q] * __builtin_amdgcn_rcpf(1.f + __builtin_amdgcn_exp2f(-1.44269504f * g1[q])) * u1[q]; }
                u32x4 w; w.x = cvt_pk_bf16(h[0], h[1]); w.y = cvt_pk_bf16(h[2], h[3]); w.z = cvt_pk_bf16(h[4], h[5]); w.w = cvt_pk_bf16(h[6], h[7]);
                *(u32x4*)rowp = w; }
    }
};
struct EpiScatter {
    static constexpr bool PERM = false;
    float* out; const int* list; const float* wl; const LAS int* cntv;
    __device__ __forceinline__ void operator()(const f32x4 (&acc)[2][2][4][2], const Unit& u, int wr, int wc, int fr, int fq) const {
        const int e = u.aux & 63, j = u.aux >> 6; const int cn = cntv[e];
        const int col0 = u.pn * BM + wc * 32 + 4 * fq;
#pragma unroll
        for (int ai = 0; ai < 2; ++ai)
#pragma unroll
            for (int m = 0; m < 4; ++m) { const int pos = j * 256 + ai * HALF + wr * 64 + m * 16 + fr;
                if (pos < cn) { const int tok = list[(size_t)e * 65536 + pos]; const float wg = wl[(size_t)e * 65536 + pos];
                    float* rowp = out + (size_t)tok * DM + col0;
#pragma unroll
                    for (int bj = 0; bj < 2; ++bj)
#pragma unroll
                        for (int n = 0; n < 2; ++n) { f32x4* p = (f32x4*)(rowp + bj * HALF + n * 16); *p = *p + wg * acc[ai][bj][m][n]; } } }
    }
};
}

struct Frame {
    LAS unsigned char* lds;
    volatile LAS unsigned* MISC;
    gu32* ctl;
    int tid, lane, wave, G, bid;
    float* out; unsigned char* ws;
};
struct Args { const float* in[31]; float* out; unsigned char* ws; int ph_lo, ph_hi, rep, pad; };
#ifndef REP_PART
#define REP_PART 0
#endif
#ifndef REP_PHASE
#define REP_PHASE -1
#endif
#define NREP(k) ((REP_PHASE == (k)) ? args.rep : 1)
__device__ __forceinline__ float wave_sum(float v) {
#pragma unroll
    for (int o = 1; o < 64; o <<= 1) v += __shfl_xor(v, o);
    return v;
}

template <class Map>
__device__ __forceinline__ void transpose_item(const float* W, int K, int pitch, int col0, int ncols, bf16* WT, LAS float* scr, int item, int lane, Map dmap) {
    const int nblk = (ncols + 31) / 32, kb = item / nblk, nb = item % nblk, k0 = 64 * kb, n0 = 32 * nb;
    const int nn = n0 + (lane & 31);
#pragma unroll 8
    for (int i = 0; i < 32; ++i) { const int kk = 2 * i + (lane >> 5); scr[kk * 33 + (lane & 31)] = (nn < ncols) ? W[(size_t)(k0 + kk) * pitch + col0 + nn] : 0.f; }
    LDS_WAIT(); asm volatile("" ::: "memory");
    const int c = lane & 7;
#pragma unroll
    for (int j = 0; j < 4; ++j) { const int n = (lane >> 3) + 8 * j; const LAS float* s = scr + (8 * c) * 33 + n;
        u32x4 o; o.x = pk2(s[0 * 33], s[1 * 33]); o.y = pk2(s[2 * 33], s[3 * 33]); o.z = pk2(s[4 * 33], s[5 * 33]); o.w = pk2(s[6 * 33], s[7 * 33]);
        if (n0 + n < ncols) *(u32x4*)(WT + (size_t)dmap(n0 + n) * K + k0 + 8 * c) = o; }
    LDS_WAIT(); asm volatile("" ::: "memory");
}
struct MapId { int off; __device__ int operator()(int n) const { return n + off; } };
struct MapEven { __device__ int operator()(int c) const {
    if (c < 1536) return c; if (c < 1544) return EDT + (c - 1536); if (c < 2056) return EQ + (c - 1544); if (c < 2120) return EK + (c - 2056);
    if (c < 2184) return EV + (c - 2120); if (c < 2440) return EIQ + (c - 2184); if (c < 2504) return EIK + (c - 2440); return EIW + (c - 2504); } };
struct MapGU { int half; __device__ int operator()(int n) const { return 256 * (n >> 7) + 128 * half + (n & 127); } };

__device__ __forceinline__ void rms_row_to_bf16(const float* xrow, const float* gain, bf16* orow, int lane) {
    const f32x4* xr = (const f32x4*)xrow + lane; const f32x4* gr = (const f32x4*)gain + lane;
    f32x4 v[4]; float s = 0.f;
#pragma unroll
    for (int j = 0; j < 4; ++j) { v[j] = xr[64 * j]; s += (v[j].x * v[j].x + v[j].y * v[j].y) + (v[j].z * v[j].z + v[j].w * v[j].w); }
    const float rs = 1.f / sqrtf(wave_sum(s) * (1.f / DM) + NORM_EPS);
    unsigned long long* o8 = (unsigned long long*)orow + lane;
#pragma unroll
    for (int j = 0; j < 4; ++j) { const f32x4 g = gr[64 * j]; o8[64 * j] = (unsigned long long)pk2(v[j].x * rs * g.x, v[j].y * rs * g.y) | ((unsigned long long)pk2(v[j].z * rs * g.z, v[j].w * rs * g.w) << 32); }
}

__device__ __forceinline__ void p_prologue(Frame& F, const Args& A) {
    LAS float* scr = (LAS float*)(F.lds + F.wave * 16384);
    const int gw = F.bid * NWAVES + F.wave, NGW = F.G * NWAVES;
    bf16* Wie = (bf16*)(F.ws + WS_WIE); bf16* Woe = (bf16*)(F.ws + WS_WOE);
    constexpr int I_IE = 16 * 79, I_OE = 16 * 32;
    for (int it = gw; it < I_IE + I_OE; it += NGW) {
        if (it < I_IE) transpose_item(A.in[4], 1024, 2508, 0, 2508, Wie, scr, it, F.lane, MapEven());
        else transpose_item(A.in[13], 1024, 1024, 0, 1024, Woe, scr, it - I_IE, F.lane, MapId{0});
    }
    {
        bf16* Wgu = (bf16*)(F.ws + WS_WGU); bf16* Wd = (bf16*)(F.ws + WS_WD); bf16* WR = (bf16*)(F.ws + WS_WR);
        for (int it = gw; it < 64 * 768; it += NGW) { const int le = it / 768, r = it % 768;
            if (r < 256) transpose_item(A.in[28] + (size_t)le * 1024 * 512, 1024, 512, 0, 512, Wgu + (size_t)le * 1024 * 1024, scr, r, F.lane, MapGU{0});
            else if (r < 512) transpose_item(A.in[29] + (size_t)le * 1024 * 512, 1024, 512, 0, 512, Wgu + (size_t)le * 1024 * 1024, scr, r - 256, F.lane, MapGU{1});
            else transpose_item(A.in[30] + (size_t)le * 512 * 1024, 512, 1024, 0, 1024, Wd + (size_t)le * 1024 * 512, scr, r - 512, F.lane, MapId{0}); }
        for (int it = gw; it < 2 * 5 * 16; it += NGW) { const int l = it / 80, r = it % 80, q = r / 16, kb = r % 16;
            if (q == 0) transpose_item(A.in[26] + (size_t)l * 1024 * 4, 1024, 4, 0, 4, WR + (size_t)l * 48 * 1024, scr, kb, F.lane, MapId{0});
            else transpose_item(A.in[27] + (size_t)(l * 4 + q - 1) * 1024 * 8, 1024, 8, 0, 8, WR + (size_t)l * 48 * 1024, scr, kb, F.lane, MapId{4 + 8 * (q - 1)}); }
        for (int i = gw * 64 + F.lane; i < 2 * 12 * 1024 / 8; i += NGW * 64) { const int l = i / (12 * 128), o = i % (12 * 128); *(u32x4*)(WR + (size_t)l * 48 * 1024 + 36 * 1024 + (size_t)o * 8) = (u32x4){0u, 0u, 0u, 0u}; }
    }
    {
        bf16* Wio = (bf16*)(F.ws + WS_WIO); bf16* Woo = (bf16*)(F.ws + WS_WOO); bf16* WGL = (bf16*)(F.ws + WS_WGL);
        bf16* W1K = (bf16*)(F.ws + WS_W1K); bf16* W1V = (bf16*)(F.ws + WS_W1V); bf16* W2 = (bf16*)(F.ws + WS_W2);
        constexpr int J0 = 16 * 80, J1 = J0 + 16, J2 = J1 + 16 * 32, J3 = J2 + 64 * 4, J4 = J3 + 64 * 4, J5 = J4 + 2 * 4, J6 = J5 + 2 * 4;
        for (int it = gw; it < J6; it += NGW) {
            if (it < J0) transpose_item(A.in[14], 1024, 2584, 0, 2560, Wio, scr, it, F.lane, MapId{0});
            else if (it < J1) transpose_item(A.in[14], 1024, 2584, 2560, 24, WGL, scr, it - J0, F.lane, MapId{0});
            else if (it < J2) transpose_item(A.in[25], 1024, 1024, 0, 1024, Woo, scr, it - J1, F.lane, MapId{0});
            else if (it < J3) transpose_item(A.in[21], 4096, 128, 0, 128, W1K, scr, it - J2, F.lane, MapId{0});
            else if (it < J4) transpose_item(A.in[23], 4096, 128, 0, 128, W1V, scr, it - J3, F.lane, MapId{0});
            else if (it < J5) transpose_item(A.in[22], 128, 128, 0, 128, W2, scr, it - J4, F.lane, MapId{0});
            else transpose_item(A.in[24], 128, 128, 0, 128, W2 + 128 * 128, scr, it - J5, F.lane, MapId{0});
        }
        for (int i = gw * 64 + F.lane; i < 8 * 1024 / 8; i += NGW * 64) *(u32x4*)(WGL + 24 * 1024 + (size_t)i * 8) = (u32x4){0u, 0u, 0u, 0u};
    }
    for (int i = gw * 64 + F.lane; i < 52 * 1024 / 8; i += NGW * 64) *(u32x4*)(Wie + (size_t)2508 * 1024 + (size_t)i * 8) = (u32x4){0u, 0u, 0u, 0u};
    bf16* HB = (bf16*)(F.ws + WS_HB);
    for (int m = gw; m < MTOK; m += NGW) rms_row_to_bf16(A.in[0] + (size_t)m * DM, A.in[2], HB + (size_t)m * DM, F.lane);
}

constexpr int SP = 136;
constexpr int L_CS = 0, L_BS = 34816, L_BT = 69632, L_XT = 104448, L_XS = 113152, L_ST = 121856, L_AC = 139264, L_DT = 139776, L_CW = 140288;
__device__ __forceinline__ bf16x8 lds_frag(LAS unsigned char* base, int row, int col) { return *(const LAS bf16x8*)(base + (row * SP + col) * 2); }

__device__ __forceinline__ void p_ssd(Frame& F, const Args& A) {
    bf16* U = (bf16*)(F.ws + WS_U);
    const int w = F.wave;
    { const int tid = F.tid;
    for (int r0 = F.bid * 64; r0 < MTOK; r0 += F.G * 64) {
        const int row = r0 + (tid >> 3), c8 = (tid & 7) * 8;
        bf16* p = U + (size_t)row * LDE + EK + c8;
        const u32x4 v = *(const u32x4*)p; float f[8] = {bflo(v.x), bfhi(v.x), bflo(v.y), bfhi(v.y), bflo(v.z), bfhi(v.z), bflo(v.w), bfhi(v.w)};
        float s = 0.f;
#pragma unroll
        for (int j = 0; j < 8; ++j) s += f[j] * f[j];
        s += __shfl_xor(s, 1); s += __shfl_xor(s, 2); s += __shfl_xor(s, 4);
        const float rs = 1.f / sqrtf(s * (1.f / 64.f) + NORM_EPS); const float* g = A.in[12] + c8;
        u32x4 o; o.x = pk2(f[0] * rs * g[0], f[1] * rs * g[1]); o.y = pk2(f[2] * rs * g[2], f[3] * rs * g[3]); o.z = pk2(f[4] * rs * g[4], f[5] * rs * g[5]); o.w = pk2(f[6] * rs * g[6], f[7] * rs * g[7]);
        *(u32x4*)p = o;
    } }
    LAS unsigned char* L = F.lds;
    LAS float* acum = (LAS float*)(L + L_AC); LAS float* dtv = (LAS float*)(L + L_DT); LAS float* cw = (LAS float*)(L + L_CW);
    const float* conv_w = A.in[5]; const float* conv_b = A.in[6];
    for (int st = F.bid; st < 256; st += F.G) {
        const int b = st >> 4, h = (st >> 1) & 7, ph = st & 1, g = h >> 2;
        { const int tid = F.tid;
        __syncthreads();
        for (int i = tid; i < 5 * 288; i += NTHR) { const int j = i / 288, lc = i % 288;
            const int ch = lc < 128 ? 512 + g * 128 + lc : (lc < 256 ? 768 + g * 128 + (lc - 128) : h * 64 + ph * 32 + (lc - 256));
            cw[i] = j < 4 ? conv_w[j * 1024 + ch] : conv_b[ch]; }
        for (int i = tid; i < 2 * 32 * SP / 2; i += NTHR) ((LAS unsigned*)(L + L_ST))[i] = 0u; }
        const float a_h = -__expf(A.in[8][h]), dtb = A.in[7][h], dsk = A.in[9][h];
        f32x16 state = {0.f, 0.f, 0.f, 0.f, 0.f, 0.f, 0.f, 0.f, 0.f, 0.f, 0.f, 0.f, 0.f, 0.f, 0.f, 0.f};
        __syncthreads();
        u32x4 rawB[7], rawC[7], rawX[4]; unsigned rawdt = 0u; unsigned rawz[16];
#define SSD_FETCH_BCX(cc) do { const size_t _rb = (size_t)b * SEQ + (size_t)(cc) * 128; const int _cg = tid & 15, _rr = tid >> 4; \
            _Pragma("unroll") for (int j = 0; j < 7; ++j) { const int tl = 4 * _rr - 3 + j; rawB[j] = (u32x4){0u, 0u, 0u, 0u}; rawC[j] = (u32x4){0u, 0u, 0u, 0u}; \
                if ((cc) > 0 || tl >= 0) { const bf16* _p = U + (size_t)((long)_rb + tl) * LDE + g * 128 + 8 * _cg; rawB[j] = *(const u32x4*)(_p + EBB); rawC[j] = *(const u32x4*)(_p + ECC); } } \
            const int _cx = tid & 3, _t = tid >> 2; \
            _Pragma("unroll") for (int j = 0; j < 4; ++j) { const int tl = _t - 3 + j; rawX[j] = (u32x4){0u, 0u, 0u, 0u}; \
                if ((cc) > 0 || tl >= 0) rawX[j] = *(const u32x4*)(U + (size_t)((long)_rb + tl) * LDE + EXS + h * 64 + ph * 32 + 8 * _cx); } \
            if (tid < 128) rawdt = U[(_rb + tid) * LDE + EDT + h]; } while (0)
#define SSD_FETCH_Z(cc) do { if (w < 4) { const size_t _rb = (size_t)b * SEQ + (size_t)(cc) * 128; \
            _Pragma("unroll") for (int i = 0; i < 16; ++i) rawz[i] = U[(_rb + 32 * w + 8 * (i >> 2) + 4 * (lane >> 5) + (i & 3)) * LDE + EZ + h * 64 + ph * 32 + (lane & 31)]; } } while (0)
        { int tid = F.tid, lane = F.lane; asm volatile("" : "+v"(tid), "+v"(lane)); SSD_FETCH_BCX(0); SSD_FETCH_Z(0); }
        for (int c = 0; c < 32; ++c) {
            const size_t rowbase = (size_t)b * SEQ + (size_t)c * 128;
            int tid = F.tid, lane = F.lane; asm volatile("" : "+v"(tid), "+v"(lane));
            if (tid < 128) {
                const float dr = bf2f((unsigned short)rawdt) + dtb;
                const float dt = dr > 20.f ? dr : log1pf(__expf(dr));
                float s = dt * a_h;
#pragma unroll
                for (int o = 1; o < 64; o <<= 1) { const float t = __shfl_up(s, o); if (lane >= o) s += t; }
                dtv[tid] = dt; acum[tid] = s;
            }
            {
                const int cg = tid & 15, rr = tid >> 4;
#pragma unroll
                for (int T = 0; T < 2; ++T) {
                    u32x4 raw[7];
#pragma unroll
                    for (int j = 0; j < 7; ++j) raw[j] = T == 0 ? rawB[j] : rawC[j];
                    LAS unsigned char* dst = L + (T == 0 ? L_BS : L_CS);
                    unsigned opk[4][4];
#pragma unroll
                    for (int e2 = 0; e2 < 4; ++e2) {
                        const int lc = T * 128 + 8 * cg + 2 * e2;
                        const f32x2 w0 = *(const LAS f32x2*)(cw + lc), w1 = *(const LAS f32x2*)(cw + 288 + lc), w2 = *(const LAS f32x2*)(cw + 576 + lc), w3 = *(const LAS f32x2*)(cw + 864 + lc), bb = *(const LAS f32x2*)(cw + 1152 + lc);
                        float lo[7], hi[7];
#pragma unroll
                        for (int j = 0; j < 7; ++j) { lo[j] = bflo(raw[j][e2]); hi[j] = bfhi(raw[j][e2]); }
                        float ol[4], oh[4];
#pragma unroll
                        for (int q = 0; q < 4; ++q) { ol[q] = siluf(bb.x + w0.x * lo[q] + w1.x * lo[q + 1] + w2.x * lo[q + 2] + w3.x * lo[q + 3]);
                                                      oh[q] = siluf(bb.y + w0.y * hi[q] + w1.y * hi[q + 1] + w2.y * hi[q + 2] + w3.y * hi[q + 3]); opk[q][e2] = pk2(ol[q], oh[q]); }
                        if (T == 0) {
                            *(LAS u32x2*)(L + L_BT + ((8 * cg + 2 * e2) * SP + 4 * rr) * 2) = (u32x2){pk2(ol[0], ol[1]), pk2(ol[2], ol[3])};
                            *(LAS u32x2*)(L + L_BT + ((8 * cg + 2 * e2 + 1) * SP + 4 * rr) * 2) = (u32x2){pk2(oh[0], oh[1]), pk2(oh[2], oh[3])};
                        }
                    }
#pragma unroll
                    for (int q = 0; q < 4; ++q) *(LAS u32x4*)(dst + ((4 * rr + q) * SP + 8 * cg) * 2) = (u32x4){opk[q][0], opk[q][1], opk[q][2], opk[q][3]};
                }
            }
            __syncthreads();
            if (tid >= 64 && tid < 128) acum[tid] += acum[63];
            __syncthreads();
            {
                const int cg = tid & 3, t = tid >> 2;
                const int gcol = EXS + h * 64 + ph * 32 + 8 * cg;
                u32x4 raw[4];
#pragma unroll
                for (int j = 0; j < 4; ++j) raw[j] = rawX[j];
                const float sc = dtv[t] * __expf(acum[127] - acum[t]);
#pragma unroll
                for (int e = 0; e < 8; ++e) { const int lc = 256 + 8 * cg + e;
                    float rv[4];
#pragma unroll
                    for (int j = 0; j < 4; ++j) rv[j] = (e & 1) ? bfhi(raw[j][e >> 1]) : bflo(raw[j][e >> 1]);
                    const float xv = siluf(cw[1152 + lc] + cw[lc] * rv[0] + cw[288 + lc] * rv[1] + cw[576 + lc] * rv[2] + cw[864 + lc] * rv[3]);
                    *(LAS bf16*)(L + L_XT + ((8 * cg + e) * SP + t) * 2) = (bf16)f2bfh(xv);
                    *(LAS bf16*)(L + L_XS + ((8 * cg + e) * SP + t) * 2) = (bf16)f2bfh(xv * sc); }
            }
            if (c + 1 < 32) SSD_FETCH_BCX(c + 1);
            const int mt = w >> 1, nh = w & 1, r = lane & 31, hh = lane >> 5;
            f32x16 cb[2];
#pragma unroll
            for (int j = 0; j < 2; ++j) {
                cb[j] = (f32x16){0.f, 0.f, 0.f, 0.f, 0.f, 0.f, 0.f, 0.f, 0.f, 0.f, 0.f, 0.f, 0.f, 0.f, 0.f, 0.f};
                const int s0 = 64 * nh + 32 * j;
                if (s0 <= 32 * mt + 31) {
#pragma unroll
                    for (int ks = 0; ks < 8; ++ks) {
                        const bf16x8 af = lds_frag(L + L_CS, 32 * mt + r, 16 * ks + 8 * hh), bfg = lds_frag(L + L_BS, s0 + r, 16 * ks + 8 * hh);
                        cb[j] = __builtin_amdgcn_mfma_f32_32x32x16_bf16(af, bfg, cb[j], 0, 0, 0);
                    }
                }
            }
            __syncthreads();
#pragma unroll
            for (int j = 0; j < 2; ++j) {
                const int s = 64 * nh + 32 * j + r; const float as = acum[s], ds = dtv[s];
#pragma unroll
                for (int i = 0; i < 16; ++i) { const int t = 32 * mt + 8 * (i >> 2) + 4 * hh + (i & 3);
                    const float v = (s <= t) ? cb[j][i] * __expf(acum[t] - as) * ds : 0.f;
                    *(LAS bf16*)(L + L_BS + (t * SP + s) * 2) = (bf16)f2bfh(v); }
            }
            __syncthreads();
            if (w < 4) {
                f32x16 yd = {0.f, 0.f, 0.f, 0.f, 0.f, 0.f, 0.f, 0.f, 0.f, 0.f, 0.f, 0.f, 0.f, 0.f, 0.f, 0.f}, yo = yd;
                for (int ks = 0; ks < 2 * (w + 1); ++ks) {
                    const bf16x8 af = lds_frag(L + L_BS, 32 * w + r, 16 * ks + 8 * hh), bfg = lds_frag(L + L_XT, r, 16 * ks + 8 * hh);
                    yd = __builtin_amdgcn_mfma_f32_32x32x16_bf16(af, bfg, yd, 0, 0, 0);
                }
                LAS unsigned char* stc = L + L_ST + (c & 1) * (32 * SP * 2);
#pragma unroll
                for (int ks = 0; ks < 8; ++ks) {
                    const bf16x8 af = lds_frag(L + L_CS, 32 * w + r, 16 * ks + 8 * hh), bfg = lds_frag(stc, r, 16 * ks + 8 * hh);
                    yo = __builtin_amdgcn_mfma_f32_32x32x16_bf16(af, bfg, yo, 0, 0, 0);
                }
#pragma unroll
                for (int q = 0; q < 4; ++q) {
                    const int t0 = 32 * w + 8 * q + 4 * hh;
                    const u32x2 xx = *(const LAS u32x2*)(L + L_XT + (r * SP + t0) * 2);
                    const float xv[4] = {bflo(xx.x), bfhi(xx.x), bflo(xx.y), bfhi(xx.y)};
#pragma unroll
                    for (int e = 0; e < 4; ++e) { const int t = t0 + e, i = 4 * q + e;
                        bf16* zp = U + (rowbase + t) * LDE + EZ + h * 64 + ph * 32 + r;
                        const float z = bf2f((unsigned short)rawz[i]);
                        const float y = yd[i] + __expf(acum[t]) * yo[i] + dsk * xv[e];
                        *zp = (bf16)f2bfh(y * siluf(z)); }
                }
                if (c + 1 < 32) SSD_FETCH_Z(c + 1);
            } else {
                const int n0 = 32 * (w - 4); const float dec = __expf(acum[127]);
#pragma unroll
                for (int i = 0; i < 16; ++i) state[i] *= dec;
#pragma unroll
                for (int ks = 0; ks < 8; ++ks) {
                    const bf16x8 af = lds_frag(L + L_XS, r, 16 * ks + 8 * hh), bfg = lds_frag(L + L_BT, n0 + r, 16 * ks + 8 * hh);
                    state = __builtin_amdgcn_mfma_f32_32x32x16_bf16(af, bfg, state, 0, 0, 0);
                }
                LAS unsigned char* stn = L + L_ST + ((c + 1) & 1) * (32 * SP * 2);
#pragma unroll
                for (int i = 0; i < 16; ++i) { const int p = 8 * (i >> 2) + 4 * hh + (i & 3);
                    *(LAS bf16*)(stn + (p * SP + n0 + r) * 2) = (bf16)f2bfh(state[i]); }
            }
            __syncthreads();
        }
    }
}

#undef SSD_FETCH_BCX
#undef SSD_FETCH_Z
typedef short s16x4 __attribute__((ext_vector_type(4)));
__device__ __forceinline__ s16x4 lds_tr16(LAS unsigned char* p) { return __builtin_bit_cast(s16x4, __builtin_amdgcn_ds_read_tr16_b64_v4i16((LAS s16x4*)p)); }
__device__ __forceinline__ int t5_bucket_dev(int d) {
    if (d < 16) return d;
    const int v = 16 + (int)(log((double)d / 16.0) / log(8.0) * 16.0);
    return v < 31 ? v : 31;
}
constexpr int D_SEL = 131072, D_LUT = 135168, VP = 72;
__device__ __forceinline__ int okey(float f) { const int iv = __builtin_bit_cast(int, f); return iv ^ ((iv >> 31) & 0x7fffffff); }

__device__ __forceinline__ void p_dsa(Frame& F, const Args& A) {
    bf16* U = (bf16*)(F.ws + WS_U); bf16* HB = (bf16*)(F.ws + WS_HB);
    const int w = F.wave;
    const float* ng = A.in[10];
    LAS unsigned char* L = F.lds;
    LAS float* LUT = (LAS float*)(L + D_LUT);
    for (int i = F.tid; i < 1024; i += NTHR) LUT[i] = A.in[1][t5_bucket_dev(i >> 3) * 8 + (i & 7)];
    __syncthreads();
    for (int blk = F.bid; blk < MTOK / 8; blk += F.G) {
        int lane = F.lane; asm volatile("" : "+v"(lane));
        const int kr = blk >> 8, cc = blk & 255, b = kr >> 1, tb = (kr & 1) ? 511 - cc : cc, t0 = tb * 8;
        const size_t bat = (size_t)b * SEQ, rowb = bat + t0;
        {
            const size_t row = rowb + w;
            const u32x4 v = *(const u32x4*)(U + row * LDE + EZ + 8 * lane);
            float f[8] = {bflo(v.x), bfhi(v.x), bflo(v.y), bfhi(v.y), bflo(v.z), bfhi(v.z), bflo(v.w), bfhi(v.w)};
            float s = 0.f;
#pragma unroll
            for (int j = 0; j < 8; ++j) s += f[j] * f[j];
#pragma unroll
            for (int o = 1; o < 32; o <<= 1) s += __shfl_xor(s, o);
            const float rs = 1.f / sqrtf(s * (1.f / 256.f) + NORM_EPS); const float* g = ng + 8 * lane;
            u32x4 o; o.x = pk2(f[0] * rs * g[0], f[1] * rs * g[1]); o.y = pk2(f[2] * rs * g[2], f[3] * rs * g[3]); o.z = pk2(f[4] * rs * g[4], f[5] * rs * g[5]); o.w = pk2(f[6] * rs * g[6], f[7] * rs * g[7]);
            *(u32x4*)(HB + row * DM + 8 * lane) = o;
        }
        {
            const int r = lane & 31, hh = lane >> 5;
            bf16x8 qa[4];
#pragma unroll
            for (int ks = 0; ks < 4; ++ks) qa[ks] = *(const bf16x8*)(U + (rowb + (r >> 2)) * LDE + EIQ + (r & 3) * 64 + 16 * ks + 8 * hh);
            float wv[4][4];
#pragma unroll
            for (int q = 0; q < 4; ++q) { const u32x2 ww = *(const u32x2*)(U + (rowb + 2 * q + hh) * LDE + EIW); wv[q][0] = bflo(ww.x); wv[q][1] = bfhi(ww.x); wv[q][2] = bflo(ww.y); wv[q][3] = bfhi(ww.y); }
            const int ntile = (t0 + 8 + 31) >> 5;
            for (int tb = w; tb < ntile; tb += 4 * NWAVES) {
                bf16x8 kf[4][4];
#pragma unroll
                for (int u4 = 0; u4 < 4; ++u4) { const int tl = tb + 8 * u4 < 128 ? tb + 8 * u4 : 127; const int key = 32 * tl + r;
#pragma unroll
                    for (int ks = 0; ks < 4; ++ks) kf[u4][ks] = *(const bf16x8*)(U + (bat + key) * LDE + EIK + 16 * ks + 8 * hh); }
#pragma unroll
                for (int u4 = 0; u4 < 4; ++u4) {
                    const int tile = tb + 8 * u4;
                    f32x16 acc = {0.f, 0.f, 0.f, 0.f, 0.f, 0.f, 0.f, 0.f, 0.f, 0.f, 0.f, 0.f, 0.f, 0.f, 0.f, 0.f};
#pragma unroll
                    for (int ks = 0; ks < 4; ++ks) acc = __builtin_amdgcn_mfma_f32_32x32x16_bf16(qa[ks], kf[u4][ks], acc, 0, 0, 0);
                    if (tile < ntile) {
#pragma unroll
                        for (int q = 0; q < 4; ++q) {
                            const float sc = wv[q][0] * fmaxf(acc[4 * q], 0.f) + wv[q][1] * fmaxf(acc[4 * q + 1], 0.f) + wv[q][2] * fmaxf(acc[4 * q + 2], 0.f) + wv[q][3] * fmaxf(acc[4 * q + 3], 0.f);
                            *(LAS float*)(L + ((2 * q + hh) * 4096 + 32 * tile + r) * 4) = sc + 0.f;
                        }
                    }
                }
            }
        }
        __syncthreads();
        const int t = t0 + w, n = t + 1;
        LAS unsigned short* sel = (LAS unsigned short*)(L + D_SEL) + w * 256;
        const int cnt = n < 256 ? n : 256;
        if (n <= 256) {
#pragma unroll
            for (int i = 0; i < 4; ++i) { const int s = lane + 64 * i; sel[s] = (unsigned short)(s < n ? s : 0); }
        } else {
            const int nj = (t0 + 8 + 63) >> 6;
            const LAS float* myrow = (const LAS float*)(L + w * 16384);
            int v[64]; int vmax = (int)0x80000000, vmin = 0x7fffffff;
#pragma unroll
            for (int jb = 0; jb < 4; ++jb) {
                if (16 * jb < nj) {
#pragma unroll
                    for (int jj = 0; jj < 16; ++jj) { const int j = 16 * jb + jj; const int idx = lane + 64 * j; const int kv = okey(myrow[idx]);
                        const bool ok = idx <= t; v[j] = ok ? kv : (int)0x80000000; vmax = v[j] > vmax ? v[j] : vmax; const int x = ok ? kv : 0x7fffffff; vmin = x < vmin ? x : vmin; }
                } else {
#pragma unroll
                    for (int jj = 0; jj < 16; ++jj) v[16 * jb + jj] = (int)0x80000000;
                }
            }
#pragma unroll
            for (int o = 1; o < 64; o <<= 1) { const int x = __shfl_xor(vmax, o); vmax = x > vmax ? x : vmax; const int y = __shfl_xor(vmin, o); vmin = y < vmin ? y : vmin; }
            vmax = __builtin_amdgcn_readfirstlane(vmax); vmin = __builtin_amdgcn_readfirstlane(vmin);
            int lo = vmin, hi = vmax, clo = n, chi = 0, it = 0;
            for (int rps = 0; rps < (REP_PART == 4 ? A.rep : 1); ++rps) { lo = vmin; hi = vmax; clo = n; chi = 0; it = 0;
            while (lo < hi) {
                int mid;
                const int ph3 = it % 3;
                if (ph3 == 2) mid = lo + (int)(((long long)hi - (long long)lo + 1) >> 1);
                else {
                    const float lof = __builtin_bit_cast(float, lo >= 0 ? lo : lo ^ 0x7fffffff), hif = __builtin_bit_cast(float, hi >= 0 ? hi : hi ^ 0x7fffffff);
                    const float fr = ph3 == 0 ? ((float)(clo - 256) + 0.5f) / (float)(clo - chi) : 0.5f;
                    mid = okey(lof + (hif - lof) * fr);
                    mid = mid > hi ? hi : mid; mid = mid <= lo ? lo + 1 : mid;
                }
                int c = 0;
#pragma unroll
                for (int jb = 0; jb < 4; ++jb) if (16 * jb < nj) {
#pragma unroll
                    for (int jj = 0; jj < 16; ++jj) c += __popcll(__ballot(v[16 * jb + jj] >= mid)); }
                ++it;
                if (c == 256) { lo = mid; break; }
                if (c > 256) { lo = mid; clo = c; } else { hi = mid - 1; chi = c; }
            } }
            const int T = lo;
            int cgt = 0;
#pragma unroll
            for (int jb = 0; jb < 4; ++jb) if (16 * jb < nj) {
#pragma unroll
                for (int jj = 0; jj < 16; ++jj) cgt += __popcll(__ballot(v[16 * jb + jj] > T)); }
            const int need_eq = 256 - cgt;
            int obase = 0, ebase = 0;
            for (int rpf = 0; rpf < (REP_PART == 5 ? A.rep : 1); ++rpf) { obase = 0; ebase = 0;
#pragma unroll
            for (int jb = 0; jb < 4; ++jb) if (16 * jb < nj) {
#pragma unroll
                for (int jj = 0; jj < 16; ++jj) { const int j = 16 * jb + jj;
                    const bool gt = v[j] > T, eq = v[j] == T;
                    const unsigned long long be = __ballot(eq);
                    const int erank = ebase + (int)__builtin_amdgcn_mbcnt_hi((unsigned)(be >> 32), __builtin_amdgcn_mbcnt_lo((unsigned)be, 0u));
                    const bool take = gt || (eq && erank < need_eq);
                    const unsigned long long bt = __ballot(take);
                    const int pos = obase + (int)__builtin_amdgcn_mbcnt_hi((unsigned)(bt >> 32), __builtin_amdgcn_mbcnt_lo((unsigned)bt, 0u));
                    if (take && pos < 256) sel[pos] = (unsigned short)(lane + 64 * j);
                    obase += __popcll(bt); ebase += __popcll(be); } } }
        }
        __syncthreads();
        {
            const int hd = lane & 15, g4 = lane >> 4;
            const size_t row = rowb + w;
            bf16x8 qb[2];
            {
                float qf[2][8]; float ss = 0.f;
#pragma unroll
                for (int ks = 0; ks < 2; ++ks) { u32x4 qq = (u32x4){0u, 0u, 0u, 0u};
                    if (hd < 8) qq = *(const u32x4*)(U + row * LDE + EQ + hd * 64 + 32 * ks + 8 * g4);
                    qf[ks][0] = bflo(qq.x); qf[ks][1] = bfhi(qq.x); qf[ks][2] = bflo(qq.y); qf[ks][3] = bfhi(qq.y); qf[ks][4] = bflo(qq.z); qf[ks][5] = bfhi(qq.z); qf[ks][6] = bflo(qq.w); qf[ks][7] = bfhi(qq.w);
#pragma unroll
                    for (int j = 0; j < 8; ++j) ss += qf[ks][j] * qf[ks][j]; }
                ss += __shfl_xor(ss, 16); ss += __shfl_xor(ss, 32);
                const float rs = 0.125f / sqrtf(ss * (1.f / 64.f) + NORM_EPS);
#pragma unroll
                for (int ks = 0; ks < 2; ++ks) { const float* gq = A.in[11] + 32 * ks + 8 * g4;
                    u32x4 pk; pk.x = pk2(qf[ks][0] * rs * gq[0], qf[ks][1] * rs * gq[1]); pk.y = pk2(qf[ks][2] * rs * gq[2], qf[ks][3] * rs * gq[3]);
                    pk.z = pk2(qf[ks][4] * rs * gq[4], qf[ks][5] * rs * gq[5]); pk.w = pk2(qf[ks][6] * rs * gq[6], qf[ks][7] * rs * gq[7]);
                    qb[ks] = __builtin_bit_cast(bf16x8, pk); }
            }
            float lg[16][4]; float mx = -3.0e38f;
            const int vsl = lane >> 3, vpart = lane & 7;
            u32x4 vr[2][8];
#pragma unroll
            for (int hb = 0; hb < 2; ++hb) {
                bf16x8 ka[8][2];
#pragma unroll
                for (int T8 = 0; T8 < 8; ++T8) { const int sm = sel[16 * (8 * hb + T8) + hd]; const bf16* kp = U + (bat + sm) * LDE + EK + 8 * g4;
                    ka[T8][0] = *(const bf16x8*)kp; ka[T8][1] = *(const bf16x8*)(kp + 32); }
#pragma unroll
                for (int e = 0; e < 8; ++e) { const int sm = sel[64 * hb + 8 * e + vsl]; vr[hb][e] = *(const u32x4*)(U + (bat + sm) * LDE + EV + 8 * vpart); }
#pragma unroll
                for (int T8 = 0; T8 < 8; ++T8) { const int T = 8 * hb + T8;
                    f32x4 acc = {0.f, 0.f, 0.f, 0.f};
                    acc = __builtin_amdgcn_mfma_f32_16x16x32_bf16(ka[T8][0], qb[0], acc, 0, 0, 0);
                    acc = __builtin_amdgcn_mfma_f32_16x16x32_bf16(ka[T8][1], qb[1], acc, 0, 0, 0);
                    const u32x2 sl = *(const LAS u32x2*)(sel + 16 * T + 4 * g4);
                    const int s4[4] = {(int)(sl.x & 0xffffu), (int)(sl.x >> 16), (int)(sl.y & 0xffffu), (int)(sl.y >> 16)};
#pragma unroll
                    for (int i = 0; i < 4; ++i) { int dist = t - s4[i]; dist = dist < 0 ? 0 : (dist > 127 ? 127 : dist);
                        const float bia = LUT[dist * 8 + (hd & 7)];
                        const bool valid = (16 * T + 4 * g4 + i) < cnt;
                        lg[T][i] = valid ? acc[i] + bia : -3.0e38f; mx = fmaxf(mx, lg[T][i]); }
                }
            }
            mx = fmaxf(mx, __shfl_xor(mx, 16)); mx = fmaxf(mx, __shfl_xor(mx, 32));
            float sum = 0.f;
#pragma unroll
            for (int T = 0; T < 16; ++T) {
#pragma unroll
                for (int i = 0; i < 4; ++i) { const float p = lg[T][i] > -1.0e38f ? __expf(lg[T][i] - mx) : 0.f; lg[T][i] = p; sum += p; }
                if ((T & 3) == 3) __builtin_amdgcn_sched_barrier(0); }
            sum += __shfl_xor(sum, 16); sum += __shfl_xor(sum, 32);
            const float inv = 1.f / fmaxf(sum, 1e-30f);
            f32x4 oacc[4];
#pragma unroll
            for (int dt = 0; dt < 4; ++dt) oacc[dt] = (f32x4){0.f, 0.f, 0.f, 0.f};
            LAS unsigned char* Vl = L + w * 16384;
#pragma unroll
            for (int ch = 0; ch < 4; ++ch) {
                LDS_WAIT();
#pragma unroll
                for (int e = 0; e < 8; ++e) *(LAS u32x4*)(Vl + ((8 * e + vsl) * VP + 8 * vpart) * 2) = vr[ch & 1][e];
                if (ch + 2 < 4) {
#pragma unroll
                    for (int e = 0; e < 8; ++e) { const int sm = sel[64 * (ch + 2) + 8 * e + vsl]; vr[ch & 1][e] = *(const u32x4*)(U + (bat + sm) * LDE + EV + 8 * vpart); }
                }
                LDS_WAIT();
#pragma unroll
                for (int kk = 0; kk < 2; ++kk) {
                    const int T0 = 2 * (2 * ch + kk);
                    u32x4 pp; pp.x = pk2(lg[T0][0] * inv, lg[T0][1] * inv); pp.y = pk2(lg[T0][2] * inv, lg[T0][3] * inv); pp.z = pk2(lg[T0 + 1][0] * inv, lg[T0 + 1][1] * inv); pp.w = pk2(lg[T0 + 1][2] * inv, lg[T0 + 1][3] * inv);
                    const bf16x8 pf = __builtin_bit_cast(bf16x8, pp);
                    const int qq = (lane & 15) >> 2, p4 = lane & 3;
#pragma unroll
                    for (int dt = 0; dt < 4; ++dt) {
                        const s16x4 b0 = lds_tr16(Vl + ((32 * kk + 4 * g4 + qq) * VP + 16 * dt + 4 * p4) * 2);
                        const s16x4 b1 = lds_tr16(Vl + ((32 * kk + 16 + 4 * g4 + qq) * VP + 16 * dt + 4 * p4) * 2);
                        bf16x8 bfg; bfg[0] = b0[0]; bfg[1] = b0[1]; bfg[2] = b0[2]; bfg[3] = b0[3]; bfg[4] = b1[0]; bfg[5] = b1[1]; bfg[6] = b1[2]; bfg[7] = b1[3];
                        oacc[dt] = __builtin_amdgcn_mfma_f32_16x16x32_bf16(pf, bfg, oacc[dt], 0, 0, 0);
                    }
                }
            }
            if (g4 < 2) {
#pragma unroll
                for (int i = 0; i < 4; ++i)
#pragma unroll
                    for (int dt = 0; dt < 4; ++dt) HB[row * DM + 512 + (4 * g4 + i) * 64 + 16 * dt + hd] = (bf16)f2bfh(oacc[dt][i]);
            }
        }
        __syncthreads();
    }
}

template <int MODE> __device__ __forceinline__ void p_norm_route(Frame& F, const float* xin, const float* gain, int layer) {
    constexpr int NT = MODE == 0 ? 3 : 2;
    bf16* HB = (bf16*)(F.ws + WS_HB); const bf16* WR = MODE == 0 ? (const bf16*)(F.ws + WS_WR) + (size_t)layer * 48 * 1024 : (const bf16*)(F.ws + WS_WGL);
    float* GL = (float*)(F.ws + WS_GL);
    int* list = (int*)(F.ws + WS_LIST); float* wl = (float*)(F.ws + WS_LISTW);
    LAS unsigned char* L = F.lds;
    LAS float* lgt = (LAS float*)L + F.wave * (16 * 48);
    LAS int* cntl = (LAS int*)(L + 32768); LAS int* basel = (LAS int*)(L + 33024);
    LAS int* ri_e = (LAS int*)(L + 34816); LAS int* ri_p = (LAS int*)(L + 36864); LAS float* ri_w = (LAS float*)(L + 38912);
    const int w = F.wave;
    for (int base = F.bid * 256; base < MTOK; base += F.G * 256) {
        int lane = F.lane; asm volatile("" : "+v"(lane));
        if (F.tid < 64) cntl[F.tid] = 0;
        __syncthreads();
#pragma unroll 1
        for (int half = 0; half < 2; ++half) {
            const int R0 = base + w * 32 + half * 16;
#pragma unroll 1
            for (int i = 0; i < 16; ++i) rms_row_to_bf16(xin + (size_t)(R0 + i) * DM, gain, HB + (size_t)(R0 + i) * DM, lane);
            VM_WAIT();
            const int n16 = lane & 15, g4 = lane >> 4;
            f32x4 acc[NT];
#pragma unroll
            for (int nt = 0; nt < NT; ++nt) acc[nt] = (f32x4){0.f, 0.f, 0.f, 0.f};
#pragma unroll 4
            for (int kk = 0; kk < 32; ++kk) {
                const bf16x8 a = *(const bf16x8*)(HB + (size_t)(R0 + n16) * DM + 32 * kk + 8 * g4);
#pragma unroll
                for (int nt = 0; nt < NT; ++nt) { const bf16x8 bb = *(const bf16x8*)(WR + (size_t)(16 * nt + n16) * DM + 32 * kk + 8 * g4);
                    acc[nt] = __builtin_amdgcn_mfma_f32_16x16x32_bf16(a, bb, acc[nt], 0, 0, 0); }
            }
            if constexpr (MODE == 1) {
#pragma unroll
                for (int nt = 0; nt < NT; ++nt)
#pragma unroll
                    for (int i = 0; i < 4; ++i) if (16 * nt + n16 < 24) GL[(size_t)(R0 + 4 * g4 + i) * 24 + 16 * nt + n16] = acc[nt][i];
            } else {
#pragma unroll
            for (int nt = 0; nt < NT; ++nt)
#pragma unroll
                for (int i = 0; i < 4; ++i) lgt[(4 * g4 + i) * 48 + 16 * nt + n16] = acc[nt][i];
            LDS_WAIT();
            if (lane < 16) {
                const LAS float* lr = lgt + lane * 48;
                int gs = 0; float gm = lr[0];
#pragma unroll
                for (int j = 1; j < 4; ++j) if (lr[j] > gm) { gm = lr[j]; gs = j; }
                float gsum = 0.f;
#pragma unroll
                for (int j = 0; j < 4; ++j) gsum += __expf(lr[j] - gm);
                const float gw = 1.f / gsum;
                const LAS float* er = lr + 4 + 8 * gs;
                int i0 = 0; float m0 = er[0];
#pragma unroll
                for (int j = 1; j < 8; ++j) if (er[j] > m0) { m0 = er[j]; i0 = j; }
                int i1 = -1; float m1 = -3.0e38f;
#pragma unroll
                for (int j = 0; j < 8; ++j) if (j != i0 && er[j] > m1) { m1 = er[j]; i1 = j; }
                const float w0 = 1.f / (1.f + __expf(m1 - m0));
                const int e0 = gs * 8 + i0, e1 = 32 + gs * 8 + i1;
                const int rs = (w * 32 + half * 16 + lane) * 2;
                ri_e[rs] = e0; ri_p[rs] = __hip_atomic_fetch_add(cntl + e0, 1, __ATOMIC_RELAXED, __HIP_MEMORY_SCOPE_WORKGROUP); ri_w[rs] = w0 * gw;
                ri_e[rs + 1] = e1; ri_p[rs + 1] = __hip_atomic_fetch_add(cntl + e1, 1, __ATOMIC_RELAXED, __HIP_MEMORY_SCOPE_WORKGROUP); ri_w[rs + 1] = (1.f - w0) * gw;
            }
            LDS_WAIT();
            }
        }
        if constexpr (MODE == 1) continue;
        __syncthreads();
        if (F.tid < 64) { const int c = cntl[F.tid]; basel[F.tid] = c ? (int)__hip_atomic_fetch_add((unsigned*)(F.ctl + CW_CNT + layer * 4096 + 64 * F.tid), (unsigned)c, RLX_AGENT) : 0; }
        __syncthreads();
        { const int rs = F.tid, e = ri_e[rs], pos = basel[e] + ri_p[rs];
          list[(size_t)e * 65536 + pos] = base + (rs >> 1); wl[(size_t)e * 65536 + pos] = ri_w[rs]; }
        __syncthreads();
    }
}
__device__ __forceinline__ void moe_tables(Frame& F, int layer) {
    LAS int* ptile = (LAS int*)(F.lds + MOE_OFF); LAS int* cntv = ptile + 128;
    __syncthreads();
    if (F.tid < 64) {
        const int c = (int)__hip_atomic_load((unsigned*)(F.ctl + CW_CNT + layer * 4096 + 64 * F.tid), RLX_AGENT);
        cntv[F.tid] = c;
        int nt = (c + 255) >> 8, incl = nt;
#pragma unroll
        for (int o = 1; o < 64; o <<= 1) { const int t = __shfl_up(incl, o); if (F.lane >= o) incl += t; }
        ptile[F.tid] = incl - nt; if (F.tid == 63) ptile[64] = incl;
    }
    __syncthreads();
}
__device__ __forceinline__ void p_moe_gu(Frame& F, int layer) {
    moe_tables(F, layer);
    const LAS int* ptile = (const LAS int*)(F.lds + MOE_OFF); const LAS int* cntv = ptile + 128;
    pg8::MoeOrder S{(const char*)(F.ws + WS_HB), (const char*)(F.ws + WS_WGU) + (size_t)layer * 32 * 1024 * 1024 * 2, (size_t)1024 * 1024 * 2, 1024, F.G, F.bid, 0, ptile[64], ptile, cntv, (const int*)(F.ws + WS_LIST), true};
    pg8::EpiSwiGLU E{(bf16*)(F.ws + WS_U)};
    pg8::gemm_phase<pg8::EpiSwiGLU, pg8::MoeOrder, true>(F.lds, 1024, S, E);
}
__device__ __forceinline__ void p_moe_down(Frame& F, int layer, int slot) {
    moe_tables(F, layer);
    const LAS int* ptile = (const LAS int*)(F.lds + MOE_OFF); const LAS int* cntv = ptile + 128;
    pg8::MoeOrder S{(const char*)(F.ws + WS_U), (const char*)(F.ws + WS_WD) + (size_t)layer * 32 * 1024 * 512 * 2, (size_t)1024 * 512 * 2, 512, F.G, F.bid, ptile[32 * slot], ptile[32 * slot + 32], ptile, cntv, (const int*)(F.ws + WS_LIST), false};
    pg8::EpiScatter E{F.out, (const int*)(F.ws + WS_LIST), (const float*)(F.ws + WS_LISTW), cntv};
    pg8::gemm_phase<pg8::EpiScatter, pg8::MoeOrder, true>(F.lds, 512, S, E);
}

__device__ __forceinline__ void p_compress(Frame& F, const Args& A) {
    bf16* U = (bf16*)(F.ws + WS_U);
    LAS unsigned char* L = F.lds;
    const int w = F.wave;
    {
        const int tid = F.tid, sub = tid & 15;
        for (int v0 = F.bid * 32; v0 < MTOK * 4; v0 += F.G * 32) {
            const int vec = v0 + (tid >> 4), row = vec >> 2, wh = vec & 3;
            bf16* p = U + (size_t)row * LDO + ((wh >> 1) ? OKW : OKS) + (wh & 1) * 128 + 8 * sub;
            const float* g = ((wh >> 1) ? A.in[18] : A.in[17]) + 8 * sub;
            const u32x4 v = *(const u32x4*)p; float f[8] = {bflo(v.x), bfhi(v.x), bflo(v.y), bfhi(v.y), bflo(v.z), bfhi(v.z), bflo(v.w), bfhi(v.w)};
            float s = 0.f;
#pragma unroll
            for (int j = 0; j < 8; ++j) s += f[j] * f[j];
            s += __shfl_xor(s, 1); s += __shfl_xor(s, 2); s += __shfl_xor(s, 4); s += __shfl_xor(s, 8);
            const float rs = 1.f / sqrtf(s * (1.f / 128.f) + NORM_EPS);
            u32x4 o; o.x = pk2(f[0] * rs * g[0], f[1] * rs * g[1]); o.y = pk2(f[2] * rs * g[2], f[3] * rs * g[3]); o.z = pk2(f[4] * rs * g[4], f[5] * rs * g[5]); o.w = pk2(f[6] * rs * g[6], f[7] * rs * g[7]);
            *(u32x4*)p = o;
        }
    }
    constexpr int C_A = 0, C_B = 17408, C_H = 52224, C_S = 69632;
    for (int unit = F.bid; unit < 256; unit += F.G) {
        int tid = F.tid, lane = F.lane; asm volatile("" : "+v"(tid), "+v"(lane));
        const int T = unit >> 7, b = (unit >> 3) & 15, g = (unit >> 2) & 1, cb = unit & 3;
        const int col = (T ? OVC : OKC) + g * 128;
        const float* pos = T ? A.in[20] : A.in[19];
        const bf16* w1t = (const bf16*)(F.ws + (T ? WS_W1V : WS_W1K)); const bf16* w2t = (const bf16*)(F.ws + WS_W2) + T * 128 * 128;
        const int wm = w >> 2, wn = w & 3, r = lane & 31, hh = lane >> 5;
        f32x16 acc = {0.f, 0.f, 0.f, 0.f, 0.f, 0.f, 0.f, 0.f, 0.f, 0.f, 0.f, 0.f, 0.f, 0.f, 0.f, 0.f};
#pragma unroll 1
        for (int l = 0; l < 32; ++l) {
            __syncthreads();
#pragma unroll
            for (int e = 0; e < 2; ++e) { const int q = tid + 512 * e, c = q >> 4, part = q & 15; const int tok = 16 * (64 * cb + c) + l;
                u32x4 v = (u32x4){0u, 0u, 0u, 0u};
                if (tok < SEQ) v = *(const u32x4*)(U + ((size_t)b * SEQ + tok) * LDO + col + 8 * part);
                const f32x4 p0 = *(const f32x4*)(pos + l * 128 + 8 * part), p1 = *(const f32x4*)(pos + l * 128 + 8 * part + 4);
                u32x4 o; o.x = pk2(bflo(v.x) + p0.x, bfhi(v.x) + p0.y); o.y = pk2(bflo(v.y) + p0.z, bfhi(v.y) + p0.w); o.z = pk2(bflo(v.z) + p1.x, bfhi(v.z) + p1.y); o.w = pk2(bflo(v.w) + p1.z, bfhi(v.w) + p1.w);
                *(LAS u32x4*)(L + C_A + (c * SP + 8 * part) * 2) = o; }
#pragma unroll
            for (int e = 0; e < 4; ++e) { const int q = tid + 512 * e, j = q >> 4, part = q & 15;
                *(LAS u32x4*)(L + C_B + (j * SP + 8 * part) * 2) = *(const u32x4*)(w1t + (size_t)j * 4096 + l * 128 + 8 * part); }
            __syncthreads();
#pragma unroll
            for (int ks = 0; ks < 8; ++ks) {
                const bf16x8 af = lds_frag(L + C_A, 32 * wm + r, 16 * ks + 8 * hh), bfg = lds_frag(L + C_B, 32 * wn + r, 16 * ks + 8 * hh);
                acc = __builtin_amdgcn_mfma_f32_32x32x16_bf16(af, bfg, acc, 0, 0, 0);
            }
        }
#pragma unroll
        for (int i = 0; i < 16; ++i) { const int c = 32 * wm + 8 * (i >> 2) + 4 * hh + (i & 3);
            *(LAS bf16*)(L + C_H + (c * SP + 32 * wn + r) * 2) = (bf16)f2bfh(siluf(acc[i])); }
        __syncthreads();
        f32x16 a2 = {0.f, 0.f, 0.f, 0.f, 0.f, 0.f, 0.f, 0.f, 0.f, 0.f, 0.f, 0.f, 0.f, 0.f, 0.f, 0.f};
#pragma unroll
        for (int ks = 0; ks < 8; ++ks) {
            const bf16x8 af = lds_frag(L + C_H, 32 * wm + r, 16 * ks + 8 * hh), bfg = *(const bf16x8*)(w2t + (size_t)(32 * wn + r) * 128 + 16 * ks + 8 * hh);
            a2 = __builtin_amdgcn_mfma_f32_32x32x16_bf16(af, bfg, a2, 0, 0, 0);
        }
        float rsv[16];
        if (T == 0) {
            LAS float* st = (LAS float*)(L + C_S);
#pragma unroll
            for (int i = 0; i < 16; ++i) { float q = a2[i] * a2[i];
                q += __shfl_xor(q, 1); q += __shfl_xor(q, 2); q += __shfl_xor(q, 4); q += __shfl_xor(q, 8); q += __shfl_xor(q, 16);
                if (r == 0) st[(32 * wm + 8 * (i >> 2) + 4 * hh + (i & 3)) * 4 + wn] = q; }
            __syncthreads();
#pragma unroll
            for (int i = 0; i < 16; ++i) { const f32x4 q = *(const LAS f32x4*)(st + (32 * wm + 8 * (i >> 2) + 4 * hh + (i & 3)) * 4);
                rsv[i] = A.in[16][32 * wn + r] / sqrtf((q.x + q.y + q.z + q.w) * (1.f / 128.f) + NORM_EPS); }
        } else {
#pragma unroll
            for (int i = 0; i < 16; ++i) rsv[i] = 1.f;
        }
        bf16* dst = (bf16*)(F.ws + (T ? WS_VCMP : WS_KCMP));
#pragma unroll
        for (int i = 0; i < 16; ++i) { const int c = 64 * cb + 32 * wm + 8 * (i >> 2) + 4 * hh + (i & 3);
            dst[(((size_t)b * 256 + c) * 2 + g) * 128 + 32 * wn + r] = (bf16)f2bfh(a2[i] * rsv[i]); }
    }
}

constexpr int N_STG = 32768;
constexpr int N_K = 0, N_V = 16384, N_LUT = 3 * N_STG, N_IMP = N_LUT + 4096, N_FAC = N_IMP + 16384, N_MSK = N_FAC + 1024, N_UNI = N_MSK + 512, N_CST = N_UNI + 64;
constexpr float LOG2E = 1.44269504f;
enum { BR_CMP = 0, BR_SEL = 1, BR_WIN = 2 };
struct NsaCtx {
    LAS unsigned char* L; const bf16* U; const bf16* KC; const bf16* VC;
    int tid, lane, w, r, hh, b, g, qblk, t0, t, head; size_t bat;
    float mrow, cfar; unsigned mlo, mhi;
};
__device__ __forceinline__ void glds16(const void* gsrc, unsigned lds_dst) { unsigned keep;
    asm volatile("s_mov_b32 %0, m0\n\ts_mov_b32 m0, %2\n\ts_nop 0\n\tglobal_load_lds_dwordx4 %1, off\n\ts_mov_b32 m0, %0" : "=&s"(keep) : "v"(gsrc), "s"(lds_dst) : "memory"); }
#define NSA_BAR() do { asm volatile("" ::: "memory"); __builtin_amdgcn_s_barrier(); asm volatile("" ::: "memory"); } while (0)
template <int BR, bool SUM, bool PV, bool IMP, bool UNITFAC = false>
__device__ __forceinline__ void nsa_pass(const NsaCtx& X, const bf16x8 (&qf)[8], f32x16 (&oacc)[4], float& lsum, const float colfac, const int tlo, const int thi, const unsigned long long tmask) {
    LAS unsigned char* L = X.L; const int r = X.r, hh = X.hh, lane = X.lane;
    const LAS float* LUT = (const LAS float*)(L + N_LUT);
    auto dma = [&](int tl, int st) {
#pragma unroll
        for (int e = 0; e < 2; ++e) { const int pidx = e * 8 + X.w, row = pidx * 4 + (lane >> 4), ch = (lane & 15) ^ (((lane >> 4) << 2) | (X.w & 3));
            const bf16* kp; const bf16* vp;
            if (BR == BR_CMP) { const size_t o = (((size_t)X.b * 256 + 64 * tl + row) * 2 + X.g) * 128 + 8 * ch; kp = X.KC + o; vp = X.VC + o; }
            else { const size_t o = (X.bat + 64 * tl + row) * LDO + X.g * 128 + 8 * ch; kp = X.U + o + (BR == BR_SEL ? OKS : OKW); vp = X.U + o + (BR == BR_SEL ? OVS : OVW); }
            const unsigned ld = (unsigned)__builtin_amdgcn_readfirstlane((int)(unsigned)(__SIZE_TYPE__)(L + st * N_STG + N_K + pidx * 1024));
            glds16(kp, ld); if (PV) glds16(vp, ld + N_V); }
    };
    auto nextt = [&](int tl) { ++tl; while (tl <= thi && !((tmask >> tl) & 1ull)) ++tl; return tl; };
    int tile = nextt(tlo - 1);
    if (tile > thi) return;
    asm volatile("s_waitcnt vmcnt(0)" ::: "memory");
    int nxt = nextt(tile);
    int nn = nxt <= thi ? nextt(nxt) : nxt;
    dma(tile, 0); if (nxt <= thi) dma(nxt, 1);
    int cur = 0;
    const bool gB = X.w >= 4;
    const int kswz = ((r & 3) << 2) | ((r >> 2) & 3);
#define NSA_WAIT_KEEP(has_newer) do { if (has_newer) { if (PV) asm volatile("s_waitcnt vmcnt(4)" ::: "memory"); else asm volatile("s_waitcnt vmcnt(2)" ::: "memory"); } else asm volatile("s_waitcnt vmcnt(0)" ::: "memory"); } while (0)
    if (gB) { NSA_WAIT_KEEP(nxt <= thi); NSA_BAR(); }
    while (tile <= thi) {
        const int st2 = cur >= 1 ? cur - 1 : 2;
        if (!gB) NSA_WAIT_KEEP(nxt <= thi);
        NSA_BAR();
        if (gB && nn <= thi) dma(nn, st2);
        LAS unsigned char* Ls = L + cur * N_STG;
        const int maxpos = BR == BR_CMP ? 16 * (64 * tile + 63) + 31 : 64 * tile + 63, minpos = BR == BR_CMP ? 16 * (64 * tile) + 31 : 64 * tile;
        const bool far = (X.t0 - maxpos >= 113) && (BR != BR_WIN || (X.t0 + 63 - minpos < 512));
        bool selb = true; if (BR == BR_SEL) selb = (tile < 32 ? (X.mlo >> tile) : (X.mhi >> (tile - 32))) & 1u;
        bf16x8 pa[2][2];
        {
            bf16x8 kf[2][8];
#pragma unroll
            for (int mt = 0; mt < 2; ++mt)
#pragma unroll
                for (int ks = 0; ks < 8; ++ks) kf[mt][ks] = *(const LAS bf16x8*)(Ls + N_K + (32 * mt + r) * 256 + 16 * ((2 * ks + hh) ^ kswz));
            asm volatile("" ::: "memory");
            f32x16 sacc[2];
#pragma unroll
            for (int mt = 0; mt < 2; ++mt) sacc[mt] = (f32x16){0.f, 0.f, 0.f, 0.f, 0.f, 0.f, 0.f, 0.f, 0.f, 0.f, 0.f, 0.f, 0.f, 0.f, 0.f, 0.f};
#pragma unroll
            for (int ks = 0; ks < 8; ++ks)
#pragma unroll
                for (int mt = 0; mt < 2; ++mt) sacc[mt] = __builtin_amdgcn_mfma_f32_32x32x16_bf16(kf[mt][ks], qf[ks], sacc[mt], 0, 0, 0);
            const float cf = (BR == BR_SEL && !selb) ? -1.0e30f : X.cfar;
#pragma unroll
            for (int mt = 0; mt < 2; ++mt) {
                if (far) {
#pragma unroll
                    for (int i = 0; i < 16; ++i) { const float p = __builtin_amdgcn_exp2f(sacc[mt][i] + cf);
                        if (SUM) lsum += p; sacc[mt][i] = UNITFAC ? p : p * colfac; }
                } else {
#pragma unroll
                    for (int i = 0; i < 16; ++i) { const int kidx = 32 * mt + 8 * (i >> 2) + 4 * hh + (i & 3);
                        int dist; bool ok;
                        if (BR == BR_CMP) { dist = X.t - (16 * (64 * tile + kidx) + 31); ok = dist >= 0; }
                        else { dist = X.t - (64 * tile + kidx); ok = BR == BR_SEL ? (selb && dist >= 0) : (dist >= 0 && dist < 512); }
                        const int dc = dist < 0 ? 0 : (dist > 127 ? 127 : dist);
                        const float bia = LUT[dc * 8 + X.head];
                        const float ev = __builtin_amdgcn_exp2f(sacc[mt][i] + bia - X.mrow);
                        const float p = ok ? ev : 0.f;
                        if (SUM) lsum += p;
                        sacc[mt][i] = UNITFAC ? p : p * colfac; }
                }
                if (IMP) {
                    LAS float* imp = (LAS float*)(L + N_IMP) + (X.w * 8 + (r >> 2)) * 64;
#pragma unroll
                    for (int q = 0; q < 4; ++q) { float s4 = (sacc[mt][4 * q] + sacc[mt][4 * q + 1]) + (sacc[mt][4 * q + 2] + sacc[mt][4 * q + 3]), s3 = sacc[mt][4 * q + 3];
                        s4 += __shfl_xor(s4, 1); s4 += __shfl_xor(s4, 2); s3 += __shfl_xor(s3, 1); s3 += __shfl_xor(s3, 2);
                        const int n = 16 * tile + 8 * mt + 2 * q + hh;
                        if ((r & 3) == 0) { __hip_atomic_fetch_add(imp + n, s4, __ATOMIC_RELAXED, __HIP_MEMORY_SCOPE_WORKGROUP); if (n < 63) __hip_atomic_fetch_add(imp + n + 1, s3, __ATOMIC_RELAXED, __HIP_MEMORY_SCOPE_WORKGROUP); } }
                }
                if (PV) {
#pragma unroll
                    for (int sI = 0; sI < 2; ++sI) { u32x4 pp; pp.x = pk2(sacc[mt][8 * sI], sacc[mt][8 * sI + 1]); pp.y = pk2(sacc[mt][8 * sI + 2], sacc[mt][8 * sI + 3]); pp.z = pk2(sacc[mt][8 * sI + 4], sacc[mt][8 * sI + 5]); pp.w = pk2(sacc[mt][8 * sI + 6], sacc[mt][8 * sI + 7]);
                        pa[mt][sI] = __builtin_bit_cast(bf16x8, pp); }
                }
            }
        }
        if (gB && nxt <= thi) NSA_WAIT_KEEP(nn <= thi);
        NSA_BAR();
        if (!gB && nn <= thi) dma(nn, st2);
        if (PV) {
            const int q4 = (lane & 15) >> 2, k2 = 2 * ((lane >> 4) & 1) + ((lane & 3) >> 1), sub8 = 8 * (lane & 1);
            s16x4 vb[2][8];
#define NSA_LDV(g, dst) do { const int _row0 = 16 * (g) + 4 * hh + q4; _Pragma("unroll") for (int nt = 0; nt < 4; ++nt) { \
                dst[2 * nt] = lds_tr16(Ls + N_V + _row0 * 256 + 64 * (nt ^ q4) + 16 * (k2 ^ hh) + sub8); \
                dst[2 * nt + 1] = lds_tr16(Ls + N_V + (_row0 + 8) * 256 + 64 * (nt ^ q4) + 16 * (k2 ^ (hh + 2)) + sub8); } } while (0)
            NSA_LDV(0, vb[0]);
#pragma unroll
            for (int g = 0; g < 4; ++g) {
                if (g == 0) NSA_LDV(1, vb[1]); else if (g == 1) NSA_LDV(2, vb[0]); else if (g == 2) NSA_LDV(3, vb[1]);
                asm volatile("" ::: "memory");
#pragma unroll
                for (int nt = 0; nt < 4; ++nt) { const s16x4 b0 = vb[g & 1][2 * nt], b1 = vb[g & 1][2 * nt + 1];
                    bf16x8 bfg; bfg[0] = b0[0]; bfg[1] = b0[1]; bfg[2] = b0[2]; bfg[3] = b0[3]; bfg[4] = b1[0]; bfg[5] = b1[1]; bfg[6] = b1[2]; bfg[7] = b1[3];
                    oacc[nt] = __builtin_amdgcn_mfma_f32_32x32x16_bf16(pa[g >> 1][g & 1], bfg, oacc[nt], 0, 0, 0); }
            }
#undef NSA_LDV
        }
        tile = nxt; nxt = nn; nn = nn <= thi ? nextt(nn) : nn;
        cur = cur == 2 ? 0 : cur + 1;
    }
#undef NSA_WAIT_KEEP
    if (!gB) NSA_BAR();
    __syncthreads();
}

__device__ __forceinline__ void p_nsa(Frame& F, const Args& A) {
    const bf16* U = (const bf16*)(F.ws + WS_U); bf16* HB = (bf16*)(F.ws + WS_HB); const float* GL = (const float*)(F.ws + WS_GL);
    LAS unsigned char* L = F.lds;
    LAS float* LUT = (LAS float*)(L + N_LUT); LAS float* cst = (LAS float*)(L + N_CST);
    for (int i = F.tid; i < 1024; i += NTHR) LUT[i] = A.in[1][t5_bucket_dev(i >> 3) * 8 + (i & 7)] * LOG2E;
    if (F.wave == 0) {
        float gm = 0.f, bm = 0.f;
        for (int i = F.lane; i < 128; i += 64) gm = fmaxf(gm, fmaxf(fabsf(A.in[16][i]), fmaxf(fabsf(A.in[17][i]), fabsf(A.in[18][i]))));
        for (int i = F.lane; i < 256; i += 64) bm = fmaxf(bm, fabsf(A.in[1][i]));
#pragma unroll
        for (int o = 1; o < 64; o <<= 1) { gm = fmaxf(gm, __shfl_xor(gm, o)); bm = fmaxf(bm, __shfl_xor(bm, o)); }
        if (F.lane == 0) { cst[0] = gm * 11.3137085f; cst[1] = bm * LOG2E; }
    }
    __syncthreads();
    const float kmax = cst[0], bmax = cst[1];
    for (int ui = F.bid; ui < 2048; ui += F.G) {
        NsaCtx X; X.L = L; X.U = U; X.KC = (const bf16*)(F.ws + WS_KCMP); X.VC = (const bf16*)(F.ws + WS_VCMP);
        int tid = F.tid, lane = F.lane; asm volatile("" : "+v"(tid), "+v"(lane));
        X.tid = tid; X.lane = lane; X.w = F.wave; X.r = lane & 31; X.hh = lane >> 5;
        const int kr = ui >> 8, cc = ui & 255, bg = kr * 4 + (cc >> 6);
        X.b = bg >> 1; X.g = bg & 1; X.qblk = (kr & 1) ? 63 - (cc & 63) : (cc & 63); X.t0 = 64 * X.qblk; X.bat = (size_t)X.b * SEQ;
        const int tq = X.r >> 2, hd = X.r & 3; X.t = X.t0 + 8 * X.w + tq; X.head = 4 * X.g + hd;
        const size_t row = X.bat + X.t;
        if (tid == 0) *(LAS unsigned long long*)(L + N_UNI) = 0ull;
        for (int i = tid; i < 4096; i += NTHR) ((LAS float*)(L + N_IMP))[i] = 0.f;
        bf16x8 qf[8]; float qn2 = 0.f;
        {
            u32x4 qr[8]; float ss = 0.f;
#pragma unroll
            for (int ks = 0; ks < 8; ++ks) { qr[ks] = *(const u32x4*)(U + row * LDO + OQ + X.head * 128 + 16 * ks + 8 * X.hh);
#pragma unroll
                for (int e = 0; e < 4; ++e) { const float a = bflo(qr[ks][e]), c = bfhi(qr[ks][e]); ss += a * a + c * c; } }
            ss += __shfl_xor(ss, 32);
            const float rs = 1.f / sqrtf(ss * (1.f / 128.f) + NORM_EPS);
#pragma unroll
            for (int ks = 0; ks < 8; ++ks) { const float* gq = A.in[15] + 16 * ks + 8 * X.hh; u32x4 pk;
#pragma unroll
                for (int e = 0; e < 4; ++e) { const float a = bflo(qr[ks][e]) * rs * gq[2 * e], c = bfhi(qr[ks][e]) * rs * gq[2 * e + 1]; qn2 += a * a + c * c; pk[e] = pk2(a * (0.0883883476f * LOG2E), c * (0.0883883476f * LOG2E)); }
                qf[ks] = __builtin_bit_cast(bf16x8, pk); }
            qn2 += __shfl_xor(qn2, 32);
        }
        X.mrow = sqrtf(qn2) * (0.0883883476f * LOG2E) * kmax + bmax;
        X.cfar = LUT[127 * 8 + X.head] - X.mrow;
        X.mlo = 0u; X.mhi = 0u;
        const float g_c = 1.f / (1.f + __expf(-GL[row * 24 + X.head])), g_s = 1.f / (1.f + __expf(-GL[row * 24 + 8 + X.head])), g_w = 1.f / (1.f + __expf(-GL[row * 24 + 16 + X.head]));
        f32x16 oacc[4];
#pragma unroll
        for (int nt = 0; nt < 4; ++nt) oacc[nt] = (f32x16){0.f, 0.f, 0.f, 0.f, 0.f, 0.f, 0.f, 0.f, 0.f, 0.f, 0.f, 0.f, 0.f, 0.f, 0.f, 0.f};
        const int ntc = ((4 * X.qblk + 2) >> 6) + 1;
        float l_c = 0.f;
        nsa_pass<BR_CMP, true, false, false, true>(X, qf, oacc, l_c, 1.f, 0, ntc - 1, ~0ull);
        l_c += __shfl_xor(l_c, 32);
        const float il_c = l_c > 0.f ? 1.f / l_c : 0.f;
        { float dummy = 0.f; nsa_pass<BR_CMP, false, false, true>(X, qf, oacc, dummy, il_c, 0, ntc - 1, ~0ull); }
        {
            LDS_WAIT();
            const LAS float* impw = (const LAS float*)(L + N_IMP) + X.w * 8 * 64;
            const int n = lane, cur = X.qblk;
            unsigned long long wor = 0ull;
#pragma unroll 1
            for (int q = 0; q < 8; ++q) {
                const float imp = impw[q * 64 + n];
                const bool forced = (n == 0) || (n == cur) || (n == cur - 1);
                float val = forced ? 3.0e38f : imp; if (n > cur) val = -3.0e38f;
                int rank = 0;
#pragma unroll 8
                for (int m = 0; m < 64; ++m) { const float vm = __shfl(val, m); rank += (vm > val || (vm == val && m < n)) ? 1 : 0; }
                const unsigned long long mk = __ballot(n <= cur && rank < 16);
                wor |= mk;
                if ((X.r >> 2) == q) { X.mlo = (unsigned)mk; X.mhi = (unsigned)(mk >> 32); }
            }
            if (lane == 0) __hip_atomic_fetch_or((LAS unsigned long long*)(L + N_UNI), wor, __ATOMIC_RELAXED, __HIP_MEMORY_SCOPE_WORKGROUP);
        }
        __syncthreads();
        const unsigned long long uni = *(const LAS unsigned long long*)(L + N_UNI);
        float l_s = 0.f;
        nsa_pass<BR_SEL, true, true, false, true>(X, qf, oacc, l_s, 1.f, 0, X.qblk, uni);
        if (REP_PART == 7) for (int rp = 1; rp < A.rep; ++rp) { float dummy = 0.f; nsa_pass<BR_SEL, false, true, false, false>(X, qf, oacc, dummy, 0.f, 0, X.qblk, uni); }
        l_s += __shfl_xor(l_s, 32);
        {
            LAS float* fac = (LAS float*)(L + N_FAC) + X.w * 32;
            if (lane < 32) fac[lane] = l_s > 0.f ? g_s / l_s : 0.f;
            LDS_WAIT();
#pragma unroll
            for (int q = 0; q < 4; ++q) { const f32x4 fr = *(const LAS f32x4*)(fac + 8 * q + 4 * X.hh);
#pragma unroll
                for (int nt = 0; nt < 4; ++nt) { oacc[nt][4 * q] *= fr.x; oacc[nt][4 * q + 1] *= fr.y; oacc[nt][4 * q + 2] *= fr.z; oacc[nt][4 * q + 3] *= fr.w; } }
        }
        { float dummy = 0.f; nsa_pass<BR_CMP, false, true, false>(X, qf, oacc, dummy, g_c * il_c, 0, ntc - 1, ~0ull); }
        const int wlo = X.qblk >= 8 ? X.qblk - 8 : 0;
        float l_w = 0.f;
        nsa_pass<BR_WIN, true, false, false, true>(X, qf, oacc, l_w, 1.f, wlo, X.qblk, ~0ull);
        l_w += __shfl_xor(l_w, 32);
        { float dummy = 0.f; nsa_pass<BR_WIN, false, true, false>(X, qf, oacc, dummy, l_w > 0.f ? g_w / l_w : 0.f, wlo, X.qblk, ~0ull); }
#pragma unroll
        for (int i = 0; i < 16; ++i) { const int c32 = 8 * (i >> 2) + 4 * X.hh + (i & 3);
            bf16* op = HB + (X.bat + X.t0 + 8 * X.w + (c32 >> 2)) * DM + (4 * X.g + (c32 & 3)) * 128 + X.r;
#pragma unroll
            for (int nt = 0; nt < 4; ++nt) op[32 * nt] = (bf16)f2bfh(oacc[nt][i]); }
    }
}

constexpr int N_PHASES = 18;
__global__ void __launch_bounds__(NTHR, 2) mk_fwd(Args args) {
    extern __shared__ __attribute__((aligned(16))) unsigned char lds[];
    Frame F;
    F.lds = (LAS unsigned char*)lds;
    F.MISC = (volatile LAS unsigned*)(F.lds + MISC_OFF);
    F.tid = threadIdx.x; F.lane = F.tid & 63; F.wave = __builtin_amdgcn_readfirstlane(F.tid >> 6);
    F.G = gridDim.x; F.bid = blockIdx.x;
    F.ws = args.ws; F.out = args.out; F.ctl = (gu32*)(args.ws + WS_CTL);
    if (F.tid < 64) F.MISC[F.tid] = 0u;
    __syncthreads();
    const int lo = args.ph_lo, hi = args.ph_hi;
    XcdBarrier bar; bar.bar = (unsigned*)(F.ctl + CW_BAR); bar.x = 0; bar.st = nullptr;
    if (hi - lo > 1) bar = xcd_barrier_post((unsigned*)(F.ctl + CW_BAR), F.MISC + 8);
#ifndef PHMASK
#define PHMASK 0xffffffffu
#endif
#define IN(k) (((PHMASK >> (k)) & 1u) && lo <= (k) && (k) < hi)
#ifndef REPMASK
#define REPMASK 0u
#endif
#define RUNS(k) (1 + (int)((REPMASK >> (k)) & 1u))
#define SEAM(k) do { if (IN(k) && IN((k) + 1)) xcd_barrier(bar); } while (0)
    if (IN(0)) { for (int rp = 0; rp < RUNS(0); ++rp) p_prologue(F, args); } SEAM(0);
    if (IN(1)) for (int rp = 0; rp < RUNS(1); ++rp) {
        pg8::StaticOrder S; S.init(F.ws + WS_HB, F.ws + WS_WIE, MTOK, LDE, DM, F.G, F.bid);
        pg8::EpiBf16 E{(bf16*)(F.ws + WS_U), LDE};
        pg8::gemm_phase<pg8::EpiBf16, pg8::StaticOrder, true>(F.lds, DM, S, E);
    } SEAM(1);
    if (IN(2)) { p_ssd(F, args); } SEAM(2);
    if (IN(3)) { for (int rp = 0; rp < RUNS(3); ++rp) p_dsa(F, args); } SEAM(3);
    if (IN(4)) {
        pg8::StaticOrder S; S.init(F.ws + WS_HB, F.ws + WS_WOE, MTOK, DM, DM, F.G, F.bid);
        pg8::EpiResF32 E{args.in[0], F.out, DM};
        pg8::gemm_phase<pg8::EpiResF32, pg8::StaticOrder, true>(F.lds, DM, S, E);
    } SEAM(4);
    if (IN(5)) { p_norm_route<0>(F, F.out, args.in[3], 0); } SEAM(5);
    if (IN(6)) { p_moe_gu(F, 0);
#if (REPMASK >> 6) & 1
        p_moe_gu(F, 0);
#endif
    } SEAM(6);
    if (IN(7)) { p_moe_down(F, 0, 0); } SEAM(7);
    if (IN(8)) { p_moe_down(F, 0, 1); } SEAM(8);
    if (IN(9)) { for (int rp = 0; rp < RUNS(9); ++rp) p_norm_route<1>(F, F.out, args.in[2] + DM, 0); } SEAM(9);
    if (IN(10)) {
        pg8::StaticOrder S; S.init(F.ws + WS_HB, F.ws + WS_WIO, MTOK, LDO, DM, F.G, F.bid);
        pg8::EpiBf16 E{(bf16*)(F.ws + WS_U), LDO};
        pg8::gemm_phase<pg8::EpiBf16, pg8::StaticOrder, true>(F.lds, DM, S, E);
    } SEAM(10);
    if (IN(11)) { p_compress(F, args); } SEAM(11);
    if (IN(12)) { p_nsa(F, args);
#if (REPMASK >> 12) & 1
        p_nsa(F, args);
#endif
    } SEAM(12);
    if (IN(13)) {
        pg8::StaticOrder S; S.init(F.ws + WS_HB, F.ws + WS_WOO, MTOK, DM, DM, F.G, F.bid);
        pg8::EpiResF32 E{F.out, F.out, DM};
        pg8::gemm_phase<pg8::EpiResF32, pg8::StaticOrder, true>(F.lds, DM, S, E);
    } SEAM(13);
    if (IN(14)) { p_norm_route<0>(F, F.out, args.in[3] + DM, 1); } SEAM(14);
    if (IN(15)) { p_moe_gu(F, 1); } SEAM(15);
    if (IN(16)) { p_moe_down(F, 1, 0); } SEAM(16);
    if (IN(17)) { p_moe_down(F, 1, 1); }
#undef IN
#undef SEAM
}

extern "C" void kernel_launch(void* const* d_in, const int* in_sizes, int n_in, void* d_out, int out_size, void* d_ws, size_t ws_size, hipStream_t stream) {
    static int grid = 0;
    if (grid == 0) {
        if (n_in != 31 || ws_size < WS_END) { fprintf(stderr, "kernel_launch: unexpected n_in %d / ws %zu\n", n_in, ws_size); grid = -1; return; }
        int dev = 0, cus = 0;
        if (hipGetDevice(&dev) != hipSuccess || hipDeviceGetAttribute(&cus, hipDeviceAttributeMultiprocessorCount, dev) != hipSuccess) { grid = -1; return; }
        if (hipFuncSetAttribute((const void*)mk_fwd, hipFuncAttributeMaxDynamicSharedMemorySize, LDS_BYTES) != hipSuccess) { fprintf(stderr, "kernel_launch: hipFuncSetAttribute failed\n"); grid = -1; return; }
        grid = cus;
    }
    if (grid < 0) return;
    (void)hipMemsetAsync((char*)d_ws + WS_CTL, 0, CTL_ZERO_BYTES, stream);
    Args a{};
    for (int i = 0; i < 31; ++i) a.in[i] = (const float*)d_in[i];
    a.out = (float*)d_out; a.ws = (unsigned char*)d_ws; a.rep = (REP_PART || REP_PHASE >= 0) ? 2 : 1; a.pad = 0; a.rep = 2; a.pad = 0;
#if defined(MK_PER_PHASE)
    for (int p = 0; p < N_PHASES; ++p) { a.ph_lo = p; a.ph_hi = p + 1; hipLaunchKernelGGL(mk_fwd, dim3(grid), dim3(NTHR), LDS_BYTES, stream, a); }
#else
    a.ph_lo = 0; a.ph_hi = N_PHASES; hipLaunchKernelGGL(mk_fwd, dim3(grid), dim3(NTHR), LDS_BYTES, stream, a);
#endif
}
```

```cpp
#include <hip/hip_runtime.h>
#include <cstdio>
#include <cstdint>

#define GAS __attribute__((address_space(1)))
#define LAS __attribute__((address_space(3)))
typedef unsigned short bf16;
typedef short bf16x8 __attribute__((ext_vector_type(8)));
typedef float f32x4 __attribute__((ext_vector_type(4)));
typedef float f32x2 __attribute__((ext_vector_type(2)));
typedef float f32x16 __attribute__((ext_vector_type(16)));
typedef unsigned u32x4 __attribute__((ext_vector_type(4)));
typedef unsigned u32x2 __attribute__((ext_vector_type(2)));
typedef GAS unsigned gu32;
#define RLX_AGENT __ATOMIC_RELAXED, __HIP_MEMORY_SCOPE_AGENT
#define LDS_WAIT() asm volatile("s_waitcnt lgkmcnt(0)" ::: "memory")
#define VM_WAIT() asm volatile("s_waitcnt vmcnt(0)" ::: "memory")

constexpr int NB = 16, SEQ = 4096, DM = 1024, MTOK = NB * SEQ;
constexpr float NORM_EPS = 1e-6f;
constexpr int LDE = 2560;
constexpr int EZ = 0, EXS = 512, EBB = 1024, ECC = 1280, EQ = 1536, EK = 2048, EV = 2112, EIQ = 2176, EIK = 2432, EDT = 2496, EIW = 2504;
constexpr int LDO = 2560;
constexpr int OQ = 0, OKC = 1024, OVC = 1280, OKS = 1536, OVS = 1792, OKW = 2048, OVW = 2304;
constexpr int NWAVES = 8, NTHR = 512;

constexpr size_t MiB = 1u << 20;
constexpr size_t WS_CTL = 0, CTL_ZERO_BYTES = 1 * MiB;
constexpr size_t WS_WIE = 1 * MiB, WS_WOE = 6 * MiB, WS_WIO = 8 * MiB, WS_WOO = 13 * MiB;
constexpr size_t WS_W1K = 15 * MiB, WS_W1V = 16 * MiB, WS_W2 = 17 * MiB, WS_WR = 18 * MiB;
constexpr size_t WS_WGL = WS_WR + 256 * 1024;
constexpr size_t WS_TOK = 19 * MiB;
constexpr size_t WS_GL = 20 * MiB;
constexpr size_t WS_KCMP = 26 * MiB, WS_VCMP = 28 * MiB;
constexpr size_t WS_LIST = 32 * MiB;
constexpr size_t WS_WGU = 48 * MiB;
constexpr size_t WS_WD = 176 * MiB;
constexpr size_t WS_HB = 240 * MiB;
constexpr size_t WS_U = 368 * MiB;
constexpr size_t WS_LISTW = 720 * MiB;
constexpr size_t WS_END = 736 * MiB;
constexpr int CW_TMO = 0, CW_CODE = 1, CW_BAR = 4096, CW_CNT = 8192;

constexpr int RING_BYTES = 131072;
constexpr int LDS_BYTES = 147456;
constexpr int MISC_OFF = LDS_BYTES - 256;
constexpr int MOE_OFF = LDS_BYTES - 2048;

__device__ __forceinline__ unsigned f2bf(float f) { unsigned u = __builtin_bit_cast(unsigned, f); return (u + 0x7fffu + ((u >> 16) & 1u)) >> 16; }
typedef __bf16 bf16x2_t __attribute__((ext_vector_type(2)));
__device__ __forceinline__ unsigned pk2(float lo, float hi) { const f32x2 v = {lo, hi}; const bf16x2_t b = __builtin_convertvector(v, bf16x2_t); return __builtin_bit_cast(unsigned, b); }
__device__ __forceinline__ unsigned short f2bfh(float f) { return (unsigned short)(pk2(f, f) & 0xffffu); }
__device__ __forceinline__ float bf2f(unsigned short b) { return __builtin_bit_cast(float, ((unsigned)b) << 16); }
__device__ __forceinline__ float bflo(unsigned w) { return __builtin_bit_cast(float, w << 16); }
__device__ __forceinline__ float bfhi(unsigned w) { return __builtin_bit_cast(float, w & 0xffff0000u); }
__device__ __forceinline__ float siluf(float v) { return v * __builtin_amdgcn_rcpf(1.f + __builtin_amdgcn_exp2f(-1.44269504f * v)); }

#define XB_TMO      128
#define XB_XCNT(j)  (256  + 64 * (j))
#define XB_XSUB(j)  (1280 + 64 * (j))
#define XB_XGEN(j)  (2304 + 64 * (j))
#define XB_TOP      3328
#define XB_TOPGEN   3392
#define XCD_BAR_WORDS 3456
#define XB_SPIN_CAP (1u << 20)
__device__ __forceinline__ unsigned xb_ld(unsigned* p)              { return __hip_atomic_load(p, __ATOMIC_RELAXED, __HIP_MEMORY_SCOPE_AGENT); }
__device__ __forceinline__ unsigned xb_add(unsigned* p, unsigned v) { return __hip_atomic_fetch_add(p, v, __ATOMIC_RELAXED, __HIP_MEMORY_SCOPE_AGENT); }
__device__ __forceinline__ unsigned xb_xcc_id() { return (unsigned)__builtin_amdgcn_s_getreg((3 << 11) | 20) & 0xFu; }
#define XB_SPIN(cond, bar) do { unsigned _sp = 0; while (cond) { __builtin_amdgcn_s_sleep(1); \
    if ((++_sp & 255u) == 0u) { if (xb_ld(&(bar)[XB_TMO])) break; if (_sp > XB_SPIN_CAP) { atomicAdd(&(bar)[XB_TMO], 1u); break; } } } } while (0)
struct XcdBarrier { unsigned* bar; unsigned x; volatile LAS unsigned* st; };
__device__ __forceinline__ XcdBarrier xcd_barrier_post(unsigned* bar, volatile LAS unsigned* st) {
    XcdBarrier b; b.bar = bar; b.x = xb_xcc_id(); b.st = st;
    if (threadIdx.x == 0) (void)xb_add(&bar[XB_XCNT(b.x)], 1u);
    return b;
}
__device__ __forceinline__ void xcd_barrier_complete(unsigned* bar, unsigned x, unsigned& nloc, unsigned& nx) {
    const unsigned G = gridDim.x * gridDim.y * gridDim.z;
    unsigned sum, cnt, mine, sp = 0u;
    for (;;) {
        sum = 0u; cnt = 0u; mine = 0u;
#pragma unroll
        for (unsigned j = 0; j < 16; ++j) { const unsigned c = xb_ld(&bar[XB_XCNT(j)]); sum += c; cnt += (c > 0u) ? 1u : 0u; mine = (j == x) ? c : mine; }
        if (sum == G) break;
        __builtin_amdgcn_s_sleep(1);
        if ((++sp & 255u) == 0u) { if (xb_ld(&bar[XB_TMO])) break; if (sp > XB_SPIN_CAP) { atomicAdd(&bar[XB_TMO], 1u); break; } }
    }
    nloc = mine > 0u ? mine : 1u; nx = cnt > 0u ? cnt : 1u;
}
__device__ __forceinline__ void xcd_barrier(const XcdBarrier& b) {
    asm volatile("s_waitcnt vmcnt(0)" ::: "memory");
    __syncthreads();
    if (threadIdx.x == 0) {
        unsigned* bar = b.bar;
        __builtin_amdgcn_s_waitcnt(0);
        unsigned nloc = b.st[0], nx = b.st[1];
        if (nloc == 0u) { xcd_barrier_complete(bar, b.x, nloc, nx); b.st[0] = nloc; b.st[1] = nx; }
        const unsigned old = xb_add(&bar[XB_XSUB(b.x)], 1u);
        const unsigned gen = old / nloc;
        if (old + 1u == (gen + 1u) * nloc) {
            __builtin_amdgcn_fence(__ATOMIC_RELEASE, "agent");
            asm volatile("s_waitcnt vmcnt(0)" ::: "memory");
            const unsigned og = xb_add(&bar[XB_TOP], 1u);
            const unsigned tg = og / nx;
            if (og + 1u == (tg + 1u) * nx) xb_add(&bar[XB_TOPGEN], 1u);
            else XB_SPIN(xb_ld(&bar[XB_TOPGEN]) == tg, bar);
            __builtin_amdgcn_fence(__ATOMIC_ACQUIRE, "agent");
            xb_add(&bar[XB_XGEN(b.x)], 1u);
            asm volatile("s_waitcnt vmcnt(0)" ::: "memory");
        } else {
            XB_SPIN(xb_ld(&bar[XB_XGEN(b.x)]) == gen, bar);
            __builtin_amdgcn_fence(__ATOMIC_ACQUIRE, "agent");
            asm volatile("s_waitcnt vmcnt(0)" ::: "memory");
        }
    }
    __syncthreads();
}

namespace pg8 {
constexpr int BM = 256, BK = 64, HALF = 128, HTB = HALF * BK * 2, STAGE_BYTES = 8 * HTB, NXCD = 8, WGM = 8;
__host__ __device__ __forceinline__ int lds_byte(int r, int c) { const int st = (r >> 4) * 2 + (c >> 5), rr = r & 15, cc = c & 31, ob = rr * 64 + cc * 2; return st * 1024 + (ob ^ (((ob >> 9) & 1) << 5)); }
__host__ __device__ __forceinline__ void stage_rc(int b, int& R, int& C) { const int st = b / 1024, sb = b % 1024, swz = sb ^ (((sb >> 9) & 1) << 5); R = (st >> 1) * 16 + swz / 64; C = (st & 1) * 32 + (swz % 64) / 2; }
__host__ __device__ __forceinline__ int perm32(int rho) { const int n = rho >> 4, i = rho & 15; return 8 * (i >> 2) + 4 * n + (i & 3); }
__device__ __forceinline__ unsigned cvt_pk_bf16(float lo, float hi) { unsigned r; asm volatile("v_cvt_pk_bf16_f32 %0, %1, %2" : "=v"(r) : "v"(lo), "v"(hi)); return r; }

struct Unit { const char* A; const char* B; int pm, pn, aux; };

struct StaticOrder {
    const char* A; const char* Bt; int K, nM, nN, nwg, G, c;
    __device__ void init(const void* A_, const void* Bt_, int M, int N, int K_, int G_, int c_) { A = (const char*)A_; Bt = (const char*)Bt_; K = K_; nM = M / BM; nN = N / BM; nwg = nM * nN; G = G_; c = c_; }
    __device__ __forceinline__ bool next(int i, Unit& u) const {
        const long L = (long)i * G + c; if (L >= nwg) return false;
        int wgid = (int)L; { const int q = nwg / NXCD, r = nwg % NXCD, xcd = wgid % NXCD, off = wgid / NXCD; wgid = (xcd < r ? xcd * (q + 1) : r * (q + 1) + (xcd - r) * q) + off; }
        const int nig = WGM * nN, gid = wgid / nig, fm = gid * WGM, gsz = (nM - fm) < WGM ? (nM - fm) : WGM;
        u.pm = fm + ((wgid % nig) % gsz); u.pn = (wgid % nig) / gsz; u.aux = 0;
        u.A = A + (size_t)u.pm * BM * K * 2; u.B = Bt + (size_t)u.pn * BM * K * 2; return true;
    }
    __device__ __forceinline__ unsigned arow(const Unit&, int r) const { return (unsigned)(r * K) * 2u; }
};

template <class Epi, class Sched, bool ALIGN_EPI>
__device__ __forceinline__ void gemm_phase(LAS unsigned char* lds, const int K, const Sched& S, const Epi& E) {
    const int tid = threadIdx.x, wid = __builtin_amdgcn_readfirstlane(tid >> 6), lane = tid & 63, wr = wid >> 2, wc = wid & 3, fr = lane & 15, fq = lane >> 4;
    const int nt = K / BK;
    int RA[2], CA[2]; unsigned voffB[2];
#pragma unroll
    for (int i = 0; i < 2; ++i) { int R, C; stage_rc(tid * 16 + i * 8192, R, C); const int Rb = Epi::PERM ? ((R & ~31) + perm32(R & 31)) : R;
        RA[i] = R; CA[i] = C; voffB[i] = (unsigned)(Rb * K + C) * 2u; }
    const size_t kstep = (size_t)(BK * 2);
    const size_t hstep = (size_t)HALF * K * 2;
    const unsigned ldsw = (unsigned)wid * 1024u;
    const int aoff = lds_byte(wr * 64 + fr, fq * 8), boff = lds_byte(wc * 32 + fr, fq * 8);
#define PG8_SA(b, h) (((b) * 2 + (h)) * HTB)
#define PG8_SB(b, h) ((4 + (b) * 2 + (h)) * HTB)
#define PG8_STAGE(bufoff, gbase, voff) do { _Pragma("unroll") for (int _i = 0; _i < 2; ++_i) \
        __builtin_amdgcn_global_load_lds((const unsigned*)((const char*)(gbase) + (voff)[_i]), (LAS unsigned*)(lds + (bufoff) + ldsw + _i * 8192), 16, 0, 0); } while (0)
#define PG8_LDA(dst, b, h) do { _Pragma("unroll") for (int m = 0; m < 4; ++m) _Pragma("unroll") for (int k = 0; k < 2; ++k) dst[m][k] = *(const LAS bf16x8*)(lds + PG8_SA(b, h) + aoff + m * 2048 + k * 1024); } while (0)
#define PG8_LDB(dst, b, h) do { _Pragma("unroll") for (int n = 0; n < 2; ++n) _Pragma("unroll") for (int k = 0; k < 2; ++k) dst[n][k] = *(const LAS bf16x8*)(lds + PG8_SB(b, h) + boff + n * 2048 + k * 1024); } while (0)
#define PG8_MMA(ai, bj, At, Bt) do { __builtin_amdgcn_s_setprio(1); _Pragma("unroll") for (int m = 0; m < 4; ++m) _Pragma("unroll") for (int n = 0; n < 2; ++n) _Pragma("unroll") for (int k = 0; k < 2; ++k) \
        acc[ai][bj][m][n] = __builtin_amdgcn_mfma_f32_16x16x32_bf16(Bt[n][k], At[m][k], acc[ai][bj][m][n], 0, 0, 0); __builtin_amdgcn_s_setprio(0); } while (0)
#define PG8_WAIT_V(n) asm volatile("s_waitcnt vmcnt(" #n ")" ::: "memory")
#define PG8_WAIT_L(n) asm volatile("s_waitcnt lgkmcnt(" #n ")" ::: "memory")
#define PG8_BAR __builtin_amdgcn_s_barrier()
#define PG8_SCHED __builtin_amdgcn_sched_barrier(0)
    Unit cur, nxt; int ui = 0;
    if (!S.next(0, cur)) return;
    f32x4 acc[2][2][4][2];
#pragma unroll
    for (int a = 0; a < 2; ++a)
#pragma unroll
        for (int b = 0; b < 2; ++b)
#pragma unroll
            for (int m = 0; m < 4; ++m)
#pragma unroll
                for (int n = 0; n < 2; ++n) acc[a][b][m][n] = (f32x4){0.f, 0.f, 0.f, 0.f};
    bf16x8 At[4][2], B0[2][2], B1[2][2];
    unsigned vA0[2], vA1[2], nA0[2], nA1[2];
#pragma unroll
    for (int i = 0; i < 2; ++i) { vA0[i] = S.arow(cur, RA[i]) + CA[i] * 2u; vA1[i] = S.arow(cur, HALF + RA[i]) + CA[i] * 2u; nA0[i] = vA0[i]; nA1[i] = vA1[i]; }
    const char* cA = cur.A; const char* cB = cur.B;
    PG8_STAGE(PG8_SB(0, 0), cB, voffB); PG8_STAGE(PG8_SB(0, 1), cB + hstep, voffB); PG8_STAGE(PG8_SA(0, 0), cA, vA0); PG8_STAGE(PG8_SA(0, 1), cA, vA1);
    if (wr == 1) PG8_BAR;
    PG8_WAIT_V(2); PG8_BAR;
    PG8_STAGE(PG8_SB(1, 0), cB + kstep, voffB); PG8_STAGE(PG8_SA(1, 0), cA + kstep, vA0); PG8_STAGE(PG8_SB(1, 1), cB + hstep + kstep, voffB);
    PG8_WAIT_V(6); PG8_BAR;
    for (;;) {
        const bool has_next = S.next(ui + 1, nxt);
        const char* nA = has_next ? nxt.A : cA; const char* nB = has_next ? nxt.B : cB;
        if (has_next) {
#pragma unroll
            for (int i = 0; i < 2; ++i) { nA0[i] = S.arow(nxt, RA[i]) + CA[i] * 2u; nA1[i] = S.arow(nxt, HALF + RA[i]) + CA[i] * 2u; }
        }
        for (int t = 0; t < nt; t += 2) {
            const bool last = (t == nt - 2);
            const char* a1 = cA + (size_t)(t + 1) * kstep;
            const char* a2 = last ? nA : cA + (size_t)(t + 2) * kstep; const char* b2 = last ? nB : cB + (size_t)(t + 2) * kstep;
            const char* a3 = a2 + kstep; const char* b3 = b2 + kstep;
            unsigned w0[2], w1[2];
#pragma unroll
            for (int i = 0; i < 2; ++i) { w0[i] = last ? nA0[i] : vA0[i]; w1[i] = last ? nA1[i] : vA1[i]; }
            PG8_LDB(B0, 0, 0); PG8_LDB(B1, 0, 1); PG8_SCHED; PG8_LDA(At, 0, 0); PG8_STAGE(PG8_SA(1, 1), a1, vA1);
            PG8_WAIT_V(8); PG8_WAIT_L(0); PG8_BAR; PG8_MMA(0, 0, At, B0); PG8_MMA(0, 1, At, B1); PG8_BAR; PG8_SCHED;
            PG8_LDA(At, 0, 1); PG8_STAGE(PG8_SB(0, 0), b2, voffB); PG8_STAGE(PG8_SB(0, 1), b2 + hstep, voffB); PG8_STAGE(PG8_SA(0, 0), a2, w0);
            PG8_WAIT_V(8); PG8_WAIT_L(0); PG8_BAR; PG8_MMA(1, 0, At, B0); PG8_MMA(1, 1, At, B1); PG8_BAR; PG8_SCHED;
            PG8_LDB(B0, 1, 0); PG8_LDB(B1, 1, 1); PG8_SCHED; PG8_LDA(At, 1, 0); PG8_STAGE(PG8_SA(0, 1), a2, w1);
            PG8_WAIT_V(8); PG8_WAIT_L(0); PG8_BAR; PG8_MMA(0, 0, At, B0); PG8_MMA(0, 1, At, B1); PG8_BAR; PG8_SCHED;
            PG8_LDA(At, 1, 1); PG8_STAGE(PG8_SB(1, 0), b3, voffB); PG8_STAGE(PG8_SB(1, 1), b3 + hstep, voffB); PG8_STAGE(PG8_SA(1, 0), a3, w0);
            PG8_WAIT_V(8); PG8_WAIT_L(0); PG8_BAR; PG8_MMA(1, 0, At, B0); PG8_MMA(1, 1, At, B1); PG8_BAR; PG8_SCHED;
        }
        if constexpr (ALIGN_EPI) { if (wr == 0) PG8_BAR; }
        E(acc, cur, wr, wc, fr, fq);
        if (!has_next) break;
#pragma unroll
        for (int a = 0; a < 2; ++a)
#pragma unroll
            for (int b = 0; b < 2; ++b)
#pragma unroll
                for (int m = 0; m < 4; ++m)
#pragma unroll
                    for (int n = 0; n < 2; ++n) acc[a][b][m][n] = (f32x4){0.f, 0.f, 0.f, 0.f};
        cur = nxt; cA = nA; cB = nB; ++ui;
#pragma unroll
        for (int i = 0; i < 2; ++i) { vA0[i] = nA0[i]; vA1[i] = nA1[i]; }
        if constexpr (ALIGN_EPI) { if (wr == 1) PG8_BAR; }
    }
    PG8_WAIT_V(0);
    if constexpr (!ALIGN_EPI) { if (wr == 0) PG8_BAR; }
    PG8_BAR;
#undef PG8_SA
#undef PG8_SB
#undef PG8_STAGE
#undef PG8_LDA
#undef PG8_LDB
#undef PG8_MMA
#undef PG8_WAIT_V
#undef PG8_WAIT_L
#undef PG8_BAR
#undef PG8_SCHED
}

struct EpiBf16 {
    static constexpr bool PERM = true;
    bf16* O; int ldc;
    __device__ __forceinline__ void operator()(const f32x4 (&acc)[2][2][4][2], const Unit& u, int wr, int wc, int fr, int fq) const {
        const int row0 = u.pm * BM + wr * 64 + fr; const int col0 = u.pn * BM + wc * 32 + 8 * fq;
#pragma unroll
        for (int ai = 0; ai < 2; ++ai)
#pragma unroll
            for (int m = 0; m < 4; ++m) { bf16* rowp = O + (size_t)(row0 + ai * HALF + m * 16) * ldc + col0;
#pragma unroll
                for (int bj = 0; bj < 2; ++bj) { const f32x4 v0 = acc[ai][bj][m][0], v1 = acc[ai][bj][m][1];
                    u32x4 w; w.x = cvt_pk_bf16(v0[0], v0[1]); w.y = cvt_pk_bf16(v0[2], v0[3]); w.z = cvt_pk_bf16(v1[0], v1[1]); w.w = cvt_pk_bf16(v1[2], v1[3]);
                    *(u32x4*)(rowp + bj * HALF) = w; } }
    }
};
struct EpiResF32 {
    static constexpr bool PERM = false;
    const float* base; float* out; int ldc;
    __device__ __forceinline__ void operator()(const f32x4 (&acc)[2][2][4][2], const Unit& u, int wr, int wc, int fr, int fq) const {
        const int row0 = u.pm * BM + wr * 64 + fr, col0 = u.pn * BM + wc * 32 + 4 * fq;
#pragma unroll
        for (int ai = 0; ai < 2; ++ai)
#pragma unroll
            for (int m = 0; m < 4; ++m) { const size_t off = (size_t)(row0 + ai * HALF + m * 16) * ldc + col0;
#pragma unroll
                for (int bj = 0; bj < 2; ++bj)
#pragma unroll
                    for (int n = 0; n < 2; ++n) { const f32x4 bs = *(const f32x4*)(base + off + bj * HALF + n * 16); *(f32x4*)(out + off + bj * HALF + n * 16) = bs + acc[ai][bj][m][n]; } }
    }
};

struct MoeOrder {
    const char* Abase; const char* Bbase; size_t bstride; int K, G, c, tile_lo, tile_hi; const LAS int* ptile; const LAS int* cntv; const int* list; bool gather;
    __device__ __forceinline__ bool next(int i, Unit& u) const {
        const int NT = tile_hi - tile_lo; int tile, pn;
        if ((G & 7) == 0 && G >= 32) {
            const int x = c & 7, sl = c >> 3, per = G >> 3, TPX = (NT + 7) >> 3;
            const int lu = i * per + sl, lt = lu >> 2; pn = lu & 3;
            tile = tile_lo + x * TPX + lt;
            if (lt >= TPX || tile >= tile_hi) return false;
        } else {
            const long Lq = (long)i * G + c; if (Lq >= (long)NT * 4) return false;
            tile = tile_lo + (int)(Lq >> 2); pn = (int)(Lq & 3);
        }
        int e = 0;
#pragma unroll
        for (int st = 32; st >= 1; st >>= 1) { const int k = e + st; if (k < 64 && tile >= __builtin_amdgcn_readfirstlane(ptile[k])) e = k; }
        const int j = tile - __builtin_amdgcn_readfirstlane(ptile[e]);
        u.pm = tile; u.pn = pn; u.aux = e | (j << 6);
        u.A = gather ? Abase : Abase + (size_t)tile * BM * K * 2; u.B = Bbase + (size_t)(e & 31) * bstride + (size_t)pn * BM * K * 2; return true;
    }
    __device__ __forceinline__ unsigned arow(const Unit& u, int r) const {
        if (!gather) return (unsigned)(r * K) * 2u;
        const int e = u.aux & 63, pos = (u.aux >> 6) * 256 + r; const int cn = cntv[e];
        const int tok = pos < cn ? list[(size_t)e * 65536 + pos] : 0;
        return (unsigned)tok * (unsigned)(K * 2);
    }
};
struct EpiSwiGLU {
    static constexpr bool PERM = true;
    bf16* H;
    __device__ __forceinline__ void operator()(const f32x4 (&acc)[2][2][4][2], const Unit& u, int wr, int wc, int fr, int fq) const {
        const int row0 = u.pm * BM + wr * 64 + fr; const int col0 = u.pn * 128 + wc * 32 + 8 * fq;
#pragma unroll
        for (int ai = 0; ai < 2; ++ai)
#pragma unroll
            for (int m = 0; m < 4; ++m) { bf16* rowp = H + (size_t)(row0 + ai * HALF + m * 16) * 512 + col0;
                const f32x4 g0 = acc[ai][0][m][0], g1 = acc[ai][0][m][1], u0 = acc[ai][1][m][0], u1 = acc[ai][1][m][1];
                float h[8];
#pragma unroll
                for (int q = 0; q < 4; ++q) { h[q] = g0[q] * __builtin_amdgcn_rcpf(1.f + __builtin_amdgcn_exp2f(-1.44269504f * g0[q])) * u0[q]; h[4 + q] = g1[q] * __builtin_amdgcn_rcpf(1.f + __builtin_amdgcn_exp2f(-1.44269504f * g1[q])) * u1[q]; }
                u32x4 w; w.x = cvt_pk_bf16(h[0], h[1]); w.y = cvt_pk_bf16(h[2], h[3]); w.z = cvt_pk_bf16(h[4], h[5]); w.w = cvt_pk_bf16(h[6], h[7]);
                *(u32x4*)rowp = w; }
    }
};
struct EpiScatter {
    static constexpr bool PERM = false;
    float* out; const int* list; const float* wl; const LAS int* cntv;
    __device__ __forceinline__ void operator()(const f32x4 (&acc)[2][2][4][2], const Unit& u, int wr, int wc, int fr, int fq) const {
        const int e = u.aux & 63, j = u.aux >> 6; const int cn = cntv[e];
        const int col0 = u.pn * BM + wc * 32 + 4 * fq;
#pragma unroll
        for (int ai = 0; ai < 2; ++ai)
#pragma unroll
            for (int m = 0; m < 4; ++m) { const int pos = j * 256 + ai * HALF + wr * 64 + m * 16 + fr;
                if (pos < cn) { const int tok = list[(size_t)e * 65536 + pos]; const float wg = wl[(size_t)e * 65536 + pos];
                    float* rowp = out + (size_t)tok * DM + col0;
#pragma unroll
                    for (int bj = 0; bj < 2; ++bj)
#pragma unroll
                        for (int n = 0; n < 2; ++n) { f32x4* p = (f32x4*)(rowp + bj * HALF + n * 16); *p = *p + wg * acc[ai][bj][m][n]; } } }
    }
};
}

struct Frame {
    LAS unsigned char* lds;
    volatile LAS unsigned* MISC;
    gu32* ctl;
    int tid, lane, wave, G, bid;
    float* out; unsigned char* ws;
};
struct Args { const float* in[31]; float* out; unsigned char* ws; int ph_lo, ph_hi, rep, pad; };
#ifndef REP_PART
#define REP_PART 0
#endif
#ifndef REP_PHASE
#define REP_PHASE -1
#endif
#define NREP(k) ((REP_PHASE == (k)) ? args.rep : 1)
__device__ __forceinline__ float wave_sum(float v) {
#pragma unroll
    for (int o = 1; o < 64; o <<= 1) v += __shfl_xor(v, o);
    return v;
}

template <class Map>
__device__ __forceinline__ void transpose_item(const float* W, int K, int pitch, int col0, int ncols, bf16* WT, LAS float* scr, int item, int lane, Map dmap) {
    const int nblk = (ncols + 31) / 32, kb = item / nblk, nb = item % nblk, k0 = 64 * kb, n0 = 32 * nb;
    const int nn = n0 + (lane & 31);
#pragma unroll 8
    for (int i = 0; i < 32; ++i) { const int kk = 2 * i + (lane >> 5); scr[kk * 33 + (lane & 31)] = (nn < ncols) ? W[(size_t)(k0 + kk) * pitch + col0 + nn] : 0.f; }
    LDS_WAIT(); asm volatile("" ::: "memory");
    const int c = lane & 7;
#pragma unroll
    for (int j = 0; j < 4; ++j) { const int n = (lane >> 3) + 8 * j; const LAS float* s = scr + (8 * c) * 33 + n;
        u32x4 o; o.x = pk2(s[0 * 33], s[1 * 33]); o.y = pk2(s[2 * 33], s[3 * 33]); o.z = pk2(s[4 * 33], s[5 * 33]); o.w = pk2(s[6 * 33], s[7 * 33]);
        if (n0 + n < ncols) *(u32x4*)(WT + (size_t)dmap(n0 + n) * K + k0 + 8 * c) = o; }
    LDS_WAIT(); asm volatile("" ::: "memory");
}
struct MapId { int off; __device__ int operator()(int n) const { return n + off; } };
struct MapEven { __device__ int operator()(int c) const {
    if (c < 1536) return c; if (c < 1544) return EDT + (c - 1536); if (c < 2056) return EQ + (c - 1544); if (c < 2120) return EK + (c - 2056);
    if (c < 2184) return EV + (c - 2120); if (c < 2440) return EIQ + (c - 2184); if (c < 2504) return EIK + (c - 2440); return EIW + (c - 2504); } };
struct MapGU { int half; __device__ int operator()(int n) const { return 256 * (n >> 7) + 128 * half + (n & 127); } };

__device__ __forceinline__ void rms_row_to_bf16(const float* xrow, const float* gain, bf16* orow, int lane) {
    const f32x4* xr = (const f32x4*)xrow + lane; const f32x4* gr = (const f32x4*)gain + lane;
    f32x4 v[4]; float s = 0.f;
#pragma unroll
    for (int j = 0; j < 4; ++j) { v[j] = xr[64 * j]; s += (v[j].x * v[j].x + v[j].y * v[j].y) + (v[j].z * v[j].z + v[j].w * v[j].w); }
    const float rs = 1.f / sqrtf(wave_sum(s) * (1.f / DM) + NORM_EPS);
    unsigned long long* o8 = (unsigned long long*)orow + lane;
#pragma unroll
    for (int j = 0; j < 4; ++j) { const f32x4 g = gr[64 * j]; o8[64 * j] = (unsigned long long)pk2(v[j].x * rs * g.x, v[j].y * rs * g.y) | ((unsigned long long)pk2(v[j].z * rs * g.z, v[j].w * rs * g.w) << 32); }
}

__device__ __forceinline__ void p_prologue(Frame& F, const Args& A) {
    LAS float* scr = (LAS float*)(F.lds + F.wave * 16384);
    const int gw = F.bid * NWAVES + F.wave, NGW = F.G * NWAVES;
    bf16* Wie = (bf16*)(F.ws + WS_WIE); bf16* Woe = (bf16*)(F.ws + WS_WOE);
    constexpr int I_IE = 16 * 79, I_OE = 16 * 32;
    for (int it = gw; it < I_IE + I_OE; it += NGW) {
        if (it < I_IE) transpose_item(A.in[4], 1024, 2508, 0, 2508, Wie, scr, it, F.lane, MapEven());
        else transpose_item(A.in[13], 1024, 1024, 0, 1024, Woe, scr, it - I_IE, F.lane, MapId{0});
    }
    {
        bf16* Wgu = (bf16*)(F.ws + WS_WGU); bf16* Wd = (bf16*)(F.ws + WS_WD); bf16* WR = (bf16*)(F.ws + WS_WR);
        for (int it = gw; it < 64 * 768; it += NGW) { const int le = it / 768, r = it % 768;
            if (r < 256) transpose_item(A.in[28] + (size_t)le * 1024 * 512, 1024, 512, 0, 512, Wgu + (size_t)le * 1024 * 1024, scr, r, F.lane, MapGU{0});
            else if (r < 512) transpose_item(A.in[29] + (size_t)le * 1024 * 512, 1024, 512, 0, 512, Wgu + (size_t)le * 1024 * 1024, scr, r - 256, F.lane, MapGU{1});
            else transpose_item(A.in[30] + (size_t)le * 512 * 1024, 512, 1024, 0, 1024, Wd + (size_t)le * 1024 * 512, scr, r - 512, F.lane, MapId{0}); }
        for (int it = gw; it < 2 * 5 * 16; it += NGW) { const int l = it / 80, r = it % 80, q = r / 16, kb = r % 16;
            if (q == 0) transpose_item(A.in[26] + (size_t)l * 1024 * 4, 1024, 4, 0, 4, WR + (size_t)l * 48 * 1024, scr, kb, F.lane, MapId{0});
            else transpose_item(A.in[27] + (size_t)(l * 4 + q - 1) * 1024 * 8, 1024, 8, 0, 8, WR + (size_t)l * 48 * 1024, scr, kb, F.lane, MapId{4 + 8 * (q - 1)}); }
        for (int i = gw * 64 + F.lane; i < 2 * 12 * 1024 / 8; i += NGW * 64) { const int l = i / (12 * 128), o = i % (12 * 128); *(u32x4*)(WR + (size_t)l * 48 * 1024 + 36 * 1024 + (size_t)o * 8) = (u32x4){0u, 0u, 0u, 0u}; }
    }
    {
        bf16* Wio = (bf16*)(F.ws + WS_WIO); bf16* Woo = (bf16*)(F.ws + WS_WOO); bf16* WGL = (bf16*)(F.ws + WS_WGL);
        bf16* W1K = (bf16*)(F.ws + WS_W1K); bf16* W1V = (bf16*)(F.ws + WS_W1V); bf16* W2 = (bf16*)(F.ws + WS_W2);
        constexpr int J0 = 16 * 80, J1 = J0 + 16, J2 = J1 + 16 * 32, J3 = J2 + 64 * 4, J4 = J3 + 64 * 4, J5 = J4 + 2 * 4, J6 = J5 + 2 * 4;
        for (int it = gw; it < J6; it += NGW) {
            if (it < J0) transpose_item(A.in[14], 1024, 2584, 0, 2560, Wio, scr, it, F.lane, MapId{0});
            else if (it < J1) transpose_item(A.in[14], 1024, 2584, 2560, 24, WGL, scr, it - J0, F.lane, MapId{0});
            else if (it < J2) transpose_item(A.in[25], 1024, 1024, 0, 1024, Woo, scr, it - J1, F.lane, MapId{0});
            else if (it < J3) transpose_item(A.in[21], 4096, 128, 0, 128, W1K, scr, it - J2, F.lane, MapId{0});
            else if (it < J4) transpose_item(A.in[23], 4096, 128, 0, 128, W1V, scr, it - J3, F.lane, MapId{0});
            else if (it < J5) transpose_item(A.in[22], 128, 128, 0, 128, W2, scr, it - J4, F.lane, MapId{0});
            else transpose_item(A.in[24], 128, 128, 0, 128, W2 + 128 * 128, scr, it - J5, F.lane, MapId{0});
        }
        for (int i = gw * 64 + F.lane; i < 8 * 1024 / 8; i += NGW * 64) *(u32x4*)(WGL + 24 * 1024 + (size_t)i * 8) = (u32x4){0u, 0u, 0u, 0u};
    }
    for (int i = gw * 64 + F.lane; i < 52 * 1024 / 8; i += NGW * 64) *(u32x4*)(Wie + (size_t)2508 * 1024 + (size_t)i * 8) = (u32x4){0u, 0u, 0u, 0u};
    bf16* HB = (bf16*)(F.ws + WS_HB);
    for (int m = gw; m < MTOK; m += NGW) rms_row_to_bf16(A.in[0] + (size_t)m * DM, A.in[2], HB + (size_t)m * DM, F.lane);
}

constexpr int SP = 136;
constexpr int L_CS = 0, L_BS = 34816, L_BT = 69632, L_XT = 104448, L_XS = 113152, L_ST = 121856, L_AC = 139264, L_DT = 139776, L_CW = 140288;
__device__ __forceinline__ bf16x8 lds_frag(LAS unsigned char* base, int row, int col) { return *(const LAS bf16x8*)(base + (row * SP + col) * 2); }

__device__ __forceinline__ void p_ssd(Frame& F, const Args& A) {
    bf16* U = (bf16*)(F.ws + WS_U);
    const int w = F.wave;
    { const int tid = F.tid;
    for (int r0 = F.bid * 64; r0 < MTOK; r0 += F.G * 64) {
        const int row = r0 + (tid >> 3), c8 = (tid & 7) * 8;
        bf16* p = U + (size_t)row * LDE + EK + c8;
        const u32x4 v = *(const u32x4*)p; float f[8] = {bflo(v.x), bfhi(v.x), bflo(v.y), bfhi(v.y), bflo(v.z), bfhi(v.z), bflo(v.w), bfhi(v.w)};
        float s = 0.f;
#pragma unroll
        for (int j = 0; j < 8; ++j) s += f[j] * f[j];
        s += __shfl_xor(s, 1); s += __shfl_xor(s, 2); s += __shfl_xor(s, 4);
        const float rs = 1.f / sqrtf(s * (1.f / 64.f) + NORM_EPS); const float* g = A.in[12] + c8;
        u32x4 o; o.x = pk2(f[0] * rs * g[0], f[1] * rs * g[1]); o.y = pk2(f[2] * rs * g[2], f[3] * rs * g[3]); o.z = pk2(f[4] * rs * g[4], f[5] * rs * g[5]); o.w = pk2(f[6] * rs * g[6], f[7] * rs * g[7]);
        *(u32x4*)p = o;
    } }
    LAS unsigned char* L = F.lds;
    LAS float* acum = (LAS float*)(L + L_AC); LAS float* dtv = (LAS float*)(L + L_DT); LAS float* cw = (LAS float*)(L + L_CW);
    const float* conv_w = A.in[5]; const float* conv_b = A.in[6];
    for (int st = F.bid; st < 256; st += F.G) {
        const int b = st >> 4, h = (st >> 1) & 7, ph = st & 1, g = h >> 2;
        { const int tid = F.tid;
        __syncthreads();
        for (int i = tid; i < 5 * 288; i += NTHR) { const int j = i / 288, lc = i % 288;
            const int ch = lc < 128 ? 512 + g * 128 + lc : (lc < 256 ? 768 + g * 128 + (lc - 128) : h * 64 + ph * 32 + (lc - 256));
            cw[i] = j < 4 ? conv_w[j * 1024 + ch] : conv_b[ch]; }
        for (int i = tid; i < 2 * 32 * SP / 2; i += NTHR) ((LAS unsigned*)(L + L_ST))[i] = 0u; }
        const float a_h = -__expf(A.in[8][h]), dtb = A.in[7][h], dsk = A.in[9][h];
        f32x16 state = {0.f, 0.f, 0.f, 0.f, 0.f, 0.f, 0.f, 0.f, 0.f, 0.f, 0.f, 0.f, 0.f, 0.f, 0.f, 0.f};
        __syncthreads();
        u32x4 rawB[7], rawC[7], rawX[4]; unsigned rawdt = 0u; unsigned rawz[16];
#define SSD_FETCH_BCX(cc) do { const size_t _rb = (size_t)b * SEQ + (size_t)(cc) * 128; const int _cg = tid & 15, _rr = tid >> 4; \
            _Pragma("unroll") for (int j = 0; j < 7; ++j) { const int tl = 4 * _rr - 3 + j; rawB[j] = (u32x4){0u, 0u, 0u, 0u}; rawC[j] = (u32x4){0u, 0u, 0u, 0u}; \
                if ((cc) > 0 || tl >= 0) { const bf16* _p = U + (size_t)((long)_rb + tl) * LDE + g * 128 + 8 * _cg; rawB[j] = *(const u32x4*)(_p + EBB); rawC[j] = *(const u32x4*)(_p + ECC); } } \
            const int _cx = tid & 3, _t = tid >> 2; \
            _Pragma("unroll") for (int j = 0; j < 4; ++j) { const int tl = _t - 3 + j; rawX[j] = (u32x4){0u, 0u, 0u, 0u}; \
                if ((cc) > 0 || tl >= 0) rawX[j] = *(const u32x4*)(U + (size_t)((long)_rb + tl) * LDE + EXS + h * 64 + ph * 32 + 8 * _cx); } \
            if (tid < 128) rawdt = U[(_rb + tid) * LDE + EDT + h]; } while (0)
#define SSD_FETCH_Z(cc) do { if (w < 4) { const size_t _rb = (size_t)b * SEQ + (size_t)(cc) * 128; \
            _Pragma("unroll") for (int i = 0; i < 16; ++i) rawz[i] = U[(_rb + 32 * w + 8 * (i >> 2) + 4 * (lane >> 5) + (i & 3)) * LDE + EZ + h * 64 + ph * 32 + (lane & 31)]; } } while (0)
        { int tid = F.tid, lane = F.lane; asm volatile("" : "+v"(tid), "+v"(lane)); SSD_FETCH_BCX(0); SSD_FETCH_Z(0); }
        for (int c = 0; c < 32; ++c) {
            const size_t rowbase = (size_t)b * SEQ + (size_t)c * 128;
            int tid = F.tid, lane = F.lane; asm volatile("" : "+v"(tid), "+v"(lane));
            if (tid < 128) {
                const float dr = bf2f((unsigned short)rawdt) + dtb;
                const float dt = dr > 20.f ? dr : log1pf(__expf(dr));
                float s = dt * a_h;
#pragma unroll
                for (int o = 1; o < 64; o <<= 1) { const float t = __shfl_up(s, o); if (lane >= o) s += t; }
                dtv[tid] = dt; acum[tid] = s;
            }
            {
                const int cg = tid & 15, rr = tid >> 4;
#pragma unroll
                for (int T = 0; T < 2; ++T) {
                    u32x4 raw[7];
#pragma unroll
                    for (int j = 0; j < 7; ++j) raw[j] = T == 0 ? rawB[j] : rawC[j];
                    LAS unsigned char* dst = L + (T == 0 ? L_BS : L_CS);
                    unsigned opk[4][4];
#pragma unroll
                    for (int e2 = 0; e2 < 4; ++e2) {
                        const int lc = T * 128 + 8 * cg + 2 * e2;
                        const f32x2 w0 = *(const LAS f32x2*)(cw + lc), w1 = *(const LAS f32x2*)(cw + 288 + lc), w2 = *(const LAS f32x2*)(cw + 576 + lc), w3 = *(const LAS f32x2*)(cw + 864 + lc), bb = *(const LAS f32x2*)(cw + 1152 + lc);
                        float lo[7], hi[7];
#pragma unroll
                        for (int j = 0; j < 7; ++j) { lo[j] = bflo(raw[j][e2]); hi[j] = bfhi(raw[j][e2]); }
                        float ol[4], oh[4];
#pragma unroll
                        for (int q = 0; q < 4; ++q) { ol[q] = siluf(bb.x + w0.x * lo[q] + w1.x * lo[q + 1] + w2.x * lo[q + 2] + w3.x * lo[q + 3]);
                                                      oh[q] = siluf(bb.y + w0.y * hi[q] + w1.y * hi[q + 1] + w2.y * hi[q + 2] + w3.y * hi[q + 3]); opk[q][e2] = pk2(ol[q], oh[q]); }
                        if (T == 0) {
                            *(LAS u32x2*)(L + L_BT + ((8 * cg + 2 * e2) * SP + 4 * rr) * 2) = (u32x2){pk2(ol[0], ol[1]), pk2(ol[2], ol[3])};
                            *(LAS u32x2*)(L + L_BT + ((8 * cg + 2 * e2 + 1) * SP + 4 * rr) * 2) = (u32x2){pk2(oh[0], oh[1]), pk2(oh[2], oh[3])};
                        }
                    }
#pragma unroll
                    for (int q = 0; q < 4; ++q) *(LAS u32x4*)(dst + ((4 * rr + q) * SP + 8 * cg) * 2) = (u32x4){opk[q][0], opk[q][1], opk[q][2], opk[q][3]};
                }
            }
            __syncthreads();
            if (tid >= 64 && tid < 128) acum[tid] += acum[63];
            __syncthreads();
            {
                const int cg = tid & 3, t = tid >> 2;
                const int gcol = EXS + h * 64 + ph * 32 + 8 * cg;
                u32x4 raw[4];
#pragma unroll
                for (int j = 0; j < 4; ++j) raw[j] = rawX[j];
                const float sc = dtv[t] * __expf(acum[127] - acum[t]);
#pragma unroll
                for (int e = 0; e < 8; ++e) { const int lc = 256 + 8 * cg + e;
                    float rv[4];
#pragma unroll
                    for (int j = 0; j < 4; ++j) rv[j] = (e & 1) ? bfhi(raw[j][e >> 1]) : bflo(raw[j][e >> 1]);
                    const float xv = siluf(cw[1152 + lc] + cw[lc] * rv[0] + cw[288 + lc] * rv[1] + cw[576 + lc] * rv[2] + cw[864 + lc] * rv[3]);
                    *(LAS bf16*)(L + L_XT + ((8 * cg + e) * SP + t) * 2) = (bf16)f2bfh(xv);
                    *(LAS bf16*)(L + L_XS + ((8 * cg + e) * SP + t) * 2) = (bf16)f2bfh(xv * sc); }
            }
            if (c + 1 < 32) SSD_FETCH_BCX(c + 1);
            const int mt = w >> 1, nh = w & 1, r = lane & 31, hh = lane >> 5;
            f32x16 cb[2];
#pragma unroll
            for (int j = 0; j < 2; ++j) {
                cb[j] = (f32x16){0.f, 0.f, 0.f, 0.f, 0.f, 0.f, 0.f, 0.f, 0.f, 0.f, 0.f, 0.f, 0.f, 0.f, 0.f, 0.f};
                const int s0 = 64 * nh + 32 * j;
                if (s0 <= 32 * mt + 31) {
#pragma unroll
                    for (int ks = 0; ks < 8; ++ks) {
                        const bf16x8 af = lds_frag(L + L_CS, 32 * mt + r, 16 * ks + 8 * hh), bfg = lds_frag(L + L_BS, s0 + r, 16 * ks + 8 * hh);
                        cb[j] = __builtin_amdgcn_mfma_f32_32x32x16_bf16(af, bfg, cb[j], 0, 0, 0);
                    }
                }
            }
            __syncthreads();
#pragma unroll
            for (int j = 0; j < 2; ++j) {
                const int s = 64 * nh + 32 * j + r; const float as = acum[s], ds = dtv[s];
#pragma unroll
                for (int i = 0; i < 16; ++i) { const int t = 32 * mt + 8 * (i >> 2) + 4 * hh + (i & 3);
                    const float v = (s <= t) ? cb[j][i] * __expf(acum[t] - as) * ds : 0.f;
                    *(LAS bf16*)(L + L_BS + (t * SP + s) * 2) = (bf16)f2bfh(v); }
            }
            __syncthreads();
            if (w < 4) {
                f32x16 yd = {0.f, 0.f, 0.f, 0.f, 0.f, 0.f, 0.f, 0.f, 0.f, 0.f, 0.f, 0.f, 0.f, 0.f, 0.f, 0.f}, yo = yd;
                for (int ks = 0; ks < 2 * (w + 1); ++ks) {
                    const bf16x8 af = lds_frag(L + L_BS, 32 * w + r, 16 * ks + 8 * hh), bfg = lds_frag(L + L_XT, r, 16 * ks + 8 * hh);
                    yd = __builtin_amdgcn_mfma_f32_32x32x16_bf16(af, bfg, yd, 0, 0, 0);
                }
                LAS unsigned char* stc = L + L_ST + (c & 1) * (32 * SP * 2);
#pragma unroll
                for (int ks = 0; ks < 8; ++ks) {
                    const bf16x8 af = lds_frag(L + L_CS, 32 * w + r, 16 * ks + 8 * hh), bfg = lds_frag(stc, r, 16 * ks + 8 * hh);
                    yo = __builtin_amdgcn_mfma_f32_32x32x16_bf16(af, bfg, yo, 0, 0, 0);
                }
#pragma unroll
                for (int q = 0; q < 4; ++q) {
                    const int t0 = 32 * w + 8 * q + 4 * hh;
                    const u32x2 xx = *(const LAS u32x2*)(L + L_XT + (r * SP + t0) * 2);
                    const float xv[4] = {bflo(xx.x), bfhi(xx.x), bflo(xx.y), bfhi(xx.y)};
#pragma unroll
                    for (int e = 0; e < 4; ++e) { const int t = t0 + e, i = 4 * q + e;
                        bf16* zp = U + (rowbase + t) * LDE + EZ + h * 64 + ph * 32 + r;
                        const float z = bf2f((unsigned short)rawz[i]);
                        const float y = yd[i] + __expf(acum[t]) * yo[i] + dsk * xv[e];
                        *zp = (bf16)f2bfh(y * siluf(z)); }
                }
                if (c + 1 < 32) SSD_FETCH_Z(c + 1);
            } else {
                const int n0 = 32 * (w - 4); const float dec = __expf(acum[127]);
#pragma unroll
                for (int i = 0; i < 16; ++i) state[i] *= dec;
#pragma unroll
                for (int ks = 0; ks < 8; ++ks) {
                    const bf16x8 af = lds_frag(L + L_XS, r, 16 * ks + 8 * hh), bfg = lds_frag(L + L_BT, n0 + r, 16 * ks + 8 * hh);
                    state = __builtin_amdgcn_mfma_f32_32x32x16_bf16(af, bfg, state, 0, 0, 0);
                }
                LAS unsigned char* stn = L + L_ST + ((c + 1) & 1) * (32 * SP * 2);
#pragma unroll
                for (int i = 0; i < 16; ++i) { const int p = 8 * (i >> 2) + 4 * hh + (i & 3);
                    *(LAS bf16*)(stn + (p * SP + n0 + r) * 2) = (bf16)f2bfh(state[i]); }
            }
            __syncthreads();
        }
    }
}

#undef SSD_FETCH_BCX
#undef SSD_FETCH_Z
typedef short s16x4 __attribute__((ext_vector_type(4)));
__device__ __forceinline__ s16x4 lds_tr16(LAS unsigned char* p) { return __builtin_bit_cast(s16x4, __builtin_amdgcn_ds_read_tr16_b64_v4i16((LAS s16x4*)p)); }
__device__ __forceinline__ int t5_bucket_dev(int d) {
    if (d < 16) return d;
    const int v = 16 + (int)(log((double)d / 16.0) / log(8.0) * 16.0);
    return v < 31 ? v : 31;
}
constexpr int D_SEL = 131072, D_LUT = 135168, VP = 72;
__device__ __forceinline__ int okey(float f) { const int iv = __builtin_bit_cast(int, f); return iv ^ ((iv >> 31) & 0x7fffffff); }

__device__ __forceinline__ void p_dsa(Frame& F, const Args& A) {
    bf16* U = (bf16*)(F.ws + WS_U); bf16* HB = (bf16*)(F.ws + WS_HB);
    const int w = F.wave;
    const float* ng = A.in[10];
    LAS unsigned char* L = F.lds;
    LAS float* LUT = (LAS float*)(L + D_LUT);
    for (int i = F.tid; i < 1024; i += NTHR) LUT[i] = A.in[1][t5_bucket_dev(i >> 3) * 8 + (i & 7)];
    __syncthreads();
    for (int blk = F.bid; blk < MTOK / 8; blk += F.G) {
        int lane = F.lane; asm volatile("" : "+v"(lane));
        const int kr = blk >> 8, cc = blk & 255, b = kr >> 1, tb = (kr & 1) ? 511 - cc : cc, t0 = tb * 8;
        const size_t bat = (size_t)b * SEQ, rowb = bat + t0;
        {
            const size_t row = rowb + w;
            const u32x4 v = *(const u32x4*)(U + row * LDE + EZ + 8 * lane);
            float f[8] = {bflo(v.x), bfhi(v.x), bflo(v.y), bfhi(v.y), bflo(v.z), bfhi(v.z), bflo(v.w), bfhi(v.w)};
            float s = 0.f;
#pragma unroll
            for (int j = 0; j < 8; ++j) s += f[j] * f[j];
#pragma unroll
            for (int o = 1; o < 32; o <<= 1) s += __shfl_xor(s, o);
            const float rs = 1.f / sqrtf(s * (1.f / 256.f) + NORM_EPS); const float* g = ng + 8 * lane;
            u32x4 o; o.x = pk2(f[0] * rs * g[0], f[1] * rs * g[1]); o.y = pk2(f[2] * rs * g[2], f[3] * rs * g[3]); o.z = pk2(f[4] * rs * g[4], f[5] * rs * g[5]); o.w = pk2(f[6] * rs * g[6], f[7] * rs * g[7]);
            *(u32x4*)(HB + row * DM + 8 * lane) = o;
        }
        {
            const int r = lane & 31, hh = lane >> 5;
            bf16x8 qa[4];
#pragma unroll
            for (int ks = 0; ks < 4; ++ks) qa[ks] = *(const bf16x8*)(U + (rowb + (r >> 2)) * LDE + EIQ + (r & 3) * 64 + 16 * ks + 8 * hh);
            float wv[4][4];
#pragma unroll
            for (int q = 0; q < 4; ++q) { const u32x2 ww = *(const u32x2*)(U + (rowb + 2 * q + hh) * LDE + EIW); wv[q][0] = bflo(ww.x); wv[q][1] = bfhi(ww.x); wv[q][2] = bflo(ww.y); wv[q][3] = bfhi(ww.y); }
            const int ntile = (t0 + 8 + 31) >> 5;
            for (int tb = w; tb < ntile; tb += 4 * NWAVES) {
                bf16x8 kf[4][4];
#pragma unroll
                for (int u4 = 0; u4 < 4; ++u4) { const int tl = tb + 8 * u4 < 128 ? tb + 8 * u4 : 127; const int key = 32 * tl + r;
#pragma unroll
                    for (int ks = 0; ks < 4; ++ks) kf[u4][ks] = *(const bf16x8*)(U + (bat + key) * LDE + EIK + 16 * ks + 8 * hh); }
#pragma unroll
                for (int u4 = 0; u4 < 4; ++u4) {
                    const int tile = tb + 8 * u4;
                    f32x16 acc = {0.f, 0.f, 0.f, 0.f, 0.f, 0.f, 0.f, 0.f, 0.f, 0.f, 0.f, 0.f, 0.f, 0.f, 0.f, 0.f};
#pragma unroll
                    for (int ks = 0; ks < 4; ++ks) acc = __builtin_amdgcn_mfma_f32_32x32x16_bf16(qa[ks], kf[u4][ks], acc, 0, 0, 0);
                    if (tile < ntile) {
#pragma unroll
                        for (int q = 0; q < 4; ++q) {
                            const float sc = wv[q][0] * fmaxf(acc[4 * q], 0.f) + wv[q][1] * fmaxf(acc[4 * q + 1], 0.f) + wv[q][2] * fmaxf(acc[4 * q + 2], 0.f) + wv[q][3] * fmaxf(acc[4 * q + 3], 0.f);
                            *(LAS float*)(L + ((2 * q + hh) * 4096 + 32 * tile + r) * 4) = sc + 0.f;
                        }
                    }
                }
            }
        }
        __syncthreads();
        const int t = t0 + w, n = t + 1;
        LAS unsigned short* sel = (LAS unsigned short*)(L + D_SEL) + w * 256;
        const int cnt = n < 256 ? n : 256;
        if (n <= 256) {
#pragma unroll
            for (int i = 0; i < 4; ++i) { const int s = lane + 64 * i; sel[s] = (unsigned short)(s < n ? s : 0); }
        } else {
            const int nj = (t0 + 8 + 63) >> 6;
            const LAS float* myrow = (const LAS float*)(L + w * 16384);
            int v[64]; int vmax = (int)0x80000000, vmin = 0x7fffffff;
#pragma unroll
            for (int jb = 0; jb < 4; ++jb) {
                if (16 * jb < nj) {
#pragma unroll
                    for (int jj = 0; jj < 16; ++jj) { const int j = 16 * jb + jj; const int idx = lane + 64 * j; const int kv = okey(myrow[idx]);
                        const bool ok = idx <= t; v[j] = ok ? kv : (int)0x80000000; vmax = v[j] > vmax ? v[j] : vmax; const int x = ok ? kv : 0x7fffffff; vmin = x < vmin ? x : vmin; }
                } else {
#pragma unroll
                    for (int jj = 0; jj < 16; ++jj) v[16 * jb + jj] = (int)0x80000000;
                }
            }
#pragma unroll
            for (int o = 1; o < 64; o <<= 1) { const int x = __shfl_xor(vmax, o); vmax = x > vmax ? x : vmax; const int y = __shfl_xor(vmin, o); vmin = y < vmin ? y : vmin; }
            vmax = __builtin_amdgcn_readfirstlane(vmax); vmin = __builtin_amdgcn_readfirstlane(vmin);
            int lo = vmin, hi = vmax, clo = n, chi = 0, it = 0;
            for (int rps = 0; rps < (REP_PART == 4 ? A.rep : 1); ++rps) { lo = vmin; hi = vmax; clo = n; chi = 0; it = 0;
            while (lo < hi) {
                int mid;
                const int ph3 = it % 3;
                if (ph3 == 2) mid = lo + (int)(((long long)hi - (long long)lo + 1) >> 1);
                else {
                    const float lof = __builtin_bit_cast(float, lo >= 0 ? lo : lo ^ 0x7fffffff), hif = __builtin_bit_cast(float, hi >= 0 ? hi : hi ^ 0x7fffffff);
                    const float fr = ph3 == 0 ? ((float)(clo - 256) + 0.5f) / (float)(clo - chi) : 0.5f;
                    mid = okey(lof + (hif - lof) * fr);
                    mid = mid > hi ? hi : mid; mid = mid <= lo ? lo + 1 : mid;
                }
                int c = 0;
#pragma unroll
                for (int jb = 0; jb < 4; ++jb) if (16 * jb < nj) {
#pragma unroll
                    for (int jj = 0; jj < 16; ++jj) c += __popcll(__ballot(v[16 * jb + jj] >= mid)); }
                ++it;
                if (c == 256) { lo = mid; break; }
                if (c > 256) { lo = mid; clo = c; } else { hi = mid - 1; chi = c; }
            } }
            const int T = lo;
            int cgt = 0;
#pragma unroll
            for (int jb = 0; jb < 4; ++jb) if (16 * jb < nj) {
#pragma unroll
                for (int jj = 0; jj < 16; ++jj) cgt += __popcll(__ballot(v[16 * jb + jj] > T)); }
            const int need_eq = 256 - cgt;
            int obase = 0, ebase = 0;
            for (int rpf = 0; rpf < (REP_PART == 5 ? A.rep : 1); ++rpf) { obase = 0; ebase = 0;
#pragma unroll
            for (int jb = 0; jb < 4; ++jb) if (16 * jb < nj) {
#pragma unroll
                for (int jj = 0; jj < 16; ++jj) { const int j = 16 * jb + jj;
                    const bool gt = v[j] > T, eq = v[j] == T;
                    const unsigned long long be = __ballot(eq);
                    const int erank = ebase + (int)__builtin_amdgcn_mbcnt_hi((unsigned)(be >> 32), __builtin_amdgcn_mbcnt_lo((unsigned)be, 0u));
                    const bool take = gt || (eq && erank < need_eq);
                    const unsigned long long bt = __ballot(take);
                    const int pos = obase + (int)__builtin_amdgcn_mbcnt_hi((unsigned)(bt >> 32), __builtin_amdgcn_mbcnt_lo((unsigned)bt, 0u));
                    if (take && pos < 256) sel[pos] = (unsigned short)(lane + 64 * j);
                    obase += __popcll(bt); ebase += __popcll(be); } } }
        }
        __syncthreads();
        {
            const int hd = lane & 15, g4 = lane >> 4;
            const size_t row = rowb + w;
            bf16x8 qb[2];
            {
                float qf[2][8]; float ss = 0.f;
#pragma unroll
                for (int ks = 0; ks < 2; ++ks) { u32x4 qq = (u32x4){0u, 0u, 0u, 0u};
                    if (hd < 8) qq = *(const u32x4*)(U + row * LDE + EQ + hd * 64 + 32 * ks + 8 * g4);
                    qf[ks][0] = bflo(qq.x); qf[ks][1] = bfhi(qq.x); qf[ks][2] = bflo(qq.y); qf[ks][3] = bfhi(qq.y); qf[ks][4] = bflo(qq.z); qf[ks][5] = bfhi(qq.z); qf[ks][6] = bflo(qq.w); qf[ks][7] = bfhi(qq.w);
#pragma unroll
                    for (int j = 0; j < 8; ++j) ss += qf[ks][j] * qf[ks][j]; }
                ss += __shfl_xor(ss, 16); ss += __shfl_xor(ss, 32);
                const float rs = 0.125f / sqrtf(ss * (1.f / 64.f) + NORM_EPS);
#pragma unroll
                for (int ks = 0; ks < 2; ++ks) { const float* gq = A.in[11] + 32 * ks + 8 * g4;
                    u32x4 pk; pk.x = pk2(qf[ks][0] * rs * gq[0], qf[ks][1] * rs * gq[1]); pk.y = pk2(qf[ks][2] * rs * gq[2], qf[ks][3] * rs * gq[3]);
                    pk.z = pk2(qf[ks][4] * rs * gq[4], qf[ks][5] * rs * gq[5]); pk.w = pk2(qf[ks][6] * rs * gq[6], qf[ks][7] * rs * gq[7]);
                    qb[ks] = __builtin_bit_cast(bf16x8, pk); }
            }
            float lg[16][4]; float mx = -3.0e38f;
            const int vsl = lane >> 3, vpart = lane & 7;
            u32x4 vr[2][8];
#pragma unroll
            for (int hb = 0; hb < 2; ++hb) {
                bf16x8 ka[8][2];
#pragma unroll
                for (int T8 = 0; T8 < 8; ++T8) { const int sm = sel[16 * (8 * hb + T8) + hd]; const bf16* kp = U + (bat + sm) * LDE + EK + 8 * g4;
                    ka[T8][0] = *(const bf16x8*)kp; ka[T8][1] = *(const bf16x8*)(kp + 32); }
#pragma unroll
                for (int e = 0; e < 8; ++e) { const int sm = sel[64 * hb + 8 * e + vsl]; vr[hb][e] = *(const u32x4*)(U + (bat + sm) * LDE + EV + 8 * vpart); }
#pragma unroll
                for (int T8 = 0; T8 < 8; ++T8) { const int T = 8 * hb + T8;
                    f32x4 acc = {0.f, 0.f, 0.f, 0.f};
                    acc = __builtin_amdgcn_mfma_f32_16x16x32_bf16(ka[T8][0], qb[0], acc, 0, 0, 0);
                    acc = __builtin_amdgcn_mfma_f32_16x16x32_bf16(ka[T8][1], qb[1], acc, 0, 0, 0);
                    const u32x2 sl = *(const LAS u32x2*)(sel + 16 * T + 4 * g4);
                    const int s4[4] = {(int)(sl.x & 0xffffu), (int)(sl.x >> 16), (int)(sl.y & 0xffffu), (int)(sl.y >> 16)};
#pragma unroll
                    for (int i = 0; i < 4; ++i) { int dist = t - s4[i]; dist = dist < 0 ? 0 : (dist > 127 ? 127 : dist);
                        const float bia = LUT[dist * 8 + (hd & 7)];
                        const bool valid = (16 * T + 4 * g4 + i) < cnt;
                        lg[T][i] = valid ? acc[i] + bia : -3.0e38f; mx = fmaxf(mx, lg[T][i]); }
                }
            }
            mx = fmaxf(mx, __shfl_xor(mx, 16)); mx = fmaxf(mx, __shfl_xor(mx, 32));
            float sum = 0.f;
#pragma unroll
            for (int T = 0; T < 16; ++T) {
#pragma unroll
                for (int i = 0; i < 4; ++i) { const float p = lg[T][i] > -1.0e38f ? __expf(lg[T][i] - mx) : 0.f; lg[T][i] = p; sum += p; }
                if ((T & 3) == 3) __builtin_amdgcn_sched_barrier(0); }
            sum += __shfl_xor(sum, 16); sum += __shfl_xor(sum, 32);
            const float inv = 1.f / fmaxf(sum, 1e-30f);
            f32x4 oacc[4];
#pragma unroll
            for (int dt = 0; dt < 4; ++dt) oacc[dt] = (f32x4){0.f, 0.f, 0.f, 0.f};
            LAS unsigned char* Vl = L + w * 16384;
#pragma unroll
            for (int ch = 0; ch < 4; ++ch) {
                LDS_WAIT();
#pragma unroll
                for (int e = 0; e < 8; ++e) *(LAS u32x4*)(Vl + ((8 * e + vsl) * VP + 8 * vpart) * 2) = vr[ch & 1][e];
                if (ch + 2 < 4) {
#pragma unroll
                    for (int e = 0; e < 8; ++e) { const int sm = sel[64 * (ch + 2) + 8 * e + vsl]; vr[ch & 1][e] = *(const u32x4*)(U + (bat + sm) * LDE + EV + 8 * vpart); }
                }
                LDS_WAIT();
#pragma unroll
                for (int kk = 0; kk < 2; ++kk) {
                    const int T0 = 2 * (2 * ch + kk);
                    u32x4 pp; pp.x = pk2(lg[T0][0] * inv, lg[T0][1] * inv); pp.y = pk2(lg[T0][2] * inv, lg[T0][3] * inv); pp.z = pk2(lg[T0 + 1][0] * inv, lg[T0 + 1][1] * inv); pp.w = pk2(lg[T0 + 1][2] * inv, lg[T0 + 1][3] * inv);
                    const bf16x8 pf = __builtin_bit_cast(bf16x8, pp);
                    const int qq = (lane & 15) >> 2, p4 = lane & 3;
#pragma unroll
                    for (int dt = 0; dt < 4; ++dt) {
                        const s16x4 b0 = lds_tr16(Vl + ((32 * kk + 4 * g4 + qq) * VP + 16 * dt + 4 * p4) * 2);
                        const s16x4 b1 = lds_tr16(Vl + ((32 * kk + 16 + 4 * g4 + qq) * VP + 16 * dt + 4 * p4) * 2);
                        bf16x8 bfg; bfg[0] = b0[0]; bfg[1] = b0[1]; bfg[2] = b0[2]; bfg[3] = b0[3]; bfg[4] = b1[0]; bfg[5] = b1[1]; bfg[6] = b1[2]; bfg[7] = b1[3];
                        oacc[dt] = __builtin_amdgcn_mfma_f32_16x16x32_bf16(pf, bfg, oacc[dt], 0, 0, 0);
                    }
                }
            }
            if (g4 < 2) {
#pragma unroll
                for (int i = 0; i < 4; ++i)
#pragma unroll
                    for (int dt = 0; dt < 4; ++dt) HB[row * DM + 512 + (4 * g4 + i) * 64 + 16 * dt + hd] = (bf16)f2bfh(oacc[dt][i]);
            }
        }
        __syncthreads();
    }
}

template <int MODE> __device__ __forceinline__ void p_norm_route(Frame& F, const float* xin, const float* gain, int layer) {
    constexpr int NT = MODE == 0 ? 3 : 2;
    bf16* HB = (bf16*)(F.ws + WS_HB); const bf16* WR = MODE == 0 ? (const bf16*)(F.ws + WS_WR) + (size_t)layer * 48 * 1024 : (const bf16*)(F.ws + WS_WGL);
    float* GL = (float*)(F.ws + WS_GL);
    int* list = (int*)(F.ws + WS_LIST); float* wl = (float*)(F.ws + WS_LISTW);
    LAS unsigned char* L = F.lds;
    LAS float* lgt = (LAS float*)L + F.wave * (16 * 48);
    LAS int* cntl = (LAS int*)(L + 32768); LAS int* basel = (LAS int*)(L + 33024);
    LAS int* ri_e = (LAS int*)(L + 34816); LAS int* ri_p = (LAS int*)(L + 36864); LAS float* ri_w = (LAS float*)(L + 38912);
    const int w = F.wave;
    for (int base = F.bid * 256; base < MTOK; base += F.G * 256) {
        int lane = F.lane; asm volatile("" : "+v"(lane));
        if (F.tid < 64) cntl[F.tid] = 0;
        __syncthreads();
#pragma unroll 1
        for (int half = 0; half < 2; ++half) {
            const int R0 = base + w * 32 + half * 16;
#pragma unroll 1
            for (int i = 0; i < 16; ++i) rms_row_to_bf16(xin + (size_t)(R0 + i) * DM, gain, HB + (size_t)(R0 + i) * DM, lane);
            VM_WAIT();
            const int n16 = lane & 15, g4 = lane >> 4;
            f32x4 acc[NT];
#pragma unroll
            for (int nt = 0; nt < NT; ++nt) acc[nt] = (f32x4){0.f, 0.f, 0.f, 0.f};
#pragma unroll 4
            for (int kk = 0; kk < 32; ++kk) {
                const bf16x8 a = *(const bf16x8*)(HB + (size_t)(R0 + n16) * DM + 32 * kk + 8 * g4);
#pragma unroll
                for (int nt = 0; nt < NT; ++nt) { const bf16x8 bb = *(const bf16x8*)(WR + (size_t)(16 * nt + n16) * DM + 32 * kk + 8 * g4);
                    acc[nt] = __builtin_amdgcn_mfma_f32_16x16x32_bf16(a, bb, acc[nt], 0, 0, 0); }
            }
            if constexpr (MODE == 1) {
#pragma unroll
                for (int nt = 0; nt < NT; ++nt)
#pragma unroll
                    for (int i = 0; i < 4; ++i) if (16 * nt + n16 < 24) GL[(size_t)(R0 + 4 * g4 + i) * 24 + 16 * nt + n16] = acc[nt][i];
            } else {
#pragma unroll
            for (int nt = 0; nt < NT; ++nt)
#pragma unroll
                for (int i = 0; i < 4; ++i) lgt[(4 * g4 + i) * 48 + 16 * nt + n16] = acc[nt][i];
            LDS_WAIT();
            if (lane < 16) {
                const LAS float* lr = lgt + lane * 48;
                int gs = 0; float gm = lr[0];
#pragma unroll
                for (int j = 1; j < 4; ++j) if (lr[j] > gm) { gm = lr[j]; gs = j; }
                float gsum = 0.f;
#pragma unroll
                for (int j = 0; j < 4; ++j) gsum += __expf(lr[j] - gm);
                const float gw = 1.f / gsum;
                const LAS float* er = lr + 4 + 8 * gs;
                int i0 = 0; float m0 = er[0];
#pragma unroll
                for (int j = 1; j < 8; ++j) if (er[j] > m0) { m0 = er[j]; i0 = j; }
                int i1 = -1; float m1 = -3.0e38f;
#pragma unroll
                for (int j = 0; j < 8; ++j) if (j != i0 && er[j] > m1) { m1 = er[j]; i1 = j; }
                const float w0 = 1.f / (1.f + __expf(m1 - m0));
                const int e0 = gs * 8 + i0, e1 = 32 + gs * 8 + i1;
                const int rs = (w * 32 + half * 16 + lane) * 2;
                ri_e[rs] = e0; ri_p[rs] = __hip_atomic_fetch_add(cntl + e0, 1, __ATOMIC_RELAXED, __HIP_MEMORY_SCOPE_WORKGROUP); ri_w[rs] = w0 * gw;
                ri_e[rs + 1] = e1; ri_p[rs + 1] = __hip_atomic_fetch_add(cntl + e1, 1, __ATOMIC_RELAXED, __HIP_MEMORY_SCOPE_WORKGROUP); ri_w[rs + 1] = (1.f - w0) * gw;
            }
            LDS_WAIT();
            }
        }
        if constexpr (MODE == 1) continue;
        __syncthreads();
        if (F.tid < 64) { const int c = cntl[F.tid]; basel[F.tid] = c ? (int)__hip_atomic_fetch_add((unsigned*)(F.ctl + CW_CNT + layer * 4096 + 64 * F.tid), (unsigned)c, RLX_AGENT) : 0; }
        __syncthreads();
        { const int rs = F.tid, e = ri_e[rs], pos = basel[e] + ri_p[rs];
          list[(size_t)e * 65536 + pos] = base + (rs >> 1); wl[(size_t)e * 65536 + pos] = ri_w[rs]; }
        __syncthreads();
    }
}
__device__ __forceinline__ void moe_tables(Frame& F, int layer) {
    LAS int* ptile = (LAS int*)(F.lds + MOE_OFF); LAS int* cntv = ptile + 128;
    __syncthreads();
    if (F.tid < 64) {
        const int c = (int)__hip_atomic_load((unsigned*)(F.ctl + CW_CNT + layer * 4096 + 64 * F.tid), RLX_AGENT);
        cntv[F.tid] = c;
        int nt = (c + 255) >> 8, incl = nt;
#pragma unroll
        for (int o = 1; o < 64; o <<= 1) { const int t = __shfl_up(incl, o); if (F.lane >= o) incl += t; }
        ptile[F.tid] = incl - nt; if (F.tid == 63) ptile[64] = incl;
    }
    __syncthreads();
}
__device__ __forceinline__ void p_moe_gu(Frame& F, int layer) {
    moe_tables(F, layer);
    const LAS int* ptile = (const LAS int*)(F.lds + MOE_OFF); const LAS int* cntv = ptile + 128;
    pg8::MoeOrder S{(const char*)(F.ws + WS_HB), (const char*)(F.ws + WS_WGU) + (size_t)layer * 32 * 1024 * 1024 * 2, (size_t)1024 * 1024 * 2, 1024, F.G, F.bid, 0, ptile[64], ptile, cntv, (const int*)(F.ws + WS_LIST), true};
    pg8::EpiSwiGLU E{(bf16*)(F.ws + WS_U)};
    pg8::gemm_phase<pg8::EpiSwiGLU, pg8::MoeOrder, true>(F.lds, 1024, S, E);
}
__device__ __forceinline__ void p_moe_down(Frame& F, int layer, int slot) {
    moe_tables(F, layer);
    const LAS int* ptile = (const LAS int*)(F.lds + MOE_OFF); const LAS int* cntv = ptile + 128;
    pg8::MoeOrder S{(const char*)(F.ws + WS_U), (const char*)(F.ws + WS_WD) + (size_t)layer * 32 * 1024 * 512 * 2, (size_t)1024 * 512 * 2, 512, F.G, F.bid, ptile[32 * slot], ptile[32 * slot + 32], ptile, cntv, (const int*)(F.ws + WS_LIST), false};
    pg8::EpiScatter E{F.out, (const int*)(F.ws + WS_LIST), (const float*)(F.ws + WS_LISTW), cntv};
    pg8::gemm_phase<pg8::EpiScatter, pg8::MoeOrder, true>(F.lds, 512, S, E);
}

__device__ __forceinline__ void p_compress(Frame& F, const Args& A) {
    bf16* U = (bf16*)(F.ws + WS_U);
    LAS unsigned char* L = F.lds;
    const int w = F.wave;
    {
        const int tid = F.tid, sub = tid & 15;
        for (int v0 = F.bid * 32; v0 < MTOK * 4; v0 += F.G * 32) {
            const int vec = v0 + (tid >> 4), row = vec >> 2, wh = vec & 3;
            bf16* p = U + (size_t)row * LDO + ((wh >> 1) ? OKW : OKS) + (wh & 1) * 128 + 8 * sub;
            const float* g = ((wh >> 1) ? A.in[18] : A.in[17]) + 8 * sub;
            const u32x4 v = *(const u32x4*)p; float f[8] = {bflo(v.x), bfhi(v.x), bflo(v.y), bfhi(v.y), bflo(v.z), bfhi(v.z), bflo(v.w), bfhi(v.w)};
            float s = 0.f;
#pragma unroll
            for (int j = 0; j < 8; ++j) s += f[j] * f[j];
            s += __shfl_xor(s, 1); s += __shfl_xor(s, 2); s += __shfl_xor(s, 4); s += __shfl_xor(s, 8);
            const float rs = 1.f / sqrtf(s * (1.f / 128.f) + NORM_EPS);
            u32x4 o; o.x = pk2(f[0] * rs * g[0], f[1] * rs * g[1]); o.y = pk2(f[2] * rs * g[2], f[3] * rs * g[3]); o.z = pk2(f[4] * rs * g[4], f[5] * rs * g[5]); o.w = pk2(f[6] * rs * g[6], f[7] * rs * g[7]);
            *(u32x4*)p = o;
        }
    }
    constexpr int C_A = 0, C_B = 17408, C_H = 52224, C_S = 69632;
    for (int unit = F.bid; unit < 256; unit += F.G) {
        int tid = F.tid, lane = F.lane; asm volatile("" : "+v"(tid), "+v"(lane));
        const int T = unit >> 7, b = (unit >> 3) & 15, g = (unit >> 2) & 1, cb = unit & 3;
        const int col = (T ? OVC : OKC) + g * 128;
        const float* pos = T ? A.in[20] : A.in[19];
        const bf16* w1t = (const bf16*)(F.ws + (T ? WS_W1V : WS_W1K)); const bf16* w2t = (const bf16*)(F.ws + WS_W2) + T * 128 * 128;
        const int wm = w >> 2, wn = w & 3, r = lane & 31, hh = lane >> 5;
        f32x16 acc = {0.f, 0.f, 0.f, 0.f, 0.f, 0.f, 0.f, 0.f, 0.f, 0.f, 0.f, 0.f, 0.f, 0.f, 0.f, 0.f};
#pragma unroll 1
        for (int l = 0; l < 32; ++l) {
            __syncthreads();
#pragma unroll
            for (int e = 0; e < 2; ++e) { const int q = tid + 512 * e, c = q >> 4, part = q & 15; const int tok = 16 * (64 * cb + c) + l;
                u32x4 v = (u32x4){0u, 0u, 0u, 0u};
                if (tok < SEQ) v = *(const u32x4*)(U + ((size_t)b * SEQ + tok) * LDO + col + 8 * part);
                const f32x4 p0 = *(const f32x4*)(pos + l * 128 + 8 * part), p1 = *(const f32x4*)(pos + l * 128 + 8 * part + 4);
                u32x4 o; o.x = pk2(bflo(v.x) + p0.x, bfhi(v.x) + p0.y); o.y = pk2(bflo(v.y) + p0.z, bfhi(v.y) + p0.w); o.z = pk2(bflo(v.z) + p1.x, bfhi(v.z) + p1.y); o.w = pk2(bflo(v.w) + p1.z, bfhi(v.w) + p1.w);
                *(LAS u32x4*)(L + C_A + (c * SP + 8 * part) * 2) = o; }
#pragma unroll
            for (int e = 0; e < 4; ++e) { const int q = tid + 512 * e, j = q >> 4, part = q & 15;
                *(LAS u32x4*)(L + C_B + (j * SP + 8 * part) * 2) = *(const u32x4*)(w1t + (size_t)j * 4096 + l * 128 + 8 * part); }
            __syncthreads();
#pragma unroll
            for (int ks = 0; ks < 8; ++ks) {
                const bf16x8 af = lds_frag(L + C_A, 32 * wm + r, 16 * ks + 8 * hh), bfg = lds_frag(L + C_B, 32 * wn + r, 16 * ks + 8 * hh);
                acc = __builtin_amdgcn_mfma_f32_32x32x16_bf16(af, bfg, acc, 0, 0, 0);
            }
        }
#pragma unroll
        for (int i = 0; i < 16; ++i) { const int c = 32 * wm + 8 * (i >> 2) + 4 * hh + (i & 3);
            *(LAS bf16*)(L + C_H + (c * SP + 32 * wn + r) * 2) = (bf16)f2bfh(siluf(acc[i])); }
        __syncthreads();
        f32x16 a2 = {0.f, 0.f, 0.f, 0.f, 0.f, 0.f, 0.f, 0.f, 0.f, 0.f, 0.f, 0.f, 0.f, 0.f, 0.f, 0.f};
#pragma unroll
        for (int ks = 0; ks < 8; ++ks) {
            const bf16x8 af = lds_frag(L + C_H, 32 * wm + r, 16 * ks + 8 * hh), bfg = *(const bf16x8*)(w2t + (size_t)(32 * wn + r) * 128 + 16 * ks + 8 * hh);
            a2 = __builtin_amdgcn_mfma_f32_32x32x16_bf16(af, bfg, a2, 0, 0, 0);
        }
        float rsv[16];
        if (T == 0) {
            LAS float* st = (LAS float*)(L + C_S);
#pragma unroll
            for (int i = 0; i < 16; ++i) { float q = a2[i] * a2[i];
                q += __shfl_xor(q, 1); q += __shfl_xor(q, 2); q += __shfl_xor(q, 4); q += __shfl_xor(q, 8); q += __shfl_xor(q, 16);
                if (r == 0) st[(32 * wm + 8 * (i >> 2) + 4 * hh + (i & 3)) * 4 + wn] = q; }
            __syncthreads();
#pragma unroll
            for (int i = 0; i < 16; ++i) { const f32x4 q = *(const LAS f32x4*)(st + (32 * wm + 8 * (i >> 2) + 4 * hh + (i & 3)) * 4);
                rsv[i] = A.in[16][32 * wn + r] / sqrtf((q.x + q.y + q.z + q.w) * (1.f / 128.f) + NORM_EPS); }
        } else {
#pragma unroll
            for (int i = 0; i < 16; ++i) rsv[i] = 1.f;
        }
        bf16* dst = (bf16*)(F.ws + (T ? WS_VCMP : WS_KCMP));
#pragma unroll
        for (int i = 0; i < 16; ++i) { const int c = 64 * cb + 32 * wm + 8 * (i >> 2) + 4 * hh + (i & 3);
            dst[(((size_t)b * 256 + c) * 2 + g) * 128 + 32 * wn + r] = (bf16)f2bfh(a2[i] * rsv[i]); }
    }
}

constexpr int N_STG = 32768;
constexpr int N_K = 0, N_V = 16384, N_LUT = 3 * N_STG, N_IMP = N_LUT + 4096, N_FAC = N_IMP + 16384, N_MSK = N_FAC + 1024, N_UNI = N_MSK + 512, N_CST = N_UNI + 64;
constexpr float LOG2E = 1.44269504f;
enum { BR_CMP = 0, BR_SEL = 1, BR_WIN = 2 };
struct NsaCtx {
    LAS unsigned char* L; const bf16* U; const bf16* KC; const bf16* VC;
    int tid, lane, w, r, hh, b, g, qblk, t0, t, head; size_t bat;
    float mrow, cfar; unsigned mlo, mhi;
};
__device__ __forceinline__ void glds16(const void* gsrc, unsigned lds_dst) { unsigned keep;
    asm volatile("s_mov_b32 %0, m0\n\ts_mov_b32 m0, %2\n\ts_nop 0\n\tglobal_load_lds_dwordx4 %1, off\n\ts_mov_b32 m0, %0" : "=&s"(keep) : "v"(gsrc), "s"(lds_dst) : "memory"); }
#define NSA_BAR() do { asm volatile("" ::: "memory"); __builtin_amdgcn_s_barrier(); asm volatile("" ::: "memory"); } while (0)
template <int BR, bool SUM, bool PV, bool IMP, bool UNITFAC = false>
__device__ __forceinline__ void nsa_pass(const NsaCtx& X, const bf16x8 (&qf)[8], f32x16 (&oacc)[4], float& lsum, const float colfac, const int tlo, const int thi, const unsigned long long tmask) {
    LAS unsigned char* L = X.L; const int r = X.r, hh = X.hh, lane = X.lane;
    const LAS float* LUT = (const LAS float*)(L + N_LUT);
    auto dma = [&](int tl, int st) {
#pragma unroll
        for (int e = 0; e < 2; ++e) { const int pidx = e * 8 + X.w, row = pidx * 4 + (lane >> 4), ch = (lane & 15) ^ (((lane >> 4) << 2) | (X.w & 3));
            const bf16* kp; const bf16* vp;
            if (BR == BR_CMP) { const size_t o = (((size_t)X.b * 256 + 64 * tl + row) * 2 + X.g) * 128 + 8 * ch; kp = X.KC + o; vp = X.VC + o; }
            else { const size_t o = (X.bat + 64 * tl + row) * LDO + X.g * 128 + 8 * ch; kp = X.U + o + (BR == BR_SEL ? OKS : OKW); vp = X.U + o + (BR == BR_SEL ? OVS : OVW); }
            const unsigned ld = (unsigned)__builtin_amdgcn_readfirstlane((int)(unsigned)(__SIZE_TYPE__)(L + st * N_STG + N_K + pidx * 1024));
            glds16(kp, ld); if (PV) glds16(vp, ld + N_V); }
    };
    auto nextt = [&](int tl) { ++tl; while (tl <= thi && !((tmask >> tl) & 1ull)) ++tl; return tl; };
    int tile = nextt(tlo - 1);
    if (tile > thi) return;
    asm volatile("s_waitcnt vmcnt(0)" ::: "memory");
    int nxt = nextt(tile);
    int nn = nxt <= thi ? nextt(nxt) : nxt;
    dma(tile, 0); if (nxt <= thi) dma(nxt, 1);
    int cur = 0;
    const bool gB = X.w >= 4;
    const int kswz = ((r & 3) << 2) | ((r >> 2) & 3);
#define NSA_WAIT_KEEP(has_newer) do { if (has_newer) { if (PV) asm volatile("s_waitcnt vmcnt(4)" ::: "memory"); else asm volatile("s_waitcnt vmcnt(2)" ::: "memory"); } else asm volatile("s_waitcnt vmcnt(0)" ::: "memory"); } while (0)
    if (gB) { NSA_WAIT_KEEP(nxt <= thi); NSA_BAR(); }
    while (tile <= thi) {
        const int st2 = cur >= 1 ? cur - 1 : 2;
        if (!gB) NSA_WAIT_KEEP(nxt <= thi);
        NSA_BAR();
        if (gB && nn <= thi) dma(nn, st2);
        LAS unsigned char* Ls = L + cur * N_STG;
        const int maxpos = BR == BR_CMP ? 16 * (64 * tile + 63) + 31 : 64 * tile + 63, minpos = BR == BR_CMP ? 16 * (64 * tile) + 31 : 64 * tile;
        const bool far = (X.t0 - maxpos >= 113) && (BR != BR_WIN || (X.t0 + 63 - minpos < 512));
        bool selb = true; if (BR == BR_SEL) selb = (tile < 32 ? (X.mlo >> tile) : (X.mhi >> (tile - 32))) & 1u;
        bf16x8 pa[2][2];
        {
            bf16x8 kf[2][8];
#pragma unroll
            for (int mt = 0; mt < 2; ++mt)
#pragma unroll
                for (int ks = 0; ks < 8; ++ks) kf[mt][ks] = *(const LAS bf16x8*)(Ls + N_K + (32 * mt + r) * 256 + 16 * ((2 * ks + hh) ^ kswz));
            asm volatile("" ::: "memory");
            f32x16 sacc[2];
#pragma unroll
            for (int mt = 0; mt < 2; ++mt) sacc[mt] = (f32x16){0.f, 0.f, 0.f, 0.f, 0.f, 0.f, 0.f, 0.f, 0.f, 0.f, 0.f, 0.f, 0.f, 0.f, 0.f, 0.f};
#pragma unroll
            for (int ks = 0; ks < 8; ++ks)
#pragma unroll
                for (int mt = 0; mt < 2; ++mt) sacc[mt] = __builtin_amdgcn_mfma_f32_32x32x16_bf16(kf[mt][ks], qf[ks], sacc[mt], 0, 0, 0);
            const float cf = (BR == BR_SEL && !selb) ? -1.0e30f : X.cfar;
#pragma unroll
            for (int mt = 0; mt < 2; ++mt) {
                if (far) {
#pragma unroll
                    for (int i = 0; i < 16; ++i) { const float p = __builtin_amdgcn_exp2f(sacc[mt][i] + cf);
                        if (SUM) lsum += p; sacc[mt][i] = UNITFAC ? p : p * colfac; }
                } else {
#pragma unroll
                    for (int i = 0; i < 16; ++i) { const int kidx = 32 * mt + 8 * (i >> 2) + 4 * hh + (i & 3);
                        int dist; bool ok;
                        if (BR == BR_CMP) { dist = X.t - (16 * (64 * tile + kidx) + 31); ok = dist >= 0; }
                        else { dist = X.t - (64 * tile + kidx); ok = BR == BR_SEL ? (selb && dist >= 0) : (dist >= 0 && dist < 512); }
                        const int dc = dist < 0 ? 0 : (dist > 127 ? 127 : dist);
                        const float bia = LUT[dc * 8 + X.head];
                        const float ev = __builtin_amdgcn_exp2f(sacc[mt][i] + bia - X.mrow);
                        const float p = ok ? ev : 0.f;
                        if (SUM) lsum += p;
                        sacc[mt][i] = UNITFAC ? p : p * colfac; }
                }
                if (IMP) {
                    LAS float* imp = (LAS float*)(L + N_IMP) + (X.w * 8 + (r >> 2)) * 64;
#pragma unroll
                    for (int q = 0; q < 4; ++q) { float s4 = (sacc[mt][4 * q] + sacc[mt][4 * q + 1]) + (sacc[mt][4 * q + 2] + sacc[mt][4 * q + 3]), s3 = sacc[mt][4 * q + 3];
                        s4 += __shfl_xor(s4, 1); s4 += __shfl_xor(s4, 2); s3 += __shfl_xor(s3, 1); s3 += __shfl_xor(s3, 2);
                        const int n = 16 * tile + 8 * mt + 2 * q + hh;
                        if ((r & 3) == 0) { __hip_atomic_fetch_add(imp + n, s4, __ATOMIC_RELAXED, __HIP_MEMORY_SCOPE_WORKGROUP); if (n < 63) __hip_atomic_fetch_add(imp + n + 1, s3, __ATOMIC_RELAXED, __HIP_MEMORY_SCOPE_WORKGROUP); } }
                }
                if (PV) {
#pragma unroll
                    for (int sI = 0; sI < 2; ++sI) { u32x4 pp; pp.x = pk2(sacc[mt][8 * sI], sacc[mt][8 * sI + 1]); pp.y = pk2(sacc[mt][8 * sI + 2], sacc[mt][8 * sI + 3]); pp.z = pk2(sacc[mt][8 * sI + 4], sacc[mt][8 * sI + 5]); pp.w = pk2(sacc[mt][8 * sI + 6], sacc[mt][8 * sI + 7]);
                        pa[mt][sI] = __builtin_bit_cast(bf16x8, pp); }
                }
            }
        }
        if (gB && nxt <= thi) NSA_WAIT_KEEP(nn <= thi);
        NSA_BAR();
        if (!gB && nn <= thi) dma(nn, st2);
        if (PV) {
            const int q4 = (lane & 15) >> 2, k2 = 2 * ((lane >> 4) & 1) + ((lane & 3) >> 1), sub8 = 8 * (lane & 1);
            s16x4 vb[2][8];
#define NSA_LDV(g, dst) do { const int _row0 = 16 * (g) + 4 * hh + q4; _Pragma("unroll") for (int nt = 0; nt < 4; ++nt) { \
                dst[2 * nt] = lds_tr16(Ls + N_V + _row0 * 256 + 64 * (nt ^ q4) + 16 * (k2 ^ hh) + sub8); \
                dst[2 * nt + 1] = lds_tr16(Ls + N_V + (_row0 + 8) * 256 + 64 * (nt ^ q4) + 16 * (k2 ^ (hh + 2)) + sub8); } } while (0)
            NSA_LDV(0, vb[0]);
#pragma unroll
            for (int g = 0; g < 4; ++g) {
                if (g == 0) NSA_LDV(1, vb[1]); else if (g == 1) NSA_LDV(2, vb[0]); else if (g == 2) NSA_LDV(3, vb[1]);
                asm volatile("" ::: "memory");
#pragma unroll
                for (int nt = 0; nt < 4; ++nt) { const s16x4 b0 = vb[g & 1][2 * nt], b1 = vb[g & 1][2 * nt + 1];
                    bf16x8 bfg; bfg[0] = b0[0]; bfg[1] = b0[1]; bfg[2] = b0[2]; bfg[3] = b0[3]; bfg[4] = b1[0]; bfg[5] = b1[1]; bfg[6] = b1[2]; bfg[7] = b1[3];
                    oacc[nt] = __builtin_amdgcn_mfma_f32_32x32x16_bf16(pa[g >> 1][g & 1], bfg, oacc[nt], 0, 0, 0); }
            }
#undef NSA_LDV
        }
        tile = nxt; nxt = nn; nn = nn <= thi ? nextt(nn) : nn;
        cur = cur == 2 ? 0 : cur + 1;
    }
#undef NSA_WAIT_KEEP
    if (!gB) NSA_BAR();
    __syncthreads();
}

__device__ __forceinline__ void p_nsa(Frame& F, const Args& A) {
    const bf16* U = (const bf16*)(F.ws + WS_U); bf16* HB = (bf16*)(F.ws + WS_HB); const float* GL = (const float*)(F.ws + WS_GL);
    LAS unsigned char* L = F.lds;
    LAS float* LUT = (LAS float*)(L + N_LUT); LAS float* cst = (LAS float*)(L + N_CST);
    for (int i = F.tid; i < 1024; i += NTHR) LUT[i] = A.in[1][t5_bucket_dev(i >> 3) * 8 + (i & 7)] * LOG2E;
    if (F.wave == 0) {
        float gm = 0.f, bm = 0.f;
        for (int i = F.lane; i < 128; i += 64) gm = fmaxf(gm, fmaxf(fabsf(A.in[16][i]), fmaxf(fabsf(A.in[17][i]), fabsf(A.in[18][i]))));
        for (int i = F.lane; i < 256; i += 64) bm = fmaxf(bm, fabsf(A.in[1][i]));
#pragma unroll
        for (int o = 1; o < 64; o <<= 1) { gm = fmaxf(gm, __shfl_xor(gm, o)); bm = fmaxf(bm, __shfl_xor(bm, o)); }
        if (F.lane == 0) { cst[0] = gm * 11.3137085f; cst[1] = bm * LOG2E; }
    }
    __syncthreads();
    const float kmax = cst[0], bmax = cst[1];
    for (int ui = F.bid; ui < 2048; ui += F.G) {
        NsaCtx X; X.L = L; X.U = U; X.KC = (const bf16*)(F.ws + WS_KCMP); X.VC = (const bf16*)(F.ws + WS_VCMP);
        int tid = F.tid, lane = F.lane; asm volatile("" : "+v"(tid), "+v"(lane));
        X.tid = tid; X.lane = lane; X.w = F.wave; X.r = lane & 31; X.hh = lane >> 5;
        const int kr = ui >> 8, cc = ui & 255, bg = kr * 4 + (cc >> 6);
        X.b = bg >> 1; X.g = bg & 1; X.qblk = (kr & 1) ? 63 - (cc & 63) : (cc & 63); X.t0 = 64 * X.qblk; X.bat = (size_t)X.b * SEQ;
        const int tq = X.r >> 2, hd = X.r & 3; X.t = X.t0 + 8 * X.w + tq; X.head = 4 * X.g + hd;
        const size_t row = X.bat + X.t;
        if (tid == 0) *(LAS unsigned long long*)(L + N_UNI) = 0ull;
        for (int i = tid; i < 4096; i += NTHR) ((LAS float*)(L + N_IMP))[i] = 0.f;
        bf16x8 qf[8]; float qn2 = 0.f;
        {
            u32x4 qr[8]; float ss = 0.f;
#pragma unroll
            for (int ks = 0; ks < 8; ++ks) { qr[ks] = *(const u32x4*)(U + row * LDO + OQ + X.head * 128 + 16 * ks + 8 * X.hh);
#pragma unroll
                for (int e = 0; e < 4; ++e) { const float a = bflo(qr[ks][e]), c = bfhi(qr[ks][e]); ss += a * a + c * c; } }
            ss += __shfl_xor(ss, 32);
            const float rs = 1.f / sqrtf(ss * (1.f / 128.f) + NORM_EPS);
#pragma unroll
            for (int ks = 0; ks < 8; ++ks) { const float* gq = A.in[15] + 16 * ks + 8 * X.hh; u32x4 pk;
#pragma unroll
                for (int e = 0; e < 4; ++e) { const float a = bflo(qr[ks][e]) * rs * gq[2 * e], c = bfhi(qr[ks][e]) * rs * gq[2 * e + 1]; qn2 += a * a + c * c; pk[e] = pk2(a * (0.0883883476f * LOG2E), c * (0.0883883476f * LOG2E)); }
                qf[ks] = __builtin_bit_cast(bf16x8, pk); }
            qn2 += __shfl_xor(qn2, 32);
        }
        X.mrow = sqrtf(qn2) * (0.0883883476f * LOG2E) * kmax + bmax;
        X.cfar = LUT[127 * 8 + X.head] - X.mrow;
        X.mlo = 0u; X.mhi = 0u;
        const float g_c = 1.f / (1.f + __expf(-GL[row * 24 + X.head])), g_s = 1.f / (1.f + __expf(-GL[row * 24 + 8 + X.head])), g_w = 1.f / (1.f + __expf(-GL[row * 24 + 16 + X.head]));
        f32x16 oacc[4];
#pragma unroll
        for (int nt = 0; nt < 4; ++nt) oacc[nt] = (f32x16){0.f, 0.f, 0.f, 0.f, 0.f, 0.f, 0.f, 0.f, 0.f, 0.f, 0.f, 0.f, 0.f, 0.f, 0.f, 0.f};
        const int ntc = ((4 * X.qblk + 2) >> 6) + 1;
        float l_c = 0.f;
        nsa_pass<BR_CMP, true, false, false, true>(X, qf, oacc, l_c, 1.f, 0, ntc - 1, ~0ull);
        l_c += __shfl_xor(l_c, 32);
        const float il_c = l_c > 0.f ? 1.f / l_c : 0.f;
        { float dummy = 0.f; nsa_pass<BR_CMP, false, false, true>(X, qf, oacc, dummy, il_c, 0, ntc - 1, ~0ull); }
        {
            LDS_WAIT();
            const LAS float* impw = (const LAS float*)(L + N_IMP) + X.w * 8 * 64;
            const int n = lane, cur = X.qblk;
            unsigned long long wor = 0ull;
#pragma unroll 1
            for (int q = 0; q < 8; ++q) {
                const float imp = impw[q * 64 + n];
                const bool forced = (n == 0) || (n == cur) || (n == cur - 1);
                float val = forced ? 3.0e38f : imp; if (n > cur) val = -3.0e38f;
                int rank = 0;
#pragma unroll 8
                for (int m = 0; m < 64; ++m) { const float vm = __shfl(val, m); rank += (vm > val || (vm == val && m < n)) ? 1 : 0; }
                const unsigned long long mk = __ballot(n <= cur && rank < 16);
                wor |= mk;
                if ((X.r >> 2) == q) { X.mlo = (unsigned)mk; X.mhi = (unsigned)(mk >> 32); }
            }
            if (lane == 0) __hip_atomic_fetch_or((LAS unsigned long long*)(L + N_UNI), wor, __ATOMIC_RELAXED, __HIP_MEMORY_SCOPE_WORKGROUP);
        }
        __syncthreads();
        const unsigned long long uni = *(const LAS unsigned long long*)(L + N_UNI);
        float l_s = 0.f;
        nsa_pass<BR_SEL, true, true, false, true>(X, qf, oacc, l_s, 1.f, 0, X.qblk, uni);
        if (REP_PART == 7) for (int rp = 1; rp < A.rep; ++rp) { float dummy = 0.f; nsa_pass<BR_SEL, false, true, false, false>(X, qf, oacc, dummy, 0.f, 0, X.qblk, uni); }
        l_s += __shfl_xor(l_s, 32);
        {
            LAS float* fac = (LAS float*)(L + N_FAC) + X.w * 32;
            if (lane < 32) fac[lane] = l_s > 0.f ? g_s / l_s : 0.f;
            LDS_WAIT();
#pragma unroll
            for (int q = 0; q < 4; ++q) { const f32x4 fr = *(const LAS f32x4*)(fac + 8 * q + 4 * X.hh);
#pragma unroll
                for (int nt = 0; nt < 4; ++nt) { oacc[nt][4 * q] *= fr.x; oacc[nt][4 * q + 1] *= fr.y; oacc[nt][4 * q + 2] *= fr.z; oacc[nt][4 * q + 3] *= fr.w; } }
        }
        { float dummy = 0.f; nsa_pass<BR_CMP, false, true, false>(X, qf, oacc, dummy, g_c * il_c, 0, ntc - 1, ~0ull); }
        const int wlo = X.qblk >= 8 ? X.qblk - 8 : 0;
        float l_w = 0.f;
        nsa_pass<BR_WIN, true, false, false, true>(X, qf, oacc, l_w, 1.f, wlo, X.qblk, ~0ull);
        l_w += __shfl_xor(l_w, 32);
        { float dummy = 0.f; nsa_pass<BR_WIN, false, true, false>(X, qf, oacc, dummy, l_w > 0.f ? g_w / l_w : 0.f, wlo, X.qblk, ~0ull); }
#pragma unroll
        for (int i = 0; i < 16; ++i) { const int c32 = 8 * (i >> 2) + 4 * X.hh + (i & 3);
            bf16* op = HB + (X.bat + X.t0 + 8 * X.w + (c32 >> 2)) * DM + (4 * X.g + (c32 & 3)) * 128 + X.r;
#pragma unroll
            for (int nt = 0; nt < 4; ++nt) op[32 * nt] = (bf16)f2bfh(oacc[nt][i]); }
    }
}

constexpr int N_PHASES = 18;
__global__ void __launch_bounds__(NTHR, 2) mk_fwd(Args args) {
    extern __shared__ __attribute__((aligned(16))) unsigned char lds[];
    Frame F;
    F.lds = (LAS unsigned char*)lds;
    F.MISC = (volatile LAS unsigned*)(F.lds + MISC_OFF);
    F.tid = threadIdx.x; F.lane = F.tid & 63; F.wave = __builtin_amdgcn_readfirstlane(F.tid >> 6);
    F.G = gridDim.x; F.bid = blockIdx.x;
    F.ws = args.ws; F.out = args.out; F.ctl = (gu32*)(args.ws + WS_CTL);
    if (F.tid < 64) F.MISC[F.tid] = 0u;
    __syncthreads();
    const int lo = args.ph_lo, hi = args.ph_hi;
    XcdBarrier bar; bar.bar = (unsigned*)(F.ctl + CW_BAR); bar.x = 0; bar.st = nullptr;
    if (hi - lo > 1) bar = xcd_barrier_post((unsigned*)(F.ctl + CW_BAR), F.MISC + 8);
#ifndef PHMASK
#define PHMASK 0xffffffffu
#endif
#define IN(k) (((PHMASK >> (k)) & 1u) && lo <= (k) && (k) < hi)
#ifndef REPMASK
#define REPMASK 0u
#endif
#define RUNS(k) (1 + (int)((REPMASK >> (k)) & 1u))
#define SEAM(k) do { if (IN(k) && IN((k) + 1)) xcd_barrier(bar); } while (0)
    if (IN(0)) { for (int rp = 0; rp < RUNS(0); ++rp) p_prologue(F, args); } SEAM(0);
    if (IN(1)) for (int rp = 0; rp < RUNS(1); ++rp) {
        pg8::StaticOrder S; S.init(F.ws + WS_HB, F.ws + WS_WIE, MTOK, LDE, DM, F.G, F.bid);
        pg8::EpiBf16 E{(bf16*)(F.ws + WS_U), LDE};
        pg8::gemm_phase<pg8::EpiBf16, pg8::StaticOrder, true>(F.lds, DM, S, E);
    } SEAM(1);
    if (IN(2)) { p_ssd(F, args); } SEAM(2);
    if (IN(3)) { for (int rp = 0; rp < RUNS(3); ++rp) p_dsa(F, args); } SEAM(3);
    if (IN(4)) {
        pg8::StaticOrder S; S.init(F.ws + WS_HB, F.ws + WS_WOE, MTOK, DM, DM, F.G, F.bid);
        pg8::EpiResF32 E{args.in[0], F.out, DM};
        pg8::gemm_phase<pg8::EpiResF32, pg8::StaticOrder, true>(F.lds, DM, S, E);
    } SEAM(4);
    if (IN(5)) { p_norm_route<0>(F, F.out, args.in[3], 0); } SEAM(5);
    if (IN(6)) { p_moe_gu(F, 0);
#if (REPMASK >> 6) & 1
        p_moe_gu(F, 0);
#endif
    } SEAM(6);
    if (IN(7)) { p_moe_down(F, 0, 0); } SEAM(7);
    if (IN(8)) { p_moe_down(F, 0, 1); } SEAM(8);
    if (IN(9)) { for (int rp = 0; rp < RUNS(9); ++rp) p_norm_route<1>(F, F.out, args.in[2] + DM, 0); } SEAM(9);
    if (IN(10)) {
        pg8::StaticOrder S; S.init(F.ws + WS_HB, F.ws + WS_WIO, MTOK, LDO, DM, F.G, F.bid);
        pg8::EpiBf16 E{(bf16*)(F.ws + WS_U), LDO};
        pg8::gemm_phase<pg8::EpiBf16, pg8::StaticOrder, true>(F.lds, DM, S, E);
    } SEAM(10);
    if (IN(11)) { p_compress(F, args); } SEAM(11);
    if (IN(12)) { p_nsa(F, args);
#if (REPMASK >> 12) & 1
        p_nsa(F, args);
#endif
    } SEAM(12);
    if (IN(13)) {
        pg8::StaticOrder S; S.init(F.ws + WS_HB, F.ws + WS_WOO, MTOK, DM, DM, F.G, F.bid);
        pg8::EpiResF32 E{F.out, F.out, DM};
        pg8::gemm_phase<pg8::EpiResF32, pg8::StaticOrder, true>(F.lds, DM, S, E);
    } SEAM(13);
    if (IN(14)) { p_norm_route<0>(F, F.out, args.in[3] + DM, 1); } SEAM(14);
    if (IN(15)) { p_moe_gu(F, 1); } SEAM(15);
    if (IN(16)) { p_moe_down(F, 1, 0); } SEAM(16);
    if (IN(17)) { p_moe_down(F, 1, 1); }
#undef IN
#undef SEAM
}

extern "C" void kernel_launch(void* const* d_in, const int* in_sizes, int n_in, void* d_out, int out_size, void* d_ws, size_t ws_size, hipStream_t stream) {
    static int grid = 0;
    if (grid == 0) {
        if (n_in != 31 || ws_size < WS_END) { fprintf(stderr, "kernel_launch: unexpected n_in %d / ws %zu\n", n_in, ws_size); grid = -1; return; }
        int dev = 0, cus = 0;
        if (hipGetDevice(&dev) != hipSuccess || hipDeviceGetAttribute(&cus, hipDeviceAttributeMultiprocessorCount, dev) != hipSuccess) { grid = -1; return; }
        if (hipFuncSetAttribute((const void*)mk_fwd, hipFuncAttributeMaxDynamicSharedMemorySize, LDS_BYTES) != hipSuccess) { fprintf(stderr, "kernel_launch: hipFuncSetAttribute failed\n"); grid = -1; return; }
        grid = cus;
    }
    if (grid < 0) return;
    (void)hipMemsetAsync((char*)d_ws + WS_CTL, 0, CTL_ZERO_BYTES, stream);
    Args a{};
    for (int i = 0; i < 31; ++i) a.in[i] = (const float*)d_in[i];
    a.out = (float*)d_out; a.ws = (unsigned char*)d_ws; a.rep = (REP_PART || REP_PHASE >= 0) ? 2 : 1; a.pad = 0; a.rep = 2; a.pad = 0;
#if defined(MK_PER_PHASE)
    for (int p = 0; p < N_PHASES; ++p) { a.ph_lo = p; a.ph_hi = p + 1; hipLaunchKernelGGL(mk_fwd, dim3(grid), dim3(NTHR), LDS_BYTES, stream, a); }
#else
    a.ph_lo = 0; a.ph_hi = N_PHASES; hipLaunchKernelGGL(mk_fwd, dim3(grid), dim3(NTHR), LDS_BYTES, stream, a);
#endif
}
```

```cpp
#include <hip/hip_runtime.h>
#include <cstdio>
#include <cstdint>

#define GAS __attribute__((address_space(1)))
#define LAS __attribute__((address_space(3)))
typedef unsigned short bf16;
typedef short bf16x8 __attribute__((ext_vector_type(8)));
typedef float f32x4 __attribute__((ext_vector_type(4)));
typedef float f32x2 __attribute__((ext_vector_type(2)));
typedef float f32x16 __attribute__((ext_vector_type(16)));
typedef unsigned u32x4 __attribute__((ext_vector_type(4)));
typedef unsigned u32x2 __attribute__((ext_vector_type(2)));
typedef GAS unsigned gu32;
#define RLX_AGENT __ATOMIC_RELAXED, __HIP_MEMORY_SCOPE_AGENT
#define LDS_WAIT() asm volatile("s_waitcnt lgkmcnt(0)" ::: "memory")
#define VM_WAIT() asm volatile("s_waitcnt vmcnt(0)" ::: "memory")

constexpr int NB = 16, SEQ = 4096, DM = 1024, MTOK = NB * SEQ;
constexpr float NORM_EPS = 1e-6f;
constexpr int LDE = 2560;
constexpr int EZ = 0, EXS = 512, EBB = 1024, ECC = 1280, EQ = 1536, EK = 2048, EV = 2112, EIQ = 2176, EIK = 2432, EDT = 2496, EIW = 2504;
constexpr int LDO = 2560;
constexpr int OQ = 0, OKC = 1024, OVC = 1280, OKS = 1536, OVS = 1792, OKW = 2048, OVW = 2304;
constexpr int NWAVES = 8, NTHR = 512;

constexpr size_t MiB = 1u << 20;
constexpr size_t WS_CTL = 0, CTL_ZERO_BYTES = 1 * MiB;
constexpr size_t WS_WIE = 1 * MiB, WS_WOE = 6 * MiB, WS_WIO = 8 * MiB, WS_WOO = 13 * MiB;
constexpr size_t WS_W1K = 15 * MiB, WS_W1V = 16 * MiB, WS_W2 = 17 * MiB, WS_WR = 18 * MiB;
constexpr size_t WS_WGL = WS_WR + 256 * 1024;
constexpr size_t WS_TOK = 19 * MiB;
constexpr size_t WS_GL = 20 * MiB;
constexpr size_t WS_KCMP = 26 * MiB, WS_VCMP = 28 * MiB;
constexpr size_t WS_LIST = 32 * MiB;
constexpr size_t WS_WGU = 48 * MiB;
constexpr size_t WS_WD = 176 * MiB;
constexpr size_t WS_HB = 240 * MiB;
constexpr size_t WS_U = 368 * MiB;
constexpr size_t WS_LISTW = 720 * MiB;
constexpr size_t WS_XB = 736 * MiB;
constexpr size_t WS_END = 864 * MiB;
constexpr int CW_TMO = 0, CW_CODE = 1, CW_BAR = 4096, CW_CNT = 8192;

constexpr int RING_BYTES = 131072;
constexpr int LDS_BYTES = 147456;
constexpr int MISC_OFF = LDS_BYTES - 256;
constexpr int MOE_OFF = LDS_BYTES - 2048;

__device__ __forceinline__ unsigned f2bf(float f) { unsigned u = __builtin_bit_cast(unsigned, f); return (u + 0x7fffu + ((u >> 16) & 1u)) >> 16; }
typedef __bf16 bf16x2_t __attribute__((ext_vector_type(2)));
__device__ __forceinline__ unsigned pk2(float lo, float hi) { const f32x2 v = {lo, hi}; const bf16x2_t b = __builtin_convertvector(v, bf16x2_t); return __builtin_bit_cast(unsigned, b); }
__device__ __forceinline__ unsigned short f2bfh(float f) { return (unsigned short)(pk2(f, f) & 0xffffu); }
__device__ __forceinline__ float bf2f(unsigned short b) { return __builtin_bit_cast(float, ((unsigned)b) << 16); }
__device__ __forceinline__ float bflo(unsigned w) { return __builtin_bit_cast(float, w << 16); }
__device__ __forceinline__ float bfhi(unsigned w) { return __builtin_bit_cast(float, w & 0xffff0000u); }
__device__ __forceinline__ float siluf(float v) { return v * __builtin_amdgcn_rcpf(1.f + __builtin_amdgcn_exp2f(-1.44269504f * v)); }

#define XB_TMO      128
#define XB_XCNT(j)  (256  + 64 * (j))
#define XB_XSUB(j)  (1280 + 64 * (j))
#define XB_XGEN(j)  (2304 + 64 * (j))
#define XB_TOP      3328
#define XB_TOPGEN   3392
#define XCD_BAR_WORDS 3456
#define XB_SPIN_CAP (1u << 20)
__device__ __forceinline__ unsigned xb_ld(unsigned* p)              { return __hip_atomic_load(p, __ATOMIC_RELAXED, __HIP_MEMORY_SCOPE_AGENT); }
__device__ __forceinline__ unsigned xb_add(unsigned* p, unsigned v) { return __hip_atomic_fetch_add(p, v, __ATOMIC_RELAXED, __HIP_MEMORY_SCOPE_AGENT); }
__device__ __forceinline__ unsigned xb_xcc_id() { return (unsigned)__builtin_amdgcn_s_getreg((3 << 11) | 20) & 0xFu; }
#define XB_SPIN(cond, bar) do { unsigned _sp = 0; while (cond) { __builtin_amdgcn_s_sleep(1); \
    if ((++_sp & 255u) == 0u) { if (xb_ld(&(bar)[XB_TMO])) break; if (_sp > XB_SPIN_CAP) { atomicAdd(&(bar)[XB_TMO], 1u); break; } } } } while (0)
struct XcdBarrier { unsigned* bar; unsigned x; volatile LAS unsigned* st; };
__device__ __forceinline__ XcdBarrier xcd_barrier_post(unsigned* bar, volatile LAS unsigned* st) {
    XcdBarrier b; b.bar = bar; b.x = xb_xcc_id(); b.st = st;
    if (threadIdx.x == 0) (void)xb_add(&bar[XB_XCNT(b.x)], 1u);
    return b;
}
__device__ __forceinline__ void xcd_barrier_complete(unsigned* bar, unsigned x, unsigned& nloc, unsigned& nx) {
    const unsigned G = gridDim.x * gridDim.y * gridDim.z;
    unsigned sum, cnt, mine, sp = 0u;
    for (;;) {
        sum = 0u; cnt = 0u; mine = 0u;
#pragma unroll
        for (unsigned j = 0; j < 16; ++j) { const unsigned c = xb_ld(&bar[XB_XCNT(j)]); sum += c; cnt += (c > 0u) ? 1u : 0u; mine = (j == x) ? c : mine; }
        if (sum == G) break;
        __builtin_amdgcn_s_sleep(1);
        if ((++sp & 255u) == 0u) { if (xb_ld(&bar[XB_TMO])) break; if (sp > XB_SPIN_CAP) { atomicAdd(&bar[XB_TMO], 1u); break; } }
    }
    nloc = mine > 0u ? mine : 1u; nx = cnt > 0u ? cnt : 1u;
}
__device__ __forceinline__ void xcd_barrier(const XcdBarrier& b) {
    asm volatile("s_waitcnt vmcnt(0)" ::: "memory");
    __syncthreads();
    if (threadIdx.x == 0) {
        unsigned* bar = b.bar;
        __builtin_amdgcn_s_waitcnt(0);
        unsigned nloc = b.st[0], nx = b.st[1];
        if (nloc == 0u) { xcd_barrier_complete(bar, b.x, nloc, nx); b.st[0] = nloc; b.st[1] = nx; }
        const unsigned old = xb_add(&bar[XB_XSUB(b.x)], 1u);
        const unsigned gen = old / nloc;
        if (old + 1u == (gen + 1u) * nloc) {
            __builtin_amdgcn_fence(__ATOMIC_RELEASE, "agent");
            asm volatile("s_waitcnt vmcnt(0)" ::: "memory");
            const unsigned og = xb_add(&bar[XB_TOP], 1u);
            const unsigned tg = og / nx;
            if (og + 1u == (tg + 1u) * nx) xb_add(&bar[XB_TOPGEN], 1u);
            else XB_SPIN(xb_ld(&bar[XB_TOPGEN]) == tg, bar);
            __builtin_amdgcn_fence(__ATOMIC_ACQUIRE, "agent");
            xb_add(&bar[XB_XGEN(b.x)], 1u);
            asm volatile("s_waitcnt vmcnt(0)" ::: "memory");
        } else {
            XB_SPIN(xb_ld(&bar[XB_XGEN(b.x)]) == gen, bar);
            __builtin_amdgcn_fence(__ATOMIC_ACQUIRE, "agent");
            asm volatile("s_waitcnt vmcnt(0)" ::: "memory");
        }
    }
    __syncthreads();
}

namespace pg8 {
constexpr int BM = 256, BK = 64, HALF = 128, HTB = HALF * BK * 2, STAGE_BYTES = 8 * HTB, NXCD = 8, WGM = 8;
__host__ __device__ __forceinline__ int lds_byte(int r, int c) { const int st = (r >> 4) * 2 + (c >> 5), rr = r & 15, cc = c & 31, ob = rr * 64 + cc * 2; return st * 1024 + (ob ^ (((ob >> 9) & 1) << 5)); }
__host__ __device__ __forceinline__ void stage_rc(int b, int& R, int& C) { const int st = b / 1024, sb = b % 1024, swz = sb ^ (((sb >> 9) & 1) << 5); R = (st >> 1) * 16 + swz / 64; C = (st & 1) * 32 + (swz % 64) / 2; }
__host__ __device__ __forceinline__ int perm32(int rho) { const int n = rho >> 4, i = rho & 15; return 8 * (i >> 2) + 4 * n + (i & 3); }
__device__ __forceinline__ unsigned cvt_pk_bf16(float lo, float hi) { unsigned r; asm volatile("v_cvt_pk_bf16_f32 %0, %1, %2" : "=v"(r) : "v"(lo), "v"(hi)); return r; }

struct Unit { const char* A; const char* B; int pm, pn, aux; };

struct StaticOrder {
    const char* A; const char* Bt; int K, nM, nN, nwg, G, c;
    __device__ void init(const void* A_, const void* Bt_, int M, int N, int K_, int G_, int c_) { A = (const char*)A_; Bt = (const char*)Bt_; K = K_; nM = M / BM; nN = N / BM; nwg = nM * nN; G = G_; c = c_; }
    __device__ __forceinline__ bool next(int i, Unit& u) const {
        const long L = (long)i * G + c; if (L >= nwg) return false;
        int wgid = (int)L; { const int q = nwg / NXCD, r = nwg % NXCD, xcd = wgid % NXCD, off = wgid / NXCD; wgid = (xcd < r ? xcd * (q + 1) : r * (q + 1) + (xcd - r) * q) + off; }
        const int nig = WGM * nN, gid = wgid / nig, fm = gid * WGM, gsz = (nM - fm) < WGM ? (nM - fm) : WGM;
        u.pm = fm + ((wgid % nig) % gsz); u.pn = (wgid % nig) / gsz; u.aux = 0;
        u.A = A + (size_t)u.pm * BM * K * 2; u.B = Bt + (size_t)u.pn * BM * K * 2; return true;
    }
    __device__ __forceinline__ unsigned arow(const Unit&, int r) const { return (unsigned)(r * K) * 2u; }
};

template <class Epi, class Sched, bool ALIGN_EPI>
__device__ __forceinline__ void gemm_phase(LAS unsigned char* lds, const int K, const Sched& S, const Epi& E) {
    const int tid = threadIdx.x, wid = __builtin_amdgcn_readfirstlane(tid >> 6), lane = tid & 63, wr = wid >> 2, wc = wid & 3, fr = lane & 15, fq = lane >> 4;
    const int nt = K / BK;
    int RA[2], CA[2]; unsigned voffB[2];
#pragma unroll
    for (int i = 0; i < 2; ++i) { int R, C; stage_rc(tid * 16 + i * 8192, R, C); const int Rb = Epi::PERM ? ((R & ~31) + perm32(R & 31)) : R;
        RA[i] = R; CA[i] = C; voffB[i] = (unsigned)(Rb * K + C) * 2u; }
    const size_t kstep = (size_t)(BK * 2);
    const size_t hstep = (size_t)HALF * K * 2;
    const unsigned ldsw = (unsigned)wid * 1024u;
    const int aoff = lds_byte(wr * 64 + fr, fq * 8), boff = lds_byte(wc * 32 + fr, fq * 8);
#define PG8_SA(b, h) (((b) * 2 + (h)) * HTB)
#define PG8_SB(b, h) ((4 + (b) * 2 + (h)) * HTB)
#define PG8_STAGE(bufoff, gbase, voff) do { _Pragma("unroll") for (int _i = 0; _i < 2; ++_i) \
        __builtin_amdgcn_global_load_lds((const unsigned*)((const char*)(gbase) + (voff)[_i]), (LAS unsigned*)(lds + (bufoff) + ldsw + _i * 8192), 16, 0, 0); } while (0)
#define PG8_LDA(dst, b, h) do { _Pragma("unroll") for (int m = 0; m < 4; ++m) _Pragma("unroll") for (int k = 0; k < 2; ++k) dst[m][k] = *(const LAS bf16x8*)(lds + PG8_SA(b, h) + aoff + m * 2048 + k * 1024); } while (0)
#define PG8_LDB(dst, b, h) do { _Pragma("unroll") for (int n = 0; n < 2; ++n) _Pragma("unroll") for (int k = 0; k < 2; ++k) dst[n][k] = *(const LAS bf16x8*)(lds + PG8_SB(b, h) + boff + n * 2048 + k * 1024); } while (0)
#define PG8_MMA(ai, bj, At, Bt) do { __builtin_amdgcn_s_setprio(1); _Pragma("unroll") for (int m = 0; m < 4; ++m) _Pragma("unroll") for (int n = 0; n < 2; ++n) _Pragma("unroll") for (int k = 0; k < 2; ++k) \
        acc[ai][bj][m][n] = __builtin_amdgcn_mfma_f32_16x16x32_bf16(Bt[n][k], At[m][k], acc[ai][bj][m][n], 0, 0, 0); __builtin_amdgcn_s_setprio(0); } while (0)
#define PG8_WAIT_V(n) asm volatile("s_waitcnt vmcnt(" #n ")" ::: "memory")
#define PG8_WAIT_L(n) asm volatile("s_waitcnt lgkmcnt(" #n ")" ::: "memory")
#define PG8_BAR __builtin_amdgcn_s_barrier()
#define PG8_SCHED __builtin_amdgcn_sched_barrier(0)
    Unit cur, nxt; int ui = 0;
    if (!S.next(0, cur)) return;
    f32x4 acc[2][2][4][2];
#pragma unroll
    for (int a = 0; a < 2; ++a)
#pragma unroll
        for (int b = 0; b < 2; ++b)
#pragma unroll
            for (int m = 0; m < 4; ++m)
#pragma unroll
                for (int n = 0; n < 2; ++n) acc[a][b][m][n] = (f32x4){0.f, 0.f, 0.f, 0.f};
    bf16x8 At[4][2], B0[2][2], B1[2][2];
    unsigned vA0[2], vA1[2], nA0[2], nA1[2];
#pragma unroll
    for (int i = 0; i < 2; ++i) { vA0[i] = S.arow(cur, RA[i]) + CA[i] * 2u; vA1[i] = S.arow(cur, HALF + RA[i]) + CA[i] * 2u; nA0[i] = vA0[i]; nA1[i] = vA1[i]; }
    const char* cA = cur.A; const char* cB = cur.B;
    PG8_STAGE(PG8_SB(0, 0), cB, voffB); PG8_STAGE(PG8_SB(0, 1), cB + hstep, voffB); PG8_STAGE(PG8_SA(0, 0), cA, vA0); PG8_STAGE(PG8_SA(0, 1), cA, vA1);
    if (wr == 1) PG8_BAR;
    PG8_WAIT_V(2); PG8_BAR;
    PG8_STAGE(PG8_SB(1, 0), cB + kstep, voffB); PG8_STAGE(PG8_SA(1, 0), cA + kstep, vA0); PG8_STAGE(PG8_SB(1, 1), cB + hstep + kstep, voffB);
    PG8_WAIT_V(6); PG8_BAR;
    for (;;) {
        const bool has_next = S.next(ui + 1, nxt);
        const char* nA = has_next ? nxt.A : cA; const char* nB = has_next ? nxt.B : cB;
        if (has_next) {
#pragma unroll
            for (int i = 0; i < 2; ++i) { nA0[i] = S.arow(nxt, RA[i]) + CA[i] * 2u; nA1[i] = S.arow(nxt, HALF + RA[i]) + CA[i] * 2u; }
        }
        for (int t = 0; t < nt; t += 2) {
            const bool last = (t == nt - 2);
            const char* a1 = cA + (size_t)(t + 1) * kstep;
            const char* a2 = last ? nA : cA + (size_t)(t + 2) * kstep; const char* b2 = last ? nB : cB + (size_t)(t + 2) * kstep;
            const char* a3 = a2 + kstep; const char* b3 = b2 + kstep;
            unsigned w0[2], w1[2];
#pragma unroll
            for (int i = 0; i < 2; ++i) { w0[i] = last ? nA0[i] : vA0[i]; w1[i] = last ? nA1[i] : vA1[i]; }
            PG8_LDB(B0, 0, 0); PG8_LDB(B1, 0, 1); PG8_SCHED; PG8_LDA(At, 0, 0); PG8_STAGE(PG8_SA(1, 1), a1, vA1);
            PG8_WAIT_V(8); PG8_WAIT_L(0); PG8_BAR; PG8_MMA(0, 0, At, B0); PG8_MMA(0, 1, At, B1); PG8_BAR; PG8_SCHED;
            PG8_LDA(At, 0, 1); PG8_STAGE(PG8_SB(0, 0), b2, voffB); PG8_STAGE(PG8_SB(0, 1), b2 + hstep, voffB); PG8_STAGE(PG8_SA(0, 0), a2, w0);
            PG8_WAIT_V(8); PG8_WAIT_L(0); PG8_BAR; PG8_MMA(1, 0, At, B0); PG8_MMA(1, 1, At, B1); PG8_BAR; PG8_SCHED;
            PG8_LDB(B0, 1, 0); PG8_LDB(B1, 1, 1); PG8_SCHED; PG8_LDA(At, 1, 0); PG8_STAGE(PG8_SA(0, 1), a2, w1);
            PG8_WAIT_V(8); PG8_WAIT_L(0); PG8_BAR; PG8_MMA(0, 0, At, B0); PG8_MMA(0, 1, At, B1); PG8_BAR; PG8_SCHED;
            PG8_LDA(At, 1, 1); PG8_STAGE(PG8_SB(1, 0), b3, voffB); PG8_STAGE(PG8_SB(1, 1), b3 + hstep, voffB); PG8_STAGE(PG8_SA(1, 0), a3, w0);
            PG8_WAIT_V(8); PG8_WAIT_L(0); PG8_BAR; PG8_MMA(1, 0, At, B0); PG8_MMA(1, 1, At, B1); PG8_BAR; PG8_SCHED;
        }
        if constexpr (ALIGN_EPI) { if (wr == 0) PG8_BAR; }
        E(acc, cur, wr, wc, fr, fq);
        if (!has_next) break;
#pragma unroll
        for (int a = 0; a < 2; ++a)
#pragma unroll
            for (int b = 0; b < 2; ++b)
#pragma unroll
                for (int m = 0; m < 4; ++m)
#pragma unroll
                    for (int n = 0; n < 2; ++n) acc[a][b][m][n] = (f32x4){0.f, 0.f, 0.f, 0.f};
        cur = nxt; cA = nA; cB = nB; ++ui;
#pragma unroll
        for (int i = 0; i < 2; ++i) { vA0[i] = nA0[i]; vA1[i] = nA1[i]; }
        if constexpr (ALIGN_EPI) { if (wr == 1) PG8_BAR; }
    }
    PG8_WAIT_V(0);
    if constexpr (!ALIGN_EPI) { if (wr == 0) PG8_BAR; }
    PG8_BAR;
#undef PG8_SA
#undef PG8_SB
#undef PG8_STAGE
#undef PG8_LDA
#undef PG8_LDB
#undef PG8_MMA
#undef PG8_WAIT_V
#undef PG8_WAIT_L
#undef PG8_BAR
#undef PG8_SCHED
}

struct EpiBf16 {
    static constexpr bool PERM = true;
    bf16* O; int ldc;
    __device__ __forceinline__ void operator()(const f32x4 (&acc)[2][2][4][2], const Unit& u, int wr, int wc, int fr, int fq) const {
        const int row0 = u.pm * BM + wr * 64 + fr; const int col0 = u.pn * BM + wc * 32 + 8 * fq;
#pragma unroll
        for (int ai = 0; ai < 2; ++ai)
#pragma unroll
            for (int m = 0; m < 4; ++m) { bf16* rowp = O + (size_t)(row0 + ai * HALF + m * 16) * ldc + col0;
#pragma unroll
                for (int bj = 0; bj < 2; ++bj) { const f32x4 v0 = acc[ai][bj][m][0], v1 = acc[ai][bj][m][1];
                    u32x4 w; w.x = cvt_pk_bf16(v0[0], v0[1]); w.y = cvt_pk_bf16(v0[2], v0[3]); w.z = cvt_pk_bf16(v1[0], v1[1]); w.w = cvt_pk_bf16(v1[2], v1[3]);
                    *(u32x4*)(rowp + bj * HALF) = w; } }
    }
};
struct EpiResF32 {
    static constexpr bool PERM = false;
    const float* base; float* out; int ldc;
    __device__ __forceinline__ void operator()(const f32x4 (&acc)[2][2][4][2], const Unit& u, int wr, int wc, int fr, int fq) const {
        const int row0 = u.pm * BM + wr * 64 + fr, col0 = u.pn * BM + wc * 32 + 4 * fq;
#pragma unroll
        for (int ai = 0; ai < 2; ++ai)
#pragma unroll
            for (int m = 0; m < 4; ++m) { const size_t off = (size_t)(row0 + ai * HALF + m * 16) * ldc + col0;
#pragma unroll
                for (int bj = 0; bj < 2; ++bj)
#pragma unroll
                    for (int n = 0; n < 2; ++n) { const f32x4 bs = *(const f32x4*)(base + off + bj * HALF + n * 16); *(f32x4*)(out + off + bj * HALF + n * 16) = bs + acc[ai][bj][m][n]; } }
    }
};

struct EpiResXB {
    static constexpr bool PERM = true;
    const float* srcf; const bf16* srcb; bf16* xb;
    __device__ __forceinline__ void operator()(const f32x4 (&acc)[2][2][4][2], const Unit& u, int wr, int wc, int fr, int fq) const {
        const int row0 = u.pm * BM + wr * 64 + fr, col0 = u.pn * BM + wc * 32 + 8 * fq;
#pragma unroll
        for (int ai = 0; ai < 2; ++ai)
#pragma unroll
            for (int m = 0; m < 4; ++m) { const size_t off = (size_t)(row0 + ai * HALF + m * 16) * DM + col0;
#pragma unroll
                for (int bj = 0; bj < 2; ++bj) { f32x4 a0, a1;
                    if (srcf) { a0 = *(const f32x4*)(srcf + off + bj * HALF); a1 = *(const f32x4*)(srcf + off + bj * HALF + 4); }
                    else { const u32x4 v = *(const u32x4*)(srcb + off + bj * HALF); a0 = (f32x4){bflo(v.x), bfhi(v.x), bflo(v.y), bfhi(v.y)}; a1 = (f32x4){bflo(v.z), bfhi(v.z), bflo(v.w), bfhi(v.w)}; }
                    a0 += acc[ai][bj][m][0]; a1 += acc[ai][bj][m][1];
                    *(u32x4*)(xb + off + bj * HALF) = (u32x4){pk2(a0[0], a0[1]), pk2(a0[2], a0[3]), pk2(a1[0], a1[1]), pk2(a1[2], a1[3])}; } }
    }
};

struct MoeOrder {
    const char* Abase; const char* Bbase; size_t bstride; int K, G, c, tile_lo, tile_hi; const LAS int* ptile; const LAS int* cntv; const int* list; bool gather;
    __device__ __forceinline__ bool next(int i, Unit& u) const {
        const int NT = tile_hi - tile_lo; int tile, pn;
        if ((G & 7) == 0 && G >= 32) {
            const int x = c & 7, sl = c >> 3, per = G >> 3, TPX = (NT + 7) >> 3;
            const int lu = i * per + sl, lt = lu >> 2; pn = lu & 3;
            tile = tile_lo + x * TPX + lt;
            if (lt >= TPX || tile >= tile_hi) return false;
        } else {
            const long Lq = (long)i * G + c; if (Lq >= (long)NT * 4) return false;
            tile = tile_lo + (int)(Lq >> 2); pn = (int)(Lq & 3);
        }
        int e = 0;
#pragma unroll
        for (int st = 32; st >= 1; st >>= 1) { const int k = e + st; if (k < 64 && tile >= __builtin_amdgcn_readfirstlane(ptile[k])) e = k; }
        const int j = tile - __builtin_amdgcn_readfirstlane(ptile[e]);
        u.pm = tile; u.pn = pn; u.aux = e | (j << 6);
        u.A = gather ? Abase : Abase + (size_t)tile * BM * K * 2; u.B = Bbase + (size_t)(e & 31) * bstride + (size_t)pn * BM * K * 2; return true;
    }
    __device__ __forceinline__ unsigned arow(const Unit& u, int r) const {
        if (!gather) return (unsigned)(r * K) * 2u;
        const int e = u.aux & 63, pos = (u.aux >> 6) * 256 + r; const int cn = cntv[e];
        const int tok = pos < cn ? list[(size_t)e * 65536 + pos] : 0;
        return (unsigned)tok * (unsigned)(K * 2);
    }
};
struct EpiSwiGLU {
    static constexpr bool PERM = true;
    bf16* H;
    __device__ __forceinline__ void operator()(const f32x4 (&acc)[2][2][4][2], const Unit& u, int wr, int wc, int fr, int fq) const {
        const int row0 = u.pm * BM + wr * 64 + fr; const int col0 = u.pn * 128 + wc * 32 + 8 * fq;
#pragma unroll
        for (int ai = 0; ai < 2; ++ai)
#pragma unroll
            for (int m = 0; m < 4; ++m) { bf16* rowp = H + (size_t)(row0 + ai * HALF + m * 16) * 512 + col0;
                const f32x4 g0 = acc[ai][0][m][0], g1 = acc[ai][0][m][1], u0 = acc[ai][1][m][0], u1 = acc[ai][1][m][1];
                float h[8];
#pragma unroll
                for (int q = 0; q < 4; ++q) { h[q] = g0[q] * __builtin_amdgcn_rcpf(1.f + __builtin_amdgcn_exp2f(-1.44269504f * g0[q])) * u0[q]; h[4 + q] = g1[q] * __builtin_amdgcn_rcpf(1.f + __builtin_amdgcn_exp2f(-1.44269504f * g1[q])) * u1[q]; }
                u32x4 w; w.x = cvt_pk_bf16(h[0], h[1]); w.y = cvt_pk_bf16(h[2], h[3]); w.z = cvt_pk_bf16(h[4], h[5]); w.w = cvt_pk_bf16(h[6], h[7]);
                *(u32x4*)rowp = w; }
    }
};
template <bool FINAL> struct EpiScatter {
    static constexpr bool PERM = true;
    bf16* xb; float* out; const int* list; const float* wl; const LAS int* cntv;
    __device__ __forceinline__ void operator()(const f32x4 (&acc)[2][2][4][2], const Unit& u, int wr, int wc, int fr, int fq) const {
        const int e = u.aux & 63, j = u.aux >> 6; const int cn = cntv[e];
        const int col0 = u.pn * BM + wc * 32 + 8 * fq;
#pragma unroll
        for (int ai = 0; ai < 2; ++ai)
#pragma unroll
            for (int m = 0; m < 4; ++m) { const int pos = j * 256 + ai * HALF + wr * 64 + m * 16 + fr;
                if (pos < cn) { const int tok = list[(size_t)e * 65536 + pos]; const float wg = wl[(size_t)e * 65536 + pos];
                    const size_t off = (size_t)tok * DM + col0;
#pragma unroll
                    for (int bj = 0; bj < 2; ++bj) { const u32x4 v = *(const u32x4*)(xb + off + bj * HALF);
                        const f32x4 a0 = (f32x4){bflo(v.x), bfhi(v.x), bflo(v.y), bfhi(v.y)} + wg * acc[ai][bj][m][0], a1 = (f32x4){bflo(v.z), bfhi(v.z), bflo(v.w), bfhi(v.w)} + wg * acc[ai][bj][m][1];
                        if (FINAL) { *(f32x4*)(out + off + bj * HALF) = a0; *(f32x4*)(out + off + bj * HALF + 4) = a1; }
                        else *(u32x4*)(xb + off + bj * HALF) = (u32x4){pk2(a0[0], a0[1]), pk2(a0[2], a0[3]), pk2(a1[0], a1[1]), pk2(a1[2], a1[3])}; } } }
    }
};
}

struct Frame {
    LAS unsigned char* lds;
    volatile LAS unsigned* MISC;
    gu32* ctl;
    int tid, lane, wave, G, bid;
    float* out; unsigned char* ws;
};
struct Args { const float* in[31]; float* out; unsigned char* ws; int ph_lo, ph_hi, rep, pad; };
#ifndef REP_PART
#define REP_PART 0
#endif
#ifndef REP_PHASE
#define REP_PHASE -1
#endif
#define NREP(k) ((REP_PHASE == (k)) ? args.rep : 1)
__device__ __forceinline__ float wave_sum(float v) {
#pragma unroll
    for (int o = 1; o < 64; o <<= 1) v += __shfl_xor(v, o);
    return v;
}

template <class Map>
__device__ __forceinline__ void transpose_item(const float* W, int K, int pitch, int col0, int ncols, bf16* WT, LAS float* scr, int item, int lane, Map dmap) {
    const int nblk = (ncols + 31) / 32, kb = item / nblk, nb = item % nblk, k0 = 64 * kb, n0 = 32 * nb;
    const int nn = n0 + (lane & 31);
#pragma unroll 8
    for (int i = 0; i < 32; ++i) { const int kk = 2 * i + (lane >> 5); scr[kk * 33 + (lane & 31)] = (nn < ncols) ? W[(size_t)(k0 + kk) * pitch + col0 + nn] : 0.f; }
    LDS_WAIT(); asm volatile("" ::: "memory");
    const int c = lane & 7;
#pragma unroll
    for (int j = 0; j < 4; ++j) { const int n = (lane >> 3) + 8 * j; const LAS float* s = scr + (8 * c) * 33 + n;
        u32x4 o; o.x = pk2(s[0 * 33], s[1 * 33]); o.y = pk2(s[2 * 33], s[3 * 33]); o.z = pk2(s[4 * 33], s[5 * 33]); o.w = pk2(s[6 * 33], s[7 * 33]);
        if (n0 + n < ncols) *(u32x4*)(WT + (size_t)dmap(n0 + n) * K + k0 + 8 * c) = o; }
    LDS_WAIT(); asm volatile("" ::: "memory");
}
struct MapId { int off; __device__ int operator()(int n) const { return n + off; } };
struct MapEven { __device__ int operator()(int c) const {
    if (c < 1536) return c; if (c < 1544) return EDT + (c - 1536); if (c < 2056) return EQ + (c - 1544); if (c < 2120) return EK + (c - 2056);
    if (c < 2184) return EV + (c - 2120); if (c < 2440) return EIQ + (c - 2184); if (c < 2504) return EIK + (c - 2440); return EIW + (c - 2504); } };
struct MapGU { int half; __device__ int operator()(int n) const { return 256 * (n >> 7) + 128 * half + (n & 127); } };

__device__ __forceinline__ void rms_row_to_bf16(const float* xrow, const float* gain, bf16* orow, int lane) {
    const f32x4* xr = (const f32x4*)xrow + lane; const f32x4* gr = (const f32x4*)gain + lane;
    f32x4 v[4]; float s = 0.f;
#pragma unroll
    for (int j = 0; j < 4; ++j) { v[j] = xr[64 * j]; s += (v[j].x * v[j].x + v[j].y * v[j].y) + (v[j].z * v[j].z + v[j].w * v[j].w); }
    const float rs = 1.f / sqrtf(wave_sum(s) * (1.f / DM) + NORM_EPS);
    unsigned long long* o8 = (unsigned long long*)orow + lane;
#pragma unroll
    for (int j = 0; j < 4; ++j) { const f32x4 g = gr[64 * j]; o8[64 * j] = (unsigned long long)pk2(v[j].x * rs * g.x, v[j].y * rs * g.y) | ((unsigned long long)pk2(v[j].z * rs * g.z, v[j].w * rs * g.w) << 32); }
}

__device__ __forceinline__ void rms_rowb_to_bf16(const bf16* xrow, const float* gain, bf16* orow, int lane) {
    const u32x2* xr = (const u32x2*)xrow + lane; const f32x4* gr = (const f32x4*)gain + lane;
    f32x4 v[4]; float s = 0.f;
#pragma unroll
    for (int j = 0; j < 4; ++j) { const u32x2 q = xr[64 * j]; v[j] = (f32x4){bflo(q.x), bfhi(q.x), bflo(q.y), bfhi(q.y)}; s += (v[j].x * v[j].x + v[j].y * v[j].y) + (v[j].z * v[j].z + v[j].w * v[j].w); }
    const float rs = 1.f / sqrtf(wave_sum(s) * (1.f / DM) + NORM_EPS);
    unsigned long long* o8 = (unsigned long long*)orow + lane;
#pragma unroll
    for (int j = 0; j < 4; ++j) { const f32x4 g = gr[64 * j]; o8[64 * j] = (unsigned long long)pk2(v[j].x * rs * g.x, v[j].y * rs * g.y) | ((unsigned long long)pk2(v[j].z * rs * g.z, v[j].w * rs * g.w) << 32); }
}
__device__ __forceinline__ void p_prologue(Frame& F, const Args& A) {
    LAS float* scr = (LAS float*)(F.lds + F.wave * 16384);
    const int gw = F.bid * NWAVES + F.wave, NGW = F.G * NWAVES;
    bf16* Wie = (bf16*)(F.ws + WS_WIE); bf16* Woe = (bf16*)(F.ws + WS_WOE);
    constexpr int I_IE = 16 * 79, I_OE = 16 * 32;
    for (int it = gw; it < I_IE + I_OE; it += NGW) {
        if (it < I_IE) transpose_item(A.in[4], 1024, 2508, 0, 2508, Wie, scr, it, F.lane, MapEven());
        else transpose_item(A.in[13], 1024, 1024, 0, 1024, Woe, scr, it - I_IE, F.lane, MapId{0});
    }
    {
        bf16* Wgu = (bf16*)(F.ws + WS_WGU); bf16* Wd = (bf16*)(F.ws + WS_WD); bf16* WR = (bf16*)(F.ws + WS_WR);
        for (int it = gw; it < 64 * 768; it += NGW) { const int le = it / 768, r = it % 768;
            if (r < 256) transpose_item(A.in[28] + (size_t)le * 1024 * 512, 1024, 512, 0, 512, Wgu + (size_t)le * 1024 * 1024, scr, r, F.lane, MapGU{0});
            else if (r < 512) transpose_item(A.in[29] + (size_t)le * 1024 * 512, 1024, 512, 0, 512, Wgu + (size_t)le * 1024 * 1024, scr, r - 256, F.lane, MapGU{1});
            else transpose_item(A.in[30] + (size_t)le * 512 * 1024, 512, 1024, 0, 1024, Wd + (size_t)le * 1024 * 512, scr, r - 512, F.lane, MapId{0}); }
        for (int it = gw; it < 2 * 5 * 16; it += NGW) { const int l = it / 80, r = it % 80, q = r / 16, kb = r % 16;
            if (q == 0) transpose_item(A.in[26] + (size_t)l * 1024 * 4, 1024, 4, 0, 4, WR + (size_t)l * 48 * 1024, scr, kb, F.lane, MapId{0});
            else transpose_item(A.in[27] + (size_t)(l * 4 + q - 1) * 1024 * 8, 1024, 8, 0, 8, WR + (size_t)l * 48 * 1024, scr, kb, F.lane, MapId{4 + 8 * (q - 1)}); }
        for (int i = gw * 64 + F.lane; i < 2 * 12 * 1024 / 8; i += NGW * 64) { const int l = i / (12 * 128), o = i % (12 * 128); *(u32x4*)(WR + (size_t)l * 48 * 1024 + 36 * 1024 + (size_t)o * 8) = (u32x4){0u, 0u, 0u, 0u}; }
    }
    {
        bf16* Wio = (bf16*)(F.ws + WS_WIO); bf16* Woo = (bf16*)(F.ws + WS_WOO); bf16* WGL = (bf16*)(F.ws + WS_WGL);
        bf16* W1K = (bf16*)(F.ws + WS_W1K); bf16* W1V = (bf16*)(F.ws + WS_W1V); bf16* W2 = (bf16*)(F.ws + WS_W2);
        constexpr int J0 = 16 * 80, J1 = J0 + 16, J2 = J1 + 16 * 32, J3 = J2 + 64 * 4, J4 = J3 + 64 * 4, J5 = J4 + 2 * 4, J6 = J5 + 2 * 4;
        for (int it = gw; it < J6; it += NGW) {
            if (it < J0) transpose_item(A.in[14], 1024, 2584, 0, 2560, Wio, scr, it, F.lane, MapId{0});
            else if (it < J1) transpose_item(A.in[14], 1024, 2584, 2560, 24, WGL, scr, it - J0, F.lane, MapId{0});
            else if (it < J2) transpose_item(A.in[25], 1024, 1024, 0, 1024, Woo, scr, it - J1, F.lane, MapId{0});
            else if (it < J3) transpose_item(A.in[21], 4096, 128, 0, 128, W1K, scr, it - J2, F.lane, MapId{0});
            else if (it < J4) transpose_item(A.in[23], 4096, 128, 0, 128, W1V, scr, it - J3, F.lane, MapId{0});
            else if (it < J5) transpose_item(A.in[22], 128, 128, 0, 128, W2, scr, it - J4, F.lane, MapId{0});
            else transpose_item(A.in[24], 128, 128, 0, 128, W2 + 128 * 128, scr, it - J5, F.lane, MapId{0});
        }
        for (int i = gw * 64 + F.lane; i < 8 * 1024 / 8; i += NGW * 64) *(u32x4*)(WGL + 24 * 1024 + (size_t)i * 8) = (u32x4){0u, 0u, 0u, 0u};
    }
    for (int i = gw * 64 + F.lane; i < 52 * 1024 / 8; i += NGW * 64) *(u32x4*)(Wie + (size_t)2508 * 1024 + (size_t)i * 8) = (u32x4){0u, 0u, 0u, 0u};
    bf16* HB = (bf16*)(F.ws + WS_HB);
    for (int m = gw; m < MTOK; m += NGW) rms_row_to_bf16(A.in[0] + (size_t)m * DM, A.in[2], HB + (size_t)m * DM, F.lane);
}

constexpr int SP = 136;
constexpr int L_CS = 0, L_BS = 34816, L_BT = 69632, L_XT = 104448, L_XS = 113152, L_ST = 121856, L_AC = 139264, L_DT = 139776, L_CW = 140288;
__device__ __forceinline__ bf16x8 lds_frag(LAS unsigned char* base, int row, int col) { return *(const LAS bf16x8*)(base + (row * SP + col) * 2); }

__device__ __forceinline__ void p_ssd(Frame& F, const Args& A) {
    bf16* U = (bf16*)(F.ws + WS_U);
    const int w = F.wave;
    { const int tid = F.tid;
    for (int r0 = F.bid * 64; r0 < MTOK; r0 += F.G * 64) {
        const int row = r0 + (tid >> 3), c8 = (tid & 7) * 8;
        bf16* p = U + (size_t)row * LDE + EK + c8;
        const u32x4 v = *(const u32x4*)p; float f[8] = {bflo(v.x), bfhi(v.x), bflo(v.y), bfhi(v.y), bflo(v.z), bfhi(v.z), bflo(v.w), bfhi(v.w)};
        float s = 0.f;
#pragma unroll
        for (int j = 0; j < 8; ++j) s += f[j] * f[j];
        s += __shfl_xor(s, 1); s += __shfl_xor(s, 2); s += __shfl_xor(s, 4);
        const float rs = 1.f / sqrtf(s * (1.f / 64.f) + NORM_EPS); const float* g = A.in[12] + c8;
        u32x4 o; o.x = pk2(f[0] * rs * g[0], f[1] * rs * g[1]); o.y = pk2(f[2] * rs * g[2], f[3] * rs * g[3]); o.z = pk2(f[4] * rs * g[4], f[5] * rs * g[5]); o.w = pk2(f[6] * rs * g[6], f[7] * rs * g[7]);
        *(u32x4*)p = o;
    } }
    LAS unsigned char* L = F.lds;
    LAS float* acum = (LAS float*)(L + L_AC); LAS float* dtv = (LAS float*)(L + L_DT); LAS float* cw = (LAS float*)(L + L_CW);
    const float* conv_w = A.in[5]; const float* conv_b = A.in[6];
    for (int st = F.bid; st < 256; st += F.G) {
        const int b = st >> 4, h = (st >> 1) & 7, ph = st & 1, g = h >> 2;
        { const int tid = F.tid;
        __syncthreads();
        for (int i = tid; i < 5 * 288; i += NTHR) { const int j = i / 288, lc = i % 288;
            const int ch = lc < 128 ? 512 + g * 128 + lc : (lc < 256 ? 768 + g * 128 + (lc - 128) : h * 64 + ph * 32 + (lc - 256));
            cw[i] = j < 4 ? conv_w[j * 1024 + ch] : conv_b[ch]; }
        for (int i = tid; i < 2 * 32 * SP / 2; i += NTHR) ((LAS unsigned*)(L + L_ST))[i] = 0u; }
        const float a_h = -__expf(A.in[8][h]), dtb = A.in[7][h], dsk = A.in[9][h];
        f32x16 state = {0.f, 0.f, 0.f, 0.f, 0.f, 0.f, 0.f, 0.f, 0.f, 0.f, 0.f, 0.f, 0.f, 0.f, 0.f, 0.f};
        __syncthreads();
        u32x4 rawB[7], rawC[7], rawX[4]; unsigned rawdt = 0u; unsigned rawz[16];
#define SSD_FETCH_BCX(cc) do { const size_t _rb = (size_t)b * SEQ + (size_t)(cc) * 128; const int _cg = tid & 15, _rr = tid >> 4; \
            _Pragma("unroll") for (int j = 0; j < 7; ++j) { const int tl = 4 * _rr - 3 + j; rawB[j] = (u32x4){0u, 0u, 0u, 0u}; rawC[j] = (u32x4){0u, 0u, 0u, 0u}; \
                if ((cc) > 0 || tl >= 0) { const bf16* _p = U + (size_t)((long)_rb + tl) * LDE + g * 128 + 8 * _cg; rawB[j] = *(const u32x4*)(_p + EBB); rawC[j] = *(const u32x4*)(_p + ECC); } } \
            const int _cx = tid & 3, _t = tid >> 2; \
            _Pragma("unroll") for (int j = 0; j < 4; ++j) { const int tl = _t - 3 + j; rawX[j] = (u32x4){0u, 0u, 0u, 0u}; \
                if ((cc) > 0 || tl >= 0) rawX[j] = *(const u32x4*)(U + (size_t)((long)_rb + tl) * LDE + EXS + h * 64 + ph * 32 + 8 * _cx); } \
            if (tid < 128) rawdt = U[(_rb + tid) * LDE + EDT + h]; } while (0)
#define SSD_FETCH_Z(cc) do { if (w < 4) { const size_t _rb = (size_t)b * SEQ + (size_t)(cc) * 128; \
            _Pragma("unroll") for (int i = 0; i < 16; ++i) rawz[i] = U[(_rb + 32 * w + 8 * (i >> 2) + 4 * (lane >> 5) + (i & 3)) * LDE + EZ + h * 64 + ph * 32 + (lane & 31)]; } } while (0)
        { int tid = F.tid, lane = F.lane; asm volatile("" : "+v"(tid), "+v"(lane)); SSD_FETCH_BCX(0); SSD_FETCH_Z(0); }
        for (int c = 0; c < 32; ++c) {
            const size_t rowbase = (size_t)b * SEQ + (size_t)c * 128;
            int tid = F.tid, lane = F.lane; asm volatile("" : "+v"(tid), "+v"(lane));
            if (tid < 128) {
                const float dr = bf2f((unsigned short)rawdt) + dtb;
                const float dt = dr > 20.f ? dr : log1pf(__expf(dr));
                float s = dt * a_h;
#pragma unroll
                for (int o = 1; o < 64; o <<= 1) { const float t = __shfl_up(s, o); if (lane >= o) s += t; }
                dtv[tid] = dt; acum[tid] = s;
            }
            {
                const int cg = tid & 15, rr = tid >> 4;
#pragma unroll
                for (int T = 0; T < 2; ++T) {
                    u32x4 raw[7];
#pragma unroll
                    for (int j = 0; j < 7; ++j) raw[j] = T == 0 ? rawB[j] : rawC[j];
                    LAS unsigned char* dst = L + (T == 0 ? L_BS : L_CS);
                    unsigned opk[4][4];
#pragma unroll
                    for (int e2 = 0; e2 < 4; ++e2) {
                        const int lc = T * 128 + 8 * cg + 2 * e2;
                        const f32x2 w0 = *(const LAS f32x2*)(cw + lc), w1 = *(const LAS f32x2*)(cw + 288 + lc), w2 = *(const LAS f32x2*)(cw + 576 + lc), w3 = *(const LAS f32x2*)(cw + 864 + lc), bb = *(const LAS f32x2*)(cw + 1152 + lc);
                        float lo[7], hi[7];
#pragma unroll
                        for (int j = 0; j < 7; ++j) { lo[j] = bflo(raw[j][e2]); hi[j] = bfhi(raw[j][e2]); }
                        float ol[4], oh[4];
#pragma unroll
                        for (int q = 0; q < 4; ++q) { ol[q] = siluf(bb.x + w0.x * lo[q] + w1.x * lo[q + 1] + w2.x * lo[q + 2] + w3.x * lo[q + 3]);
                                                      oh[q] = siluf(bb.y + w0.y * hi[q] + w1.y * hi[q + 1] + w2.y * hi[q + 2] + w3.y * hi[q + 3]); opk[q][e2] = pk2(ol[q], oh[q]); }
                        if (T == 0) {
                            *(LAS u32x2*)(L + L_BT + ((8 * cg + 2 * e2) * SP + 4 * rr) * 2) = (u32x2){pk2(ol[0], ol[1]), pk2(ol[2], ol[3])};
                            *(LAS u32x2*)(L + L_BT + ((8 * cg + 2 * e2 + 1) * SP + 4 * rr) * 2) = (u32x2){pk2(oh[0], oh[1]), pk2(oh[2], oh[3])};
                        }
                    }
#pragma unroll
                    for (int q = 0; q < 4; ++q) *(LAS u32x4*)(dst + ((4 * rr + q) * SP + 8 * cg) * 2) = (u32x4){opk[q][0], opk[q][1], opk[q][2], opk[q][3]};
                }
            }
            __syncthreads();
            if (tid >= 64 && tid < 128) acum[tid] += acum[63];
            __syncthreads();
            {
                const int cg = tid & 3, t = tid >> 2;
                const int gcol = EXS + h * 64 + ph * 32 + 8 * cg;
                u32x4 raw[4];
#pragma unroll
                for (int j = 0; j < 4; ++j) raw[j] = rawX[j];
                const float sc = dtv[t] * __expf(acum[127] - acum[t]);
#pragma unroll
                for (int e = 0; e < 8; ++e) { const int lc = 256 + 8 * cg + e;
                    float rv[4];
#pragma unroll
                    for (int j = 0; j < 4; ++j) rv[j] = (e & 1) ? bfhi(raw[j][e >> 1]) : bflo(raw[j][e >> 1]);
                    const float xv = siluf(cw[1152 + lc] + cw[lc] * rv[0] + cw[288 + lc] * rv[1] + cw[576 + lc] * rv[2] + cw[864 + lc] * rv[3]);
                    *(LAS bf16*)(L + L_XT + ((8 * cg + e) * SP + t) * 2) = (bf16)f2bfh(xv);
                    *(LAS bf16*)(L + L_XS + ((8 * cg + e) * SP + t) * 2) = (bf16)f2bfh(xv * sc); }
            }
            if (c + 1 < 32) SSD_FETCH_BCX(c + 1);
            const int mt = w >> 1, nh = w & 1, r = lane & 31, hh = lane >> 5;
            f32x16 cb[2];
#pragma unroll
            for (int j = 0; j < 2; ++j) {
                cb[j] = (f32x16){0.f, 0.f, 0.f, 0.f, 0.f, 0.f, 0.f, 0.f, 0.f, 0.f, 0.f, 0.f, 0.f, 0.f, 0.f, 0.f};
                const int s0 = 64 * nh + 32 * j;
                if (s0 <= 32 * mt + 31) {
#pragma unroll
                    for (int ks = 0; ks < 8; ++ks) {
                        const bf16x8 af = lds_frag(L + L_CS, 32 * mt + r, 16 * ks + 8 * hh), bfg = lds_frag(L + L_BS, s0 + r, 16 * ks + 8 * hh);
                        cb[j] = __builtin_amdgcn_mfma_f32_32x32x16_bf16(af, bfg, cb[j], 0, 0, 0);
                    }
                }
            }
            __syncthreads();
#pragma unroll
            for (int j = 0; j < 2; ++j) {
                const int s = 64 * nh + 32 * j + r; const float as = acum[s], ds = dtv[s];
#pragma unroll
                for (int i = 0; i < 16; ++i) { const int t = 32 * mt + 8 * (i >> 2) + 4 * hh + (i & 3);
                    const float v = (s <= t) ? cb[j][i] * __expf(acum[t] - as) * ds : 0.f;
                    *(LAS bf16*)(L + L_BS + (t * SP + s) * 2) = (bf16)f2bfh(v); }
            }
            __syncthreads();
            if (w < 4) {
                f32x16 yd = {0.f, 0.f, 0.f, 0.f, 0.f, 0.f, 0.f, 0.f, 0.f, 0.f, 0.f, 0.f, 0.f, 0.f, 0.f, 0.f}, yo = yd;
                for (int ks = 0; ks < 2 * (w + 1); ++ks) {
                    const bf16x8 af = lds_frag(L + L_BS, 32 * w + r, 16 * ks + 8 * hh), bfg = lds_frag(L + L_XT, r, 16 * ks + 8 * hh);
                    yd = __builtin_amdgcn_mfma_f32_32x32x16_bf16(af, bfg, yd, 0, 0, 0);
                }
                LAS unsigned char* stc = L + L_ST + (c & 1) * (32 * SP * 2);
#pragma unroll
                for (int ks = 0; ks < 8; ++ks) {
                    const bf16x8 af = lds_frag(L + L_CS, 32 * w + r, 16 * ks + 8 * hh), bfg = lds_frag(stc, r, 16 * ks + 8 * hh);
                    yo = __builtin_amdgcn_mfma_f32_32x32x16_bf16(af, bfg, yo, 0, 0, 0);
                }
#pragma unroll
                for (int q = 0; q < 4; ++q) {
                    const int t0 = 32 * w + 8 * q + 4 * hh;
                    const u32x2 xx = *(const LAS u32x2*)(L + L_XT + (r * SP + t0) * 2);
                    const float xv[4] = {bflo(xx.x), bfhi(xx.x), bflo(xx.y), bfhi(xx.y)};
#pragma unroll
                    for (int e = 0; e < 4; ++e) { const int t = t0 + e, i = 4 * q + e;
                        bf16* zp = U + (rowbase + t) * LDE + EZ + h * 64 + ph * 32 + r;
                        const float z = bf2f((unsigned short)rawz[i]);
                        const float y = yd[i] + __expf(acum[t]) * yo[i] + dsk * xv[e];
                        *zp = (bf16)f2bfh(y * siluf(z)); }
                }
                if (c + 1 < 32) SSD_FETCH_Z(c + 1);
            } else {
                const int n0 = 32 * (w - 4); const float dec = __expf(acum[127]);
#pragma unroll
                for (int i = 0; i < 16; ++i) state[i] *= dec;
#pragma unroll
                for (int ks = 0; ks < 8; ++ks) {
                    const bf16x8 af = lds_frag(L + L_XS, r, 16 * ks + 8 * hh), bfg = lds_frag(L + L_BT, n0 + r, 16 * ks + 8 * hh);
                    state = __builtin_amdgcn_mfma_f32_32x32x16_bf16(af, bfg, state, 0, 0, 0);
                }
                LAS unsigned char* stn = L + L_ST + ((c + 1) & 1) * (32 * SP * 2);
#pragma unroll
                for (int i = 0; i < 16; ++i) { const int p = 8 * (i >> 2) + 4 * hh + (i & 3);
                    *(LAS bf16*)(stn + (p * SP + n0 + r) * 2) = (bf16)f2bfh(state[i]); }
            }
            __syncthreads();
        }
    }
}

#undef SSD_FETCH_BCX
#undef SSD_FETCH_Z
typedef short s16x4 __attribute__((ext_vector_type(4)));
__device__ __forceinline__ s16x4 lds_tr16(LAS unsigned char* p) { return __builtin_bit_cast(s16x4, __builtin_amdgcn_ds_read_tr16_b64_v4i16((LAS s16x4*)p)); }
__device__ __forceinline__ int t5_bucket_dev(int d) {
    if (d < 16) return d;
    const int v = 16 + (int)(log((double)d / 16.0) / log(8.0) * 16.0);
    return v < 31 ? v : 31;
}
constexpr int D_SEL = 131072, D_LUT = 135168, VP = 72;
__device__ __forceinline__ int okey(float f) { const int iv = __builtin_bit_cast(int, f); return iv ^ ((iv >> 31) & 0x7fffffff); }

__device__ __forceinline__ void p_dsa(Frame& F, const Args& A) {
    bf16* U = (bf16*)(F.ws + WS_U); bf16* HB = (bf16*)(F.ws + WS_HB);
    const int w = F.wave;
    const float* ng = A.in[10];
    LAS unsigned char* L = F.lds;
    LAS float* LUT = (LAS float*)(L + D_LUT);
    for (int i = F.tid; i < 1024; i += NTHR) LUT[i] = A.in[1][t5_bucket_dev(i >> 3) * 8 + (i & 7)];
    __syncthreads();
    for (int blk = F.bid; blk < MTOK / 8; blk += F.G) {
        int lane = F.lane; asm volatile("" : "+v"(lane));
        const int kr = blk >> 8, cc = blk & 255, b = kr >> 1, tb = (kr & 1) ? 511 - cc : cc, t0 = tb * 8;
        const size_t bat = (size_t)b * SEQ, rowb = bat + t0;
        {
            const size_t row = rowb + w;
            const u32x4 v = *(const u32x4*)(U + row * LDE + EZ + 8 * lane);
            float f[8] = {bflo(v.x), bfhi(v.x), bflo(v.y), bfhi(v.y), bflo(v.z), bfhi(v.z), bflo(v.w), bfhi(v.w)};
            float s = 0.f;
#pragma unroll
            for (int j = 0; j < 8; ++j) s += f[j] * f[j];
#pragma unroll
            for (int o = 1; o < 32; o <<= 1) s += __shfl_xor(s, o);
            const float rs = 1.f / sqrtf(s * (1.f / 256.f) + NORM_EPS); const float* g = ng + 8 * lane;
            u32x4 o; o.x = pk2(f[0] * rs * g[0], f[1] * rs * g[1]); o.y = pk2(f[2] * rs * g[2], f[3] * rs * g[3]); o.z = pk2(f[4] * rs * g[4], f[5] * rs * g[5]); o.w = pk2(f[6] * rs * g[6], f[7] * rs * g[7]);
            *(u32x4*)(HB + row * DM + 8 * lane) = o;
        }
        {
            const int r = lane & 31, hh = lane >> 5;
            bf16x8 qa[4];
#pragma unroll
            for (int ks = 0; ks < 4; ++ks) qa[ks] = *(const bf16x8*)(U + (rowb + (r >> 2)) * LDE + EIQ + (r & 3) * 64 + 16 * ks + 8 * hh);
            float wv[4][4];
#pragma unroll
            for (int q = 0; q < 4; ++q) { const u32x2 ww = *(const u32x2*)(U + (rowb + 2 * q + hh) * LDE + EIW); wv[q][0] = bflo(ww.x); wv[q][1] = bfhi(ww.x); wv[q][2] = bflo(ww.y); wv[q][3] = bfhi(ww.y); }
            const int ntile = (t0 + 8 + 31) >> 5;
            for (int tb = w; tb < ntile; tb += 4 * NWAVES) {
                bf16x8 kf[4][4];
#pragma unroll
                for (int u4 = 0; u4 < 4; ++u4) { const int tl = tb + 8 * u4 < 128 ? tb + 8 * u4 : 127; const int key = 32 * tl + r;
#pragma unroll
                    for (int ks = 0; ks < 4; ++ks) kf[u4][ks] = *(const bf16x8*)(U + (bat + key) * LDE + EIK + 16 * ks + 8 * hh); }
#pragma unroll
                for (int u4 = 0; u4 < 4; ++u4) {
                    const int tile = tb + 8 * u4;
                    f32x16 acc = {0.f, 0.f, 0.f, 0.f, 0.f, 0.f, 0.f, 0.f, 0.f, 0.f, 0.f, 0.f, 0.f, 0.f, 0.f, 0.f};
#pragma unroll
                    for (int ks = 0; ks < 4; ++ks) acc = __builtin_amdgcn_mfma_f32_32x32x16_bf16(qa[ks], kf[u4][ks], acc, 0, 0, 0);
                    if (tile < ntile) {
#pragma unroll
                        for (int q = 0; q < 4; ++q) {
                            const float sc = wv[q][0] * fmaxf(acc[4 * q], 0.f) + wv[q][1] * fmaxf(acc[4 * q + 1], 0.f) + wv[q][2] * fmaxf(acc[4 * q + 2], 0.f) + wv[q][3] * fmaxf(acc[4 * q + 3], 0.f);
                            *(LAS float*)(L + ((2 * q + hh) * 4096 + 32 * tile + r) * 4) = sc + 0.f;
                        }
                    }
                }
            }
        }
        __syncthreads();
        const int t = t0 + w, n = t + 1;
        LAS unsigned short* sel = (LAS unsigned short*)(L + D_SEL) + w * 256;
        const int cnt = n < 256 ? n : 256;
        if (n <= 256) {
#pragma unroll
            for (int i = 0; i < 4; ++i) { const int s = lane + 64 * i; sel[s] = (unsigned short)(s < n ? s : 0); }
        } else {
            const int nj = (t0 + 8 + 63) >> 6;
            const LAS float* myrow = (const LAS float*)(L + w * 16384);
            int v[64]; int vmax = (int)0x80000000, vmin = 0x7fffffff;
#pragma unroll
            for (int jb = 0; jb < 4; ++jb) {
                if (16 * jb < nj) {
#pragma unroll
                    for (int jj = 0; jj < 16; ++jj) { const int j = 16 * jb + jj; const int idx = lane + 64 * j; const int kv = okey(myrow[idx]);
                        const bool ok = idx <= t; v[j] = ok ? kv : (int)0x80000000; vmax = v[j] > vmax ? v[j] : vmax; const int x = ok ? kv : 0x7fffffff; vmin = x < vmin ? x : vmin; }
                } else {
#pragma unroll
                    for (int jj = 0; jj < 16; ++jj) v[16 * jb + jj] = (int)0x80000000;
                }
            }
#pragma unroll
            for (int o = 1; o < 64; o <<= 1) { const int x = __shfl_xor(vmax, o); vmax = x > vmax ? x : vmax; const int y = __shfl_xor(vmin, o); vmin = y < vmin ? y : vmin; }
            vmax = __builtin_amdgcn_readfirstlane(vmax); vmin = __builtin_amdgcn_readfirstlane(vmin);
            int lo = vmin, hi = vmax, clo = n, chi = 0, it = 0;
            for (int rps = 0; rps < (REP_PART == 4 ? A.rep : 1); ++rps) { lo = vmin; hi = vmax; clo = n; chi = 0; it = 0;
            while (lo < hi) {
                int mid;
                const int ph3 = it % 3;
                if (ph3 == 2) mid = lo + (int)(((long long)hi - (long long)lo + 1) >> 1);
                else {
                    const float lof = __builtin_bit_cast(float, lo >= 0 ? lo : lo ^ 0x7fffffff), hif = __builtin_bit_cast(float, hi >= 0 ? hi : hi ^ 0x7fffffff);
                    const float fr = ph3 == 0 ? ((float)(clo - 256) + 0.5f) / (float)(clo - chi) : 0.5f;
                    mid = okey(lof + (hif - lof) * fr);
                    mid = mid > hi ? hi : mid; mid = mid <= lo ? lo + 1 : mid;
                }
                int c = 0;
#pragma unroll
                for (int jb = 0; jb < 4; ++jb) if (16 * jb < nj) {
#pragma unroll
                    for (int jj = 0; jj < 16; ++jj) c += __popcll(__ballot(v[16 * jb + jj] >= mid)); }
                ++it;
                if (c == 256) { lo = mid; break; }
                if (c > 256) { lo = mid; clo = c; } else { hi = mid - 1; chi = c; }
            } }
            const int T = lo;
            int cgt = 0;
#pragma unroll
            for (int jb = 0; jb < 4; ++jb) if (16 * jb < nj) {
#pragma unroll
                for (int jj = 0; jj < 16; ++jj) cgt += __popcll(__ballot(v[16 * jb + jj] > T)); }
            const int need_eq = 256 - cgt;
            int obase = 0, ebase = 0;
            for (int rpf = 0; rpf < (REP_PART == 5 ? A.rep : 1); ++rpf) { obase = 0; ebase = 0;
#pragma unroll
            for (int jb = 0; jb < 4; ++jb) if (16 * jb < nj) {
#pragma unroll
                for (int jj = 0; jj < 16; ++jj) { const int j = 16 * jb + jj;
                    const bool gt = v[j] > T, eq = v[j] == T;
                    const unsigned long long be = __ballot(eq);
                    const int erank = ebase + (int)__builtin_amdgcn_mbcnt_hi((unsigned)(be >> 32), __builtin_amdgcn_mbcnt_lo((unsigned)be, 0u));
                    const bool take = gt || (eq && erank < need_eq);
                    const unsigned long long bt = __ballot(take);
                    const int pos = obase + (int)__builtin_amdgcn_mbcnt_hi((unsigned)(bt >> 32), __builtin_amdgcn_mbcnt_lo((unsigned)bt, 0u));
                    if (take && pos < 256) sel[pos] = (unsigned short)(lane + 64 * j);
                    obase += __popcll(bt); ebase += __popcll(be); } } }
        }
        __syncthreads();
        {
            const int hd = lane & 15, g4 = lane >> 4;
            const size_t row = rowb + w;
            bf16x8 qb[2];
            {
                float qf[2][8]; float ss = 0.f;
#pragma unroll
                for (int ks = 0; ks < 2; ++ks) { u32x4 qq = (u32x4){0u, 0u, 0u, 0u};
                    if (hd < 8) qq = *(const u32x4*)(U + row * LDE + EQ + hd * 64 + 32 * ks + 8 * g4);
                    qf[ks][0] = bflo(qq.x); qf[ks][1] = bfhi(qq.x); qf[ks][2] = bflo(qq.y); qf[ks][3] = bfhi(qq.y); qf[ks][4] = bflo(qq.z); qf[ks][5] = bfhi(qq.z); qf[ks][6] = bflo(qq.w); qf[ks][7] = bfhi(qq.w);
#pragma unroll
                    for (int j = 0; j < 8; ++j) ss += qf[ks][j] * qf[ks][j]; }
                ss += __shfl_xor(ss, 16); ss += __shfl_xor(ss, 32);
                const float rs = 0.125f / sqrtf(ss * (1.f / 64.f) + NORM_EPS);
#pragma unroll
                for (int ks = 0; ks < 2; ++ks) { const float* gq = A.in[11] + 32 * ks + 8 * g4;
                    u32x4 pk; pk.x = pk2(qf[ks][0] * rs * gq[0], qf[ks][1] * rs * gq[1]); pk.y = pk2(qf[ks][2] * rs * gq[2], qf[ks][3] * rs * gq[3]);
                    pk.z = pk2(qf[ks][4] * rs * gq[4], qf[ks][5] * rs * gq[5]); pk.w = pk2(qf[ks][6] * rs * gq[6], qf[ks][7] * rs * gq[7]);
                    qb[ks] = __builtin_bit_cast(bf16x8, pk); }
            }
            float lg[16][4]; float mx = -3.0e38f;
            const int vsl = lane >> 3, vpart = lane & 7;
            u32x4 vr[2][8];
#pragma unroll
            for (int hb = 0; hb < 2; ++hb) {
                bf16x8 ka[8][2];
#pragma unroll
                for (int T8 = 0; T8 < 8; ++T8) { const int sm = sel[16 * (8 * hb + T8) + hd]; const bf16* kp = U + (bat + sm) * LDE + EK + 8 * g4;
                    ka[T8][0] = *(const bf16x8*)kp; ka[T8][1] = *(const bf16x8*)(kp + 32); }
#pragma unroll
                for (int e = 0; e < 8; ++e) { const int sm = sel[64 * hb + 8 * e + vsl]; vr[hb][e] = *(const u32x4*)(U + (bat + sm) * LDE + EV + 8 * vpart); }
#pragma unroll
                for (int T8 = 0; T8 < 8; ++T8) { const int T = 8 * hb + T8;
                    f32x4 acc = {0.f, 0.f, 0.f, 0.f};
                    acc = __builtin_amdgcn_mfma_f32_16x16x32_bf16(ka[T8][0], qb[0], acc, 0, 0, 0);
                    acc = __builtin_amdgcn_mfma_f32_16x16x32_bf16(ka[T8][1], qb[1], acc, 0, 0, 0);
                    const u32x2 sl = *(const LAS u32x2*)(sel + 16 * T + 4 * g4);
                    const int s4[4] = {(int)(sl.x & 0xffffu), (int)(sl.x >> 16), (int)(sl.y & 0xffffu), (int)(sl.y >> 16)};
#pragma unroll
                    for (int i = 0; i < 4; ++i) { int dist = t - s4[i]; dist = dist < 0 ? 0 : (dist > 127 ? 127 : dist);
                        const float bia = LUT[dist * 8 + (hd & 7)];
                        const bool valid = (16 * T + 4 * g4 + i) < cnt;
                        lg[T][i] = valid ? acc[i] + bia : -3.0e38f; mx = fmaxf(mx, lg[T][i]); }
                }
            }
            mx = fmaxf(mx, __shfl_xor(mx, 16)); mx = fmaxf(mx, __shfl_xor(mx, 32));
            float sum = 0.f;
#pragma unroll
            for (int T = 0; T < 16; ++T) {
#pragma unroll
                for (int i = 0; i < 4; ++i) { const float p = lg[T][i] > -1.0e38f ? __expf(lg[T][i] - mx) : 0.f; lg[T][i] = p; sum += p; }
                if ((T & 3) == 3) __builtin_amdgcn_sched_barrier(0); }
            sum += __shfl_xor(sum, 16); sum += __shfl_xor(sum, 32);
            const float inv = 1.f / fmaxf(sum, 1e-30f);
            f32x4 oacc[4];
#pragma unroll
            for (int dt = 0; dt < 4; ++dt) oacc[dt] = (f32x4){0.f, 0.f, 0.f, 0.f};
            LAS unsigned char* Vl = L + w * 16384;
#pragma unroll
            for (int ch = 0; ch < 4; ++ch) {
                LDS_WAIT();
#pragma unroll
                for (int e = 0; e < 8; ++e) *(LAS u32x4*)(Vl + ((8 * e + vsl) * VP + 8 * vpart) * 2) = vr[ch & 1][e];
                if (ch + 2 < 4) {
#pragma unroll
                    for (int e = 0; e < 8; ++e) { const int sm = sel[64 * (ch + 2) + 8 * e + vsl]; vr[ch & 1][e] = *(const u32x4*)(U + (bat + sm) * LDE + EV + 8 * vpart); }
                }
                LDS_WAIT();
#pragma unroll
                for (int kk = 0; kk < 2; ++kk) {
                    const int T0 = 2 * (2 * ch + kk);
                    u32x4 pp; pp.x = pk2(lg[T0][0] * inv, lg[T0][1] * inv); pp.y = pk2(lg[T0][2] * inv, lg[T0][3] * inv); pp.z = pk2(lg[T0 + 1][0] * inv, lg[T0 + 1][1] * inv); pp.w = pk2(lg[T0 + 1][2] * inv, lg[T0 + 1][3] * inv);
                    const bf16x8 pf = __builtin_bit_cast(bf16x8, pp);
                    const int qq = (lane & 15) >> 2, p4 = lane & 3;
#pragma unroll
                    for (int dt = 0; dt < 4; ++dt) {
                        const s16x4 b0 = lds_tr16(Vl + ((32 * kk + 4 * g4 + qq) * VP + 16 * dt + 4 * p4) * 2);
                        const s16x4 b1 = lds_tr16(Vl + ((32 * kk + 16 + 4 * g4 + qq) * VP + 16 * dt + 4 * p4) * 2);
                        bf16x8 bfg; bfg[0] = b0[0]; bfg[1] = b0[1]; bfg[2] = b0[2]; bfg[3] = b0[3]; bfg[4] = b1[0]; bfg[5] = b1[1]; bfg[6] = b1[2]; bfg[7] = b1[3];
                        oacc[dt] = __builtin_amdgcn_mfma_f32_16x16x32_bf16(pf, bfg, oacc[dt], 0, 0, 0);
                    }
                }
            }
            if (g4 < 2) {
#pragma unroll
                for (int i = 0; i < 4; ++i)
#pragma unroll
                    for (int dt = 0; dt < 4; ++dt) HB[row * DM + 512 + (4 * g4 + i) * 64 + 16 * dt + hd] = (bf16)f2bfh(oacc[dt][i]);
            }
        }
        __syncthreads();
    }
}

template <int MODE> __device__ __forceinline__ void p_norm_route(Frame& F, const bf16* xin, const float* gain, int layer) {
    constexpr int NT = MODE == 0 ? 3 : 2;
    bf16* HB = (bf16*)(F.ws + WS_HB); const bf16* WR = MODE == 0 ? (const bf16*)(F.ws + WS_WR) + (size_t)layer * 48 * 1024 : (const bf16*)(F.ws + WS_WGL);
    float* GL = (float*)(F.ws + WS_GL);
    int* list = (int*)(F.ws + WS_LIST); float* wl = (float*)(F.ws + WS_LISTW);
    LAS unsigned char* L = F.lds;
    LAS float* lgt = (LAS float*)L + F.wave * (16 * 48);
    LAS int* cntl = (LAS int*)(L + 32768); LAS int* basel = (LAS int*)(L + 33024);
    LAS int* ri_e = (LAS int*)(L + 34816); LAS int* ri_p = (LAS int*)(L + 36864); LAS float* ri_w = (LAS float*)(L + 38912);
    const int w = F.wave;
    for (int base = F.bid * 256; base < MTOK; base += F.G * 256) {
        int lane = F.lane; asm volatile("" : "+v"(lane));
        if (F.tid < 64) cntl[F.tid] = 0;
        __syncthreads();
#pragma unroll 1
        for (int half = 0; half < 2; ++half) {
            const int R0 = base + w * 32 + half * 16;
#pragma unroll 1
            for (int i = 0; i < 16; ++i) rms_rowb_to_bf16(xin + (size_t)(R0 + i) * DM, gain, HB + (size_t)(R0 + i) * DM, lane);
            VM_WAIT();
            const int n16 = lane & 15, g4 = lane >> 4;
            f32x4 acc[NT];
#pragma unroll
            for (int nt = 0; nt < NT; ++nt) acc[nt] = (f32x4){0.f, 0.f, 0.f, 0.f};
#pragma unroll 4
            for (int kk = 0; kk < 32; ++kk) {
                const bf16x8 a = *(const bf16x8*)(HB + (size_t)(R0 + n16) * DM + 32 * kk + 8 * g4);
#pragma unroll
                for (int nt = 0; nt < NT; ++nt) { const bf16x8 bb = *(const bf16x8*)(WR + (size_t)(16 * nt + n16) * DM + 32 * kk + 8 * g4);
                    acc[nt] = __builtin_amdgcn_mfma_f32_16x16x32_bf16(a, bb, acc[nt], 0, 0, 0); }
            }
            if constexpr (MODE == 1) {
#pragma unroll
                for (int nt = 0; nt < NT; ++nt)
#pragma unroll
                    for (int i = 0; i < 4; ++i) if (16 * nt + n16 < 24) GL[(size_t)(R0 + 4 * g4 + i) * 24 + 16 * nt + n16] = acc[nt][i];
            } else {
#pragma unroll
            for (int nt = 0; nt < NT; ++nt)
#pragma unroll
                for (int i = 0; i < 4; ++i) lgt[(4 * g4 + i) * 48 + 16 * nt + n16] = acc[nt][i];
            LDS_WAIT();
            if (lane < 16) {
                const LAS float* lr = lgt + lane * 48;
                int gs = 0; float gm = lr[0];
#pragma unroll
                for (int j = 1; j < 4; ++j) if (lr[j] > gm) { gm = lr[j]; gs = j; }
                float gsum = 0.f;
#pragma unroll
                for (int j = 0; j < 4; ++j) gsum += __expf(lr[j] - gm);
                const float gw = 1.f / gsum;
                const LAS float* er = lr + 4 + 8 * gs;
                int i0 = 0; float m0 = er[0];
#pragma unroll
                for (int j = 1; j < 8; ++j) if (er[j] > m0) { m0 = er[j]; i0 = j; }
                int i1 = -1; float m1 = -3.0e38f;
#pragma unroll
                for (int j = 0; j < 8; ++j) if (j != i0 && er[j] > m1) { m1 = er[j]; i1 = j; }
                const float w0 = 1.f / (1.f + __expf(m1 - m0));
                const int e0 = gs * 8 + i0, e1 = 32 + gs * 8 + i1;
                const int rs = (w * 32 + half * 16 + lane) * 2;
                ri_e[rs] = e0; ri_p[rs] = __hip_atomic_fetch_add(cntl + e0, 1, __ATOMIC_RELAXED, __HIP_MEMORY_SCOPE_WORKGROUP); ri_w[rs] = w0 * gw;
                ri_e[rs + 1] = e1; ri_p[rs + 1] = __hip_atomic_fetch_add(cntl + e1, 1, __ATOMIC_RELAXED, __HIP_MEMORY_SCOPE_WORKGROUP); ri_w[rs + 1] = (1.f - w0) * gw;
            }
            LDS_WAIT();
            }
        }
        if constexpr (MODE == 1) continue;
        __syncthreads();
        if (F.tid < 64) { const int c = cntl[F.tid]; basel[F.tid] = c ? (int)__hip_atomic_fetch_add((unsigned*)(F.ctl + CW_CNT + layer * 4096 + 64 * F.tid), (unsigned)c, RLX_AGENT) : 0; }
        __syncthreads();
        { const int rs = F.tid, e = ri_e[rs], pos = basel[e] + ri_p[rs];
          list[(size_t)e * 65536 + pos] = base + (rs >> 1); wl[(size_t)e * 65536 + pos] = ri_w[rs]; }
        __syncthreads();
    }
}
__device__ __forceinline__ void moe_tables(Frame& F, int layer) {
    LAS int* ptile = (LAS int*)(F.lds + MOE_OFF); LAS int* cntv = ptile + 128;
    __syncthreads();
    if (F.tid < 64) {
        const int c = (int)__hip_atomic_load((unsigned*)(F.ctl + CW_CNT + layer * 4096 + 64 * F.tid), RLX_AGENT);
        cntv[F.tid] = c;
        int nt = (c + 255) >> 8, incl = nt;
#pragma unroll
        for (int o = 1; o < 64; o <<= 1) { const int t = __shfl_up(incl, o); if (F.lane >= o) incl += t; }
        ptile[F.tid] = incl - nt; if (F.tid == 63) ptile[64] = incl;
    }
    __syncthreads();
}
__device__ __forceinline__ void p_moe_gu(Frame& F, int layer) {
    moe_tables(F, layer);
    const LAS int* ptile = (const LAS int*)(F.lds + MOE_OFF); const LAS int* cntv = ptile + 128;
    pg8::MoeOrder S{(const char*)(F.ws + WS_HB), (const char*)(F.ws + WS_WGU) + (size_t)layer * 32 * 1024 * 1024 * 2, (size_t)1024 * 1024 * 2, 1024, F.G, F.bid, 0, ptile[64], ptile, cntv, (const int*)(F.ws + WS_LIST), true};
    pg8::EpiSwiGLU E{(bf16*)(F.ws + WS_U)};
    pg8::gemm_phase<pg8::EpiSwiGLU, pg8::MoeOrder, true>(F.lds, 1024, S, E);
}
template <bool FINAL> __device__ __forceinline__ void p_moe_down(Frame& F, int layer, int slot) {
    moe_tables(F, layer);
    const LAS int* ptile = (const LAS int*)(F.lds + MOE_OFF); const LAS int* cntv = ptile + 128;
    pg8::MoeOrder S{(const char*)(F.ws + WS_U), (const char*)(F.ws + WS_WD) + (size_t)layer * 32 * 1024 * 512 * 2, (size_t)1024 * 512 * 2, 512, F.G, F.bid, ptile[32 * slot], ptile[32 * slot + 32], ptile, cntv, (const int*)(F.ws + WS_LIST), false};
    pg8::EpiScatter<FINAL> E{(bf16*)(F.ws + WS_XB), F.out, (const int*)(F.ws + WS_LIST), (const float*)(F.ws + WS_LISTW), cntv};
    pg8::gemm_phase<pg8::EpiScatter<FINAL>, pg8::MoeOrder, true>(F.lds, 512, S, E);
}

__device__ __forceinline__ void p_compress(Frame& F, const Args& A) {
    bf16* U = (bf16*)(F.ws + WS_U);
    LAS unsigned char* L = F.lds;
    const int w = F.wave;
    {
        const int tid = F.tid, sub = tid & 15;
        for (int v0 = F.bid * 32; v0 < MTOK * 4; v0 += F.G * 32) {
            const int vec = v0 + (tid >> 4), row = vec >> 2, wh = vec & 3;
            bf16* p = U + (size_t)row * LDO + ((wh >> 1) ? OKW : OKS) + (wh & 1) * 128 + 8 * sub;
            const float* g = ((wh >> 1) ? A.in[18] : A.in[17]) + 8 * sub;
            const u32x4 v = *(const u32x4*)p; float f[8] = {bflo(v.x), bfhi(v.x), bflo(v.y), bfhi(v.y), bflo(v.z), bfhi(v.z), bflo(v.w), bfhi(v.w)};
            float s = 0.f;
#pragma unroll
            for (int j = 0; j < 8; ++j) s += f[j] * f[j];
            s += __shfl_xor(s, 1); s += __shfl_xor(s, 2); s += __shfl_xor(s, 4); s += __shfl_xor(s, 8);
            const float rs = 1.f / sqrtf(s * (1.f / 128.f) + NORM_EPS);
            u32x4 o; o.x = pk2(f[0] * rs * g[0], f[1] * rs * g[1]); o.y = pk2(f[2] * rs * g[2], f[3] * rs * g[3]); o.z = pk2(f[4] * rs * g[4], f[5] * rs * g[5]); o.w = pk2(f[6] * rs * g[6], f[7] * rs * g[7]);
            *(u32x4*)p = o;
        }
    }
    constexpr int C_A = 0, C_B = 17408, C_H = 52224, C_S = 69632;
    for (int unit = F.bid; unit < 256; unit += F.G) {
        int tid = F.tid, lane = F.lane; asm volatile("" : "+v"(tid), "+v"(lane));
        const int T = unit >> 7, b = (unit >> 3) & 15, g = (unit >> 2) & 1, cb = unit & 3;
        const int col = (T ? OVC : OKC) + g * 128;
        const float* pos = T ? A.in[20] : A.in[19];
        const bf16* w1t = (const bf16*)(F.ws + (T ? WS_W1V : WS_W1K)); const bf16* w2t = (const bf16*)(F.ws + WS_W2) + T * 128 * 128;
        const int wm = w >> 2, wn = w & 3, r = lane & 31, hh = lane >> 5;
        f32x16 acc = {0.f, 0.f, 0.f, 0.f, 0.f, 0.f, 0.f, 0.f, 0.f, 0.f, 0.f, 0.f, 0.f, 0.f, 0.f, 0.f};
#pragma unroll 1
        for (int l = 0; l < 32; ++l) {
            __syncthreads();
#pragma unroll
            for (int e = 0; e < 2; ++e) { const int q = tid + 512 * e, c = q >> 4, part = q & 15; const int tok = 16 * (64 * cb + c) + l;
                u32x4 v = (u32x4){0u, 0u, 0u, 0u};
                if (tok < SEQ) v = *(const u32x4*)(U + ((size_t)b * SEQ + tok) * LDO + col + 8 * part);
                const f32x4 p0 = *(const f32x4*)(pos + l * 128 + 8 * part), p1 = *(const f32x4*)(pos + l * 128 + 8 * part + 4);
                u32x4 o; o.x = pk2(bflo(v.x) + p0.x, bfhi(v.x) + p0.y); o.y = pk2(bflo(v.y) + p0.z, bfhi(v.y) + p0.w); o.z = pk2(bflo(v.z) + p1.x, bfhi(v.z) + p1.y); o.w = pk2(bflo(v.w) + p1.z, bfhi(v.w) + p1.w);
                *(LAS u32x4*)(L + C_A + (c * SP + 8 * part) * 2) = o; }
#pragma unroll
            for (int e = 0; e < 4; ++e) { const int q = tid + 512 * e, j = q >> 4, part = q & 15;
                *(LAS u32x4*)(L + C_B + (j * SP + 8 * part) * 2) = *(const u32x4*)(w1t + (size_t)j * 4096 + l * 128 + 8 * part); }
            __syncthreads();
#pragma unroll
            for (int ks = 0; ks < 8; ++ks) {
                const bf16x8 af = lds_frag(L + C_A, 32 * wm + r, 16 * ks + 8 * hh), bfg = lds_frag(L + C_B, 32 * wn + r, 16 * ks + 8 * hh);
                acc = __builtin_amdgcn_mfma_f32_32x32x16_bf16(af, bfg, acc, 0, 0, 0);
            }
        }
#pragma unroll
        for (int i = 0; i < 16; ++i) { const int c = 32 * wm + 8 * (i >> 2) + 4 * hh + (i & 3);
            *(LAS bf16*)(L + C_H + (c * SP + 32 * wn + r) * 2) = (bf16)f2bfh(siluf(acc[i])); }
        __syncthreads();
        f32x16 a2 = {0.f, 0.f, 0.f, 0.f, 0.f, 0.f, 0.f, 0.f, 0.f, 0.f, 0.f, 0.f, 0.f, 0.f, 0.f, 0.f};
#pragma unroll
        for (int ks = 0; ks < 8; ++ks) {
            const bf16x8 af = lds_frag(L + C_H, 32 * wm + r, 16 * ks + 8 * hh), bfg = *(const bf16x8*)(w2t + (size_t)(32 * wn + r) * 128 + 16 * ks + 8 * hh);
            a2 = __builtin_amdgcn_mfma_f32_32x32x16_bf16(af, bfg, a2, 0, 0, 0);
        }
        float rsv[16];
        if (T == 0) {
            LAS float* st = (LAS float*)(L + C_S);
#pragma unroll
            for (int i = 0; i < 16; ++i) { float q = a2[i] * a2[i];
                q += __shfl_xor(q, 1); q += __shfl_xor(q, 2); q += __shfl_xor(q, 4); q += __shfl_xor(q, 8); q += __shfl_xor(q, 16);
                if (r == 0) st[(32 * wm + 8 * (i >> 2) + 4 * hh + (i & 3)) * 4 + wn] = q; }
            __syncthreads();
#pragma unroll
            for (int i = 0; i < 16; ++i) { const f32x4 q = *(const LAS f32x4*)(st + (32 * wm + 8 * (i >> 2) + 4 * hh + (i & 3)) * 4);
                rsv[i] = A.in[16][32 * wn + r] / sqrtf((q.x + q.y + q.z + q.w) * (1.f / 128.f) + NORM_EPS); }
        } else {
#pragma unroll
            for (int i = 0; i < 16; ++i) rsv[i] = 1.f;
        }
        bf16* dst = (bf16*)(F.ws + (T ? WS_VCMP : WS_KCMP));
#pragma unroll
        for (int i = 0; i < 16; ++i) { const int c = 64 * cb + 32 * wm + 8 * (i >> 2) + 4 * hh + (i & 3);
            dst[(((size_t)b * 256 + c) * 2 + g) * 128 + 32 * wn + r] = (bf16)f2bfh(a2[i] * rsv[i]); }
    }
}

constexpr int N_STG = 32768;
constexpr int N_K = 0, N_V = 16384, N_LUT = 3 * N_STG, N_IMP = N_LUT + 4096, N_FAC = N_IMP + 16384, N_MSK = N_FAC + 1024, N_UNI = N_MSK + 512, N_CST = N_UNI + 64;
constexpr float LOG2E = 1.44269504f;
enum { BR_CMP = 0, BR_SEL = 1, BR_WIN = 2 };
struct NsaCtx {
    LAS unsigned char* L; const bf16* U; const bf16* KC; const bf16* VC;
    int tid, lane, w, r, hh, b, g, qblk, t0, t, head; size_t bat;
    float mrow, cfar; unsigned mlo, mhi;
};
__device__ __forceinline__ void glds16(const void* gsrc, unsigned lds_dst) { unsigned keep;
    asm volatile("s_mov_b32 %0, m0\n\ts_mov_b32 m0, %2\n\ts_nop 0\n\tglobal_load_lds_dwordx4 %1, off\n\ts_mov_b32 m0, %0" : "=&s"(keep) : "v"(gsrc), "s"(lds_dst) : "memory"); }
#define NSA_BAR() do { asm volatile("" ::: "memory"); __builtin_amdgcn_s_barrier(); asm volatile("" ::: "memory"); } while (0)
template <int BR, bool SUM, bool PV, bool IMP, bool UNITFAC = false>
__device__ __forceinline__ void nsa_pass(const NsaCtx& X, const bf16x8 (&qf)[8], f32x16 (&oacc)[4], float& lsum, const float colfac, const int tlo, const int thi, const unsigned long long tmask) {
    LAS unsigned char* L = X.L; const int r = X.r, hh = X.hh, lane = X.lane;
    const LAS float* LUT = (const LAS float*)(L + N_LUT);
    auto dma = [&](int tl, int st) {
#pragma unroll
        for (int e = 0; e < 2; ++e) { const int pidx = e * 8 + X.w, row = pidx * 4 + (lane >> 4), ch = (lane & 15) ^ (((lane >> 4) << 2) | (X.w & 3));
            const bf16* kp; const bf16* vp;
            if (BR == BR_CMP) { const size_t o = (((size_t)X.b * 256 + 64 * tl + row) * 2 + X.g) * 128 + 8 * ch; kp = X.KC + o; vp = X.VC + o; }
            else { const size_t o = (X.bat + 64 * tl + row) * LDO + X.g * 128 + 8 * ch; kp = X.U + o + (BR == BR_SEL ? OKS : OKW); vp = X.U + o + (BR == BR_SEL ? OVS : OVW); }
            const unsigned ld = (unsigned)__builtin_amdgcn_readfirstlane((int)(unsigned)(__SIZE_TYPE__)(L + st * N_STG + N_K + pidx * 1024));
            glds16(kp, ld); if (PV) glds16(vp, ld + N_V); }
    };
    auto nextt = [&](int tl) { ++tl; while (tl <= thi && !((tmask >> tl) & 1ull)) ++tl; return tl; };
    int tile = nextt(tlo - 1);
    if (tile > thi) return;
    asm volatile("s_waitcnt vmcnt(0)" ::: "memory");
    int nxt = nextt(tile);
    int nn = nxt <= thi ? nextt(nxt) : nxt;
    dma(tile, 0); if (nxt <= thi) dma(nxt, 1);
    int cur = 0;
    const bool gB = X.w >= 4;
    const int kswz = ((r & 3) << 2) | ((r >> 2) & 3);
#define NSA_WAIT_KEEP(has_newer) do { if (has_newer) { if (PV) asm volatile("s_waitcnt vmcnt(4)" ::: "memory"); else asm volatile("s_waitcnt vmcnt(2)" ::: "memory"); } else asm volatile("s_waitcnt vmcnt(0)" ::: "memory"); } while (0)
    if (gB) { NSA_WAIT_KEEP(nxt <= thi); NSA_BAR(); }
    while (tile <= thi) {
        const int st2 = cur >= 1 ? cur - 1 : 2;
        if (!gB) NSA_WAIT_KEEP(nxt <= thi);
        NSA_BAR();
        if (gB && nn <= thi) dma(nn, st2);
        LAS unsigned char* Ls = L + cur * N_STG;
        const int maxpos = BR == BR_CMP ? 16 * (64 * tile + 63) + 31 : 64 * tile + 63, minpos = BR == BR_CMP ? 16 * (64 * tile) + 31 : 64 * tile;
        const bool far = (X.t0 - maxpos >= 113) && (BR != BR_WIN || (X.t0 + 63 - minpos < 512));
        bool selb = true; if (BR == BR_SEL) selb = (tile < 32 ? (X.mlo >> tile) : (X.mhi >> (tile - 32))) & 1u;
        bf16x8 pa[2][2];
        {
            bf16x8 kf[2][8];
#pragma unroll
            for (int mt = 0; mt < 2; ++mt)
#pragma unroll
                for (int ks = 0; ks < 8; ++ks) kf[mt][ks] = *(const LAS bf16x8*)(Ls + N_K + (32 * mt + r) * 256 + 16 * ((2 * ks + hh) ^ kswz));
            asm volatile("" ::: "memory");
            f32x16 sacc[2];
#pragma unroll
            for (int mt = 0; mt < 2; ++mt) sacc[mt] = (f32x16){0.f, 0.f, 0.f, 0.f, 0.f, 0.f, 0.f, 0.f, 0.f, 0.f, 0.f, 0.f, 0.f, 0.f, 0.f, 0.f};
#pragma unroll
            for (int ks = 0; ks < 8; ++ks)
#pragma unroll
                for (int mt = 0; mt < 2; ++mt) sacc[mt] = __builtin_amdgcn_mfma_f32_32x32x16_bf16(kf[mt][ks], qf[ks], sacc[mt], 0, 0, 0);
            const float cf = (BR == BR_SEL && !selb) ? -1.0e30f : X.cfar;
#pragma unroll
            for (int mt = 0; mt < 2; ++mt) {
                if (far) {
#pragma unroll
                    for (int i = 0; i < 16; ++i) { const float p = __builtin_amdgcn_exp2f(sacc[mt][i] + cf);
                        if (SUM) lsum += p; sacc[mt][i] = UNITFAC ? p : p * colfac; }
                } else {
#pragma unroll
                    for (int i = 0; i < 16; ++i) { const int kidx = 32 * mt + 8 * (i >> 2) + 4 * hh + (i & 3);
                        int dist; bool ok;
                        if (BR == BR_CMP) { dist = X.t - (16 * (64 * tile + kidx) + 31); ok = dist >= 0; }
                        else { dist = X.t - (64 * tile + kidx); ok = BR == BR_SEL ? (selb && dist >= 0) : (dist >= 0 && dist < 512); }
                        const int dc = dist < 0 ? 0 : (dist > 127 ? 127 : dist);
                        const float bia = LUT[dc * 8 + X.head];
                        const float ev = __builtin_amdgcn_exp2f(sacc[mt][i] + bia - X.mrow);
                        const float p = ok ? ev : 0.f;
                        if (SUM) lsum += p;
                        sacc[mt][i] = UNITFAC ? p : p * colfac; }
                }
                if (IMP) {
                    LAS float* imp = (LAS float*)(L + N_IMP) + (X.w * 8 + (r >> 2)) * 64;
#pragma unroll
                    for (int q = 0; q < 4; ++q) { float s4 = (sacc[mt][4 * q] + sacc[mt][4 * q + 1]) + (sacc[mt][4 * q + 2] + sacc[mt][4 * q + 3]), s3 = sacc[mt][4 * q + 3];
                        s4 += __shfl_xor(s4, 1); s4 += __shfl_xor(s4, 2); s3 += __shfl_xor(s3, 1); s3 += __shfl_xor(s3, 2);
                        const int n = 16 * tile + 8 * mt + 2 * q + hh;
                        if ((r & 3) == 0) { __hip_atomic_fetch_add(imp + n, s4, __ATOMIC_RELAXED, __HIP_MEMORY_SCOPE_WORKGROUP); if (n < 63) __hip_atomic_fetch_add(imp + n + 1, s3, __ATOMIC_RELAXED, __HIP_MEMORY_SCOPE_WORKGROUP); } }
                }
                if (PV) {
#pragma unroll
                    for (int sI = 0; sI < 2; ++sI) { u32x4 pp; pp.x = pk2(sacc[mt][8 * sI], sacc[mt][8 * sI + 1]); pp.y = pk2(sacc[mt][8 * sI + 2], sacc[mt][8 * sI + 3]); pp.z = pk2(sacc[mt][8 * sI + 4], sacc[mt][8 * sI + 5]); pp.w = pk2(sacc[mt][8 * sI + 6], sacc[mt][8 * sI + 7]);
                        pa[mt][sI] = __builtin_bit_cast(bf16x8, pp); }
                }
            }
        }
        if (gB && nxt <= thi) NSA_WAIT_KEEP(nn <= thi);
        NSA_BAR();
        if (!gB && nn <= thi) dma(nn, st2);
        if (PV) {
            const int q4 = (lane & 15) >> 2, k2 = 2 * ((lane >> 4) & 1) + ((lane & 3) >> 1), sub8 = 8 * (lane & 1);
            s16x4 vb[2][8];
#define NSA_LDV(g, dst) do { const int _row0 = 16 * (g) + 4 * hh + q4; _Pragma("unroll") for (int nt = 0; nt < 4; ++nt) { \
                dst[2 * nt] = lds_tr16(Ls + N_V + _row0 * 256 + 64 * (nt ^ q4) + 16 * (k2 ^ hh) + sub8); \
                dst[2 * nt + 1] = lds_tr16(Ls + N_V + (_row0 + 8) * 256 + 64 * (nt ^ q4) + 16 * (k2 ^ (hh + 2)) + sub8); } } while (0)
            NSA_LDV(0, vb[0]);
#pragma unroll
            for (int g = 0; g < 4; ++g) {
                if (g == 0) NSA_LDV(1, vb[1]); else if (g == 1) NSA_LDV(2, vb[0]); else if (g == 2) NSA_LDV(3, vb[1]);
                asm volatile("" ::: "memory");
#pragma unroll
                for (int nt = 0; nt < 4; ++nt) { const s16x4 b0 = vb[g & 1][2 * nt], b1 = vb[g & 1][2 * nt + 1];
                    bf16x8 bfg; bfg[0] = b0[0]; bfg[1] = b0[1]; bfg[2] = b0[2]; bfg[3] = b0[3]; bfg[4] = b1[0]; bfg[5] = b1[1]; bfg[6] = b1[2]; bfg[7] = b1[3];
                    oacc[nt] = __builtin_amdgcn_mfma_f32_32x32x16_bf16(pa[g >> 1][g & 1], bfg, oacc[nt], 0, 0, 0); }
            }
#undef NSA_LDV
        }
        tile = nxt; nxt = nn; nn = nn <= thi ? nextt(nn) : nn;
        cur = cur == 2 ? 0 : cur + 1;
    }
#undef NSA_WAIT_KEEP
    if (!gB) NSA_BAR();
    __syncthreads();
}

__device__ __forceinline__ void p_nsa(Frame& F, const Args& A) {
    const bf16* U = (const bf16*)(F.ws + WS_U); bf16* HB = (bf16*)(F.ws + WS_HB); const float* GL = (const float*)(F.ws + WS_GL);
    LAS unsigned char* L = F.lds;
    LAS float* LUT = (LAS float*)(L + N_LUT); LAS float* cst = (LAS float*)(L + N_CST);
    for (int i = F.tid; i < 1024; i += NTHR) LUT[i] = A.in[1][t5_bucket_dev(i >> 3) * 8 + (i & 7)] * LOG2E;
    if (F.wave == 0) {
        float gm = 0.f, bm = 0.f;
        for (int i = F.lane; i < 128; i += 64) gm = fmaxf(gm, fmaxf(fabsf(A.in[16][i]), fmaxf(fabsf(A.in[17][i]), fabsf(A.in[18][i]))));
        for (int i = F.lane; i < 256; i += 64) bm = fmaxf(bm, fabsf(A.in[1][i]));
#pragma unroll
        for (int o = 1; o < 64; o <<= 1) { gm = fmaxf(gm, __shfl_xor(gm, o)); bm = fmaxf(bm, __shfl_xor(bm, o)); }
        if (F.lane == 0) { cst[0] = gm * 11.3137085f; cst[1] = bm * LOG2E; }
    }
    __syncthreads();
    const float kmax = cst[0], bmax = cst[1];
    for (int ui = F.bid; ui < 2048; ui += F.G) {
        NsaCtx X; X.L = L; X.U = U; X.KC = (const bf16*)(F.ws + WS_KCMP); X.VC = (const bf16*)(F.ws + WS_VCMP);
        int tid = F.tid, lane = F.lane; asm volatile("" : "+v"(tid), "+v"(lane));
        X.tid = tid; X.lane = lane; X.w = F.wave; X.r = lane & 31; X.hh = lane >> 5;
        const int kr = ui >> 8, cc = ui & 255, bg = kr * 4 + (cc >> 6);
        X.b = bg >> 1; X.g = bg & 1; X.qblk = (kr & 1) ? 63 - (cc & 63) : (cc & 63); X.t0 = 64 * X.qblk; X.bat = (size_t)X.b * SEQ;
        const int tq = X.r >> 2, hd = X.r & 3; X.t = X.t0 + 8 * X.w + tq; X.head = 4 * X.g + hd;
        const size_t row = X.bat + X.t;
        if (tid == 0) *(LAS unsigned long long*)(L + N_UNI) = 0ull;
        for (int i = tid; i < 4096; i += NTHR) ((LAS float*)(L + N_IMP))[i] = 0.f;
        bf16x8 qf[8]; float qn2 = 0.f;
        {
            u32x4 qr[8]; float ss = 0.f;
#pragma unroll
            for (int ks = 0; ks < 8; ++ks) { qr[ks] = *(const u32x4*)(U + row * LDO + OQ + X.head * 128 + 16 * ks + 8 * X.hh);
#pragma unroll
                for (int e = 0; e < 4; ++e) { const float a = bflo(qr[ks][e]), c = bfhi(qr[ks][e]); ss += a * a + c * c; } }
            ss += __shfl_xor(ss, 32);
            const float rs = 1.f / sqrtf(ss * (1.f / 128.f) + NORM_EPS);
#pragma unroll
            for (int ks = 0; ks < 8; ++ks) { const float* gq = A.in[15] + 16 * ks + 8 * X.hh; u32x4 pk;
#pragma unroll
                for (int e = 0; e < 4; ++e) { const float a = bflo(qr[ks][e]) * rs * gq[2 * e], c = bfhi(qr[ks][e]) * rs * gq[2 * e + 1]; qn2 += a * a + c * c; pk[e] = pk2(a * (0.0883883476f * LOG2E), c * (0.0883883476f * LOG2E)); }
                qf[ks] = __builtin_bit_cast(bf16x8, pk); }
            qn2 += __shfl_xor(qn2, 32);
        }
        X.mrow = sqrtf(qn2) * (0.0883883476f * LOG2E) * kmax + bmax;
        X.cfar = LUT[127 * 8 + X.head] - X.mrow;
        X.mlo = 0u; X.mhi = 0u;
        const float g_c = 1.f / (1.f + __expf(-GL[row * 24 + X.head])), g_s = 1.f / (1.f + __expf(-GL[row * 24 + 8 + X.head])), g_w = 1.f / (1.f + __expf(-GL[row * 24 + 16 + X.head]));
        f32x16 oacc[4];
#pragma unroll
        for (int nt = 0; nt < 4; ++nt) oacc[nt] = (f32x16){0.f, 0.f, 0.f, 0.f, 0.f, 0.f, 0.f, 0.f, 0.f, 0.f, 0.f, 0.f, 0.f, 0.f, 0.f, 0.f};
        const int ntc = ((4 * X.qblk + 2) >> 6) + 1;
        float l_c = 0.f;
        nsa_pass<BR_CMP, true, false, false, true>(X, qf, oacc, l_c, 1.f, 0, ntc - 1, ~0ull);
        l_c += __shfl_xor(l_c, 32);
        const float il_c = l_c > 0.f ? 1.f / l_c : 0.f;
        { float dummy = 0.f; nsa_pass<BR_CMP, false, false, true>(X, qf, oacc, dummy, il_c, 0, ntc - 1, ~0ull); }
        {
            LDS_WAIT();
            const LAS float* impw = (const LAS float*)(L + N_IMP) + X.w * 8 * 64;
            const int n = lane, cur = X.qblk;
            unsigned long long wor = 0ull;
#pragma unroll 1
            for (int q = 0; q < 8; ++q) {
                const float imp = impw[q * 64 + n];
                const bool forced = (n == 0) || (n == cur) || (n == cur - 1);
                float val = forced ? 3.0e38f : imp; if (n > cur) val = -3.0e38f;
                int rank = 0;
#pragma unroll 8
                for (int m = 0; m < 64; ++m) { const float vm = __shfl(val, m); rank += (vm > val || (vm == val && m < n)) ? 1 : 0; }
                const unsigned long long mk = __ballot(n <= cur && rank < 16);
                wor |= mk;
                if ((X.r >> 2) == q) { X.mlo = (unsigned)mk; X.mhi = (unsigned)(mk >> 32); }
            }
            if (lane == 0) __hip_atomic_fetch_or((LAS unsigned long long*)(L + N_UNI), wor, __ATOMIC_RELAXED, __HIP_MEMORY_SCOPE_WORKGROUP);
        }
        __syncthreads();
        const unsigned long long uni = *(const LAS unsigned long long*)(L + N_UNI);
        float l_s = 0.f;
        nsa_pass<BR_SEL, true, true, false, true>(X, qf, oacc, l_s, 1.f, 0, X.qblk, uni);
        if (REP_PART == 7) for (int rp = 1; rp < A.rep; ++rp) { float dummy = 0.f; nsa_pass<BR_SEL, false, true, false, false>(X, qf, oacc, dummy, 0.f, 0, X.qblk, uni); }
        l_s += __shfl_xor(l_s, 32);
        {
            LAS float* fac = (LAS float*)(L + N_FAC) + X.w * 32;
            if (lane < 32) fac[lane] = l_s > 0.f ? g_s / l_s : 0.f;
            LDS_WAIT();
#pragma unroll
            for (int q = 0; q < 4; ++q) { const f32x4 fr = *(const LAS f32x4*)(fac + 8 * q + 4 * X.hh);
#pragma unroll
                for (int nt = 0; nt < 4; ++nt) { oacc[nt][4 * q] *= fr.x; oacc[nt][4 * q + 1] *= fr.y; oacc[nt][4 * q + 2] *= fr.z; oacc[nt][4 * q + 3] *= fr.w; } }
        }
        { float dummy = 0.f; nsa_pass<BR_CMP, false, true, false>(X, qf, oacc, dummy, g_c * il_c, 0, ntc - 1, ~0ull); }
        const int wlo = X.qblk >= 8 ? X.qblk - 8 : 0;
        float l_w = 0.f;
        nsa_pass<BR_WIN, true, false, false, true>(X, qf, oacc, l_w, 1.f, wlo, X.qblk, ~0ull);
        l_w += __shfl_xor(l_w, 32);
        { float dummy = 0.f; nsa_pass<BR_WIN, false, true, false>(X, qf, oacc, dummy, l_w > 0.f ? g_w / l_w : 0.f, wlo, X.qblk, ~0ull); }
#pragma unroll
        for (int i = 0; i < 16; ++i) { const int c32 = 8 * (i >> 2) + 4 * X.hh + (i & 3);
            bf16* op = HB + (X.bat + X.t0 + 8 * X.w + (c32 >> 2)) * DM + (4 * X.g + (c32 & 3)) * 128 + X.r;
#pragma unroll
            for (int nt = 0; nt < 4; ++nt) op[32 * nt] = (bf16)f2bfh(oacc[nt][i]); }
    }
}

constexpr int N_PHASES = 18;
__global__ void __launch_bounds__(NTHR, 2) mk_fwd(Args args) {
    extern __shared__ __attribute__((aligned(16))) unsigned char lds[];
    Frame F;
    F.lds = (LAS unsigned char*)lds;
    F.MISC = (volatile LAS unsigned*)(F.lds + MISC_OFF);
    F.tid = threadIdx.x; F.lane = F.tid & 63; F.wave = __builtin_amdgcn_readfirstlane(F.tid >> 6);
    F.G = gridDim.x; F.bid = blockIdx.x;
    F.ws = args.ws; F.out = args.out; F.ctl = (gu32*)(args.ws + WS_CTL);
    if (F.tid < 64) F.MISC[F.tid] = 0u;
    __syncthreads();
    const int lo = args.ph_lo, hi = args.ph_hi;
    XcdBarrier bar; bar.bar = (unsigned*)(F.ctl + CW_BAR); bar.x = 0; bar.st = nullptr;
    if (hi - lo > 1) bar = xcd_barrier_post((unsigned*)(F.ctl + CW_BAR), F.MISC + 8);
#ifndef PHMASK
#define PHMASK 0xffffffffu
#endif
#define IN(k) (((PHMASK >> (k)) & 1u) && lo <= (k) && (k) < hi)
#ifndef REPMASK
#define REPMASK 0u
#endif
#define RUNS(k) (1 + (int)((REPMASK >> (k)) & 1u))
#define SEAM(k) do { if (IN(k) && IN((k) + 1)) xcd_barrier(bar); } while (0)
    if (IN(0)) { for (int rp = 0; rp < RUNS(0); ++rp) p_prologue(F, args); } SEAM(0);
    if (IN(1)) for (int rp = 0; rp < RUNS(1); ++rp) {
        pg8::StaticOrder S; S.init(F.ws + WS_HB, F.ws + WS_WIE, MTOK, LDE, DM, F.G, F.bid);
        pg8::EpiBf16 E{(bf16*)(F.ws + WS_U), LDE};
        pg8::gemm_phase<pg8::EpiBf16, pg8::StaticOrder, true>(F.lds, DM, S, E);
    } SEAM(1);
    if (IN(2)) { p_ssd(F, args); } SEAM(2);
    if (IN(3)) { for (int rp = 0; rp < RUNS(3); ++rp) p_dsa(F, args); } SEAM(3);
    if (IN(4)) {
        pg8::StaticOrder S; S.init(F.ws + WS_HB, F.ws + WS_WOE, MTOK, DM, DM, F.G, F.bid);
        pg8::EpiResXB E{args.in[0], nullptr, (bf16*)(F.ws + WS_XB)};
        pg8::gemm_phase<pg8::EpiResXB, pg8::StaticOrder, true>(F.lds, DM, S, E);
    } SEAM(4);
    if (IN(5)) { p_norm_route<0>(F, (const bf16*)(F.ws + WS_XB), args.in[3], 0); } SEAM(5);
    if (IN(6)) { p_moe_gu(F, 0);
#if (REPMASK >> 6) & 1
        p_moe_gu(F, 0);
#endif
    } SEAM(6);
    if (IN(7)) { p_moe_down<false>(F, 0, 0); } SEAM(7);
    if (IN(8)) { p_moe_down<false>(F, 0, 1); } SEAM(8);
    if (IN(9)) { for (int rp = 0; rp < RUNS(9); ++rp) p_norm_route<1>(F, (const bf16*)(F.ws + WS_XB), args.in[2] + DM, 0); } SEAM(9);
    if (IN(10)) {
        pg8::StaticOrder S; S.init(F.ws + WS_HB, F.ws + WS_WIO, MTOK, LDO, DM, F.G, F.bid);
        pg8::EpiBf16 E{(bf16*)(F.ws + WS_U), LDO};
        pg8::gemm_phase<pg8::EpiBf16, pg8::StaticOrder, true>(F.lds, DM, S, E);
    } SEAM(10);
    if (IN(11)) { p_compress(F, args); } SEAM(11);
    if (IN(12)) { p_nsa(F, args);
#if (REPMASK >> 12) & 1
        p_nsa(F, args);
#endif
    } SEAM(12);
    if (IN(13)) {
        pg8::StaticOrder S; S.init(F.ws + WS_HB, F.ws + WS_WOO, MTOK, DM, DM, F.G, F.bid);
        pg8::EpiResXB E{nullptr, (const bf16*)(F.ws + WS_XB), (bf16*)(F.ws + WS_XB)};
        pg8::gemm_phase<pg8::EpiResXB, pg8::StaticOrder, true>(F.lds, DM, S, E);
    } SEAM(13);
    if (IN(14)) { p_norm_route<0>(F, (const bf16*)(F.ws + WS_XB), args.in[3] + DM, 1); } SEAM(14);
    if (IN(15)) { p_moe_gu(F, 1); } SEAM(15);
    if (IN(16)) { p_moe_down<false>(F, 1, 0); } SEAM(16);
    if (IN(17)) { p_moe_down<true>(F, 1, 1); }
#undef IN
#undef SEAM
}

extern "C" void kernel_launch(void* const* d_in, const int* in_sizes, int n_in, void* d_out, int out_size, void* d_ws, size_t ws_size, hipStream_t stream) {
    static int grid = 0;
    if (grid == 0) {
        if (n_in != 31 || ws_size < WS_END) { fprintf(stderr, "kernel_launch: unexpected n_in %d / ws %zu\n", n_in, ws_size); grid = -1; return; }
        int dev = 0, cus = 0;
        if (hipGetDevice(&dev) != hipSuccess || hipDeviceGetAttribute(&cus, hipDeviceAttributeMultiprocessorCount, dev) != hipSuccess) { grid = -1; return; }
        if (hipFuncSetAttribute((const void*)mk_fwd, hipFuncAttributeMaxDynamicSharedMemorySize, LDS_BYTES) != hipSuccess) { fprintf(stderr, "kernel_launch: hipFuncSetAttribute failed\n"); grid = -1; return; }
        grid = cus;
    }
    if (grid < 0) return;
    (void)hipMemsetAsync((char*)d_ws + WS_CTL, 0, CTL_ZERO_BYTES, stream);
    Args a{};
    for (int i = 0; i < 31; ++i) a.in[i] = (const float*)d_in[i];
    a.out = (float*)d_out; a.ws = (unsigned char*)d_ws; a.rep = (REP_PART || REP_PHASE >= 0) ? 2 : 1; a.pad = 0; a.rep = 2; a.pad = 0;
#if defined(MK_PER_PHASE)
    for (int p = 0; p < N_PHASES; ++p) { a.ph_lo = p; a.ph_hi = p + 1; hipLaunchKernelGGL(mk_fwd, dim3(grid), dim3(NTHR), LDS_BYTES, stream, a); }
#else
    a.ph_lo = 0; a.ph_hi = N_PHASES; hipLaunchKernelGGL(mk_fwd, dim3(grid), dim3(NTHR), LDS_BYTES, stream, a);
#endif
}
```

```cpp
#include <hip/hip_runtime.h>
#include <cstdio>
#include <cstdint>

#define GAS __attribute__((address_space(1)))
#define LAS __attribute__((address_space(3)))
typedef unsigned short bf16;
typedef short bf16x8 __attribute__((ext_vector_type(8)));
typedef float f32x4 __attribute__((ext_vector_type(4)));
typedef float f32x2 __attribute__((ext_vector_type(2)));
typedef float f32x16 __attribute__((ext_vector_type(16)));
typedef unsigned u32x4 __attribute__((ext_vector_type(4)));
typedef unsigned u32x2 __attribute__((ext_vector_type(2)));
typedef GAS unsigned gu32;
#define RLX_AGENT __ATOMIC_RELAXED, __HIP_MEMORY_SCOPE_AGENT
#define LDS_WAIT() asm volatile("s_waitcnt lgkmcnt(0)" ::: "memory")
#define VM_WAIT() asm volatile("s_waitcnt vmcnt(0)" ::: "memory")

constexpr int NB = 16, SEQ = 4096, DM = 1024, MTOK = NB * SEQ;
constexpr float NORM_EPS = 1e-6f;
constexpr int LDE = 2560;
constexpr int EZ = 0, EXS = 512, EBB = 1024, ECC = 1280, EQ = 1536, EK = 2048, EV = 2112, EIQ = 2176, EIK = 2432, EDT = 2496, EIW = 2504;
constexpr int LDO = 2560;
constexpr int OQ = 0, OKC = 1024, OVC = 1280, OKS = 1536, OVS = 1792, OKW = 2048, OVW = 2304;
constexpr int NWAVES = 8, NTHR = 512;

constexpr size_t MiB = 1u << 20;
constexpr size_t WS_CTL = 0, CTL_ZERO_BYTES = 1 * MiB;
constexpr size_t WS_WIE = 1 * MiB, WS_WOE = 6 * MiB, WS_WIO = 8 * MiB, WS_WOO = 13 * MiB;
constexpr size_t WS_W1K = 15 * MiB, WS_W1V = 16 * MiB, WS_W2 = 17 * MiB, WS_WR = 18 * MiB;
constexpr size_t WS_WGL = WS_WR + 256 * 1024;
constexpr size_t WS_TOK = 19 * MiB;
constexpr size_t WS_GL = 20 * MiB;
constexpr size_t WS_KCMP = 26 * MiB, WS_VCMP = 28 * MiB;
constexpr size_t WS_LIST = 32 * MiB;
constexpr size_t WS_WGU = 48 * MiB;
constexpr size_t WS_WD = 176 * MiB;
constexpr size_t WS_HB = 240 * MiB;
constexpr size_t WS_U = 368 * MiB;
constexpr size_t WS_LISTW = 720 * MiB;
constexpr size_t WS_XB = 736 * MiB;
constexpr size_t WS_END = 864 * MiB;
constexpr int CW_TMO = 0, CW_CODE = 1, CW_BAR = 4096, CW_CNT = 8192;

constexpr int RING_BYTES = 131072;
constexpr int LDS_BYTES = 147456;
constexpr int MISC_OFF = LDS_BYTES - 256;
constexpr int MOE_OFF = LDS_BYTES - 2048;

__device__ __forceinline__ unsigned f2bf(float f) { unsigned u = __builtin_bit_cast(unsigned, f); return (u + 0x7fffu + ((u >> 16) & 1u)) >> 16; }
typedef __bf16 bf16x2_t __attribute__((ext_vector_type(2)));
__device__ __forceinline__ unsigned pk2(float lo, float hi) { const f32x2 v = {lo, hi}; const bf16x2_t b = __builtin_convertvector(v, bf16x2_t); return __builtin_bit_cast(unsigned, b); }
__device__ __forceinline__ unsigned short f2bfh(float f) { return (unsigned short)(pk2(f, f) & 0xffffu); }
__device__ __forceinline__ float bf2f(unsigned short b) { return __builtin_bit_cast(float, ((unsigned)b) << 16); }
__device__ __forceinline__ float bflo(unsigned w) { return __builtin_bit_cast(float, w << 16); }
__device__ __forceinline__ float bfhi(unsigned w) { return __builtin_bit_cast(float, w & 0xffff0000u); }
__device__ __forceinline__ float siluf(float v) { return v * __builtin_amdgcn_rcpf(1.f + __builtin_amdgcn_exp2f(-1.44269504f * v)); }

#define XB_TMO      128
#define XB_XCNT(j)  (256  + 64 * (j))
#define XB_XSUB(j)  (1280 + 64 * (j))
#define XB_XGEN(j)  (2304 + 64 * (j))
#define XB_TOP      3328
#define XB_TOPGEN   3392
#define XCD_BAR_WORDS 3456
#define XB_SPIN_CAP (1u << 20)
__device__ __forceinline__ unsigned xb_ld(unsigned* p)              { return __hip_atomic_load(p, __ATOMIC_RELAXED, __HIP_MEMORY_SCOPE_AGENT); }
__device__ __forceinline__ unsigned xb_add(unsigned* p, unsigned v) { return __hip_atomic_fetch_add(p, v, __ATOMIC_RELAXED, __HIP_MEMORY_SCOPE_AGENT); }
__device__ __forceinline__ unsigned xb_xcc_id() { return (unsigned)__builtin_amdgcn_s_getreg((3 << 11) | 20) & 0xFu; }
#define XB_SPIN(cond, bar) do { unsigned _sp = 0; while (cond) { __builtin_amdgcn_s_sleep(1); \
    if ((++_sp & 255u) == 0u) { if (xb_ld(&(bar)[XB_TMO])) break; if (_sp > XB_SPIN_CAP) { atomicAdd(&(bar)[XB_TMO], 1u); break; } } } } while (0)
struct XcdBarrier { unsigned* bar; unsigned x; volatile LAS unsigned* st; };
__device__ __forceinline__ XcdBarrier xcd_barrier_post(unsigned* bar, volatile LAS unsigned* st) {
    XcdBarrier b; b.bar = bar; b.x = xb_xcc_id(); b.st = st;
    if (threadIdx.x == 0) (void)xb_add(&bar[XB_XCNT(b.x)], 1u);
    return b;
}
__device__ __forceinline__ void xcd_barrier_complete(unsigned* bar, unsigned x, unsigned& nloc, unsigned& nx) {
    const unsigned G = gridDim.x * gridDim.y * gridDim.z;
    unsigned sum, cnt, mine, sp = 0u;
    for (;;) {
        sum = 0u; cnt = 0u; mine = 0u;
#pragma unroll
        for (unsigned j = 0; j < 16; ++j) { const unsigned c = xb_ld(&bar[XB_XCNT(j)]); sum += c; cnt += (c > 0u) ? 1u : 0u; mine = (j == x) ? c : mine; }
        if (sum == G) break;
        __builtin_amdgcn_s_sleep(1);
        if ((++sp & 255u) == 0u) { if (xb_ld(&bar[XB_TMO])) break; if (sp > XB_SPIN_CAP) { atomicAdd(&bar[XB_TMO], 1u); break; } }
    }
    nloc = mine > 0u ? mine : 1u; nx = cnt > 0u ? cnt : 1u;
}
__device__ __forceinline__ void xcd_barrier(const XcdBarrier& b) {
    asm volatile("s_waitcnt vmcnt(0)" ::: "memory");
    __syncthreads();
    if (threadIdx.x == 0) {
        unsigned* bar = b.bar;
        __builtin_amdgcn_s_waitcnt(0);
        unsigned nloc = b.st[0], nx = b.st[1];
        if (nloc == 0u) { xcd_barrier_complete(bar, b.x, nloc, nx); b.st[0] = nloc; b.st[1] = nx; }
        const unsigned old = xb_add(&bar[XB_XSUB(b.x)], 1u);
        const unsigned gen = old / nloc;
        if (old + 1u == (gen + 1u) * nloc) {
            __builtin_amdgcn_fence(__ATOMIC_RELEASE, "agent");
            asm volatile("s_waitcnt vmcnt(0)" ::: "memory");
            const unsigned og = xb_add(&bar[XB_TOP], 1u);
            const unsigned tg = og / nx;
            if (og + 1u == (tg + 1u) * nx) xb_add(&bar[XB_TOPGEN], 1u);
            else XB_SPIN(xb_ld(&bar[XB_TOPGEN]) == tg, bar);
            __builtin_amdgcn_fence(__ATOMIC_ACQUIRE, "agent");
            xb_add(&bar[XB_XGEN(b.x)], 1u);
            asm volatile("s_waitcnt vmcnt(0)" ::: "memory");
        } else {
            XB_SPIN(xb_ld(&bar[XB_XGEN(b.x)]) == gen, bar);
            __builtin_amdgcn_fence(__ATOMIC_ACQUIRE, "agent");
            asm volatile("s_waitcnt vmcnt(0)" ::: "memory");
        }
    }
    __syncthreads();
}

namespace pg8 {
constexpr int BM = 256, BK = 64, HALF = 128, HTB = HALF * BK * 2, STAGE_BYTES = 8 * HTB, NXCD = 8, WGM = 8;
__host__ __device__ __forceinline__ int lds_byte(int r, int c) { const int st = (r >> 4) * 2 + (c >> 5), rr = r & 15, cc = c & 31, ob = rr * 64 + cc * 2; return st * 1024 + (ob ^ (((ob >> 9) & 1) << 5)); }
__host__ __device__ __forceinline__ void stage_rc(int b, int& R, int& C) { const int st = b / 1024, sb = b % 1024, swz = sb ^ (((sb >> 9) & 1) << 5); R = (st >> 1) * 16 + swz / 64; C = (st & 1) * 32 + (swz % 64) / 2; }
__host__ __device__ __forceinline__ int perm32(int rho) { const int n = rho >> 4, i = rho & 15; return 8 * (i >> 2) + 4 * n + (i & 3); }
__device__ __forceinline__ unsigned cvt_pk_bf16(float lo, float hi) { unsigned r; asm volatile("v_cvt_pk_bf16_f32 %0, %1, %2" : "=v"(r) : "v"(lo), "v"(hi)); return r; }

struct Unit { const char* A; const char* B; int pm, pn, aux; };

struct StaticOrder {
    const char* A; const char* Bt; int K, nM, nN, nwg, G, c;
    __device__ void init(const void* A_, const void* Bt_, int M, int N, int K_, int G_, int c_) { A = (const char*)A_; Bt = (const char*)Bt_; K = K_; nM = M / BM; nN = N / BM; nwg = nM * nN; G = G_; c = c_; }
    __device__ __forceinline__ bool next(int i, Unit& u) const {
        const long L = (long)i * G + c; if (L >= nwg) return false;
        int wgid = (int)L; { const int q = nwg / NXCD, r = nwg % NXCD, xcd = wgid % NXCD, off = wgid / NXCD; wgid = (xcd < r ? xcd * (q + 1) : r * (q + 1) + (xcd - r) * q) + off; }
        const int nig = WGM * nN, gid = wgid / nig, fm = gid * WGM, gsz = (nM - fm) < WGM ? (nM - fm) : WGM;
        u.pm = fm + ((wgid % nig) % gsz); u.pn = (wgid % nig) / gsz; u.aux = 0;
        u.A = A + (size_t)u.pm * BM * K * 2; u.B = Bt + (size_t)u.pn * BM * K * 2; return true;
    }
    __device__ __forceinline__ unsigned arow(const Unit&, int r) const { return (unsigned)(r * K) * 2u; }
};

template <class Epi, class Sched, bool ALIGN_EPI>
__device__ __forceinline__ void gemm_phase(LAS unsigned char* lds, const int K, const Sched& S, const Epi& E) {
    const int tid = threadIdx.x, wid = __builtin_amdgcn_readfirstlane(tid >> 6), lane = tid & 63, wr = wid >> 2, wc = wid & 3, fr = lane & 15, fq = lane >> 4;
    const int nt = K / BK;
    int RA[2], CA[2]; unsigned voffB[2];
#pragma unroll
    for (int i = 0; i < 2; ++i) { int R, C; stage_rc(tid * 16 + i * 8192, R, C); const int Rb = Epi::PERM ? ((R & ~31) + perm32(R & 31)) : R;
        RA[i] = R; CA[i] = C; voffB[i] = (unsigned)(Rb * K + C) * 2u; }
    const size_t kstep = (size_t)(BK * 2);
    const size_t hstep = (size_t)HALF * K * 2;
    const unsigned ldsw = (unsigned)wid * 1024u;
    const int aoff = lds_byte(wr * 64 + fr, fq * 8), boff = lds_byte(wc * 32 + fr, fq * 8);
#define PG8_SA(b, h) (((b) * 2 + (h)) * HTB)
#define PG8_SB(b, h) ((4 + (b) * 2 + (h)) * HTB)
#define PG8_STAGE(bufoff, gbase, voff) do { _Pragma("unroll") for (int _i = 0; _i < 2; ++_i) \
        __builtin_amdgcn_global_load_lds((const unsigned*)((const char*)(gbase) + (voff)[_i]), (LAS unsigned*)(lds + (bufoff) + ldsw + _i * 8192), 16, 0, 0); } while (0)
#define PG8_LDA(dst, b, h) do { _Pragma("unroll") for (int m = 0; m < 4; ++m) _Pragma("unroll") for (int k = 0; k < 2; ++k) dst[m][k] = *(const LAS bf16x8*)(lds + PG8_SA(b, h) + aoff + m * 2048 + k * 1024); } while (0)
#define PG8_LDB(dst, b, h) do { _Pragma("unroll") for (int n = 0; n < 2; ++n) _Pragma("unroll") for (int k = 0; k < 2; ++k) dst[n][k] = *(const LAS bf16x8*)(lds + PG8_SB(b, h) + boff + n * 2048 + k * 1024); } while (0)
#define PG8_MMA(ai, bj, At, Bt) do { __builtin_amdgcn_s_setprio(1); _Pragma("unroll") for (int m = 0; m < 4; ++m) _Pragma("unroll") for (int n = 0; n < 2; ++n) _Pragma("unroll") for (int k = 0; k < 2; ++k) \
        acc[ai][bj][m][n] = __builtin_amdgcn_mfma_f32_16x16x32_bf16(Bt[n][k], At[m][k], acc[ai][bj][m][n], 0, 0, 0); __builtin_amdgcn_s_setprio(0); } while (0)
#define PG8_WAIT_V(n) asm volatile("s_waitcnt vmcnt(" #n ")" ::: "memory")
#define PG8_WAIT_L(n) asm volatile("s_waitcnt lgkmcnt(" #n ")" ::: "memory")
#define PG8_BAR __builtin_amdgcn_s_barrier()
#define PG8_SCHED __builtin_amdgcn_sched_barrier(0)
    Unit cur, nxt; int ui = 0;
    if (!S.next(0, cur)) return;
    f32x4 acc[2][2][4][2];
#pragma unroll
    for (int a = 0; a < 2; ++a)
#pragma unroll
        for (int b = 0; b < 2; ++b)
#pragma unroll
            for (int m = 0; m < 4; ++m)
#pragma unroll
                for (int n = 0; n < 2; ++n) acc[a][b][m][n] = (f32x4){0.f, 0.f, 0.f, 0.f};
    bf16x8 At[4][2], B0[2][2], B1[2][2];
    unsigned vA0[2], vA1[2], nA0[2], nA1[2];
#pragma unroll
    for (int i = 0; i < 2; ++i) { vA0[i] = S.arow(cur, RA[i]) + CA[i] * 2u; vA1[i] = S.arow(cur, HALF + RA[i]) + CA[i] * 2u; nA0[i] = vA0[i]; nA1[i] = vA1[i]; }
    const char* cA = cur.A; const char* cB = cur.B;
    PG8_STAGE(PG8_SB(0, 0), cB, voffB); PG8_STAGE(PG8_SB(0, 1), cB + hstep, voffB); PG8_STAGE(PG8_SA(0, 0), cA, vA0); PG8_STAGE(PG8_SA(0, 1), cA, vA1);
    if (wr == 1) PG8_BAR;
    PG8_WAIT_V(2); PG8_BAR;
    PG8_STAGE(PG8_SB(1, 0), cB + kstep, voffB); PG8_STAGE(PG8_SA(1, 0), cA + kstep, vA0); PG8_STAGE(PG8_SB(1, 1), cB + hstep + kstep, voffB);
    PG8_WAIT_V(6); PG8_BAR;
    for (;;) {
        const bool has_next = S.next(ui + 1, nxt);
        const char* nA = has_next ? nxt.A : cA; const char* nB = has_next ? nxt.B : cB;
        if (has_next) {
#pragma unroll
            for (int i = 0; i < 2; ++i) { nA0[i] = S.arow(nxt, RA[i]) + CA[i] * 2u; nA1[i] = S.arow(nxt, HALF + RA[i]) + CA[i] * 2u; }
        }
        for (int t = 0; t < nt; t += 2) {
            const bool last = (t == nt - 2);
            const char* a1 = cA + (size_t)(t + 1) * kstep;
            const char* a2 = last ? nA : cA + (size_t)(t + 2) * kstep; const char* b2 = last ? nB : cB + (size_t)(t + 2) * kstep;
            const char* a3 = a2 + kstep; const char* b3 = b2 + kstep;
            unsigned w0[2], w1[2];
#pragma unroll
            for (int i = 0; i < 2; ++i) { w0[i] = last ? nA0[i] : vA0[i]; w1[i] = last ? nA1[i] : vA1[i]; }
            PG8_LDB(B0, 0, 0); PG8_LDB(B1, 0, 1); PG8_SCHED; PG8_LDA(At, 0, 0); PG8_STAGE(PG8_SA(1, 1), a1, vA1);
            PG8_WAIT_V(8); PG8_WAIT_L(0); PG8_BAR; PG8_MMA(0, 0, At, B0); PG8_MMA(0, 1, At, B1); PG8_BAR; PG8_SCHED;
            PG8_LDA(At, 0, 1); PG8_STAGE(PG8_SB(0, 0), b2, voffB); PG8_STAGE(PG8_SB(0, 1), b2 + hstep, voffB); PG8_STAGE(PG8_SA(0, 0), a2, w0);
            PG8_WAIT_V(8); PG8_WAIT_L(0); PG8_BAR; PG8_MMA(1, 0, At, B0); PG8_MMA(1, 1, At, B1); PG8_BAR; PG8_SCHED;
            PG8_LDB(B0, 1, 0); PG8_LDB(B1, 1, 1); PG8_SCHED; PG8_LDA(At, 1, 0); PG8_STAGE(PG8_SA(0, 1), a2, w1);
            PG8_WAIT_V(8); PG8_WAIT_L(0); PG8_BAR; PG8_MMA(0, 0, At, B0); PG8_MMA(0, 1, At, B1); PG8_BAR; PG8_SCHED;
            PG8_LDA(At, 1, 1); PG8_STAGE(PG8_SB(1, 0), b3, voffB); PG8_STAGE(PG8_SB(1, 1), b3 + hstep, voffB); PG8_STAGE(PG8_SA(1, 0), a3, w0);
            PG8_WAIT_V(8); PG8_WAIT_L(0); PG8_BAR; PG8_MMA(1, 0, At, B0); PG8_MMA(1, 1, At, B1); PG8_BAR; PG8_SCHED;
        }
        if constexpr (ALIGN_EPI) { if (wr == 0) PG8_BAR; }
        E(acc, cur, wr, wc, fr, fq);
        if (!has_next) break;
#pragma unroll
        for (int a = 0; a < 2; ++a)
#pragma unroll
            for (int b = 0; b < 2; ++b)
#pragma unroll
                for (int m = 0; m < 4; ++m)
#pragma unroll
                    for (int n = 0; n < 2; ++n) acc[a][b][m][n] = (f32x4){0.f, 0.f, 0.f, 0.f};
        cur = nxt; cA = nA; cB = nB; ++ui;
#pragma unroll
        for (int i = 0; i < 2; ++i) { vA0[i] = nA0[i]; vA1[i] = nA1[i]; }
        if constexpr (ALIGN_EPI) { if (wr == 1) PG8_BAR; }
    }
    PG8_WAIT_V(0);
    if constexpr (!ALIGN_EPI) { if (wr == 0) PG8_BAR; }
    PG8_BAR;
#undef PG8_SA
#undef PG8_SB
#undef PG8_STAGE
#undef PG8_LDA
#undef PG8_LDB
#undef PG8_MMA
#undef PG8_WAIT_V
#undef PG8_WAIT_L
#undef PG8_BAR
#undef PG8_SCHED
}

struct EpiBf16 {
    static constexpr bool PERM = true;
    bf16* O; int ldc;
    __device__ __forceinline__ void operator()(const f32x4 (&acc)[2][2][4][2], const Unit& u, int wr, int wc, int fr, int fq) const {
        const int row0 = u.pm * BM + wr * 64 + fr; const int col0 = u.pn * BM + wc * 32 + 8 * fq;
#pragma unroll
        for (int ai = 0; ai < 2; ++ai)
#pragma unroll
            for (int m = 0; m < 4; ++m) { bf16* rowp = O + (size_t)(row0 + ai * HALF + m * 16) * ldc + col0;
#pragma unroll
                for (int bj = 0; bj < 2; ++bj) { const f32x4 v0 = acc[ai][bj][m][0], v1 = acc[ai][bj][m][1];
                    u32x4 w; w.x = cvt_pk_bf16(v0[0], v0[1]); w.y = cvt_pk_bf16(v0[2], v0[3]); w.z = cvt_pk_bf16(v1[0], v1[1]); w.w = cvt_pk_bf16(v1[2], v1[3]);
                    *(u32x4*)(rowp + bj * HALF) = w; } }
    }
};
struct EpiResF32 {
    static constexpr bool PERM = false;
    const float* base; float* out; int ldc;
    __device__ __forceinline__ void operator()(const f32x4 (&acc)[2][2][4][2], const Unit& u, int wr, int wc, int fr, int fq) const {
        const int row0 = u.pm * BM + wr * 64 + fr, col0 = u.pn * BM + wc * 32 + 4 * fq;
#pragma unroll
        for (int ai = 0; ai < 2; ++ai)
#pragma unroll
            for (int m = 0; m < 4; ++m) { const size_t off = (size_t)(row0 + ai * HALF + m * 16) * ldc + col0;
#pragma unroll
                for (int bj = 0; bj < 2; ++bj)
#pragma unroll
                    for (int n = 0; n < 2; ++n) { const f32x4 bs = *(const f32x4*)(base + off + bj * HALF + n * 16); *(f32x4*)(out + off + bj * HALF + n * 16) = bs + acc[ai][bj][m][n]; } }
    }
};

struct EpiResXB {
    static constexpr bool PERM = true;
    const float* srcf; const bf16* srcb; bf16* xb;
    __device__ __forceinline__ void operator()(const f32x4 (&acc)[2][2][4][2], const Unit& u, int wr, int wc, int fr, int fq) const {
        const int row0 = u.pm * BM + wr * 64 + fr, col0 = u.pn * BM + wc * 32 + 8 * fq;
#pragma unroll
        for (int ai = 0; ai < 2; ++ai)
#pragma unroll
            for (int m = 0; m < 4; ++m) { const size_t off = (size_t)(row0 + ai * HALF + m * 16) * DM + col0;
#pragma unroll
                for (int bj = 0; bj < 2; ++bj) { f32x4 a0, a1;
                    if (srcf) { a0 = *(const f32x4*)(srcf + off + bj * HALF); a1 = *(const f32x4*)(srcf + off + bj * HALF + 4); }
                    else { const u32x4 v = *(const u32x4*)(srcb + off + bj * HALF); a0 = (f32x4){bflo(v.x), bfhi(v.x), bflo(v.y), bfhi(v.y)}; a1 = (f32x4){bflo(v.z), bfhi(v.z), bflo(v.w), bfhi(v.w)}; }
                    a0 += acc[ai][bj][m][0]; a1 += acc[ai][bj][m][1];
                    *(u32x4*)(xb + off + bj * HALF) = (u32x4){pk2(a0[0], a0[1]), pk2(a0[2], a0[3]), pk2(a1[0], a1[1]), pk2(a1[2], a1[3])}; } }
    }
};

struct MoeOrder {
    const char* Abase; const char* Bbase; size_t bstride; int K, G, c, tile_lo, tile_hi; const LAS int* ptile; const LAS int* cntv; const int* list; bool gather;
    __device__ __forceinline__ bool next(int i, Unit& u) const {
        const int NT = tile_hi - tile_lo; int tile, pn;
        if ((G & 7) == 0 && G >= 32) {
            const int x = c & 7, sl = c >> 3, per = G >> 3, TPX = (NT + 7) >> 3;
            const int lu = i * per + sl, lt = lu >> 2; pn = lu & 3;
            tile = tile_lo + x * TPX + lt;
            if (lt >= TPX || tile >= tile_hi) return false;
        } else {
            const long Lq = (long)i * G + c; if (Lq >= (long)NT * 4) return false;
            tile = tile_lo + (int)(Lq >> 2); pn = (int)(Lq & 3);
        }
        int e = 0;
#pragma unroll
        for (int st = 32; st >= 1; st >>= 1) { const int k = e + st; if (k < 64 && tile >= __builtin_amdgcn_readfirstlane(ptile[k])) e = k; }
        const int j = tile - __builtin_amdgcn_readfirstlane(ptile[e]);
        u.pm = tile; u.pn = pn; u.aux = e | (j << 6);
        u.A = gather ? Abase : Abase + (size_t)tile * BM * K * 2; u.B = Bbase + (size_t)(e & 31) * bstride + (size_t)pn * BM * K * 2; return true;
    }
    __device__ __forceinline__ unsigned arow(const Unit& u, int r) const {
        if (!gather) return (unsigned)(r * K) * 2u;
        const int e = u.aux & 63, pos = (u.aux >> 6) * 256 + r; const int cn = cntv[e];
        const int tok = pos < cn ? list[(size_t)e * 65536 + pos] : 0;
        return (unsigned)tok * (unsigned)(K * 2);
    }
};
struct EpiSwiGLU {
    static constexpr bool PERM = true;
    bf16* H;
    __device__ __forceinline__ void operator()(const f32x4 (&acc)[2][2][4][2], const Unit& u, int wr, int wc, int fr, int fq) const {
        const int row0 = u.pm * BM + wr * 64 + fr; const int col0 = u.pn * 128 + wc * 32 + 8 * fq;
#pragma unroll
        for (int ai = 0; ai < 2; ++ai)
#pragma unroll
            for (int m = 0; m < 4; ++m) { bf16* rowp = H + (size_t)(row0 + ai * HALF + m * 16) * 512 + col0;
                const f32x4 g0 = acc[ai][0][m][0], g1 = acc[ai][0][m][1], u0 = acc[ai][1][m][0], u1 = acc[ai][1][m][1];
                float h[8];
#pragma unroll
                for (int q = 0; q < 4; ++q) { h[q] = g0[q] * __builtin_amdgcn_rcpf(1.f + __builtin_amdgcn_exp2f(-1.44269504f * g0[q])) * u0[q]; h[4 + q] = g1[q] * __builtin_amdgcn_rcpf(1.f + __builtin_amdgcn_exp2f(-1.44269504f * g1[q])) * u1[q]; }
                u32x4 w; w.x = cvt_pk_bf16(h[0], h[1]); w.y = cvt_pk_bf16(h[2], h[3]); w.z = cvt_pk_bf16(h[4], h[5]); w.w = cvt_pk_bf16(h[6], h[7]);
                *(u32x4*)rowp = w; }
    }
};
template <bool FINAL> struct EpiScatter {
    static constexpr bool PERM = true;
    bf16* xb; float* out; const int* list; const float* wl; const LAS int* cntv;
    __device__ __forceinline__ void operator()(const f32x4 (&acc)[2][2][4][2], const Unit& u, int wr, int wc, int fr, int fq) const {
        const int e = u.aux & 63, j = u.aux >> 6; const int cn = cntv[e];
        const int col0 = u.pn * BM + wc * 32 + 8 * fq;
#pragma unroll
        for (int ai = 0; ai < 2; ++ai)
#pragma unroll
            for (int m = 0; m < 4; ++m) { const int pos = j * 256 + ai * HALF + wr * 64 + m * 16 + fr;
                if (pos < cn) { const int tok = list[(size_t)e * 65536 + pos]; const float wg = wl[(size_t)e * 65536 + pos];
                    const size_t off = (size_t)tok * DM + col0;
#pragma unroll
                    for (int bj = 0; bj < 2; ++bj) { const u32x4 v = *(const u32x4*)(xb + off + bj * HALF);
                        const f32x4 a0 = (f32x4){bflo(v.x), bfhi(v.x), bflo(v.y), bfhi(v.y)} + wg * acc[ai][bj][m][0], a1 = (f32x4){bflo(v.z), bfhi(v.z), bflo(v.w), bfhi(v.w)} + wg * acc[ai][bj][m][1];
                        if (FINAL) { *(f32x4*)(out + off + bj * HALF) = a0; *(f32x4*)(out + off + bj * HALF + 4) = a1; }
                        else *(u32x4*)(xb + off + bj * HALF) = (u32x4){pk2(a0[0], a0[1]), pk2(a0[2], a0[3]), pk2(a1[0], a1[1]), pk2(a1[2], a1[3])}; } } }
    }
};
}

struct Frame {
    LAS unsigned char* lds;
    volatile LAS unsigned* MISC;
    gu32* ctl;
    int tid, lane, wave, G, bid;
    float* out; unsigned char* ws;
};
struct Args { const float* in[31]; float* out; unsigned char* ws; int ph_lo, ph_hi, rep, pad; };
#ifndef REP_PART
#define REP_PART 0
#endif
#ifndef REP_PHASE
#define REP_PHASE -1
#endif
#define NREP(k) ((REP_PHASE == (k)) ? args.rep : 1)
__device__ __forceinline__ float wave_sum(float v) {
#pragma unroll
    for (int o = 1; o < 64; o <<= 1) v += __shfl_xor(v, o);
    return v;
}

template <class Map>
__device__ __forceinline__ void transpose_item(const float* W, int K, int pitch, int col0, int ncols, bf16* WT, LAS float* scr, int item, int lane, Map dmap) {
    const int nblk = (ncols + 31) / 32, kb = item / nblk, nb = item % nblk, k0 = 64 * kb, n0 = 32 * nb;
    const int nn = n0 + (lane & 31);
#pragma unroll 8
    for (int i = 0; i < 32; ++i) { const int kk = 2 * i + (lane >> 5); scr[kk * 33 + (lane & 31)] = (nn < ncols) ? W[(size_t)(k0 + kk) * pitch + col0 + nn] : 0.f; }
    LDS_WAIT(); asm volatile("" ::: "memory");
    const int c = lane & 7;
#pragma unroll
    for (int j = 0; j < 4; ++j) { const int n = (lane >> 3) + 8 * j; const LAS float* s = scr + (8 * c) * 33 + n;
        u32x4 o; o.x = pk2(s[0 * 33], s[1 * 33]); o.y = pk2(s[2 * 33], s[3 * 33]); o.z = pk2(s[4 * 33], s[5 * 33]); o.w = pk2(s[6 * 33], s[7 * 33]);
        if (n0 + n < ncols) *(u32x4*)(WT + (size_t)dmap(n0 + n) * K + k0 + 8 * c) = o; }
    LDS_WAIT(); asm volatile("" ::: "memory");
}
struct MapId { int off; __device__ int operator()(int n) const { return n + off; } };
struct MapEven { __device__ int operator()(int c) const {
    if (c < 1536) return c; if (c < 1544) return EDT + (c - 1536); if (c < 2056) return EQ + (c - 1544); if (c < 2120) return EK + (c - 2056);
    if (c < 2184) return EV + (c - 2120); if (c < 2440) return EIQ + (c - 2184); if (c < 2504) return EIK + (c - 2440); return EIW + (c - 2504); } };
struct MapGU { int half; __device__ int operator()(int n) const { return 256 * (n >> 7) + 128 * half + (n & 127); } };

__device__ __forceinline__ void rms_row_to_bf16(const float* xrow, const float* gain, bf16* orow, int lane) {
    const f32x4* xr = (const f32x4*)xrow + lane; const f32x4* gr = (const f32x4*)gain + lane;
    f32x4 v[4]; float s = 0.f;
#pragma unroll
    for (int j = 0; j < 4; ++j) { v[j] = xr[64 * j]; s += (v[j].x * v[j].x + v[j].y * v[j].y) + (v[j].z * v[j].z + v[j].w * v[j].w); }
    const float rs = 1.f / sqrtf(wave_sum(s) * (1.f / DM) + NORM_EPS);
    unsigned long long* o8 = (unsigned long long*)orow + lane;
#pragma unroll
    for (int j = 0; j < 4; ++j) { const f32x4 g = gr[64 * j]; o8[64 * j] = (unsigned long long)pk2(v[j].x * rs * g.x, v[j].y * rs * g.y) | ((unsigned long long)pk2(v[j].z * rs * g.z, v[j].w * rs * g.w) << 32); }
}

__device__ __forceinline__ void rms_rowb_to_bf16(const bf16* xrow, const float* gain, bf16* orow, int lane) {
    const u32x2* xr = (const u32x2*)xrow + lane; const f32x4* gr = (const f32x4*)gain + lane;
    f32x4 v[4]; float s = 0.f;
#pragma unroll
    for (int j = 0; j < 4; ++j) { const u32x2 q = xr[64 * j]; v[j] = (f32x4){bflo(q.x), bfhi(q.x), bflo(q.y), bfhi(q.y)}; s += (v[j].x * v[j].x + v[j].y * v[j].y) + (v[j].z * v[j].z + v[j].w * v[j].w); }
    const float rs = 1.f / sqrtf(wave_sum(s) * (1.f / DM) + NORM_EPS);
    unsigned long long* o8 = (unsigned long long*)orow + lane;
#pragma unroll
    for (int j = 0; j < 4; ++j) { const f32x4 g = gr[64 * j]; o8[64 * j] = (unsigned long long)pk2(v[j].x * rs * g.x, v[j].y * rs * g.y) | ((unsigned long long)pk2(v[j].z * rs * g.z, v[j].w * rs * g.w) << 32); }
}
__device__ __forceinline__ void p_prologue(Frame& F, const Args& A) {
    LAS float* scr = (LAS float*)(F.lds + F.wave * 16384);
    const int gw = F.bid * NWAVES + F.wave, NGW = F.G * NWAVES;
    bf16* Wie = (bf16*)(F.ws + WS_WIE); bf16* Woe = (bf16*)(F.ws + WS_WOE);
    constexpr int I_IE = 16 * 79, I_OE = 16 * 32;
    for (int it = gw; it < I_IE + I_OE; it += NGW) {
        if (it < I_IE) transpose_item(A.in[4], 1024, 2508, 0, 2508, Wie, scr, it, F.lane, MapEven());
        else transpose_item(A.in[13], 1024, 1024, 0, 1024, Woe, scr, it - I_IE, F.lane, MapId{0});
    }
    {
        bf16* Wgu = (bf16*)(F.ws + WS_WGU); bf16* Wd = (bf16*)(F.ws + WS_WD); bf16* WR = (bf16*)(F.ws + WS_WR);
        for (int it = gw; it < 64 * 768; it += NGW) { const int le = it / 768, r = it % 768;
            if (r < 256) transpose_item(A.in[28] + (size_t)le * 1024 * 512, 1024, 512, 0, 512, Wgu + (size_t)le * 1024 * 1024, scr, r, F.lane, MapGU{0});
            else if (r < 512) transpose_item(A.in[29] + (size_t)le * 1024 * 512, 1024, 512, 0, 512, Wgu + (size_t)le * 1024 * 1024, scr, r - 256, F.lane, MapGU{1});
            else transpose_item(A.in[30] + (size_t)le * 512 * 1024, 512, 1024, 0, 1024, Wd + (size_t)le * 1024 * 512, scr, r - 512, F.lane, MapId{0}); }
        for (int it = gw; it < 2 * 5 * 16; it += NGW) { const int l = it / 80, r = it % 80, q = r / 16, kb = r % 16;
            if (q == 0) transpose_item(A.in[26] + (size_t)l * 1024 * 4, 1024, 4, 0, 4, WR + (size_t)l * 48 * 1024, scr, kb, F.lane, MapId{0});
            else transpose_item(A.in[27] + (size_t)(l * 4 + q - 1) * 1024 * 8, 1024, 8, 0, 8, WR + (size_t)l * 48 * 1024, scr, kb, F.lane, MapId{4 + 8 * (q - 1)}); }
        for (int i = gw * 64 + F.lane; i < 2 * 12 * 1024 / 8; i += NGW * 64) { const int l = i / (12 * 128), o = i % (12 * 128); *(u32x4*)(WR + (size_t)l * 48 * 1024 + 36 * 1024 + (size_t)o * 8) = (u32x4){0u, 0u, 0u, 0u}; }
    }
    {
        bf16* Wio = (bf16*)(F.ws + WS_WIO); bf16* Woo = (bf16*)(F.ws + WS_WOO); bf16* WGL = (bf16*)(F.ws + WS_WGL);
        bf16* W1K = (bf16*)(F.ws + WS_W1K); bf16* W1V = (bf16*)(F.ws + WS_W1V); bf16* W2 = (bf16*)(F.ws + WS_W2);
        constexpr int J0 = 16 * 80, J1 = J0 + 16, J2 = J1 + 16 * 32, J3 = J2 + 64 * 4, J4 = J3 + 64 * 4, J5 = J4 + 2 * 4, J6 = J5 + 2 * 4;
        for (int it = gw; it < J6; it += NGW) {
            if (it < J0) transpose_item(A.in[14], 1024, 2584, 0, 2560, Wio, scr, it, F.lane, MapId{0});
            else if (it < J1) transpose_item(A.in[14], 1024, 2584, 2560, 24, WGL, scr, it - J0, F.lane, MapId{0});
            else if (it < J2) transpose_item(A.in[25], 1024, 1024, 0, 1024, Woo, scr, it - J1, F.lane, MapId{0});
            else if (it < J3) transpose_item(A.in[21], 4096, 128, 0, 128, W1K, scr, it - J2, F.lane, MapId{0});
            else if (it < J4) transpose_item(A.in[23], 4096, 128, 0, 128, W1V, scr, it - J3, F.lane, MapId{0});
            else if (it < J5) transpose_item(A.in[22], 128, 128, 0, 128, W2, scr, it - J4, F.lane, MapId{0});
            else transpose_item(A.in[24], 128, 128, 0, 128, W2 + 128 * 128, scr, it - J5, F.lane, MapId{0});
        }
        for (int i = gw * 64 + F.lane; i < 8 * 1024 / 8; i += NGW * 64) *(u32x4*)(WGL + 24 * 1024 + (size_t)i * 8) = (u32x4){0u, 0u, 0u, 0u};
    }
    for (int i = gw * 64 + F.lane; i < 52 * 1024 / 8; i += NGW * 64) *(u32x4*)(Wie + (size_t)2508 * 1024 + (size_t)i * 8) = (u32x4){0u, 0u, 0u, 0u};
    bf16* HB = (bf16*)(F.ws + WS_HB);
    for (int m = gw; m < MTOK; m += NGW) rms_row_to_bf16(A.in[0] + (size_t)m * DM, A.in[2], HB + (size_t)m * DM, F.lane);
}

constexpr int SP = 136;
constexpr int L_CS = 0, L_BS = 34816, L_BT = 69632, L_XT = 104448, L_XS = 113152, L_ST = 121856, L_AC = 139264, L_DT = 139776, L_CW = 140288;
__device__ __forceinline__ bf16x8 lds_frag(LAS unsigned char* base, int row, int col) { return *(const LAS bf16x8*)(base + (row * SP + col) * 2); }

__device__ __forceinline__ void p_ssd(Frame& F, const Args& A) {
    bf16* U = (bf16*)(F.ws + WS_U);
    const int w = F.wave;
    { const int tid = F.tid;
    for (int r0 = F.bid * 64; r0 < MTOK; r0 += F.G * 64) {
        const int row = r0 + (tid >> 3), c8 = (tid & 7) * 8;
        bf16* p = U + (size_t)row * LDE + EK + c8;
        const u32x4 v = *(const u32x4*)p; float f[8] = {bflo(v.x), bfhi(v.x), bflo(v.y), bfhi(v.y), bflo(v.z), bfhi(v.z), bflo(v.w), bfhi(v.w)};
        float s = 0.f;
#pragma unroll
        for (int j = 0; j < 8; ++j) s += f[j] * f[j];
        s += __shfl_xor(s, 1); s += __shfl_xor(s, 2); s += __shfl_xor(s, 4);
        const float rs = 1.f / sqrtf(s * (1.f / 64.f) + NORM_EPS); const float* g = A.in[12] + c8;
        u32x4 o; o.x = pk2(f[0] * rs * g[0], f[1] * rs * g[1]); o.y = pk2(f[2] * rs * g[2], f[3] * rs * g[3]); o.z = pk2(f[4] * rs * g[4], f[5] * rs * g[5]); o.w = pk2(f[6] * rs * g[6], f[7] * rs * g[7]);
        *(u32x4*)p = o;
    } }
    LAS unsigned char* L = F.lds;
    LAS float* acum = (LAS float*)(L + L_AC); LAS float* dtv = (LAS float*)(L + L_DT); LAS float* cw = (LAS float*)(L + L_CW);
    const float* conv_w = A.in[5]; const float* conv_b = A.in[6];
    for (int st = F.bid; st < 256; st += F.G) {
        const int b = st >> 4, h = (st >> 1) & 7, ph = st & 1, g = h >> 2;
        { const int tid = F.tid;
        __syncthreads();
        for (int i = tid; i < 5 * 288; i += NTHR) { const int j = i / 288, lc = i % 288;
            const int ch = lc < 128 ? 512 + g * 128 + lc : (lc < 256 ? 768 + g * 128 + (lc - 128) : h * 64 + ph * 32 + (lc - 256));
            cw[i] = j < 4 ? conv_w[j * 1024 + ch] : conv_b[ch]; }
        for (int i = tid; i < 2 * 32 * SP / 2; i += NTHR) ((LAS unsigned*)(L + L_ST))[i] = 0u; }
        const float a_h = -__expf(A.in[8][h]), dtb = A.in[7][h], dsk = A.in[9][h];
        f32x16 state = {0.f, 0.f, 0.f, 0.f, 0.f, 0.f, 0.f, 0.f, 0.f, 0.f, 0.f, 0.f, 0.f, 0.f, 0.f, 0.f};
        __syncthreads();
        u32x4 rawB[7], rawC[7], rawX[4]; unsigned rawdt = 0u; unsigned rawz[16];
#define SSD_FETCH_BCX(cc) do { const size_t _rb = (size_t)b * SEQ + (size_t)(cc) * 128; const int _cg = tid & 15, _rr = tid >> 4; \
            _Pragma("unroll") for (int j = 0; j < 7; ++j) { const int tl = 4 * _rr - 3 + j; rawB[j] = (u32x4){0u, 0u, 0u, 0u}; rawC[j] = (u32x4){0u, 0u, 0u, 0u}; \
                if ((cc) > 0 || tl >= 0) { const bf16* _p = U + (size_t)((long)_rb + tl) * LDE + g * 128 + 8 * _cg; rawB[j] = *(const u32x4*)(_p + EBB); rawC[j] = *(const u32x4*)(_p + ECC); } } \
            const int _cx = tid & 3, _t = tid >> 2; \
            _Pragma("unroll") for (int j = 0; j < 4; ++j) { const int tl = _t - 3 + j; rawX[j] = (u32x4){0u, 0u, 0u, 0u}; \
                if ((cc) > 0 || tl >= 0) rawX[j] = *(const u32x4*)(U + (size_t)((long)_rb + tl) * LDE + EXS + h * 64 + ph * 32 + 8 * _cx); } \
            if (tid < 128) rawdt = U[(_rb + tid) * LDE + EDT + h]; } while (0)
#define SSD_FETCH_Z(cc) do { if (w < 4) { const size_t _rb = (size_t)b * SEQ + (size_t)(cc) * 128; \
            _Pragma("unroll") for (int i = 0; i < 16; ++i) rawz[i] = U[(_rb + 32 * w + 8 * (i >> 2) + 4 * (lane >> 5) + (i & 3)) * LDE + EZ + h * 64 + ph * 32 + (lane & 31)]; } } while (0)
        { int tid = F.tid, lane = F.lane; asm volatile("" : "+v"(tid), "+v"(lane)); SSD_FETCH_BCX(0); SSD_FETCH_Z(0); }
        for (int c = 0; c < 32; ++c) {
            const size_t rowbase = (size_t)b * SEQ + (size_t)c * 128;
            int tid = F.tid, lane = F.lane; asm volatile("" : "+v"(tid), "+v"(lane));
            if (tid < 128) {
                const float dr = bf2f((unsigned short)rawdt) + dtb;
                const float dt = dr > 20.f ? dr : log1pf(__expf(dr));
                float s = dt * a_h;
#pragma unroll
                for (int o = 1; o < 64; o <<= 1) { const float t = __shfl_up(s, o); if (lane >= o) s += t; }
                dtv[tid] = dt; acum[tid] = s;
            }
            {
                const int cg = tid & 15, rr = tid >> 4;
#pragma unroll
                for (int T = 0; T < 2; ++T) {
                    u32x4 raw[7];
#pragma unroll
                    for (int j = 0; j < 7; ++j) raw[j] = T == 0 ? rawB[j] : rawC[j];
                    LAS unsigned char* dst = L + (T == 0 ? L_BS : L_CS);
                    unsigned opk[4][4];
#pragma unroll
                    for (int e2 = 0; e2 < 4; ++e2) {
                        const int lc = T * 128 + 8 * cg + 2 * e2;
                        const f32x2 w0 = *(const LAS f32x2*)(cw + lc), w1 = *(const LAS f32x2*)(cw + 288 + lc), w2 = *(const LAS f32x2*)(cw + 576 + lc), w3 = *(const LAS f32x2*)(cw + 864 + lc), bb = *(const LAS f32x2*)(cw + 1152 + lc);
                        float lo[7], hi[7];
#pragma unroll
                        for (int j = 0; j < 7; ++j) { lo[j] = bflo(raw[j][e2]); hi[j] = bfhi(raw[j][e2]); }
                        float ol[4], oh[4];
#pragma unroll
                        for (int q = 0; q < 4; ++q) { ol[q] = siluf(bb.x + w0.x * lo[q] + w1.x * lo[q + 1] + w2.x * lo[q + 2] + w3.x * lo[q + 3]);
                                                      oh[q] = siluf(bb.y + w0.y * hi[q] + w1.y * hi[q + 1] + w2.y * hi[q + 2] + w3.y * hi[q + 3]); opk[q][e2] = pk2(ol[q], oh[q]); }
                        if (T == 0) {
                            *(LAS u32x2*)(L + L_BT + ((8 * cg + 2 * e2) * SP + 4 * rr) * 2) = (u32x2){pk2(ol[0], ol[1]), pk2(ol[2], ol[3])};
                            *(LAS u32x2*)(L + L_BT + ((8 * cg + 2 * e2 + 1) * SP + 4 * rr) * 2) = (u32x2){pk2(oh[0], oh[1]), pk2(oh[2], oh[3])};
                        }
                    }
#pragma unroll
                    for (int q = 0; q < 4; ++q) *(LAS u32x4*)(dst + ((4 * rr + q) * SP + 8 * cg) * 2) = (u32x4){opk[q][0], opk[q][1], opk[q][2], opk[q][3]};
                }
            }
            __syncthreads();
            if (tid >= 64 && tid < 128) acum[tid] += acum[63];
            __syncthreads();
            {
                const int cg = tid & 3, t = tid >> 2;
                const int gcol = EXS + h * 64 + ph * 32 + 8 * cg;
                u32x4 raw[4];
#pragma unroll
                for (int j = 0; j < 4; ++j) raw[j] = rawX[j];
                const float sc = dtv[t] * __expf(acum[127] - acum[t]);
#pragma unroll
                for (int e = 0; e < 8; ++e) { const int lc = 256 + 8 * cg + e;
                    float rv[4];
#pragma unroll
                    for (int j = 0; j < 4; ++j) rv[j] = (e & 1) ? bfhi(raw[j][e >> 1]) : bflo(raw[j][e >> 1]);
                    const float xv = siluf(cw[1152 + lc] + cw[lc] * rv[0] + cw[288 + lc] * rv[1] + cw[576 + lc] * rv[2] + cw[864 + lc] * rv[3]);
                    *(LAS bf16*)(L + L_XT + ((8 * cg + e) * SP + t) * 2) = (bf16)f2bfh(xv);
                    *(LAS bf16*)(L + L_XS + ((8 * cg + e) * SP + t) * 2) = (bf16)f2bfh(xv * sc); }
            }
            if (c + 1 < 32) SSD_FETCH_BCX(c + 1);
            const int mt = w >> 1, nh = w & 1, r = lane & 31, hh = lane >> 5;
            f32x16 cb[2];
#pragma unroll
            for (int j = 0; j < 2; ++j) {
                cb[j] = (f32x16){0.f, 0.f, 0.f, 0.f, 0.f, 0.f, 0.f, 0.f, 0.f, 0.f, 0.f, 0.f, 0.f, 0.f, 0.f, 0.f};
                const int s0 = 64 * nh + 32 * j;
                if (s0 <= 32 * mt + 31) {
#pragma unroll
                    for (int ks = 0; ks < 8; ++ks) {
                        const bf16x8 af = lds_frag(L + L_CS, 32 * mt + r, 16 * ks + 8 * hh), bfg = lds_frag(L + L_BS, s0 + r, 16 * ks + 8 * hh);
                        cb[j] = __builtin_amdgcn_mfma_f32_32x32x16_bf16(af, bfg, cb[j], 0, 0, 0);
                    }
                }
            }
            __syncthreads();
#pragma unroll
            for (int j = 0; j < 2; ++j) {
                const int s = 64 * nh + 32 * j + r; const float as = acum[s], ds = dtv[s];
#pragma unroll
                for (int i = 0; i < 16; ++i) { const int t = 32 * mt + 8 * (i >> 2) + 4 * hh + (i & 3);
                    const float v = (s <= t) ? cb[j][i] * __expf(acum[t] - as) * ds : 0.f;
                    *(LAS bf16*)(L + L_BS + (t * SP + s) * 2) = (bf16)f2bfh(v); }
            }
            __syncthreads();
            if (w < 4) {
                f32x16 yd = {0.f, 0.f, 0.f, 0.f, 0.f, 0.f, 0.f, 0.f, 0.f, 0.f, 0.f, 0.f, 0.f, 0.f, 0.f, 0.f}, yo = yd;
                for (int ks = 0; ks < 2 * (w + 1); ++ks) {
                    const bf16x8 af = lds_frag(L + L_BS, 32 * w + r, 16 * ks + 8 * hh), bfg = lds_frag(L + L_XT, r, 16 * ks + 8 * hh);
                    yd = __builtin_amdgcn_mfma_f32_32x32x16_bf16(af, bfg, yd, 0, 0, 0);
                }
                LAS unsigned char* stc = L + L_ST + (c & 1) * (32 * SP * 2);
#pragma unroll
                for (int ks = 0; ks < 8; ++ks) {
                    const bf16x8 af = lds_frag(L + L_CS, 32 * w + r, 16 * ks + 8 * hh), bfg = lds_frag(stc, r, 16 * ks + 8 * hh);
                    yo = __builtin_amdgcn_mfma_f32_32x32x16_bf16(af, bfg, yo, 0, 0, 0);
                }
#pragma unroll
                for (int q = 0; q < 4; ++q) {
                    const int t0 = 32 * w + 8 * q + 4 * hh;
                    const u32x2 xx = *(const LAS u32x2*)(L + L_XT + (r * SP + t0) * 2);
                    const float xv[4] = {bflo(xx.x), bfhi(xx.x), bflo(xx.y), bfhi(xx.y)};
#pragma unroll
                    for (int e = 0; e < 4; ++e) { const int t = t0 + e, i = 4 * q + e;
                        bf16* zp = U + (rowbase + t) * LDE + EZ + h * 64 + ph * 32 + r;
                        const float z = bf2f((unsigned short)rawz[i]);
                        const float y = yd[i] + __expf(acum[t]) * yo[i] + dsk * xv[e];
                        *zp = (bf16)f2bfh(y * siluf(z)); }
                }
                if (c + 1 < 32) SSD_FETCH_Z(c + 1);
            } else {
                const int n0 = 32 * (w - 4); const float dec = __expf(acum[127]);
#pragma unroll
                for (int i = 0; i < 16; ++i) state[i] *= dec;
#pragma unroll
                for (int ks = 0; ks < 8; ++ks) {
                    const bf16x8 af = lds_frag(L + L_XS, r, 16 * ks + 8 * hh), bfg = lds_frag(L + L_BT, n0 + r, 16 * ks + 8 * hh);
                    state = __builtin_amdgcn_mfma_f32_32x32x16_bf16(af, bfg, state, 0, 0, 0);
                }
                LAS unsigned char* stn = L + L_ST + ((c + 1) & 1) * (32 * SP * 2);
#pragma unroll
                for (int i = 0; i < 16; ++i) { const int p = 8 * (i >> 2) + 4 * hh + (i & 3);
                    *(LAS bf16*)(stn + (p * SP + n0 + r) * 2) = (bf16)f2bfh(state[i]); }
            }
            __syncthreads();
        }
    }
}

#undef SSD_FETCH_BCX
#undef SSD_FETCH_Z
typedef short s16x4 __attribute__((ext_vector_type(4)));
__device__ __forceinline__ s16x4 lds_tr16(LAS unsigned char* p) { return __builtin_bit_cast(s16x4, __builtin_amdgcn_ds_read_tr16_b64_v4i16((LAS s16x4*)p)); }
__device__ __forceinline__ int t5_bucket_dev(int d) {
    if (d < 16) return d;
    const int v = 16 + (int)(log((double)d / 16.0) / log(8.0) * 16.0);
    return v < 31 ? v : 31;
}
constexpr int D_SEL = 131072, D_LUT = 135168, D_DMY = 139264, VP = 72;
__device__ __forceinline__ unsigned long long mask_ge(int v, int x) { unsigned long long m; asm("v_cmp_ge_i32_e64 %0, %1, %2" : "=s"(m) : "v"(v), "s"(x)); return m; }
__device__ __forceinline__ unsigned long long mask_gt(int v, int x) { unsigned long long m; asm("v_cmp_gt_i32_e64 %0, %1, %2" : "=s"(m) : "v"(v), "s"(x)); return m; }
__device__ __forceinline__ int count_ge8(int a0, int a1, int a2, int a3, int a4, int a5, int a6, int a7, int x) {
    unsigned long long m0, m1, m2, m3, m4, m5, m6, m7;
    asm("v_cmp_ge_i32_e64 %0, %8, %16\n\tv_cmp_ge_i32_e64 %1, %9, %16\n\tv_cmp_ge_i32_e64 %2, %10, %16\n\tv_cmp_ge_i32_e64 %3, %11, %16\n\t"
        "v_cmp_ge_i32_e64 %4, %12, %16\n\tv_cmp_ge_i32_e64 %5, %13, %16\n\tv_cmp_ge_i32_e64 %6, %14, %16\n\tv_cmp_ge_i32_e64 %7, %15, %16"
        : "=&s"(m0), "=&s"(m1), "=&s"(m2), "=&s"(m3), "=&s"(m4), "=&s"(m5), "=&s"(m6), "=&s"(m7)
        : "v"(a0), "v"(a1), "v"(a2), "v"(a3), "v"(a4), "v"(a5), "v"(a6), "v"(a7), "s"(x));
    return (__popcll(m0) + __popcll(m1)) + (__popcll(m2) + __popcll(m3)) + ((__popcll(m4) + __popcll(m5)) + (__popcll(m6) + __popcll(m7)));
}
__device__ __forceinline__ void masks_ge8(int a0, int a1, int a2, int a3, int a4, int a5, int a6, int a7, int x, unsigned long long (&m)[8]) {
    asm("v_cmp_ge_i32_e64 %0, %8, %16\n\tv_cmp_ge_i32_e64 %1, %9, %16\n\tv_cmp_ge_i32_e64 %2, %10, %16\n\tv_cmp_ge_i32_e64 %3, %11, %16\n\t"
        "v_cmp_ge_i32_e64 %4, %12, %16\n\tv_cmp_ge_i32_e64 %5, %13, %16\n\tv_cmp_ge_i32_e64 %6, %14, %16\n\tv_cmp_ge_i32_e64 %7, %15, %16"
        : "=&s"(m[0]), "=&s"(m[1]), "=&s"(m[2]), "=&s"(m[3]), "=&s"(m[4]), "=&s"(m[5]), "=&s"(m[6]), "=&s"(m[7])
        : "v"(a0), "v"(a1), "v"(a2), "v"(a3), "v"(a4), "v"(a5), "v"(a6), "v"(a7), "s"(x));
}
__device__ __forceinline__ int sel_mask(int a, int b, unsigned long long m) { int r; asm("v_cndmask_b32_e64 %0, %1, %2, %3" : "=v"(r) : "v"(a), "v"(b), "s"(m)); return r; }
__device__ __forceinline__ int okey(float f) { const int iv = __builtin_bit_cast(int, f); return iv ^ ((iv >> 31) & 0x7fffffff); }

__device__ __forceinline__ void p_dsa(Frame& F, const Args& A) {
    bf16* U = (bf16*)(F.ws + WS_U); bf16* HB = (bf16*)(F.ws + WS_HB);
    const int w = F.wave;
    const float* ng = A.in[10];
    LAS unsigned char* L = F.lds;
    LAS float* LUT = (LAS float*)(L + D_LUT);
    for (int i = F.tid; i < 1024; i += NTHR) LUT[i] = A.in[1][t5_bucket_dev(i >> 3) * 8 + (i & 7)];
    __syncthreads();
    for (int blk = F.bid; blk < MTOK / 8; blk += F.G) {
        int lane = F.lane; asm volatile("" : "+v"(lane));
        const int kr = blk >> 8, cc = blk & 255, b = kr >> 1, tb = (kr & 1) ? 511 - cc : cc, t0 = tb * 8;
        const size_t bat = (size_t)b * SEQ, rowb = bat + t0;
        {
            const size_t row = rowb + w;
            const u32x4 v = *(const u32x4*)(U + row * LDE + EZ + 8 * lane);
            float f[8] = {bflo(v.x), bfhi(v.x), bflo(v.y), bfhi(v.y), bflo(v.z), bfhi(v.z), bflo(v.w), bfhi(v.w)};
            float s = 0.f;
#pragma unroll
            for (int j = 0; j < 8; ++j) s += f[j] * f[j];
#pragma unroll
            for (int o = 1; o < 32; o <<= 1) s += __shfl_xor(s, o);
            const float rs = 1.f / sqrtf(s * (1.f / 256.f) + NORM_EPS); const float* g = ng + 8 * lane;
            u32x4 o; o.x = pk2(f[0] * rs * g[0], f[1] * rs * g[1]); o.y = pk2(f[2] * rs * g[2], f[3] * rs * g[3]); o.z = pk2(f[4] * rs * g[4], f[5] * rs * g[5]); o.w = pk2(f[6] * rs * g[6], f[7] * rs * g[7]);
            *(u32x4*)(HB + row * DM + 8 * lane) = o;
        }
        {
            const int r = lane & 31, hh = lane >> 5;
            bf16x8 qa[4];
#pragma unroll
            for (int ks = 0; ks < 4; ++ks) qa[ks] = *(const bf16x8*)(U + (rowb + (r >> 2)) * LDE + EIQ + (r & 3) * 64 + 16 * ks + 8 * hh);
            float wv[4][4];
#pragma unroll
            for (int q = 0; q < 4; ++q) { const u32x2 ww = *(const u32x2*)(U + (rowb + 2 * q + hh) * LDE + EIW); wv[q][0] = bflo(ww.x); wv[q][1] = bfhi(ww.x); wv[q][2] = bflo(ww.y); wv[q][3] = bfhi(ww.y); }
            const int ntile = (t0 + 8 + 31) >> 5;
            for (int tb = w; tb < ntile; tb += 4 * NWAVES) {
                bf16x8 kf[4][4];
#pragma unroll
                for (int u4 = 0; u4 < 4; ++u4) { const int tl = tb + 8 * u4 < 128 ? tb + 8 * u4 : 127; const int key = 32 * tl + r;
#pragma unroll
                    for (int ks = 0; ks < 4; ++ks) kf[u4][ks] = *(const bf16x8*)(U + (bat + key) * LDE + EIK + 16 * ks + 8 * hh); }
#pragma unroll
                for (int u4 = 0; u4 < 4; ++u4) {
                    const int tile = tb + 8 * u4;
                    f32x16 acc = {0.f, 0.f, 0.f, 0.f, 0.f, 0.f, 0.f, 0.f, 0.f, 0.f, 0.f, 0.f, 0.f, 0.f, 0.f, 0.f};
#pragma unroll
                    for (int ks = 0; ks < 4; ++ks) acc = __builtin_amdgcn_mfma_f32_32x32x16_bf16(qa[ks], kf[u4][ks], acc, 0, 0, 0);
                    if (tile < ntile) {
#pragma unroll
                        for (int q = 0; q < 4; ++q) {
                            const float sc = wv[q][0] * fmaxf(acc[4 * q], 0.f) + wv[q][1] * fmaxf(acc[4 * q + 1], 0.f) + wv[q][2] * fmaxf(acc[4 * q + 2], 0.f) + wv[q][3] * fmaxf(acc[4 * q + 3], 0.f);
                            *(LAS float*)(L + ((2 * q + hh) * 4096 + 32 * tile + r) * 4) = sc + 0.f;
                        }
                    }
                }
            }
        }
        __syncthreads();
        const int t = t0 + w, n = t + 1;
        LAS unsigned short* sel = (LAS unsigned short*)(L + D_SEL) + w * 256;
        const int cnt = n < 256 ? n : 256;
        if (n <= 256) {
#pragma unroll
            for (int i = 0; i < 4; ++i) { const int s = lane + 64 * i; sel[s] = (unsigned short)(s < n ? s : 0); }
        } else {
            const int nj = (t0 + 8 + 63) >> 6;
            const LAS float* myrow = (const LAS float*)(L + w * 16384);
            int v[64]; int vmax = (int)0x80000000, vmin = 0x7fffffff;
#pragma unroll
            for (int jb = 0; jb < 4; ++jb) {
                if (16 * jb < nj) {
#pragma unroll
                    for (int jj = 0; jj < 16; ++jj) { const int j = 16 * jb + jj; const int idx = lane + 64 * j; const int kv = okey(myrow[idx]);
                        const bool ok = idx <= t; v[j] = ok ? kv : (int)0x80000000; vmax = v[j] > vmax ? v[j] : vmax; const int x = ok ? kv : 0x7fffffff; vmin = x < vmin ? x : vmin; }
                } else {
#pragma unroll
                    for (int jj = 0; jj < 16; ++jj) v[16 * jb + jj] = (int)0x80000000;
                }
            }
#pragma unroll
            for (int o = 1; o < 64; o <<= 1) { const int x = __shfl_xor(vmax, o); vmax = x > vmax ? x : vmax; const int y = __shfl_xor(vmin, o); vmin = y < vmin ? y : vmin; }
            vmax = __builtin_amdgcn_readfirstlane(vmax); vmin = __builtin_amdgcn_readfirstlane(vmin);
            int lo = vmin, hi = vmax, clo = n, chi = 0, it = 0;
            for (int rps = 0; rps < (REP_PART == 4 ? A.rep : 1); ++rps) { lo = vmin; hi = vmax; clo = n; chi = 0; it = 0;
            while (lo < hi) {
                int mid;
                const int ph3 = it % 3;
                if (ph3 == 2) mid = lo + (int)(((long long)hi - (long long)lo + 1) >> 1);
                else {
                    const float lof = __builtin_bit_cast(float, lo >= 0 ? lo : lo ^ 0x7fffffff), hif = __builtin_bit_cast(float, hi >= 0 ? hi : hi ^ 0x7fffffff);
                    const float fr = ph3 == 0 ? ((float)(clo - 256) + 0.5f) / (float)(clo - chi) : 0.5f;
                    mid = okey(lof + (hif - lof) * fr);
                    mid = mid > hi ? hi : mid; mid = mid <= lo ? lo + 1 : mid;
                }
                int c = 0;
#pragma unroll
                for (int jb = 0; jb < 4; ++jb) if (16 * jb < nj) {
#pragma unroll
                    for (int jj = 0; jj < 16; jj += 8) { const int j0 = 16 * jb + jj; c += count_ge8(v[j0], v[j0 + 1], v[j0 + 2], v[j0 + 3], v[j0 + 4], v[j0 + 5], v[j0 + 6], v[j0 + 7], mid); } }
                ++it;
                if (c == 256) { lo = mid; break; }
                if (c > 256) { lo = mid; clo = c; } else { hi = mid - 1; chi = c; }
            } }
            const int T = lo;
            int cge = 0, cgt = 0;
#pragma unroll
            for (int jb = 0; jb < 4; ++jb) if (16 * jb < nj) {
#pragma unroll
                for (int jj = 0; jj < 16; jj += 8) { const int j0 = 16 * jb + jj;
                    cge += count_ge8(v[j0], v[j0 + 1], v[j0 + 2], v[j0 + 3], v[j0 + 4], v[j0 + 5], v[j0 + 6], v[j0 + 7], T);
                    cgt += count_ge8(v[j0], v[j0 + 1], v[j0 + 2], v[j0 + 3], v[j0 + 4], v[j0 + 5], v[j0 + 6], v[j0 + 7], T + 1); } }
            const int need_eq = 256 - cgt;
            if (cge - cgt == need_eq) {
                LAS unsigned short* dummy = (LAS unsigned short*)(L + D_DMY) + w * 64 + lane;
                int obase = 0;
#pragma unroll
                for (int jb = 0; jb < 4; ++jb) if (16 * jb < nj) {
#pragma unroll
                    for (int jj = 0; jj < 16; jj += 8) { const int j0 = 16 * jb + jj; unsigned long long m[8];
                        masks_ge8(v[j0], v[j0 + 1], v[j0 + 2], v[j0 + 3], v[j0 + 4], v[j0 + 5], v[j0 + 6], v[j0 + 7], T, m);
#pragma unroll
                        for (int e = 0; e < 8; ++e) {
                            const int pos = (int)__builtin_amdgcn_mbcnt_hi((unsigned)(m[e] >> 32), __builtin_amdgcn_mbcnt_lo((unsigned)m[e], (unsigned)obase));
                            LAS unsigned short* dst = (LAS unsigned short*)(unsigned)sel_mask((int)(unsigned)(__SIZE_TYPE__)dummy, (int)(unsigned)(__SIZE_TYPE__)(sel + pos), m[e]);
                            *dst = (unsigned short)(lane + 64 * (j0 + e));
                            obase += __popcll(m[e]); } } }
            } else {
            int obase = 0, ebase = 0;
#pragma unroll
            for (int jb = 0; jb < 4; ++jb) if (16 * jb < nj) {
#pragma unroll
                for (int jj = 0; jj < 16; ++jj) { const int j = 16 * jb + jj;
                    const bool gt = v[j] > T, eq = v[j] == T;
                    const unsigned long long be = __ballot(eq);
                    const int erank = ebase + (int)__builtin_amdgcn_mbcnt_hi((unsigned)(be >> 32), __builtin_amdgcn_mbcnt_lo((unsigned)be, 0u));
                    const bool take = gt || (eq && erank < need_eq);
                    const unsigned long long bt = __ballot(take);
                    const int pos = obase + (int)__builtin_amdgcn_mbcnt_hi((unsigned)(bt >> 32), __builtin_amdgcn_mbcnt_lo((unsigned)bt, 0u));
                    if (take && pos < 256) sel[pos] = (unsigned short)(lane + 64 * j);
                    obase += __popcll(bt); ebase += __popcll(be); } }
            }
        }
        __syncthreads();
        {
            const int hd = lane & 15, g4 = lane >> 4;
            const size_t row = rowb + w;
            bf16x8 qb[2];
            {
                float qf[2][8]; float ss = 0.f;
#pragma unroll
                for (int ks = 0; ks < 2; ++ks) { u32x4 qq = (u32x4){0u, 0u, 0u, 0u};
                    if (hd < 8) qq = *(const u32x4*)(U + row * LDE + EQ + hd * 64 + 32 * ks + 8 * g4);
                    qf[ks][0] = bflo(qq.x); qf[ks][1] = bfhi(qq.x); qf[ks][2] = bflo(qq.y); qf[ks][3] = bfhi(qq.y); qf[ks][4] = bflo(qq.z); qf[ks][5] = bfhi(qq.z); qf[ks][6] = bflo(qq.w); qf[ks][7] = bfhi(qq.w);
#pragma unroll
                    for (int j = 0; j < 8; ++j) ss += qf[ks][j] * qf[ks][j]; }
                ss += __shfl_xor(ss, 16); ss += __shfl_xor(ss, 32);
                const float rs = 0.125f / sqrtf(ss * (1.f / 64.f) + NORM_EPS);
#pragma unroll
                for (int ks = 0; ks < 2; ++ks) { const float* gq = A.in[11] + 32 * ks + 8 * g4;
                    u32x4 pk; pk.x = pk2(qf[ks][0] * rs * gq[0], qf[ks][1] * rs * gq[1]); pk.y = pk2(qf[ks][2] * rs * gq[2], qf[ks][3] * rs * gq[3]);
                    pk.z = pk2(qf[ks][4] * rs * gq[4], qf[ks][5] * rs * gq[5]); pk.w = pk2(qf[ks][6] * rs * gq[6], qf[ks][7] * rs * gq[7]);
                    qb[ks] = __builtin_bit_cast(bf16x8, pk); }
            }
            float lg[16][4]; float mx = -3.0e38f;
            const int vsl = lane >> 3, vpart = lane & 7;
            u32x4 vr[2][8];
#pragma unroll
            for (int hb = 0; hb < 2; ++hb) {
                bf16x8 ka[8][2];
#pragma unroll
                for (int T8 = 0; T8 < 8; ++T8) { const int sm = sel[16 * (8 * hb + T8) + hd]; const bf16* kp = U + (bat + sm) * LDE + EK + 8 * g4;
                    ka[T8][0] = *(const bf16x8*)kp; ka[T8][1] = *(const bf16x8*)(kp + 32); }
#pragma unroll
                for (int e = 0; e < 8; ++e) { const int sm = sel[64 * hb + 8 * e + vsl]; vr[hb][e] = *(const u32x4*)(U + (bat + sm) * LDE + EV + 8 * vpart); }
#pragma unroll
                for (int T8 = 0; T8 < 8; ++T8) { const int T = 8 * hb + T8;
                    f32x4 acc = {0.f, 0.f, 0.f, 0.f};
                    acc = __builtin_amdgcn_mfma_f32_16x16x32_bf16(ka[T8][0], qb[0], acc, 0, 0, 0);
                    acc = __builtin_amdgcn_mfma_f32_16x16x32_bf16(ka[T8][1], qb[1], acc, 0, 0, 0);
                    const u32x2 sl = *(const LAS u32x2*)(sel + 16 * T + 4 * g4);
                    const int s4[4] = {(int)(sl.x & 0xffffu), (int)(sl.x >> 16), (int)(sl.y & 0xffffu), (int)(sl.y >> 16)};
#pragma unroll
                    for (int i = 0; i < 4; ++i) { int dist = t - s4[i]; dist = dist < 0 ? 0 : (dist > 127 ? 127 : dist);
                        const float bia = LUT[dist * 8 + (hd & 7)];
                        const bool valid = (16 * T + 4 * g4 + i) < cnt;
                        lg[T][i] = valid ? acc[i] + bia : -3.0e38f; mx = fmaxf(mx, lg[T][i]); }
                }
            }
            mx = fmaxf(mx, __shfl_xor(mx, 16)); mx = fmaxf(mx, __shfl_xor(mx, 32));
            float sum = 0.f;
#pragma unroll
            for (int T = 0; T < 16; ++T) {
#pragma unroll
                for (int i = 0; i < 4; ++i) { const float p = lg[T][i] > -1.0e38f ? __expf(lg[T][i] - mx) : 0.f; lg[T][i] = p; sum += p; }
                if ((T & 3) == 3) __builtin_amdgcn_sched_barrier(0); }
            sum += __shfl_xor(sum, 16); sum += __shfl_xor(sum, 32);
            const float inv = 1.f / fmaxf(sum, 1e-30f);
            f32x4 oacc[4];
#pragma unroll
            for (int dt = 0; dt < 4; ++dt) oacc[dt] = (f32x4){0.f, 0.f, 0.f, 0.f};
            LAS unsigned char* Vl = L + w * 16384;
#pragma unroll
            for (int ch = 0; ch < 4; ++ch) {
                LDS_WAIT();
#pragma unroll
                for (int e = 0; e < 8; ++e) *(LAS u32x4*)(Vl + ((8 * e + vsl) * VP + 8 * vpart) * 2) = vr[ch & 1][e];
                if (ch + 2 < 4) {
#pragma unroll
                    for (int e = 0; e < 8; ++e) { const int sm = sel[64 * (ch + 2) + 8 * e + vsl]; vr[ch & 1][e] = *(const u32x4*)(U + (bat + sm) * LDE + EV + 8 * vpart); }
                }
                LDS_WAIT();
#pragma unroll
                for (int kk = 0; kk < 2; ++kk) {
                    const int T0 = 2 * (2 * ch + kk);
                    u32x4 pp; pp.x = pk2(lg[T0][0] * inv, lg[T0][1] * inv); pp.y = pk2(lg[T0][2] * inv, lg[T0][3] * inv); pp.z = pk2(lg[T0 + 1][0] * inv, lg[T0 + 1][1] * inv); pp.w = pk2(lg[T0 + 1][2] * inv, lg[T0 + 1][3] * inv);
                    const bf16x8 pf = __builtin_bit_cast(bf16x8, pp);
                    const int qq = (lane & 15) >> 2, p4 = lane & 3;
#pragma unroll
                    for (int dt = 0; dt < 4; ++dt) {
                        const s16x4 b0 = lds_tr16(Vl + ((32 * kk + 4 * g4 + qq) * VP + 16 * dt + 4 * p4) * 2);
                        const s16x4 b1 = lds_tr16(Vl + ((32 * kk + 16 + 4 * g4 + qq) * VP + 16 * dt + 4 * p4) * 2);
                        bf16x8 bfg; bfg[0] = b0[0]; bfg[1] = b0[1]; bfg[2] = b0[2]; bfg[3] = b0[3]; bfg[4] = b1[0]; bfg[5] = b1[1]; bfg[6] = b1[2]; bfg[7] = b1[3];
                        oacc[dt] = __builtin_amdgcn_mfma_f32_16x16x32_bf16(pf, bfg, oacc[dt], 0, 0, 0);
                    }
                }
            }
            if (g4 < 2) {
#pragma unroll
                for (int i = 0; i < 4; ++i)
#pragma unroll
                    for (int dt = 0; dt < 4; ++dt) HB[row * DM + 512 + (4 * g4 + i) * 64 + 16 * dt + hd] = (bf16)f2bfh(oacc[dt][i]);
            }
        }
        __syncthreads();
    }
}

template <int MODE> __device__ __forceinline__ void p_norm_route(Frame& F, const bf16* xin, const float* gain, int layer) {
    constexpr int NT = MODE == 0 ? 3 : 2;
    bf16* HB = (bf16*)(F.ws + WS_HB); const bf16* WR = MODE == 0 ? (const bf16*)(F.ws + WS_WR) + (size_t)layer * 48 * 1024 : (const bf16*)(F.ws + WS_WGL);
    float* GL = (float*)(F.ws + WS_GL);
    int* list = (int*)(F.ws + WS_LIST); float* wl = (float*)(F.ws + WS_LISTW);
    LAS unsigned char* L = F.lds;
    LAS float* lgt = (LAS float*)L + F.wave * (16 * 48);
    LAS int* cntl = (LAS int*)(L + 32768); LAS int* basel = (LAS int*)(L + 33024);
    LAS int* ri_e = (LAS int*)(L + 34816); LAS int* ri_p = (LAS int*)(L + 36864); LAS float* ri_w = (LAS float*)(L + 38912);
    const int w = F.wave;
    for (int base = F.bid * 256; base < MTOK; base += F.G * 256) {
        int lane = F.lane; asm volatile("" : "+v"(lane));
        if (F.tid < 64) cntl[F.tid] = 0;
        __syncthreads();
#pragma unroll 1
        for (int half = 0; half < 2; ++half) {
            const int R0 = base + w * 32 + half * 16;
#pragma unroll 1
            for (int i = 0; i < 16; ++i) rms_rowb_to_bf16(xin + (size_t)(R0 + i) * DM, gain, HB + (size_t)(R0 + i) * DM, lane);
            VM_WAIT();
            const int n16 = lane & 15, g4 = lane >> 4;
            f32x4 acc[NT];
#pragma unroll
            for (int nt = 0; nt < NT; ++nt) acc[nt] = (f32x4){0.f, 0.f, 0.f, 0.f};
#pragma unroll 4
            for (int kk = 0; kk < 32; ++kk) {
                const bf16x8 a = *(const bf16x8*)(HB + (size_t)(R0 + n16) * DM + 32 * kk + 8 * g4);
#pragma unroll
                for (int nt = 0; nt < NT; ++nt) { const bf16x8 bb = *(const bf16x8*)(WR + (size_t)(16 * nt + n16) * DM + 32 * kk + 8 * g4);
                    acc[nt] = __builtin_amdgcn_mfma_f32_16x16x32_bf16(a, bb, acc[nt], 0, 0, 0); }
            }
            if constexpr (MODE == 1) {
#pragma unroll
                for (int nt = 0; nt < NT; ++nt)
#pragma unroll
                    for (int i = 0; i < 4; ++i) if (16 * nt + n16 < 24) GL[(size_t)(R0 + 4 * g4 + i) * 24 + 16 * nt + n16] = acc[nt][i];
            } else {
#pragma unroll
            for (int nt = 0; nt < NT; ++nt)
#pragma unroll
                for (int i = 0; i < 4; ++i) lgt[(4 * g4 + i) * 48 + 16 * nt + n16] = acc[nt][i];
            LDS_WAIT();
            if (lane < 16) {
                const LAS float* lr = lgt + lane * 48;
                int gs = 0; float gm = lr[0];
#pragma unroll
                for (int j = 1; j < 4; ++j) if (lr[j] > gm) { gm = lr[j]; gs = j; }
                float gsum = 0.f;
#pragma unroll
                for (int j = 0; j < 4; ++j) gsum += __expf(lr[j] - gm);
                const float gw = 1.f / gsum;
                const LAS float* er = lr + 4 + 8 * gs;
                int i0 = 0; float m0 = er[0];
#pragma unroll
                for (int j = 1; j < 8; ++j) if (er[j] > m0) { m0 = er[j]; i0 = j; }
                int i1 = -1; float m1 = -3.0e38f;
#pragma unroll
                for (int j = 0; j < 8; ++j) if (j != i0 && er[j] > m1) { m1 = er[j]; i1 = j; }
                const float w0 = 1.f / (1.f + __expf(m1 - m0));
                const int e0 = gs * 8 + i0, e1 = 32 + gs * 8 + i1;
                const int rs = (w * 32 + half * 16 + lane) * 2;
                ri_e[rs] = e0; ri_p[rs] = __hip_atomic_fetch_add(cntl + e0, 1, __ATOMIC_RELAXED, __HIP_MEMORY_SCOPE_WORKGROUP); ri_w[rs] = w0 * gw;
                ri_e[rs + 1] = e1; ri_p[rs + 1] = __hip_atomic_fetch_add(cntl + e1, 1, __ATOMIC_RELAXED, __HIP_MEMORY_SCOPE_WORKGROUP); ri_w[rs + 1] = (1.f - w0) * gw;
            }
            LDS_WAIT();
            }
        }
        if constexpr (MODE == 1) continue;
        __syncthreads();
        if (F.tid < 64) { const int c = cntl[F.tid]; basel[F.tid] = c ? (int)__hip_atomic_fetch_add((unsigned*)(F.ctl + CW_CNT + layer * 4096 + 64 * F.tid), (unsigned)c, RLX_AGENT) : 0; }
        __syncthreads();
        { const int rs = F.tid, e = ri_e[rs], pos = basel[e] + ri_p[rs];
          list[(size_t)e * 65536 + pos] = base + (rs >> 1); wl[(size_t)e * 65536 + pos] = ri_w[rs]; }
        __syncthreads();
    }
}
__device__ __forceinline__ void moe_tables(Frame& F, int layer) {
    LAS int* ptile = (LAS int*)(F.lds + MOE_OFF); LAS int* cntv = ptile + 128;
    __syncthreads();
    if (F.tid < 64) {
        const int c = (int)__hip_atomic_load((unsigned*)(F.ctl + CW_CNT + layer * 4096 + 64 * F.tid), RLX_AGENT);
        cntv[F.tid] = c;
        int nt = (c + 255) >> 8, incl = nt;
#pragma unroll
        for (int o = 1; o < 64; o <<= 1) { const int t = __shfl_up(incl, o); if (F.lane >= o) incl += t; }
        ptile[F.tid] = incl - nt; if (F.tid == 63) ptile[64] = incl;
    }
    __syncthreads();
}
__device__ __forceinline__ void p_moe_gu(Frame& F, int layer) {
    moe_tables(F, layer);
    const LAS int* ptile = (const LAS int*)(F.lds + MOE_OFF); const LAS int* cntv = ptile + 128;
    pg8::MoeOrder S{(const char*)(F.ws + WS_HB), (const char*)(F.ws + WS_WGU) + (size_t)layer * 32 * 1024 * 1024 * 2, (size_t)1024 * 1024 * 2, 1024, F.G, F.bid, 0, ptile[64], ptile, cntv, (const int*)(F.ws + WS_LIST), true};
    pg8::EpiSwiGLU E{(bf16*)(F.ws + WS_U)};
    pg8::gemm_phase<pg8::EpiSwiGLU, pg8::MoeOrder, true>(F.lds, 1024, S, E);
}
template <bool FINAL> __device__ __forceinline__ void p_moe_down(Frame& F, int layer, int slot) {
    moe_tables(F, layer);
    const LAS int* ptile = (const LAS int*)(F.lds + MOE_OFF); const LAS int* cntv = ptile + 128;
    pg8::MoeOrder S{(const char*)(F.ws + WS_U), (const char*)(F.ws + WS_WD) + (size_t)layer * 32 * 1024 * 512 * 2, (size_t)1024 * 512 * 2, 512, F.G, F.bid, ptile[32 * slot], ptile[32 * slot + 32], ptile, cntv, (const int*)(F.ws + WS_LIST), false};
    pg8::EpiScatter<FINAL> E{(bf16*)(F.ws + WS_XB), F.out, (const int*)(F.ws + WS_LIST), (const float*)(F.ws + WS_LISTW), cntv};
    pg8::gemm_phase<pg8::EpiScatter<FINAL>, pg8::MoeOrder, true>(F.lds, 512, S, E);
}

__device__ __forceinline__ void p_compress(Frame& F, const Args& A) {
    bf16* U = (bf16*)(F.ws + WS_U);
    LAS unsigned char* L = F.lds;
    const int w = F.wave;
    {
        const int tid = F.tid, sub = tid & 15;
        for (int v0 = F.bid * 32; v0 < MTOK * 4; v0 += F.G * 32) {
            const int vec = v0 + (tid >> 4), row = vec >> 2, wh = vec & 3;
            bf16* p = U + (size_t)row * LDO + ((wh >> 1) ? OKW : OKS) + (wh & 1) * 128 + 8 * sub;
            const float* g = ((wh >> 1) ? A.in[18] : A.in[17]) + 8 * sub;
            const u32x4 v = *(const u32x4*)p; float f[8] = {bflo(v.x), bfhi(v.x), bflo(v.y), bfhi(v.y), bflo(v.z), bfhi(v.z), bflo(v.w), bfhi(v.w)};
            float s = 0.f;
#pragma unroll
            for (int j = 0; j < 8; ++j) s += f[j] * f[j];
            s += __shfl_xor(s, 1); s += __shfl_xor(s, 2); s += __shfl_xor(s, 4); s += __shfl_xor(s, 8);
            const float rs = 1.f / sqrtf(s * (1.f / 128.f) + NORM_EPS);
            u32x4 o; o.x = pk2(f[0] * rs * g[0], f[1] * rs * g[1]); o.y = pk2(f[2] * rs * g[2], f[3] * rs * g[3]); o.z = pk2(f[4] * rs * g[4], f[5] * rs * g[5]); o.w = pk2(f[6] * rs * g[6], f[7] * rs * g[7]);
            *(u32x4*)p = o;
        }
    }
    constexpr int C_A = 0, C_B = 17408, C_H = 52224, C_S = 69632;
    for (int unit = F.bid; unit < 256; unit += F.G) {
        int tid = F.tid, lane = F.lane; asm volatile("" : "+v"(tid), "+v"(lane));
        const int T = unit >> 7, b = (unit >> 3) & 15, g = (unit >> 2) & 1, cb = unit & 3;
        const int col = (T ? OVC : OKC) + g * 128;
        const float* pos = T ? A.in[20] : A.in[19];
        const bf16* w1t = (const bf16*)(F.ws + (T ? WS_W1V : WS_W1K)); const bf16* w2t = (const bf16*)(F.ws + WS_W2) + T * 128 * 128;
        const int wm = w >> 2, wn = w & 3, r = lane & 31, hh = lane >> 5;
        f32x16 acc = {0.f, 0.f, 0.f, 0.f, 0.f, 0.f, 0.f, 0.f, 0.f, 0.f, 0.f, 0.f, 0.f, 0.f, 0.f, 0.f};
#pragma unroll 1
        for (int l = 0; l < 32; ++l) {
            __syncthreads();
#pragma unroll
            for (int e = 0; e < 2; ++e) { const int q = tid + 512 * e, c = q >> 4, part = q & 15; const int tok = 16 * (64 * cb + c) + l;
                u32x4 v = (u32x4){0u, 0u, 0u, 0u};
                if (tok < SEQ) v = *(const u32x4*)(U + ((size_t)b * SEQ + tok) * LDO + col + 8 * part);
                const f32x4 p0 = *(const f32x4*)(pos + l * 128 + 8 * part), p1 = *(const f32x4*)(pos + l * 128 + 8 * part + 4);
                u32x4 o; o.x = pk2(bflo(v.x) + p0.x, bfhi(v.x) + p0.y); o.y = pk2(bflo(v.y) + p0.z, bfhi(v.y) + p0.w); o.z = pk2(bflo(v.z) + p1.x, bfhi(v.z) + p1.y); o.w = pk2(bflo(v.w) + p1.z, bfhi(v.w) + p1.w);
                *(LAS u32x4*)(L + C_A + (c * SP + 8 * part) * 2) = o; }
#pragma unroll
            for (int e = 0; e < 4; ++e) { const int q = tid + 512 * e, j = q >> 4, part = q & 15;
                *(LAS u32x4*)(L + C_B + (j * SP + 8 * part) * 2) = *(const u32x4*)(w1t + (size_t)j * 4096 + l * 128 + 8 * part); }
            __syncthreads();
#pragma unroll
            for (int ks = 0; ks < 8; ++ks) {
                const bf16x8 af = lds_frag(L + C_A, 32 * wm + r, 16 * ks + 8 * hh), bfg = lds_frag(L + C_B, 32 * wn + r, 16 * ks + 8 * hh);
                acc = __builtin_amdgcn_mfma_f32_32x32x16_bf16(af, bfg, acc, 0, 0, 0);
            }
        }
#pragma unroll
        for (int i = 0; i < 16; ++i) { const int c = 32 * wm + 8 * (i >> 2) + 4 * hh + (i & 3);
            *(LAS bf16*)(L + C_H + (c * SP + 32 * wn + r) * 2) = (bf16)f2bfh(siluf(acc[i])); }
        __syncthreads();
        f32x16 a2 = {0.f, 0.f, 0.f, 0.f, 0.f, 0.f, 0.f, 0.f, 0.f, 0.f, 0.f, 0.f, 0.f, 0.f, 0.f, 0.f};
#pragma unroll
        for (int ks = 0; ks < 8; ++ks) {
            const bf16x8 af = lds_frag(L + C_H, 32 * wm + r, 16 * ks + 8 * hh), bfg = *(const bf16x8*)(w2t + (size_t)(32 * wn + r) * 128 + 16 * ks + 8 * hh);
            a2 = __builtin_amdgcn_mfma_f32_32x32x16_bf16(af, bfg, a2, 0, 0, 0);
        }
        float rsv[16];
        if (T == 0) {
            LAS float* st = (LAS float*)(L + C_S);
#pragma unroll
            for (int i = 0; i < 16; ++i) { float q = a2[i] * a2[i];
                q += __shfl_xor(q, 1); q += __shfl_xor(q, 2); q += __shfl_xor(q, 4); q += __shfl_xor(q, 8); q += __shfl_xor(q, 16);
                if (r == 0) st[(32 * wm + 8 * (i >> 2) + 4 * hh + (i & 3)) * 4 + wn] = q; }
            __syncthreads();
#pragma unroll
            for (int i = 0; i < 16; ++i) { const f32x4 q = *(const LAS f32x4*)(st + (32 * wm + 8 * (i >> 2) + 4 * hh + (i & 3)) * 4);
                rsv[i] = A.in[16][32 * wn + r] / sqrtf((q.x + q.y + q.z + q.w) * (1.f / 128.f) + NORM_EPS); }
        } else {
#pragma unroll
            for (int i = 0; i < 16; ++i) rsv[i] = 1.f;
        }
        bf16* dst = (bf16*)(F.ws + (T ? WS_VCMP : WS_KCMP));
#pragma unroll
        for (int i = 0; i < 16; ++i) { const int c = 64 * cb + 32 * wm + 8 * (i >> 2) + 4 * hh + (i & 3);
            dst[(((size_t)b * 256 + c) * 2 + g) * 128 + 32 * wn + r] = (bf16)f2bfh(a2[i] * rsv[i]); }
    }
}

constexpr int N_STG = 32768;
constexpr int N_K = 0, N_V = 16384, N_LUT = 3 * N_STG, N_IMP = N_LUT + 4096, N_FAC = N_IMP + 16384, N_MSK = N_FAC + 1024, N_UNI = N_MSK + 512, N_CST = N_UNI + 64;
constexpr float LOG2E = 1.44269504f;
enum { BR_CMP = 0, BR_SEL = 1, BR_WIN = 2 };
struct NsaCtx {
    LAS unsigned char* L; const bf16* U; const bf16* KC; const bf16* VC;
    int tid, lane, w, r, hh, b, g, qblk, t0, t, head; size_t bat;
    float mrow, cfar; unsigned mlo, mhi;
};
__device__ __forceinline__ void glds16(const void* gsrc, unsigned lds_dst) { unsigned keep;
    asm volatile("s_mov_b32 %0, m0\n\ts_mov_b32 m0, %2\n\ts_nop 0\n\tglobal_load_lds_dwordx4 %1, off\n\ts_mov_b32 m0, %0" : "=&s"(keep) : "v"(gsrc), "s"(lds_dst) : "memory"); }
#define NSA_BAR() do { asm volatile("" ::: "memory"); __builtin_amdgcn_s_barrier(); asm volatile("" ::: "memory"); } while (0)
template <int BR, bool SUM, bool PV, bool IMP, bool UNITFAC = false>
__device__ __forceinline__ void nsa_pass(const NsaCtx& X, const bf16x8 (&qf)[8], f32x16 (&oacc)[4], float& lsum, const float colfac, const int tlo, const int thi, const unsigned long long tmask) {
    LAS unsigned char* L = X.L; const int r = X.r, hh = X.hh, lane = X.lane;
    const LAS float* LUT = (const LAS float*)(L + N_LUT);
    auto dma = [&](int tl, int st) {
#pragma unroll
        for (int e = 0; e < 2; ++e) { const int pidx = e * 8 + X.w, row = pidx * 4 + (lane >> 4), ch = (lane & 15) ^ (((lane >> 4) << 2) | (X.w & 3));
            const bf16* kp; const bf16* vp;
            if (BR == BR_CMP) { const size_t o = (((size_t)X.b * 256 + 64 * tl + row) * 2 + X.g) * 128 + 8 * ch; kp = X.KC + o; vp = X.VC + o; }
            else { const size_t o = (X.bat + 64 * tl + row) * LDO + X.g * 128 + 8 * ch; kp = X.U + o + (BR == BR_SEL ? OKS : OKW); vp = X.U + o + (BR == BR_SEL ? OVS : OVW); }
            const unsigned ld = (unsigned)__builtin_amdgcn_readfirstlane((int)(unsigned)(__SIZE_TYPE__)(L + st * N_STG + N_K + pidx * 1024));
            glds16(kp, ld); if (PV) glds16(vp, ld + N_V); }
    };
    auto nextt = [&](int tl) { ++tl; while (tl <= thi && !((tmask >> tl) & 1ull)) ++tl; return tl; };
    int tile = nextt(tlo - 1);
    if (tile > thi) return;
    asm volatile("s_waitcnt vmcnt(0)" ::: "memory");
    int nxt = nextt(tile);
    int nn = nxt <= thi ? nextt(nxt) : nxt;
    dma(tile, 0); if (nxt <= thi) dma(nxt, 1);
    int cur = 0;
    const bool gB = X.w >= 4;
    const int kswz = ((r & 3) << 2) | ((r >> 2) & 3);
#define NSA_WAIT_KEEP(has_newer) do { if (has_newer) { if (PV) asm volatile("s_waitcnt vmcnt(4)" ::: "memory"); else asm volatile("s_waitcnt vmcnt(2)" ::: "memory"); } else asm volatile("s_waitcnt vmcnt(0)" ::: "memory"); } while (0)
    if (gB) { NSA_WAIT_KEEP(nxt <= thi); NSA_BAR(); }
    while (tile <= thi) {
        const int st2 = cur >= 1 ? cur - 1 : 2;
        if (!gB) NSA_WAIT_KEEP(nxt <= thi);
        NSA_BAR();
        if (gB && nn <= thi) dma(nn, st2);
        LAS unsigned char* Ls = L + cur * N_STG;
        const int maxpos = BR == BR_CMP ? 16 * (64 * tile + 63) + 31 : 64 * tile + 63, minpos = BR == BR_CMP ? 16 * (64 * tile) + 31 : 64 * tile;
        const bool far = (X.t0 - maxpos >= 113) && (BR != BR_WIN || (X.t0 + 63 - minpos < 512));
        bool selb = true; if (BR == BR_SEL) selb = (tile < 32 ? (X.mlo >> tile) : (X.mhi >> (tile - 32))) & 1u;
        bf16x8 pa[2][2];
        {
            bf16x8 kf[2][8];
#pragma unroll
            for (int mt = 0; mt < 2; ++mt)
#pragma unroll
                for (int ks = 0; ks < 8; ++ks) kf[mt][ks] = *(const LAS bf16x8*)(Ls + N_K + (32 * mt + r) * 256 + 16 * ((2 * ks + hh) ^ kswz));
            asm volatile("" ::: "memory");
            f32x16 sacc[2];
#pragma unroll
            for (int mt = 0; mt < 2; ++mt) sacc[mt] = (f32x16){0.f, 0.f, 0.f, 0.f, 0.f, 0.f, 0.f, 0.f, 0.f, 0.f, 0.f, 0.f, 0.f, 0.f, 0.f, 0.f};
#pragma unroll
            for (int ks = 0; ks < 8; ++ks)
#pragma unroll
                for (int mt = 0; mt < 2; ++mt) sacc[mt] = __builtin_amdgcn_mfma_f32_32x32x16_bf16(kf[mt][ks], qf[ks], sacc[mt], 0, 0, 0);
            const float cf = (BR == BR_SEL && !selb) ? -1.0e30f : X.cfar;
#pragma unroll
            for (int mt = 0; mt < 2; ++mt) {
                if (far) {
#pragma unroll
                    for (int i = 0; i < 16; ++i) { const float p = __builtin_amdgcn_exp2f(sacc[mt][i] + cf);
                        if (SUM) lsum += p; sacc[mt][i] = UNITFAC ? p : p * colfac; }
                } else {
#pragma unroll
                    for (int i = 0; i < 16; ++i) { const int kidx = 32 * mt + 8 * (i >> 2) + 4 * hh + (i & 3);
                        int dist; bool ok;
                        if (BR == BR_CMP) { dist = X.t - (16 * (64 * tile + kidx) + 31); ok = dist >= 0; }
                        else { dist = X.t - (64 * tile + kidx); ok = BR == BR_SEL ? (selb && dist >= 0) : (dist >= 0 && dist < 512); }
                        const int dc = dist < 0 ? 0 : (dist > 127 ? 127 : dist);
                        const float bia = LUT[dc * 8 + X.head];
                        const float ev = __builtin_amdgcn_exp2f(sacc[mt][i] + bia - X.mrow);
                        const float p = ok ? ev : 0.f;
                        if (SUM) lsum += p;
                        sacc[mt][i] = UNITFAC ? p : p * colfac; }
                }
                if (IMP) {
                    LAS float* imp = (LAS float*)(L + N_IMP) + (X.w * 8 + (r >> 2)) * 64;
#pragma unroll
                    for (int q = 0; q < 4; ++q) { float s4 = (sacc[mt][4 * q] + sacc[mt][4 * q + 1]) + (sacc[mt][4 * q + 2] + sacc[mt][4 * q + 3]), s3 = sacc[mt][4 * q + 3];
                        s4 += __shfl_xor(s4, 1); s4 += __shfl_xor(s4, 2); s3 += __shfl_xor(s3, 1); s3 += __shfl_xor(s3, 2);
                        const int n = 16 * tile + 8 * mt + 2 * q + hh;
                        if ((r & 3) == 0) { __hip_atomic_fetch_add(imp + n, s4, __ATOMIC_RELAXED, __HIP_MEMORY_SCOPE_WORKGROUP); if (n < 63) __hip_atomic_fetch_add(imp + n + 1, s3, __ATOMIC_RELAXED, __HIP_MEMORY_SCOPE_WORKGROUP); } }
                }
                if (PV) {
#pragma unroll
                    for (int sI = 0; sI < 2; ++sI) { u32x4 pp; pp.x = pk2(sacc[mt][8 * sI], sacc[mt][8 * sI + 1]); pp.y = pk2(sacc[mt][8 * sI + 2], sacc[mt][8 * sI + 3]); pp.z = pk2(sacc[mt][8 * sI + 4], sacc[mt][8 * sI + 5]); pp.w = pk2(sacc[mt][8 * sI + 6], sacc[mt][8 * sI + 7]);
                        pa[mt][sI] = __builtin_bit_cast(bf16x8, pp); }
                }
            }
        }
        if (gB && nxt <= thi) NSA_WAIT_KEEP(nn <= thi);
        NSA_BAR();
        if (!gB && nn <= thi) dma(nn, st2);
        if (PV) {
            const int q4 = (lane & 15) >> 2, k2 = 2 * ((lane >> 4) & 1) + ((lane & 3) >> 1), sub8 = 8 * (lane & 1);
            s16x4 vb[2][8];
#define NSA_LDV(g, dst) do { const int _row0 = 16 * (g) + 4 * hh + q4; _Pragma("unroll") for (int nt = 0; nt < 4; ++nt) { \
                dst[2 * nt] = lds_tr16(Ls + N_V + _row0 * 256 + 64 * (nt ^ q4) + 16 * (k2 ^ hh) + sub8); \
                dst[2 * nt + 1] = lds_tr16(Ls + N_V + (_row0 + 8) * 256 + 64 * (nt ^ q4) + 16 * (k2 ^ (hh + 2)) + sub8); } } while (0)
            NSA_LDV(0, vb[0]);
#pragma unroll
            for (int g = 0; g < 4; ++g) {
                if (g == 0) NSA_LDV(1, vb[1]); else if (g == 1) NSA_LDV(2, vb[0]); else if (g == 2) NSA_LDV(3, vb[1]);
                asm volatile("" ::: "memory");
#pragma unroll
                for (int nt = 0; nt < 4; ++nt) { const s16x4 b0 = vb[g & 1][2 * nt], b1 = vb[g & 1][2 * nt + 1];
                    bf16x8 bfg; bfg[0] = b0[0]; bfg[1] = b0[1]; bfg[2] = b0[2]; bfg[3] = b0[3]; bfg[4] = b1[0]; bfg[5] = b1[1]; bfg[6] = b1[2]; bfg[7] = b1[3];
                    oacc[nt] = __builtin_amdgcn_mfma_f32_32x32x16_bf16(pa[g >> 1][g & 1], bfg, oacc[nt], 0, 0, 0); }
            }
#undef NSA_LDV
        }
        tile = nxt; nxt = nn; nn = nn <= thi ? nextt(nn) : nn;
        cur = cur == 2 ? 0 : cur + 1;
    }
#undef NSA_WAIT_KEEP
    if (!gB) NSA_BAR();
    __syncthreads();
}

__device__ __forceinline__ void p_nsa(Frame& F, const Args& A) {
    const bf16* U = (const bf16*)(F.ws + WS_U); bf16* HB = (bf16*)(F.ws + WS_HB); const float* GL = (const float*)(F.ws + WS_GL);
    LAS unsigned char* L = F.lds;
    LAS float* LUT = (LAS float*)(L + N_LUT); LAS float* cst = (LAS float*)(L + N_CST);
    for (int i = F.tid; i < 1024; i += NTHR) LUT[i] = A.in[1][t5_bucket_dev(i >> 3) * 8 + (i & 7)] * LOG2E;
    if (F.wave == 0) {
        float gm = 0.f, bm = 0.f;
        for (int i = F.lane; i < 128; i += 64) gm = fmaxf(gm, fmaxf(fabsf(A.in[16][i]), fmaxf(fabsf(A.in[17][i]), fabsf(A.in[18][i]))));
        for (int i = F.lane; i < 256; i += 64) bm = fmaxf(bm, fabsf(A.in[1][i]));
#pragma unroll
        for (int o = 1; o < 64; o <<= 1) { gm = fmaxf(gm, __shfl_xor(gm, o)); bm = fmaxf(bm, __shfl_xor(bm, o)); }
        if (F.lane == 0) { cst[0] = gm * 11.3137085f; cst[1] = bm * LOG2E; }
    }
    __syncthreads();
    const float kmax = cst[0], bmax = cst[1];
    for (int ui = F.bid; ui < 2048; ui += F.G) {
        NsaCtx X; X.L = L; X.U = U; X.KC = (const bf16*)(F.ws + WS_KCMP); X.VC = (const bf16*)(F.ws + WS_VCMP);
        int tid = F.tid, lane = F.lane; asm volatile("" : "+v"(tid), "+v"(lane));
        X.tid = tid; X.lane = lane; X.w = F.wave; X.r = lane & 31; X.hh = lane >> 5;
        const int kr = ui >> 8, cc = ui & 255, bg = kr * 4 + (cc >> 6);
        X.b = bg >> 1; X.g = bg & 1; X.qblk = (kr & 1) ? 63 - (cc & 63) : (cc & 63); X.t0 = 64 * X.qblk; X.bat = (size_t)X.b * SEQ;
        const int tq = X.r >> 2, hd = X.r & 3; X.t = X.t0 + 8 * X.w + tq; X.head = 4 * X.g + hd;
        const size_t row = X.bat + X.t;
        if (tid == 0) *(LAS unsigned long long*)(L + N_UNI) = 0ull;
        for (int i = tid; i < 4096; i += NTHR) ((LAS float*)(L + N_IMP))[i] = 0.f;
        bf16x8 qf[8]; float qn2 = 0.f;
        {
            u32x4 qr[8]; float ss = 0.f;
#pragma unroll
            for (int ks = 0; ks < 8; ++ks) { qr[ks] = *(const u32x4*)(U + row * LDO + OQ + X.head * 128 + 16 * ks + 8 * X.hh);
#pragma unroll
                for (int e = 0; e < 4; ++e) { const float a = bflo(qr[ks][e]), c = bfhi(qr[ks][e]); ss += a * a + c * c; } }
            ss += __shfl_xor(ss, 32);
            const float rs = 1.f / sqrtf(ss * (1.f / 128.f) + NORM_EPS);
#pragma unroll
            for (int ks = 0; ks < 8; ++ks) { const float* gq = A.in[15] + 16 * ks + 8 * X.hh; u32x4 pk;
#pragma unroll
                for (int e = 0; e < 4; ++e) { const float a = bflo(qr[ks][e]) * rs * gq[2 * e], c = bfhi(qr[ks][e]) * rs * gq[2 * e + 1]; qn2 += a * a + c * c; pk[e] = pk2(a * (0.0883883476f * LOG2E), c * (0.0883883476f * LOG2E)); }
                qf[ks] = __builtin_bit_cast(bf16x8, pk); }
            qn2 += __shfl_xor(qn2, 32);
        }
        X.mrow = sqrtf(qn2) * (0.0883883476f * LOG2E) * kmax + bmax;
        X.cfar = LUT[127 * 8 + X.head] - X.mrow;
        X.mlo = 0u; X.mhi = 0u;
        const float g_c = 1.f / (1.f + __expf(-GL[row * 24 + X.head])), g_s = 1.f / (1.f + __expf(-GL[row * 24 + 8 + X.head])), g_w = 1.f / (1.f + __expf(-GL[row * 24 + 16 + X.head]));
        f32x16 oacc[4];
#pragma unroll
        for (int nt = 0; nt < 4; ++nt) oacc[nt] = (f32x16){0.f, 0.f, 0.f, 0.f, 0.f, 0.f, 0.f, 0.f, 0.f, 0.f, 0.f, 0.f, 0.f, 0.f, 0.f, 0.f};
        const int ntc = ((4 * X.qblk + 2) >> 6) + 1;
        float l_c = 0.f;
        nsa_pass<BR_CMP, true, false, false, true>(X, qf, oacc, l_c, 1.f, 0, ntc - 1, ~0ull);
        l_c += __shfl_xor(l_c, 32);
        const float il_c = l_c > 0.f ? 1.f / l_c : 0.f;
        { float dummy = 0.f; nsa_pass<BR_CMP, false, false, true>(X, qf, oacc, dummy, il_c, 0, ntc - 1, ~0ull); }
        {
            LDS_WAIT();
            const LAS float* impw = (const LAS float*)(L + N_IMP) + X.w * 8 * 64;
            const int n = lane, cur = X.qblk;
            unsigned long long wor = 0ull;
#pragma unroll 1
            for (int q = 0; q < 8; ++q) {
                const float imp = impw[q * 64 + n];
                const bool forced = (n == 0) || (n == cur) || (n == cur - 1);
                float val = forced ? 3.0e38f : imp; if (n > cur) val = -3.0e38f;
                int rank = 0;
#pragma unroll 8
                for (int m = 0; m < 64; ++m) { const float vm = __shfl(val, m); rank += (vm > val || (vm == val && m < n)) ? 1 : 0; }
                const unsigned long long mk = __ballot(n <= cur && rank < 16);
                wor |= mk;
                if ((X.r >> 2) == q) { X.mlo = (unsigned)mk; X.mhi = (unsigned)(mk >> 32); }
            }
            if (lane == 0) __hip_atomic_fetch_or((LAS unsigned long long*)(L + N_UNI), wor, __ATOMIC_RELAXED, __HIP_MEMORY_SCOPE_WORKGROUP);
        }
        __syncthreads();
        const unsigned long long uni = *(const LAS unsigned long long*)(L + N_UNI);
        float l_s = 0.f;
        nsa_pass<BR_SEL, true, true, false, true>(X, qf, oacc, l_s, 1.f, 0, X.qblk, uni);
        if (REP_PART == 7) for (int rp = 1; rp < A.rep; ++rp) { float dummy = 0.f; nsa_pass<BR_SEL, false, true, false, false>(X, qf, oacc, dummy, 0.f, 0, X.qblk, uni); }
        l_s += __shfl_xor(l_s, 32);
        {
            LAS float* fac = (LAS float*)(L + N_FAC) + X.w * 32;
            if (lane < 32) fac[lane] = l_s > 0.f ? g_s / l_s : 0.f;
            LDS_WAIT();
#pragma unroll
            for (int q = 0; q < 4; ++q) { const f32x4 fr = *(const LAS f32x4*)(fac + 8 * q + 4 * X.hh);
#pragma unroll
                for (int nt = 0; nt < 4; ++nt) { oacc[nt][4 * q] *= fr.x; oacc[nt][4 * q + 1] *= fr.y; oacc[nt][4 * q + 2] *= fr.z; oacc[nt][4 * q + 3] *= fr.w; } }
        }
        { float dummy = 0.f; nsa_pass<BR_CMP, false, true, false>(X, qf, oacc, dummy, g_c * il_c, 0, ntc - 1, ~0ull); }
        const int wlo = X.qblk >= 8 ? X.qblk - 8 : 0;
        float l_w = 0.f;
        nsa_pass<BR_WIN, true, false, false, true>(X, qf, oacc, l_w, 1.f, wlo, X.qblk, ~0ull);
        l_w += __shfl_xor(l_w, 32);
        { float dummy = 0.f; nsa_pass<BR_WIN, false, true, false>(X, qf, oacc, dummy, l_w > 0.f ? g_w / l_w : 0.f, wlo, X.qblk, ~0ull); }
#pragma unroll
        for (int i = 0; i < 16; ++i) { const int c32 = 8 * (i >> 2) + 4 * X.hh + (i & 3);
            bf16* op = HB + (X.bat + X.t0 + 8 * X.w + (c32 >> 2)) * DM + (4 * X.g + (c32 & 3)) * 128 + X.r;
#pragma unroll
            for (int nt = 0; nt < 4; ++nt) op[32 * nt] = (bf16)f2bfh(oacc[nt][i]); }
    }
}

constexpr int N_PHASES = 18;
__global__ void __launch_bounds__(NTHR, 2) mk_fwd(Args args) {
    extern __shared__ __attribute__((aligned(16))) unsigned char lds[];
    Frame F;
    F.lds = (LAS unsigned char*)lds;
    F.MISC = (volatile LAS unsigned*)(F.lds + MISC_OFF);
    F.tid = threadIdx.x; F.lane = F.tid & 63; F.wave = __builtin_amdgcn_readfirstlane(F.tid >> 6);
    F.G = gridDim.x; F.bid = blockIdx.x;
    F.ws = args.ws; F.out = args.out; F.ctl = (gu32*)(args.ws + WS_CTL);
    if (F.tid < 64) F.MISC[F.tid] = 0u;
    __syncthreads();
    const int lo = args.ph_lo, hi = args.ph_hi;
    XcdBarrier bar; bar.bar = (unsigned*)(F.ctl + CW_BAR); bar.x = 0; bar.st = nullptr;
    if (hi - lo > 1) bar = xcd_barrier_post((unsigned*)(F.ctl + CW_BAR), F.MISC + 8);
#ifndef PHMASK
#define PHMASK 0xffffffffu
#endif
#define IN(k) (((PHMASK >> (k)) & 1u) && lo <= (k) && (k) < hi)
#ifndef REPMASK
#define REPMASK 0u
#endif
#define RUNS(k) (1 + (int)((REPMASK >> (k)) & 1u))
#define SEAM(k) do { if (IN(k) && IN((k) + 1)) xcd_barrier(bar); } while (0)
    if (IN(0)) { for (int rp = 0; rp < RUNS(0); ++rp) p_prologue(F, args); } SEAM(0);
    if (IN(1)) for (int rp = 0; rp < RUNS(1); ++rp) {
        pg8::StaticOrder S; S.init(F.ws + WS_HB, F.ws + WS_WIE, MTOK, LDE, DM, F.G, F.bid);
        pg8::EpiBf16 E{(bf16*)(F.ws + WS_U), LDE};
        pg8::gemm_phase<pg8::EpiBf16, pg8::StaticOrder, true>(F.lds, DM, S, E);
    } SEAM(1);
    if (IN(2)) { p_ssd(F, args); } SEAM(2);
    if (IN(3)) { for (int rp = 0; rp < RUNS(3); ++rp) p_dsa(F, args); } SEAM(3);
    if (IN(4)) {
        pg8::StaticOrder S; S.init(F.ws + WS_HB, F.ws + WS_WOE, MTOK, DM, DM, F.G, F.bid);
        pg8::EpiResXB E{args.in[0], nullptr, (bf16*)(F.ws + WS_XB)};
        pg8::gemm_phase<pg8::EpiResXB, pg8::StaticOrder, true>(F.lds, DM, S, E);
    } SEAM(4);
    if (IN(5)) { p_norm_route<0>(F, (const bf16*)(F.ws + WS_XB), args.in[3], 0); } SEAM(5);
    if (IN(6)) { p_moe_gu(F, 0);
#if (REPMASK >> 6) & 1
        p_moe_gu(F, 0);
#endif
    } SEAM(6);
    if (IN(7)) { p_moe_down<false>(F, 0, 0); } SEAM(7);
    if (IN(8)) { p_moe_down<false>(F, 0, 1); } SEAM(8);
    if (IN(9)) { for (int rp = 0; rp < RUNS(9); ++rp) p_norm_route<1>(F, (const bf16*)(F.ws + WS_XB), args.in[2] + DM, 0); } SEAM(9);
    if (IN(10)) {
        pg8::StaticOrder S; S.init(F.ws + WS_HB, F.ws + WS_WIO, MTOK, LDO, DM, F.G, F.bid);
        pg8::EpiBf16 E{(bf16*)(F.ws + WS_U), LDO};
        pg8::gemm_phase<pg8::EpiBf16, pg8::StaticOrder, true>(F.lds, DM, S, E);
    } SEAM(10);
    if (IN(11)) { p_compress(F, args); } SEAM(11);
    if (IN(12)) { p_nsa(F, args);
#if (REPMASK >> 12) & 1
        p_nsa(F, args);
#endif
    } SEAM(12);
    if (IN(13)) {
        pg8::StaticOrder S; S.init(F.ws + WS_HB, F.ws + WS_WOO, MTOK, DM, DM, F.G, F.bid);
        pg8::EpiResXB E{nullptr, (const bf16*)(F.ws + WS_XB), (bf16*)(F.ws + WS_XB)};
        pg8::gemm_phase<pg8::EpiResXB, pg8::StaticOrder, true>(F.lds, DM, S, E);
    } SEAM(13);
    if (IN(14)) { p_norm_route<0>(F, (const bf16*)(F.ws + WS_XB), args.in[3] + DM, 1); } SEAM(14);
    if (IN(15)) { p_moe_gu(F, 1); } SEAM(15);
    if (IN(16)) { p_moe_down<false>(F, 1, 0); } SEAM(16);
    if (IN(17)) { p_moe_down<true>(F, 1, 1); }
#undef IN
#undef SEAM
}

extern "C" void kernel_launch(void* const* d_in, const int* in_sizes, int n_in, void* d_out, int out_size, void* d_ws, size_t ws_size, hipStream_t stream) {
    static int grid = 0;
    if (grid == 0) {
        if (n_in != 31 || ws_size < WS_END) { fprintf(stderr, "kernel_launch: unexpected n_in %d / ws %zu\n", n_in, ws_size); grid = -1; return; }
        int dev = 0, cus = 0;
        if (hipGetDevice(&dev) != hipSuccess || hipDeviceGetAttribute(&cus, hipDeviceAttributeMultiprocessorCount, dev) != hipSuccess) { grid = -1; return; }
        if (hipFuncSetAttribute((const void*)mk_fwd, hipFuncAttributeMaxDynamicSharedMemorySize, LDS_BYTES) != hipSuccess) { fprintf(stderr, "kernel_launch: hipFuncSetAttribute failed\n"); grid = -1; return; }
        grid = cus;
    }
    if (grid < 0) return;
    (void)hipMemsetAsync((char*)d_ws + WS_CTL, 0, CTL_ZERO_BYTES, stream);
    Args a{};
    for (int i = 0; i < 31; ++i) a.in[i] = (const float*)d_in[i];
    a.out = (float*)d_out; a.ws = (unsigned char*)d_ws; a.rep = (REP_PART || REP_PHASE >= 0) ? 2 : 1; a.pad = 0; a.rep = 2; a.pad = 0;
#if defined(MK_PER_PHASE)
    for (int p = 0; p < N_PHASES; ++p) { a.ph_lo = p; a.ph_hi = p + 1; hipLaunchKernelGGL(mk_fwd, dim3(grid), dim3(NTHR), LDS_BYTES, stream, a); }
#else
    a.ph_lo = 0; a.ph_hi = N_PHASES; hipLaunchKernelGGL(mk_fwd, dim3(grid), dim3(NTHR), LDS_BYTES, stream, a);
#endif
}
```

```cpp
#include <hip/hip_runtime.h>
#include <cstdio>
#include <cstdint>

#define GAS __attribute__((address_space(1)))
#define LAS __attribute__((address_space(3)))
typedef unsigned short bf16;
typedef short bf16x8 __attribute__((ext_vector_type(8)));
typedef float f32x4 __attribute__((ext_vector_type(4)));
typedef float f32x2 __attribute__((ext_vector_type(2)));
typedef float f32x16 __attribute__((ext_vector_type(16)));
typedef unsigned u32x4 __attribute__((ext_vector_type(4)));
typedef unsigned u32x2 __attribute__((ext_vector_type(2)));
typedef GAS unsigned gu32;
#define RLX_AGENT __ATOMIC_RELAXED, __HIP_MEMORY_SCOPE_AGENT
#define LDS_WAIT() asm volatile("s_waitcnt lgkmcnt(0)" ::: "memory")
#define VM_WAIT() asm volatile("s_waitcnt vmcnt(0)" ::: "memory")

constexpr int NB = 16, SEQ = 4096, DM = 1024, MTOK = NB * SEQ;
constexpr float NORM_EPS = 1e-6f;
constexpr int LDE = 2560;
constexpr int EZ = 0, EXS = 512, EBB = 1024, ECC = 1280, EQ = 1536, EK = 2048, EV = 2112, EIQ = 2176, EIK = 2432, EDT = 2496, EIW = 2504;
constexpr int LDO = 2560;
constexpr int OQ = 0, OKC = 1024, OVC = 1280, OKS = 1536, OVS = 1792, OKW = 2048, OVW = 2304;
constexpr int NWAVES = 8, NTHR = 512;

constexpr size_t MiB = 1u << 20;
constexpr size_t WS_CTL = 0, CTL_ZERO_BYTES = 1 * MiB;
constexpr size_t WS_WIE = 1 * MiB, WS_WOE = 6 * MiB, WS_WIO = 8 * MiB, WS_WOO = 13 * MiB;
constexpr size_t WS_W1K = 15 * MiB, WS_W1V = 16 * MiB, WS_W2 = 17 * MiB, WS_WR = 18 * MiB;
constexpr size_t WS_WGL = WS_WR + 256 * 1024;
constexpr size_t WS_TOK = 19 * MiB;
constexpr size_t WS_GL = 20 * MiB;
constexpr size_t WS_KCMP = 26 * MiB, WS_VCMP = 28 * MiB;
constexpr size_t WS_LIST = 32 * MiB;
constexpr size_t WS_WGU = 48 * MiB;
constexpr size_t WS_WD = 176 * MiB;
constexpr size_t WS_HB = 240 * MiB;
constexpr size_t WS_U = 368 * MiB;
constexpr size_t WS_LISTW = 720 * MiB;
constexpr size_t WS_XB = 736 * MiB;
constexpr size_t WS_PARK = 864 * MiB;
constexpr size_t WS_END = 880 * MiB;
constexpr int CW_TMO = 0, CW_CODE = 1, CW_BAR = 4096, CW_CNT = 8192;

constexpr int RING_BYTES = 131072;
constexpr int LDS_BYTES = 147456;
constexpr int MISC_OFF = LDS_BYTES - 256;
constexpr int MOE_OFF = LDS_BYTES - 2048;

__device__ __forceinline__ unsigned f2bf(float f) { unsigned u = __builtin_bit_cast(unsigned, f); return (u + 0x7fffu + ((u >> 16) & 1u)) >> 16; }
typedef __bf16 bf16x2_t __attribute__((ext_vector_type(2)));
__device__ __forceinline__ unsigned pk2(float lo, float hi) { const f32x2 v = {lo, hi}; const bf16x2_t b = __builtin_convertvector(v, bf16x2_t); return __builtin_bit_cast(unsigned, b); }
__device__ __forceinline__ unsigned short f2bfh(float f) { return (unsigned short)(pk2(f, f) & 0xffffu); }
__device__ __forceinline__ float bf2f(unsigned short b) { return __builtin_bit_cast(float, ((unsigned)b) << 16); }
__device__ __forceinline__ float bflo(unsigned w) { return __builtin_bit_cast(float, w << 16); }
__device__ __forceinline__ float bfhi(unsigned w) { return __builtin_bit_cast(float, w & 0xffff0000u); }
__device__ __forceinline__ float siluf(float v) { return v * __builtin_amdgcn_rcpf(1.f + __builtin_amdgcn_exp2f(-1.44269504f * v)); }

#define XB_TMO      128
#define XB_XCNT(j)  (256  + 64 * (j))
#define XB_XSUB(j)  (1280 + 64 * (j))
#define XB_XGEN(j)  (2304 + 64 * (j))
#define XB_TOP      3328
#define XB_TOPGEN   3392
#define XCD_BAR_WORDS 3456
#define XB_SPIN_CAP (1u << 20)
__device__ __forceinline__ unsigned xb_ld(unsigned* p)              { return __hip_atomic_load(p, __ATOMIC_RELAXED, __HIP_MEMORY_SCOPE_AGENT); }
__device__ __forceinline__ unsigned xb_add(unsigned* p, unsigned v) { return __hip_atomic_fetch_add(p, v, __ATOMIC_RELAXED, __HIP_MEMORY_SCOPE_AGENT); }
__device__ __forceinline__ unsigned xb_xcc_id() { return (unsigned)__builtin_amdgcn_s_getreg((3 << 11) | 20) & 0xFu; }
#define XB_SPIN(cond, bar) do { unsigned _sp = 0; while (cond) { __builtin_amdgcn_s_sleep(1); \
    if ((++_sp & 255u) == 0u) { if (xb_ld(&(bar)[XB_TMO])) break; if (_sp > XB_SPIN_CAP) { atomicAdd(&(bar)[XB_TMO], 1u); break; } } } } while (0)
struct XcdBarrier { unsigned* bar; unsigned x; volatile LAS unsigned* st; };
__device__ __forceinline__ XcdBarrier xcd_barrier_post(unsigned* bar, volatile LAS unsigned* st) {
    XcdBarrier b; b.bar = bar; b.x = xb_xcc_id(); b.st = st;
    if (threadIdx.x == 0) (void)xb_add(&bar[XB_XCNT(b.x)], 1u);
    return b;
}
__device__ __forceinline__ void xcd_barrier_complete(unsigned* bar, unsigned x, unsigned& nloc, unsigned& nx) {
    const unsigned G = gridDim.x * gridDim.y * gridDim.z;
    unsigned sum, cnt, mine, sp = 0u;
    for (;;) {
        sum = 0u; cnt = 0u; mine = 0u;
#pragma unroll
        for (unsigned j = 0; j < 16; ++j) { const unsigned c = xb_ld(&bar[XB_XCNT(j)]); sum += c; cnt += (c > 0u) ? 1u : 0u; mine = (j == x) ? c : mine; }
        if (sum == G) break;
        __builtin_amdgcn_s_sleep(1);
        if ((++sp & 255u) == 0u) { if (xb_ld(&bar[XB_TMO])) break; if (sp > XB_SPIN_CAP) { atomicAdd(&bar[XB_TMO], 1u); break; } }
    }
    nloc = mine > 0u ? mine : 1u; nx = cnt > 0u ? cnt : 1u;
}
__device__ __forceinline__ void xcd_barrier(const XcdBarrier& b) {
    asm volatile("s_waitcnt vmcnt(0)" ::: "memory");
    __syncthreads();
    if (threadIdx.x == 0) {
        unsigned* bar = b.bar;
        __builtin_amdgcn_s_waitcnt(0);
        unsigned nloc = b.st[0], nx = b.st[1];
        if (nloc == 0u) { xcd_barrier_complete(bar, b.x, nloc, nx); b.st[0] = nloc; b.st[1] = nx; }
        const unsigned old = xb_add(&bar[XB_XSUB(b.x)], 1u);
        const unsigned gen = old / nloc;
        if (old + 1u == (gen + 1u) * nloc) {
            __builtin_amdgcn_fence(__ATOMIC_RELEASE, "agent");
            asm volatile("s_waitcnt vmcnt(0)" ::: "memory");
            const unsigned og = xb_add(&bar[XB_TOP], 1u);
            const unsigned tg = og / nx;
            if (og + 1u == (tg + 1u) * nx) xb_add(&bar[XB_TOPGEN], 1u);
            else XB_SPIN(xb_ld(&bar[XB_TOPGEN]) == tg, bar);
            __builtin_amdgcn_fence(__ATOMIC_ACQUIRE, "agent");
            xb_add(&bar[XB_XGEN(b.x)], 1u);
            asm volatile("s_waitcnt vmcnt(0)" ::: "memory");
        } else {
            XB_SPIN(xb_ld(&bar[XB_XGEN(b.x)]) == gen, bar);
            __builtin_amdgcn_fence(__ATOMIC_ACQUIRE, "agent");
            asm volatile("s_waitcnt vmcnt(0)" ::: "memory");
        }
    }
    __syncthreads();
}

namespace pg8 {
constexpr int BM = 256, BK = 64, HALF = 128, HTB = HALF * BK * 2, STAGE_BYTES = 8 * HTB, NXCD = 8, WGM = 8;
__host__ __device__ __forceinline__ int lds_byte(int r, int c) { const int st = (r >> 4) * 2 + (c >> 5), rr = r & 15, cc = c & 31, ob = rr * 64 + cc * 2; return st * 1024 + (ob ^ (((ob >> 9) & 1) << 5)); }
__host__ __device__ __forceinline__ void stage_rc(int b, int& R, int& C) { const int st = b / 1024, sb = b % 1024, swz = sb ^ (((sb >> 9) & 1) << 5); R = (st >> 1) * 16 + swz / 64; C = (st & 1) * 32 + (swz % 64) / 2; }
__host__ __device__ __forceinline__ int perm32(int rho) { const int n = rho >> 4, i = rho & 15; return 8 * (i >> 2) + 4 * n + (i & 3); }
__device__ __forceinline__ unsigned cvt_pk_bf16(float lo, float hi) { unsigned r; asm volatile("v_cvt_pk_bf16_f32 %0, %1, %2" : "=v"(r) : "v"(lo), "v"(hi)); return r; }

struct Unit { const char* A; const char* B; int pm, pn, aux; };

struct StaticOrder {
    const char* A; const char* Bt; int K, nM, nN, nwg, G, c;
    __device__ void init(const void* A_, const void* Bt_, int M, int N, int K_, int G_, int c_) { A = (const char*)A_; Bt = (const char*)Bt_; K = K_; nM = M / BM; nN = N / BM; nwg = nM * nN; G = G_; c = c_; }
    __device__ __forceinline__ bool next(int i, Unit& u) const {
        const long L = (long)i * G + c; if (L >= nwg) return false;
        int wgid = (int)L; { const int q = nwg / NXCD, r = nwg % NXCD, xcd = wgid % NXCD, off = wgid / NXCD; wgid = (xcd < r ? xcd * (q + 1) : r * (q + 1) + (xcd - r) * q) + off; }
        const int nig = WGM * nN, gid = wgid / nig, fm = gid * WGM, gsz = (nM - fm) < WGM ? (nM - fm) : WGM;
        u.pm = fm + ((wgid % nig) % gsz); u.pn = (wgid % nig) / gsz; u.aux = 0;
        u.A = A + (size_t)u.pm * BM * K * 2; u.B = Bt + (size_t)u.pn * BM * K * 2; return true;
    }
    __device__ __forceinline__ unsigned arow(const Unit&, int r) const { return (unsigned)(r * K) * 2u; }
};

template <class Epi, class Sched, bool ALIGN_EPI>
__device__ __forceinline__ void gemm_phase(LAS unsigned char* lds, const int K, const Sched& S, const Epi& E) {
    const int tid = threadIdx.x, wid = __builtin_amdgcn_readfirstlane(tid >> 6), lane = tid & 63, wr = wid >> 2, wc = wid & 3, fr = lane & 15, fq = lane >> 4;
    const int nt = K / BK;
    int RA[2], CA[2]; unsigned voffB[2];
#pragma unroll
    for (int i = 0; i < 2; ++i) { int R, C; stage_rc(tid * 16 + i * 8192, R, C); const int Rb = Epi::PERM ? ((R & ~31) + perm32(R & 31)) : R;
        RA[i] = R; CA[i] = C; voffB[i] = (unsigned)(Rb * K + C) * 2u; }
    const size_t kstep = (size_t)(BK * 2);
    const size_t hstep = (size_t)HALF * K * 2;
    const unsigned ldsw = (unsigned)wid * 1024u;
    const int aoff = lds_byte(wr * 64 + fr, fq * 8), boff = lds_byte(wc * 32 + fr, fq * 8);
#define PG8_SA(b, h) (((b) * 2 + (h)) * HTB)
#define PG8_SB(b, h) ((4 + (b) * 2 + (h)) * HTB)
#define PG8_STAGE(bufoff, gbase, voff) do { _Pragma("unroll") for (int _i = 0; _i < 2; ++_i) \
        __builtin_amdgcn_global_load_lds((const unsigned*)((const char*)(gbase) + (voff)[_i]), (LAS unsigned*)(lds + (bufoff) + ldsw + _i * 8192), 16, 0, 0); } while (0)
#define PG8_LDA(dst, b, h) do { _Pragma("unroll") for (int m = 0; m < 4; ++m) _Pragma("unroll") for (int k = 0; k < 2; ++k) dst[m][k] = *(const LAS bf16x8*)(lds + PG8_SA(b, h) + aoff + m * 2048 + k * 1024); } while (0)
#define PG8_LDB(dst, b, h) do { _Pragma("unroll") for (int n = 0; n < 2; ++n) _Pragma("unroll") for (int k = 0; k < 2; ++k) dst[n][k] = *(const LAS bf16x8*)(lds + PG8_SB(b, h) + boff + n * 2048 + k * 1024); } while (0)
#define PG8_MMA(ai, bj, At, Bt) do { __builtin_amdgcn_s_setprio(1); _Pragma("unroll") for (int m = 0; m < 4; ++m) _Pragma("unroll") for (int n = 0; n < 2; ++n) _Pragma("unroll") for (int k = 0; k < 2; ++k) \
        acc[ai][bj][m][n] = __builtin_amdgcn_mfma_f32_16x16x32_bf16(Bt[n][k], At[m][k], acc[ai][bj][m][n], 0, 0, 0); __builtin_amdgcn_s_setprio(0); } while (0)
#define PG8_WAIT_V(n) asm volatile("s_waitcnt vmcnt(" #n ")" ::: "memory")
#define PG8_WAIT_L(n) asm volatile("s_waitcnt lgkmcnt(" #n ")" ::: "memory")
#define PG8_BAR __builtin_amdgcn_s_barrier()
#define PG8_SCHED __builtin_amdgcn_sched_barrier(0)
    Unit cur, nxt; int ui = 0;
    if (!S.next(0, cur)) return;
    f32x4 acc[2][2][4][2];
#pragma unroll
    for (int a = 0; a < 2; ++a)
#pragma unroll
        for (int b = 0; b < 2; ++b)
#pragma unroll
            for (int m = 0; m < 4; ++m)
#pragma unroll
                for (int n = 0; n < 2; ++n) acc[a][b][m][n] = (f32x4){0.f, 0.f, 0.f, 0.f};
    bf16x8 At[4][2], B0[2][2], B1[2][2];
    unsigned vA0[2], vA1[2], nA0[2], nA1[2];
#pragma unroll
    for (int i = 0; i < 2; ++i) { vA0[i] = S.arow(cur, RA[i]) + CA[i] * 2u; vA1[i] = S.arow(cur, HALF + RA[i]) + CA[i] * 2u; nA0[i] = vA0[i]; nA1[i] = vA1[i]; }
    const char* cA = cur.A; const char* cB = cur.B;
    PG8_STAGE(PG8_SB(0, 0), cB, voffB); PG8_STAGE(PG8_SB(0, 1), cB + hstep, voffB); PG8_STAGE(PG8_SA(0, 0), cA, vA0); PG8_STAGE(PG8_SA(0, 1), cA, vA1);
    if (wr == 1) PG8_BAR;
    PG8_WAIT_V(2); PG8_BAR;
    PG8_STAGE(PG8_SB(1, 0), cB + kstep, voffB); PG8_STAGE(PG8_SA(1, 0), cA + kstep, vA0); PG8_STAGE(PG8_SB(1, 1), cB + hstep + kstep, voffB);
    PG8_WAIT_V(6); PG8_BAR;
    for (;;) {
        const bool has_next = S.next(ui + 1, nxt);
        const char* nA = has_next ? nxt.A : cA; const char* nB = has_next ? nxt.B : cB;
        if (has_next) {
#pragma unroll
            for (int i = 0; i < 2; ++i) { nA0[i] = S.arow(nxt, RA[i]) + CA[i] * 2u; nA1[i] = S.arow(nxt, HALF + RA[i]) + CA[i] * 2u; }
        }
        for (int t = 0; t < nt; t += 2) {
            const bool last = (t == nt - 2);
            const char* a1 = cA + (size_t)(t + 1) * kstep;
            const char* a2 = last ? nA : cA + (size_t)(t + 2) * kstep; const char* b2 = last ? nB : cB + (size_t)(t + 2) * kstep;
            const char* a3 = a2 + kstep; const char* b3 = b2 + kstep;
            unsigned w0[2], w1[2];
#pragma unroll
            for (int i = 0; i < 2; ++i) { w0[i] = last ? nA0[i] : vA0[i]; w1[i] = last ? nA1[i] : vA1[i]; }
            PG8_LDB(B0, 0, 0); PG8_LDB(B1, 0, 1); PG8_SCHED; PG8_LDA(At, 0, 0); PG8_STAGE(PG8_SA(1, 1), a1, vA1);
            PG8_WAIT_V(8); PG8_WAIT_L(0); PG8_BAR; PG8_MMA(0, 0, At, B0); PG8_MMA(0, 1, At, B1); PG8_BAR; PG8_SCHED;
            PG8_LDA(At, 0, 1); PG8_STAGE(PG8_SB(0, 0), b2, voffB); PG8_STAGE(PG8_SB(0, 1), b2 + hstep, voffB); PG8_STAGE(PG8_SA(0, 0), a2, w0);
            PG8_WAIT_V(8); PG8_WAIT_L(0); PG8_BAR; PG8_MMA(1, 0, At, B0); PG8_MMA(1, 1, At, B1); PG8_BAR; PG8_SCHED;
            PG8_LDB(B0, 1, 0); PG8_LDB(B1, 1, 1); PG8_SCHED; PG8_LDA(At, 1, 0); PG8_STAGE(PG8_SA(0, 1), a2, w1);
            PG8_WAIT_V(8); PG8_WAIT_L(0); PG8_BAR; PG8_MMA(0, 0, At, B0); PG8_MMA(0, 1, At, B1); PG8_BAR; PG8_SCHED;
            PG8_LDA(At, 1, 1); PG8_STAGE(PG8_SB(1, 0), b3, voffB); PG8_STAGE(PG8_SB(1, 1), b3 + hstep, voffB); PG8_STAGE(PG8_SA(1, 0), a3, w0);
            PG8_WAIT_V(8); PG8_WAIT_L(0); PG8_BAR; PG8_MMA(1, 0, At, B0); PG8_MMA(1, 1, At, B1); PG8_BAR; PG8_SCHED;
        }
        if constexpr (ALIGN_EPI) { if (wr == 0) PG8_BAR; }
        E(acc, cur, wr, wc, fr, fq);
        if (!has_next) break;
#pragma unroll
        for (int a = 0; a < 2; ++a)
#pragma unroll
            for (int b = 0; b < 2; ++b)
#pragma unroll
                for (int m = 0; m < 4; ++m)
#pragma unroll
                    for (int n = 0; n < 2; ++n) acc[a][b][m][n] = (f32x4){0.f, 0.f, 0.f, 0.f};
        cur = nxt; cA = nA; cB = nB; ++ui;
#pragma unroll
        for (int i = 0; i < 2; ++i) { vA0[i] = nA0[i]; vA1[i] = nA1[i]; }
        if constexpr (ALIGN_EPI) { if (wr == 1) PG8_BAR; }
    }
    PG8_WAIT_V(0);
    if constexpr (!ALIGN_EPI) { if (wr == 0) PG8_BAR; }
    PG8_BAR;
#undef PG8_SA
#undef PG8_SB
#undef PG8_STAGE
#undef PG8_LDA
#undef PG8_LDB
#undef PG8_MMA
#undef PG8_WAIT_V
#undef PG8_WAIT_L
#undef PG8_BAR
#undef PG8_SCHED
}

struct EpiBf16 {
    static constexpr bool PERM = true;
    bf16* O; int ldc;
    __device__ __forceinline__ void operator()(const f32x4 (&acc)[2][2][4][2], const Unit& u, int wr, int wc, int fr, int fq) const {
        const int row0 = u.pm * BM + wr * 64 + fr; const int col0 = u.pn * BM + wc * 32 + 8 * fq;
#pragma unroll
        for (int ai = 0; ai < 2; ++ai)
#pragma unroll
            for (int m = 0; m < 4; ++m) { bf16* rowp = O + (size_t)(row0 + ai * HALF + m * 16) * ldc + col0;
#pragma unroll
                for (int bj = 0; bj < 2; ++bj) { const f32x4 v0 = acc[ai][bj][m][0], v1 = acc[ai][bj][m][1];
                    u32x4 w; w.x = cvt_pk_bf16(v0[0], v0[1]); w.y = cvt_pk_bf16(v0[2], v0[3]); w.z = cvt_pk_bf16(v1[0], v1[1]); w.w = cvt_pk_bf16(v1[2], v1[3]);
                    *(u32x4*)(rowp + bj * HALF) = w; } }
    }
};
struct EpiResF32 {
    static constexpr bool PERM = false;
    const float* base; float* out; int ldc;
    __device__ __forceinline__ void operator()(const f32x4 (&acc)[2][2][4][2], const Unit& u, int wr, int wc, int fr, int fq) const {
        const int row0 = u.pm * BM + wr * 64 + fr, col0 = u.pn * BM + wc * 32 + 4 * fq;
#pragma unroll
        for (int ai = 0; ai < 2; ++ai)
#pragma unroll
            for (int m = 0; m < 4; ++m) { const size_t off = (size_t)(row0 + ai * HALF + m * 16) * ldc + col0;
#pragma unroll
                for (int bj = 0; bj < 2; ++bj)
#pragma unroll
                    for (int n = 0; n < 2; ++n) { const f32x4 bs = *(const f32x4*)(base + off + bj * HALF + n * 16); *(f32x4*)(out + off + bj * HALF + n * 16) = bs + acc[ai][bj][m][n]; } }
    }
};

struct EpiResXB {
    static constexpr bool PERM = true;
    const float* srcf; const bf16* srcb; bf16* xb;
    __device__ __forceinline__ void operator()(const f32x4 (&acc)[2][2][4][2], const Unit& u, int wr, int wc, int fr, int fq) const {
        const int row0 = u.pm * BM + wr * 64 + fr, col0 = u.pn * BM + wc * 32 + 8 * fq;
#pragma unroll
        for (int ai = 0; ai < 2; ++ai)
#pragma unroll
            for (int m = 0; m < 4; ++m) { const size_t off = (size_t)(row0 + ai * HALF + m * 16) * DM + col0;
#pragma unroll
                for (int bj = 0; bj < 2; ++bj) { f32x4 a0, a1;
                    if (srcf) { a0 = *(const f32x4*)(srcf + off + bj * HALF); a1 = *(const f32x4*)(srcf + off + bj * HALF + 4); }
                    else { const u32x4 v = *(const u32x4*)(srcb + off + bj * HALF); a0 = (f32x4){bflo(v.x), bfhi(v.x), bflo(v.y), bfhi(v.y)}; a1 = (f32x4){bflo(v.z), bfhi(v.z), bflo(v.w), bfhi(v.w)}; }
                    a0 += acc[ai][bj][m][0]; a1 += acc[ai][bj][m][1];
                    *(u32x4*)(xb + off + bj * HALF) = (u32x4){pk2(a0[0], a0[1]), pk2(a0[2], a0[3]), pk2(a1[0], a1[1]), pk2(a1[2], a1[3])}; } }
    }
};

struct MoeOrder {
    const char* Abase; const char* Bbase; size_t bstride; int K, G, c, tile_lo, tile_hi; const LAS int* ptile; const LAS int* cntv; const int* list; bool gather;
    __device__ __forceinline__ bool next(int i, Unit& u) const {
        const int NT = tile_hi - tile_lo; int tile, pn;
        if ((G & 7) == 0 && G >= 32) {
            const int x = c & 7, sl = c >> 3, per = G >> 3, TPX = (NT + 7) >> 3;
            const int lu = i * per + sl, lt = lu >> 2; pn = lu & 3;
            tile = tile_lo + x * TPX + lt;
            if (lt >= TPX || tile >= tile_hi) return false;
        } else {
            const long Lq = (long)i * G + c; if (Lq >= (long)NT * 4) return false;
            tile = tile_lo + (int)(Lq >> 2); pn = (int)(Lq & 3);
        }
        int e = 0;
#pragma unroll
        for (int st = 32; st >= 1; st >>= 1) { const int k = e + st; if (k < 64 && tile >= __builtin_amdgcn_readfirstlane(ptile[k])) e = k; }
        const int j = tile - __builtin_amdgcn_readfirstlane(ptile[e]);
        u.pm = tile; u.pn = pn; u.aux = e | (j << 6);
        u.A = gather ? Abase : Abase + (size_t)tile * BM * K * 2; u.B = Bbase + (size_t)(e & 31) * bstride + (size_t)pn * BM * K * 2; return true;
    }
    __device__ __forceinline__ unsigned arow(const Unit& u, int r) const {
        if (!gather) return (unsigned)(r * K) * 2u;
        const int e = u.aux & 63, pos = (u.aux >> 6) * 256 + r; const int cn = cntv[e];
        const int tok = pos < cn ? list[(size_t)e * 65536 + pos] : 0;
        return (unsigned)tok * (unsigned)(K * 2);
    }
};
struct EpiSwiGLU {
    static constexpr bool PERM = true;
    bf16* H;
    __device__ __forceinline__ void operator()(const f32x4 (&acc)[2][2][4][2], const Unit& u, int wr, int wc, int fr, int fq) const {
        const int row0 = u.pm * BM + wr * 64 + fr; const int col0 = u.pn * 128 + wc * 32 + 8 * fq;
#pragma unroll
        for (int ai = 0; ai < 2; ++ai)
#pragma unroll
            for (int m = 0; m < 4; ++m) { bf16* rowp = H + (size_t)(row0 + ai * HALF + m * 16) * 512 + col0;
                const f32x4 g0 = acc[ai][0][m][0], g1 = acc[ai][0][m][1], u0 = acc[ai][1][m][0], u1 = acc[ai][1][m][1];
                float h[8];
#pragma unroll
                for (int q = 0; q < 4; ++q) { h[q] = g0[q] * __builtin_amdgcn_rcpf(1.f + __builtin_amdgcn_exp2f(-1.44269504f * g0[q])) * u0[q]; h[4 + q] = g1[q] * __builtin_amdgcn_rcpf(1.f + __builtin_amdgcn_exp2f(-1.44269504f * g1[q])) * u1[q]; }
                u32x4 w; w.x = cvt_pk_bf16(h[0], h[1]); w.y = cvt_pk_bf16(h[2], h[3]); w.z = cvt_pk_bf16(h[4], h[5]); w.w = cvt_pk_bf16(h[6], h[7]);
                *(u32x4*)rowp = w; }
    }
};
template <bool FINAL> struct EpiScatter {
    static constexpr bool PERM = true;
    bf16* xb; float* out; const int* list; const float* wl; const LAS int* cntv;
    __device__ __forceinline__ void operator()(const f32x4 (&acc)[2][2][4][2], const Unit& u, int wr, int wc, int fr, int fq) const {
        const int e = u.aux & 63, j = u.aux >> 6; const int cn = cntv[e];
        const int col0 = u.pn * BM + wc * 32 + 8 * fq;
#pragma unroll
        for (int ai = 0; ai < 2; ++ai)
#pragma unroll
            for (int m = 0; m < 4; ++m) { const int pos = j * 256 + ai * HALF + wr * 64 + m * 16 + fr;
                if (pos < cn) { const int tok = list[(size_t)e * 65536 + pos]; const float wg = wl[(size_t)e * 65536 + pos];
                    const size_t off = (size_t)tok * DM + col0;
#pragma unroll
                    for (int bj = 0; bj < 2; ++bj) { const u32x4 v = *(const u32x4*)(xb + off + bj * HALF);
                        const f32x4 a0 = (f32x4){bflo(v.x), bfhi(v.x), bflo(v.y), bfhi(v.y)} + wg * acc[ai][bj][m][0], a1 = (f32x4){bflo(v.z), bfhi(v.z), bflo(v.w), bfhi(v.w)} + wg * acc[ai][bj][m][1];
                        if (FINAL) { *(f32x4*)(out + off + bj * HALF) = a0; *(f32x4*)(out + off + bj * HALF + 4) = a1; }
                        else *(u32x4*)(xb + off + bj * HALF) = (u32x4){pk2(a0[0], a0[1]), pk2(a0[2], a0[3]), pk2(a1[0], a1[1]), pk2(a1[2], a1[3])}; } } }
    }
};
}

struct Frame {
    LAS unsigned char* lds;
    volatile LAS unsigned* MISC;
    gu32* ctl;
    int tid, lane, wave, G, bid;
    float* out; unsigned char* ws;
};
struct Args { const float* in[31]; float* out; unsigned char* ws; int ph_lo, ph_hi, rep, pad; };
#ifndef REP_PART
#define REP_PART 0
#endif
#ifndef REP_PHASE
#define REP_PHASE -1
#endif
#define NREP(k) ((REP_PHASE == (k)) ? args.rep : 1)
__device__ __forceinline__ float wave_sum(float v) {
#pragma unroll
    for (int o = 1; o < 64; o <<= 1) v += __shfl_xor(v, o);
    return v;
}

template <class Map>
__device__ __forceinline__ void transpose_item(const float* W, int K, int pitch, int col0, int ncols, bf16* WT, LAS float* scr, int item, int lane, Map dmap) {
    const int nblk = (ncols + 31) / 32, kb = item / nblk, nb = item % nblk, k0 = 64 * kb, n0 = 32 * nb;
    const int nn = n0 + (lane & 31);
#pragma unroll 8
    for (int i = 0; i < 32; ++i) { const int kk = 2 * i + (lane >> 5); scr[kk * 33 + (lane & 31)] = (nn < ncols) ? W[(size_t)(k0 + kk) * pitch + col0 + nn] : 0.f; }
    LDS_WAIT(); asm volatile("" ::: "memory");
    const int c = lane & 7;
#pragma unroll
    for (int j = 0; j < 4; ++j) { const int n = (lane >> 3) + 8 * j; const LAS float* s = scr + (8 * c) * 33 + n;
        u32x4 o; o.x = pk2(s[0 * 33], s[1 * 33]); o.y = pk2(s[2 * 33], s[3 * 33]); o.z = pk2(s[4 * 33], s[5 * 33]); o.w = pk2(s[6 * 33], s[7 * 33]);
        if (n0 + n < ncols) *(u32x4*)(WT + (size_t)dmap(n0 + n) * K + k0 + 8 * c) = o; }
    LDS_WAIT(); asm volatile("" ::: "memory");
}
struct MapId { int off; __device__ int operator()(int n) const { return n + off; } };
struct MapEven { __device__ int operator()(int c) const {
    if (c < 1536) return c; if (c < 1544) return EDT + (c - 1536); if (c < 2056) return EQ + (c - 1544); if (c < 2120) return EK + (c - 2056);
    if (c < 2184) return EV + (c - 2120); if (c < 2440) return EIQ + (c - 2184); if (c < 2504) return EIK + (c - 2440); return EIW + (c - 2504); } };
struct MapGU { int half; __device__ int operator()(int n) const { return 256 * (n >> 7) + 128 * half + (n & 127); } };

__device__ __forceinline__ void rms_row_to_bf16(const float* xrow, const float* gain, bf16* orow, int lane) {
    const f32x4* xr = (const f32x4*)xrow + lane; const f32x4* gr = (const f32x4*)gain + lane;
    f32x4 v[4]; float s = 0.f;
#pragma unroll
    for (int j = 0; j < 4; ++j) { v[j] = xr[64 * j]; s += (v[j].x * v[j].x + v[j].y * v[j].y) + (v[j].z * v[j].z + v[j].w * v[j].w); }
    const float rs = 1.f / sqrtf(wave_sum(s) * (1.f / DM) + NORM_EPS);
    unsigned long long* o8 = (unsigned long long*)orow + lane;
#pragma unroll
    for (int j = 0; j < 4; ++j) { const f32x4 g = gr[64 * j]; o8[64 * j] = (unsigned long long)pk2(v[j].x * rs * g.x, v[j].y * rs * g.y) | ((unsigned long long)pk2(v[j].z * rs * g.z, v[j].w * rs * g.w) << 32); }
}

__device__ __forceinline__ void rms_rowb_to_bf16(const bf16* xrow, const float* gain, bf16* orow, int lane) {
    const u32x2* xr = (const u32x2*)xrow + lane; const f32x4* gr = (const f32x4*)gain + lane;
    f32x4 v[4]; float s = 0.f;
#pragma unroll
    for (int j = 0; j < 4; ++j) { const u32x2 q = xr[64 * j]; v[j] = (f32x4){bflo(q.x), bfhi(q.x), bflo(q.y), bfhi(q.y)}; s += (v[j].x * v[j].x + v[j].y * v[j].y) + (v[j].z * v[j].z + v[j].w * v[j].w); }
    const float rs = 1.f / sqrtf(wave_sum(s) * (1.f / DM) + NORM_EPS);
    unsigned long long* o8 = (unsigned long long*)orow + lane;
#pragma unroll
    for (int j = 0; j < 4; ++j) { const f32x4 g = gr[64 * j]; o8[64 * j] = (unsigned long long)pk2(v[j].x * rs * g.x, v[j].y * rs * g.y) | ((unsigned long long)pk2(v[j].z * rs * g.z, v[j].w * rs * g.w) << 32); }
}
__device__ __forceinline__ void p_prologue(Frame& F, const Args& A) {
    LAS float* scr = (LAS float*)(F.lds + F.wave * 16384);
    const int gw = F.bid * NWAVES + F.wave, NGW = F.G * NWAVES;
    bf16* Wie = (bf16*)(F.ws + WS_WIE); bf16* Woe = (bf16*)(F.ws + WS_WOE);
    constexpr int I_IE = 16 * 79, I_OE = 16 * 32;
    for (int it = gw; it < I_IE + I_OE; it += NGW) {
        if (it < I_IE) transpose_item(A.in[4], 1024, 2508, 0, 2508, Wie, scr, it, F.lane, MapEven());
        else transpose_item(A.in[13], 1024, 1024, 0, 1024, Woe, scr, it - I_IE, F.lane, MapId{0});
    }
    {
        bf16* Wgu = (bf16*)(F.ws + WS_WGU); bf16* Wd = (bf16*)(F.ws + WS_WD); bf16* WR = (bf16*)(F.ws + WS_WR);
        for (int it = gw; it < 64 * 768; it += NGW) { const int le = it / 768, r = it % 768;
            if (r < 256) transpose_item(A.in[28] + (size_t)le * 1024 * 512, 1024, 512, 0, 512, Wgu + (size_t)le * 1024 * 1024, scr, r, F.lane, MapGU{0});
            else if (r < 512) transpose_item(A.in[29] + (size_t)le * 1024 * 512, 1024, 512, 0, 512, Wgu + (size_t)le * 1024 * 1024, scr, r - 256, F.lane, MapGU{1});
            else transpose_item(A.in[30] + (size_t)le * 512 * 1024, 512, 1024, 0, 1024, Wd + (size_t)le * 1024 * 512, scr, r - 512, F.lane, MapId{0}); }
        for (int it = gw; it < 2 * 5 * 16; it += NGW) { const int l = it / 80, r = it % 80, q = r / 16, kb = r % 16;
            if (q == 0) transpose_item(A.in[26] + (size_t)l * 1024 * 4, 1024, 4, 0, 4, WR + (size_t)l * 48 * 1024, scr, kb, F.lane, MapId{0});
            else transpose_item(A.in[27] + (size_t)(l * 4 + q - 1) * 1024 * 8, 1024, 8, 0, 8, WR + (size_t)l * 48 * 1024, scr, kb, F.lane, MapId{4 + 8 * (q - 1)}); }
        for (int i = gw * 64 + F.lane; i < 2 * 12 * 1024 / 8; i += NGW * 64) { const int l = i / (12 * 128), o = i % (12 * 128); *(u32x4*)(WR + (size_t)l * 48 * 1024 + 36 * 1024 + (size_t)o * 8) = (u32x4){0u, 0u, 0u, 0u}; }
    }
    {
        bf16* Wio = (bf16*)(F.ws + WS_WIO); bf16* Woo = (bf16*)(F.ws + WS_WOO); bf16* WGL = (bf16*)(F.ws + WS_WGL);
        bf16* W1K = (bf16*)(F.ws + WS_W1K); bf16* W1V = (bf16*)(F.ws + WS_W1V); bf16* W2 = (bf16*)(F.ws + WS_W2);
        constexpr int J0 = 16 * 80, J1 = J0 + 16, J2 = J1 + 16 * 32, J3 = J2 + 64 * 4, J4 = J3 + 64 * 4, J5 = J4 + 2 * 4, J6 = J5 + 2 * 4;
        for (int it = gw; it < J6; it += NGW) {
            if (it < J0) transpose_item(A.in[14], 1024, 2584, 0, 2560, Wio, scr, it, F.lane, MapId{0});
            else if (it < J1) transpose_item(A.in[14], 1024, 2584, 2560, 24, WGL, scr, it - J0, F.lane, MapId{0});
            else if (it < J2) transpose_item(A.in[25], 1024, 1024, 0, 1024, Woo, scr, it - J1, F.lane, MapId{0});
            else if (it < J3) transpose_item(A.in[21], 4096, 128, 0, 128, W1K, scr, it - J2, F.lane, MapId{0});
            else if (it < J4) transpose_item(A.in[23], 4096, 128, 0, 128, W1V, scr, it - J3, F.lane, MapId{0});
            else if (it < J5) transpose_item(A.in[22], 128, 128, 0, 128, W2, scr, it - J4, F.lane, MapId{0});
            else transpose_item(A.in[24], 128, 128, 0, 128, W2 + 128 * 128, scr, it - J5, F.lane, MapId{0});
        }
        for (int i = gw * 64 + F.lane; i < 8 * 1024 / 8; i += NGW * 64) *(u32x4*)(WGL + 24 * 1024 + (size_t)i * 8) = (u32x4){0u, 0u, 0u, 0u};
    }
    for (int i = gw * 64 + F.lane; i < 52 * 1024 / 8; i += NGW * 64) *(u32x4*)(Wie + (size_t)2508 * 1024 + (size_t)i * 8) = (u32x4){0u, 0u, 0u, 0u};
    bf16* HB = (bf16*)(F.ws + WS_HB);
    for (int m = gw; m < MTOK; m += NGW) rms_row_to_bf16(A.in[0] + (size_t)m * DM, A.in[2], HB + (size_t)m * DM, F.lane);
}

constexpr int SP = 136;
constexpr int L_CS = 0, L_BS = 34816, L_BT = 69632, L_XT = 104448, L_XS = 113152, L_ST = 121856, L_AC = 139264, L_DT = 139776, L_CW = 140288;
__device__ __forceinline__ bf16x8 lds_frag(LAS unsigned char* base, int row, int col) { return *(const LAS bf16x8*)(base + (row * SP + col) * 2); }

__device__ __forceinline__ void p_ssd(Frame& F, const Args& A) {
    bf16* U = (bf16*)(F.ws + WS_U);
    const int w = F.wave;
    { const int tid = F.tid;
    for (int r0 = F.bid * 64; r0 < MTOK; r0 += F.G * 64) {
        const int row = r0 + (tid >> 3), c8 = (tid & 7) * 8;
        bf16* p = U + (size_t)row * LDE + EK + c8;
        const u32x4 v = *(const u32x4*)p; float f[8] = {bflo(v.x), bfhi(v.x), bflo(v.y), bfhi(v.y), bflo(v.z), bfhi(v.z), bflo(v.w), bfhi(v.w)};
        float s = 0.f;
#pragma unroll
        for (int j = 0; j < 8; ++j) s += f[j] * f[j];
        s += __shfl_xor(s, 1); s += __shfl_xor(s, 2); s += __shfl_xor(s, 4);
        const float rs = 1.f / sqrtf(s * (1.f / 64.f) + NORM_EPS); const float* g = A.in[12] + c8;
        u32x4 o; o.x = pk2(f[0] * rs * g[0], f[1] * rs * g[1]); o.y = pk2(f[2] * rs * g[2], f[3] * rs * g[3]); o.z = pk2(f[4] * rs * g[4], f[5] * rs * g[5]); o.w = pk2(f[6] * rs * g[6], f[7] * rs * g[7]);
        *(u32x4*)p = o;
    } }
    LAS unsigned char* L = F.lds;
    LAS float* acum = (LAS float*)(L + L_AC); LAS float* dtv = (LAS float*)(L + L_DT); LAS float* cw = (LAS float*)(L + L_CW);
    const float* conv_w = A.in[5]; const float* conv_b = A.in[6];
    for (int st = F.bid; st < 256; st += F.G) {
        const int b = st >> 4, h = (st >> 1) & 7, ph = st & 1, g = h >> 2;
        { const int tid = F.tid;
        __syncthreads();
        for (int i = tid; i < 5 * 288; i += NTHR) { const int j = i / 288, lc = i % 288;
            const int ch = lc < 128 ? 512 + g * 128 + lc : (lc < 256 ? 768 + g * 128 + (lc - 128) : h * 64 + ph * 32 + (lc - 256));
            cw[i] = j < 4 ? conv_w[j * 1024 + ch] : conv_b[ch]; }
        for (int i = tid; i < 2 * 32 * SP / 2; i += NTHR) ((LAS unsigned*)(L + L_ST))[i] = 0u; }
        const float a_h = -__expf(A.in[8][h]), dtb = A.in[7][h], dsk = A.in[9][h];
        f32x16 state = {0.f, 0.f, 0.f, 0.f, 0.f, 0.f, 0.f, 0.f, 0.f, 0.f, 0.f, 0.f, 0.f, 0.f, 0.f, 0.f};
        __syncthreads();
        u32x4 rawB[7], rawC[7], rawX[4]; unsigned rawdt = 0u; unsigned rawz[16];
#define SSD_FETCH_BCX(cc) do { const size_t _rb = (size_t)b * SEQ + (size_t)(cc) * 128; const int _cg = tid & 15, _rr = tid >> 4; \
            _Pragma("unroll") for (int j = 0; j < 7; ++j) { const int tl = 4 * _rr - 3 + j; rawB[j] = (u32x4){0u, 0u, 0u, 0u}; rawC[j] = (u32x4){0u, 0u, 0u, 0u}; \
                if ((cc) > 0 || tl >= 0) { const bf16* _p = U + (size_t)((long)_rb + tl) * LDE + g * 128 + 8 * _cg; rawB[j] = *(const u32x4*)(_p + EBB); rawC[j] = *(const u32x4*)(_p + ECC); } } \
            const int _cx = tid & 3, _t = tid >> 2; \
            _Pragma("unroll") for (int j = 0; j < 4; ++j) { const int tl = _t - 3 + j; rawX[j] = (u32x4){0u, 0u, 0u, 0u}; \
                if ((cc) > 0 || tl >= 0) rawX[j] = *(const u32x4*)(U + (size_t)((long)_rb + tl) * LDE + EXS + h * 64 + ph * 32 + 8 * _cx); } \
            if (tid < 128) rawdt = U[(_rb + tid) * LDE + EDT + h]; } while (0)
#define SSD_FETCH_Z(cc) do { if (w < 4) { const size_t _rb = (size_t)b * SEQ + (size_t)(cc) * 128; \
            _Pragma("unroll") for (int i = 0; i < 16; ++i) rawz[i] = U[(_rb + 32 * w + 8 * (i >> 2) + 4 * (lane >> 5) + (i & 3)) * LDE + EZ + h * 64 + ph * 32 + (lane & 31)]; } } while (0)
        { int tid = F.tid, lane = F.lane; asm volatile("" : "+v"(tid), "+v"(lane)); SSD_FETCH_BCX(0); SSD_FETCH_Z(0); }
        for (int c = 0; c < 32; ++c) {
            const size_t rowbase = (size_t)b * SEQ + (size_t)c * 128;
            int tid = F.tid, lane = F.lane; asm volatile("" : "+v"(tid), "+v"(lane));
            if (tid < 128) {
                const float dr = bf2f((unsigned short)rawdt) + dtb;
                const float dt = dr > 20.f ? dr : log1pf(__expf(dr));
                float s = dt * a_h;
#pragma unroll
                for (int o = 1; o < 64; o <<= 1) { const float t = __shfl_up(s, o); if (lane >= o) s += t; }
                dtv[tid] = dt; acum[tid] = s;
            }
            {
                const int cg = tid & 15, rr = tid >> 4;
#pragma unroll
                for (int T = 0; T < 2; ++T) {
                    u32x4 raw[7];
#pragma unroll
                    for (int j = 0; j < 7; ++j) raw[j] = T == 0 ? rawB[j] : rawC[j];
                    LAS unsigned char* dst = L + (T == 0 ? L_BS : L_CS);
                    unsigned opk[4][4];
#pragma unroll
                    for (int e2 = 0; e2 < 4; ++e2) {
                        const int lc = T * 128 + 8 * cg + 2 * e2;
                        const f32x2 w0 = *(const LAS f32x2*)(cw + lc), w1 = *(const LAS f32x2*)(cw + 288 + lc), w2 = *(const LAS f32x2*)(cw + 576 + lc), w3 = *(const LAS f32x2*)(cw + 864 + lc), bb = *(const LAS f32x2*)(cw + 1152 + lc);
                        float lo[7], hi[7];
#pragma unroll
                        for (int j = 0; j < 7; ++j) { lo[j] = bflo(raw[j][e2]); hi[j] = bfhi(raw[j][e2]); }
                        float ol[4], oh[4];
#pragma unroll
                        for (int q = 0; q < 4; ++q) { ol[q] = siluf(bb.x + w0.x * lo[q] + w1.x * lo[q + 1] + w2.x * lo[q + 2] + w3.x * lo[q + 3]);
                                                      oh[q] = siluf(bb.y + w0.y * hi[q] + w1.y * hi[q + 1] + w2.y * hi[q + 2] + w3.y * hi[q + 3]); opk[q][e2] = pk2(ol[q], oh[q]); }
                        if (T == 0) {
                            *(LAS u32x2*)(L + L_BT + ((8 * cg + 2 * e2) * SP + 4 * rr) * 2) = (u32x2){pk2(ol[0], ol[1]), pk2(ol[2], ol[3])};
                            *(LAS u32x2*)(L + L_BT + ((8 * cg + 2 * e2 + 1) * SP + 4 * rr) * 2) = (u32x2){pk2(oh[0], oh[1]), pk2(oh[2], oh[3])};
                        }
                    }
#pragma unroll
                    for (int q = 0; q < 4; ++q) *(LAS u32x4*)(dst + ((4 * rr + q) * SP + 8 * cg) * 2) = (u32x4){opk[q][0], opk[q][1], opk[q][2], opk[q][3]};
                }
            }
            __syncthreads();
            if (tid >= 64 && tid < 128) acum[tid] += acum[63];
            __syncthreads();
            {
                const int cg = tid & 3, t = tid >> 2;
                const int gcol = EXS + h * 64 + ph * 32 + 8 * cg;
                u32x4 raw[4];
#pragma unroll
                for (int j = 0; j < 4; ++j) raw[j] = rawX[j];
                const float sc = dtv[t] * __expf(acum[127] - acum[t]);
#pragma unroll
                for (int e = 0; e < 8; ++e) { const int lc = 256 + 8 * cg + e;
                    float rv[4];
#pragma unroll
                    for (int j = 0; j < 4; ++j) rv[j] = (e & 1) ? bfhi(raw[j][e >> 1]) : bflo(raw[j][e >> 1]);
                    const float xv = siluf(cw[1152 + lc] + cw[lc] * rv[0] + cw[288 + lc] * rv[1] + cw[576 + lc] * rv[2] + cw[864 + lc] * rv[3]);
                    *(LAS bf16*)(L + L_XT + ((8 * cg + e) * SP + t) * 2) = (bf16)f2bfh(xv);
                    *(LAS bf16*)(L + L_XS + ((8 * cg + e) * SP + t) * 2) = (bf16)f2bfh(xv * sc); }
            }
            if (c + 1 < 32) SSD_FETCH_BCX(c + 1);
            const int mt = w >> 1, nh = w & 1, r = lane & 31, hh = lane >> 5;
            f32x16 cb[2];
#pragma unroll
            for (int j = 0; j < 2; ++j) {
                cb[j] = (f32x16){0.f, 0.f, 0.f, 0.f, 0.f, 0.f, 0.f, 0.f, 0.f, 0.f, 0.f, 0.f, 0.f, 0.f, 0.f, 0.f};
                const int s0 = 64 * nh + 32 * j;
                if (s0 <= 32 * mt + 31) {
#pragma unroll
                    for (int ks = 0; ks < 8; ++ks) {
                        const bf16x8 af = lds_frag(L + L_CS, 32 * mt + r, 16 * ks + 8 * hh), bfg = lds_frag(L + L_BS, s0 + r, 16 * ks + 8 * hh);
                        cb[j] = __builtin_amdgcn_mfma_f32_32x32x16_bf16(af, bfg, cb[j], 0, 0, 0);
                    }
                }
            }
            __syncthreads();
#pragma unroll
            for (int j = 0; j < 2; ++j) {
                const int s = 64 * nh + 32 * j + r; const float as = acum[s], ds = dtv[s];
#pragma unroll
                for (int i = 0; i < 16; ++i) { const int t = 32 * mt + 8 * (i >> 2) + 4 * hh + (i & 3);
                    const float v = (s <= t) ? cb[j][i] * __expf(acum[t] - as) * ds : 0.f;
                    *(LAS bf16*)(L + L_BS + (t * SP + s) * 2) = (bf16)f2bfh(v); }
            }
            __syncthreads();
            if (w < 4) {
                f32x16 yd = {0.f, 0.f, 0.f, 0.f, 0.f, 0.f, 0.f, 0.f, 0.f, 0.f, 0.f, 0.f, 0.f, 0.f, 0.f, 0.f}, yo = yd;
                for (int ks = 0; ks < 2 * (w + 1); ++ks) {
                    const bf16x8 af = lds_frag(L + L_BS, 32 * w + r, 16 * ks + 8 * hh), bfg = lds_frag(L + L_XT, r, 16 * ks + 8 * hh);
                    yd = __builtin_amdgcn_mfma_f32_32x32x16_bf16(af, bfg, yd, 0, 0, 0);
                }
                LAS unsigned char* stc = L + L_ST + (c & 1) * (32 * SP * 2);
#pragma unroll
                for (int ks = 0; ks < 8; ++ks) {
                    const bf16x8 af = lds_frag(L + L_CS, 32 * w + r, 16 * ks + 8 * hh), bfg = lds_frag(stc, r, 16 * ks + 8 * hh);
                    yo = __builtin_amdgcn_mfma_f32_32x32x16_bf16(af, bfg, yo, 0, 0, 0);
                }
#pragma unroll
                for (int q = 0; q < 4; ++q) {
                    const int t0 = 32 * w + 8 * q + 4 * hh;
                    const u32x2 xx = *(const LAS u32x2*)(L + L_XT + (r * SP + t0) * 2);
                    const float xv[4] = {bflo(xx.x), bfhi(xx.x), bflo(xx.y), bfhi(xx.y)};
#pragma unroll
                    for (int e = 0; e < 4; ++e) { const int t = t0 + e, i = 4 * q + e;
                        bf16* zp = U + (rowbase + t) * LDE + EZ + h * 64 + ph * 32 + r;
                        const float z = bf2f((unsigned short)rawz[i]);
                        const float y = yd[i] + __expf(acum[t]) * yo[i] + dsk * xv[e];
                        *zp = (bf16)f2bfh(y * siluf(z)); }
                }
                if (c + 1 < 32) SSD_FETCH_Z(c + 1);
            } else {
                const int n0 = 32 * (w - 4); const float dec = __expf(acum[127]);
#pragma unroll
                for (int i = 0; i < 16; ++i) state[i] *= dec;
#pragma unroll
                for (int ks = 0; ks < 8; ++ks) {
                    const bf16x8 af = lds_frag(L + L_XS, r, 16 * ks + 8 * hh), bfg = lds_frag(L + L_BT, n0 + r, 16 * ks + 8 * hh);
                    state = __builtin_amdgcn_mfma_f32_32x32x16_bf16(af, bfg, state, 0, 0, 0);
                }
                LAS unsigned char* stn = L + L_ST + ((c + 1) & 1) * (32 * SP * 2);
#pragma unroll
                for (int i = 0; i < 16; ++i) { const int p = 8 * (i >> 2) + 4 * hh + (i & 3);
                    *(LAS bf16*)(stn + (p * SP + n0 + r) * 2) = (bf16)f2bfh(state[i]); }
            }
            __syncthreads();
        }
    }
}

#undef SSD_FETCH_BCX
#undef SSD_FETCH_Z
typedef short s16x4 __attribute__((ext_vector_type(4)));
__device__ __forceinline__ s16x4 lds_tr16(LAS unsigned char* p) { return __builtin_bit_cast(s16x4, __builtin_amdgcn_ds_read_tr16_b64_v4i16((LAS s16x4*)p)); }
__device__ __forceinline__ int t5_bucket_dev(int d) {
    if (d < 16) return d;
    const int v = 16 + (int)(log((double)d / 16.0) / log(8.0) * 16.0);
    return v < 31 ? v : 31;
}
constexpr int D_SEL = 131072, D_LUT = 135168, D_DMY = 139264, VP = 72;
__device__ __forceinline__ unsigned long long mask_ge(int v, int x) { unsigned long long m; asm("v_cmp_ge_i32_e64 %0, %1, %2" : "=s"(m) : "v"(v), "s"(x)); return m; }
__device__ __forceinline__ unsigned long long mask_gt(int v, int x) { unsigned long long m; asm("v_cmp_gt_i32_e64 %0, %1, %2" : "=s"(m) : "v"(v), "s"(x)); return m; }
__device__ __forceinline__ int count_ge8(int a0, int a1, int a2, int a3, int a4, int a5, int a6, int a7, int x) {
    unsigned long long m0, m1, m2, m3, m4, m5, m6, m7;
    asm("v_cmp_ge_i32_e64 %0, %8, %16\n\tv_cmp_ge_i32_e64 %1, %9, %16\n\tv_cmp_ge_i32_e64 %2, %10, %16\n\tv_cmp_ge_i32_e64 %3, %11, %16\n\t"
        "v_cmp_ge_i32_e64 %4, %12, %16\n\tv_cmp_ge_i32_e64 %5, %13, %16\n\tv_cmp_ge_i32_e64 %6, %14, %16\n\tv_cmp_ge_i32_e64 %7, %15, %16"
        : "=&s"(m0), "=&s"(m1), "=&s"(m2), "=&s"(m3), "=&s"(m4), "=&s"(m5), "=&s"(m6), "=&s"(m7)
        : "v"(a0), "v"(a1), "v"(a2), "v"(a3), "v"(a4), "v"(a5), "v"(a6), "v"(a7), "s"(x));
    return (__popcll(m0) + __popcll(m1)) + (__popcll(m2) + __popcll(m3)) + ((__popcll(m4) + __popcll(m5)) + (__popcll(m6) + __popcll(m7)));
}
__device__ __forceinline__ void masks_ge8(int a0, int a1, int a2, int a3, int a4, int a5, int a6, int a7, int x, unsigned long long (&m)[8]) {
    asm("v_cmp_ge_i32_e64 %0, %8, %16\n\tv_cmp_ge_i32_e64 %1, %9, %16\n\tv_cmp_ge_i32_e64 %2, %10, %16\n\tv_cmp_ge_i32_e64 %3, %11, %16\n\t"
        "v_cmp_ge_i32_e64 %4, %12, %16\n\tv_cmp_ge_i32_e64 %5, %13, %16\n\tv_cmp_ge_i32_e64 %6, %14, %16\n\tv_cmp_ge_i32_e64 %7, %15, %16"
        : "=&s"(m[0]), "=&s"(m[1]), "=&s"(m[2]), "=&s"(m[3]), "=&s"(m[4]), "=&s"(m[5]), "=&s"(m[6]), "=&s"(m[7])
        : "v"(a0), "v"(a1), "v"(a2), "v"(a3), "v"(a4), "v"(a5), "v"(a6), "v"(a7), "s"(x));
}
__device__ __forceinline__ int sel_mask(int a, int b, unsigned long long m) { int r; asm("v_cndmask_b32_e64 %0, %1, %2, %3" : "=v"(r) : "v"(a), "v"(b), "s"(m)); return r; }
__device__ __forceinline__ int okey(float f) { const int iv = __builtin_bit_cast(int, f); return iv ^ ((iv >> 31) & 0x7fffffff); }

__device__ __forceinline__ void p_dsa(Frame& F, const Args& A) {
    bf16* U = (bf16*)(F.ws + WS_U); bf16* HB = (bf16*)(F.ws + WS_HB);
    const int w = F.wave;
    const float* ng = A.in[10];
    LAS unsigned char* L = F.lds;
    LAS float* LUT = (LAS float*)(L + D_LUT);
    for (int i = F.tid; i < 1024; i += NTHR) LUT[i] = A.in[1][t5_bucket_dev(i >> 3) * 8 + (i & 7)];
    __syncthreads();
    for (int blk = F.bid; blk < MTOK / 8; blk += F.G) {
        int lane = F.lane; asm volatile("" : "+v"(lane));
        const int kr = blk >> 8, cc = blk & 255, b = kr >> 1, tb = (kr & 1) ? 511 - cc : cc, t0 = tb * 8;
        const size_t bat = (size_t)b * SEQ, rowb = bat + t0;
        {
            const size_t row = rowb + w;
            const u32x4 v = *(const u32x4*)(U + row * LDE + EZ + 8 * lane);
            float f[8] = {bflo(v.x), bfhi(v.x), bflo(v.y), bfhi(v.y), bflo(v.z), bfhi(v.z), bflo(v.w), bfhi(v.w)};
            float s = 0.f;
#pragma unroll
            for (int j = 0; j < 8; ++j) s += f[j] * f[j];
#pragma unroll
            for (int o = 1; o < 32; o <<= 1) s += __shfl_xor(s, o);
            const float rs = 1.f / sqrtf(s * (1.f / 256.f) + NORM_EPS); const float* g = ng + 8 * lane;
            u32x4 o; o.x = pk2(f[0] * rs * g[0], f[1] * rs * g[1]); o.y = pk2(f[2] * rs * g[2], f[3] * rs * g[3]); o.z = pk2(f[4] * rs * g[4], f[5] * rs * g[5]); o.w = pk2(f[6] * rs * g[6], f[7] * rs * g[7]);
            *(u32x4*)(HB + row * DM + 8 * lane) = o;
        }
        {
            const int r = lane & 31, hh = lane >> 5;
            bf16x8 qa[4];
#pragma unroll
            for (int ks = 0; ks < 4; ++ks) qa[ks] = *(const bf16x8*)(U + (rowb + (r >> 2)) * LDE + EIQ + (r & 3) * 64 + 16 * ks + 8 * hh);
            float wv[4][4];
#pragma unroll
            for (int q = 0; q < 4; ++q) { const u32x2 ww = *(const u32x2*)(U + (rowb + 2 * q + hh) * LDE + EIW); wv[q][0] = bflo(ww.x); wv[q][1] = bfhi(ww.x); wv[q][2] = bflo(ww.y); wv[q][3] = bfhi(ww.y); }
            const int ntile = (t0 + 8 + 31) >> 5;
            for (int tb = w; tb < ntile; tb += 4 * NWAVES) {
                bf16x8 kf[4][4];
#pragma unroll
                for (int u4 = 0; u4 < 4; ++u4) { const int tl = tb + 8 * u4 < 128 ? tb + 8 * u4 : 127; const int key = 32 * tl + r;
#pragma unroll
                    for (int ks = 0; ks < 4; ++ks) kf[u4][ks] = *(const bf16x8*)(U + (bat + key) * LDE + EIK + 16 * ks + 8 * hh); }
#pragma unroll
                for (int u4 = 0; u4 < 4; ++u4) {
                    const int tile = tb + 8 * u4;
                    f32x16 acc = {0.f, 0.f, 0.f, 0.f, 0.f, 0.f, 0.f, 0.f, 0.f, 0.f, 0.f, 0.f, 0.f, 0.f, 0.f, 0.f};
#pragma unroll
                    for (int ks = 0; ks < 4; ++ks) acc = __builtin_amdgcn_mfma_f32_32x32x16_bf16(qa[ks], kf[u4][ks], acc, 0, 0, 0);
                    if (tile < ntile) {
#pragma unroll
                        for (int q = 0; q < 4; ++q) {
                            const float sc = wv[q][0] * fmaxf(acc[4 * q], 0.f) + wv[q][1] * fmaxf(acc[4 * q + 1], 0.f) + wv[q][2] * fmaxf(acc[4 * q + 2], 0.f) + wv[q][3] * fmaxf(acc[4 * q + 3], 0.f);
                            *(LAS float*)(L + ((2 * q + hh) * 4096 + 32 * tile + r) * 4) = sc + 0.f;
                        }
                    }
                }
            }
        }
        __syncthreads();
        const int t = t0 + w, n = t + 1;
        LAS unsigned short* sel = (LAS unsigned short*)(L + D_SEL) + w * 256;
        const int cnt = n < 256 ? n : 256;
        if (n <= 256) {
#pragma unroll
            for (int i = 0; i < 4; ++i) { const int s = lane + 64 * i; sel[s] = (unsigned short)(s < n ? s : 0); }
        } else {
            const int nj = (t0 + 8 + 63) >> 6;
            const LAS float* myrow = (const LAS float*)(L + w * 16384);
            int v[64]; int vmax = (int)0x80000000, vmin = 0x7fffffff;
#pragma unroll
            for (int jb = 0; jb < 4; ++jb) {
                if (16 * jb < nj) {
#pragma unroll
                    for (int jj = 0; jj < 16; ++jj) { const int j = 16 * jb + jj; const int idx = lane + 64 * j; const int kv = okey(myrow[idx]);
                        const bool ok = idx <= t; v[j] = ok ? kv : (int)0x80000000; vmax = v[j] > vmax ? v[j] : vmax; const int x = ok ? kv : 0x7fffffff; vmin = x < vmin ? x : vmin; }
                } else {
#pragma unroll
                    for (int jj = 0; jj < 16; ++jj) v[16 * jb + jj] = (int)0x80000000;
                }
            }
#pragma unroll
            for (int o = 1; o < 64; o <<= 1) { const int x = __shfl_xor(vmax, o); vmax = x > vmax ? x : vmax; const int y = __shfl_xor(vmin, o); vmin = y < vmin ? y : vmin; }
            vmax = __builtin_amdgcn_readfirstlane(vmax); vmin = __builtin_amdgcn_readfirstlane(vmin);
            int lo = vmin, hi = vmax, clo = n, chi = 0, it = 0;
            for (int rps = 0; rps < (REP_PART == 4 ? A.rep : 1); ++rps) { lo = vmin; hi = vmax; clo = n; chi = 0; it = 0;
            while (lo < hi) {
                int mid;
                const int ph3 = it % 3;
                if (ph3 == 2) mid = lo + (int)(((long long)hi - (long long)lo + 1) >> 1);
                else {
                    const float lof = __builtin_bit_cast(float, lo >= 0 ? lo : lo ^ 0x7fffffff), hif = __builtin_bit_cast(float, hi >= 0 ? hi : hi ^ 0x7fffffff);
                    const float fr = ph3 == 0 ? ((float)(clo - 256) + 0.5f) / (float)(clo - chi) : 0.5f;
                    mid = okey(lof + (hif - lof) * fr);
                    mid = mid > hi ? hi : mid; mid = mid <= lo ? lo + 1 : mid;
                }
                int c = 0;
#pragma unroll
                for (int jb = 0; jb < 4; ++jb) if (16 * jb < nj) {
#pragma unroll
                    for (int jj = 0; jj < 16; jj += 8) { const int j0 = 16 * jb + jj; c += count_ge8(v[j0], v[j0 + 1], v[j0 + 2], v[j0 + 3], v[j0 + 4], v[j0 + 5], v[j0 + 6], v[j0 + 7], mid); } }
                ++it;
                if (c == 256) { lo = mid; break; }
                if (c > 256) { lo = mid; clo = c; } else { hi = mid - 1; chi = c; }
            } }
            const int T = lo;
            int cge = 0, cgt = 0;
#pragma unroll
            for (int jb = 0; jb < 4; ++jb) if (16 * jb < nj) {
#pragma unroll
                for (int jj = 0; jj < 16; jj += 8) { const int j0 = 16 * jb + jj;
                    cge += count_ge8(v[j0], v[j0 + 1], v[j0 + 2], v[j0 + 3], v[j0 + 4], v[j0 + 5], v[j0 + 6], v[j0 + 7], T);
                    cgt += count_ge8(v[j0], v[j0 + 1], v[j0 + 2], v[j0 + 3], v[j0 + 4], v[j0 + 5], v[j0 + 6], v[j0 + 7], T + 1); } }
            const int need_eq = 256 - cgt;
            if (cge - cgt == need_eq) {
                LAS unsigned short* dummy = (LAS unsigned short*)(L + D_DMY) + w * 64 + lane;
                int obase = 0;
#pragma unroll
                for (int jb = 0; jb < 4; ++jb) if (16 * jb < nj) {
#pragma unroll
                    for (int jj = 0; jj < 16; jj += 8) { const int j0 = 16 * jb + jj; unsigned long long m[8];
                        masks_ge8(v[j0], v[j0 + 1], v[j0 + 2], v[j0 + 3], v[j0 + 4], v[j0 + 5], v[j0 + 6], v[j0 + 7], T, m);
#pragma unroll
                        for (int e = 0; e < 8; ++e) {
                            const int pos = (int)__builtin_amdgcn_mbcnt_hi((unsigned)(m[e] >> 32), __builtin_amdgcn_mbcnt_lo((unsigned)m[e], (unsigned)obase));
                            LAS unsigned short* dst = (LAS unsigned short*)(unsigned)sel_mask((int)(unsigned)(__SIZE_TYPE__)dummy, (int)(unsigned)(__SIZE_TYPE__)(sel + pos), m[e]);
                            *dst = (unsigned short)(lane + 64 * (j0 + e));
                            obase += __popcll(m[e]); } } }
            } else {
            int obase = 0, ebase = 0;
#pragma unroll
            for (int jb = 0; jb < 4; ++jb) if (16 * jb < nj) {
#pragma unroll
                for (int jj = 0; jj < 16; ++jj) { const int j = 16 * jb + jj;
                    const bool gt = v[j] > T, eq = v[j] == T;
                    const unsigned long long be = __ballot(eq);
                    const int erank = ebase + (int)__builtin_amdgcn_mbcnt_hi((unsigned)(be >> 32), __builtin_amdgcn_mbcnt_lo((unsigned)be, 0u));
                    const bool take = gt || (eq && erank < need_eq);
                    const unsigned long long bt = __ballot(take);
                    const int pos = obase + (int)__builtin_amdgcn_mbcnt_hi((unsigned)(bt >> 32), __builtin_amdgcn_mbcnt_lo((unsigned)bt, 0u));
                    if (take && pos < 256) sel[pos] = (unsigned short)(lane + 64 * j);
                    obase += __popcll(bt); ebase += __popcll(be); } }
            }
        }
        __syncthreads();
        {
            const int hd = lane & 15, g4 = lane >> 4;
            const size_t row = rowb + w;
            bf16x8 qb[2];
            {
                float qf[2][8]; float ss = 0.f;
#pragma unroll
                for (int ks = 0; ks < 2; ++ks) { u32x4 qq = (u32x4){0u, 0u, 0u, 0u};
                    if (hd < 8) qq = *(const u32x4*)(U + row * LDE + EQ + hd * 64 + 32 * ks + 8 * g4);
                    qf[ks][0] = bflo(qq.x); qf[ks][1] = bfhi(qq.x); qf[ks][2] = bflo(qq.y); qf[ks][3] = bfhi(qq.y); qf[ks][4] = bflo(qq.z); qf[ks][5] = bfhi(qq.z); qf[ks][6] = bflo(qq.w); qf[ks][7] = bfhi(qq.w);
#pragma unroll
                    for (int j = 0; j < 8; ++j) ss += qf[ks][j] * qf[ks][j]; }
                ss += __shfl_xor(ss, 16); ss += __shfl_xor(ss, 32);
                const float rs = 0.125f / sqrtf(ss * (1.f / 64.f) + NORM_EPS);
#pragma unroll
                for (int ks = 0; ks < 2; ++ks) { const float* gq = A.in[11] + 32 * ks + 8 * g4;
                    u32x4 pk; pk.x = pk2(qf[ks][0] * rs * gq[0], qf[ks][1] * rs * gq[1]); pk.y = pk2(qf[ks][2] * rs * gq[2], qf[ks][3] * rs * gq[3]);
                    pk.z = pk2(qf[ks][4] * rs * gq[4], qf[ks][5] * rs * gq[5]); pk.w = pk2(qf[ks][6] * rs * gq[6], qf[ks][7] * rs * gq[7]);
                    qb[ks] = __builtin_bit_cast(bf16x8, pk); }
            }
            float lg[16][4]; float mx = -3.0e38f;
            const int vsl = lane >> 3, vpart = lane & 7;
            u32x4 vr[2][8];
#pragma unroll
            for (int hb = 0; hb < 2; ++hb) {
                bf16x8 ka[8][2];
#pragma unroll
                for (int T8 = 0; T8 < 8; ++T8) { const int sm = sel[16 * (8 * hb + T8) + hd]; const bf16* kp = U + (bat + sm) * LDE + EK + 8 * g4;
                    ka[T8][0] = *(const bf16x8*)kp; ka[T8][1] = *(const bf16x8*)(kp + 32); }
#pragma unroll
                for (int e = 0; e < 8; ++e) { const int sm = sel[64 * hb + 8 * e + vsl]; vr[hb][e] = *(const u32x4*)(U + (bat + sm) * LDE + EV + 8 * vpart); }
#pragma unroll
                for (int T8 = 0; T8 < 8; ++T8) { const int T = 8 * hb + T8;
                    f32x4 acc = {0.f, 0.f, 0.f, 0.f};
                    acc = __builtin_amdgcn_mfma_f32_16x16x32_bf16(ka[T8][0], qb[0], acc, 0, 0, 0);
                    acc = __builtin_amdgcn_mfma_f32_16x16x32_bf16(ka[T8][1], qb[1], acc, 0, 0, 0);
                    const u32x2 sl = *(const LAS u32x2*)(sel + 16 * T + 4 * g4);
                    const int s4[4] = {(int)(sl.x & 0xffffu), (int)(sl.x >> 16), (int)(sl.y & 0xffffu), (int)(sl.y >> 16)};
#pragma unroll
                    for (int i = 0; i < 4; ++i) { int dist = t - s4[i]; dist = dist < 0 ? 0 : (dist > 127 ? 127 : dist);
                        const float bia = LUT[dist * 8 + (hd & 7)];
                        const bool valid = (16 * T + 4 * g4 + i) < cnt;
                        lg[T][i] = valid ? acc[i] + bia : -3.0e38f; mx = fmaxf(mx, lg[T][i]); }
                }
            }
            mx = fmaxf(mx, __shfl_xor(mx, 16)); mx = fmaxf(mx, __shfl_xor(mx, 32));
            float sum = 0.f;
#pragma unroll
            for (int T = 0; T < 16; ++T) {
#pragma unroll
                for (int i = 0; i < 4; ++i) { const float p = lg[T][i] > -1.0e38f ? __expf(lg[T][i] - mx) : 0.f; lg[T][i] = p; sum += p; }
                if ((T & 3) == 3) __builtin_amdgcn_sched_barrier(0); }
            sum += __shfl_xor(sum, 16); sum += __shfl_xor(sum, 32);
            const float inv = 1.f / fmaxf(sum, 1e-30f);
            f32x4 oacc[4];
#pragma unroll
            for (int dt = 0; dt < 4; ++dt) oacc[dt] = (f32x4){0.f, 0.f, 0.f, 0.f};
            LAS unsigned char* Vl = L + w * 16384;
#pragma unroll
            for (int ch = 0; ch < 4; ++ch) {
                LDS_WAIT();
#pragma unroll
                for (int e = 0; e < 8; ++e) *(LAS u32x4*)(Vl + ((8 * e + vsl) * VP + 8 * vpart) * 2) = vr[ch & 1][e];
                if (ch + 2 < 4) {
#pragma unroll
                    for (int e = 0; e < 8; ++e) { const int sm = sel[64 * (ch + 2) + 8 * e + vsl]; vr[ch & 1][e] = *(const u32x4*)(U + (bat + sm) * LDE + EV + 8 * vpart); }
                }
                LDS_WAIT();
#pragma unroll
                for (int kk = 0; kk < 2; ++kk) {
                    const int T0 = 2 * (2 * ch + kk);
                    u32x4 pp; pp.x = pk2(lg[T0][0] * inv, lg[T0][1] * inv); pp.y = pk2(lg[T0][2] * inv, lg[T0][3] * inv); pp.z = pk2(lg[T0 + 1][0] * inv, lg[T0 + 1][1] * inv); pp.w = pk2(lg[T0 + 1][2] * inv, lg[T0 + 1][3] * inv);
                    const bf16x8 pf = __builtin_bit_cast(bf16x8, pp);
                    const int qq = (lane & 15) >> 2, p4 = lane & 3;
#pragma unroll
                    for (int dt = 0; dt < 4; ++dt) {
                        const s16x4 b0 = lds_tr16(Vl + ((32 * kk + 4 * g4 + qq) * VP + 16 * dt + 4 * p4) * 2);
                        const s16x4 b1 = lds_tr16(Vl + ((32 * kk + 16 + 4 * g4 + qq) * VP + 16 * dt + 4 * p4) * 2);
                        bf16x8 bfg; bfg[0] = b0[0]; bfg[1] = b0[1]; bfg[2] = b0[2]; bfg[3] = b0[3]; bfg[4] = b1[0]; bfg[5] = b1[1]; bfg[6] = b1[2]; bfg[7] = b1[3];
                        oacc[dt] = __builtin_amdgcn_mfma_f32_16x16x32_bf16(pf, bfg, oacc[dt], 0, 0, 0);
                    }
                }
            }
            if (g4 < 2) {
#pragma unroll
                for (int i = 0; i < 4; ++i)
#pragma unroll
                    for (int dt = 0; dt < 4; ++dt) HB[row * DM + 512 + (4 * g4 + i) * 64 + 16 * dt + hd] = (bf16)f2bfh(oacc[dt][i]);
            }
        }
        __syncthreads();
    }
}

template <int MODE> __device__ __forceinline__ void p_norm_route(Frame& F, const bf16* xin, const float* gain, int layer) {
    constexpr int NT = MODE == 0 ? 3 : 2;
    bf16* HB = (bf16*)(F.ws + WS_HB); const bf16* WR = MODE == 0 ? (const bf16*)(F.ws + WS_WR) + (size_t)layer * 48 * 1024 : (const bf16*)(F.ws + WS_WGL);
    float* GL = (float*)(F.ws + WS_GL);
    int* list = (int*)(F.ws + WS_LIST); float* wl = (float*)(F.ws + WS_LISTW);
    LAS unsigned char* L = F.lds;
    LAS float* lgt = (LAS float*)L + F.wave * (16 * 48);
    LAS int* cntl = (LAS int*)(L + 32768); LAS int* basel = (LAS int*)(L + 33024);
    LAS int* ri_e = (LAS int*)(L + 34816); LAS int* ri_p = (LAS int*)(L + 36864); LAS float* ri_w = (LAS float*)(L + 38912);
    const int w = F.wave;
    for (int base = F.bid * 256; base < MTOK; base += F.G * 256) {
        int lane = F.lane; asm volatile("" : "+v"(lane));
        if (F.tid < 64) cntl[F.tid] = 0;
        __syncthreads();
#pragma unroll 1
        for (int half = 0; half < 2; ++half) {
            const int R0 = base + w * 32 + half * 16;
#pragma unroll 1
            for (int i = 0; i < 16; ++i) rms_rowb_to_bf16(xin + (size_t)(R0 + i) * DM, gain, HB + (size_t)(R0 + i) * DM, lane);
            VM_WAIT();
            const int n16 = lane & 15, g4 = lane >> 4;
            f32x4 acc[NT];
#pragma unroll
            for (int nt = 0; nt < NT; ++nt) acc[nt] = (f32x4){0.f, 0.f, 0.f, 0.f};
#pragma unroll 4
            for (int kk = 0; kk < 32; ++kk) {
                const bf16x8 a = *(const bf16x8*)(HB + (size_t)(R0 + n16) * DM + 32 * kk + 8 * g4);
#pragma unroll
                for (int nt = 0; nt < NT; ++nt) { const bf16x8 bb = *(const bf16x8*)(WR + (size_t)(16 * nt + n16) * DM + 32 * kk + 8 * g4);
                    acc[nt] = __builtin_amdgcn_mfma_f32_16x16x32_bf16(a, bb, acc[nt], 0, 0, 0); }
            }
            if constexpr (MODE == 1) {
#pragma unroll
                for (int nt = 0; nt < NT; ++nt)
#pragma unroll
                    for (int i = 0; i < 4; ++i) if (16 * nt + n16 < 24) GL[(size_t)(R0 + 4 * g4 + i) * 24 + 16 * nt + n16] = acc[nt][i];
            } else {
#pragma unroll
            for (int nt = 0; nt < NT; ++nt)
#pragma unroll
                for (int i = 0; i < 4; ++i) lgt[(4 * g4 + i) * 48 + 16 * nt + n16] = acc[nt][i];
            LDS_WAIT();
            if (lane < 16) {
                const LAS float* lr = lgt + lane * 48;
                int gs = 0; float gm = lr[0];
#pragma unroll
                for (int j = 1; j < 4; ++j) if (lr[j] > gm) { gm = lr[j]; gs = j; }
                float gsum = 0.f;
#pragma unroll
                for (int j = 0; j < 4; ++j) gsum += __expf(lr[j] - gm);
                const float gw = 1.f / gsum;
                const LAS float* er = lr + 4 + 8 * gs;
                int i0 = 0; float m0 = er[0];
#pragma unroll
                for (int j = 1; j < 8; ++j) if (er[j] > m0) { m0 = er[j]; i0 = j; }
                int i1 = -1; float m1 = -3.0e38f;
#pragma unroll
                for (int j = 0; j < 8; ++j) if (j != i0 && er[j] > m1) { m1 = er[j]; i1 = j; }
                const float w0 = 1.f / (1.f + __expf(m1 - m0));
                const int e0 = gs * 8 + i0, e1 = 32 + gs * 8 + i1;
                const int rs = (w * 32 + half * 16 + lane) * 2;
                ri_e[rs] = e0; ri_p[rs] = __hip_atomic_fetch_add(cntl + e0, 1, __ATOMIC_RELAXED, __HIP_MEMORY_SCOPE_WORKGROUP); ri_w[rs] = w0 * gw;
                ri_e[rs + 1] = e1; ri_p[rs + 1] = __hip_atomic_fetch_add(cntl + e1, 1, __ATOMIC_RELAXED, __HIP_MEMORY_SCOPE_WORKGROUP); ri_w[rs + 1] = (1.f - w0) * gw;
            }
            LDS_WAIT();
            }
        }
        if constexpr (MODE == 1) continue;
        __syncthreads();
        if (F.tid < 64) { const int c = cntl[F.tid]; basel[F.tid] = c ? (int)__hip_atomic_fetch_add((unsigned*)(F.ctl + CW_CNT + layer * 4096 + 64 * F.tid), (unsigned)c, RLX_AGENT) : 0; }
        __syncthreads();
        { const int rs = F.tid, e = ri_e[rs], pos = basel[e] + ri_p[rs];
          list[(size_t)e * 65536 + pos] = base + (rs >> 1); wl[(size_t)e * 65536 + pos] = ri_w[rs]; }
        __syncthreads();
    }
}
__device__ __forceinline__ void moe_tables(Frame& F, int layer) {
    LAS int* ptile = (LAS int*)(F.lds + MOE_OFF); LAS int* cntv = ptile + 128;
    __syncthreads();
    if (F.tid < 64) {
        const int c = (int)__hip_atomic_load((unsigned*)(F.ctl + CW_CNT + layer * 4096 + 64 * F.tid), RLX_AGENT);
        cntv[F.tid] = c;
        int nt = (c + 255) >> 8, incl = nt;
#pragma unroll
        for (int o = 1; o < 64; o <<= 1) { const int t = __shfl_up(incl, o); if (F.lane >= o) incl += t; }
        ptile[F.tid] = incl - nt; if (F.tid == 63) ptile[64] = incl;
    }
    __syncthreads();
}
__device__ __forceinline__ void p_moe_gu(Frame& F, int layer) {
    moe_tables(F, layer);
    const LAS int* ptile = (const LAS int*)(F.lds + MOE_OFF); const LAS int* cntv = ptile + 128;
    pg8::MoeOrder S{(const char*)(F.ws + WS_HB), (const char*)(F.ws + WS_WGU) + (size_t)layer * 32 * 1024 * 1024 * 2, (size_t)1024 * 1024 * 2, 1024, F.G, F.bid, 0, ptile[64], ptile, cntv, (const int*)(F.ws + WS_LIST), true};
    pg8::EpiSwiGLU E{(bf16*)(F.ws + WS_U)};
    pg8::gemm_phase<pg8::EpiSwiGLU, pg8::MoeOrder, true>(F.lds, 1024, S, E);
}
template <bool FINAL> __device__ __forceinline__ void p_moe_down(Frame& F, int layer, int slot) {
    moe_tables(F, layer);
    const LAS int* ptile = (const LAS int*)(F.lds + MOE_OFF); const LAS int* cntv = ptile + 128;
    pg8::MoeOrder S{(const char*)(F.ws + WS_U), (const char*)(F.ws + WS_WD) + (size_t)layer * 32 * 1024 * 512 * 2, (size_t)1024 * 512 * 2, 512, F.G, F.bid, ptile[32 * slot], ptile[32 * slot + 32], ptile, cntv, (const int*)(F.ws + WS_LIST), false};
    pg8::EpiScatter<FINAL> E{(bf16*)(F.ws + WS_XB), F.out, (const int*)(F.ws + WS_LIST), (const float*)(F.ws + WS_LISTW), cntv};
    pg8::gemm_phase<pg8::EpiScatter<FINAL>, pg8::MoeOrder, true>(F.lds, 512, S, E);
}

__device__ __forceinline__ void p_compress(Frame& F, const Args& A) {
    bf16* U = (bf16*)(F.ws + WS_U);
    LAS unsigned char* L = F.lds;
    const int w = F.wave;
    {
        const int tid = F.tid, sub = tid & 15;
        for (int v0 = F.bid * 32; v0 < MTOK * 4; v0 += F.G * 32) {
            const int vec = v0 + (tid >> 4), row = vec >> 2, wh = vec & 3;
            bf16* p = U + (size_t)row * LDO + ((wh >> 1) ? OKW : OKS) + (wh & 1) * 128 + 8 * sub;
            const float* g = ((wh >> 1) ? A.in[18] : A.in[17]) + 8 * sub;
            const u32x4 v = *(const u32x4*)p; float f[8] = {bflo(v.x), bfhi(v.x), bflo(v.y), bfhi(v.y), bflo(v.z), bfhi(v.z), bflo(v.w), bfhi(v.w)};
            float s = 0.f;
#pragma unroll
            for (int j = 0; j < 8; ++j) s += f[j] * f[j];
            s += __shfl_xor(s, 1); s += __shfl_xor(s, 2); s += __shfl_xor(s, 4); s += __shfl_xor(s, 8);
            const float rs = 1.f / sqrtf(s * (1.f / 128.f) + NORM_EPS);
            u32x4 o; o.x = pk2(f[0] * rs * g[0], f[1] * rs * g[1]); o.y = pk2(f[2] * rs * g[2], f[3] * rs * g[3]); o.z = pk2(f[4] * rs * g[4], f[5] * rs * g[5]); o.w = pk2(f[6] * rs * g[6], f[7] * rs * g[7]);
            *(u32x4*)p = o;
        }
    }
    constexpr int C_A = 0, C_B = 17408, C_H = 52224, C_S = 69632;
    for (int unit = F.bid; unit < 256; unit += F.G) {
        int tid = F.tid, lane = F.lane; asm volatile("" : "+v"(tid), "+v"(lane));
        const int T = unit >> 7, b = (unit >> 3) & 15, g = (unit >> 2) & 1, cb = unit & 3;
        const int col = (T ? OVC : OKC) + g * 128;
        const float* pos = T ? A.in[20] : A.in[19];
        const bf16* w1t = (const bf16*)(F.ws + (T ? WS_W1V : WS_W1K)); const bf16* w2t = (const bf16*)(F.ws + WS_W2) + T * 128 * 128;
        const int wm = w >> 2, wn = w & 3, r = lane & 31, hh = lane >> 5;
        f32x16 acc = {0.f, 0.f, 0.f, 0.f, 0.f, 0.f, 0.f, 0.f, 0.f, 0.f, 0.f, 0.f, 0.f, 0.f, 0.f, 0.f};
#pragma unroll 1
        for (int l = 0; l < 32; ++l) {
            __syncthreads();
#pragma unroll
            for (int e = 0; e < 2; ++e) { const int q = tid + 512 * e, c = q >> 4, part = q & 15; const int tok = 16 * (64 * cb + c) + l;
                u32x4 v = (u32x4){0u, 0u, 0u, 0u};
                if (tok < SEQ) v = *(const u32x4*)(U + ((size_t)b * SEQ + tok) * LDO + col + 8 * part);
                const f32x4 p0 = *(const f32x4*)(pos + l * 128 + 8 * part), p1 = *(const f32x4*)(pos + l * 128 + 8 * part + 4);
                u32x4 o; o.x = pk2(bflo(v.x) + p0.x, bfhi(v.x) + p0.y); o.y = pk2(bflo(v.y) + p0.z, bfhi(v.y) + p0.w); o.z = pk2(bflo(v.z) + p1.x, bfhi(v.z) + p1.y); o.w = pk2(bflo(v.w) + p1.z, bfhi(v.w) + p1.w);
                *(LAS u32x4*)(L + C_A + (c * SP + 8 * part) * 2) = o; }
#pragma unroll
            for (int e = 0; e < 4; ++e) { const int q = tid + 512 * e, j = q >> 4, part = q & 15;
                *(LAS u32x4*)(L + C_B + (j * SP + 8 * part) * 2) = *(const u32x4*)(w1t + (size_t)j * 4096 + l * 128 + 8 * part); }
            __syncthreads();
#pragma unroll
            for (int ks = 0; ks < 8; ++ks) {
                const bf16x8 af = lds_frag(L + C_A, 32 * wm + r, 16 * ks + 8 * hh), bfg = lds_frag(L + C_B, 32 * wn + r, 16 * ks + 8 * hh);
                acc = __builtin_amdgcn_mfma_f32_32x32x16_bf16(af, bfg, acc, 0, 0, 0);
            }
        }
#pragma unroll
        for (int i = 0; i < 16; ++i) { const int c = 32 * wm + 8 * (i >> 2) + 4 * hh + (i & 3);
            *(LAS bf16*)(L + C_H + (c * SP + 32 * wn + r) * 2) = (bf16)f2bfh(siluf(acc[i])); }
        __syncthreads();
        f32x16 a2 = {0.f, 0.f, 0.f, 0.f, 0.f, 0.f, 0.f, 0.f, 0.f, 0.f, 0.f, 0.f, 0.f, 0.f, 0.f, 0.f};
#pragma unroll
        for (int ks = 0; ks < 8; ++ks) {
            const bf16x8 af = lds_frag(L + C_H, 32 * wm + r, 16 * ks + 8 * hh), bfg = *(const bf16x8*)(w2t + (size_t)(32 * wn + r) * 128 + 16 * ks + 8 * hh);
            a2 = __builtin_amdgcn_mfma_f32_32x32x16_bf16(af, bfg, a2, 0, 0, 0);
        }
        float rsv[16];
        if (T == 0) {
            LAS float* st = (LAS float*)(L + C_S);
#pragma unroll
            for (int i = 0; i < 16; ++i) { float q = a2[i] * a2[i];
                q += __shfl_xor(q, 1); q += __shfl_xor(q, 2); q += __shfl_xor(q, 4); q += __shfl_xor(q, 8); q += __shfl_xor(q, 16);
                if (r == 0) st[(32 * wm + 8 * (i >> 2) + 4 * hh + (i & 3)) * 4 + wn] = q; }
            __syncthreads();
#pragma unroll
            for (int i = 0; i < 16; ++i) { const f32x4 q = *(const LAS f32x4*)(st + (32 * wm + 8 * (i >> 2) + 4 * hh + (i & 3)) * 4);
                rsv[i] = A.in[16][32 * wn + r] / sqrtf((q.x + q.y + q.z + q.w) * (1.f / 128.f) + NORM_EPS); }
        } else {
#pragma unroll
            for (int i = 0; i < 16; ++i) rsv[i] = 1.f;
        }
        bf16* dst = (bf16*)(F.ws + (T ? WS_VCMP : WS_KCMP));
#pragma unroll
        for (int i = 0; i < 16; ++i) { const int c = 64 * cb + 32 * wm + 8 * (i >> 2) + 4 * hh + (i & 3);
            dst[(((size_t)b * 256 + c) * 2 + g) * 128 + 32 * wn + r] = (bf16)f2bfh(a2[i] * rsv[i]); }
    }
}

constexpr int N_STG = 32768;
constexpr int N_K = 0, N_V = 16384, N_LUT = 3 * N_STG, N_IMP = N_LUT + 4096, N_FAC = N_IMP + 16384, N_MSK = N_FAC + 1024, N_UNI = N_MSK + 512, N_CST = N_UNI + 64;
constexpr float LOG2E = 1.44269504f;
enum { BR_CMP = 0, BR_SEL = 1, BR_WIN = 2 };
struct NsaCtx {
    LAS unsigned char* L; const bf16* U; const bf16* KC; const bf16* VC;
    int tid, lane, w, r, hh, b, g, qblk, t0, t, head; size_t bat;
    float mrow, cfar; unsigned mlo, mhi;
};
__device__ __forceinline__ void glds16(const void* gsrc, unsigned lds_dst) { unsigned keep;
    asm volatile("s_mov_b32 %0, m0\n\ts_mov_b32 m0, %2\n\ts_nop 0\n\tglobal_load_lds_dwordx4 %1, off\n\ts_mov_b32 m0, %0" : "=&s"(keep) : "v"(gsrc), "s"(lds_dst) : "memory"); }
#define NSA_BAR() do { asm volatile("" ::: "memory"); __builtin_amdgcn_s_barrier(); asm volatile("" ::: "memory"); } while (0)
template <int BR, bool SUM, bool PV, bool IMP, bool UNITFAC = false>
__device__ __forceinline__ void nsa_pass(const NsaCtx& X, const bf16x8 (&qf)[8], f32x16 (&oacc)[4], float& lsum, const float colfac, const int tlo, const int thi, const unsigned long long tmask) {
    LAS unsigned char* L = X.L; const int r = X.r, hh = X.hh, lane = X.lane;
    const LAS float* LUT = (const LAS float*)(L + N_LUT);
    auto dma = [&](int tl, int st) {
#pragma unroll
        for (int e = 0; e < 2; ++e) { const int pidx = e * 8 + X.w, row = pidx * 4 + (lane >> 4), ch = (lane & 15) ^ (((lane >> 4) << 2) | (X.w & 3));
            const bf16* kp; const bf16* vp;
            if (BR == BR_CMP) { const size_t o = (((size_t)X.b * 256 + 64 * tl + row) * 2 + X.g) * 128 + 8 * ch; kp = X.KC + o; vp = X.VC + o; }
            else { const size_t o = (X.bat + 64 * tl + row) * LDO + X.g * 128 + 8 * ch; kp = X.U + o + (BR == BR_SEL ? OKS : OKW); vp = X.U + o + (BR == BR_SEL ? OVS : OVW); }
            const unsigned ld = (unsigned)__builtin_amdgcn_readfirstlane((int)(unsigned)(__SIZE_TYPE__)(L + st * N_STG + N_K + pidx * 1024));
            glds16(kp, ld); if (PV) glds16(vp, ld + N_V); }
    };
    auto nextt = [&](int tl) { ++tl; while (tl <= thi && !((tmask >> tl) & 1ull)) ++tl; return tl; };
    int tile = nextt(tlo - 1);
    if (tile > thi) return;
    asm volatile("s_waitcnt vmcnt(0)" ::: "memory");
    int nxt = nextt(tile);
    int nn = nxt <= thi ? nextt(nxt) : nxt;
    dma(tile, 0); if (nxt <= thi) dma(nxt, 1);
    int cur = 0;
    const bool gB = X.w >= 4;
    const int kswz = ((r & 3) << 2) | ((r >> 2) & 3);
#define NSA_WAIT_KEEP(has_newer) do { if (has_newer) { if (PV) asm volatile("s_waitcnt vmcnt(4)" ::: "memory"); else asm volatile("s_waitcnt vmcnt(2)" ::: "memory"); } else asm volatile("s_waitcnt vmcnt(0)" ::: "memory"); } while (0)
    if (gB) { NSA_WAIT_KEEP(nxt <= thi); NSA_BAR(); }
    while (tile <= thi) {
        const int st2 = cur >= 1 ? cur - 1 : 2;
        if (!gB) NSA_WAIT_KEEP(nxt <= thi);
        NSA_BAR();
        if (gB && nn <= thi) dma(nn, st2);
        LAS unsigned char* Ls = L + cur * N_STG;
        const int maxpos = BR == BR_CMP ? 16 * (64 * tile + 63) + 31 : 64 * tile + 63, minpos = BR == BR_CMP ? 16 * (64 * tile) + 31 : 64 * tile;
        const bool far = (X.t0 - maxpos >= 113) && (BR != BR_WIN || (X.t0 + 63 - minpos < 512));
        bool selb = true; if (BR == BR_SEL) selb = (tile < 32 ? (X.mlo >> tile) : (X.mhi >> (tile - 32))) & 1u;
        bf16x8 pa[2][2];
        {
            bf16x8 kf[2][8];
#pragma unroll
            for (int mt = 0; mt < 2; ++mt)
#pragma unroll
                for (int ks = 0; ks < 8; ++ks) kf[mt][ks] = *(const LAS bf16x8*)(Ls + N_K + (32 * mt + r) * 256 + 16 * ((2 * ks + hh) ^ kswz));
            asm volatile("" ::: "memory");
            f32x16 sacc[2];
#pragma unroll
            for (int mt = 0; mt < 2; ++mt) sacc[mt] = (f32x16){0.f, 0.f, 0.f, 0.f, 0.f, 0.f, 0.f, 0.f, 0.f, 0.f, 0.f, 0.f, 0.f, 0.f, 0.f, 0.f};
#pragma unroll
            for (int ks = 0; ks < 8; ++ks)
#pragma unroll
                for (int mt = 0; mt < 2; ++mt) sacc[mt] = __builtin_amdgcn_mfma_f32_32x32x16_bf16(kf[mt][ks], qf[ks], sacc[mt], 0, 0, 0);
            const float cf = (BR == BR_SEL && !selb) ? -1.0e30f : X.cfar;
#pragma unroll
            for (int mt = 0; mt < 2; ++mt) {
                if (far) {
#pragma unroll
                    for (int i = 0; i < 16; ++i) { const float p = __builtin_amdgcn_exp2f(sacc[mt][i] + cf);
                        if (SUM) lsum += p; sacc[mt][i] = UNITFAC ? p : p * colfac; }
                } else {
#pragma unroll
                    for (int i = 0; i < 16; ++i) { const int kidx = 32 * mt + 8 * (i >> 2) + 4 * hh + (i & 3);
                        int dist; bool ok;
                        if (BR == BR_CMP) { dist = X.t - (16 * (64 * tile + kidx) + 31); ok = dist >= 0; }
                        else { dist = X.t - (64 * tile + kidx); ok = BR == BR_SEL ? (selb && dist >= 0) : (dist >= 0 && dist < 512); }
                        const int dc = dist < 0 ? 0 : (dist > 127 ? 127 : dist);
                        const float bia = LUT[dc * 8 + X.head];
                        const float ev = __builtin_amdgcn_exp2f(sacc[mt][i] + bia - X.mrow);
                        const float p = ok ? ev : 0.f;
                        if (SUM) lsum += p;
                        sacc[mt][i] = UNITFAC ? p : p * colfac; }
                }
                if (IMP) {
                    LAS float* imp = (LAS float*)(L + N_IMP) + (X.w * 8 + (r >> 2)) * 64;
#pragma unroll
                    for (int q = 0; q < 4; ++q) { float s4 = (sacc[mt][4 * q] + sacc[mt][4 * q + 1]) + (sacc[mt][4 * q + 2] + sacc[mt][4 * q + 3]), s3 = sacc[mt][4 * q + 3];
                        s4 += __shfl_xor(s4, 1); s4 += __shfl_xor(s4, 2); s3 += __shfl_xor(s3, 1); s3 += __shfl_xor(s3, 2);
                        const int n = 16 * tile + 8 * mt + 2 * q + hh;
                        if ((r & 3) == 0) { __hip_atomic_fetch_add(imp + n, s4, __ATOMIC_RELAXED, __HIP_MEMORY_SCOPE_WORKGROUP); if (n < 63) __hip_atomic_fetch_add(imp + n + 1, s3, __ATOMIC_RELAXED, __HIP_MEMORY_SCOPE_WORKGROUP); } }
                }
                if (PV) {
#pragma unroll
                    for (int sI = 0; sI < 2; ++sI) { u32x4 pp; pp.x = pk2(sacc[mt][8 * sI], sacc[mt][8 * sI + 1]); pp.y = pk2(sacc[mt][8 * sI + 2], sacc[mt][8 * sI + 3]); pp.z = pk2(sacc[mt][8 * sI + 4], sacc[mt][8 * sI + 5]); pp.w = pk2(sacc[mt][8 * sI + 6], sacc[mt][8 * sI + 7]);
                        pa[mt][sI] = __builtin_bit_cast(bf16x8, pp); }
                }
            }
        }
        if (gB && nxt <= thi) NSA_WAIT_KEEP(nn <= thi);
        NSA_BAR();
        if (!gB && nn <= thi) dma(nn, st2);
        if (PV) {
            const int q4 = (lane & 15) >> 2, k2 = 2 * ((lane >> 4) & 1) + ((lane & 3) >> 1), sub8 = 8 * (lane & 1);
            s16x4 vb[2][8];
#define NSA_LDV(g, dst) do { const int _row0 = 16 * (g) + 4 * hh + q4; _Pragma("unroll") for (int nt = 0; nt < 4; ++nt) { \
                dst[2 * nt] = lds_tr16(Ls + N_V + _row0 * 256 + 64 * (nt ^ q4) + 16 * (k2 ^ hh) + sub8); \
                dst[2 * nt + 1] = lds_tr16(Ls + N_V + (_row0 + 8) * 256 + 64 * (nt ^ q4) + 16 * (k2 ^ (hh + 2)) + sub8); } } while (0)
            NSA_LDV(0, vb[0]);
#pragma unroll
            for (int g = 0; g < 4; ++g) {
                if (g == 0) NSA_LDV(1, vb[1]); else if (g == 1) NSA_LDV(2, vb[0]); else if (g == 2) NSA_LDV(3, vb[1]);
                asm volatile("" ::: "memory");
#pragma unroll
                for (int nt = 0; nt < 4; ++nt) { const s16x4 b0 = vb[g & 1][2 * nt], b1 = vb[g & 1][2 * nt + 1];
                    bf16x8 bfg; bfg[0] = b0[0]; bfg[1] = b0[1]; bfg[2] = b0[2]; bfg[3] = b0[3]; bfg[4] = b1[0]; bfg[5] = b1[1]; bfg[6] = b1[2]; bfg[7] = b1[3];
                    oacc[nt] = __builtin_amdgcn_mfma_f32_32x32x16_bf16(pa[g >> 1][g & 1], bfg, oacc[nt], 0, 0, 0); }
            }
#undef NSA_LDV
        }
        tile = nxt; nxt = nn; nn = nn <= thi ? nextt(nn) : nn;
        cur = cur == 2 ? 0 : cur + 1;
    }
#undef NSA_WAIT_KEEP
    if (!gB) NSA_BAR();
    __syncthreads();
}

__device__ __forceinline__ void p_nsa(Frame& F, const Args& A) {
    const bf16* U = (const bf16*)(F.ws + WS_U); bf16* HB = (bf16*)(F.ws + WS_HB); const float* GL = (const float*)(F.ws + WS_GL);
    LAS unsigned char* L = F.lds;
    LAS float* LUT = (LAS float*)(L + N_LUT); LAS float* cst = (LAS float*)(L + N_CST);
    for (int i = F.tid; i < 1024; i += NTHR) LUT[i] = A.in[1][t5_bucket_dev(i >> 3) * 8 + (i & 7)] * LOG2E;
    if (F.wave == 0) {
        float gm = 0.f, bm = 0.f;
        for (int i = F.lane; i < 128; i += 64) gm = fmaxf(gm, fmaxf(fabsf(A.in[16][i]), fmaxf(fabsf(A.in[17][i]), fabsf(A.in[18][i]))));
        for (int i = F.lane; i < 256; i += 64) bm = fmaxf(bm, fabsf(A.in[1][i]));
#pragma unroll
        for (int o = 1; o < 64; o <<= 1) { gm = fmaxf(gm, __shfl_xor(gm, o)); bm = fmaxf(bm, __shfl_xor(bm, o)); }
        if (F.lane == 0) { cst[0] = gm * 11.3137085f; cst[1] = bm * LOG2E; }
    }
    __syncthreads();
    const float kmax = cst[0], bmax = cst[1];
    for (int ui = F.bid; ui < 2048; ui += F.G) {
        NsaCtx X; X.L = L; X.U = U; X.KC = (const bf16*)(F.ws + WS_KCMP); X.VC = (const bf16*)(F.ws + WS_VCMP);
        int tid = F.tid, lane = F.lane; asm volatile("" : "+v"(tid), "+v"(lane));
        X.tid = tid; X.lane = lane; X.w = F.wave; X.r = lane & 31; X.hh = lane >> 5;
        const int kr = ui >> 8, cc = ui & 255, bg = kr * 4 + (cc >> 6);
        X.b = bg >> 1; X.g = bg & 1; X.qblk = (kr & 1) ? 63 - (cc & 63) : (cc & 63); X.t0 = 64 * X.qblk; X.bat = (size_t)X.b * SEQ;
        const int tq = X.r >> 2, hd = X.r & 3; X.t = X.t0 + 8 * X.w + tq; X.head = 4 * X.g + hd;
        const size_t row = X.bat + X.t;
        if (tid == 0) *(LAS unsigned long long*)(L + N_UNI) = 0ull;
        for (int i = tid; i < 4096; i += NTHR) ((LAS float*)(L + N_IMP))[i] = 0.f;
        bf16x8 qf[8]; float qn2 = 0.f;
        {
            u32x4 qr[8]; float ss = 0.f;
#pragma unroll
            for (int ks = 0; ks < 8; ++ks) { qr[ks] = *(const u32x4*)(U + row * LDO + OQ + X.head * 128 + 16 * ks + 8 * X.hh);
#pragma unroll
                for (int e = 0; e < 4; ++e) { const float a = bflo(qr[ks][e]), c = bfhi(qr[ks][e]); ss += a * a + c * c; } }
            ss += __shfl_xor(ss, 32);
            const float rs = 1.f / sqrtf(ss * (1.f / 128.f) + NORM_EPS);
#pragma unroll
            for (int ks = 0; ks < 8; ++ks) { const float* gq = A.in[15] + 16 * ks + 8 * X.hh; u32x4 pk;
#pragma unroll
                for (int e = 0; e < 4; ++e) { const float a = bflo(qr[ks][e]) * rs * gq[2 * e], c = bfhi(qr[ks][e]) * rs * gq[2 * e + 1]; qn2 += a * a + c * c; pk[e] = pk2(a * (0.0883883476f * LOG2E), c * (0.0883883476f * LOG2E)); }
                qf[ks] = __builtin_bit_cast(bf16x8, pk); }
            qn2 += __shfl_xor(qn2, 32);
        }
        X.mrow = sqrtf(qn2) * (0.0883883476f * LOG2E) * kmax + bmax;
        X.cfar = LUT[127 * 8 + X.head] - X.mrow;
        X.mlo = 0u; X.mhi = 0u;
        const float g_c = 1.f / (1.f + __expf(-GL[row * 24 + X.head])), g_s = 1.f / (1.f + __expf(-GL[row * 24 + 8 + X.head])), g_w = 1.f / (1.f + __expf(-GL[row * 24 + 16 + X.head]));
        f32x16 oacc[4];
#pragma unroll
        for (int nt = 0; nt < 4; ++nt) oacc[nt] = (f32x16){0.f, 0.f, 0.f, 0.f, 0.f, 0.f, 0.f, 0.f, 0.f, 0.f, 0.f, 0.f, 0.f, 0.f, 0.f, 0.f};
        const int ntc = ((4 * X.qblk + 2) >> 6) + 1;
        u32x4* park = (u32x4*)(F.ws + WS_PARK) + ((size_t)(F.bid * NWAVES + X.w) * 64 + lane) * 8;
#define NSA_FOLD(fcol, FIRST, LAST) do { LAS float* _fac = (LAS float*)(L + N_FAC) + X.w * 32; LDS_WAIT(); if (lane < 32) _fac[lane] = (fcol); LDS_WAIT(); \
            if (!(FIRST)) { asm volatile("s_waitcnt vmcnt(0)" ::: "memory"); __builtin_amdgcn_fence(__ATOMIC_ACQUIRE, "agent"); } \
            _Pragma("unroll") for (int nt = 0; nt < 4; ++nt) { u32x4 _p0 = (u32x4){0u, 0u, 0u, 0u}, _p1 = _p0; if (!(FIRST)) { _p0 = park[2 * nt]; _p1 = park[2 * nt + 1]; } \
                _Pragma("unroll") for (int q = 0; q < 4; ++q) { const f32x4 _fr = *(const LAS f32x4*)(_fac + 8 * q + 4 * X.hh); const unsigned _wa = q < 2 ? _p0[2 * q] : _p1[2 * q - 4], _wb = q < 2 ? _p0[2 * q + 1] : _p1[2 * q - 3]; \
                    float _a = oacc[nt][4 * q] * _fr.x, _b = oacc[nt][4 * q + 1] * _fr.y, _c = oacc[nt][4 * q + 2] * _fr.z, _d = oacc[nt][4 * q + 3] * _fr.w; \
                    if (!(FIRST)) { _a += bflo(_wa); _b += bfhi(_wa); _c += bflo(_wb); _d += bfhi(_wb); } \
                    oacc[nt][4 * q] = _a; oacc[nt][4 * q + 1] = _b; oacc[nt][4 * q + 2] = _c; oacc[nt][4 * q + 3] = _d; } \
                if (!(LAST)) { park[2 * nt] = (u32x4){pk2(oacc[nt][0], oacc[nt][1]), pk2(oacc[nt][2], oacc[nt][3]), pk2(oacc[nt][4], oacc[nt][5]), pk2(oacc[nt][6], oacc[nt][7])}; \
                               park[2 * nt + 1] = (u32x4){pk2(oacc[nt][8], oacc[nt][9]), pk2(oacc[nt][10], oacc[nt][11]), pk2(oacc[nt][12], oacc[nt][13]), pk2(oacc[nt][14], oacc[nt][15])}; \
                               oacc[nt] = (f32x16){0.f, 0.f, 0.f, 0.f, 0.f, 0.f, 0.f, 0.f, 0.f, 0.f, 0.f, 0.f, 0.f, 0.f, 0.f, 0.f}; } } } while (0)
        float l_c = 0.f;
        nsa_pass<BR_CMP, true, true, false, true>(X, qf, oacc, l_c, 1.f, 0, ntc - 1, ~0ull);
        l_c += __shfl_xor(l_c, 32);
        const float il_c = l_c > 0.f ? 1.f / l_c : 0.f;
        NSA_FOLD(g_c * il_c, true, false);
        { float dummy = 0.f; nsa_pass<BR_CMP, false, false, true>(X, qf, oacc, dummy, il_c, 0, ntc - 1, ~0ull); }
        {
            LDS_WAIT();
            const LAS float* impw = (const LAS float*)(L + N_IMP) + X.w * 8 * 64;
            const int n = lane, cur = X.qblk;
            unsigned long long wor = 0ull;
#pragma unroll 1
            for (int q = 0; q < 8; ++q) {
                const float imp = impw[q * 64 + n];
                const bool forced = (n == 0) || (n == cur) || (n == cur - 1);
                float val = forced ? 3.0e38f : imp; if (n > cur) val = -3.0e38f;
                int rank = 0;
#pragma unroll 8
                for (int m = 0; m < 64; ++m) { const float vm = __shfl(val, m); rank += (vm > val || (vm == val && m < n)) ? 1 : 0; }
                const unsigned long long mk = __ballot(n <= cur && rank < 16);
                wor |= mk;
                if ((X.r >> 2) == q) { X.mlo = (unsigned)mk; X.mhi = (unsigned)(mk >> 32); }
            }
            if (lane == 0) __hip_atomic_fetch_or((LAS unsigned long long*)(L + N_UNI), wor, __ATOMIC_RELAXED, __HIP_MEMORY_SCOPE_WORKGROUP);
        }
        __syncthreads();
        const unsigned long long uni = *(const LAS unsigned long long*)(L + N_UNI);
        float l_s = 0.f;
        nsa_pass<BR_SEL, true, true, false, true>(X, qf, oacc, l_s, 1.f, 0, X.qblk, uni);
        l_s += __shfl_xor(l_s, 32);
        NSA_FOLD(l_s > 0.f ? g_s / l_s : 0.f, false, false);
        const int wlo = X.qblk >= 8 ? X.qblk - 8 : 0;
        float l_w = 0.f;
        nsa_pass<BR_WIN, true, true, false, true>(X, qf, oacc, l_w, 1.f, wlo, X.qblk, ~0ull);
        l_w += __shfl_xor(l_w, 32);
        NSA_FOLD(l_w > 0.f ? g_w / l_w : 0.f, false, true);
#undef NSA_FOLD
#pragma unroll
        for (int i = 0; i < 16; ++i) { const int c32 = 8 * (i >> 2) + 4 * X.hh + (i & 3);
            bf16* op = HB + (X.bat + X.t0 + 8 * X.w + (c32 >> 2)) * DM + (4 * X.g + (c32 & 3)) * 128 + X.r;
#pragma unroll
            for (int nt = 0; nt < 4; ++nt) op[32 * nt] = (bf16)f2bfh(oacc[nt][i]); }
    }
}

constexpr int N_PHASES = 18;
__global__ void __launch_bounds__(NTHR, 2) mk_fwd(Args args) {
    extern __shared__ __attribute__((aligned(16))) unsigned char lds[];
    Frame F;
    F.lds = (LAS unsigned char*)lds;
    F.MISC = (volatile LAS unsigned*)(F.lds + MISC_OFF);
    F.tid = threadIdx.x; F.lane = F.tid & 63; F.wave = __builtin_amdgcn_readfirstlane(F.tid >> 6);
    F.G = gridDim.x; F.bid = blockIdx.x;
    F.ws = args.ws; F.out = args.out; F.ctl = (gu32*)(args.ws + WS_CTL);
    if (F.tid < 64) F.MISC[F.tid] = 0u;
    __syncthreads();
    const int lo = args.ph_lo, hi = args.ph_hi;
    XcdBarrier bar; bar.bar = (unsigned*)(F.ctl + CW_BAR); bar.x = 0; bar.st = nullptr;
    if (hi - lo > 1) bar = xcd_barrier_post((unsigned*)(F.ctl + CW_BAR), F.MISC + 8);
#ifndef PHMASK
#define PHMASK 0xffffffffu
#endif
#define IN(k) (((PHMASK >> (k)) & 1u) && lo <= (k) && (k) < hi)
#ifndef REPMASK
#define REPMASK 0u
#endif
#define RUNS(k) (1 + (int)((REPMASK >> (k)) & 1u))
#define SEAM(k) do { if (IN(k) && IN((k) + 1)) xcd_barrier(bar); } while (0)
    if (IN(0)) { for (int rp = 0; rp < RUNS(0); ++rp) p_prologue(F, args); } SEAM(0);
    if (IN(1)) for (int rp = 0; rp < RUNS(1); ++rp) {
        pg8::StaticOrder S; S.init(F.ws + WS_HB, F.ws + WS_WIE, MTOK, LDE, DM, F.G, F.bid);
        pg8::EpiBf16 E{(bf16*)(F.ws + WS_U), LDE};
        pg8::gemm_phase<pg8::EpiBf16, pg8::StaticOrder, true>(F.lds, DM, S, E);
    } SEAM(1);
    if (IN(2)) { p_ssd(F, args); } SEAM(2);
    if (IN(3)) { for (int rp = 0; rp < RUNS(3); ++rp) p_dsa(F, args); } SEAM(3);
    if (IN(4)) {
        pg8::StaticOrder S; S.init(F.ws + WS_HB, F.ws + WS_WOE, MTOK, DM, DM, F.G, F.bid);
        pg8::EpiResXB E{args.in[0], nullptr, (bf16*)(F.ws + WS_XB)};
        pg8::gemm_phase<pg8::EpiResXB, pg8::StaticOrder, true>(F.lds, DM, S, E);
    } SEAM(4);
    if (IN(5)) { p_norm_route<0>(F, (const bf16*)(F.ws + WS_XB), args.in[3], 0); } SEAM(5);
    if (IN(6)) { p_moe_gu(F, 0);
#if (REPMASK >> 6) & 1
        p_moe_gu(F, 0);
#endif
    } SEAM(6);
    if (IN(7)) { p_moe_down<false>(F, 0, 0); } SEAM(7);
    if (IN(8)) { p_moe_down<false>(F, 0, 1); } SEAM(8);
    if (IN(9)) { for (int rp = 0; rp < RUNS(9); ++rp) p_norm_route<1>(F, (const bf16*)(F.ws + WS_XB), args.in[2] + DM, 0); } SEAM(9);
    if (IN(10)) {
        pg8::StaticOrder S; S.init(F.ws + WS_HB, F.ws + WS_WIO, MTOK, LDO, DM, F.G, F.bid);
        pg8::EpiBf16 E{(bf16*)(F.ws + WS_U), LDO};
        pg8::gemm_phase<pg8::EpiBf16, pg8::StaticOrder, true>(F.lds, DM, S, E);
    } SEAM(10);
    if (IN(11)) { p_compress(F, args); } SEAM(11);
    if (IN(12)) { p_nsa(F, args);
#if (REPMASK >> 12) & 1
        p_nsa(F, args);
#endif
    } SEAM(12);
    if (IN(13)) {
        pg8::StaticOrder S; S.init(F.ws + WS_HB, F.ws + WS_WOO, MTOK, DM, DM, F.G, F.bid);
        pg8::EpiResXB E{nullptr, (const bf16*)(F.ws + WS_XB), (bf16*)(F.ws + WS_XB)};
        pg8::gemm_phase<pg8::EpiResXB, pg8::StaticOrder, true>(F.lds, DM, S, E);
    } SEAM(13);
    if (IN(14)) { p_norm_route<0>(F, (const bf16*)(F.ws + WS_XB), args.in[3] + DM, 1); } SEAM(14);
    if (IN(15)) { p_moe_gu(F, 1); } SEAM(15);
    if (IN(16)) { p_moe_down<false>(F, 1, 0); } SEAM(16);
    if (IN(17)) { p_moe_down<true>(F, 1, 1); }
#undef IN
#undef SEAM
}

extern "C" void kernel_launch(void* const* d_in, const int* in_sizes, int n_in, void* d_out, int out_size, void* d_ws, size_t ws_size, hipStream_t stream) {
    static int grid = 0;
    if (grid == 0) {
        if (n_in != 31 || ws_size < WS_END) { fprintf(stderr, "kernel_launch: unexpected n_in %d / ws %zu\n", n_in, ws_size); grid = -1; return; }
        int dev = 0, cus = 0;
        if (hipGetDevice(&dev) != hipSuccess || hipDeviceGetAttribute(&cus, hipDeviceAttributeMultiprocessorCount, dev) != hipSuccess) { grid = -1; return; }
        if (hipFuncSetAttribute((const void*)mk_fwd, hipFuncAttributeMaxDynamicSharedMemorySize, LDS_BYTES) != hipSuccess) { fprintf(stderr, "kernel_launch: hipFuncSetAttribute failed\n"); grid = -1; return; }
        grid = cus;
    }
    if (grid < 0) return;
    (void)hipMemsetAsync((char*)d_ws + WS_CTL, 0, CTL_ZERO_BYTES, stream);
    Args a{};
    for (int i = 0; i < 31; ++i) a.in[i] = (const float*)d_in[i];
    a.out = (float*)d_out; a.ws = (unsigned char*)d_ws; a.rep = (REP_PART || REP_PHASE >= 0) ? 2 : 1; a.pad = 0; a.rep = 2; a.pad = 0;
#if defined(MK_PER_PHASE)
    for (int p = 0; p < N_PHASES; ++p) { a.ph_lo = p; a.ph_hi = p + 1; hipLaunchKernelGGL(mk_fwd, dim3(grid), dim3(NTHR), LDS_BYTES, stream, a); }
#else
    a.ph_lo = 0; a.ph_hi = N_PHASES; hipLaunchKernelGGL(mk_fwd, dim3(grid), dim3(NTHR), LDS_BYTES, stream, a);
#endif
}
```

```cpp
#include <hip/hip_runtime.h>
#include <cstdio>
#include <cstdint>

#define GAS __attribute__((address_space(1)))
#define LAS __attribute__((address_space(3)))
typedef unsigned short bf16;
typedef short bf16x8 __attribute__((ext_vector_type(8)));
typedef float f32x4 __attribute__((ext_vector_type(4)));
typedef float f32x2 __attribute__((ext_vector_type(2)));
typedef float f32x16 __attribute__((ext_vector_type(16)));
typedef unsigned u32x4 __attribute__((ext_vector_type(4)));
typedef unsigned u32x2 __attribute__((ext_vector_type(2)));
typedef GAS unsigned gu32;
#define RLX_AGENT __ATOMIC_RELAXED, __HIP_MEMORY_SCOPE_AGENT
#define LDS_WAIT() asm volatile("s_waitcnt lgkmcnt(0)" ::: "memory")
#define VM_WAIT() asm volatile("s_waitcnt vmcnt(0)" ::: "memory")

constexpr int NB = 16, SEQ = 4096, DM = 1024, MTOK = NB * SEQ;
constexpr float NORM_EPS = 1e-6f;
constexpr int LDE = 2560;
constexpr int EZ = 0, EXS = 512, EBB = 1024, ECC = 1280, EQ = 1536, EK = 2048, EV = 2112, EIQ = 2176, EIK = 2432, EDT = 2496, EIW = 2504;
constexpr int LDO = 2560;
constexpr int OQ = 0, OKC = 1024, OVC = 1280, OKS = 1536, OVS = 1792, OKW = 2048, OVW = 2304;
constexpr int NWAVES = 8, NTHR = 512;

constexpr size_t MiB = 1u << 20;
constexpr size_t WS_CTL = 0, CTL_ZERO_BYTES = 1 * MiB;
constexpr size_t WS_WIE = 1 * MiB, WS_WOE = 6 * MiB, WS_WIO = 8 * MiB, WS_WOO = 13 * MiB;
constexpr size_t WS_W1K = 15 * MiB, WS_W1V = 16 * MiB, WS_W2 = 17 * MiB, WS_WR = 18 * MiB;
constexpr size_t WS_WGL = WS_WR + 256 * 1024;
constexpr size_t WS_TOK = 19 * MiB;
constexpr size_t WS_GL = 20 * MiB;
constexpr size_t WS_KCMP = 26 * MiB, WS_VCMP = 28 * MiB;
constexpr size_t WS_LIST = 32 * MiB;
constexpr size_t WS_WGU = 48 * MiB;
constexpr size_t WS_WD = 176 * MiB;
constexpr size_t WS_HB = 240 * MiB;
constexpr size_t WS_U = 368 * MiB;
constexpr size_t WS_LISTW = 720 * MiB;
constexpr size_t WS_XB = 736 * MiB;
constexpr size_t WS_PARK = 864 * MiB;
constexpr size_t WS_CC = 880 * MiB;
constexpr size_t WS_AC = 912 * MiB;
constexpr size_t WS_END = 916 * MiB;
constexpr int CW_TMO = 0, CW_CODE = 1, CW_BAR = 4096, CW_CNT = 8192;

constexpr int RING_BYTES = 131072;
constexpr int LDS_BYTES = 147456;
constexpr int MISC_OFF = LDS_BYTES - 256;
constexpr int MOE_OFF = LDS_BYTES - 2048;

__device__ __forceinline__ unsigned f2bf(float f) { unsigned u = __builtin_bit_cast(unsigned, f); return (u + 0x7fffu + ((u >> 16) & 1u)) >> 16; }
typedef __bf16 bf16x2_t __attribute__((ext_vector_type(2)));
__device__ __forceinline__ unsigned pk2(float lo, float hi) { const f32x2 v = {lo, hi}; const bf16x2_t b = __builtin_convertvector(v, bf16x2_t); return __builtin_bit_cast(unsigned, b); }
__device__ __forceinline__ unsigned short f2bfh(float f) { return (unsigned short)(pk2(f, f) & 0xffffu); }
__device__ __forceinline__ float bf2f(unsigned short b) { return __builtin_bit_cast(float, ((unsigned)b) << 16); }
__device__ __forceinline__ float bflo(unsigned w) { return __builtin_bit_cast(float, w << 16); }
__device__ __forceinline__ float bfhi(unsigned w) { return __builtin_bit_cast(float, w & 0xffff0000u); }
__device__ __forceinline__ float siluf(float v) { return v * __builtin_amdgcn_rcpf(1.f + __builtin_amdgcn_exp2f(-1.44269504f * v)); }

#define XB_TMO      128
#define XB_XCNT(j)  (256  + 64 * (j))
#define XB_XSUB(j)  (1280 + 64 * (j))
#define XB_XGEN(j)  (2304 + 64 * (j))
#define XB_TOP      3328
#define XB_TOPGEN   3392
#define XCD_BAR_WORDS 3456
#define XB_SPIN_CAP (1u << 20)
__device__ __forceinline__ unsigned xb_ld(unsigned* p)              { return __hip_atomic_load(p, __ATOMIC_RELAXED, __HIP_MEMORY_SCOPE_AGENT); }
__device__ __forceinline__ unsigned xb_add(unsigned* p, unsigned v) { return __hip_atomic_fetch_add(p, v, __ATOMIC_RELAXED, __HIP_MEMORY_SCOPE_AGENT); }
__device__ __forceinline__ unsigned xb_xcc_id() { return (unsigned)__builtin_amdgcn_s_getreg((3 << 11) | 20) & 0xFu; }
#define XB_SPIN(cond, bar) do { unsigned _sp = 0; while (cond) { __builtin_amdgcn_s_sleep(1); \
    if ((++_sp & 255u) == 0u) { if (xb_ld(&(bar)[XB_TMO])) break; if (_sp > XB_SPIN_CAP) { atomicAdd(&(bar)[XB_TMO], 1u); break; } } } } while (0)
struct XcdBarrier { unsigned* bar; unsigned x; volatile LAS unsigned* st; };
__device__ __forceinline__ XcdBarrier xcd_barrier_post(unsigned* bar, volatile LAS unsigned* st) {
    XcdBarrier b; b.bar = bar; b.x = xb_xcc_id(); b.st = st;
    if (threadIdx.x == 0) (void)xb_add(&bar[XB_XCNT(b.x)], 1u);
    return b;
}
__device__ __forceinline__ void xcd_barrier_complete(unsigned* bar, unsigned x, unsigned& nloc, unsigned& nx) {
    const unsigned G = gridDim.x * gridDim.y * gridDim.z;
    unsigned sum, cnt, mine, sp = 0u;
    for (;;) {
        sum = 0u; cnt = 0u; mine = 0u;
#pragma unroll
        for (unsigned j = 0; j < 16; ++j) { const unsigned c = xb_ld(&bar[XB_XCNT(j)]); sum += c; cnt += (c > 0u) ? 1u : 0u; mine = (j == x) ? c : mine; }
        if (sum == G) break;
        __builtin_amdgcn_s_sleep(1);
        if ((++sp & 255u) == 0u) { if (xb_ld(&bar[XB_TMO])) break; if (sp > XB_SPIN_CAP) { atomicAdd(&bar[XB_TMO], 1u); break; } }
    }
    nloc = mine > 0u ? mine : 1u; nx = cnt > 0u ? cnt : 1u;
}
__device__ __forceinline__ void xcd_barrier(const XcdBarrier& b) {
    asm volatile("s_waitcnt vmcnt(0)" ::: "memory");
    __syncthreads();
    if (threadIdx.x == 0) {
        unsigned* bar = b.bar;
        __builtin_amdgcn_s_waitcnt(0);
        unsigned nloc = b.st[0], nx = b.st[1];
        if (nloc == 0u) { xcd_barrier_complete(bar, b.x, nloc, nx); b.st[0] = nloc; b.st[1] = nx; }
        const unsigned old = xb_add(&bar[XB_XSUB(b.x)], 1u);
        const unsigned gen = old / nloc;
        if (old + 1u == (gen + 1u) * nloc) {
            __builtin_amdgcn_fence(__ATOMIC_RELEASE, "agent");
            asm volatile("s_waitcnt vmcnt(0)" ::: "memory");
            const unsigned og = xb_add(&bar[XB_TOP], 1u);
            const unsigned tg = og / nx;
            if (og + 1u == (tg + 1u) * nx) xb_add(&bar[XB_TOPGEN], 1u);
            else XB_SPIN(xb_ld(&bar[XB_TOPGEN]) == tg, bar);
            __builtin_amdgcn_fence(__ATOMIC_ACQUIRE, "agent");
            xb_add(&bar[XB_XGEN(b.x)], 1u);
            asm volatile("s_waitcnt vmcnt(0)" ::: "memory");
        } else {
            XB_SPIN(xb_ld(&bar[XB_XGEN(b.x)]) == gen, bar);
            __builtin_amdgcn_fence(__ATOMIC_ACQUIRE, "agent");
            asm volatile("s_waitcnt vmcnt(0)" ::: "memory");
        }
    }
    __syncthreads();
}

namespace pg8 {
constexpr int BM = 256, BK = 64, HALF = 128, HTB = HALF * BK * 2, STAGE_BYTES = 8 * HTB, NXCD = 8, WGM = 8;
__host__ __device__ __forceinline__ int lds_byte(int r, int c) { const int st = (r >> 4) * 2 + (c >> 5), rr = r & 15, cc = c & 31, ob = rr * 64 + cc * 2; return st * 1024 + (ob ^ (((ob >> 9) & 1) << 5)); }
__host__ __device__ __forceinline__ void stage_rc(int b, int& R, int& C) { const int st = b / 1024, sb = b % 1024, swz = sb ^ (((sb >> 9) & 1) << 5); R = (st >> 1) * 16 + swz / 64; C = (st & 1) * 32 + (swz % 64) / 2; }
__host__ __device__ __forceinline__ int perm32(int rho) { const int n = rho >> 4, i = rho & 15; return 8 * (i >> 2) + 4 * n + (i & 3); }
__device__ __forceinline__ unsigned cvt_pk_bf16(float lo, float hi) { unsigned r; asm volatile("v_cvt_pk_bf16_f32 %0, %1, %2" : "=v"(r) : "v"(lo), "v"(hi)); return r; }

struct Unit { const char* A; const char* B; int pm, pn, aux; };

struct StaticOrder {
    const char* A; const char* Bt; int K, nM, nN, nwg, G, c;
    __device__ void init(const void* A_, const void* Bt_, int M, int N, int K_, int G_, int c_) { A = (const char*)A_; Bt = (const char*)Bt_; K = K_; nM = M / BM; nN = N / BM; nwg = nM * nN; G = G_; c = c_; }
    __device__ __forceinline__ bool next(int i, Unit& u) const {
        const long L = (long)i * G + c; if (L >= nwg) return false;
        int wgid = (int)L; { const int q = nwg / NXCD, r = nwg % NXCD, xcd = wgid % NXCD, off = wgid / NXCD; wgid = (xcd < r ? xcd * (q + 1) : r * (q + 1) + (xcd - r) * q) + off; }
        const int nig = WGM * nN, gid = wgid / nig, fm = gid * WGM, gsz = (nM - fm) < WGM ? (nM - fm) : WGM;
        u.pm = fm + ((wgid % nig) % gsz); u.pn = (wgid % nig) / gsz; u.aux = 0;
        u.A = A + (size_t)u.pm * BM * K * 2; u.B = Bt + (size_t)u.pn * BM * K * 2; return true;
    }
    __device__ __forceinline__ unsigned arow(const Unit&, int r) const { return (unsigned)(r * K) * 2u; }
};

template <class Epi, class Sched, bool ALIGN_EPI>
__device__ __forceinline__ void gemm_phase(LAS unsigned char* lds, const int K, const Sched& S, const Epi& E) {
    const int tid = threadIdx.x, wid = __builtin_amdgcn_readfirstlane(tid >> 6), lane = tid & 63, wr = wid >> 2, wc = wid & 3, fr = lane & 15, fq = lane >> 4;
    const int nt = K / BK;
    int RA[2], CA[2]; unsigned voffB[2];
#pragma unroll
    for (int i = 0; i < 2; ++i) { int R, C; stage_rc(tid * 16 + i * 8192, R, C); const int Rb = Epi::PERM ? ((R & ~31) + perm32(R & 31)) : R;
        RA[i] = R; CA[i] = C; voffB[i] = (unsigned)(Rb * K + C) * 2u; }
    const size_t kstep = (size_t)(BK * 2);
    const size_t hstep = (size_t)HALF * K * 2;
    const unsigned ldsw = (unsigned)wid * 1024u;
    const int aoff = lds_byte(wr * 64 + fr, fq * 8), boff = lds_byte(wc * 32 + fr, fq * 8);
#define PG8_SA(b, h) (((b) * 2 + (h)) * HTB)
#define PG8_SB(b, h) ((4 + (b) * 2 + (h)) * HTB)
#define PG8_STAGE(bufoff, gbase, voff) do { _Pragma("unroll") for (int _i = 0; _i < 2; ++_i) \
        __builtin_amdgcn_global_load_lds((const unsigned*)((const char*)(gbase) + (voff)[_i]), (LAS unsigned*)(lds + (bufoff) + ldsw + _i * 8192), 16, 0, 0); } while (0)
#define PG8_LDA(dst, b, h) do { _Pragma("unroll") for (int m = 0; m < 4; ++m) _Pragma("unroll") for (int k = 0; k < 2; ++k) dst[m][k] = *(const LAS bf16x8*)(lds + PG8_SA(b, h) + aoff + m * 2048 + k * 1024); } while (0)
#define PG8_LDB(dst, b, h) do { _Pragma("unroll") for (int n = 0; n < 2; ++n) _Pragma("unroll") for (int k = 0; k < 2; ++k) dst[n][k] = *(const LAS bf16x8*)(lds + PG8_SB(b, h) + boff + n * 2048 + k * 1024); } while (0)
#define PG8_MMA(ai, bj, At, Bt) do { __builtin_amdgcn_s_setprio(1); _Pragma("unroll") for (int m = 0; m < 4; ++m) _Pragma("unroll") for (int n = 0; n < 2; ++n) _Pragma("unroll") for (int k = 0; k < 2; ++k) \
        acc[ai][bj][m][n] = __builtin_amdgcn_mfma_f32_16x16x32_bf16(Bt[n][k], At[m][k], acc[ai][bj][m][n], 0, 0, 0); __builtin_amdgcn_s_setprio(0); } while (0)
#define PG8_WAIT_V(n) asm volatile("s_waitcnt vmcnt(" #n ")" ::: "memory")
#define PG8_WAIT_L(n) asm volatile("s_waitcnt lgkmcnt(" #n ")" ::: "memory")
#define PG8_BAR __builtin_amdgcn_s_barrier()
#define PG8_SCHED __builtin_amdgcn_sched_barrier(0)
    Unit cur, nxt; int ui = 0;
    if (!S.next(0, cur)) return;
    f32x4 acc[2][2][4][2];
#pragma unroll
    for (int a = 0; a < 2; ++a)
#pragma unroll
        for (int b = 0; b < 2; ++b)
#pragma unroll
            for (int m = 0; m < 4; ++m)
#pragma unroll
                for (int n = 0; n < 2; ++n) acc[a][b][m][n] = (f32x4){0.f, 0.f, 0.f, 0.f};
    bf16x8 At[4][2], B0[2][2], B1[2][2];
    unsigned vA0[2], vA1[2], nA0[2], nA1[2];
#pragma unroll
    for (int i = 0; i < 2; ++i) { vA0[i] = S.arow(cur, RA[i]) + CA[i] * 2u; vA1[i] = S.arow(cur, HALF + RA[i]) + CA[i] * 2u; nA0[i] = vA0[i]; nA1[i] = vA1[i]; }
    const char* cA = cur.A; const char* cB = cur.B;
    PG8_STAGE(PG8_SB(0, 0), cB, voffB); PG8_STAGE(PG8_SB(0, 1), cB + hstep, voffB); PG8_STAGE(PG8_SA(0, 0), cA, vA0); PG8_STAGE(PG8_SA(0, 1), cA, vA1);
    if (wr == 1) PG8_BAR;
    PG8_WAIT_V(2); PG8_BAR;
    PG8_STAGE(PG8_SB(1, 0), cB + kstep, voffB); PG8_STAGE(PG8_SA(1, 0), cA + kstep, vA0); PG8_STAGE(PG8_SB(1, 1), cB + hstep + kstep, voffB);
    PG8_WAIT_V(6); PG8_BAR;
    for (;;) {
        const bool has_next = S.next(ui + 1, nxt);
        const char* nA = has_next ? nxt.A : cA; const char* nB = has_next ? nxt.B : cB;
        if (has_next) {
#pragma unroll
            for (int i = 0; i < 2; ++i) { nA0[i] = S.arow(nxt, RA[i]) + CA[i] * 2u; nA1[i] = S.arow(nxt, HALF + RA[i]) + CA[i] * 2u; }
        }
        for (int t = 0; t < nt; t += 2) {
            const bool last = (t == nt - 2);
            const char* a1 = cA + (size_t)(t + 1) * kstep;
            const char* a2 = last ? nA : cA + (size_t)(t + 2) * kstep; const char* b2 = last ? nB : cB + (size_t)(t + 2) * kstep;
            const char* a3 = a2 + kstep; const char* b3 = b2 + kstep;
            unsigned w0[2], w1[2];
#pragma unroll
            for (int i = 0; i < 2; ++i) { w0[i] = last ? nA0[i] : vA0[i]; w1[i] = last ? nA1[i] : vA1[i]; }
            PG8_LDB(B0, 0, 0); PG8_LDB(B1, 0, 1); PG8_SCHED; PG8_LDA(At, 0, 0); PG8_STAGE(PG8_SA(1, 1), a1, vA1);
            PG8_WAIT_V(8); PG8_WAIT_L(0); PG8_BAR; PG8_MMA(0, 0, At, B0); PG8_MMA(0, 1, At, B1); PG8_BAR; PG8_SCHED;
            PG8_LDA(At, 0, 1); PG8_STAGE(PG8_SB(0, 0), b2, voffB); PG8_STAGE(PG8_SB(0, 1), b2 + hstep, voffB); PG8_STAGE(PG8_SA(0, 0), a2, w0);
            PG8_WAIT_V(8); PG8_WAIT_L(0); PG8_BAR; PG8_MMA(1, 0, At, B0); PG8_MMA(1, 1, At, B1); PG8_BAR; PG8_SCHED;
            PG8_LDB(B0, 1, 0); PG8_LDB(B1, 1, 1); PG8_SCHED; PG8_LDA(At, 1, 0); PG8_STAGE(PG8_SA(0, 1), a2, w1);
            PG8_WAIT_V(8); PG8_WAIT_L(0); PG8_BAR; PG8_MMA(0, 0, At, B0); PG8_MMA(0, 1, At, B1); PG8_BAR; PG8_SCHED;
            PG8_LDA(At, 1, 1); PG8_STAGE(PG8_SB(1, 0), b3, voffB); PG8_STAGE(PG8_SB(1, 1), b3 + hstep, voffB); PG8_STAGE(PG8_SA(1, 0), a3, w0);
            PG8_WAIT_V(8); PG8_WAIT_L(0); PG8_BAR; PG8_MMA(1, 0, At, B0); PG8_MMA(1, 1, At, B1); PG8_BAR; PG8_SCHED;
        }
        if constexpr (ALIGN_EPI) { if (wr == 0) PG8_BAR; }
        E(acc, cur, wr, wc, fr, fq);
        if (!has_next) break;
#pragma unroll
        for (int a = 0; a < 2; ++a)
#pragma unroll
            for (int b = 0; b < 2; ++b)
#pragma unroll
                for (int m = 0; m < 4; ++m)
#pragma unroll
                    for (int n = 0; n < 2; ++n) acc[a][b][m][n] = (f32x4){0.f, 0.f, 0.f, 0.f};
        cur = nxt; cA = nA; cB = nB; ++ui;
#pragma unroll
        for (int i = 0; i < 2; ++i) { vA0[i] = nA0[i]; vA1[i] = nA1[i]; }
        if constexpr (ALIGN_EPI) { if (wr == 1) PG8_BAR; }
    }
    PG8_WAIT_V(0);
    if constexpr (!ALIGN_EPI) { if (wr == 0) PG8_BAR; }
    PG8_BAR;
#undef PG8_SA
#undef PG8_SB
#undef PG8_STAGE
#undef PG8_LDA
#undef PG8_LDB
#undef PG8_MMA
#undef PG8_WAIT_V
#undef PG8_WAIT_L
#undef PG8_BAR
#undef PG8_SCHED
}

struct EpiBf16 {
    static constexpr bool PERM = true;
    bf16* O; int ldc;
    __device__ __forceinline__ void operator()(const f32x4 (&acc)[2][2][4][2], const Unit& u, int wr, int wc, int fr, int fq) const {
        const int row0 = u.pm * BM + wr * 64 + fr; const int col0 = u.pn * BM + wc * 32 + 8 * fq;
#pragma unroll
        for (int ai = 0; ai < 2; ++ai)
#pragma unroll
            for (int m = 0; m < 4; ++m) { bf16* rowp = O + (size_t)(row0 + ai * HALF + m * 16) * ldc + col0;
#pragma unroll
                for (int bj = 0; bj < 2; ++bj) { const f32x4 v0 = acc[ai][bj][m][0], v1 = acc[ai][bj][m][1];
                    u32x4 w; w.x = cvt_pk_bf16(v0[0], v0[1]); w.y = cvt_pk_bf16(v0[2], v0[3]); w.z = cvt_pk_bf16(v1[0], v1[1]); w.w = cvt_pk_bf16(v1[2], v1[3]);
                    *(u32x4*)(rowp + bj * HALF) = w; } }
    }
};
struct EpiResF32 {
    static constexpr bool PERM = false;
    const float* base; float* out; int ldc;
    __device__ __forceinline__ void operator()(const f32x4 (&acc)[2][2][4][2], const Unit& u, int wr, int wc, int fr, int fq) const {
        const int row0 = u.pm * BM + wr * 64 + fr, col0 = u.pn * BM + wc * 32 + 4 * fq;
#pragma unroll
        for (int ai = 0; ai < 2; ++ai)
#pragma unroll
            for (int m = 0; m < 4; ++m) { const size_t off = (size_t)(row0 + ai * HALF + m * 16) * ldc + col0;
#pragma unroll
                for (int bj = 0; bj < 2; ++bj)
#pragma unroll
                    for (int n = 0; n < 2; ++n) { const f32x4 bs = *(const f32x4*)(base + off + bj * HALF + n * 16); *(f32x4*)(out + off + bj * HALF + n * 16) = bs + acc[ai][bj][m][n]; } }
    }
};

struct EpiResXB {
    static constexpr bool PERM = true;
    const float* srcf; const bf16* srcb; bf16* xb;
    __device__ __forceinline__ void operator()(const f32x4 (&acc)[2][2][4][2], const Unit& u, int wr, int wc, int fr, int fq) const {
        const int row0 = u.pm * BM + wr * 64 + fr, col0 = u.pn * BM + wc * 32 + 8 * fq;
#pragma unroll
        for (int ai = 0; ai < 2; ++ai)
#pragma unroll
            for (int m = 0; m < 4; ++m) { const size_t off = (size_t)(row0 + ai * HALF + m * 16) * DM + col0;
#pragma unroll
                for (int bj = 0; bj < 2; ++bj) { f32x4 a0, a1;
                    if (srcf) { a0 = *(const f32x4*)(srcf + off + bj * HALF); a1 = *(const f32x4*)(srcf + off + bj * HALF + 4); }
                    else { const u32x4 v = *(const u32x4*)(srcb + off + bj * HALF); a0 = (f32x4){bflo(v.x), bfhi(v.x), bflo(v.y), bfhi(v.y)}; a1 = (f32x4){bflo(v.z), bfhi(v.z), bflo(v.w), bfhi(v.w)}; }
                    a0 += acc[ai][bj][m][0]; a1 += acc[ai][bj][m][1];
                    *(u32x4*)(xb + off + bj * HALF) = (u32x4){pk2(a0[0], a0[1]), pk2(a0[2], a0[3]), pk2(a1[0], a1[1]), pk2(a1[2], a1[3])}; } }
    }
};

struct MoeOrder {
    const char* Abase; const char* Bbase; size_t bstride; int K, G, c, tile_lo, tile_hi; const LAS int* ptile; const LAS int* cntv; const int* list; bool gather;
    __device__ __forceinline__ bool next(int i, Unit& u) const {
        const int NT = tile_hi - tile_lo; int tile, pn;
        if ((G & 7) == 0 && G >= 32) {
            const int x = c & 7, sl = c >> 3, per = G >> 3, TPX = (NT + 7) >> 3;
            const int lu = i * per + sl, lt = lu >> 2; pn = lu & 3;
            tile = tile_lo + x * TPX + lt;
            if (lt >= TPX || tile >= tile_hi) return false;
        } else {
            const long Lq = (long)i * G + c; if (Lq >= (long)NT * 4) return false;
            tile = tile_lo + (int)(Lq >> 2); pn = (int)(Lq & 3);
        }
        int e = 0;
#pragma unroll
        for (int st = 32; st >= 1; st >>= 1) { const int k = e + st; if (k < 64 && tile >= __builtin_amdgcn_readfirstlane(ptile[k])) e = k; }
        const int j = tile - __builtin_amdgcn_readfirstlane(ptile[e]);
        u.pm = tile; u.pn = pn; u.aux = e | (j << 6);
        u.A = gather ? Abase : Abase + (size_t)tile * BM * K * 2; u.B = Bbase + (size_t)(e & 31) * bstride + (size_t)pn * BM * K * 2; return true;
    }
    __device__ __forceinline__ unsigned arow(const Unit& u, int r) const {
        if (!gather) return (unsigned)(r * K) * 2u;
        const int e = u.aux & 63, pos = (u.aux >> 6) * 256 + r; const int cn = cntv[e];
        const int tok = pos < cn ? list[(size_t)e * 65536 + pos] : 0;
        return (unsigned)tok * (unsigned)(K * 2);
    }
};
struct EpiSwiGLU {
    static constexpr bool PERM = true;
    bf16* H;
    __device__ __forceinline__ void operator()(const f32x4 (&acc)[2][2][4][2], const Unit& u, int wr, int wc, int fr, int fq) const {
        const int row0 = u.pm * BM + wr * 64 + fr; const int col0 = u.pn * 128 + wc * 32 + 8 * fq;
#pragma unroll
        for (int ai = 0; ai < 2; ++ai)
#pragma unroll
            for (int m = 0; m < 4; ++m) { bf16* rowp = H + (size_t)(row0 + ai * HALF + m * 16) * 512 + col0;
                const f32x4 g0 = acc[ai][0][m][0], g1 = acc[ai][0][m][1], u0 = acc[ai][1][m][0], u1 = acc[ai][1][m][1];
                float h[8];
#pragma unroll
                for (int q = 0; q < 4; ++q) { h[q] = g0[q] * __builtin_amdgcn_rcpf(1.f + __builtin_amdgcn_exp2f(-1.44269504f * g0[q])) * u0[q]; h[4 + q] = g1[q] * __builtin_amdgcn_rcpf(1.f + __builtin_amdgcn_exp2f(-1.44269504f * g1[q])) * u1[q]; }
                u32x4 w; w.x = cvt_pk_bf16(h[0], h[1]); w.y = cvt_pk_bf16(h[2], h[3]); w.z = cvt_pk_bf16(h[4], h[5]); w.w = cvt_pk_bf16(h[6], h[7]);
                *(u32x4*)rowp = w; }
    }
};
template <bool FINAL> struct EpiScatter {
    static constexpr bool PERM = true;
    bf16* xb; float* out; const int* list; const float* wl; const LAS int* cntv;
    __device__ __forceinline__ void operator()(const f32x4 (&acc)[2][2][4][2], const Unit& u, int wr, int wc, int fr, int fq) const {
        const int e = u.aux & 63, j = u.aux >> 6; const int cn = cntv[e];
        const int col0 = u.pn * BM + wc * 32 + 8 * fq;
#pragma unroll
        for (int ai = 0; ai < 2; ++ai)
#pragma unroll
            for (int m = 0; m < 4; ++m) { const int pos = j * 256 + ai * HALF + wr * 64 + m * 16 + fr;
                if (pos < cn) { const int tok = list[(size_t)e * 65536 + pos]; const float wg = wl[(size_t)e * 65536 + pos];
                    const size_t off = (size_t)tok * DM + col0;
#pragma unroll
                    for (int bj = 0; bj < 2; ++bj) { const u32x4 v = *(const u32x4*)(xb + off + bj * HALF);
                        const f32x4 a0 = (f32x4){bflo(v.x), bfhi(v.x), bflo(v.y), bfhi(v.y)} + wg * acc[ai][bj][m][0], a1 = (f32x4){bflo(v.z), bfhi(v.z), bflo(v.w), bfhi(v.w)} + wg * acc[ai][bj][m][1];
                        if (FINAL) { *(f32x4*)(out + off + bj * HALF) = a0; *(f32x4*)(out + off + bj * HALF + 4) = a1; }
                        else *(u32x4*)(xb + off + bj * HALF) = (u32x4){pk2(a0[0], a0[1]), pk2(a0[2], a0[3]), pk2(a1[0], a1[1]), pk2(a1[2], a1[3])}; } } }
    }
};
}

struct Frame {
    LAS unsigned char* lds;
    volatile LAS unsigned* MISC;
    gu32* ctl;
    int tid, lane, wave, G, bid;
    float* out; unsigned char* ws;
};
struct Args { const float* in[31]; float* out; unsigned char* ws; int ph_lo, ph_hi, rep, pad; };
#ifndef REP_PART
#define REP_PART 0
#endif
#ifndef REP_PHASE
#define REP_PHASE -1
#endif
#define NREP(k) ((REP_PHASE == (k)) ? args.rep : 1)
__device__ __forceinline__ float wave_sum(float v) {
#pragma unroll
    for (int o = 1; o < 64; o <<= 1) v += __shfl_xor(v, o);
    return v;
}

template <class Map>
__device__ __forceinline__ void transpose_item(const float* W, int K, int pitch, int col0, int ncols, bf16* WT, LAS float* scr, int item, int lane, Map dmap) {
    const int nblk = (ncols + 31) / 32, kb = item / nblk, nb = item % nblk, k0 = 64 * kb, n0 = 32 * nb;
    const int nn = n0 + (lane & 31);
#pragma unroll 8
    for (int i = 0; i < 32; ++i) { const int kk = 2 * i + (lane >> 5); scr[kk * 33 + (lane & 31)] = (nn < ncols) ? W[(size_t)(k0 + kk) * pitch + col0 + nn] : 0.f; }
    LDS_WAIT(); asm volatile("" ::: "memory");
    const int c = lane & 7;
#pragma unroll
    for (int j = 0; j < 4; ++j) { const int n = (lane >> 3) + 8 * j; const LAS float* s = scr + (8 * c) * 33 + n;
        u32x4 o; o.x = pk2(s[0 * 33], s[1 * 33]); o.y = pk2(s[2 * 33], s[3 * 33]); o.z = pk2(s[4 * 33], s[5 * 33]); o.w = pk2(s[6 * 33], s[7 * 33]);
        if (n0 + n < ncols) *(u32x4*)(WT + (size_t)dmap(n0 + n) * K + k0 + 8 * c) = o; }
    LDS_WAIT(); asm volatile("" ::: "memory");
}
struct MapId { int off; __device__ int operator()(int n) const { return n + off; } };
struct MapEven { __device__ int operator()(int c) const {
    if (c < 1536) return c; if (c < 1544) return EDT + (c - 1536); if (c < 2056) return EQ + (c - 1544); if (c < 2120) return EK + (c - 2056);
    if (c < 2184) return EV + (c - 2120); if (c < 2440) return EIQ + (c - 2184); if (c < 2504) return EIK + (c - 2440); return EIW + (c - 2504); } };
struct MapGU { int half; __device__ int operator()(int n) const { return 256 * (n >> 7) + 128 * half + (n & 127); } };

__device__ __forceinline__ void rms_row_to_bf16(const float* xrow, const float* gain, bf16* orow, int lane) {
    const f32x4* xr = (const f32x4*)xrow + lane; const f32x4* gr = (const f32x4*)gain + lane;
    f32x4 v[4]; float s = 0.f;
#pragma unroll
    for (int j = 0; j < 4; ++j) { v[j] = xr[64 * j]; s += (v[j].x * v[j].x + v[j].y * v[j].y) + (v[j].z * v[j].z + v[j].w * v[j].w); }
    const float rs = 1.f / sqrtf(wave_sum(s) * (1.f / DM) + NORM_EPS);
    unsigned long long* o8 = (unsigned long long*)orow + lane;
#pragma unroll
    for (int j = 0; j < 4; ++j) { const f32x4 g = gr[64 * j]; o8[64 * j] = (unsigned long long)pk2(v[j].x * rs * g.x, v[j].y * rs * g.y) | ((unsigned long long)pk2(v[j].z * rs * g.z, v[j].w * rs * g.w) << 32); }
}

__device__ __forceinline__ void rms_rowb_to_bf16(const bf16* xrow, const float* gain, bf16* orow, int lane) {
    const u32x2* xr = (const u32x2*)xrow + lane; const f32x4* gr = (const f32x4*)gain + lane;
    f32x4 v[4]; float s = 0.f;
#pragma unroll
    for (int j = 0; j < 4; ++j) { const u32x2 q = xr[64 * j]; v[j] = (f32x4){bflo(q.x), bfhi(q.x), bflo(q.y), bfhi(q.y)}; s += (v[j].x * v[j].x + v[j].y * v[j].y) + (v[j].z * v[j].z + v[j].w * v[j].w); }
    const float rs = 1.f / sqrtf(wave_sum(s) * (1.f / DM) + NORM_EPS);
    unsigned long long* o8 = (unsigned long long*)orow + lane;
#pragma unroll
    for (int j = 0; j < 4; ++j) { const f32x4 g = gr[64 * j]; o8[64 * j] = (unsigned long long)pk2(v[j].x * rs * g.x, v[j].y * rs * g.y) | ((unsigned long long)pk2(v[j].z * rs * g.z, v[j].w * rs * g.w) << 32); }
}
__device__ __forceinline__ void p_prologue(Frame& F, const Args& A) {
    LAS float* scr = (LAS float*)(F.lds + F.wave * 16384);
    const int gw = F.bid * NWAVES + F.wave, NGW = F.G * NWAVES;
    bf16* Wie = (bf16*)(F.ws + WS_WIE); bf16* Woe = (bf16*)(F.ws + WS_WOE);
    constexpr int I_IE = 16 * 79, I_OE = 16 * 32;
    for (int it = gw; it < I_IE + I_OE; it += NGW) {
        if (it < I_IE) transpose_item(A.in[4], 1024, 2508, 0, 2508, Wie, scr, it, F.lane, MapEven());
        else transpose_item(A.in[13], 1024, 1024, 0, 1024, Woe, scr, it - I_IE, F.lane, MapId{0});
    }
    {
        bf16* Wgu = (bf16*)(F.ws + WS_WGU); bf16* Wd = (bf16*)(F.ws + WS_WD); bf16* WR = (bf16*)(F.ws + WS_WR);
        for (int it = gw; it < 64 * 768; it += NGW) { const int le = it / 768, r = it % 768;
            if (r < 256) transpose_item(A.in[28] + (size_t)le * 1024 * 512, 1024, 512, 0, 512, Wgu + (size_t)le * 1024 * 1024, scr, r, F.lane, MapGU{0});
            else if (r < 512) transpose_item(A.in[29] + (size_t)le * 1024 * 512, 1024, 512, 0, 512, Wgu + (size_t)le * 1024 * 1024, scr, r - 256, F.lane, MapGU{1});
            else transpose_item(A.in[30] + (size_t)le * 512 * 1024, 512, 1024, 0, 1024, Wd + (size_t)le * 1024 * 512, scr, r - 512, F.lane, MapId{0}); }
        for (int it = gw; it < 2 * 5 * 16; it += NGW) { const int l = it / 80, r = it % 80, q = r / 16, kb = r % 16;
            if (q == 0) transpose_item(A.in[26] + (size_t)l * 1024 * 4, 1024, 4, 0, 4, WR + (size_t)l * 48 * 1024, scr, kb, F.lane, MapId{0});
            else transpose_item(A.in[27] + (size_t)(l * 4 + q - 1) * 1024 * 8, 1024, 8, 0, 8, WR + (size_t)l * 48 * 1024, scr, kb, F.lane, MapId{4 + 8 * (q - 1)}); }
        for (int i = gw * 64 + F.lane; i < 2 * 12 * 1024 / 8; i += NGW * 64) { const int l = i / (12 * 128), o = i % (12 * 128); *(u32x4*)(WR + (size_t)l * 48 * 1024 + 36 * 1024 + (size_t)o * 8) = (u32x4){0u, 0u, 0u, 0u}; }
    }
    {
        bf16* Wio = (bf16*)(F.ws + WS_WIO); bf16* Woo = (bf16*)(F.ws + WS_WOO); bf16* WGL = (bf16*)(F.ws + WS_WGL);
        bf16* W1K = (bf16*)(F.ws + WS_W1K); bf16* W1V = (bf16*)(F.ws + WS_W1V); bf16* W2 = (bf16*)(F.ws + WS_W2);
        constexpr int J0 = 16 * 80, J1 = J0 + 16, J2 = J1 + 16 * 32, J3 = J2 + 64 * 4, J4 = J3 + 64 * 4, J5 = J4 + 2 * 4, J6 = J5 + 2 * 4;
        for (int it = gw; it < J6; it += NGW) {
            if (it < J0) transpose_item(A.in[14], 1024, 2584, 0, 2560, Wio, scr, it, F.lane, MapId{0});
            else if (it < J1) transpose_item(A.in[14], 1024, 2584, 2560, 24, WGL, scr, it - J0, F.lane, MapId{0});
            else if (it < J2) transpose_item(A.in[25], 1024, 1024, 0, 1024, Woo, scr, it - J1, F.lane, MapId{0});
            else if (it < J3) transpose_item(A.in[21], 4096, 128, 0, 128, W1K, scr, it - J2, F.lane, MapId{0});
            else if (it < J4) transpose_item(A.in[23], 4096, 128, 0, 128, W1V, scr, it - J3, F.lane, MapId{0});
            else if (it < J5) transpose_item(A.in[22], 128, 128, 0, 128, W2, scr, it - J4, F.lane, MapId{0});
            else transpose_item(A.in[24], 128, 128, 0, 128, W2 + 128 * 128, scr, it - J5, F.lane, MapId{0});
        }
        for (int i = gw * 64 + F.lane; i < 8 * 1024 / 8; i += NGW * 64) *(u32x4*)(WGL + 24 * 1024 + (size_t)i * 8) = (u32x4){0u, 0u, 0u, 0u};
    }
    for (int i = gw * 64 + F.lane; i < 52 * 1024 / 8; i += NGW * 64) *(u32x4*)(Wie + (size_t)2508 * 1024 + (size_t)i * 8) = (u32x4){0u, 0u, 0u, 0u};
    bf16* HB = (bf16*)(F.ws + WS_HB);
    for (int m = gw; m < MTOK; m += NGW) rms_row_to_bf16(A.in[0] + (size_t)m * DM, A.in[2], HB + (size_t)m * DM, F.lane);
}

constexpr int SP = 136;
constexpr int L_CS = 0, L_BS = 34816, L_BT = 69632, L_XT = 104448, L_XS = 113152, L_ST = 121856, L_AC = 139264, L_DT = 139776, L_CW = 140288;
__device__ __forceinline__ bf16x8 lds_frag(LAS unsigned char* base, int row, int col) { return *(const LAS bf16x8*)(base + (row * SP + col) * 2); }

constexpr int S_CS = 0, S_BS = 34816, S_BT = 69632, S_XT = 104448, S_XS = 121856, S_AC = 139264, S_DT = 141312;
__device__ __forceinline__ void p_ssd1(Frame& F, const Args& A) {
    bf16* U = (bf16*)(F.ws + WS_U); bf16* YD = (bf16*)(F.ws + WS_HB); bf16* CS = (bf16*)(F.ws + WS_XB); bf16* CC = (bf16*)(F.ws + WS_CC); float* AC = (float*)(F.ws + WS_AC);
    const int w = F.wave;
    { const int tid = F.tid;
    for (int r0 = F.bid * 64; r0 < MTOK; r0 += F.G * 64) {
        const int row = r0 + (tid >> 3), c8 = (tid & 7) * 8;
        bf16* p = U + (size_t)row * LDE + EK + c8;
        const u32x4 v = *(const u32x4*)p; float f[8] = {bflo(v.x), bfhi(v.x), bflo(v.y), bfhi(v.y), bflo(v.z), bfhi(v.z), bflo(v.w), bfhi(v.w)};
        float s = 0.f;
#pragma unroll
        for (int j = 0; j < 8; ++j) s += f[j] * f[j];
        s += __shfl_xor(s, 1); s += __shfl_xor(s, 2); s += __shfl_xor(s, 4);
        const float rs = 1.f / sqrtf(s * (1.f / 64.f) + NORM_EPS); const float* g = A.in[12] + c8;
        u32x4 o; o.x = pk2(f[0] * rs * g[0], f[1] * rs * g[1]); o.y = pk2(f[2] * rs * g[2], f[3] * rs * g[3]); o.z = pk2(f[4] * rs * g[4], f[5] * rs * g[5]); o.w = pk2(f[6] * rs * g[6], f[7] * rs * g[7]);
        *(u32x4*)p = o;
    } }
    LAS unsigned char* L = F.lds;
    LAS float* acum = (LAS float*)(L + S_AC); LAS float* dtv = (LAS float*)(L + S_DT);
    const float* conv_w = A.in[5]; const float* conv_b = A.in[6];
    for (int unit = F.bid; unit < 1024; unit += F.G) {
        int tid = F.tid, lane = F.lane; asm volatile("" : "+v"(tid), "+v"(lane));
        const int b = unit >> 6, c = (unit >> 1) & 31, g = unit & 1;
        const size_t rowbase = (size_t)b * SEQ + (size_t)c * 128;
        __syncthreads();
        {
            const int hq = tid >> 7, t = tid & 127, h = 4 * g + hq;
            const float dr = bf2f(U[(rowbase + t) * LDE + EDT + h]) + A.in[7][h];
            const float dt = dr > 20.f ? dr : log1pf(__expf(dr));
            float sc = dt * (-__expf(A.in[8][h]));
#pragma unroll
            for (int o = 1; o < 64; o <<= 1) { const float x = __shfl_up(sc, o); if (lane >= o) sc += x; }
            dtv[tid] = dt; acum[tid] = sc;
        }
        {
            const int cg = tid & 15, rr = tid >> 4;
#pragma unroll 1
            for (int T = 0; T < 2; ++T) {
                const int ch0 = (T == 0 ? 512 : 768) + g * 128 + 8 * cg;
                u32x4 raw[7];
#pragma unroll
                for (int j = 0; j < 7; ++j) { const int tl = 4 * rr - 3 + j; raw[j] = (u32x4){0u, 0u, 0u, 0u};
                    if (c > 0 || tl >= 0) raw[j] = *(const u32x4*)(U + (size_t)((long)rowbase + tl) * LDE + 512 + ch0); }
                LAS unsigned char* dst = L + (T == 0 ? S_BS : S_CS);
                unsigned opk[4][4];
#pragma unroll
                for (int e2 = 0; e2 < 4; ++e2) {
                    const float* wp = conv_w + ch0 + 2 * e2;
                    const f32x2 w0 = *(const f32x2*)wp, w1 = *(const f32x2*)(wp + 1024), w2 = *(const f32x2*)(wp + 2048), w3 = *(const f32x2*)(wp + 3072), bb = *(const f32x2*)(conv_b + ch0 + 2 * e2);
                    float lo[7], hi[7];
#pragma unroll
                    for (int j = 0; j < 7; ++j) { lo[j] = bflo(raw[j][e2]); hi[j] = bfhi(raw[j][e2]); }
                    float ol[4], oh[4];
#pragma unroll
                    for (int q = 0; q < 4; ++q) { ol[q] = siluf(bb.x + w0.x * lo[q] + w1.x * lo[q + 1] + w2.x * lo[q + 2] + w3.x * lo[q + 3]);
                                                  oh[q] = siluf(bb.y + w0.y * hi[q] + w1.y * hi[q + 1] + w2.y * hi[q + 2] + w3.y * hi[q + 3]); opk[q][e2] = pk2(ol[q], oh[q]); }
                    if (T == 0) {
                        *(LAS u32x2*)(L + S_BT + ((8 * cg + 2 * e2) * SP + 4 * rr) * 2) = (u32x2){pk2(ol[0], ol[1]), pk2(ol[2], ol[3])};
                        *(LAS u32x2*)(L + S_BT + ((8 * cg + 2 * e2 + 1) * SP + 4 * rr) * 2) = (u32x2){pk2(oh[0], oh[1]), pk2(oh[2], oh[3])};
                    }
                }
#pragma unroll
                for (int q = 0; q < 4; ++q) { const u32x4 pk = (u32x4){opk[q][0], opk[q][1], opk[q][2], opk[q][3]};
                    *(LAS u32x4*)(dst + ((4 * rr + q) * SP + 8 * cg) * 2) = pk;
                    if (T == 1) *(u32x4*)(CC + ((size_t)((b * 32 + c) * 2 + g) * 128 + 4 * rr + q) * 128 + 8 * cg) = pk; }
            }
        }
        __syncthreads();
        if (w & 1) acum[tid] += acum[tid - lane - 1];
        __syncthreads();
        AC[(rowbase + (tid & 127)) * 8 + 4 * g + (tid >> 7)] = acum[tid];
        const int mt = w >> 1, nh = w & 1, r = lane & 31, hh = lane >> 5;
        f32x16 cb[2];
#pragma unroll
        for (int j = 0; j < 2; ++j) {
            cb[j] = (f32x16){0.f, 0.f, 0.f, 0.f, 0.f, 0.f, 0.f, 0.f, 0.f, 0.f, 0.f, 0.f, 0.f, 0.f, 0.f, 0.f};
            const int s0 = 64 * nh + 32 * j;
            if (s0 <= 32 * mt + 31) {
#pragma unroll
                for (int ks = 0; ks < 8; ++ks) cb[j] = __builtin_amdgcn_mfma_f32_32x32x16_bf16(lds_frag(L + S_CS, 32 * mt + r, 16 * ks + 8 * hh), lds_frag(L + S_BS, s0 + r, 16 * ks + 8 * hh), cb[j], 0, 0, 0);
            }
        }
        __syncthreads();
#pragma unroll 1
        for (int hq = 0; hq < 4; ++hq) {
            const int h = 4 * g + hq;
            int tidq = F.tid, laneq = F.lane; asm volatile("" : "+v"(tidq), "+v"(laneq));
            const int r = laneq & 31, hh = laneq >> 5;
            const LAS float* ac = acum + hq * 128; const LAS float* dv = dtv + hq * 128;
            {
                const int cgx = tidq & 7;
                const float* wp = conv_w + h * 64 + 8 * cgx; const float* bp = conv_b + h * 64 + 8 * cgx;
                const float aend = ac[127];
#pragma unroll
                for (int e = 0; e < 2; ++e) { const int t = (tidq >> 3) + 64 * e;
                    u32x4 raw[4];
#pragma unroll
                    for (int j = 0; j < 4; ++j) { const int tl = t - 3 + j; raw[j] = (u32x4){0u, 0u, 0u, 0u};
                        if (c > 0 || tl >= 0) raw[j] = *(const u32x4*)(U + (size_t)((long)rowbase + tl) * LDE + EXS + h * 64 + 8 * cgx); }
                    const float sc = dv[t] * __expf(aend - ac[t]);
#pragma unroll
                    for (int e8 = 0; e8 < 8; ++e8) { float rv[4];
#pragma unroll
                        for (int j = 0; j < 4; ++j) rv[j] = (e8 & 1) ? bfhi(raw[j][e8 >> 1]) : bflo(raw[j][e8 >> 1]);
                        const float xv = siluf(bp[e8] + wp[e8] * rv[0] + wp[1024 + e8] * rv[1] + wp[2048 + e8] * rv[2] + wp[3072 + e8] * rv[3]);
                        *(LAS bf16*)(L + S_XT + ((8 * cgx + e8) * SP + t) * 2) = (bf16)f2bfh(xv);
                        *(LAS bf16*)(L + S_XS + ((8 * cgx + e8) * SP + t) * 2) = (bf16)f2bfh(xv * sc); } }
            }
#pragma unroll
            for (int j = 0; j < 2; ++j) { const int sI = 64 * nh + 32 * j + r; const float as = ac[sI], ds = dv[sI];
#pragma unroll
                for (int i = 0; i < 16; ++i) { const int t = 32 * mt + 8 * (i >> 2) + 4 * hh + (i & 3);
                    const float v = (sI <= t) ? cb[j][i] * __expf(ac[t] - as) * ds : 0.f;
                    *(LAS bf16*)(L + S_BS + (t * SP + sI) * 2) = (bf16)f2bfh(v); } }
            __syncthreads();
            {
                const int nt = w & 1;
                f32x16 yd = {0.f, 0.f, 0.f, 0.f, 0.f, 0.f, 0.f, 0.f, 0.f, 0.f, 0.f, 0.f, 0.f, 0.f, 0.f, 0.f}, cs = yd;
                for (int ks = 0; ks < 2 * (mt + 1); ++ks) yd = __builtin_amdgcn_mfma_f32_32x32x16_bf16(lds_frag(L + S_BS, 32 * mt + r, 16 * ks + 8 * hh), lds_frag(L + S_XT, 32 * nt + r, 16 * ks + 8 * hh), yd, 0, 0, 0);
                const int mp = w >> 2, nn = w & 3;
#pragma unroll
                for (int ks = 0; ks < 8; ++ks) cs = __builtin_amdgcn_mfma_f32_32x32x16_bf16(lds_frag(L + S_XS, 32 * mp + r, 16 * ks + 8 * hh), lds_frag(L + S_BT, 32 * nn + r, 16 * ks + 8 * hh), cs, 0, 0, 0);
                const float dsk = A.in[9][h];
#pragma unroll
                for (int q = 0; q < 4; ++q) { const int t0 = 32 * mt + 8 * q + 4 * hh;
                    const u32x2 xx = *(const LAS u32x2*)(L + S_XT + ((32 * nt + r) * SP + t0) * 2);
                    const float xv[4] = {bflo(xx.x), bfhi(xx.x), bflo(xx.y), bfhi(xx.y)};
#pragma unroll
                    for (int e = 0; e < 4; ++e) YD[(rowbase + t0 + e) * 512 + h * 64 + 32 * nt + r] = (bf16)f2bfh(yd[4 * q + e] + dsk * xv[e]); }
                bf16* csp = CS + ((size_t)((b * 32 + c) * 8 + h) * 64) * 128 + 32 * nn + r;
#pragma unroll
                for (int i = 0; i < 16; ++i) csp[(size_t)(32 * mp + 8 * (i >> 2) + 4 * hh + (i & 3)) * 128] = (bf16)f2bfh(cs[i]);
            }
            __syncthreads();
        }
    }
}
__device__ __forceinline__ void p_ssd2(Frame& F) {
    const bf16* CS = (const bf16*)(F.ws + WS_XB); bf16* SI = (bf16*)(F.ws + WS_XB + 64 * MiB); const float* AC = (const float*)(F.ws + WS_AC);
    LAS float* decs = (LAS float*)F.lds;
    for (int st = F.bid; st < 256; st += F.G) {
        const int b = st >> 4, h = (st >> 1) & 7, ph = st & 1;
        const int e0 = F.tid * 8, p = 32 * ph + (e0 >> 7), n = e0 & 127;
        __syncthreads();
        if (F.tid < 32) decs[F.tid] = __expf(AC[((size_t)b * SEQ + F.tid * 128 + 127) * 8 + h]);
        float stt[8] = {0.f, 0.f, 0.f, 0.f, 0.f, 0.f, 0.f, 0.f};
        const size_t off0 = ((size_t)(b * 32 * 8 + h) * 64 + p) * 128 + n, cstep = (size_t)8 * 64 * 128;
        u32x4 ring[4];
#pragma unroll
        for (int k = 0; k < 4; ++k) ring[k] = *(const u32x4*)(CS + off0 + (size_t)k * cstep);
        __syncthreads();
#pragma unroll 1
        for (int c4 = 0; c4 < 32; c4 += 4) {
#pragma unroll
            for (int k = 0; k < 4; ++k) { const int c = c4 + k;
                const u32x4 cur = ring[k];
                if (c + 4 < 32) ring[k] = *(const u32x4*)(CS + off0 + (size_t)(c + 4) * cstep);
                *(u32x4*)(SI + off0 + (size_t)c * cstep) = (u32x4){pk2(stt[0], stt[1]), pk2(stt[2], stt[3]), pk2(stt[4], stt[5]), pk2(stt[6], stt[7])};
                const float dec = decs[c];
                stt[0] = stt[0] * dec + bflo(cur.x); stt[1] = stt[1] * dec + bfhi(cur.x); stt[2] = stt[2] * dec + bflo(cur.y); stt[3] = stt[3] * dec + bfhi(cur.y);
                stt[4] = stt[4] * dec + bflo(cur.z); stt[5] = stt[5] * dec + bfhi(cur.z); stt[6] = stt[6] * dec + bflo(cur.w); stt[7] = stt[7] * dec + bfhi(cur.w); }
        }
    }
}
__device__ __forceinline__ void p_ssd3(Frame& F) {
    bf16* U = (bf16*)(F.ws + WS_U); const bf16* YD = (const bf16*)(F.ws + WS_HB); const bf16* SI = (const bf16*)(F.ws + WS_XB + 64 * MiB); const bf16* CC = (const bf16*)(F.ws + WS_CC); const float* AC = (const float*)(F.ws + WS_AC);
    const int w = F.wave;
    for (int unit = F.bid; unit < 2048; unit += F.G) {
        int lane = F.lane; asm volatile("" : "+v"(lane));
        const int b = unit >> 7, c = (unit >> 2) & 31, hp = unit & 3;
        const int h = 2 * hp + (w >> 2), g = h >> 2, tt = w & 3, r = lane & 31, hh = lane >> 5;
        const size_t row = (size_t)b * SEQ + (size_t)c * 128 + 32 * tt + r;
        const bf16* sp = SI + ((size_t)((b * 32 + c) * 8 + h) * 64 + r) * 128 + 8 * hh;
        const bf16* cp = CC + ((size_t)((b * 32 + c) * 2 + g) * 128 + 32 * tt + r) * 128 + 8 * hh;
        bf16x8 s0[8], s1[8], cf[8];
#pragma unroll
        for (int ks = 0; ks < 8; ++ks) { s0[ks] = *(const bf16x8*)(sp + 16 * ks); s1[ks] = *(const bf16x8*)(sp + 32 * 128 + 16 * ks); cf[ks] = *(const bf16x8*)(cp + 16 * ks); }
        const float ea = __expf(AC[row * 8 + h]);
        const bf16* yp = YD + row * 512 + h * 64 + 4 * hh; bf16* zp = U + row * LDE + EZ + h * 64 + 4 * hh;
        u32x2 yv[8], zv[8];
#pragma unroll
        for (int k = 0; k < 8; ++k) { yv[k] = *(const u32x2*)(yp + 32 * (k >> 2) + 8 * (k & 3)); zv[k] = *(const u32x2*)(zp + 32 * (k >> 2) + 8 * (k & 3)); }
        f32x16 a0 = {0.f, 0.f, 0.f, 0.f, 0.f, 0.f, 0.f, 0.f, 0.f, 0.f, 0.f, 0.f, 0.f, 0.f, 0.f, 0.f}, a1 = a0;
#pragma unroll
        for (int ks = 0; ks < 8; ++ks) { a0 = __builtin_amdgcn_mfma_f32_32x32x16_bf16(s0[ks], cf[ks], a0, 0, 0, 0); a1 = __builtin_amdgcn_mfma_f32_32x32x16_bf16(s1[ks], cf[ks], a1, 0, 0, 0); }
#pragma unroll
        for (int k = 0; k < 8; ++k) { const int q = k & 3;
            const float o0 = (k < 4 ? a0[4 * q] : a1[4 * q]), o1 = (k < 4 ? a0[4 * q + 1] : a1[4 * q + 1]), o2 = (k < 4 ? a0[4 * q + 2] : a1[4 * q + 2]), o3 = (k < 4 ? a0[4 * q + 3] : a1[4 * q + 3]);
            const float y0 = bflo(yv[k].x) + ea * o0, y1 = bfhi(yv[k].x) + ea * o1, y2 = bflo(yv[k].y) + ea * o2, y3 = bfhi(yv[k].y) + ea * o3;
            const float z0 = bflo(zv[k].x), z1 = bfhi(zv[k].x), z2 = bflo(zv[k].y), z3 = bfhi(zv[k].y);
            *(u32x2*)(zp + 32 * (k >> 2) + 8 * q) = (u32x2){pk2(y0 * siluf(z0), y1 * siluf(z1)), pk2(y2 * siluf(z2), y3 * siluf(z3))}; }
    }
}

typedef short s16x4 __attribute__((ext_vector_type(4)));
__device__ __forceinline__ s16x4 lds_tr16(LAS unsigned char* p) { return __builtin_bit_cast(s16x4, __builtin_amdgcn_ds_read_tr16_b64_v4i16((LAS s16x4*)p)); }
__device__ __forceinline__ int t5_bucket_dev(int d) {
    if (d < 16) return d;
    const int v = 16 + (int)(log((double)d / 16.0) / log(8.0) * 16.0);
    return v < 31 ? v : 31;
}
constexpr int D_SEL = 131072, D_LUT = 135168, D_DMY = 139264, VP = 72;
__device__ __forceinline__ unsigned long long mask_ge(int v, int x) { unsigned long long m; asm("v_cmp_ge_i32_e64 %0, %1, %2" : "=s"(m) : "v"(v), "s"(x)); return m; }
__device__ __forceinline__ unsigned long long mask_gt(int v, int x) { unsigned long long m; asm("v_cmp_gt_i32_e64 %0, %1, %2" : "=s"(m) : "v"(v), "s"(x)); return m; }
__device__ __forceinline__ int count_ge8(int a0, int a1, int a2, int a3, int a4, int a5, int a6, int a7, int x) {
    unsigned long long m0, m1, m2, m3, m4, m5, m6, m7;
    asm("v_cmp_ge_i32_e64 %0, %8, %16\n\tv_cmp_ge_i32_e64 %1, %9, %16\n\tv_cmp_ge_i32_e64 %2, %10, %16\n\tv_cmp_ge_i32_e64 %3, %11, %16\n\t"
        "v_cmp_ge_i32_e64 %4, %12, %16\n\tv_cmp_ge_i32_e64 %5, %13, %16\n\tv_cmp_ge_i32_e64 %6, %14, %16\n\tv_cmp_ge_i32_e64 %7, %15, %16"
        : "=&s"(m0), "=&s"(m1), "=&s"(m2), "=&s"(m3), "=&s"(m4), "=&s"(m5), "=&s"(m6), "=&s"(m7)
        : "v"(a0), "v"(a1), "v"(a2), "v"(a3), "v"(a4), "v"(a5), "v"(a6), "v"(a7), "s"(x));
    return (__popcll(m0) + __popcll(m1)) + (__popcll(m2) + __popcll(m3)) + ((__popcll(m4) + __popcll(m5)) + (__popcll(m6) + __popcll(m7)));
}
__device__ __forceinline__ void masks_ge8(int a0, int a1, int a2, int a3, int a4, int a5, int a6, int a7, int x, unsigned long long (&m)[8]) {
    asm("v_cmp_ge_i32_e64 %0, %8, %16\n\tv_cmp_ge_i32_e64 %1, %9, %16\n\tv_cmp_ge_i32_e64 %2, %10, %16\n\tv_cmp_ge_i32_e64 %3, %11, %16\n\t"
        "v_cmp_ge_i32_e64 %4, %12, %16\n\tv_cmp_ge_i32_e64 %5, %13, %16\n\tv_cmp_ge_i32_e64 %6, %14, %16\n\tv_cmp_ge_i32_e64 %7, %15, %16"
        : "=&s"(m[0]), "=&s"(m[1]), "=&s"(m[2]), "=&s"(m[3]), "=&s"(m[4]), "=&s"(m[5]), "=&s"(m[6]), "=&s"(m[7])
        : "v"(a0), "v"(a1), "v"(a2), "v"(a3), "v"(a4), "v"(a5), "v"(a6), "v"(a7), "s"(x));
}
__device__ __forceinline__ int sel_mask(int a, int b, unsigned long long m) { int r; asm("v_cndmask_b32_e64 %0, %1, %2, %3" : "=v"(r) : "v"(a), "v"(b), "s"(m)); return r; }
__device__ __forceinline__ int okey(float f) { const int iv = __builtin_bit_cast(int, f); return iv ^ ((iv >> 31) & 0x7fffffff); }

__device__ __forceinline__ void p_dsa(Frame& F, const Args& A) {
    bf16* U = (bf16*)(F.ws + WS_U); bf16* HB = (bf16*)(F.ws + WS_HB);
    const int w = F.wave;
    const float* ng = A.in[10];
    LAS unsigned char* L = F.lds;
    LAS float* LUT = (LAS float*)(L + D_LUT);
    for (int i = F.tid; i < 1024; i += NTHR) LUT[i] = A.in[1][t5_bucket_dev(i >> 3) * 8 + (i & 7)];
    __syncthreads();
    for (int blk = F.bid; blk < MTOK / 8; blk += F.G) {
        int lane = F.lane; asm volatile("" : "+v"(lane));
        const int kr = blk >> 8, cc = blk & 255, b = kr >> 1, tb = (kr & 1) ? 511 - cc : cc, t0 = tb * 8;
        const size_t bat = (size_t)b * SEQ, rowb = bat + t0;
        {
            const size_t row = rowb + w;
            const u32x4 v = *(const u32x4*)(U + row * LDE + EZ + 8 * lane);
            float f[8] = {bflo(v.x), bfhi(v.x), bflo(v.y), bfhi(v.y), bflo(v.z), bfhi(v.z), bflo(v.w), bfhi(v.w)};
            float s = 0.f;
#pragma unroll
            for (int j = 0; j < 8; ++j) s += f[j] * f[j];
#pragma unroll
            for (int o = 1; o < 32; o <<= 1) s += __shfl_xor(s, o);
            const float rs = 1.f / sqrtf(s * (1.f / 256.f) + NORM_EPS); const float* g = ng + 8 * lane;
            u32x4 o; o.x = pk2(f[0] * rs * g[0], f[1] * rs * g[1]); o.y = pk2(f[2] * rs * g[2], f[3] * rs * g[3]); o.z = pk2(f[4] * rs * g[4], f[5] * rs * g[5]); o.w = pk2(f[6] * rs * g[6], f[7] * rs * g[7]);
            *(u32x4*)(HB + row * DM + 8 * lane) = o;
        }
        {
            const int r = lane & 31, hh = lane >> 5;
            bf16x8 qa[4];
#pragma unroll
            for (int ks = 0; ks < 4; ++ks) qa[ks] = *(const bf16x8*)(U + (rowb + (r >> 2)) * LDE + EIQ + (r & 3) * 64 + 16 * ks + 8 * hh);
            float wv[4][4];
#pragma unroll
            for (int q = 0; q < 4; ++q) { const u32x2 ww = *(const u32x2*)(U + (rowb + 2 * q + hh) * LDE + EIW); wv[q][0] = bflo(ww.x); wv[q][1] = bfhi(ww.x); wv[q][2] = bflo(ww.y); wv[q][3] = bfhi(ww.y); }
            const int ntile = (t0 + 8 + 31) >> 5;
            for (int tb = w; tb < ntile; tb += 4 * NWAVES) {
                bf16x8 kf[4][4];
#pragma unroll
                for (int u4 = 0; u4 < 4; ++u4) { const int tl = tb + 8 * u4 < 128 ? tb + 8 * u4 : 127; const int key = 32 * tl + r;
#pragma unroll
                    for (int ks = 0; ks < 4; ++ks) kf[u4][ks] = *(const bf16x8*)(U + (bat + key) * LDE + EIK + 16 * ks + 8 * hh); }
#pragma unroll
                for (int u4 = 0; u4 < 4; ++u4) {
                    const int tile = tb + 8 * u4;
                    f32x16 acc = {0.f, 0.f, 0.f, 0.f, 0.f, 0.f, 0.f, 0.f, 0.f, 0.f, 0.f, 0.f, 0.f, 0.f, 0.f, 0.f};
#pragma unroll
                    for (int ks = 0; ks < 4; ++ks) acc = __builtin_amdgcn_mfma_f32_32x32x16_bf16(qa[ks], kf[u4][ks], acc, 0, 0, 0);
                    if (tile < ntile) {
#pragma unroll
                        for (int q = 0; q < 4; ++q) {
                            const float sc = wv[q][0] * fmaxf(acc[4 * q], 0.f) + wv[q][1] * fmaxf(acc[4 * q + 1], 0.f) + wv[q][2] * fmaxf(acc[4 * q + 2], 0.f) + wv[q][3] * fmaxf(acc[4 * q + 3], 0.f);
                            *(LAS float*)(L + ((2 * q + hh) * 4096 + 32 * tile + r) * 4) = sc + 0.f;
                        }
                    }
                }
            }
        }
        __syncthreads();
        const int t = t0 + w, n = t + 1;
        LAS unsigned short* sel = (LAS unsigned short*)(L + D_SEL) + w * 256;
        const int cnt = n < 256 ? n : 256;
        if (n <= 256) {
#pragma unroll
            for (int i = 0; i < 4; ++i) { const int s = lane + 64 * i; sel[s] = (unsigned short)(s < n ? s : 0); }
        } else {
            const int nj = (t0 + 8 + 63) >> 6;
            const LAS float* myrow = (const LAS float*)(L + w * 16384);
            int v[64]; int vmax = (int)0x80000000, vmin = 0x7fffffff;
#pragma unroll
            for (int jb = 0; jb < 4; ++jb) {
                if (16 * jb < nj) {
#pragma unroll
                    for (int jj = 0; jj < 16; ++jj) { const int j = 16 * jb + jj; const int idx = lane + 64 * j; const int kv = okey(myrow[idx]);
                        const bool ok = idx <= t; v[j] = ok ? kv : (int)0x80000000; vmax = v[j] > vmax ? v[j] : vmax; const int x = ok ? kv : 0x7fffffff; vmin = x < vmin ? x : vmin; }
                } else {
#pragma unroll
                    for (int jj = 0; jj < 16; ++jj) v[16 * jb + jj] = (int)0x80000000;
                }
            }
#pragma unroll
            for (int o = 1; o < 64; o <<= 1) { const int x = __shfl_xor(vmax, o); vmax = x > vmax ? x : vmax; const int y = __shfl_xor(vmin, o); vmin = y < vmin ? y : vmin; }
            vmax = __builtin_amdgcn_readfirstlane(vmax); vmin = __builtin_amdgcn_readfirstlane(vmin);
            int lo = vmin, hi = vmax, clo = n, chi = 0, it = 0;
            for (int rps = 0; rps < (REP_PART == 4 ? A.rep : 1); ++rps) { lo = vmin; hi = vmax; clo = n; chi = 0; it = 0;
            while (lo < hi) {
                int mid;
                const int ph3 = it % 3;
                if (ph3 == 2) mid = lo + (int)(((long long)hi - (long long)lo + 1) >> 1);
                else {
                    const float lof = __builtin_bit_cast(float, lo >= 0 ? lo : lo ^ 0x7fffffff), hif = __builtin_bit_cast(float, hi >= 0 ? hi : hi ^ 0x7fffffff);
                    const float fr = ph3 == 0 ? ((float)(clo - 256) + 0.5f) / (float)(clo - chi) : 0.5f;
                    mid = okey(lof + (hif - lof) * fr);
                    mid = mid > hi ? hi : mid; mid = mid <= lo ? lo + 1 : mid;
                }
                int c = 0;
#pragma unroll
                for (int jb = 0; jb < 4; ++jb) if (16 * jb < nj) {
#pragma unroll
                    for (int jj = 0; jj < 16; jj += 8) { const int j0 = 16 * jb + jj; c += count_ge8(v[j0], v[j0 + 1], v[j0 + 2], v[j0 + 3], v[j0 + 4], v[j0 + 5], v[j0 + 6], v[j0 + 7], mid); } }
                ++it;
                if (c == 256) { lo = mid; break; }
                if (c > 256) { lo = mid; clo = c; } else { hi = mid - 1; chi = c; }
            } }
            const int T = lo;
            int cge = 0, cgt = 0;
#pragma unroll
            for (int jb = 0; jb < 4; ++jb) if (16 * jb < nj) {
#pragma unroll
                for (int jj = 0; jj < 16; jj += 8) { const int j0 = 16 * jb + jj;
                    cge += count_ge8(v[j0], v[j0 + 1], v[j0 + 2], v[j0 + 3], v[j0 + 4], v[j0 + 5], v[j0 + 6], v[j0 + 7], T);
                    cgt += count_ge8(v[j0], v[j0 + 1], v[j0 + 2], v[j0 + 3], v[j0 + 4], v[j0 + 5], v[j0 + 6], v[j0 + 7], T + 1); } }
            const int need_eq = 256 - cgt;
            if (cge - cgt == need_eq) {
                LAS unsigned short* dummy = (LAS unsigned short*)(L + D_DMY) + w * 64 + lane;
                int obase = 0;
#pragma unroll
                for (int jb = 0; jb < 4; ++jb) if (16 * jb < nj) {
#pragma unroll
                    for (int jj = 0; jj < 16; jj += 8) { const int j0 = 16 * jb + jj; unsigned long long m[8];
                        masks_ge8(v[j0], v[j0 + 1], v[j0 + 2], v[j0 + 3], v[j0 + 4], v[j0 + 5], v[j0 + 6], v[j0 + 7], T, m);
#pragma unroll
                        for (int e = 0; e < 8; ++e) {
                            const int pos = (int)__builtin_amdgcn_mbcnt_hi((unsigned)(m[e] >> 32), __builtin_amdgcn_mbcnt_lo((unsigned)m[e], (unsigned)obase));
                            LAS unsigned short* dst = (LAS unsigned short*)(unsigned)sel_mask((int)(unsigned)(__SIZE_TYPE__)dummy, (int)(unsigned)(__SIZE_TYPE__)(sel + pos), m[e]);
                            *dst = (unsigned short)(lane + 64 * (j0 + e));
                            obase += __popcll(m[e]); } } }
            } else {
            int obase = 0, ebase = 0;
#pragma unroll
            for (int jb = 0; jb < 4; ++jb) if (16 * jb < nj) {
#pragma unroll
                for (int jj = 0; jj < 16; ++jj) { const int j = 16 * jb + jj;
                    const bool gt = v[j] > T, eq = v[j] == T;
                    const unsigned long long be = __ballot(eq);
                    const int erank = ebase + (int)__builtin_amdgcn_mbcnt_hi((unsigned)(be >> 32), __builtin_amdgcn_mbcnt_lo((unsigned)be, 0u));
                    const bool take = gt || (eq && erank < need_eq);
                    const unsigned long long bt = __ballot(take);
                    const int pos = obase + (int)__builtin_amdgcn_mbcnt_hi((unsigned)(bt >> 32), __builtin_amdgcn_mbcnt_lo((unsigned)bt, 0u));
                    if (take && pos < 256) sel[pos] = (unsigned short)(lane + 64 * j);
                    obase += __popcll(bt); ebase += __popcll(be); } }
            }
        }
        __syncthreads();
        {
            const int hd = lane & 15, g4 = lane >> 4;
            const size_t row = rowb + w;
            bf16x8 qb[2];
            {
                float qf[2][8]; float ss = 0.f;
#pragma unroll
                for (int ks = 0; ks < 2; ++ks) { u32x4 qq = (u32x4){0u, 0u, 0u, 0u};
                    if (hd < 8) qq = *(const u32x4*)(U + row * LDE + EQ + hd * 64 + 32 * ks + 8 * g4);
                    qf[ks][0] = bflo(qq.x); qf[ks][1] = bfhi(qq.x); qf[ks][2] = bflo(qq.y); qf[ks][3] = bfhi(qq.y); qf[ks][4] = bflo(qq.z); qf[ks][5] = bfhi(qq.z); qf[ks][6] = bflo(qq.w); qf[ks][7] = bfhi(qq.w);
#pragma unroll
                    for (int j = 0; j < 8; ++j) ss += qf[ks][j] * qf[ks][j]; }
                ss += __shfl_xor(ss, 16); ss += __shfl_xor(ss, 32);
                const float rs = 0.125f / sqrtf(ss * (1.f / 64.f) + NORM_EPS);
#pragma unroll
                for (int ks = 0; ks < 2; ++ks) { const float* gq = A.in[11] + 32 * ks + 8 * g4;
                    u32x4 pk; pk.x = pk2(qf[ks][0] * rs * gq[0], qf[ks][1] * rs * gq[1]); pk.y = pk2(qf[ks][2] * rs * gq[2], qf[ks][3] * rs * gq[3]);
                    pk.z = pk2(qf[ks][4] * rs * gq[4], qf[ks][5] * rs * gq[5]); pk.w = pk2(qf[ks][6] * rs * gq[6], qf[ks][7] * rs * gq[7]);
                    qb[ks] = __builtin_bit_cast(bf16x8, pk); }
            }
            float lg[16][4]; float mx = -3.0e38f;
            const int vsl = lane >> 3, vpart = lane & 7;
            u32x4 vr[2][8];
#pragma unroll
            for (int hb = 0; hb < 2; ++hb) {
                bf16x8 ka[8][2];
#pragma unroll
                for (int T8 = 0; T8 < 8; ++T8) { const int sm = sel[16 * (8 * hb + T8) + hd]; const bf16* kp = U + (bat + sm) * LDE + EK + 8 * g4;
                    ka[T8][0] = *(const bf16x8*)kp; ka[T8][1] = *(const bf16x8*)(kp + 32); }
#pragma unroll
                for (int e = 0; e < 8; ++e) { const int sm = sel[64 * hb + 8 * e + vsl]; vr[hb][e] = *(const u32x4*)(U + (bat + sm) * LDE + EV + 8 * vpart); }
#pragma unroll
                for (int T8 = 0; T8 < 8; ++T8) { const int T = 8 * hb + T8;
                    f32x4 acc = {0.f, 0.f, 0.f, 0.f};
                    acc = __builtin_amdgcn_mfma_f32_16x16x32_bf16(ka[T8][0], qb[0], acc, 0, 0, 0);
                    acc = __builtin_amdgcn_mfma_f32_16x16x32_bf16(ka[T8][1], qb[1], acc, 0, 0, 0);
                    const u32x2 sl = *(const LAS u32x2*)(sel + 16 * T + 4 * g4);
                    const int s4[4] = {(int)(sl.x & 0xffffu), (int)(sl.x >> 16), (int)(sl.y & 0xffffu), (int)(sl.y >> 16)};
#pragma unroll
                    for (int i = 0; i < 4; ++i) { int dist = t - s4[i]; dist = dist < 0 ? 0 : (dist > 127 ? 127 : dist);
                        const float bia = LUT[dist * 8 + (hd & 7)];
                        const bool valid = (16 * T + 4 * g4 + i) < cnt;
                        lg[T][i] = valid ? acc[i] + bia : -3.0e38f; mx = fmaxf(mx, lg[T][i]); }
                }
            }
            mx = fmaxf(mx, __shfl_xor(mx, 16)); mx = fmaxf(mx, __shfl_xor(mx, 32));
            float sum = 0.f;
#pragma unroll
            for (int T = 0; T < 16; ++T) {
#pragma unroll
                for (int i = 0; i < 4; ++i) { const float p = lg[T][i] > -1.0e38f ? __expf(lg[T][i] - mx) : 0.f; lg[T][i] = p; sum += p; }
                if ((T & 3) == 3) __builtin_amdgcn_sched_barrier(0); }
            sum += __shfl_xor(sum, 16); sum += __shfl_xor(sum, 32);
            const float inv = 1.f / fmaxf(sum, 1e-30f);
            f32x4 oacc[4];
#pragma unroll
            for (int dt = 0; dt < 4; ++dt) oacc[dt] = (f32x4){0.f, 0.f, 0.f, 0.f};
            LAS unsigned char* Vl = L + w * 16384;
#pragma unroll
            for (int ch = 0; ch < 4; ++ch) {
                LDS_WAIT();
#pragma unroll
                for (int e = 0; e < 8; ++e) *(LAS u32x4*)(Vl + ((8 * e + vsl) * VP + 8 * vpart) * 2) = vr[ch & 1][e];
                if (ch + 2 < 4) {
#pragma unroll
                    for (int e = 0; e < 8; ++e) { const int sm = sel[64 * (ch + 2) + 8 * e + vsl]; vr[ch & 1][e] = *(const u32x4*)(U + (bat + sm) * LDE + EV + 8 * vpart); }
                }
                LDS_WAIT();
#pragma unroll
                for (int kk = 0; kk < 2; ++kk) {
                    const int T0 = 2 * (2 * ch + kk);
                    u32x4 pp; pp.x = pk2(lg[T0][0] * inv, lg[T0][1] * inv); pp.y = pk2(lg[T0][2] * inv, lg[T0][3] * inv); pp.z = pk2(lg[T0 + 1][0] * inv, lg[T0 + 1][1] * inv); pp.w = pk2(lg[T0 + 1][2] * inv, lg[T0 + 1][3] * inv);
                    const bf16x8 pf = __builtin_bit_cast(bf16x8, pp);
                    const int qq = (lane & 15) >> 2, p4 = lane & 3;
#pragma unroll
                    for (int dt = 0; dt < 4; ++dt) {
                        const s16x4 b0 = lds_tr16(Vl + ((32 * kk + 4 * g4 + qq) * VP + 16 * dt + 4 * p4) * 2);
                        const s16x4 b1 = lds_tr16(Vl + ((32 * kk + 16 + 4 * g4 + qq) * VP + 16 * dt + 4 * p4) * 2);
                        bf16x8 bfg; bfg[0] = b0[0]; bfg[1] = b0[1]; bfg[2] = b0[2]; bfg[3] = b0[3]; bfg[4] = b1[0]; bfg[5] = b1[1]; bfg[6] = b1[2]; bfg[7] = b1[3];
                        oacc[dt] = __builtin_amdgcn_mfma_f32_16x16x32_bf16(pf, bfg, oacc[dt], 0, 0, 0);
                    }
                }
            }
            if (g4 < 2) {
#pragma unroll
                for (int i = 0; i < 4; ++i)
#pragma unroll
                    for (int dt = 0; dt < 4; ++dt) HB[row * DM + 512 + (4 * g4 + i) * 64 + 16 * dt + hd] = (bf16)f2bfh(oacc[dt][i]);
            }
        }
        __syncthreads();
    }
}

template <int MODE> __device__ __forceinline__ void p_norm_route(Frame& F, const bf16* xin, const float* gain, int layer) {
    constexpr int NT = MODE == 0 ? 3 : 2;
    bf16* HB = (bf16*)(F.ws + WS_HB); const bf16* WR = MODE == 0 ? (const bf16*)(F.ws + WS_WR) + (size_t)layer * 48 * 1024 : (const bf16*)(F.ws + WS_WGL);
    float* GL = (float*)(F.ws + WS_GL);
    int* list = (int*)(F.ws + WS_LIST); float* wl = (float*)(F.ws + WS_LISTW);
    LAS unsigned char* L = F.lds;
    LAS float* lgt = (LAS float*)L + F.wave * (16 * 48);
    LAS int* cntl = (LAS int*)(L + 32768); LAS int* basel = (LAS int*)(L + 33024);
    LAS int* ri_e = (LAS int*)(L + 34816); LAS int* ri_p = (LAS int*)(L + 36864); LAS float* ri_w = (LAS float*)(L + 38912);
    const int w = F.wave;
    for (int base = F.bid * 256; base < MTOK; base += F.G * 256) {
        int lane = F.lane; asm volatile("" : "+v"(lane));
        if (F.tid < 64) cntl[F.tid] = 0;
        __syncthreads();
#pragma unroll 1
        for (int half = 0; half < 2; ++half) {
            const int R0 = base + w * 32 + half * 16;
#pragma unroll 1
            for (int i = 0; i < 16; ++i) rms_rowb_to_bf16(xin + (size_t)(R0 + i) * DM, gain, HB + (size_t)(R0 + i) * DM, lane);
            VM_WAIT();
            const int n16 = lane & 15, g4 = lane >> 4;
            f32x4 acc[NT];
#pragma unroll
            for (int nt = 0; nt < NT; ++nt) acc[nt] = (f32x4){0.f, 0.f, 0.f, 0.f};
#pragma unroll 4
            for (int kk = 0; kk < 32; ++kk) {
                const bf16x8 a = *(const bf16x8*)(HB + (size_t)(R0 + n16) * DM + 32 * kk + 8 * g4);
#pragma unroll
                for (int nt = 0; nt < NT; ++nt) { const bf16x8 bb = *(const bf16x8*)(WR + (size_t)(16 * nt + n16) * DM + 32 * kk + 8 * g4);
                    acc[nt] = __builtin_amdgcn_mfma_f32_16x16x32_bf16(a, bb, acc[nt], 0, 0, 0); }
            }
            if constexpr (MODE == 1) {
#pragma unroll
                for (int nt = 0; nt < NT; ++nt)
#pragma unroll
                    for (int i = 0; i < 4; ++i) if (16 * nt + n16 < 24) GL[(size_t)(R0 + 4 * g4 + i) * 24 + 16 * nt + n16] = acc[nt][i];
            } else {
#pragma unroll
            for (int nt = 0; nt < NT; ++nt)
#pragma unroll
                for (int i = 0; i < 4; ++i) lgt[(4 * g4 + i) * 48 + 16 * nt + n16] = acc[nt][i];
            LDS_WAIT();
            if (lane < 16) {
                const LAS float* lr = lgt + lane * 48;
                int gs = 0; float gm = lr[0];
#pragma unroll
                for (int j = 1; j < 4; ++j) if (lr[j] > gm) { gm = lr[j]; gs = j; }
                float gsum = 0.f;
#pragma unroll
                for (int j = 0; j < 4; ++j) gsum += __expf(lr[j] - gm);
                const float gw = 1.f / gsum;
                const LAS float* er = lr + 4 + 8 * gs;
                int i0 = 0; float m0 = er[0];
#pragma unroll
                for (int j = 1; j < 8; ++j) if (er[j] > m0) { m0 = er[j]; i0 = j; }
                int i1 = -1; float m1 = -3.0e38f;
#pragma unroll
                for (int j = 0; j < 8; ++j) if (j != i0 && er[j] > m1) { m1 = er[j]; i1 = j; }
                const float w0 = 1.f / (1.f + __expf(m1 - m0));
                const int e0 = gs * 8 + i0, e1 = 32 + gs * 8 + i1;
                const int rs = (w * 32 + half * 16 + lane) * 2;
                ri_e[rs] = e0; ri_p[rs] = __hip_atomic_fetch_add(cntl + e0, 1, __ATOMIC_RELAXED, __HIP_MEMORY_SCOPE_WORKGROUP); ri_w[rs] = w0 * gw;
                ri_e[rs + 1] = e1; ri_p[rs + 1] = __hip_atomic_fetch_add(cntl + e1, 1, __ATOMIC_RELAXED, __HIP_MEMORY_SCOPE_WORKGROUP); ri_w[rs + 1] = (1.f - w0) * gw;
            }
            LDS_WAIT();
            }
        }
        if constexpr (MODE == 1) continue;
        __syncthreads();
        if (F.tid < 64) { const int c = cntl[F.tid]; basel[F.tid] = c ? (int)__hip_atomic_fetch_add((unsigned*)(F.ctl + CW_CNT + layer * 4096 + 64 * F.tid), (unsigned)c, RLX_AGENT) : 0; }
        __syncthreads();
        { const int rs = F.tid, e = ri_e[rs], pos = basel[e] + ri_p[rs];
          list[(size_t)e * 65536 + pos] = base + (rs >> 1); wl[(size_t)e * 65536 + pos] = ri_w[rs]; }
        __syncthreads();
    }
}
__device__ __forceinline__ void moe_tables(Frame& F, int layer) {
    LAS int* ptile = (LAS int*)(F.lds + MOE_OFF); LAS int* cntv = ptile + 128;
    __syncthreads();
    if (F.tid < 64) {
        const int c = (int)__hip_atomic_load((unsigned*)(F.ctl + CW_CNT + layer * 4096 + 64 * F.tid), RLX_AGENT);
        cntv[F.tid] = c;
        int nt = (c + 255) >> 8, incl = nt;
#pragma unroll
        for (int o = 1; o < 64; o <<= 1) { const int t = __shfl_up(incl, o); if (F.lane >= o) incl += t; }
        ptile[F.tid] = incl - nt; if (F.tid == 63) ptile[64] = incl;
    }
    __syncthreads();
}
__device__ __forceinline__ void p_moe_gu(Frame& F, int layer) {
    moe_tables(F, layer);
    const LAS int* ptile = (const LAS int*)(F.lds + MOE_OFF); const LAS int* cntv = ptile + 128;
    pg8::MoeOrder S{(const char*)(F.ws + WS_HB), (const char*)(F.ws + WS_WGU) + (size_t)layer * 32 * 1024 * 1024 * 2, (size_t)1024 * 1024 * 2, 1024, F.G, F.bid, 0, ptile[64], ptile, cntv, (const int*)(F.ws + WS_LIST), true};
    pg8::EpiSwiGLU E{(bf16*)(F.ws + WS_U)};
    pg8::gemm_phase<pg8::EpiSwiGLU, pg8::MoeOrder, true>(F.lds, 1024, S, E);
}
template <bool FINAL> __device__ __forceinline__ void p_moe_down(Frame& F, int layer, int slot) {
    moe_tables(F, layer);
    const LAS int* ptile = (const LAS int*)(F.lds + MOE_OFF); const LAS int* cntv = ptile + 128;
    pg8::MoeOrder S{(const char*)(F.ws + WS_U), (const char*)(F.ws + WS_WD) + (size_t)layer * 32 * 1024 * 512 * 2, (size_t)1024 * 512 * 2, 512, F.G, F.bid, ptile[32 * slot], ptile[32 * slot + 32], ptile, cntv, (const int*)(F.ws + WS_LIST), false};
    pg8::EpiScatter<FINAL> E{(bf16*)(F.ws + WS_XB), F.out, (const int*)(F.ws + WS_LIST), (const float*)(F.ws + WS_LISTW), cntv};
    pg8::gemm_phase<pg8::EpiScatter<FINAL>, pg8::MoeOrder, true>(F.lds, 512, S, E);
}

__device__ __forceinline__ void p_compress(Frame& F, const Args& A) {
    bf16* U = (bf16*)(F.ws + WS_U);
    LAS unsigned char* L = F.lds;
    const int w = F.wave;
    {
        const int tid = F.tid, sub = tid & 15;
        for (int v0 = F.bid * 32; v0 < MTOK * 4; v0 += F.G * 32) {
            const int vec = v0 + (tid >> 4), row = vec >> 2, wh = vec & 3;
            bf16* p = U + (size_t)row * LDO + ((wh >> 1) ? OKW : OKS) + (wh & 1) * 128 + 8 * sub;
            const float* g = ((wh >> 1) ? A.in[18] : A.in[17]) + 8 * sub;
            const u32x4 v = *(const u32x4*)p; float f[8] = {bflo(v.x), bfhi(v.x), bflo(v.y), bfhi(v.y), bflo(v.z), bfhi(v.z), bflo(v.w), bfhi(v.w)};
            float s = 0.f;
#pragma unroll
            for (int j = 0; j < 8; ++j) s += f[j] * f[j];
            s += __shfl_xor(s, 1); s += __shfl_xor(s, 2); s += __shfl_xor(s, 4); s += __shfl_xor(s, 8);
            const float rs = 1.f / sqrtf(s * (1.f / 128.f) + NORM_EPS);
            u32x4 o; o.x = pk2(f[0] * rs * g[0], f[1] * rs * g[1]); o.y = pk2(f[2] * rs * g[2], f[3] * rs * g[3]); o.z = pk2(f[4] * rs * g[4], f[5] * rs * g[5]); o.w = pk2(f[6] * rs * g[6], f[7] * rs * g[7]);
            *(u32x4*)p = o;
        }
    }
    constexpr int C_A = 0, C_B = 17408, C_H = 52224, C_S = 69632;
    for (int unit = F.bid; unit < 256; unit += F.G) {
        int tid = F.tid, lane = F.lane; asm volatile("" : "+v"(tid), "+v"(lane));
        const int T = unit >> 7, b = (unit >> 3) & 15, g = (unit >> 2) & 1, cb = unit & 3;
        const int col = (T ? OVC : OKC) + g * 128;
        const float* pos = T ? A.in[20] : A.in[19];
        const bf16* w1t = (const bf16*)(F.ws + (T ? WS_W1V : WS_W1K)); const bf16* w2t = (const bf16*)(F.ws + WS_W2) + T * 128 * 128;
        const int wm = w >> 2, wn = w & 3, r = lane & 31, hh = lane >> 5;
        f32x16 acc = {0.f, 0.f, 0.f, 0.f, 0.f, 0.f, 0.f, 0.f, 0.f, 0.f, 0.f, 0.f, 0.f, 0.f, 0.f, 0.f};
#pragma unroll 1
        for (int l = 0; l < 32; ++l) {
            __syncthreads();
#pragma unroll
            for (int e = 0; e < 2; ++e) { const int q = tid + 512 * e, c = q >> 4, part = q & 15; const int tok = 16 * (64 * cb + c) + l;
                u32x4 v = (u32x4){0u, 0u, 0u, 0u};
                if (tok < SEQ) v = *(const u32x4*)(U + ((size_t)b * SEQ + tok) * LDO + col + 8 * part);
                const f32x4 p0 = *(const f32x4*)(pos + l * 128 + 8 * part), p1 = *(const f32x4*)(pos + l * 128 + 8 * part + 4);
                u32x4 o; o.x = pk2(bflo(v.x) + p0.x, bfhi(v.x) + p0.y); o.y = pk2(bflo(v.y) + p0.z, bfhi(v.y) + p0.w); o.z = pk2(bflo(v.z) + p1.x, bfhi(v.z) + p1.y); o.w = pk2(bflo(v.w) + p1.z, bfhi(v.w) + p1.w);
                *(LAS u32x4*)(L + C_A + (c * SP + 8 * part) * 2) = o; }
#pragma unroll
            for (int e = 0; e < 4; ++e) { const int q = tid + 512 * e, j = q >> 4, part = q & 15;
                *(LAS u32x4*)(L + C_B + (j * SP + 8 * part) * 2) = *(const u32x4*)(w1t + (size_t)j * 4096 + l * 128 + 8 * part); }
            __syncthreads();
#pragma unroll
            for (int ks = 0; ks < 8; ++ks) {
                const bf16x8 af = lds_frag(L + C_A, 32 * wm + r, 16 * ks + 8 * hh), bfg = lds_frag(L + C_B, 32 * wn + r, 16 * ks + 8 * hh);
                acc = __builtin_amdgcn_mfma_f32_32x32x16_bf16(af, bfg, acc, 0, 0, 0);
            }
        }
#pragma unroll
        for (int i = 0; i < 16; ++i) { const int c = 32 * wm + 8 * (i >> 2) + 4 * hh + (i & 3);
            *(LAS bf16*)(L + C_H + (c * SP + 32 * wn + r) * 2) = (bf16)f2bfh(siluf(acc[i])); }
        __syncthreads();
        f32x16 a2 = {0.f, 0.f, 0.f, 0.f, 0.f, 0.f, 0.f, 0.f, 0.f, 0.f, 0.f, 0.f, 0.f, 0.f, 0.f, 0.f};
#pragma unroll
        for (int ks = 0; ks < 8; ++ks) {
            const bf16x8 af = lds_frag(L + C_H, 32 * wm + r, 16 * ks + 8 * hh), bfg = *(const bf16x8*)(w2t + (size_t)(32 * wn + r) * 128 + 16 * ks + 8 * hh);
            a2 = __builtin_amdgcn_mfma_f32_32x32x16_bf16(af, bfg, a2, 0, 0, 0);
        }
        float rsv[16];
        if (T == 0) {
            LAS float* st = (LAS float*)(L + C_S);
#pragma unroll
            for (int i = 0; i < 16; ++i) { float q = a2[i] * a2[i];
                q += __shfl_xor(q, 1); q += __shfl_xor(q, 2); q += __shfl_xor(q, 4); q += __shfl_xor(q, 8); q += __shfl_xor(q, 16);
                if (r == 0) st[(32 * wm + 8 * (i >> 2) + 4 * hh + (i & 3)) * 4 + wn] = q; }
            __syncthreads();
#pragma unroll
            for (int i = 0; i < 16; ++i) { const f32x4 q = *(const LAS f32x4*)(st + (32 * wm + 8 * (i >> 2) + 4 * hh + (i & 3)) * 4);
                rsv[i] = A.in[16][32 * wn + r] / sqrtf((q.x + q.y + q.z + q.w) * (1.f / 128.f) + NORM_EPS); }
        } else {
#pragma unroll
            for (int i = 0; i < 16; ++i) rsv[i] = 1.f;
        }
        bf16* dst = (bf16*)(F.ws + (T ? WS_VCMP : WS_KCMP));
#pragma unroll
        for (int i = 0; i < 16; ++i) { const int c = 64 * cb + 32 * wm + 8 * (i >> 2) + 4 * hh + (i & 3);
            dst[(((size_t)b * 256 + c) * 2 + g) * 128 + 32 * wn + r] = (bf16)f2bfh(a2[i] * rsv[i]); }
    }
}

constexpr int N_STG = 32768;
constexpr int N_K = 0, N_V = 16384, N_LUT = 3 * N_STG, N_IMP = N_LUT + 4096, N_FAC = N_IMP + 16384, N_MSK = N_FAC + 1024, N_UNI = N_MSK + 512, N_CST = N_UNI + 64;
constexpr float LOG2E = 1.44269504f;
enum { BR_CMP = 0, BR_SEL = 1, BR_WIN = 2 };
struct NsaCtx {
    LAS unsigned char* L; const bf16* U; const bf16* KC; const bf16* VC;
    int tid, lane, w, r, hh, b, g, qblk, t0, t, head; size_t bat;
    float mrow, cfar; unsigned mlo, mhi;
};
__device__ __forceinline__ void glds16(const void* gsrc, unsigned lds_dst) { unsigned keep;
    asm volatile("s_mov_b32 %0, m0\n\ts_mov_b32 m0, %2\n\ts_nop 0\n\tglobal_load_lds_dwordx4 %1, off\n\ts_mov_b32 m0, %0" : "=&s"(keep) : "v"(gsrc), "s"(lds_dst) : "memory"); }
#define NSA_BAR() do { asm volatile("" ::: "memory"); __builtin_amdgcn_s_barrier(); asm volatile("" ::: "memory"); } while (0)
template <int BR, bool SUM, bool PV, bool IMP, bool UNITFAC = false>
__device__ __forceinline__ void nsa_pass(const NsaCtx& X, const bf16x8 (&qf)[8], f32x16 (&oacc)[4], float& lsum, const float colfac, const int tlo, const int thi, const unsigned long long tmask) {
    LAS unsigned char* L = X.L; const int r = X.r, hh = X.hh, lane = X.lane;
    const LAS float* LUT = (const LAS float*)(L + N_LUT);
    auto dma = [&](int tl, int st) {
#pragma unroll
        for (int e = 0; e < 2; ++e) { const int pidx = e * 8 + X.w, row = pidx * 4 + (lane >> 4), ch = (lane & 15) ^ (((lane >> 4) << 2) | (X.w & 3));
            const bf16* kp; const bf16* vp;
            if (BR == BR_CMP) { const size_t o = (((size_t)X.b * 256 + 64 * tl + row) * 2 + X.g) * 128 + 8 * ch; kp = X.KC + o; vp = X.VC + o; }
            else { const size_t o = (X.bat + 64 * tl + row) * LDO + X.g * 128 + 8 * ch; kp = X.U + o + (BR == BR_SEL ? OKS : OKW); vp = X.U + o + (BR == BR_SEL ? OVS : OVW); }
            const unsigned ld = (unsigned)__builtin_amdgcn_readfirstlane((int)(unsigned)(__SIZE_TYPE__)(L + st * N_STG + N_K + pidx * 1024));
            glds16(kp, ld); if (PV) glds16(vp, ld + N_V); }
    };
    auto nextt = [&](int tl) { ++tl; while (tl <= thi && !((tmask >> tl) & 1ull)) ++tl; return tl; };
    int tile = nextt(tlo - 1);
    if (tile > thi) return;
    asm volatile("s_waitcnt vmcnt(0)" ::: "memory");
    int nxt = nextt(tile);
    int nn = nxt <= thi ? nextt(nxt) : nxt;
    dma(tile, 0); if (nxt <= thi) dma(nxt, 1);
    int cur = 0;
    const bool gB = X.w >= 4;
    const int kswz = ((r & 3) << 2) | ((r >> 2) & 3);
#define NSA_WAIT_KEEP(has_newer) do { if (has_newer) { if (PV) asm volatile("s_waitcnt vmcnt(4)" ::: "memory"); else asm volatile("s_waitcnt vmcnt(2)" ::: "memory"); } else asm volatile("s_waitcnt vmcnt(0)" ::: "memory"); } while (0)
    if (gB) { NSA_WAIT_KEEP(nxt <= thi); NSA_BAR(); }
    while (tile <= thi) {
        const int st2 = cur >= 1 ? cur - 1 : 2;
        if (!gB) NSA_WAIT_KEEP(nxt <= thi);
        NSA_BAR();
        if (gB && nn <= thi) dma(nn, st2);
        LAS unsigned char* Ls = L + cur * N_STG;
        const int maxpos = BR == BR_CMP ? 16 * (64 * tile + 63) + 31 : 64 * tile + 63, minpos = BR == BR_CMP ? 16 * (64 * tile) + 31 : 64 * tile;
        const bool far = (X.t0 - maxpos >= 113) && (BR != BR_WIN || (X.t0 + 63 - minpos < 512));
        bool selb = true; if (BR == BR_SEL) selb = (tile < 32 ? (X.mlo >> tile) : (X.mhi >> (tile - 32))) & 1u;
        bf16x8 pa[2][2];
        {
            bf16x8 kf[2][8];
#pragma unroll
            for (int mt = 0; mt < 2; ++mt)
#pragma unroll
                for (int ks = 0; ks < 8; ++ks) kf[mt][ks] = *(const LAS bf16x8*)(Ls + N_K + (32 * mt + r) * 256 + 16 * ((2 * ks + hh) ^ kswz));
            asm volatile("" ::: "memory");
            f32x16 sacc[2];
#pragma unroll
            for (int mt = 0; mt < 2; ++mt) sacc[mt] = (f32x16){0.f, 0.f, 0.f, 0.f, 0.f, 0.f, 0.f, 0.f, 0.f, 0.f, 0.f, 0.f, 0.f, 0.f, 0.f, 0.f};
#pragma unroll
            for (int ks = 0; ks < 8; ++ks)
#pragma unroll
                for (int mt = 0; mt < 2; ++mt) sacc[mt] = __builtin_amdgcn_mfma_f32_32x32x16_bf16(kf[mt][ks], qf[ks], sacc[mt], 0, 0, 0);
            const float cf = (BR == BR_SEL && !selb) ? -1.0e30f : X.cfar;
#pragma unroll
            for (int mt = 0; mt < 2; ++mt) {
                if (far) {
#pragma unroll
                    for (int i = 0; i < 16; ++i) { const float p = __builtin_amdgcn_exp2f(sacc[mt][i] + cf);
                        if (SUM) lsum += p; sacc[mt][i] = UNITFAC ? p : p * colfac; }
                } else {
#pragma unroll
                    for (int i = 0; i < 16; ++i) { const int kidx = 32 * mt + 8 * (i >> 2) + 4 * hh + (i & 3);
                        int dist; bool ok;
                        if (BR == BR_CMP) { dist = X.t - (16 * (64 * tile + kidx) + 31); ok = dist >= 0; }
                        else { dist = X.t - (64 * tile + kidx); ok = BR == BR_SEL ? (selb && dist >= 0) : (dist >= 0 && dist < 512); }
                        const int dc = dist < 0 ? 0 : (dist > 127 ? 127 : dist);
                        const float bia = LUT[dc * 8 + X.head];
                        const float ev = __builtin_amdgcn_exp2f(sacc[mt][i] + bia - X.mrow);
                        const float p = ok ? ev : 0.f;
                        if (SUM) lsum += p;
                        sacc[mt][i] = UNITFAC ? p : p * colfac; }
                }
                if (IMP) {
                    LAS float* imp = (LAS float*)(L + N_IMP) + (X.w * 8 + (r >> 2)) * 64;
#pragma unroll
                    for (int q = 0; q < 4; ++q) { float s4 = (sacc[mt][4 * q] + sacc[mt][4 * q + 1]) + (sacc[mt][4 * q + 2] + sacc[mt][4 * q + 3]), s3 = sacc[mt][4 * q + 3];
                        s4 += __shfl_xor(s4, 1); s4 += __shfl_xor(s4, 2); s3 += __shfl_xor(s3, 1); s3 += __shfl_xor(s3, 2);
                        const int n = 16 * tile + 8 * mt + 2 * q + hh;
                        if ((r & 3) == 0) { __hip_atomic_fetch_add(imp + n, s4, __ATOMIC_RELAXED, __HIP_MEMORY_SCOPE_WORKGROUP); if (n < 63) __hip_atomic_fetch_add(imp + n + 1, s3, __ATOMIC_RELAXED, __HIP_MEMORY_SCOPE_WORKGROUP); } }
                }
                if (PV) {
#pragma unroll
                    for (int sI = 0; sI < 2; ++sI) { u32x4 pp; pp.x = pk2(sacc[mt][8 * sI], sacc[mt][8 * sI + 1]); pp.y = pk2(sacc[mt][8 * sI + 2], sacc[mt][8 * sI + 3]); pp.z = pk2(sacc[mt][8 * sI + 4], sacc[mt][8 * sI + 5]); pp.w = pk2(sacc[mt][8 * sI + 6], sacc[mt][8 * sI + 7]);
                        pa[mt][sI] = __builtin_bit_cast(bf16x8, pp); }
                }
            }
        }
        if (gB && nxt <= thi) NSA_WAIT_KEEP(nn <= thi);
        NSA_BAR();
        if (!gB && nn <= thi) dma(nn, st2);
        if (PV) {
            const int q4 = (lane & 15) >> 2, k2 = 2 * ((lane >> 4) & 1) + ((lane & 3) >> 1), sub8 = 8 * (lane & 1);
            s16x4 vb[2][8];
#define NSA_LDV(g, dst) do { const int _row0 = 16 * (g) + 4 * hh + q4; _Pragma("unroll") for (int nt = 0; nt < 4; ++nt) { \
                dst[2 * nt] = lds_tr16(Ls + N_V + _row0 * 256 + 64 * (nt ^ q4) + 16 * (k2 ^ hh) + sub8); \
                dst[2 * nt + 1] = lds_tr16(Ls + N_V + (_row0 + 8) * 256 + 64 * (nt ^ q4) + 16 * (k2 ^ (hh + 2)) + sub8); } } while (0)
            NSA_LDV(0, vb[0]);
#pragma unroll
            for (int g = 0; g < 4; ++g) {
                if (g == 0) NSA_LDV(1, vb[1]); else if (g == 1) NSA_LDV(2, vb[0]); else if (g == 2) NSA_LDV(3, vb[1]);
                asm volatile("" ::: "memory");
#pragma unroll
                for (int nt = 0; nt < 4; ++nt) { const s16x4 b0 = vb[g & 1][2 * nt], b1 = vb[g & 1][2 * nt + 1];
                    bf16x8 bfg; bfg[0] = b0[0]; bfg[1] = b0[1]; bfg[2] = b0[2]; bfg[3] = b0[3]; bfg[4] = b1[0]; bfg[5] = b1[1]; bfg[6] = b1[2]; bfg[7] = b1[3];
                    oacc[nt] = __builtin_amdgcn_mfma_f32_32x32x16_bf16(pa[g >> 1][g & 1], bfg, oacc[nt], 0, 0, 0); }
            }
#undef NSA_LDV
        }
        tile = nxt; nxt = nn; nn = nn <= thi ? nextt(nn) : nn;
        cur = cur == 2 ? 0 : cur + 1;
    }
#undef NSA_WAIT_KEEP
    if (!gB) NSA_BAR();
    __syncthreads();
}

__device__ __forceinline__ void p_nsa(Frame& F, const Args& A) {
    const bf16* U = (const bf16*)(F.ws + WS_U); bf16* HB = (bf16*)(F.ws + WS_HB); const float* GL = (const float*)(F.ws + WS_GL);
    LAS unsigned char* L = F.lds;
    LAS float* LUT = (LAS float*)(L + N_LUT); LAS float* cst = (LAS float*)(L + N_CST);
    for (int i = F.tid; i < 1024; i += NTHR) LUT[i] = A.in[1][t5_bucket_dev(i >> 3) * 8 + (i & 7)] * LOG2E;
    if (F.wave == 0) {
        float gm = 0.f, bm = 0.f;
        for (int i = F.lane; i < 128; i += 64) gm = fmaxf(gm, fmaxf(fabsf(A.in[16][i]), fmaxf(fabsf(A.in[17][i]), fabsf(A.in[18][i]))));
        for (int i = F.lane; i < 256; i += 64) bm = fmaxf(bm, fabsf(A.in[1][i]));
#pragma unroll
        for (int o = 1; o < 64; o <<= 1) { gm = fmaxf(gm, __shfl_xor(gm, o)); bm = fmaxf(bm, __shfl_xor(bm, o)); }
        if (F.lane == 0) { cst[0] = gm * 11.3137085f; cst[1] = bm * LOG2E; }
    }
    __syncthreads();
    const float kmax = cst[0], bmax = cst[1];
    for (int ui = F.bid; ui < 2048; ui += F.G) {
        NsaCtx X; X.L = L; X.U = U; X.KC = (const bf16*)(F.ws + WS_KCMP); X.VC = (const bf16*)(F.ws + WS_VCMP);
        int tid = F.tid, lane = F.lane; asm volatile("" : "+v"(tid), "+v"(lane));
        X.tid = tid; X.lane = lane; X.w = F.wave; X.r = lane & 31; X.hh = lane >> 5;
        const int kr = ui >> 8, cc = ui & 255, bg = kr * 4 + (cc >> 6);
        X.b = bg >> 1; X.g = bg & 1; X.qblk = (kr & 1) ? 63 - (cc & 63) : (cc & 63); X.t0 = 64 * X.qblk; X.bat = (size_t)X.b * SEQ;
        const int tq = X.r >> 2, hd = X.r & 3; X.t = X.t0 + 8 * X.w + tq; X.head = 4 * X.g + hd;
        const size_t row = X.bat + X.t;
        if (tid == 0) *(LAS unsigned long long*)(L + N_UNI) = 0ull;
        for (int i = tid; i < 4096; i += NTHR) ((LAS float*)(L + N_IMP))[i] = 0.f;
        bf16x8 qf[8]; float qn2 = 0.f;
        {
            u32x4 qr[8]; float ss = 0.f;
#pragma unroll
            for (int ks = 0; ks < 8; ++ks) { qr[ks] = *(const u32x4*)(U + row * LDO + OQ + X.head * 128 + 16 * ks + 8 * X.hh);
#pragma unroll
                for (int e = 0; e < 4; ++e) { const float a = bflo(qr[ks][e]), c = bfhi(qr[ks][e]); ss += a * a + c * c; } }
            ss += __shfl_xor(ss, 32);
            const float rs = 1.f / sqrtf(ss * (1.f / 128.f) + NORM_EPS);
#pragma unroll
            for (int ks = 0; ks < 8; ++ks) { const float* gq = A.in[15] + 16 * ks + 8 * X.hh; u32x4 pk;
#pragma unroll
                for (int e = 0; e < 4; ++e) { const float a = bflo(qr[ks][e]) * rs * gq[2 * e], c = bfhi(qr[ks][e]) * rs * gq[2 * e + 1]; qn2 += a * a + c * c; pk[e] = pk2(a * (0.0883883476f * LOG2E), c * (0.0883883476f * LOG2E)); }
                qf[ks] = __builtin_bit_cast(bf16x8, pk); }
            qn2 += __shfl_xor(qn2, 32);
        }
        X.mrow = sqrtf(qn2) * (0.0883883476f * LOG2E) * kmax + bmax;
        X.cfar = LUT[127 * 8 + X.head] - X.mrow;
        X.mlo = 0u; X.mhi = 0u;
        const float g_c = 1.f / (1.f + __expf(-GL[row * 24 + X.head])), g_s = 1.f / (1.f + __expf(-GL[row * 24 + 8 + X.head])), g_w = 1.f / (1.f + __expf(-GL[row * 24 + 16 + X.head]));
        f32x16 oacc[4];
#pragma unroll
        for (int nt = 0; nt < 4; ++nt) oacc[nt] = (f32x16){0.f, 0.f, 0.f, 0.f, 0.f, 0.f, 0.f, 0.f, 0.f, 0.f, 0.f, 0.f, 0.f, 0.f, 0.f, 0.f};
        const int ntc = ((4 * X.qblk + 2) >> 6) + 1;
        u32x4* park = (u32x4*)(F.ws + WS_PARK) + ((size_t)(F.bid * NWAVES + X.w) * 64 + lane) * 8;
#define NSA_FOLD(fcol, FIRST, LAST) do { LAS float* _fac = (LAS float*)(L + N_FAC) + X.w * 32; LDS_WAIT(); if (lane < 32) _fac[lane] = (fcol); LDS_WAIT(); \
            if (!(FIRST)) { asm volatile("s_waitcnt vmcnt(0)" ::: "memory"); __builtin_amdgcn_fence(__ATOMIC_ACQUIRE, "agent"); } \
            _Pragma("unroll") for (int nt = 0; nt < 4; ++nt) { u32x4 _p0 = (u32x4){0u, 0u, 0u, 0u}, _p1 = _p0; if (!(FIRST)) { _p0 = park[2 * nt]; _p1 = park[2 * nt + 1]; } \
                _Pragma("unroll") for (int q = 0; q < 4; ++q) { const f32x4 _fr = *(const LAS f32x4*)(_fac + 8 * q + 4 * X.hh); const unsigned _wa = q < 2 ? _p0[2 * q] : _p1[2 * q - 4], _wb = q < 2 ? _p0[2 * q + 1] : _p1[2 * q - 3]; \
                    float _a = oacc[nt][4 * q] * _fr.x, _b = oacc[nt][4 * q + 1] * _fr.y, _c = oacc[nt][4 * q + 2] * _fr.z, _d = oacc[nt][4 * q + 3] * _fr.w; \
                    if (!(FIRST)) { _a += bflo(_wa); _b += bfhi(_wa); _c += bflo(_wb); _d += bfhi(_wb); } \
                    oacc[nt][4 * q] = _a; oacc[nt][4 * q + 1] = _b; oacc[nt][4 * q + 2] = _c; oacc[nt][4 * q + 3] = _d; } \
                if (!(LAST)) { park[2 * nt] = (u32x4){pk2(oacc[nt][0], oacc[nt][1]), pk2(oacc[nt][2], oacc[nt][3]), pk2(oacc[nt][4], oacc[nt][5]), pk2(oacc[nt][6], oacc[nt][7])}; \
                               park[2 * nt + 1] = (u32x4){pk2(oacc[nt][8], oacc[nt][9]), pk2(oacc[nt][10], oacc[nt][11]), pk2(oacc[nt][12], oacc[nt][13]), pk2(oacc[nt][14], oacc[nt][15])}; \
                               oacc[nt] = (f32x16){0.f, 0.f, 0.f, 0.f, 0.f, 0.f, 0.f, 0.f, 0.f, 0.f, 0.f, 0.f, 0.f, 0.f, 0.f, 0.f}; } } } while (0)
        float l_c = 0.f;
        nsa_pass<BR_CMP, true, true, false, true>(X, qf, oacc, l_c, 1.f, 0, ntc - 1, ~0ull);
        l_c += __shfl_xor(l_c, 32);
        const float il_c = l_c > 0.f ? 1.f / l_c : 0.f;
        NSA_FOLD(g_c * il_c, true, false);
        { float dummy = 0.f; nsa_pass<BR_CMP, false, false, true>(X, qf, oacc, dummy, il_c, 0, ntc - 1, ~0ull); }
        {
            LDS_WAIT();
            const LAS float* impw = (const LAS float*)(L + N_IMP) + X.w * 8 * 64;
            const int n = lane, cur = X.qblk;
            unsigned long long wor = 0ull;
#pragma unroll 1
            for (int q = 0; q < 8; ++q) {
                const float imp = impw[q * 64 + n];
                const bool forced = (n == 0) || (n == cur) || (n == cur - 1);
                float val = forced ? 3.0e38f : imp; if (n > cur) val = -3.0e38f;
                int rank = 0;
#pragma unroll 8
                for (int m = 0; m < 64; ++m) { const float vm = __shfl(val, m); rank += (vm > val || (vm == val && m < n)) ? 1 : 0; }
                const unsigned long long mk = __ballot(n <= cur && rank < 16);
                wor |= mk;
                if ((X.r >> 2) == q) { X.mlo = (unsigned)mk; X.mhi = (unsigned)(mk >> 32); }
            }
            if (lane == 0) __hip_atomic_fetch_or((LAS unsigned long long*)(L + N_UNI), wor, __ATOMIC_RELAXED, __HIP_MEMORY_SCOPE_WORKGROUP);
        }
        __syncthreads();
        const unsigned long long uni = *(const LAS unsigned long long*)(L + N_UNI);
        float l_s = 0.f;
        nsa_pass<BR_SEL, true, true, false, true>(X, qf, oacc, l_s, 1.f, 0, X.qblk, uni);
        l_s += __shfl_xor(l_s, 32);
        NSA_FOLD(l_s > 0.f ? g_s / l_s : 0.f, false, false);
        const int wlo = X.qblk >= 8 ? X.qblk - 8 : 0;
        float l_w = 0.f;
        nsa_pass<BR_WIN, true, true, false, true>(X, qf, oacc, l_w, 1.f, wlo, X.qblk, ~0ull);
        l_w += __shfl_xor(l_w, 32);
        NSA_FOLD(l_w > 0.f ? g_w / l_w : 0.f, false, true);
#undef NSA_FOLD
#pragma unroll
        for (int i = 0; i < 16; ++i) { const int c32 = 8 * (i >> 2) + 4 * X.hh + (i & 3);
            bf16* op = HB + (X.bat + X.t0 + 8 * X.w + (c32 >> 2)) * DM + (4 * X.g + (c32 & 3)) * 128 + X.r;
#pragma unroll
            for (int nt = 0; nt < 4; ++nt) op[32 * nt] = (bf16)f2bfh(oacc[nt][i]); }
    }
}

constexpr int N_PHASES = 18;
__global__ void __launch_bounds__(NTHR, 2) mk_fwd(Args args) {
    extern __shared__ __attribute__((aligned(16))) unsigned char lds[];
    Frame F;
    F.lds = (LAS unsigned char*)lds;
    F.MISC = (volatile LAS unsigned*)(F.lds + MISC_OFF);
    F.tid = threadIdx.x; F.lane = F.tid & 63; F.wave = __builtin_amdgcn_readfirstlane(F.tid >> 6);
    F.G = gridDim.x; F.bid = blockIdx.x;
    F.ws = args.ws; F.out = args.out; F.ctl = (gu32*)(args.ws + WS_CTL);
    if (F.tid < 64) F.MISC[F.tid] = 0u;
    __syncthreads();
    const int lo = args.ph_lo, hi = args.ph_hi;
    XcdBarrier bar; bar.bar = (unsigned*)(F.ctl + CW_BAR); bar.x = 0; bar.st = nullptr;
    if (hi - lo > 1) bar = xcd_barrier_post((unsigned*)(F.ctl + CW_BAR), F.MISC + 8);
#ifndef PHMASK
#define PHMASK 0xffffffffu
#endif
#define IN(k) (((PHMASK >> (k)) & 1u) && lo <= (k) && (k) < hi)
#ifndef REPMASK
#define REPMASK 0u
#endif
#define RUNS(k) (1 + (int)((REPMASK >> (k)) & 1u))
#define SEAM(k) do { if (IN(k) && IN((k) + 1)) xcd_barrier(bar); } while (0)
    if (IN(0)) { for (int rp = 0; rp < RUNS(0); ++rp) p_prologue(F, args); } SEAM(0);
    if (IN(1)) for (int rp = 0; rp < RUNS(1); ++rp) {
        pg8::StaticOrder S; S.init(F.ws + WS_HB, F.ws + WS_WIE, MTOK, LDE, DM, F.G, F.bid);
        pg8::EpiBf16 E{(bf16*)(F.ws + WS_U), LDE};
        pg8::gemm_phase<pg8::EpiBf16, pg8::StaticOrder, true>(F.lds, DM, S, E);
    } SEAM(1);
    if (IN(2)) { p_ssd1(F, args); xcd_barrier(bar); p_ssd2(F); xcd_barrier(bar); p_ssd3(F); } SEAM(2);
    if (IN(3)) { for (int rp = 0; rp < RUNS(3); ++rp) p_dsa(F, args); } SEAM(3);
    if (IN(4)) {
        pg8::StaticOrder S; S.init(F.ws + WS_HB, F.ws + WS_WOE, MTOK, DM, DM, F.G, F.bid);
        pg8::EpiResXB E{args.in[0], nullptr, (bf16*)(F.ws + WS_XB)};
        pg8::gemm_phase<pg8::EpiResXB, pg8::StaticOrder, true>(F.lds, DM, S, E);
    } SEAM(4);
    if (IN(5)) { p_norm_route<0>(F, (const bf16*)(F.ws + WS_XB), args.in[3], 0); } SEAM(5);
    if (IN(6)) { p_moe_gu(F, 0);
#if (REPMASK >> 6) & 1
        p_moe_gu(F, 0);
#endif
    } SEAM(6);
    if (IN(7)) { p_moe_down<false>(F, 0, 0); } SEAM(7);
    if (IN(8)) { p_moe_down<false>(F, 0, 1); } SEAM(8);
    if (IN(9)) { for (int rp = 0; rp < RUNS(9); ++rp) p_norm_route<1>(F, (const bf16*)(F.ws + WS_XB), args.in[2] + DM, 0); } SEAM(9);
    if (IN(10)) {
        pg8::StaticOrder S; S.init(F.ws + WS_HB, F.ws + WS_WIO, MTOK, LDO, DM, F.G, F.bid);
        pg8::EpiBf16 E{(bf16*)(F.ws + WS_U), LDO};
        pg8::gemm_phase<pg8::EpiBf16, pg8::StaticOrder, true>(F.lds, DM, S, E);
    } SEAM(10);
    if (IN(11)) { p_compress(F, args); } SEAM(11);
    if (IN(12)) { p_nsa(F, args);
#if (REPMASK >> 12) & 1
        p_nsa(F, args);
#endif
    } SEAM(12);
    if (IN(13)) {
        pg8::StaticOrder S; S.init(F.ws + WS_HB, F.ws + WS_WOO, MTOK, DM, DM, F.G, F.bid);
        pg8::EpiResXB E{nullptr, (const bf16*)(F.ws + WS_XB), (bf16*)(F.ws + WS_XB)};
        pg8::gemm_phase<pg8::EpiResXB, pg8::StaticOrder, true>(F.lds, DM, S, E);
    } SEAM(13);
    if (IN(14)) { p_norm_route<0>(F, (const bf16*)(F.ws + WS_XB), args.in[3] + DM, 1); } SEAM(14);
    if (IN(15)) { p_moe_gu(F, 1); } SEAM(15);
    if (IN(16)) { p_moe_down<false>(F, 1, 0); } SEAM(16);
    if (IN(17)) { p_moe_down<true>(F, 1, 1); }
#undef IN
#undef SEAM
}

extern "C" void kernel_launch(void* const* d_in, const int* in_sizes, int n_in, void* d_out, int out_size, void* d_ws, size_t ws_size, hipStream_t stream) {
    static int grid = 0;
    if (grid == 0) {
        if (n_in != 31 || ws_size < WS_END) { fprintf(stderr, "kernel_launch: unexpected n_in %d / ws %zu\n", n_in, ws_size); grid = -1; return; }
        int dev = 0, cus = 0;
        if (hipGetDevice(&dev) != hipSuccess || hipDeviceGetAttribute(&cus, hipDeviceAttributeMultiprocessorCount, dev) != hipSuccess) { grid = -1; return; }
        if (hipFuncSetAttribute((const void*)mk_fwd, hipFuncAttributeMaxDynamicSharedMemorySize, LDS_BYTES) != hipSuccess) { fprintf(stderr, "kernel_launch: hipFuncSetAttribute failed\n"); grid = -1; return; }
        grid = cus;
    }
    if (grid < 0) return;
    (void)hipMemsetAsync((char*)d_ws + WS_CTL, 0, CTL_ZERO_BYTES, stream);
    Args a{};
    for (int i = 0; i < 31; ++i) a.in[i] = (const float*)d_in[i];
    a.out = (float*)d_out; a.ws = (unsigned char*)d_ws; a.rep = (REP_PART || REP_PHASE >= 0) ? 2 : 1; a.pad = 0; a.rep = 2; a.pad = 0;
#if defined(MK_PER_PHASE)
    for (int p = 0; p < N_PHASES; ++p) { a.ph_lo = p; a.ph_hi = p + 1; hipLaunchKernelGGL(mk_fwd, dim3(grid), dim3(NTHR), LDS_BYTES, stream, a); }
#else
    a.ph_lo = 0; a.ph_hi = N_PHASES; hipLaunchKernelGGL(mk_fwd, dim3(grid), dim3(NTHR), LDS_BYTES, stream, a);
#endif
}
```

```cpp
#include <hip/hip_runtime.h>
#include <cstdio>
#include <cstdint>

#define GAS __attribute__((address_space(1)))
#define LAS __attribute__((address_space(3)))
typedef unsigned short bf16;
typedef short bf16x8 __attribute__((ext_vector_type(8)));
typedef float f32x4 __attribute__((ext_vector_type(4)));
typedef float f32x2 __attribute__((ext_vector_type(2)));
typedef float f32x16 __attribute__((ext_vector_type(16)));
typedef unsigned u32x4 __attribute__((ext_vector_type(4)));
typedef unsigned u32x2 __attribute__((ext_vector_type(2)));
typedef GAS unsigned gu32;
#define RLX_AGENT __ATOMIC_RELAXED, __HIP_MEMORY_SCOPE_AGENT
#define LDS_WAIT() asm volatile("s_waitcnt lgkmcnt(0)" ::: "memory")
#define VM_WAIT() asm volatile("s_waitcnt vmcnt(0)" ::: "memory")

constexpr int NB = 16, SEQ = 4096, DM = 1024, MTOK = NB * SEQ;
constexpr float NORM_EPS = 1e-6f;
constexpr int LDE = 2560;
constexpr int EZ = 0, EXS = 512, EBB = 1024, ECC = 1280, EQ = 1536, EK = 2048, EV = 2112, EIQ = 2176, EIK = 2432, EDT = 2496, EIW = 2504;
constexpr int LDO = 2560;
constexpr int OQ = 0, OKC = 1024, OVC = 1280, OKS = 1536, OVS = 1792, OKW = 2048, OVW = 2304;
constexpr int NWAVES = 8, NTHR = 512;

constexpr size_t MiB = 1u << 20;
constexpr size_t WS_CTL = 0, CTL_ZERO_BYTES = 128 * 1024;
constexpr size_t WS_WIE = 1 * MiB, WS_WOE = 6 * MiB, WS_WIO = 8 * MiB, WS_WOO = 13 * MiB;
constexpr size_t WS_W1K = 15 * MiB, WS_W1V = 16 * MiB, WS_W2 = 17 * MiB, WS_WR = 18 * MiB;
constexpr size_t WS_WGL = WS_WR + 256 * 1024;
constexpr size_t WS_TOK = 19 * MiB;
constexpr size_t WS_GL = 20 * MiB;
constexpr size_t WS_KCMP = 26 * MiB, WS_VCMP = 28 * MiB;
constexpr size_t WS_LIST = 32 * MiB;
constexpr size_t WS_WGU = 48 * MiB;
constexpr size_t WS_WD = 176 * MiB;
constexpr size_t WS_HB = 240 * MiB;
constexpr size_t WS_U = 368 * MiB;
constexpr size_t WS_LISTW = 720 * MiB;
constexpr size_t WS_XB = 736 * MiB;
constexpr size_t WS_PARK = 864 * MiB;
constexpr size_t WS_CC = 880 * MiB;
constexpr size_t WS_AC = 912 * MiB;
constexpr size_t WS_XB8 = 368 * MiB;
constexpr size_t WS_H8 = 432 * MiB;
constexpr size_t WS_LISTR = 916 * MiB;
constexpr size_t WS_RS = 932 * MiB;
constexpr size_t WS_STASH = 933 * MiB;
constexpr size_t WS_IQK8 = 965 * MiB;
constexpr size_t WS_K8 = 985 * MiB;
constexpr size_t WS_END = 989 * MiB;
constexpr int CW_TMO = 0, CW_CODE = 1, CW_WMAX = 16, CW_BAR = 4096, CW_CNT = 8192;

constexpr int RING_BYTES = 131072;
constexpr int LDS_BYTES = 147456;
constexpr int MISC_OFF = LDS_BYTES - 256;
constexpr int MOE_OFF = LDS_BYTES - 2048;

__device__ __forceinline__ unsigned f2bf(float f) { unsigned u = __builtin_bit_cast(unsigned, f); return (u + 0x7fffu + ((u >> 16) & 1u)) >> 16; }
typedef __bf16 bf16x2_t __attribute__((ext_vector_type(2)));
constexpr float F8_SX = 8.f, F8_SH = 8.f, F8_SW = 64.f;
__device__ __forceinline__ unsigned pk4_fp8(float a, float b, float c, float d) {
    a = __builtin_amdgcn_fmed3f(a, -448.f, 448.f); b = __builtin_amdgcn_fmed3f(b, -448.f, 448.f); c = __builtin_amdgcn_fmed3f(c, -448.f, 448.f); d = __builtin_amdgcn_fmed3f(d, -448.f, 448.f);
    int w = __builtin_amdgcn_cvt_pk_fp8_f32(a, b, 0, false); w = __builtin_amdgcn_cvt_pk_fp8_f32(c, d, w, true); return (unsigned)w; }
__device__ __forceinline__ unsigned pk4_i8(float a, float b, float c, float d) {
    const int ia = __float2int_rn(__builtin_amdgcn_fmed3f(a, -127.f, 127.f)), ib = __float2int_rn(__builtin_amdgcn_fmed3f(b, -127.f, 127.f)),
              ic = __float2int_rn(__builtin_amdgcn_fmed3f(c, -127.f, 127.f)), id = __float2int_rn(__builtin_amdgcn_fmed3f(d, -127.f, 127.f));
    return (unsigned)(ia & 255) | ((unsigned)(ib & 255) << 8) | ((unsigned)(ic & 255) << 16) | ((unsigned)id << 24); }
__device__ __forceinline__ unsigned pk4_i8m(float a, float b, float c, float d) {
    const unsigned ua = __builtin_bit_cast(unsigned, a + 12582912.f), ub = __builtin_bit_cast(unsigned, b + 12582912.f), uc = __builtin_bit_cast(unsigned, c + 12582912.f), ud = __builtin_bit_cast(unsigned, d + 12582912.f);
    return (ua & 255u) | ((ub & 255u) << 8) | ((uc & 255u) << 16) | (ud << 24); }
__device__ __forceinline__ unsigned short pk2_fp8(float a, float b) { a = __builtin_amdgcn_fmed3f(a, -448.f, 448.f); b = __builtin_amdgcn_fmed3f(b, -448.f, 448.f); return (unsigned short)__builtin_amdgcn_cvt_pk_fp8_f32(a, b, 0, false); }
__device__ __forceinline__ unsigned pk2(float lo, float hi) { const f32x2 v = {lo, hi}; const bf16x2_t b = __builtin_convertvector(v, bf16x2_t); return __builtin_bit_cast(unsigned, b); }
__device__ __forceinline__ unsigned short f2bfh(float f) { return (unsigned short)(pk2(f, f) & 0xffffu); }
__device__ __forceinline__ float bf2f(unsigned short b) { return __builtin_bit_cast(float, ((unsigned)b) << 16); }
__device__ __forceinline__ float bflo(unsigned w) { return __builtin_bit_cast(float, w << 16); }
__device__ __forceinline__ float bfhi(unsigned w) { return __builtin_bit_cast(float, w & 0xffff0000u); }
__device__ __forceinline__ float siluf(float v) { return v * __builtin_amdgcn_rcpf(1.f + __builtin_amdgcn_exp2f(-1.44269504f * v)); }

#define XB_TMO      128
#define XB_XCNT(j)  (256  + 64 * (j))
#define XB_XSUB(j)  (1280 + 64 * (j))
#define XB_XGEN(j)  (2304 + 64 * (j))
#define XB_TOP      3328
#define XB_TOPGEN   3392
#define XCD_BAR_WORDS 3456
#define XB_SPIN_CAP (1u << 20)
__device__ __forceinline__ unsigned xb_ld(unsigned* p)              { return __hip_atomic_load(p, __ATOMIC_RELAXED, __HIP_MEMORY_SCOPE_AGENT); }
__device__ __forceinline__ unsigned xb_add(unsigned* p, unsigned v) { return __hip_atomic_fetch_add(p, v, __ATOMIC_RELAXED, __HIP_MEMORY_SCOPE_AGENT); }
__device__ __forceinline__ unsigned xb_xcc_id() { return (unsigned)__builtin_amdgcn_s_getreg((3 << 11) | 20) & 0xFu; }
#define XB_SPIN(cond, bar) do { unsigned _sp = 0; while (cond) { __builtin_amdgcn_s_sleep(1); \
    if ((++_sp & 255u) == 0u) { if (xb_ld(&(bar)[XB_TMO])) break; if (_sp > XB_SPIN_CAP) { atomicAdd(&(bar)[XB_TMO], 1u); break; } } } } while (0)
struct XcdBarrier { unsigned* bar; unsigned x; volatile LAS unsigned* st; };
__device__ __forceinline__ XcdBarrier xcd_barrier_post(unsigned* bar, volatile LAS unsigned* st) {
    XcdBarrier b; b.bar = bar; b.x = xb_xcc_id(); b.st = st;
    if (threadIdx.x == 0) (void)xb_add(&bar[XB_XCNT(b.x)], 1u);
    return b;
}
__device__ __forceinline__ void xcd_barrier_complete(unsigned* bar, unsigned x, unsigned& nloc, unsigned& nx) {
    const unsigned G = gridDim.x * gridDim.y * gridDim.z;
    unsigned sum, cnt, mine, sp = 0u;
    for (;;) {
        sum = 0u; cnt = 0u; mine = 0u;
#pragma unroll
        for (unsigned j = 0; j < 16; ++j) { const unsigned c = xb_ld(&bar[XB_XCNT(j)]); sum += c; cnt += (c > 0u) ? 1u : 0u; mine = (j == x) ? c : mine; }
        if (sum == G) break;
        __builtin_amdgcn_s_sleep(1);
        if ((++sp & 255u) == 0u) { if (xb_ld(&bar[XB_TMO])) break; if (sp > XB_SPIN_CAP) { atomicAdd(&bar[XB_TMO], 1u); break; } }
    }
    nloc = mine > 0u ? mine : 1u; nx = cnt > 0u ? cnt : 1u;
}
__device__ __forceinline__ void xcd_barrier(const XcdBarrier& b) {
    asm volatile("s_waitcnt vmcnt(0)" ::: "memory");
    __syncthreads();
    if (threadIdx.x == 0) {
        unsigned* bar = b.bar;
        __builtin_amdgcn_s_waitcnt(0);
        unsigned nloc = b.st[0], nx = b.st[1];
        if (nloc == 0u) { xcd_barrier_complete(bar, b.x, nloc, nx); b.st[0] = nloc; b.st[1] = nx; }
        const unsigned old = xb_add(&bar[XB_XSUB(b.x)], 1u);
        const unsigned gen = old / nloc;
        if (old + 1u == (gen + 1u) * nloc) {
            __builtin_amdgcn_fence(__ATOMIC_RELEASE, "agent");
            asm volatile("s_waitcnt vmcnt(0)" ::: "memory");
            const unsigned og = xb_add(&bar[XB_TOP], 1u);
            const unsigned tg = og / nx;
            if (og + 1u == (tg + 1u) * nx) xb_add(&bar[XB_TOPGEN], 1u);
            else XB_SPIN(xb_ld(&bar[XB_TOPGEN]) == tg, bar);
            __builtin_amdgcn_fence(__ATOMIC_ACQUIRE, "agent");
            xb_add(&bar[XB_XGEN(b.x)], 1u);
            asm volatile("s_waitcnt vmcnt(0)" ::: "memory");
        } else {
            XB_SPIN(xb_ld(&bar[XB_XGEN(b.x)]) == gen, bar);
            __builtin_amdgcn_fence(__ATOMIC_ACQUIRE, "agent");
            asm volatile("s_waitcnt vmcnt(0)" ::: "memory");
        }
    }
    __syncthreads();
}

namespace pg8 {
constexpr int BM = 256, BK = 64, HALF = 128, HTB = HALF * BK * 2, STAGE_BYTES = 8 * HTB, NXCD = 8, WGM = 8;
__host__ __device__ __forceinline__ int lds_byte(int r, int c) { const int st = (r >> 4) * 2 + (c >> 5), rr = r & 15, cc = c & 31, ob = rr * 64 + cc * 2; return st * 1024 + (ob ^ (((ob >> 9) & 1) << 5)); }
__host__ __device__ __forceinline__ void stage_rc(int b, int& R, int& C) { const int st = b / 1024, sb = b % 1024, swz = sb ^ (((sb >> 9) & 1) << 5); R = (st >> 1) * 16 + swz / 64; C = (st & 1) * 32 + (swz % 64) / 2; }
__host__ __device__ __forceinline__ int perm32(int rho) { const int n = rho >> 4, i = rho & 15; return 8 * (i >> 2) + 4 * n + (i & 3); }
__device__ __forceinline__ unsigned cvt_pk_bf16(float lo, float hi) { unsigned r; asm volatile("v_cvt_pk_bf16_f32 %0, %1, %2" : "=v"(r) : "v"(lo), "v"(hi)); return r; }

struct Unit { const char* A; const char* B; int pm, pn, aux; };

struct StaticOrder {
    const char* A; const char* Bt; int K, nM, nN, nwg, G, c;
    __device__ void init(const void* A_, const void* Bt_, int M, int N, int K_, int G_, int c_) { A = (const char*)A_; Bt = (const char*)Bt_; K = K_; nM = M / BM; nN = N / BM; nwg = nM * nN; G = G_; c = c_; }
    __device__ __forceinline__ bool next(int i, Unit& u) const {
        const long L = (long)i * G + c; if (L >= nwg) return false;
        int wgid = (int)L; { const int q = nwg / NXCD, r = nwg % NXCD, xcd = wgid % NXCD, off = wgid / NXCD; wgid = (xcd < r ? xcd * (q + 1) : r * (q + 1) + (xcd - r) * q) + off; }
        const int nig = WGM * nN, gid = wgid / nig, fm = gid * WGM, gsz = (nM - fm) < WGM ? (nM - fm) : WGM;
        u.pm = fm + ((wgid % nig) % gsz); u.pn = (wgid % nig) / gsz; u.aux = 0;
        u.A = A + (size_t)u.pm * BM * K * 2; u.B = Bt + (size_t)u.pn * BM * K * 2; return true;
    }
    __device__ __forceinline__ unsigned arow(const Unit&, int r) const { return (unsigned)(r * K) * 2u; }
};

typedef int i32x4 __attribute__((ext_vector_type(4)));
typedef int i32x8 __attribute__((ext_vector_type(8)));
template <class Epi, class Sched, bool ALIGN_EPI, int MODE = 0>
__device__ __forceinline__ void gemm_phase(LAS unsigned char* lds, const int K, const Sched& S, const Epi& E) {
    constexpr bool F8 = MODE == 1;
    const int tid = threadIdx.x, wid = __builtin_amdgcn_readfirstlane(tid >> 6), lane = tid & 63, wr = wid >> 2, wc = wid & 3, fr = lane & 15, fq = lane >> 4;
    const int nt = K / BK;
    int RA[2], CA[2]; unsigned voffB[2];
#pragma unroll
    for (int i = 0; i < 2; ++i) { int R, C; stage_rc(tid * 16 + i * 8192, R, C); const int Rb = Epi::PERM ? ((R & ~31) + perm32(R & 31)) : R;
        RA[i] = R; CA[i] = C; voffB[i] = (unsigned)(Rb * K + C) * 2u; }
    const size_t kstep = (size_t)(BK * 2);
    const size_t hstep = (size_t)HALF * K * 2;
    const unsigned ldsw = (unsigned)wid * 1024u;
    const int aoff = lds_byte(wr * 64 + fr, fq * 8), boff = lds_byte(wc * 32 + fr, fq * 8);
#define PG8_SA(b, h) (((b) * 2 + (h)) * HTB)
#define PG8_SB(b, h) ((4 + (b) * 2 + (h)) * HTB)
#define PG8_STAGE(bufoff, gbase, voff) do { _Pragma("unroll") for (int _i = 0; _i < 2; ++_i) \
        __builtin_amdgcn_global_load_lds((const unsigned*)((const char*)(gbase) + (voff)[_i]), (LAS unsigned*)(lds + (bufoff) + ldsw + _i * 8192), 16, 0, 0); } while (0)
#define PG8_LDA(dst, b, h) do { _Pragma("unroll") for (int m = 0; m < 4; ++m) _Pragma("unroll") for (int k = 0; k < 2; ++k) dst[m][k] = *(const LAS bf16x8*)(lds + PG8_SA(b, h) + aoff + m * 2048 + k * 1024); } while (0)
#define PG8_LDB(dst, b, h) do { _Pragma("unroll") for (int n = 0; n < 2; ++n) _Pragma("unroll") for (int k = 0; k < 2; ++k) dst[n][k] = *(const LAS bf16x8*)(lds + PG8_SB(b, h) + boff + n * 2048 + k * 1024); } while (0)
#define PG8_MMA(ai, bj, At, Bt) do { __builtin_amdgcn_s_setprio(1); _Pragma("unroll") for (int m = 0; m < 4; ++m) _Pragma("unroll") for (int n = 0; n < 2; ++n) { \
        if constexpr (F8) { const i32x8 _b = __builtin_shufflevector(__builtin_bit_cast(i32x4, Bt[n][0]), __builtin_bit_cast(i32x4, Bt[n][1]), 0, 1, 2, 3, 4, 5, 6, 7), \
                                        _a = __builtin_shufflevector(__builtin_bit_cast(i32x4, At[m][0]), __builtin_bit_cast(i32x4, At[m][1]), 0, 1, 2, 3, 4, 5, 6, 7); \
            asm volatile("v_mfma_scale_f32_16x16x128_f8f6f4 %0, %1, %2, %0, %3, %3 op_sel_hi:[0,0,0]" : "+v"(acc[ai][bj][m][n]) : "v"(_b), "v"(_a), "v"(f8sc)); } \
        else if constexpr (MODE == 2) { _Pragma("unroll") for (int k = 0; k < 2; ++k) acc[ai][bj][m][n] = __builtin_bit_cast(f32x4, __builtin_amdgcn_mfma_i32_16x16x64_i8(__builtin_bit_cast(i32x4, Bt[n][k]), __builtin_bit_cast(i32x4, At[m][k]), __builtin_bit_cast(i32x4, acc[ai][bj][m][n]), 0, 0, 0)); } \
        else { _Pragma("unroll") for (int k = 0; k < 2; ++k) acc[ai][bj][m][n] = __builtin_amdgcn_mfma_f32_16x16x32_bf16(Bt[n][k], At[m][k], acc[ai][bj][m][n], 0, 0, 0); } } \
        __builtin_amdgcn_s_setprio(0); } while (0)
#define PG8_WAIT_V(n) asm volatile("s_waitcnt vmcnt(" #n ")" ::: "memory")
#define PG8_WAIT_L(n) asm volatile("s_waitcnt lgkmcnt(" #n ")" ::: "memory")
#define PG8_BAR __builtin_amdgcn_s_barrier()
#define PG8_SCHED __builtin_amdgcn_sched_barrier(0)
    const int f8sc = 0x7f7f7f7f;
    Unit cur, nxt; int ui = 0;
    if (!S.next(0, cur)) return;
    typename Epi::State est; E.pre(est, cur, wr, fr);
    f32x4 acc[2][2][4][2];
#pragma unroll
    for (int a = 0; a < 2; ++a)
#pragma unroll
        for (int b = 0; b < 2; ++b)
#pragma unroll
            for (int m = 0; m < 4; ++m)
#pragma unroll
                for (int n = 0; n < 2; ++n) acc[a][b][m][n] = (f32x4){0.f, 0.f, 0.f, 0.f};
#define PG8_ACC_FENCE() do { if constexpr (F8) { _Pragma("unroll") for (int a = 0; a < 2; ++a) _Pragma("unroll") for (int b = 0; b < 2; ++b) _Pragma("unroll") for (int m = 0; m < 4; ++m) _Pragma("unroll") for (int n = 0; n < 2; ++n) \
        asm volatile("" : "+v"(acc[a][b][m][n])); asm volatile("s_nop 3" ::: "memory"); } } while (0)
    PG8_ACC_FENCE();
    bf16x8 At[4][2], B0[2][2], B1[2][2];
    unsigned vA0[2], vA1[2], nA0[2], nA1[2];
#pragma unroll
    for (int i = 0; i < 2; ++i) { vA0[i] = S.arow(cur, RA[i]) + CA[i] * 2u; vA1[i] = S.arow(cur, HALF + RA[i]) + CA[i] * 2u; nA0[i] = vA0[i]; nA1[i] = vA1[i]; }
    const char* cA = cur.A; const char* cB = cur.B;
    PG8_STAGE(PG8_SB(0, 0), cB, voffB); PG8_STAGE(PG8_SB(0, 1), cB + hstep, voffB); PG8_STAGE(PG8_SA(0, 0), cA, vA0); PG8_STAGE(PG8_SA(0, 1), cA, vA1);
    if (wr == 1) PG8_BAR;
    PG8_WAIT_V(2); PG8_BAR;
    PG8_STAGE(PG8_SB(1, 0), cB + kstep, voffB); PG8_STAGE(PG8_SA(1, 0), cA + kstep, vA0); PG8_STAGE(PG8_SB(1, 1), cB + hstep + kstep, voffB);
    PG8_WAIT_V(6); PG8_BAR;
    for (;;) {
        const bool has_next = S.next(ui + 1, nxt);
        const char* nA = has_next ? nxt.A : cA; const char* nB = has_next ? nxt.B : cB;
        if (has_next) {
#pragma unroll
            for (int i = 0; i < 2; ++i) { nA0[i] = S.arow(nxt, RA[i]) + CA[i] * 2u; nA1[i] = S.arow(nxt, HALF + RA[i]) + CA[i] * 2u; }
        }
        for (int t = 0; t < nt; t += 2) {
            const bool last = (t == nt - 2);
            const char* a1 = cA + (size_t)(t + 1) * kstep;
            const char* a2 = last ? nA : cA + (size_t)(t + 2) * kstep; const char* b2 = last ? nB : cB + (size_t)(t + 2) * kstep;
            const char* a3 = a2 + kstep; const char* b3 = b2 + kstep;
            unsigned w0[2], w1[2];
#pragma unroll
            for (int i = 0; i < 2; ++i) { w0[i] = last ? nA0[i] : vA0[i]; w1[i] = last ? nA1[i] : vA1[i]; }
            PG8_LDB(B0, 0, 0); PG8_LDB(B1, 0, 1); PG8_SCHED; PG8_LDA(At, 0, 0); PG8_STAGE(PG8_SA(1, 1), a1, vA1);
            PG8_WAIT_V(8); PG8_WAIT_L(0); PG8_BAR; PG8_MMA(0, 0, At, B0); PG8_MMA(0, 1, At, B1); PG8_BAR; PG8_SCHED;
            PG8_LDA(At, 0, 1); PG8_STAGE(PG8_SB(0, 0), b2, voffB); PG8_STAGE(PG8_SB(0, 1), b2 + hstep, voffB); PG8_STAGE(PG8_SA(0, 0), a2, w0);
            PG8_WAIT_V(8); PG8_WAIT_L(0); PG8_BAR; PG8_MMA(1, 0, At, B0); PG8_MMA(1, 1, At, B1); PG8_BAR; PG8_SCHED;
            PG8_LDB(B0, 1, 0); PG8_LDB(B1, 1, 1); PG8_SCHED; PG8_LDA(At, 1, 0); PG8_STAGE(PG8_SA(0, 1), a2, w1);
            PG8_WAIT_V(8); PG8_WAIT_L(0); PG8_BAR; PG8_MMA(0, 0, At, B0); PG8_MMA(0, 1, At, B1); PG8_BAR; PG8_SCHED;
            PG8_LDA(At, 1, 1); PG8_STAGE(PG8_SB(1, 0), b3, voffB); PG8_STAGE(PG8_SB(1, 1), b3 + hstep, voffB); PG8_STAGE(PG8_SA(1, 0), a3, w0);
            PG8_WAIT_V(8); PG8_WAIT_L(0); PG8_BAR; PG8_MMA(1, 0, At, B0); PG8_MMA(1, 1, At, B1); PG8_BAR; PG8_SCHED;
        }
        if constexpr (ALIGN_EPI) { if (wr == 0) PG8_BAR; }
        if constexpr (F8) { asm volatile("s_nop 15\n\ts_nop 15\n\ts_nop 7" ::: "memory"); __builtin_amdgcn_sched_barrier(0); }
        E(acc, cur, wr, wc, fr, fq, est);
        if (!has_next) break;
        E.pre(est, nxt, wr, fr);
#pragma unroll
        for (int a = 0; a < 2; ++a)
#pragma unroll
            for (int b = 0; b < 2; ++b)
#pragma unroll
                for (int m = 0; m < 4; ++m)
#pragma unroll
                    for (int n = 0; n < 2; ++n) acc[a][b][m][n] = (f32x4){0.f, 0.f, 0.f, 0.f};
        PG8_ACC_FENCE();
        cur = nxt; cA = nA; cB = nB; ++ui;
#pragma unroll
        for (int i = 0; i < 2; ++i) { vA0[i] = nA0[i]; vA1[i] = nA1[i]; }
        if constexpr (ALIGN_EPI) { if (wr == 1) PG8_BAR; }
    }
    PG8_WAIT_V(0);
    if constexpr (!ALIGN_EPI) { if (wr == 0) PG8_BAR; }
    PG8_BAR;
#undef PG8_SA
#undef PG8_ACC_FENCE
#undef PG8_SB
#undef PG8_STAGE
#undef PG8_LDA
#undef PG8_LDB
#undef PG8_MMA
#undef PG8_WAIT_V
#undef PG8_WAIT_L
#undef PG8_BAR
#undef PG8_SCHED
}

struct EpiBf16 {
    static constexpr bool PERM = true;
    bf16* O; int ldc;
    struct State {}; __device__ __forceinline__ void pre(State&, const Unit&, int, int) const {}
    __device__ __forceinline__ void operator()(const f32x4 (&acc)[2][2][4][2], const Unit& u, int wr, int wc, int fr, int fq, const State&) const {
        const int row0 = u.pm * BM + wr * 64 + fr; const int col0 = u.pn * BM + wc * 32 + 8 * fq;
#pragma unroll
        for (int ai = 0; ai < 2; ++ai)
#pragma unroll
            for (int m = 0; m < 4; ++m) { bf16* rowp = O + (size_t)(row0 + ai * HALF + m * 16) * ldc + col0;
#pragma unroll
                for (int bj = 0; bj < 2; ++bj) { const f32x4 v0 = acc[ai][bj][m][0], v1 = acc[ai][bj][m][1];
                    u32x4 w; w.x = cvt_pk_bf16(v0[0], v0[1]); w.y = cvt_pk_bf16(v0[2], v0[3]); w.z = cvt_pk_bf16(v1[0], v1[1]); w.w = cvt_pk_bf16(v1[2], v1[3]);
                    *(u32x4*)(rowp + bj * HALF) = w; } }
    }
};
struct EpiBf16S {
    static constexpr bool PERM = true;
    bf16* O; int ldc; const float* rs;
    struct State { float rsr[2][4]; };
    __device__ __forceinline__ void pre(State& st, const Unit& u, int wr, int fr) const {
        const int row0 = u.pm * BM + wr * 64 + fr;
#pragma unroll
        for (int ai = 0; ai < 2; ++ai)
#pragma unroll
            for (int m = 0; m < 4; ++m) st.rsr[ai][m] = rs[row0 + ai * HALF + m * 16];
    }
    __device__ __forceinline__ void operator()(const f32x4 (&acc)[2][2][4][2], const Unit& u, int wr, int wc, int fr, int fq, const State& st) const {
        const int row0 = u.pm * BM + wr * 64 + fr; const int col0 = u.pn * BM + wc * 32 + 8 * fq;
        const float (&rsr)[2][4] = st.rsr;
#pragma unroll
        for (int ai = 0; ai < 2; ++ai)
#pragma unroll
            for (int m = 0; m < 4; ++m) { bf16* rowp = O + (size_t)(row0 + ai * HALF + m * 16) * ldc + col0; const float r = rsr[ai][m];
#pragma unroll
                for (int bj = 0; bj < 2; ++bj) { const f32x4 v0 = acc[ai][bj][m][0] * r, v1 = acc[ai][bj][m][1] * r;
                    u32x4 w; w.x = cvt_pk_bf16(v0[0], v0[1]); w.y = cvt_pk_bf16(v0[2], v0[3]); w.z = cvt_pk_bf16(v1[0], v1[1]); w.w = cvt_pk_bf16(v1[2], v1[3]);
                    *(u32x4*)(rowp + bj * HALF) = w; } }
    }
};
struct EpiI8S {
    static constexpr bool PERM = true;
    bf16* O; int ldc; const float* f; const unsigned* wmaxbits; unsigned char* iqk8;
    struct State { float rsr[2][4]; };
    __device__ __forceinline__ void pre(State& st, const Unit& u, int wr, int fr) const {
        const int row0 = u.pm * BM + wr * 64 + fr;
        const float sw = __builtin_bit_cast(float, __hip_atomic_load(wmaxbits, __ATOMIC_RELAXED, __HIP_MEMORY_SCOPE_AGENT)) * (1.f / 127.f);
#pragma unroll
        for (int ai = 0; ai < 2; ++ai)
#pragma unroll
            for (int m = 0; m < 4; ++m) st.rsr[ai][m] = f[row0 + ai * HALF + m * 16] * sw;
    }
    __device__ __forceinline__ void operator()(const f32x4 (&acc)[2][2][4][2], const Unit& u, int wr, int wc, int fr, int fq, const State& st) const {
        const int row0 = u.pm * BM + wr * 64 + fr; const int col0 = u.pn * BM + wc * 32 + 8 * fq;
#pragma unroll
        for (int ai = 0; ai < 2; ++ai)
#pragma unroll
            for (int m = 0; m < 4; ++m) { bf16* rowp = O + (size_t)(row0 + ai * HALF + m * 16) * ldc + col0; const float r = st.rsr[ai][m];
#pragma unroll
                for (int bj = 0; bj < 2; ++bj) { const i32x4 i0 = __builtin_bit_cast(i32x4, acc[ai][bj][m][0]), i1 = __builtin_bit_cast(i32x4, acc[ai][bj][m][1]);
                    const int col = col0 + bj * HALF;
                    if (iqk8 && col >= 2176 && col < 2496) { const float r8 = r * 8.f;
                        *(u32x2*)(iqk8 + (size_t)(row0 + ai * HALF + m * 16) * 320 + (col - 2176)) = (u32x2){pk4_fp8((float)i0[0] * r8, (float)i0[1] * r8, (float)i0[2] * r8, (float)i0[3] * r8), pk4_fp8((float)i1[0] * r8, (float)i1[1] * r8, (float)i1[2] * r8, (float)i1[3] * r8)}; }
                    else { u32x4 w; w.x = cvt_pk_bf16((float)i0[0] * r, (float)i0[1] * r); w.y = cvt_pk_bf16((float)i0[2] * r, (float)i0[3] * r); w.z = cvt_pk_bf16((float)i1[0] * r, (float)i1[1] * r); w.w = cvt_pk_bf16((float)i1[2] * r, (float)i1[3] * r);
                        *(u32x4*)(rowp + bj * HALF) = w; } } }
    }
};
struct EpiResF32 {
    static constexpr bool PERM = false;
    const float* base; float* out; int ldc;
    struct State {}; __device__ __forceinline__ void pre(State&, const Unit&, int, int) const {}
    __device__ __forceinline__ void operator()(const f32x4 (&acc)[2][2][4][2], const Unit& u, int wr, int wc, int fr, int fq, const State&) const {
        const int row0 = u.pm * BM + wr * 64 + fr, col0 = u.pn * BM + wc * 32 + 4 * fq;
#pragma unroll
        for (int ai = 0; ai < 2; ++ai)
#pragma unroll
            for (int m = 0; m < 4; ++m) { const size_t off = (size_t)(row0 + ai * HALF + m * 16) * ldc + col0;
#pragma unroll
                for (int bj = 0; bj < 2; ++bj)
#pragma unroll
                    for (int n = 0; n < 2; ++n) { const f32x4 bs = *(const f32x4*)(base + off + bj * HALF + n * 16); *(f32x4*)(out + off + bj * HALF + n * 16) = bs + acc[ai][bj][m][n]; } }
    }
};

struct EpiResXB {
    static constexpr bool PERM = true;
    const float* srcf; const bf16* srcb; bf16* xb; unsigned char* xb8; float ascale;
    struct State {}; __device__ __forceinline__ void pre(State&, const Unit&, int, int) const {}
    __device__ __forceinline__ void operator()(const f32x4 (&acc)[2][2][4][2], const Unit& u, int wr, int wc, int fr, int fq, const State&) const {
        const int row0 = u.pm * BM + wr * 64 + fr, col0 = u.pn * BM + wc * 32 + 8 * fq;
#pragma unroll
        for (int ai = 0; ai < 2; ++ai)
#pragma unroll
            for (int m = 0; m < 4; ++m) { const size_t off = (size_t)(row0 + ai * HALF + m * 16) * DM + col0;
#pragma unroll
                for (int bj = 0; bj < 2; ++bj) { f32x4 a0, a1;
                    if (srcf) { a0 = *(const f32x4*)(srcf + off + bj * HALF); a1 = *(const f32x4*)(srcf + off + bj * HALF + 4); }
                    else { const u32x4 v = *(const u32x4*)(srcb + off + bj * HALF); a0 = (f32x4){bflo(v.x), bfhi(v.x), bflo(v.y), bfhi(v.y)}; a1 = (f32x4){bflo(v.z), bfhi(v.z), bflo(v.w), bfhi(v.w)}; }
                    a0 += acc[ai][bj][m][0] * ascale; a1 += acc[ai][bj][m][1] * ascale;
                    *(u32x4*)(xb + off + bj * HALF) = (u32x4){pk2(a0[0], a0[1]), pk2(a0[2], a0[3]), pk2(a1[0], a1[1]), pk2(a1[2], a1[3])};
                    a0 *= F8_SX; a1 *= F8_SX;
                    *(u32x2*)(xb8 + off + bj * HALF) = (u32x2){pk4_fp8(a0[0], a0[1], a0[2], a0[3]), pk4_fp8(a1[0], a1[1], a1[2], a1[3])}; } }
    }
};

struct MoeOrder {
    const char* Abase; const char* Bbase; size_t bstride; int K, G, c, tile_lo, tile_hi; const LAS int* ptile; const LAS int* cntv; const int* list; bool gather;
    __device__ __forceinline__ bool next(int i, Unit& u) const {
        const int NT = tile_hi - tile_lo; int tile, pn;
        if ((G & 7) == 0 && G >= 32) {
            const int x = c & 7, sl = c >> 3, per = G >> 3, TPX = (NT + 7) >> 3;
            const int lu = i * per + sl, lt = lu >> 2; pn = lu & 3;
            tile = tile_lo + x * TPX + lt;
            if (lt >= TPX || tile >= tile_hi) return false;
        } else {
            const long Lq = (long)i * G + c; if (Lq >= (long)NT * 4) return false;
            tile = tile_lo + (int)(Lq >> 2); pn = (int)(Lq & 3);
        }
        int e = 0;
#pragma unroll
        for (int st = 32; st >= 1; st >>= 1) { const int k = e + st; if (k < 64 && tile >= __builtin_amdgcn_readfirstlane(ptile[k])) e = k; }
        const int j = tile - __builtin_amdgcn_readfirstlane(ptile[e]);
        u.pm = tile; u.pn = pn; u.aux = e | (j << 6);
        u.A = gather ? Abase : Abase + (size_t)tile * BM * K * 2; u.B = Bbase + (size_t)(e & 31) * bstride + (size_t)pn * BM * K * 2; return true;
    }
    __device__ __forceinline__ unsigned arow(const Unit& u, int r) const {
        if (!gather) return (unsigned)(r * K) * 2u;
        const int e = u.aux & 63, pos = (u.aux >> 6) * 256 + r; const int cn = cntv[e];
        const int tok = pos < cn ? list[(size_t)e * 65536 + pos] : 0;
        return (unsigned)tok * (unsigned)(K * 2);
    }
};
struct EpiSwiGLU {
    static constexpr bool PERM = true;
    unsigned char* H; const float* rl; const LAS int* cntv;
    struct State { float rsr[2][4]; };
    __device__ __forceinline__ void pre(State& st, const Unit& u, int wr, int fr) const {
        const int e = u.aux & 63, j = u.aux >> 6; const int cn = cntv[e];
#pragma unroll
        for (int ai = 0; ai < 2; ++ai)
#pragma unroll
            for (int m = 0; m < 4; ++m) { const int pos = j * 256 + ai * HALF + wr * 64 + m * 16 + fr; st.rsr[ai][m] = rl[(size_t)e * 65536 + (pos < cn ? pos : 0)]; }
    }
    __device__ __forceinline__ void operator()(const f32x4 (&acc)[2][2][4][2], const Unit& u, int wr, int wc, int fr, int fq, const State& st) const {
        const int row0 = u.pm * BM + wr * 64 + fr; const int col0 = u.pn * 128 + wc * 32 + 8 * fq;
        const float (&rsr)[2][4] = st.rsr;
#pragma unroll
        for (int ai = 0; ai < 2; ++ai)
#pragma unroll
            for (int m = 0; m < 4; ++m) { unsigned char* rowp = H + (size_t)(row0 + ai * HALF + m * 16) * 512 + col0;
                const float rs = rsr[ai][m] * (1.f / (F8_SX * F8_SW));
                const f32x4 g0 = acc[ai][0][m][0] * rs, g1 = acc[ai][0][m][1] * rs, u0 = acc[ai][1][m][0] * rs, u1 = acc[ai][1][m][1] * rs;
                float h[8];
#pragma unroll
                for (int q = 0; q < 4; ++q) { h[q] = g0[q] * __builtin_amdgcn_rcpf(1.f + __builtin_amdgcn_exp2f(-1.44269504f * g0[q])) * u0[q]; h[4 + q] = g1[q] * __builtin_amdgcn_rcpf(1.f + __builtin_amdgcn_exp2f(-1.44269504f * g1[q])) * u1[q]; }
                *(u32x2*)rowp = (u32x2){pk4_fp8(h[0] * F8_SH, h[1] * F8_SH, h[2] * F8_SH, h[3] * F8_SH), pk4_fp8(h[4] * F8_SH, h[5] * F8_SH, h[6] * F8_SH, h[7] * F8_SH)}; }
    }
};
template <bool FINAL> struct EpiScatter {
    static constexpr bool PERM = true;
    bf16* xb; float* out; const int* list; const float* wl; const LAS int* cntv;
    struct State { int tok[2][4]; float wg[2][4]; };
    __device__ __forceinline__ void pre(State& st, const Unit& u, int wr, int fr) const {
        const int e = u.aux & 63, j = u.aux >> 6; const int cn = cntv[e];
#pragma unroll
        for (int ai = 0; ai < 2; ++ai)
#pragma unroll
            for (int m = 0; m < 4; ++m) { const int pos = j * 256 + ai * HALF + wr * 64 + m * 16 + fr; const int pc = pos < cn ? pos : 0;
                st.tok[ai][m] = list[(size_t)e * 65536 + pc]; st.wg[ai][m] = wl[(size_t)e * 65536 + pc] * (1.f / (F8_SH * F8_SW)); }
    }
    __device__ __forceinline__ void operator()(const f32x4 (&acc)[2][2][4][2], const Unit& u, int wr, int wc, int fr, int fq, const State& st) const {
        const int e = u.aux & 63, j = u.aux >> 6; const int cn = cntv[e];
        const int col0 = u.pn * BM + wc * 32 + 8 * fq;
        const int (&tok)[2][4] = st.tok; const float (&wg)[2][4] = st.wg; bool ok[2][4];
#pragma unroll
        for (int ai = 0; ai < 2; ++ai)
#pragma unroll
            for (int m = 0; m < 4; ++m) ok[ai][m] = j * 256 + ai * HALF + wr * 64 + m * 16 + fr < cn;
#pragma unroll
        for (int ai = 0; ai < 2; ++ai) {
            u32x4 v[4][2];
#pragma unroll
            for (int m = 0; m < 4; ++m)
#pragma unroll
                for (int bj = 0; bj < 2; ++bj) v[m][bj] = *(const u32x4*)(xb + (size_t)tok[ai][m] * DM + col0 + bj * HALF);
#pragma unroll
            for (int m = 0; m < 4; ++m) { const size_t off = (size_t)tok[ai][m] * DM + col0;
#pragma unroll
                for (int bj = 0; bj < 2; ++bj) { const u32x4 x = v[m][bj];
                    const f32x4 a0 = (f32x4){bflo(x.x), bfhi(x.x), bflo(x.y), bfhi(x.y)} + wg[ai][m] * acc[ai][bj][m][0], a1 = (f32x4){bflo(x.z), bfhi(x.z), bflo(x.w), bfhi(x.w)} + wg[ai][m] * acc[ai][bj][m][1];
                    if (ok[ai][m]) {
                        if (FINAL) { *(f32x4*)(out + off + bj * HALF) = a0; *(f32x4*)(out + off + bj * HALF + 4) = a1; }
                        else *(u32x4*)(xb + off + bj * HALF) = (u32x4){pk2(a0[0], a0[1]), pk2(a0[2], a0[3]), pk2(a1[0], a1[1]), pk2(a1[2], a1[3])}; } } }
        }
    }
};
}

struct Frame {
    LAS unsigned char* lds;
    volatile LAS unsigned* MISC;
    gu32* ctl;
    int tid, lane, wave, G, bid;
    float* out; unsigned char* ws;
};
struct Args { const float* in[31]; float* out; unsigned char* ws; int ph_lo, ph_hi, rep, pad; };
#ifndef REP_PART
#define REP_PART 0
#endif
#ifndef REP_PHASE
#define REP_PHASE -1
#endif
#define NREP(k) ((REP_PHASE == (k)) ? args.rep : 1)
__device__ __forceinline__ float wave_sum(float v) {
#pragma unroll
    for (int o = 1; o < 64; o <<= 1) v += __shfl_xor(v, o);
    return v;
}

template <class Map, int F8OUT = 0>
__device__ __forceinline__ void transpose_item(const float* W, int K, int pitch, int col0, int ncols, bf16* WT, LAS float* scr, int item, int lane, Map dmap, const float* gk = nullptr, float oscale = 1.f) {
    const int nblk = (ncols + 63) / 64, kb = item / nblk, nb = item % nblk, k0 = 64 * kb, n0 = 64 * nb;
    const int nn = n0 + lane;
    float v[64];
#pragma unroll
    for (int kk = 0; kk < 64; ++kk) v[kk] = (nn < ncols) ? W[(size_t)(k0 + kk) * pitch + col0 + nn] : 0.f;
#pragma unroll
    for (int kk = 0; kk < 64; ++kk) scr[kk * 65 + lane] = gk ? v[kk] * gk[k0 + kk] : v[kk];
    LDS_WAIT(); asm volatile("" ::: "memory");
    const int c = lane & 7;
#pragma unroll
    for (int j = 0; j < 8; ++j) { const int n = (lane >> 3) + 8 * j; const LAS float* s = scr + (8 * c) * 65 + n;
        if (F8OUT == 2) { const u32x2 o8 = (u32x2){pk4_i8(s[0 * 65] * oscale, s[1 * 65] * oscale, s[2 * 65] * oscale, s[3 * 65] * oscale), pk4_i8(s[4 * 65] * oscale, s[5 * 65] * oscale, s[6 * 65] * oscale, s[7 * 65] * oscale)};
            if (n0 + n < ncols) *(u32x2*)((unsigned char*)WT + (size_t)dmap(n0 + n) * K + k0 + 8 * c) = o8; }
        else if (F8OUT == 1) { const u32x2 o8 = (u32x2){pk4_fp8(s[0 * 65] * F8_SW, s[1 * 65] * F8_SW, s[2 * 65] * F8_SW, s[3 * 65] * F8_SW), pk4_fp8(s[4 * 65] * F8_SW, s[5 * 65] * F8_SW, s[6 * 65] * F8_SW, s[7 * 65] * F8_SW)};
            if (n0 + n < ncols) *(u32x2*)((unsigned char*)WT + (size_t)dmap(n0 + n) * K + k0 + 8 * c) = o8; }
        else { u32x4 o; o.x = pk2(s[0 * 65], s[1 * 65]); o.y = pk2(s[2 * 65], s[3 * 65]); o.z = pk2(s[4 * 65], s[5 * 65]); o.w = pk2(s[6 * 65], s[7 * 65]);
            if (n0 + n < ncols) *(u32x4*)(WT + (size_t)dmap(n0 + n) * K + k0 + 8 * c) = o; } }
    LDS_WAIT(); asm volatile("" ::: "memory");
}
struct MapId { int off; __device__ int operator()(int n) const { return n + off; } };
struct MapEven { __device__ int operator()(int c) const {
    if (c < 1536) return c; if (c < 1544) return EDT + (c - 1536); if (c < 2056) return EQ + (c - 1544); if (c < 2120) return EK + (c - 2056);
    if (c < 2184) return EV + (c - 2120); if (c < 2440) return EIQ + (c - 2184); if (c < 2504) return EIK + (c - 2440); return EIW + (c - 2504); } };
struct MapGU { int half; __device__ int operator()(int n) const { return 256 * (n >> 7) + 128 * half + (n & 127); } };

__device__ __forceinline__ void rms_row_to_bf16(const float* xrow, const float* gain, bf16* orow, int lane) {
    const f32x4* xr = (const f32x4*)xrow + lane; const f32x4* gr = (const f32x4*)gain + lane;
    f32x4 v[4]; float s = 0.f;
#pragma unroll
    for (int j = 0; j < 4; ++j) { v[j] = xr[64 * j]; s += (v[j].x * v[j].x + v[j].y * v[j].y) + (v[j].z * v[j].z + v[j].w * v[j].w); }
    const float rs = 1.f / sqrtf(wave_sum(s) * (1.f / DM) + NORM_EPS);
    unsigned long long* o8 = (unsigned long long*)orow + lane;
#pragma unroll
    for (int j = 0; j < 4; ++j) { const f32x4 g = gr[64 * j]; o8[64 * j] = (unsigned long long)pk2(v[j].x * rs * g.x, v[j].y * rs * g.y) | ((unsigned long long)pk2(v[j].z * rs * g.z, v[j].w * rs * g.w) << 32); }
}

template <int NR> __device__ __forceinline__ void rms_rows_to_bf16(const float* xrow0, size_t xstride, const float* gain, bf16* orow0, size_t ostride, int lane) {
    f32x4 v[NR][4]; float s[NR];
#pragma unroll
    for (int q = 0; q < NR; ++q) { const f32x4* xr = (const f32x4*)(xrow0 + q * xstride) + lane;
#pragma unroll
        for (int j = 0; j < 4; ++j) v[q][j] = xr[64 * j]; }
#pragma unroll
    for (int q = 0; q < NR; ++q) { s[q] = 0.f;
#pragma unroll
        for (int j = 0; j < 4; ++j) s[q] += (v[q][j].x * v[q][j].x + v[q][j].y * v[q][j].y) + (v[q][j].z * v[q][j].z + v[q][j].w * v[q][j].w); }
#pragma unroll
    for (int o = 1; o < 64; o <<= 1) {
#pragma unroll
        for (int q = 0; q < NR; ++q) s[q] += __shfl_xor(s[q], o); }
    const f32x4* gr = (const f32x4*)gain + lane;
#pragma unroll
    for (int q = 0; q < NR; ++q) { const float rs = 1.f / sqrtf(s[q] * (1.f / DM) + NORM_EPS); unsigned long long* o8 = (unsigned long long*)(orow0 + q * ostride) + lane;
#pragma unroll
        for (int j = 0; j < 4; ++j) { const f32x4 g = gr[64 * j]; o8[64 * j] = (unsigned long long)pk2(v[q][j].x * rs * g.x, v[q][j].y * rs * g.y) | ((unsigned long long)pk2(v[q][j].z * rs * g.z, v[q][j].w * rs * g.w) << 32); } }
}
template <int NR> __device__ __forceinline__ void rows_to_i8(const float* xrow0, size_t xstride, unsigned char* orow0, size_t ostride, float* f0, size_t fstride, int lane) {
    f32x4 v[NR][4]; float s[NR], mx[NR];
#pragma unroll
    for (int q = 0; q < NR; ++q) { const f32x4* xr = (const f32x4*)(xrow0 + q * xstride) + lane;
#pragma unroll
        for (int j = 0; j < 4; ++j) v[q][j] = xr[64 * j]; }
#pragma unroll
    for (int q = 0; q < NR; ++q) { s[q] = 0.f; mx[q] = 0.f;
#pragma unroll
        for (int j = 0; j < 4; ++j) { s[q] += (v[q][j].x * v[q][j].x + v[q][j].y * v[q][j].y) + (v[q][j].z * v[q][j].z + v[q][j].w * v[q][j].w);
            mx[q] = fmaxf(fmaxf(mx[q], fmaxf(fabsf(v[q][j].x), fabsf(v[q][j].y))), fmaxf(fabsf(v[q][j].z), fabsf(v[q][j].w))); } }
#pragma unroll
    for (int o = 1; o < 64; o <<= 1) {
#pragma unroll
        for (int q = 0; q < NR; ++q) { s[q] += __shfl_xor(s[q], o); mx[q] = fmaxf(mx[q], __shfl_xor(mx[q], o)); } }
#pragma unroll
    for (int q = 0; q < NR; ++q) { unsigned* o4 = (unsigned*)(orow0 + q * ostride) + lane;
        const float inv = mx[q] > 0.f ? 127.f / mx[q] : 0.f;
        if (lane == 0) f0[q * fstride] = (mx[q] * (1.f / 127.f)) / sqrtf(s[q] * (1.f / DM) + NORM_EPS);
#pragma unroll
        for (int j = 0; j < 4; ++j) o4[64 * j] = pk4_i8(v[q][j].x * inv, v[q][j].y * inv, v[q][j].z * inv, v[q][j].w * inv); }
}
template <int NR> __device__ __forceinline__ void rms_rowsb_to_bf16(const bf16* xrow0, const float* gain, bf16* orow0, int lane) {
    u32x2 raw[NR][4]; float s[NR];
#pragma unroll
    for (int q = 0; q < NR; ++q) { const u32x2* xr = (const u32x2*)(xrow0 + (size_t)q * DM) + lane;
#pragma unroll
        for (int j = 0; j < 4; ++j) raw[q][j] = xr[64 * j]; }
#pragma unroll
    for (int q = 0; q < NR; ++q) { s[q] = 0.f;
#pragma unroll
        for (int j = 0; j < 4; ++j) { const float a = bflo(raw[q][j].x), b = bfhi(raw[q][j].x), c = bflo(raw[q][j].y), d = bfhi(raw[q][j].y); s[q] += (a * a + b * b) + (c * c + d * d); } }
#pragma unroll
    for (int o = 1; o < 64; o <<= 1) {
#pragma unroll
        for (int q = 0; q < NR; ++q) s[q] += __shfl_xor(s[q], o); }
    const f32x4* gr = (const f32x4*)gain + lane;
#pragma unroll
    for (int q = 0; q < NR; ++q) { const float rs = 1.f / sqrtf(s[q] * (1.f / DM) + NORM_EPS); unsigned long long* o8 = (unsigned long long*)(orow0 + (size_t)q * DM) + lane;
#pragma unroll
        for (int j = 0; j < 4; ++j) { const f32x4 g = gr[64 * j];
            o8[64 * j] = (unsigned long long)pk2(bflo(raw[q][j].x) * rs * g.x, bfhi(raw[q][j].x) * rs * g.y) | ((unsigned long long)pk2(bflo(raw[q][j].y) * rs * g.z, bfhi(raw[q][j].y) * rs * g.w) << 32); } }
}
__device__ __forceinline__ void rms_rowb_to_bf16(const bf16* xrow, const float* gain, bf16* orow, int lane) {
    const u32x2* xr = (const u32x2*)xrow + lane; const f32x4* gr = (const f32x4*)gain + lane;
    f32x4 v[4]; float s = 0.f;
#pragma unroll
    for (int j = 0; j < 4; ++j) { const u32x2 q = xr[64 * j]; v[j] = (f32x4){bflo(q.x), bfhi(q.x), bflo(q.y), bfhi(q.y)}; s += (v[j].x * v[j].x + v[j].y * v[j].y) + (v[j].z * v[j].z + v[j].w * v[j].w); }
    const float rs = 1.f / sqrtf(wave_sum(s) * (1.f / DM) + NORM_EPS);
    unsigned long long* o8 = (unsigned long long*)orow + lane;
#pragma unroll
    for (int j = 0; j < 4; ++j) { const f32x4 g = gr[64 * j]; o8[64 * j] = (unsigned long long)pk2(v[j].x * rs * g.x, v[j].y * rs * g.y) | ((unsigned long long)pk2(v[j].z * rs * g.z, v[j].w * rs * g.w) << 32); }
}
__device__ __forceinline__ void p_wmax(Frame& F, const Args& A) {
    const float* W = A.in[4]; const float* g = A.in[2];
    float m = 0.f;
    for (int i = F.bid * NTHR + F.tid; i < 1024 * 2508; i += F.G * NTHR) { const int k = i / 2508; m = fmaxf(m, fabsf(W[i] * g[k])); }
#pragma unroll
    for (int o = 1; o < 64; o <<= 1) m = fmaxf(m, __shfl_xor(m, o));
    if (F.lane == 0) __hip_atomic_fetch_max((unsigned*)(F.ctl + CW_WMAX), __builtin_bit_cast(unsigned, m), __ATOMIC_RELAXED, __HIP_MEMORY_SCOPE_AGENT);
    const float* W1 = A.in[14]; const float* g1 = A.in[2] + DM;
    float m1 = 0.f;
    for (int i = F.bid * NTHR + F.tid; i < 1024 * 2560; i += F.G * NTHR) { const int k = i / 2560, n = i - k * 2560; m1 = fmaxf(m1, fabsf(W1[(size_t)k * 2584 + n] * g1[k])); }
#pragma unroll
    for (int o = 1; o < 64; o <<= 1) m1 = fmaxf(m1, __shfl_xor(m1, o));
    if (F.lane == 0) __hip_atomic_fetch_max((unsigned*)(F.ctl + CW_WMAX + 1), __builtin_bit_cast(unsigned, m1), __ATOMIC_RELAXED, __HIP_MEMORY_SCOPE_AGENT);
}
__device__ __forceinline__ void p_prologue(Frame& F, const Args& A) {
    LAS float* scr = (LAS float*)(F.lds + F.wave * 17408);
    const int gw = F.bid * NWAVES + F.wave, NGW = F.G * NWAVES;
    bf16* Wie = (bf16*)(F.ws + WS_WIE); bf16* Woe = (bf16*)(F.ws + WS_WOE);
    constexpr int I_IE = 16 * 40, I_OE = 16 * 16;
    const float wmaxv = __builtin_bit_cast(float, __hip_atomic_load((unsigned*)(F.ctl + CW_WMAX), __ATOMIC_RELAXED, __HIP_MEMORY_SCOPE_AGENT));
    const float wq = wmaxv > 0.f ? 127.f / wmaxv : 0.f;
    const float wmaxv1 = __builtin_bit_cast(float, __hip_atomic_load((unsigned*)(F.ctl + CW_WMAX + 1), __ATOMIC_RELAXED, __HIP_MEMORY_SCOPE_AGENT));
    const float wq1 = wmaxv1 > 0.f ? 127.f / wmaxv1 : 0.f;
    for (int it = gw; it < I_IE + I_OE; it += NGW) {
        if (it < I_IE) transpose_item<MapEven, 2>(A.in[4], 1024, 2508, 0, 2508, Wie, scr, it, F.lane, MapEven(), A.in[2], wq);
        else transpose_item<MapId, 1>(A.in[13], 1024, 1024, 0, 1024, Woe, scr, it - I_IE, F.lane, MapId{0});
    }
    {
        bf16* Wgu = (bf16*)(F.ws + WS_WGU); bf16* Wd = (bf16*)(F.ws + WS_WD); bf16* WR = (bf16*)(F.ws + WS_WR);
        (void)Wgu; (void)Wd;
        for (int it = gw; it < 2 * 5 * 16; it += NGW) { const int l = it / 80, r = it % 80, q = r / 16, kb = r % 16;
            if (q == 0) transpose_item(A.in[26] + (size_t)l * 1024 * 4, 1024, 4, 0, 4, WR + (size_t)l * 48 * 1024, scr, kb, F.lane, MapId{0}, A.in[3] + l * DM);
            else transpose_item(A.in[27] + (size_t)(l * 4 + q - 1) * 1024 * 8, 1024, 8, 0, 8, WR + (size_t)l * 48 * 1024, scr, kb, F.lane, MapId{4 + 8 * (q - 1)}, A.in[3] + l * DM); }
        for (int i = gw * 64 + F.lane; i < 2 * 12 * 1024 / 8; i += NGW * 64) { const int l = i / (12 * 128), o = i % (12 * 128); *(u32x4*)(WR + (size_t)l * 48 * 1024 + 36 * 1024 + (size_t)o * 8) = (u32x4){0u, 0u, 0u, 0u}; }
    }
    {
        bf16* Wio = (bf16*)(F.ws + WS_WIO); bf16* Woo = (bf16*)(F.ws + WS_WOO); bf16* WGL = (bf16*)(F.ws + WS_WGL);
        bf16* W1K = (bf16*)(F.ws + WS_W1K); bf16* W1V = (bf16*)(F.ws + WS_W1V); bf16* W2 = (bf16*)(F.ws + WS_W2);
        constexpr int J0 = 16 * 40, J1 = J0 + 16, J2 = J1 + 16 * 16, J3 = J2 + 64 * 2, J4 = J3 + 64 * 2, J5 = J4 + 2 * 2, J6 = J5 + 2 * 2;
        for (int it = gw; it < J6; it += NGW) {
            if (it < J0) transpose_item<MapId, 2>(A.in[14], 1024, 2584, 0, 2560, Wio, scr, it, F.lane, MapId{0}, A.in[2] + DM, wq1);
            else if (it < J1) transpose_item(A.in[14], 1024, 2584, 2560, 24, WGL, scr, it - J0, F.lane, MapId{0}, A.in[2] + DM);
            else if (it < J2) transpose_item<MapId, 1>(A.in[25], 1024, 1024, 0, 1024, Woo, scr, it - J1, F.lane, MapId{0});
            else if (it < J3) transpose_item(A.in[21], 4096, 128, 0, 128, W1K, scr, it - J2, F.lane, MapId{0});
            else if (it < J4) transpose_item(A.in[23], 4096, 128, 0, 128, W1V, scr, it - J3, F.lane, MapId{0});
            else if (it < J5) transpose_item(A.in[22], 128, 128, 0, 128, W2, scr, it - J4, F.lane, MapId{0});
            else transpose_item(A.in[24], 128, 128, 0, 128, W2 + 128 * 128, scr, it - J5, F.lane, MapId{0});
        }
        for (int i = gw * 64 + F.lane; i < 8 * 1024 / 8; i += NGW * 64) *(u32x4*)(WGL + 24 * 1024 + (size_t)i * 8) = (u32x4){0u, 0u, 0u, 0u};
    }
    for (int i = gw * 64 + F.lane; i < 52 * 1024 / 16; i += NGW * 64) *((u32x4*)((unsigned char*)Wie + (size_t)2508 * 1024) + i) = (u32x4){0u, 0u, 0u, 0u};
    bf16* HB = (bf16*)(F.ws + WS_HB);
    { unsigned char* X8 = (unsigned char*)HB; float* FR = (float*)(F.ws + WS_RS);
      for (int m = gw; m < MTOK; m += 4 * NGW) rows_to_i8<4>(A.in[0] + (size_t)m * DM, (size_t)NGW * DM, X8 + (size_t)m * DM, (size_t)NGW * DM, FR + m, (size_t)NGW, F.lane); }
}

constexpr int SP = 136;
constexpr int L_CS = 0, L_BS = 34816, L_BT = 69632, L_XT = 104448, L_XS = 113152, L_ST = 121856, L_AC = 139264, L_DT = 139776, L_CW = 140288;
__device__ __forceinline__ bf16x8 lds_frag(LAS unsigned char* base, int row, int col) { return *(const LAS bf16x8*)(base + (row * SP + col) * 2); }

constexpr int S_CS = 0, S_BS = 34816, S_BT = 69632, S_XT = 104448, S_XS = 121856, S_AC = 139264, S_DT = 141312;
__device__ __forceinline__ void p_ssd1(Frame& F, const Args& A) {
    bf16* U = (bf16*)(F.ws + WS_U); bf16* YD = (bf16*)(F.ws + WS_HB); bf16* CS = (bf16*)(F.ws + WS_XB); bf16* CC = (bf16*)(F.ws + WS_CC); float* AC = (float*)(F.ws + WS_AC);
    const int w = F.wave;
    { const int tid = F.tid;
    for (int r0 = F.bid * 64; r0 < MTOK; r0 += F.G * 64) {
        const int row = r0 + (tid >> 3), c8 = (tid & 7) * 8;
        bf16* p = U + (size_t)row * LDE + EK + c8;
        const u32x4 v = *(const u32x4*)p; float f[8] = {bflo(v.x), bfhi(v.x), bflo(v.y), bfhi(v.y), bflo(v.z), bfhi(v.z), bflo(v.w), bfhi(v.w)};
        float s = 0.f;
#pragma unroll
        for (int j = 0; j < 8; ++j) s += f[j] * f[j];
        s += __shfl_xor(s, 1); s += __shfl_xor(s, 2); s += __shfl_xor(s, 4);
        const float rs = 1.f / sqrtf(s * (1.f / 64.f) + NORM_EPS); const float* g = A.in[12] + c8;
        const float r8 = rs * 8.f;
        *(u32x2*)(F.ws + WS_K8 + (size_t)row * 64 + c8) = (u32x2){pk4_fp8(f[0] * r8 * g[0], f[1] * r8 * g[1], f[2] * r8 * g[2], f[3] * r8 * g[3]), pk4_fp8(f[4] * r8 * g[4], f[5] * r8 * g[5], f[6] * r8 * g[6], f[7] * r8 * g[7])};
    } }
    LAS unsigned char* L = F.lds;
    LAS float* acum = (LAS float*)(L + S_AC); LAS float* dtv = (LAS float*)(L + S_DT);
    const float* conv_w = A.in[5]; const float* conv_b = A.in[6];
    for (int unit = F.bid; unit < 1024; unit += F.G) {
        int tid = F.tid, lane = F.lane; asm volatile("" : "+v"(tid), "+v"(lane));
        const int b = unit >> 6, c = (unit >> 1) & 31, g = unit & 1;
        const size_t rowbase = (size_t)b * SEQ + (size_t)c * 128;
        __syncthreads();
        {
            const int hq = tid >> 7, t = tid & 127, h = 4 * g + hq;
            const float dr = bf2f(U[(rowbase + t) * LDE + EDT + h]) + A.in[7][h];
            const float dt = dr > 20.f ? dr : log1pf(__expf(dr));
            float sc = dt * (-__expf(A.in[8][h]));
#pragma unroll
            for (int o = 1; o < 64; o <<= 1) { const float x = __shfl_up(sc, o); if (lane >= o) sc += x; }
            dtv[tid] = dt; acum[tid] = sc;
        }
        {
            const int cg = tid & 15, rr = tid >> 4;
#pragma unroll 1
            for (int T = 0; T < 2; ++T) {
                const int ch0 = (T == 0 ? 512 : 768) + g * 128 + 8 * cg;
                u32x4 raw[7];
#pragma unroll
                for (int j = 0; j < 7; ++j) { const int tl = 4 * rr - 3 + j; raw[j] = (u32x4){0u, 0u, 0u, 0u};
                    if (c > 0 || tl >= 0) raw[j] = *(const u32x4*)(U + (size_t)((long)rowbase + tl) * LDE + 512 + ch0); }
                LAS unsigned char* dst = L + (T == 0 ? S_BS : S_CS);
                unsigned opk[4][4];
#pragma unroll
                for (int e2 = 0; e2 < 4; ++e2) {
                    const float* wp = conv_w + ch0 + 2 * e2;
                    const f32x2 w0 = *(const f32x2*)wp, w1 = *(const f32x2*)(wp + 1024), w2 = *(const f32x2*)(wp + 2048), w3 = *(const f32x2*)(wp + 3072), bb = *(const f32x2*)(conv_b + ch0 + 2 * e2);
                    float lo[7], hi[7];
#pragma unroll
                    for (int j = 0; j < 7; ++j) { lo[j] = bflo(raw[j][e2]); hi[j] = bfhi(raw[j][e2]); }
                    float ol[4], oh[4];
#pragma unroll
                    for (int q = 0; q < 4; ++q) { ol[q] = siluf(bb.x + w0.x * lo[q] + w1.x * lo[q + 1] + w2.x * lo[q + 2] + w3.x * lo[q + 3]);
                                                  oh[q] = siluf(bb.y + w0.y * hi[q] + w1.y * hi[q + 1] + w2.y * hi[q + 2] + w3.y * hi[q + 3]); opk[q][e2] = pk2(ol[q], oh[q]); }
                    if (T == 0) {
                        *(LAS u32x2*)(L + S_BT + ((8 * cg + 2 * e2) * SP + 4 * rr) * 2) = (u32x2){pk2(ol[0], ol[1]), pk2(ol[2], ol[3])};
                        *(LAS u32x2*)(L + S_BT + ((8 * cg + 2 * e2 + 1) * SP + 4 * rr) * 2) = (u32x2){pk2(oh[0], oh[1]), pk2(oh[2], oh[3])};
                    }
                }
#pragma unroll
                for (int q = 0; q < 4; ++q) { const u32x4 pk = (u32x4){opk[q][0], opk[q][1], opk[q][2], opk[q][3]};
                    *(LAS u32x4*)(dst + ((4 * rr + q) * SP + 8 * cg) * 2) = pk;
                    if (T == 1) *(u32x4*)(CC + ((size_t)((b * 32 + c) * 2 + g) * 128 + 4 * rr + q) * 128 + 8 * cg) = pk; }
            }
        }
        __syncthreads();
        if (w & 1) acum[tid] += acum[tid - lane - 1];
        __syncthreads();
        AC[(rowbase + (tid & 127)) * 8 + 4 * g + (tid >> 7)] = acum[tid];
        const int mt = w >> 1, nh = w & 1, r = lane & 31, hh = lane >> 5;
        f32x16 cb[2];
#pragma unroll
        for (int j = 0; j < 2; ++j) {
            cb[j] = (f32x16){0.f, 0.f, 0.f, 0.f, 0.f, 0.f, 0.f, 0.f, 0.f, 0.f, 0.f, 0.f, 0.f, 0.f, 0.f, 0.f};
            const int s0 = 64 * nh + 32 * j;
            if (s0 <= 32 * mt + 31) {
#pragma unroll
                for (int ks = 0; ks < 8; ++ks) cb[j] = __builtin_amdgcn_mfma_f32_32x32x16_bf16(lds_frag(L + S_BS, s0 + r, 16 * ks + 8 * hh), lds_frag(L + S_CS, 32 * mt + r, 16 * ks + 8 * hh), cb[j], 0, 0, 0);
            }
        }
        __syncthreads();
#pragma unroll 1
        for (int hq = 0; hq < 4; ++hq) {
            const int h = 4 * g + hq;
            int tidq = F.tid, laneq = F.lane; asm volatile("" : "+v"(tidq), "+v"(laneq));
            const int r = laneq & 31, hh = laneq >> 5;
            const LAS float* ac = acum + hq * 128; const LAS float* dv = dtv + hq * 128;
            {
                const int cgx = tidq & 15, rr = tidq >> 4;
                const float* wp = conv_w + h * 64 + 4 * cgx; const float* bp = conv_b + h * 64 + 4 * cgx;
                const float aend = ac[127];
                u32x2 raw[7];
#pragma unroll
                for (int j = 0; j < 7; ++j) { const int tl = 4 * rr - 3 + j; raw[j] = (u32x2){0u, 0u};
                    if (c > 0 || tl >= 0) raw[j] = *(const u32x2*)(U + (size_t)((long)rowbase + tl) * LDE + EXS + h * 64 + 4 * cgx); }
                const f32x4 a4 = *(const LAS f32x4*)(ac + 4 * rr), d4 = *(const LAS f32x4*)(dv + 4 * rr);
                float sc[4];
#pragma unroll
                for (int q = 0; q < 4; ++q) sc[q] = d4[q] * __expf(aend - a4[q]);
                const f32x4 w0 = *(const f32x4*)wp, w1 = *(const f32x4*)(wp + 1024), w2 = *(const f32x4*)(wp + 2048), w3 = *(const f32x4*)(wp + 3072), bb = *(const f32x4*)bp;
#pragma unroll
                for (int ch = 0; ch < 4; ++ch) { float rv[7];
#pragma unroll
                    for (int j = 0; j < 7; ++j) rv[j] = (ch & 1) ? bfhi(raw[j][ch >> 1]) : bflo(raw[j][ch >> 1]);
                    float xv[4];
#pragma unroll
                    for (int q = 0; q < 4; ++q) xv[q] = siluf(bb[ch] + w0[ch] * rv[q] + w1[ch] * rv[q + 1] + w2[ch] * rv[q + 2] + w3[ch] * rv[q + 3]);
                    *(LAS u32x2*)(L + S_XT + ((4 * cgx + ch) * SP + 4 * rr) * 2) = (u32x2){pk2(xv[0], xv[1]), pk2(xv[2], xv[3])};
                    *(LAS u32x2*)(L + S_XS + ((4 * cgx + ch) * SP + 4 * rr) * 2) = (u32x2){pk2(xv[0] * sc[0], xv[1] * sc[1]), pk2(xv[2] * sc[2], xv[3] * sc[3])}; }
            }
            const float dskh = A.in[9][h];
#pragma unroll
            for (int j = 0; j < 2; ++j) { const int s0 = 64 * nh + 32 * j;
                if (s0 <= 32 * mt + 31) {
                    const int t = 32 * mt + r; const float at = ac[t];
#pragma unroll
                    for (int q = 0; q < 4; ++q) { const int sb = s0 + 8 * q + 4 * hh;
                        const f32x4 a4 = *(const LAS f32x4*)(ac + sb), d4 = *(const LAS f32x4*)(dv + sb);
                        float v[4];
#pragma unroll
                        for (int e = 0; e < 4; ++e) { const int sI = sb + e; v[e] = (sI <= t) ? cb[j][4 * q + e] * __expf(at - a4[e]) * d4[e] : 0.f;
                            if (sI == t) v[e] += dskh; }
                        *(LAS u32x2*)(L + S_BS + (t * SP + sb) * 2) = (u32x2){pk2(v[0], v[1]), pk2(v[2], v[3])}; }
                } }
            __syncthreads();
            {
                const int nt = w & 1;
                f32x16 yd = {0.f, 0.f, 0.f, 0.f, 0.f, 0.f, 0.f, 0.f, 0.f, 0.f, 0.f, 0.f, 0.f, 0.f, 0.f, 0.f}, cs = yd;
                for (int ks = 0; ks < 2 * (mt + 1); ++ks) yd = __builtin_amdgcn_mfma_f32_32x32x16_bf16(lds_frag(L + S_XT, 32 * nt + r, 16 * ks + 8 * hh), lds_frag(L + S_BS, 32 * mt + r, 16 * ks + 8 * hh), yd, 0, 0, 0);
                const int mp = w >> 2, nn = w & 3;
#pragma unroll
                for (int ks = 0; ks < 8; ++ks) cs = __builtin_amdgcn_mfma_f32_32x32x16_bf16(lds_frag(L + S_BT, 32 * nn + r, 16 * ks + 8 * hh), lds_frag(L + S_XS, 32 * mp + r, 16 * ks + 8 * hh), cs, 0, 0, 0);
                bf16* yp = YD + (rowbase + 32 * mt + r) * 512 + h * 64 + 32 * nt + 4 * hh;
                bf16* csp = CS + ((size_t)((b * 32 + c) * 8 + h) * 64 + 32 * mp + r) * 128 + 32 * nn + 4 * hh;
#pragma unroll
                for (int q = 0; q < 4; ++q) { *(u32x2*)(yp + 8 * q) = (u32x2){pk2(yd[4 * q], yd[4 * q + 1]), pk2(yd[4 * q + 2], yd[4 * q + 3])};
                                              *(u32x2*)(csp + 8 * q) = (u32x2){pk2(cs[4 * q], cs[4 * q + 1]), pk2(cs[4 * q + 2], cs[4 * q + 3])}; }
            }
            __syncthreads();
        }
    }
}
__device__ __forceinline__ void p_ssd2(Frame& F) {
    const bf16* CS = (const bf16*)(F.ws + WS_XB); bf16* SI = (bf16*)(F.ws + WS_XB + 64 * MiB); const float* AC = (const float*)(F.ws + WS_AC);
    LAS float* decs = (LAS float*)F.lds;
    for (int st = F.bid; st < 256; st += F.G) {
        const int b = st >> 4, h = (st >> 1) & 7, ph = st & 1;
        const int e0 = F.tid * 8, p = 32 * ph + (e0 >> 7), n = e0 & 127;
        __syncthreads();
        if (F.tid < 32) decs[F.tid] = __expf(AC[((size_t)b * SEQ + F.tid * 128 + 127) * 8 + h]);
        float stt[8] = {0.f, 0.f, 0.f, 0.f, 0.f, 0.f, 0.f, 0.f};
        const size_t off0 = ((size_t)(b * 32 * 8 + h) * 64 + p) * 128 + n, cstep = (size_t)8 * 64 * 128;
        u32x4 ring[4];
#pragma unroll
        for (int k = 0; k < 4; ++k) ring[k] = *(const u32x4*)(CS + off0 + (size_t)k * cstep);
        __syncthreads();
#pragma unroll 1
        for (int c4 = 0; c4 < 32; c4 += 4) {
#pragma unroll
            for (int k = 0; k < 4; ++k) { const int c = c4 + k;
                const u32x4 cur = ring[k];
                if (c + 4 < 32) ring[k] = *(const u32x4*)(CS + off0 + (size_t)(c + 4) * cstep);
                *(u32x4*)(SI + off0 + (size_t)c * cstep) = (u32x4){pk2(stt[0], stt[1]), pk2(stt[2], stt[3]), pk2(stt[4], stt[5]), pk2(stt[6], stt[7])};
                const float dec = decs[c];
                stt[0] = stt[0] * dec + bflo(cur.x); stt[1] = stt[1] * dec + bfhi(cur.x); stt[2] = stt[2] * dec + bflo(cur.y); stt[3] = stt[3] * dec + bfhi(cur.y);
                stt[4] = stt[4] * dec + bflo(cur.z); stt[5] = stt[5] * dec + bfhi(cur.z); stt[6] = stt[6] * dec + bflo(cur.w); stt[7] = stt[7] * dec + bfhi(cur.w); }
        }
    }
}
__device__ __forceinline__ void p_ssd3(Frame& F) {
    bf16* U = (bf16*)(F.ws + WS_U); const bf16* YD = (const bf16*)(F.ws + WS_HB); const bf16* SI = (const bf16*)(F.ws + WS_XB + 64 * MiB); const bf16* CC = (const bf16*)(F.ws + WS_CC); const float* AC = (const float*)(F.ws + WS_AC);
    const int w = F.wave;
    for (int unit = F.bid; unit < 2048; unit += F.G) {
        int lane = F.lane; asm volatile("" : "+v"(lane));
        const int b = unit >> 7, c = (unit >> 2) & 31, hp = unit & 3;
        const int h = 2 * hp + (w >> 2), g = h >> 2, tt = w & 3, r = lane & 31, hh = lane >> 5;
        const size_t row = (size_t)b * SEQ + (size_t)c * 128 + 32 * tt + r;
        const bf16* sp = SI + ((size_t)((b * 32 + c) * 8 + h) * 64 + r) * 128 + 8 * hh;
        const bf16* cp = CC + ((size_t)((b * 32 + c) * 2 + g) * 128 + 32 * tt + r) * 128 + 8 * hh;
        bf16x8 s0[8], s1[8], cf[8];
#pragma unroll
        for (int ks = 0; ks < 8; ++ks) { s0[ks] = *(const bf16x8*)(sp + 16 * ks); s1[ks] = *(const bf16x8*)(sp + 32 * 128 + 16 * ks); cf[ks] = *(const bf16x8*)(cp + 16 * ks); }
        const float ea = __expf(AC[row * 8 + h]);
        const bf16* yp = YD + row * 512 + h * 64 + 4 * hh; bf16* zp = U + row * LDE + EZ + h * 64 + 4 * hh;
        u32x2 yv[8], zv[8];
#pragma unroll
        for (int k = 0; k < 8; ++k) { yv[k] = *(const u32x2*)(yp + 32 * (k >> 2) + 8 * (k & 3)); zv[k] = *(const u32x2*)(zp + 32 * (k >> 2) + 8 * (k & 3)); }
        f32x16 a0 = {0.f, 0.f, 0.f, 0.f, 0.f, 0.f, 0.f, 0.f, 0.f, 0.f, 0.f, 0.f, 0.f, 0.f, 0.f, 0.f}, a1 = a0;
#pragma unroll
        for (int ks = 0; ks < 8; ++ks) { a0 = __builtin_amdgcn_mfma_f32_32x32x16_bf16(s0[ks], cf[ks], a0, 0, 0, 0); a1 = __builtin_amdgcn_mfma_f32_32x32x16_bf16(s1[ks], cf[ks], a1, 0, 0, 0); }
#pragma unroll
        for (int k = 0; k < 8; ++k) { const int q = k & 3;
            const float o0 = (k < 4 ? a0[4 * q] : a1[4 * q]), o1 = (k < 4 ? a0[4 * q + 1] : a1[4 * q + 1]), o2 = (k < 4 ? a0[4 * q + 2] : a1[4 * q + 2]), o3 = (k < 4 ? a0[4 * q + 3] : a1[4 * q + 3]);
            const float y0 = bflo(yv[k].x) + ea * o0, y1 = bfhi(yv[k].x) + ea * o1, y2 = bflo(yv[k].y) + ea * o2, y3 = bfhi(yv[k].y) + ea * o3;
            const float z0 = bflo(zv[k].x), z1 = bfhi(zv[k].x), z2 = bflo(zv[k].y), z3 = bfhi(zv[k].y);
            *(u32x2*)(zp + 32 * (k >> 2) + 8 * q) = (u32x2){pk2(y0 * siluf(z0), y1 * siluf(z1)), pk2(y2 * siluf(z2), y3 * siluf(z3))}; }
    }
}

typedef short s16x4 __attribute__((ext_vector_type(4)));
__device__ __forceinline__ s16x4 lds_tr16(LAS unsigned char* p) { return __builtin_bit_cast(s16x4, __builtin_amdgcn_ds_read_tr16_b64_v4i16((LAS s16x4*)p)); }
__device__ __forceinline__ int t5_bucket_dev(int d) {
    if (d < 16) return d;
    const int v = 16 + (int)(log((double)d / 16.0) / log(8.0) * 16.0);
    return v < 31 ? v : 31;
}
constexpr int D_QSL = 16896, D_QH = 8704, D_SEL = 135168, D_LUT = 139264, D_DMY = 143360, VP = 72;
__device__ __forceinline__ int key16(float f) { const int iv = __builtin_bit_cast(int, f); const unsigned u = (unsigned)iv ^ ((unsigned)(iv >> 31) | 0x80000000u); return (int)(u >> 16); }
__device__ __forceinline__ unsigned long long mask_ge(int v, int x) { unsigned long long m; asm("v_cmp_ge_i32_e64 %0, %1, %2" : "=s"(m) : "v"(v), "s"(x)); return m; }
__device__ __forceinline__ unsigned long long mask_gt(int v, int x) { unsigned long long m; asm("v_cmp_gt_i32_e64 %0, %1, %2" : "=s"(m) : "v"(v), "s"(x)); return m; }
__device__ __forceinline__ int count_ge8(int a0, int a1, int a2, int a3, int a4, int a5, int a6, int a7, int x) {
    unsigned long long m0, m1, m2, m3, m4, m5, m6, m7;
    asm("v_cmp_ge_i32_e64 %0, %8, %16\n\tv_cmp_ge_i32_e64 %1, %9, %16\n\tv_cmp_ge_i32_e64 %2, %10, %16\n\tv_cmp_ge_i32_e64 %3, %11, %16\n\t"
        "v_cmp_ge_i32_e64 %4, %12, %16\n\tv_cmp_ge_i32_e64 %5, %13, %16\n\tv_cmp_ge_i32_e64 %6, %14, %16\n\tv_cmp_ge_i32_e64 %7, %15, %16"
        : "=&s"(m0), "=&s"(m1), "=&s"(m2), "=&s"(m3), "=&s"(m4), "=&s"(m5), "=&s"(m6), "=&s"(m7)
        : "v"(a0), "v"(a1), "v"(a2), "v"(a3), "v"(a4), "v"(a5), "v"(a6), "v"(a7), "s"(x));
    return (__popcll(m0) + __popcll(m1)) + (__popcll(m2) + __popcll(m3)) + ((__popcll(m4) + __popcll(m5)) + (__popcll(m6) + __popcll(m7)));
}
__device__ __forceinline__ void masks_ge8(int a0, int a1, int a2, int a3, int a4, int a5, int a6, int a7, int x, unsigned long long (&m)[8]) {
    asm("v_cmp_ge_i32_e64 %0, %8, %16\n\tv_cmp_ge_i32_e64 %1, %9, %16\n\tv_cmp_ge_i32_e64 %2, %10, %16\n\tv_cmp_ge_i32_e64 %3, %11, %16\n\t"
        "v_cmp_ge_i32_e64 %4, %12, %16\n\tv_cmp_ge_i32_e64 %5, %13, %16\n\tv_cmp_ge_i32_e64 %6, %14, %16\n\tv_cmp_ge_i32_e64 %7, %15, %16"
        : "=&s"(m[0]), "=&s"(m[1]), "=&s"(m[2]), "=&s"(m[3]), "=&s"(m[4]), "=&s"(m[5]), "=&s"(m[6]), "=&s"(m[7])
        : "v"(a0), "v"(a1), "v"(a2), "v"(a3), "v"(a4), "v"(a5), "v"(a6), "v"(a7), "s"(x));
}
__device__ __forceinline__ void masks_eq8(int a0, int a1, int a2, int a3, int a4, int a5, int a6, int a7, int x, unsigned long long (&m)[8]) {
    asm("v_cmp_eq_i32_e64 %0, %8, %16\n\tv_cmp_eq_i32_e64 %1, %9, %16\n\tv_cmp_eq_i32_e64 %2, %10, %16\n\tv_cmp_eq_i32_e64 %3, %11, %16\n\t"
        "v_cmp_eq_i32_e64 %4, %12, %16\n\tv_cmp_eq_i32_e64 %5, %13, %16\n\tv_cmp_eq_i32_e64 %6, %14, %16\n\tv_cmp_eq_i32_e64 %7, %15, %16"
        : "=&s"(m[0]), "=&s"(m[1]), "=&s"(m[2]), "=&s"(m[3]), "=&s"(m[4]), "=&s"(m[5]), "=&s"(m[6]), "=&s"(m[7])
        : "v"(a0), "v"(a1), "v"(a2), "v"(a3), "v"(a4), "v"(a5), "v"(a6), "v"(a7), "s"(x));
}
__device__ __forceinline__ int sel_mask(int a, int b, unsigned long long m) { int r; asm("v_cndmask_b32_e64 %0, %1, %2, %3" : "=v"(r) : "v"(a), "v"(b), "s"(m)); return r; }
__device__ __forceinline__ float xor1(float v) { return __builtin_bit_cast(float, __builtin_amdgcn_update_dpp(0, __builtin_bit_cast(int, v), 0xB1, 0xF, 0xF, false)); }
__device__ __forceinline__ float xor2(float v) { return __builtin_bit_cast(float, __builtin_amdgcn_update_dpp(0, __builtin_bit_cast(int, v), 0x4E, 0xF, 0xF, false)); }
typedef __bf16 bf16v2 __attribute__((ext_vector_type(2)));
__device__ __forceinline__ float dot2ones(unsigned pk, float acc) { return __builtin_amdgcn_fdot2_f32_bf16(__builtin_bit_cast(bf16v2, pk), __builtin_bit_cast(bf16v2, 0x3f803f80u), acc, false); }
__device__ __forceinline__ int okey(float f) { const int iv = __builtin_bit_cast(int, f); return iv ^ ((iv >> 31) & 0x7fffffff); }

struct MoeConv { const float* src; unsigned char* dst; int pitch; int gk; bool on; };
__device__ __forceinline__ MoeConv moe_conv_issue(const Args& A, unsigned char* ws, int id, int lane, float (&v)[32]) {
    MoeConv c; c.on = id < 64 * 768; c.src = nullptr; c.dst = nullptr; c.pitch = 0; c.gk = -1;
    if (c.on) {
        const int le = id / 768, r = id % 768;
        int K, k0, n; const float* W; unsigned char* WT;
        if (r < 512) { const int half = r >> 8, q = r & 255, kb = q >> 3, nb = q & 7; K = 1024; c.pitch = 512; k0 = 32 * kb; n = 64 * nb + lane; c.gk = (le >> 5) * DM + k0;
            W = (half ? A.in[29] : A.in[28]) + (size_t)le * 1024 * 512; WT = ws + WS_WGU + (size_t)le * 1024 * 1024 + (size_t)(256 * (n >> 7) + 128 * half + (n & 127)) * K + k0; }
        else { const int q = r - 512, kb = q >> 4, nb = q & 15; K = 512; c.pitch = 1024; k0 = 32 * kb; n = 64 * nb + lane;
            W = A.in[30] + (size_t)le * 512 * 1024; WT = ws + WS_WD + (size_t)le * 1024 * 512 + (size_t)n * K + k0; }
        c.src = W + (size_t)k0 * c.pitch + n; c.dst = WT;
#pragma unroll
        for (int kk = 0; kk < 32; ++kk) v[kk] = c.src[(size_t)kk * c.pitch];
    }
    return c;
}
__device__ __forceinline__ void moe_conv_finish(const Args& A, const MoeConv& c, const float (&v)[32]) {
    if (c.on) {
        const int gk = __builtin_amdgcn_readfirstlane(c.gk);
        if (gk >= 0) { const float* g = A.in[3] + gk;
#pragma unroll
            for (int q = 0; q < 2; ++q) { u32x4 o;
#pragma unroll
                for (int e = 0; e < 4; ++e) { const int k = 16 * q + 4 * e; o[e] = pk4_fp8(v[k] * g[k] * F8_SW, v[k + 1] * g[k + 1] * F8_SW, v[k + 2] * g[k + 2] * F8_SW, v[k + 3] * g[k + 3] * F8_SW); }
                *(u32x4*)(c.dst + 16 * q) = o; }
        } else {
#pragma unroll
            for (int q = 0; q < 2; ++q) { u32x4 o;
#pragma unroll
                for (int e = 0; e < 4; ++e) { const int k = 16 * q + 4 * e; o[e] = pk4_fp8(v[k] * F8_SW, v[k + 1] * F8_SW, v[k + 2] * F8_SW, v[k + 3] * F8_SW); }
                *(u32x4*)(c.dst + 16 * q) = o; }
        }
    }
}
__device__ __forceinline__ void p_dsa(Frame& F, const Args& A) {
    bf16* U = (bf16*)(F.ws + WS_U); bf16* HB = (bf16*)(F.ws + WS_HB);
    const int w = F.wave;
    const float* ng = A.in[10];
    LAS unsigned char* L = F.lds;
    LAS float* LUT = (LAS float*)(L + D_LUT);
    for (int i = F.tid; i < 1024; i += NTHR) LUT[i] = A.in[1][t5_bucket_dev(i >> 3) * 8 + (i & 7)] * 1.44269504f;
    __syncthreads();
    for (int blk = F.bid; blk < MTOK / 8; blk += F.G) {
        int lane = F.lane; asm volatile("" : "+v"(lane));
        const int kr = blk >> 8, cc = blk & 255, b = kr >> 1, tb = (kr & 1) ? 511 - cc : cc, t0 = tb * 8;
        const size_t bat = (size_t)b * SEQ, rowb = bat + t0;
        {
            LAS u32x4* hz = (LAS u32x4*)(L + (F.tid >> 6) * D_QSL + D_QH) + (F.tid & 63) * 8;
#pragma unroll
            for (int i = 0; i < 8; ++i) hz[i] = (u32x4){0u, 0u, 0u, 0u};
            const int njz = (t0 + 8 + 63) >> 6, c4lo = (njz - 1) >> 2, c4hi = 4 * ((njz + 15) >> 4);
            LAS u32x2* kz = (LAS u32x2*)(L + (F.tid >> 6) * D_QSL + (F.tid & 63) * 136);
            for (int c4 = c4lo; c4 < c4hi; ++c4) kz[c4] = (u32x2){0u, 0u};
        }
        __syncthreads();
        float cvv[32]; const MoeConv cvi = moe_conv_issue(A, F.ws, blk * NWAVES + w, lane, cvv);
        const u32x4 zrow = *(const u32x4*)(U + (rowb + w) * LDE + EZ + 8 * lane);
        u32x4 qraw[2];
#pragma unroll
        for (int ks = 0; ks < 2; ++ks) { qraw[ks] = (u32x4){0u, 0u, 0u, 0u}; if ((lane & 15) < 8) qraw[ks] = *(const u32x4*)(U + (rowb + w) * LDE + EQ + (lane & 15) * 64 + 16 * (lane >> 4) + 8 * ks); }
        {
            typedef long i64x2 __attribute__((ext_vector_type(2)));
            const int r = lane & 31, hh = lane >> 5;
            const unsigned char* Q8 = F.ws + WS_IQK8;
            i64x2 qa[2];
            { const i64x2* qp = (const i64x2*)(Q8 + (rowb + (r >> 2)) * 320 + (r & 3) * 64 + 32 * hh); qa[0] = qp[0]; qa[1] = qp[1]; }
            float wv[4][4];
#pragma unroll
            for (int q = 0; q < 4; ++q) { const u32x2 ww = *(const u32x2*)(U + (rowb + 2 * q + hh) * LDE + EIW); wv[q][0] = bflo(ww.x); wv[q][1] = bfhi(ww.x); wv[q][2] = bflo(ww.y); wv[q][3] = bfhi(ww.y); }
            const int ntile = (t0 + 8 + 31) >> 5;
            for (int tb = w; tb < ntile; tb += 8 * NWAVES) {
                i64x2 kf[8][2];
#pragma unroll
                for (int u8 = 0; u8 < 8; ++u8) { const int tl = tb + 8 * u8 < 128 ? tb + 8 * u8 : 127; const int key = 32 * tl + r;
                    const i64x2* kp = (const i64x2*)(Q8 + (bat + key) * 320 + 256 + 32 * hh); kf[u8][0] = kp[0]; kf[u8][1] = kp[1]; }
#pragma unroll
                for (int u8 = 0; u8 < 8; ++u8) {
                    const int tile = tb + 8 * u8;
                    f32x16 acc = {0.f, 0.f, 0.f, 0.f, 0.f, 0.f, 0.f, 0.f, 0.f, 0.f, 0.f, 0.f, 0.f, 0.f, 0.f, 0.f};
                    acc = __builtin_amdgcn_mfma_f32_32x32x16_fp8_fp8(qa[0].x, kf[u8][0].x, acc, 0, 0, 0);
                    acc = __builtin_amdgcn_mfma_f32_32x32x16_fp8_fp8(qa[0].y, kf[u8][0].y, acc, 0, 0, 0);
                    acc = __builtin_amdgcn_mfma_f32_32x32x16_fp8_fp8(qa[1].x, kf[u8][1].x, acc, 0, 0, 0);
                    acc = __builtin_amdgcn_mfma_f32_32x32x16_fp8_fp8(qa[1].y, kf[u8][1].y, acc, 0, 0, 0);
                    if (tile < ntile) {
#pragma unroll
                        for (int q = 0; q < 4; ++q) {
                            const float sc = wv[q][0] * fmaxf(acc[4 * q], 0.f) + wv[q][1] * fmaxf(acc[4 * q + 1], 0.f) + wv[q][2] * fmaxf(acc[4 * q + 2], 0.f) + wv[q][3] * fmaxf(acc[4 * q + 3], 0.f);
                            const int tq = 2 * q + hh, key = 32 * tile + r, k16 = key16(sc + 0.f);
                            const bool live = key <= t0 + tq;
                            *(LAS unsigned short*)(L + tq * D_QSL + (key & 63) * 136 + (key >> 6) * 2) = (unsigned short)(live ? k16 : 0);
                            if (live) __hip_atomic_fetch_add((LAS unsigned*)(L + tq * D_QSL + D_QH) + (k16 >> 5), (unsigned)(((k16 >> 4) & 1) * 0xffff + 1), __ATOMIC_RELAXED, __HIP_MEMORY_SCOPE_WORKGROUP);
                        }
                    }
                }
            }
        }
        {
            const size_t row = rowb + w;
            const u32x4 v = zrow;
            float f[8] = {bflo(v.x), bfhi(v.x), bflo(v.y), bfhi(v.y), bflo(v.z), bfhi(v.z), bflo(v.w), bfhi(v.w)};
            float s = 0.f;
#pragma unroll
            for (int j = 0; j < 8; ++j) s += f[j] * f[j];
#pragma unroll
            for (int o = 1; o < 32; o <<= 1) s += __shfl_xor(s, o);
            const float rs = 1.f / sqrtf(s * (1.f / 256.f) + NORM_EPS); const float* g = ng + 8 * lane;
            const float r8 = rs * F8_SX;
            *(u32x2*)((unsigned char*)HB + row * DM + 8 * lane) = (u32x2){pk4_fp8(f[0] * r8 * g[0], f[1] * r8 * g[1], f[2] * r8 * g[2], f[3] * r8 * g[3]), pk4_fp8(f[4] * r8 * g[4], f[5] * r8 * g[5], f[6] * r8 * g[6], f[7] * r8 * g[7])};
        }
        __syncthreads();
        const int t = t0 + w, n = t + 1;
        LAS unsigned short* sel = (LAS unsigned short*)(L + D_SEL) + w * 256;
        const int cnt = n < 256 ? n : 256;
        if (n <= 256) {
#pragma unroll
            for (int i = 0; i < 4; ++i) { const int s = lane + 64 * i; sel[s] = (unsigned short)(s < n ? s : 0); }
        } else {
            const int nj = (t0 + 8 + 63) >> 6;
            const LAS unsigned char* myrow = L + w * D_QSL + lane * 136;
            int v[64];
#pragma unroll
            for (int jb = 0; jb < 4; ++jb) {
                if (16 * jb < nj) {
#pragma unroll
                    for (int g4q = 0; g4q < 4; ++g4q) { const u32x2 kk = *(const LAS u32x2*)(myrow + 32 * jb + 8 * g4q);
                        const int j0 = 16 * jb + 4 * g4q;
                        v[j0] = (int)(kk.x & 0xffffu); v[j0 + 1] = (int)(kk.x >> 16); v[j0 + 2] = (int)(kk.y & 0xffffu); v[j0 + 3] = (int)(kk.y >> 16); }
                } else {
#pragma unroll
                    for (int jj = 0; jj < 16; ++jj) v[16 * jb + jj] = -1;
                }
            }
            int bstar, ca, cb;
            {
                const LAS u32x4* hw = (const LAS u32x4*)(L + w * D_QSL + D_QH) + lane * 8;
                unsigned hv[32];
#pragma unroll
                for (int i = 0; i < 8; ++i) { const u32x4 x = hw[i]; hv[4 * i] = x.x; hv[4 * i + 1] = x.y; hv[4 * i + 2] = x.z; hv[4 * i + 3] = x.w; }
                unsigned ssum = 0u;
#pragma unroll
                for (int k = 0; k < 32; ++k) ssum += hv[k];
                const int sum = (int)(ssum & 0xffffu) + (int)(ssum >> 16);
                int suf = sum;
#pragma unroll
                for (int o = 1; o < 64; o <<= 1) { const int x = __shfl_down(suf, o); if (lane + o < 64) suf += x; }
                const int above = suf - sum;
                const unsigned long long bm = __ballot(above < 256 && suf >= 256);
                const int Ls = __builtin_amdgcn_readfirstlane((int)__builtin_ctzll(bm | 0x8000000000000000ull));
                const int aboveLs = __builtin_amdgcn_readlane(above, Ls);
                const unsigned hwv = ((const LAS unsigned*)(L + w * D_QSL + D_QH))[Ls * 32 + (lane & 31)];
                const int cw = (int)(hwv >> 16) + (int)(hwv & 0xffffu);
                int sfx = cw;
#pragma unroll
                for (int o = 1; o < 32; o <<= 1) { const int x = __shfl_down(sfx, o); if ((lane & 31) + o < 32) sfx += x; }
                const int rb = aboveLs + sfx - cw;
                const unsigned long long hb = __ballot(rb < 256 && rb + cw >= 256);
                const int wsel = __builtin_amdgcn_readfirstlane((int)__builtin_ctzll(hb | 0x8000000000000000ull)) & 31;
                const int wrun = __builtin_amdgcn_readlane(rb, wsel); const unsigned wval = (unsigned)__builtin_amdgcn_readlane((int)hwv, wsel);
                const int c1 = (int)(wval >> 16), c0 = (int)(wval & 0xffffu);
                const bool inhi = wrun + c1 >= 256;
                bstar = 64 * Ls + 2 * wsel + (inhi ? 1 : 0); ca = inhi ? wrun : wrun + c1; cb = inhi ? c1 : c0;
            }
            int lo = bstar * 16, hi = lo + 15, clo = ca + cb, chi = ca, it = 0;
            while (lo < hi) {
                const int span = hi - lo;
                int step = (it & 1) ? ((span + 1) >> 1) : (int)((float)(span + 1) * (((float)(clo - 256) + 0.5f) / (float)(clo - chi)));
                step = step < 1 ? 1 : (step > span ? span : step);
                const int mid = lo + step;
                int c = 0;
#pragma unroll
                for (int jb = 0; jb < 4; ++jb) if (16 * jb < nj) {
#pragma unroll
                    for (int jj = 0; jj < 16; jj += 8) { const int j0 = 16 * jb + jj; c += count_ge8(v[j0], v[j0 + 1], v[j0 + 2], v[j0 + 3], v[j0 + 4], v[j0 + 5], v[j0 + 6], v[j0 + 7], mid); } }
                ++it;
                if (c == 256) { lo = mid; clo = 256; break; }
                if (c > 256) { lo = mid; clo = c; } else { hi = mid - 1; chi = c; }
            }
            const int T = lo;
            LAS unsigned short* dummy = (LAS unsigned short*)(L + D_DMY) + w * 64 + lane;
            const bool all_ge = clo == 256;
            const int Tg = all_ge ? T : T + 1;
            {
                int obase = 0;
#pragma unroll
                for (int jb = 0; jb < 4; ++jb) if (16 * jb < nj) {
#pragma unroll
                    for (int jj = 0; jj < 16; jj += 8) { const int j0 = 16 * jb + jj; unsigned long long m[8];
                        masks_ge8(v[j0], v[j0 + 1], v[j0 + 2], v[j0 + 3], v[j0 + 4], v[j0 + 5], v[j0 + 6], v[j0 + 7], Tg, m);
#pragma unroll
                        for (int e = 0; e < 8; ++e) {
                            const int pos = (int)__builtin_amdgcn_mbcnt_hi((unsigned)(m[e] >> 32), __builtin_amdgcn_mbcnt_lo((unsigned)m[e], (unsigned)obase));
                            LAS unsigned short* dst = (LAS unsigned short*)(unsigned)sel_mask((int)(unsigned)(__SIZE_TYPE__)dummy, (int)(unsigned)(__SIZE_TYPE__)(sel + pos), m[e]);
                            *dst = (unsigned short)(lane + 64 * (j0 + e));
                            obase += __popcll(m[e]); } } }
            }
            if (!all_ge) {
                const int need_eq = 256 - chi; int ebase = 0;
#pragma unroll
                for (int jb = 0; jb < 4; ++jb) if (16 * jb < nj && ebase < need_eq) {
#pragma unroll
                    for (int jj = 0; jj < 16; jj += 8) { const int j0 = 16 * jb + jj; unsigned long long m[8];
                        masks_eq8(v[j0], v[j0 + 1], v[j0 + 2], v[j0 + 3], v[j0 + 4], v[j0 + 5], v[j0 + 6], v[j0 + 7], T, m);
#pragma unroll
                        for (int e = 0; e < 8; ++e) {
                            const int erank = (int)__builtin_amdgcn_mbcnt_hi((unsigned)(m[e] >> 32), __builtin_amdgcn_mbcnt_lo((unsigned)m[e], (unsigned)ebase));
                            LAS unsigned short* cand = (LAS unsigned short*)(unsigned)sel_mask((int)(unsigned)(__SIZE_TYPE__)dummy, (int)(unsigned)(__SIZE_TYPE__)(sel + chi + erank), m[e]);
                            LAS unsigned short* dst = erank < need_eq ? cand : dummy;
                            *dst = (unsigned short)(lane + 64 * (j0 + e));
                            ebase += __popcll(m[e]); } } }
            }
        }
        {
            const int hd = lane & 15, g4 = lane >> 4;
            const size_t row = rowb + w;
            long qb[2];
            {
                float qf[2][8]; float ss = 0.f;
#pragma unroll
                for (int ks = 0; ks < 2; ++ks) { const u32x4 qq = qraw[ks];
                    qf[ks][0] = bflo(qq.x); qf[ks][1] = bfhi(qq.x); qf[ks][2] = bflo(qq.y); qf[ks][3] = bfhi(qq.y); qf[ks][4] = bflo(qq.z); qf[ks][5] = bfhi(qq.z); qf[ks][6] = bflo(qq.w); qf[ks][7] = bfhi(qq.w);
#pragma unroll
                    for (int j = 0; j < 8; ++j) ss += qf[ks][j] * qf[ks][j]; }
                ss += __shfl_xor(ss, 16); ss += __shfl_xor(ss, 32);
                const float rs = (0.125f * 1.44269504f) / sqrtf(ss * (1.f / 64.f) + NORM_EPS);
#pragma unroll
                for (int ks = 0; ks < 2; ++ks) { const float* gq = A.in[11] + 16 * g4 + 8 * ks; const float r32 = rs * 32.f;
                    const u32x2 pk = (u32x2){pk4_fp8(qf[ks][0] * r32 * gq[0], qf[ks][1] * r32 * gq[1], qf[ks][2] * r32 * gq[2], qf[ks][3] * r32 * gq[3]),
                                             pk4_fp8(qf[ks][4] * r32 * gq[4], qf[ks][5] * r32 * gq[5], qf[ks][6] * r32 * gq[6], qf[ks][7] * r32 * gq[7])};
                    qb[ks] = __builtin_bit_cast(long, pk); }
            }
            float lg[16][4]; float mx = -3.0e38f;
            const int vsl = lane >> 3, vpart = lane & 7;
            u32x4 vr[2][8];
#define DSA_QK_BODY(FULL_) do { \
_Pragma("unroll") \
            for (int hb = 0; hb < 2; ++hb) { \
                typedef long i64x2 __attribute__((ext_vector_type(2))); \
                i64x2 ka[8]; \
_Pragma("unroll") \
                for (int T8 = 0; T8 < 8; ++T8) { const int sm = sel[16 * (8 * hb + T8) + hd]; ka[T8] = *(const i64x2*)(F.ws + WS_K8 + (bat + sm) * 64 + 16 * g4); } \
_Pragma("unroll") \
                for (int e = 0; e < 8; ++e) { const int sm = sel[64 * hb + 8 * e + vsl]; vr[hb][e] = *(const u32x4*)(U + (bat + sm) * LDE + EV + 8 * vpart); } \
_Pragma("unroll") \
                for (int T8 = 0; T8 < 8; ++T8) { const int T = 8 * hb + T8; \
                    f32x4 acc = {0.f, 0.f, 0.f, 0.f}; \
                    acc = __builtin_amdgcn_mfma_f32_16x16x32_fp8_fp8(ka[T8].x, qb[0], acc, 0, 0, 0); \
                    acc = __builtin_amdgcn_mfma_f32_16x16x32_fp8_fp8(ka[T8].y, qb[1], acc, 0, 0, 0); \
                    const u32x2 sl = *(const LAS u32x2*)(sel + 16 * T + 4 * g4); \
                    const int s4[4] = {(int)(sl.x & 0xffffu), (int)(sl.x >> 16), (int)(sl.y & 0xffffu), (int)(sl.y >> 16)}; \
_Pragma("unroll") \
                    for (int i = 0; i < 4; ++i) { int dist = t - s4[i]; dist = dist < 0 ? 0 : (dist > 127 ? 127 : dist); \
                        const float bia = LUT[dist * 8 + (hd & 7)]; \
                        lg[T][i] = ((FULL_) || (16 * T + 4 * g4 + i) < cnt) ? acc[i] * (1.f / 256.f) + bia : -3.0e38f; mx = fmaxf(mx, lg[T][i]); } \
                } \
            } \
            } while (0)
            if (cnt == 256) DSA_QK_BODY(true); else DSA_QK_BODY(false);
#undef DSA_QK_BODY
            mx = fmaxf(mx, __shfl_xor(mx, 16)); mx = fmaxf(mx, __shfl_xor(mx, 32));
            float sum = 0.f;
#pragma unroll
            for (int T = 0; T < 16; ++T) {
#pragma unroll
                for (int i = 0; i < 4; ++i) { const float p = __builtin_amdgcn_exp2f(lg[T][i] - mx); lg[T][i] = p; sum += p; }
                if ((T & 3) == 3) __builtin_amdgcn_sched_barrier(0); }
            sum += __shfl_xor(sum, 16); sum += __shfl_xor(sum, 32);
            const float inv = 1.f / fmaxf(sum, 1e-30f);
            f32x4 oacc[4];
#pragma unroll
            for (int dt = 0; dt < 4; ++dt) oacc[dt] = (f32x4){0.f, 0.f, 0.f, 0.f};
            LAS unsigned char* Vl = L + w * D_QSL;
#pragma unroll
            for (int ch = 0; ch < 4; ++ch) {
                LDS_WAIT();
#pragma unroll
                for (int e = 0; e < 8; ++e) *(LAS u32x4*)(Vl + ((8 * e + vsl) * VP + 8 * vpart) * 2) = vr[ch & 1][e];
                if (ch + 2 < 4) {
#pragma unroll
                    for (int e = 0; e < 8; ++e) { const int sm = sel[64 * (ch + 2) + 8 * e + vsl]; vr[ch & 1][e] = *(const u32x4*)(U + (bat + sm) * LDE + EV + 8 * vpart); }
                }
                LDS_WAIT();
#pragma unroll
                for (int kk = 0; kk < 2; ++kk) {
                    const int T0 = 2 * (2 * ch + kk);
                    u32x4 pp; pp.x = pk2(lg[T0][0] * inv, lg[T0][1] * inv); pp.y = pk2(lg[T0][2] * inv, lg[T0][3] * inv); pp.z = pk2(lg[T0 + 1][0] * inv, lg[T0 + 1][1] * inv); pp.w = pk2(lg[T0 + 1][2] * inv, lg[T0 + 1][3] * inv);
                    const bf16x8 pf = __builtin_bit_cast(bf16x8, pp);
                    const int qq = (lane & 15) >> 2, p4 = lane & 3;
#pragma unroll
                    for (int dt = 0; dt < 4; ++dt) {
                        const s16x4 b0 = lds_tr16(Vl + ((32 * kk + 4 * g4 + qq) * VP + 16 * dt + 4 * p4) * 2);
                        const s16x4 b1 = lds_tr16(Vl + ((32 * kk + 16 + 4 * g4 + qq) * VP + 16 * dt + 4 * p4) * 2);
                        bf16x8 bfg; bfg[0] = b0[0]; bfg[1] = b0[1]; bfg[2] = b0[2]; bfg[3] = b0[3]; bfg[4] = b1[0]; bfg[5] = b1[1]; bfg[6] = b1[2]; bfg[7] = b1[3];
                        oacc[dt] = __builtin_amdgcn_mfma_f32_16x16x32_bf16(pf, bfg, oacc[dt], 0, 0, 0);
                    }
                }
            }
            {
                const bool odd = hd & 1;
#pragma unroll
                for (int i = 0; i < 4; i += 2)
#pragma unroll
                    for (int dt = 0; dt < 4; ++dt) { const float a = oacc[dt][i], b = oacc[dt][i + 1]; const float rcv = xor1(odd ? a : b);
                        if (g4 < 2) *(unsigned short*)((unsigned char*)HB + row * DM + 512 + (4 * g4 + i + (odd ? 1 : 0)) * 64 + 16 * dt + (hd & ~1)) = odd ? pk2_fp8(rcv * F8_SX, b * F8_SX) : pk2_fp8(a * F8_SX, rcv * F8_SX); }
            }
        }
        moe_conv_finish(A, cvi, cvv);
        __syncthreads();
    }
}

constexpr int NR_WP = 2064, NR_WOFF = 45056;
template <int MODE> __device__ __forceinline__ void p_norm_route(Frame& F, const bf16* xin, int layer) {
    constexpr int NT = MODE == 0 ? 3 : 2;
    const bf16* WR = MODE == 0 ? (const bf16*)(F.ws + WS_WR) + (size_t)layer * 48 * 1024 : (const bf16*)(F.ws + WS_WGL);
    float* GL = (float*)(F.ws + WS_GL); float* RS = (float*)(F.ws + WS_RS);
    int* list = (int*)(F.ws + WS_LIST); float* wl = (float*)(F.ws + WS_LISTW); float* rl = (float*)(F.ws + WS_LISTR);
    LAS unsigned char* L = F.lds;
    LAS float* lgt = (LAS float*)L + F.wave * (16 * 48);
    LAS int* cntl = (LAS int*)(L + 32768); LAS int* basel = (LAS int*)(L + 33024);
    LAS int* ri_e = (LAS int*)(L + 34816); LAS int* ri_p = (LAS int*)(L + 36864); LAS float* ri_w = (LAS float*)(L + 38912); LAS float* ri_r = (LAS float*)(L + 40960);
    const int w = F.wave;
    for (int i = F.tid; i < NT * 16 * 128; i += NTHR) { const int r = i >> 7, c = i & 127; *(LAS u32x4*)(L + NR_WOFF + r * NR_WP + c * 16) = *(const u32x4*)(WR + (size_t)r * DM + c * 8); }
    for (int base = F.bid * 256; base < MTOK; base += F.G * 256) {
        int lane = F.lane; asm volatile("" : "+v"(lane));
        if (F.tid < 64) cntl[F.tid] = 0;
        __syncthreads();
        const int n16 = lane & 15, g4 = lane >> 4;
        const int R00 = base + w * 32;
        bf16x8 a[16];
        const bf16* ar = xin + (size_t)(R00 + n16) * DM + 8 * g4;
#pragma unroll
        for (int kk = 0; kk < 16; ++kk) a[kk] = *(const bf16x8*)(ar + 32 * kk);
        float mxh[2] = {0.f, 0.f};
#pragma unroll
        for (int half = 0; half < 2; ++half) {
            const int R0 = R00 + half * 16;
            f32x4 acc[NT];
#pragma unroll
            for (int nt = 0; nt < NT; ++nt) acc[nt] = (f32x4){0.f, 0.f, 0.f, 0.f};
            float ss = 0.f; unsigned short __attribute__((ext_vector_type(2))) mpk = {0, 0};
#pragma unroll
            for (int kk = 0; kk < 32; ++kk) {
                const bf16x8 av = a[kk & 15];
                { const int sn = half * 32 + kk + 16; if (sn < 64) a[kk & 15] = *(const bf16x8*)(ar + (size_t)(sn >> 5) * 16 * DM + 32 * (sn & 31)); }
#pragma unroll
                for (int nt = 0; nt < NT; ++nt) { const bf16x8 bb = *(const LAS bf16x8*)(L + NR_WOFF + (16 * nt + n16) * NR_WP + 64 * kk + 16 * g4);
                    acc[nt] = __builtin_amdgcn_mfma_f32_16x16x32_bf16(av, bb, acc[nt], 0, 0, 0); }
                const u32x4 q = __builtin_bit_cast(u32x4, av);
                { const float e0 = bflo(q.x), e1 = bfhi(q.x), e2 = bflo(q.y), e3 = bfhi(q.y), e4 = bflo(q.z), e5 = bfhi(q.z), e6 = bflo(q.w), e7 = bfhi(q.w);
                  ss += ((e0 * e0 + e1 * e1) + (e2 * e2 + e3 * e3)) + ((e4 * e4 + e5 * e5) + (e6 * e6 + e7 * e7));
                  if constexpr (MODE == 1) { typedef unsigned short u16x2 __attribute__((ext_vector_type(2)));
                    mpk = __builtin_elementwise_max(mpk, __builtin_bit_cast(u16x2, q.x & 0x7fff7fffu)); mpk = __builtin_elementwise_max(mpk, __builtin_bit_cast(u16x2, q.y & 0x7fff7fffu));
                    mpk = __builtin_elementwise_max(mpk, __builtin_bit_cast(u16x2, q.z & 0x7fff7fffu)); mpk = __builtin_elementwise_max(mpk, __builtin_bit_cast(u16x2, q.w & 0x7fff7fffu)); } }
                if ((kk & 3) == 3) __builtin_amdgcn_sched_barrier(0);
            }
            ss += __shfl_xor(ss, 16); ss += __shfl_xor(ss, 32);
            const float rsv = 1.f / sqrtf(ss * (1.f / DM) + NORM_EPS);
            float rsr[4];
#pragma unroll
            for (int i = 0; i < 4; ++i) rsr[i] = __shfl(rsv, 4 * g4 + i);
            if constexpr (MODE == 1) {
#pragma unroll
                for (int nt = 0; nt < NT; ++nt)
#pragma unroll
                    for (int i = 0; i < 4; ++i) if (16 * nt + n16 < 24) GL[(size_t)(R0 + 4 * g4 + i) * 24 + 16 * nt + n16] = acc[nt][i] * rsr[i];
                float mxl = bf2f((bf16)(mpk.x > mpk.y ? mpk.x : mpk.y));
                mxl = fmaxf(mxl, __shfl_xor(mxl, 16)); mxl = fmaxf(mxl, __shfl_xor(mxl, 32));
                if (lane < 16) RS[R0 + lane] = (mxl * (1.f / 127.f)) * rsv;
                mxh[half] = mxl;
            } else {
#pragma unroll
            for (int nt = 0; nt < NT; ++nt)
#pragma unroll
                for (int i = 0; i < 4; ++i) lgt[(4 * g4 + i) * 48 + 16 * nt + n16] = acc[nt][i] * rsr[i];
            LDS_WAIT();
            if (lane < 16) {
                const LAS float* lr = lgt + lane * 48;
                int gs = 0; float gm = lr[0];
#pragma unroll
                for (int j = 1; j < 4; ++j) if (lr[j] > gm) { gm = lr[j]; gs = j; }
                float gsum = 0.f;
#pragma unroll
                for (int j = 0; j < 4; ++j) gsum += __expf(lr[j] - gm);
                const float gw = 1.f / gsum;
                const LAS float* er = lr + 4 + 8 * gs;
                int i0 = 0; float m0 = er[0];
#pragma unroll
                for (int j = 1; j < 8; ++j) if (er[j] > m0) { m0 = er[j]; i0 = j; }
                int i1 = -1; float m1 = -3.0e38f;
#pragma unroll
                for (int j = 0; j < 8; ++j) if (j != i0 && er[j] > m1) { m1 = er[j]; i1 = j; }
                const float w0 = 1.f / (1.f + __expf(m1 - m0));
                const int e0 = gs * 8 + i0, e1 = 32 + gs * 8 + i1;
                const int rs = (w * 32 + half * 16 + lane) * 2;
                ri_e[rs] = e0; ri_p[rs] = __hip_atomic_fetch_add(cntl + e0, 1, __ATOMIC_RELAXED, __HIP_MEMORY_SCOPE_WORKGROUP); ri_w[rs] = w0 * gw;
                ri_e[rs + 1] = e1; ri_p[rs + 1] = __hip_atomic_fetch_add(cntl + e1, 1, __ATOMIC_RELAXED, __HIP_MEMORY_SCOPE_WORKGROUP); ri_w[rs + 1] = (1.f - w0) * gw;
                ri_r[rs >> 1] = rsv;
            }
            LDS_WAIT();
            }
        }
        if constexpr (MODE == 1) {
            unsigned char* X8o = F.ws + WS_HB;
#pragma unroll 4
            for (int i = 0; i < 32; ++i) { int ln = F.lane; asm volatile("" : "+v"(ln));
                const float msrc = i < 16 ? mxh[0] : mxh[1];
                const float mi = __builtin_bit_cast(float, __builtin_amdgcn_readlane(__builtin_bit_cast(int, msrc), i & 15)); const float inv = mi > 0.f ? 127.f / mi : 0.f;
                const u32x4* src = (const u32x4*)(xin + (size_t)(R00 + i) * DM) + 2 * ln; const u32x4 p0 = src[0], p1 = src[1];
                u32x4 o; o.x = pk4_i8m(bflo(p0.x) * inv, bfhi(p0.x) * inv, bflo(p0.y) * inv, bfhi(p0.y) * inv); o.y = pk4_i8m(bflo(p0.z) * inv, bfhi(p0.z) * inv, bflo(p0.w) * inv, bfhi(p0.w) * inv);
                o.z = pk4_i8m(bflo(p1.x) * inv, bfhi(p1.x) * inv, bflo(p1.y) * inv, bfhi(p1.y) * inv); o.w = pk4_i8m(bflo(p1.z) * inv, bfhi(p1.z) * inv, bflo(p1.w) * inv, bfhi(p1.w) * inv);
                *(u32x4*)(X8o + (size_t)(R00 + i) * DM + 16 * ln) = o; }
            continue;
        }
        __syncthreads();
        if (F.tid < 64) { const int c = cntl[F.tid]; basel[F.tid] = c ? (int)__hip_atomic_fetch_add((unsigned*)(F.ctl + CW_CNT + layer * 4096 + 64 * F.tid), (unsigned)c, RLX_AGENT) : 0; }
        __syncthreads();
        { const int rs = F.tid, e = ri_e[rs], pos = basel[e] + ri_p[rs];
          list[(size_t)e * 65536 + pos] = base + (rs >> 1); wl[(size_t)e * 65536 + pos] = ri_w[rs]; rl[(size_t)e * 65536 + pos] = ri_r[rs >> 1]; }
        __syncthreads();
    }
    __syncthreads();
}
__device__ __forceinline__ void moe_tables(Frame& F, int layer) {
    LAS int* ptile = (LAS int*)(F.lds + MOE_OFF); LAS int* cntv = ptile + 128;
    __syncthreads();
    if (F.tid < 64) {
        const int c = (int)__hip_atomic_load((unsigned*)(F.ctl + CW_CNT + layer * 4096 + 64 * F.tid), RLX_AGENT);
        cntv[F.tid] = c;
        int nt = (c + 255) >> 8, incl = nt;
#pragma unroll
        for (int o = 1; o < 64; o <<= 1) { const int t = __shfl_up(incl, o); if (F.lane >= o) incl += t; }
        ptile[F.tid] = incl - nt; if (F.tid == 63) ptile[64] = incl;
    }
    __syncthreads();
}
__device__ __forceinline__ void p_moe_gu(Frame& F, int layer) {
    moe_tables(F, layer);
    const LAS int* ptile = (const LAS int*)(F.lds + MOE_OFF); const LAS int* cntv = ptile + 128;
    pg8::MoeOrder S{(const char*)(F.ws + WS_XB8), (const char*)(F.ws + WS_WGU) + (size_t)layer * 32 * 1024 * 1024, (size_t)1024 * 1024, 512, F.G, F.bid, 0, ptile[64], ptile, cntv, (const int*)(F.ws + WS_LIST), true};
    pg8::EpiSwiGLU E{F.ws + WS_H8, (const float*)(F.ws + WS_LISTR), cntv};
    pg8::gemm_phase<pg8::EpiSwiGLU, pg8::MoeOrder, true, true>(F.lds, 512, S, E);
}
template <bool FINAL> __device__ __forceinline__ void p_moe_down(Frame& F, int layer, int slot) {
    moe_tables(F, layer);
    const LAS int* ptile = (const LAS int*)(F.lds + MOE_OFF); const LAS int* cntv = ptile + 128;
    pg8::MoeOrder S{(const char*)(F.ws + WS_H8), (const char*)(F.ws + WS_WD) + (size_t)layer * 32 * 1024 * 512, (size_t)1024 * 512, 256, F.G, F.bid, ptile[32 * slot], ptile[32 * slot + 32], ptile, cntv, (const int*)(F.ws + WS_LIST), false};
    pg8::EpiScatter<FINAL> E{(bf16*)(F.ws + WS_XB), F.out, (const int*)(F.ws + WS_LIST), (const float*)(F.ws + WS_LISTW), cntv};
    pg8::gemm_phase<pg8::EpiScatter<FINAL>, pg8::MoeOrder, true, true>(F.lds, 256, S, E);
}

__device__ __forceinline__ void p_compress(Frame& F, const Args& A) {
    bf16* U = (bf16*)(F.ws + WS_U);
    LAS unsigned char* L = F.lds;
    const int w = F.wave;
    {
        const int tid = F.tid, sub = tid & 15;
        for (int v0 = F.bid * 32; v0 < MTOK * 4; v0 += F.G * 32) {
            const int vec = v0 + (tid >> 4), row = vec >> 2, wh = vec & 3;
            bf16* p = U + (size_t)row * LDO + ((wh >> 1) ? OKW : OKS) + (wh & 1) * 128 + 8 * sub;
            const float* g = ((wh >> 1) ? A.in[18] : A.in[17]) + 8 * sub;
            const u32x4 v = *(const u32x4*)p; float f[8] = {bflo(v.x), bfhi(v.x), bflo(v.y), bfhi(v.y), bflo(v.z), bfhi(v.z), bflo(v.w), bfhi(v.w)};
            float s = 0.f;
#pragma unroll
            for (int j = 0; j < 8; ++j) s += f[j] * f[j];
            s += __shfl_xor(s, 1); s += __shfl_xor(s, 2); s += __shfl_xor(s, 4); s += __shfl_xor(s, 8);
            const float rs = 1.f / sqrtf(s * (1.f / 128.f) + NORM_EPS);
            u32x4 o; o.x = pk2(f[0] * rs * g[0], f[1] * rs * g[1]); o.y = pk2(f[2] * rs * g[2], f[3] * rs * g[3]); o.z = pk2(f[4] * rs * g[4], f[5] * rs * g[5]); o.w = pk2(f[6] * rs * g[6], f[7] * rs * g[7]);
            *(u32x4*)p = o;
        }
    }
    constexpr int C_A = 0, C_B = 17408, C_H = 52224, C_S = 69632;
    for (int unit = F.bid; unit < 256; unit += F.G) {
        int tid = F.tid, lane = F.lane; asm volatile("" : "+v"(tid), "+v"(lane));
        const int T = unit >> 7, b = (unit >> 3) & 15, g = (unit >> 2) & 1, cb = unit & 3;
        const int col = (T ? OVC : OKC) + g * 128;
        const float* pos = T ? A.in[20] : A.in[19];
        const bf16* w1t = (const bf16*)(F.ws + (T ? WS_W1V : WS_W1K)); const bf16* w2t = (const bf16*)(F.ws + WS_W2) + T * 128 * 128;
        const int wm = w >> 2, wn = w & 3, r = lane & 31, hh = lane >> 5;
        f32x16 acc = {0.f, 0.f, 0.f, 0.f, 0.f, 0.f, 0.f, 0.f, 0.f, 0.f, 0.f, 0.f, 0.f, 0.f, 0.f, 0.f};
        u32x4 va[2], vb[4]; f32x4 vp[2][2];
#define CMP_LOAD(l_) do { \
            _Pragma("unroll") for (int e = 0; e < 2; ++e) { const int q = tid + 512 * e, c = q >> 4, part = q & 15; const int tok = 16 * (64 * cb + c) + (l_); \
                va[e] = (u32x4){0u, 0u, 0u, 0u}; if (tok < SEQ) va[e] = *(const u32x4*)(U + ((size_t)b * SEQ + tok) * LDO + col + 8 * part); \
                vp[e][0] = *(const f32x4*)(pos + (l_) * 128 + 8 * part); vp[e][1] = *(const f32x4*)(pos + (l_) * 128 + 8 * part + 4); } \
            _Pragma("unroll") for (int e = 0; e < 4; ++e) { const int q = tid + 512 * e, j = q >> 4, part = q & 15; vb[e] = *(const u32x4*)(w1t + (size_t)j * 4096 + (l_) * 128 + 8 * part); } } while (0)
        CMP_LOAD(0);
#pragma unroll 1
        for (int l = 0; l < 32; ++l) {
            __syncthreads();
#pragma unroll
            for (int e = 0; e < 2; ++e) { const int q = tid + 512 * e, c = q >> 4, part = q & 15;
                const u32x4 v = va[e]; const f32x4 p0 = vp[e][0], p1 = vp[e][1];
                u32x4 o; o.x = pk2(bflo(v.x) + p0.x, bfhi(v.x) + p0.y); o.y = pk2(bflo(v.y) + p0.z, bfhi(v.y) + p0.w); o.z = pk2(bflo(v.z) + p1.x, bfhi(v.z) + p1.y); o.w = pk2(bflo(v.w) + p1.z, bfhi(v.w) + p1.w);
                *(LAS u32x4*)(L + C_A + (c * SP + 8 * part) * 2) = o; }
#pragma unroll
            for (int e = 0; e < 4; ++e) { const int q = tid + 512 * e, j = q >> 4, part = q & 15;
                *(LAS u32x4*)(L + C_B + (j * SP + 8 * part) * 2) = vb[e]; }
            { const int ln = l + 1 < 32 ? l + 1 : 31; CMP_LOAD(ln); }
            __syncthreads();
#pragma unroll
            for (int ks = 0; ks < 8; ++ks) {
                const bf16x8 af = lds_frag(L + C_A, 32 * wm + r, 16 * ks + 8 * hh), bfg = lds_frag(L + C_B, 32 * wn + r, 16 * ks + 8 * hh);
                acc = __builtin_amdgcn_mfma_f32_32x32x16_bf16(af, bfg, acc, 0, 0, 0);
            }
        }
#undef CMP_LOAD
#pragma unroll
        for (int i = 0; i < 16; ++i) { const int c = 32 * wm + 8 * (i >> 2) + 4 * hh + (i & 3);
            *(LAS bf16*)(L + C_H + (c * SP + 32 * wn + r) * 2) = (bf16)f2bfh(siluf(acc[i])); }
        __syncthreads();
        f32x16 a2 = {0.f, 0.f, 0.f, 0.f, 0.f, 0.f, 0.f, 0.f, 0.f, 0.f, 0.f, 0.f, 0.f, 0.f, 0.f, 0.f};
#pragma unroll
        for (int ks = 0; ks < 8; ++ks) {
            const bf16x8 af = lds_frag(L + C_H, 32 * wm + r, 16 * ks + 8 * hh), bfg = *(const bf16x8*)(w2t + (size_t)(32 * wn + r) * 128 + 16 * ks + 8 * hh);
            a2 = __builtin_amdgcn_mfma_f32_32x32x16_bf16(af, bfg, a2, 0, 0, 0);
        }
        float rsv[16];
        if (T == 0) {
            LAS float* st = (LAS float*)(L + C_S);
#pragma unroll
            for (int i = 0; i < 16; ++i) { float q = a2[i] * a2[i];
                q += __shfl_xor(q, 1); q += __shfl_xor(q, 2); q += __shfl_xor(q, 4); q += __shfl_xor(q, 8); q += __shfl_xor(q, 16);
                if (r == 0) st[(32 * wm + 8 * (i >> 2) + 4 * hh + (i & 3)) * 4 + wn] = q; }
            __syncthreads();
#pragma unroll
            for (int i = 0; i < 16; ++i) { const f32x4 q = *(const LAS f32x4*)(st + (32 * wm + 8 * (i >> 2) + 4 * hh + (i & 3)) * 4);
                rsv[i] = A.in[16][32 * wn + r] / sqrtf((q.x + q.y + q.z + q.w) * (1.f / 128.f) + NORM_EPS); }
        } else {
#pragma unroll
            for (int i = 0; i < 16; ++i) rsv[i] = 1.f;
        }
        bf16* dst = (bf16*)(F.ws + (T ? WS_VCMP : WS_KCMP));
#pragma unroll
        for (int i = 0; i < 16; ++i) { const int c = 64 * cb + 32 * wm + 8 * (i >> 2) + 4 * hh + (i & 3);
            dst[(((size_t)b * 256 + c) * 2 + g) * 128 + 32 * wn + r] = (bf16)f2bfh(a2[i] * rsv[i]); }
    }
}

constexpr int N_STG = 32768;
constexpr int N_K = 0, N_V = 16384, N_LUT = 3 * N_STG, N_IMP = N_LUT + 4096, N_FAC = N_IMP + 16384, N_MSK = N_FAC + 1024, N_UNI = N_MSK + 512, N_CST = N_UNI + 64, N_LUT2 = N_CST + 64;
constexpr float LOG2E = 1.44269504f;
enum { BR_CMP = 0, BR_SEL = 1, BR_WIN = 2 };
struct NsaCtx {
    LAS unsigned char* L; const bf16* U; const bf16* KC; const bf16* VC;
    int tid, lane, w, r, hh, b, g, qblk, t0, t, head; size_t bat;
    float mrow, cfar; unsigned mlo, mhi;
};
__device__ __forceinline__ void glds16(const void* gsrc, unsigned lds_dst) { unsigned keep;
    asm volatile("s_mov_b32 %0, m0\n\ts_mov_b32 m0, %2\n\ts_nop 0\n\tglobal_load_lds_dwordx4 %1, off\n\ts_mov_b32 m0, %0" : "=&s"(keep) : "v"(gsrc), "s"(lds_dst) : "memory"); }
#define NSA_BAR() do { asm volatile("" ::: "memory"); __builtin_amdgcn_s_barrier(); asm volatile("" ::: "memory"); } while (0)
template <int BR, bool PV>
__device__ __forceinline__ void nsa_dma(const NsaCtx& X, int tl, int st) {
    LAS unsigned char* L = X.L; const int lane = X.lane;
#pragma unroll
    for (int e = 0; e < 2; ++e) { const int pidx = e * 8 + X.w, row = pidx * 4 + (lane >> 4), ch = (lane & 15) ^ (((lane >> 4) << 2) | (X.w & 3));
        const bf16* kp; const bf16* vp;
        if (BR == BR_CMP) { const size_t o = (((size_t)X.b * 256 + 64 * tl + row) * 2 + X.g) * 128 + 8 * ch; kp = X.KC + o; vp = X.VC + o; }
        else { const size_t o = (X.bat + 64 * tl + row) * LDO + X.g * 128 + 8 * ch; kp = X.U + o + (BR == BR_SEL ? OKS : OKW); vp = X.U + o + (BR == BR_SEL ? OVS : OVW); }
        const unsigned ld = (unsigned)__builtin_amdgcn_readfirstlane((int)(unsigned)(__SIZE_TYPE__)(L + st * N_STG + N_K + pidx * 1024));
        glds16(kp, ld); if (PV) glds16(vp, ld + N_V); }
}
template <int BR, bool SUM, bool PV, bool IMP, bool UNITFAC = false, bool STASH = false, bool PRE0 = false>
__device__ __forceinline__ void nsa_pass(const NsaCtx& X, const bf16x8 (&qf)[8], f32x16 (&oacc)[4], float& lsum, const float colfac, const int tlo, const int thi, const unsigned long long tmask, u32x4* stash = nullptr) {
    LAS unsigned char* L = X.L; const int r = X.r, hh = X.hh, lane = X.lane;
    const LAS float* LUT = (const LAS float*)(L + N_LUT);
    auto dma = [&](int tl, int st) { nsa_dma<BR, PV>(X, tl, st); };
    auto nextt = [&](int tl) { ++tl; while (tl <= thi && !((tmask >> tl) & 1ull)) ++tl; return tl; };
    int tile = nextt(tlo - 1);
    if (tile > thi) return;
    asm volatile("s_waitcnt vmcnt(0)" ::: "memory");
    int nxt = nextt(tile);
    int nn = nxt <= thi ? nextt(nxt) : nxt;
    if (!PRE0) dma(tile, 0);
    if (nxt <= thi) dma(nxt, 1);
    int cur = 0;
    const bool gB = X.w >= 4;
    const int kswz = ((r & 3) << 2) | ((r >> 2) & 3);
#define NSA_WAIT_KEEP(has_newer) do { if (has_newer) { if (PV) asm volatile("s_waitcnt vmcnt(4)" ::: "memory"); else asm volatile("s_waitcnt vmcnt(2)" ::: "memory"); } else asm volatile("s_waitcnt vmcnt(0)" ::: "memory"); } while (0)
#define NSA_LDK(dst, stg, mt_, k0, k1) do { _Pragma("unroll") for (int ks = (k0); ks < (k1); ++ks) dst[ks - (k0)] = *(const LAS bf16x8*)(L + (stg) * N_STG + N_K + (32 * (mt_) + r) * 256 + 16 * ((2 * ks + hh) ^ kswz)); } while (0)
    NSA_WAIT_KEEP(nxt <= thi); NSA_BAR();
    bf16x8 kpre[2];
    NSA_LDK(kpre, 0, 0, 0, 2);
    if (gB) NSA_BAR();
    while (tile <= thi) {
        const int st2 = cur >= 1 ? cur - 1 : 2;
        const int st1 = cur == 2 ? 0 : cur + 1;
        if (gB) asm volatile("s_waitcnt vmcnt(0)" ::: "memory");
        NSA_BAR();
        if (gB && nn <= thi) dma(nn, st2);
        LAS unsigned char* Ls = L + cur * N_STG;
        const int maxpos = BR == BR_CMP ? 16 * (64 * tile + 63) + 31 : 64 * tile + 63, minpos = BR == BR_CMP ? 16 * (64 * tile) + 31 : 64 * tile;
        const bool farpos = X.t0 - maxpos >= 113, inwin = BR != BR_WIN || (X.t0 + 63 - minpos < 512);
        const bool far = farpos && inwin;
        bool selb = true; if (BR == BR_SEL) selb = (tile < 32 ? (X.mlo >> tile) : (X.mhi >> (tile - 32))) & 1u;
        const bool wsk = BR == BR_SEL && __ballot(selb) == 0ull;
        bf16x8 pa[2][2];
        if (!wsk) {
            bf16x8 kf0[6], kf1[8];
            NSA_LDK(kf0, cur, 0, 2, 8); NSA_LDK(kf1, cur, 1, 0, 8);
            asm volatile("" ::: "memory");
            f32x16 sacc[2];
#pragma unroll
            for (int mt = 0; mt < 2; ++mt) sacc[mt] = (f32x16){0.f, 0.f, 0.f, 0.f, 0.f, 0.f, 0.f, 0.f, 0.f, 0.f, 0.f, 0.f, 0.f, 0.f, 0.f, 0.f};
#pragma unroll
            for (int ks = 0; ks < 2; ++ks) sacc[0] = __builtin_amdgcn_mfma_f32_32x32x16_bf16(kpre[ks], qf[ks], sacc[0], 0, 0, 0);
#pragma unroll
            for (int ks = 2; ks < 8; ++ks) sacc[0] = __builtin_amdgcn_mfma_f32_32x32x16_bf16(kf0[ks - 2], qf[ks], sacc[0], 0, 0, 0);
#pragma unroll
            for (int ks = 0; ks < 8; ++ks) sacc[1] = __builtin_amdgcn_mfma_f32_32x32x16_bf16(kf1[ks], qf[ks], sacc[1], 0, 0, 0);
            const float cf = (BR == BR_SEL && !selb) ? -1.0e30f : X.cfar;
#pragma unroll
            for (int mt = 0; mt < 2; ++mt) {
                if (far) {
#pragma unroll
                    for (int i = 0; i < 16; ++i) { const float p = __builtin_amdgcn_exp2f(sacc[mt][i] + cf);
                        if (SUM && !PV) lsum += p; sacc[mt][i] = UNITFAC ? p : p * colfac; }
                } else if (BR == BR_CMP) {
#pragma unroll
                    for (int i = 0; i < 16; ++i) { const int kidx = 32 * mt + 8 * (i >> 2) + 4 * hh + (i & 3);
                        const int dist = X.t - (16 * (64 * tile + kidx) + 31); const bool ok = dist >= 0;
                        const int dc = dist < 0 ? 0 : (dist > 127 ? 127 : dist);
                        const float bia = LUT[dc * 8 + X.head];
                        const float ev = __builtin_amdgcn_exp2f(sacc[mt][i] + bia - X.mrow);
                        const float p = ok ? ev : 0.f;
                        if (SUM && !PV) lsum += p;
                        sacc[mt][i] = UNITFAC ? p : p * colfac; }
                } else if (BR == BR_WIN && farpos) {
                    const int dq = X.t - 64 * tile - 4 * hh;
#pragma unroll
                    for (int i = 0; i < 16; ++i) { const int koff = 32 * mt + 8 * (i >> 2) + (i & 3);
                        const float ev = __builtin_amdgcn_exp2f(sacc[mt][i] + X.cfar);
                        const float p = dq < 512 + koff ? ev : 0.f;
                        if (SUM && !PV) lsum += p;
                        sacc[mt][i] = UNITFAC ? p : p * colfac; }
                } else if (tile < X.qblk) {
                    const int dq = X.t - 64 * tile - 4 * hh;
                    const LAS float* lbm = (const LAS float*)(L + N_LUT2) + X.head * 384 + 64 + dq - 63;
                    const float mr = (BR == BR_SEL && !selb) ? 1.0e30f : X.mrow;
#pragma unroll
                    for (int i = 0; i < 16; ++i) { const int koff = 32 * mt + 8 * (i >> 2) + (i & 3);
                        const float p = __builtin_amdgcn_exp2f(sacc[mt][i] + lbm[63 - koff] - mr);
                        if (SUM && !PV) lsum += p;
                        sacc[mt][i] = UNITFAC ? p : p * colfac; }
                } else {
                    int dq = X.t - 64 * tile - 4 * hh;
                    const LAS float* lbm = (const LAS float*)(L + N_LUT2) + X.head * 384 + 64 + dq - 63;
                    if (BR == BR_SEL && !selb) dq = -1;
#pragma unroll
                    for (int i = 0; i < 16; ++i) { const int koff = 32 * mt + 8 * (i >> 2) + (i & 3);
                        const float ev = __builtin_amdgcn_exp2f(sacc[mt][i] + lbm[63 - koff] - X.mrow);
                        const float p = dq >= koff ? ev : 0.f;
                        if (SUM && !PV) lsum += p;
                        sacc[mt][i] = UNITFAC ? p : p * colfac; }
                }
                if (IMP) {
                    LAS float* imp = (LAS float*)(L + N_IMP) + (X.w * 8 + (r >> 2)) * 64;
#pragma unroll
                    for (int q = 0; q < 4; ++q) { float s4 = (sacc[mt][4 * q] + sacc[mt][4 * q + 1]) + (sacc[mt][4 * q + 2] + sacc[mt][4 * q + 3]), s3 = sacc[mt][4 * q + 3];
                        s4 += xor1(s4); s4 += xor2(s4); s3 += xor1(s3); s3 += xor2(s3);
                        const int n = 16 * tile + 8 * mt + 2 * q + hh;
                        if ((r & 3) == 0) { __hip_atomic_fetch_add(imp + n, s4, __ATOMIC_RELAXED, __HIP_MEMORY_SCOPE_WORKGROUP); if (n < 63) __hip_atomic_fetch_add(imp + n + 1, s3, __ATOMIC_RELAXED, __HIP_MEMORY_SCOPE_WORKGROUP); } }
                }
                if (PV) {
#pragma unroll
                    for (int sI = 0; sI < 2; ++sI) { u32x4 pp; pp.x = pk2(sacc[mt][8 * sI], sacc[mt][8 * sI + 1]); pp.y = pk2(sacc[mt][8 * sI + 2], sacc[mt][8 * sI + 3]); pp.z = pk2(sacc[mt][8 * sI + 4], sacc[mt][8 * sI + 5]); pp.w = pk2(sacc[mt][8 * sI + 6], sacc[mt][8 * sI + 7]);
                        if (STASH) stash[((tile * 2 + mt) * 2 + sI) * 64] = pp;
                        if (SUM) { lsum = dot2ones(pp.x, lsum); lsum = dot2ones(pp.y, lsum); lsum = dot2ones(pp.z, lsum); lsum = dot2ones(pp.w, lsum); }
                        pa[mt][sI] = __builtin_bit_cast(bf16x8, pp); }
                }
            }
        } else {
#pragma unroll
            for (int mt = 0; mt < 2; ++mt)
#pragma unroll
                for (int sI = 0; sI < 2; ++sI) pa[mt][sI] = (bf16x8){0, 0, 0, 0, 0, 0, 0, 0};
        }
        const int q4 = (lane & 15) >> 2, k2 = 2 * ((lane >> 4) & 1) + ((lane & 3) >> 1), sub8 = 8 * (lane & 1);
        s16x4 vb[2][8];
#define NSA_LDV(g, dst) do { const int _row0 = 16 * (g) + 4 * hh + q4; _Pragma("unroll") for (int nt = 0; nt < 4; ++nt) { \
            dst[2 * nt] = lds_tr16(Ls + N_V + _row0 * 256 + 64 * (nt ^ q4) + 16 * (k2 ^ hh) + sub8); \
            dst[2 * nt + 1] = lds_tr16(Ls + N_V + (_row0 + 8) * 256 + 64 * (nt ^ q4) + 16 * (k2 ^ (hh + 2)) + sub8); } } while (0)
        if (!gB) asm volatile("s_waitcnt vmcnt(0)" ::: "memory");
        NSA_BAR();
        if (!gB && nn <= thi) dma(nn, st2);
        if (PV) {
            NSA_LDV(0, vb[0]);
#pragma unroll
            for (int g = 0; g < 4; ++g) {
                if (g == 0) NSA_LDV(1, vb[1]); else if (g == 1) NSA_LDV(2, vb[0]); else if (g == 2) NSA_LDV(3, vb[1]);
                asm volatile("" ::: "memory");
#pragma unroll
                for (int nt = 0; nt < 4; ++nt) { const s16x4 b0 = vb[g & 1][2 * nt], b1 = vb[g & 1][2 * nt + 1];
                    bf16x8 bfg; bfg[0] = b0[0]; bfg[1] = b0[1]; bfg[2] = b0[2]; bfg[3] = b0[3]; bfg[4] = b1[0]; bfg[5] = b1[1]; bfg[6] = b1[2]; bfg[7] = b1[3];
                    oacc[nt] = __builtin_amdgcn_mfma_f32_32x32x16_bf16(pa[g >> 1][g & 1], bfg, oacc[nt], 0, 0, 0); }
            }
        }
#undef NSA_LDV
        if (nxt <= thi) NSA_LDK(kpre, st1, 0, 0, 2);
        tile = nxt; nxt = nn; nn = nn <= thi ? nextt(nn) : nn;
        cur = cur == 2 ? 0 : cur + 1;
    }
#undef NSA_WAIT_KEEP
#undef NSA_LDK
    if (!gB) NSA_BAR();
    __syncthreads();
}

__device__ __forceinline__ void p_nsa(Frame& F, const Args& A) {
    const bf16* U = (const bf16*)(F.ws + WS_U); bf16* HB = (bf16*)(F.ws + WS_HB); const float* GL = (const float*)(F.ws + WS_GL);
    LAS unsigned char* L = F.lds;
    LAS float* LUT = (LAS float*)(L + N_LUT); LAS float* cst = (LAS float*)(L + N_CST);
    for (int i = F.tid; i < 1024; i += NTHR) LUT[i] = A.in[1][t5_bucket_dev(i >> 3) * 8 + (i & 7)] * LOG2E;
    if (F.wave == 0) {
        float gm = 0.f, bm = 0.f;
        for (int i = F.lane; i < 128; i += 64) gm = fmaxf(gm, fmaxf(fabsf(A.in[16][i]), fmaxf(fabsf(A.in[17][i]), fabsf(A.in[18][i]))));
        for (int i = F.lane; i < 256; i += 64) bm = fmaxf(bm, fabsf(A.in[1][i]));
#pragma unroll
        for (int o = 1; o < 64; o <<= 1) { gm = fmaxf(gm, __shfl_xor(gm, o)); bm = fmaxf(bm, __shfl_xor(bm, o)); }
        if (F.lane == 0) { cst[0] = gm * 11.3137085f; cst[1] = bm * LOG2E; }
    }
    __syncthreads();
    for (int i = F.tid; i < 8 * 384; i += NTHR) { const int h = i / 384, dd = i % 384 - 64; const int d = dd < 0 ? 0 : (dd > 127 ? 127 : dd); ((LAS float*)(L + N_LUT2))[i] = LUT[d * 8 + h]; }
    __syncthreads();
    const float kmax = cst[0], bmax = cst[1];
    for (int ui = F.bid; ui < 2048; ui += F.G) {
        NsaCtx X; X.L = L; X.U = U; X.KC = (const bf16*)(F.ws + WS_KCMP); X.VC = (const bf16*)(F.ws + WS_VCMP);
        int tid = F.tid, lane = F.lane; asm volatile("" : "+v"(tid), "+v"(lane));
        X.tid = tid; X.lane = lane; X.w = F.wave; X.r = lane & 31; X.hh = lane >> 5;
        const int kr = ui >> 8, cc = ui & 255, bg = (cc & 7) * 4 + (kr >> 1), sl = cc >> 3;
        X.b = bg >> 1; X.g = bg & 1; X.qblk = (kr & 1) ? 63 - sl : sl; X.t0 = 64 * X.qblk; X.bat = (size_t)X.b * SEQ;
        const int tq = X.r >> 2, hd = X.r & 3; X.t = X.t0 + 8 * X.w + tq; X.head = 4 * X.g + hd;
        const size_t row = X.bat + X.t;
        if (tid == 0) { unsigned z = 0u; asm volatile("" : "+v"(z)); *(LAS u32x2*)(L + N_UNI) = (u32x2){z, z}; }
        for (int i = tid; i < 4096; i += NTHR) ((LAS float*)(L + N_IMP))[i] = 0.f;
        bf16x8 qf[8]; float qn2 = 0.f;
        {
            u32x4 qr[8]; float ss = 0.f;
#pragma unroll
            for (int ks = 0; ks < 8; ++ks) { qr[ks] = *(const u32x4*)(U + row * LDO + OQ + X.head * 128 + 16 * ks + 8 * X.hh);
#pragma unroll
                for (int e = 0; e < 4; ++e) { const float a = bflo(qr[ks][e]), c = bfhi(qr[ks][e]); ss += a * a + c * c; } }
            ss += __shfl_xor(ss, 32);
            const float rs = 1.f / sqrtf(ss * (1.f / 128.f) + NORM_EPS);
#pragma unroll
            for (int ks = 0; ks < 8; ++ks) { const float* gq = A.in[15] + 16 * ks + 8 * X.hh; u32x4 pk;
#pragma unroll
                for (int e = 0; e < 4; ++e) { const float a = bflo(qr[ks][e]) * rs * gq[2 * e], c = bfhi(qr[ks][e]) * rs * gq[2 * e + 1]; qn2 += a * a + c * c; pk[e] = pk2(a * (0.0883883476f * LOG2E), c * (0.0883883476f * LOG2E)); }
                qf[ks] = __builtin_bit_cast(bf16x8, pk); }
            qn2 += __shfl_xor(qn2, 32);
        }
        X.mrow = sqrtf(qn2) * (0.0883883476f * LOG2E) * kmax + bmax;
        X.cfar = LUT[127 * 8 + X.head] - X.mrow;
        X.mlo = 0u; X.mhi = 0u;
        const float gl3[3] = {GL[row * 24 + X.head], GL[row * 24 + 8 + X.head], GL[row * 24 + 16 + X.head]};
#define NSA_GATE(k_) (1.f / (1.f + __expf(-gl3[(k_)])))
        f32x16 oacc[4];
#pragma unroll
        for (int nt = 0; nt < 4; ++nt) oacc[nt] = (f32x16){0.f, 0.f, 0.f, 0.f, 0.f, 0.f, 0.f, 0.f, 0.f, 0.f, 0.f, 0.f, 0.f, 0.f, 0.f, 0.f};
        const int ntc = ((4 * X.qblk + 2) >> 6) + 1;
#define NSA_FOLD(fcol, FIRST, LAST) do { int _pl = F.lane; asm volatile("" : "+v"(_pl)); u32x4* park = (u32x4*)(F.ws + WS_PARK) + ((size_t)(F.bid * NWAVES + X.w) * 64 + _pl) * 8; \
            LAS float* _fac = (LAS float*)(L + N_FAC) + X.w * 32; LDS_WAIT(); if (lane < 32) _fac[lane] = (fcol); LDS_WAIT(); \
            if (!(FIRST)) { asm volatile("s_waitcnt vmcnt(0)" ::: "memory"); __builtin_amdgcn_fence(__ATOMIC_ACQUIRE, "agent"); } \
            _Pragma("unroll") for (int nt = 0; nt < 4; ++nt) { u32x4 _p0 = (u32x4){0u, 0u, 0u, 0u}, _p1 = _p0; if (!(FIRST)) { _p0 = park[2 * nt]; _p1 = park[2 * nt + 1]; } \
                _Pragma("unroll") for (int q = 0; q < 4; ++q) { const f32x4 _fr = *(const LAS f32x4*)(_fac + 8 * q + 4 * X.hh); const unsigned _wa = q < 2 ? _p0[2 * q] : _p1[2 * q - 4], _wb = q < 2 ? _p0[2 * q + 1] : _p1[2 * q - 3]; \
                    float _a = oacc[nt][4 * q] * _fr.x, _b = oacc[nt][4 * q + 1] * _fr.y, _c = oacc[nt][4 * q + 2] * _fr.z, _d = oacc[nt][4 * q + 3] * _fr.w; \
                    if (!(FIRST)) { _a += bflo(_wa); _b += bfhi(_wa); _c += bflo(_wb); _d += bfhi(_wb); } \
                    oacc[nt][4 * q] = _a; oacc[nt][4 * q + 1] = _b; oacc[nt][4 * q + 2] = _c; oacc[nt][4 * q + 3] = _d; } \
                if (!(LAST)) { park[2 * nt] = (u32x4){pk2(oacc[nt][0], oacc[nt][1]), pk2(oacc[nt][2], oacc[nt][3]), pk2(oacc[nt][4], oacc[nt][5]), pk2(oacc[nt][6], oacc[nt][7])}; \
                               park[2 * nt + 1] = (u32x4){pk2(oacc[nt][8], oacc[nt][9]), pk2(oacc[nt][10], oacc[nt][11]), pk2(oacc[nt][12], oacc[nt][13]), pk2(oacc[nt][14], oacc[nt][15])}; \
                               oacc[nt] = (f32x16){0.f, 0.f, 0.f, 0.f, 0.f, 0.f, 0.f, 0.f, 0.f, 0.f, 0.f, 0.f, 0.f, 0.f, 0.f, 0.f}; } } } while (0)
        float l_c = 0.f;
        u32x4* stash = (u32x4*)(F.ws + WS_STASH) + (size_t)(F.bid * NWAVES + X.w) * (16 * 64) + lane;
        nsa_pass<BR_CMP, true, true, false, true, true>(X, qf, oacc, l_c, 1.f, 0, ntc - 1, ~0ull, stash);
        nsa_dma<BR_SEL, true>(X, 0, 0);
        l_c += __shfl_xor(l_c, 32);
        const float il_c = l_c > 0.f ? 1.f / l_c : 0.f;
        NSA_FOLD(NSA_GATE(0) * il_c, true, false);
        {
            asm volatile("s_waitcnt vmcnt(0)" ::: "memory"); __builtin_amdgcn_fence(__ATOMIC_ACQUIRE, "agent");
            LAS float* imp = (LAS float*)(L + N_IMP) + (X.w * 8 + (X.r >> 2)) * 64;
#pragma unroll 1
            for (int tile = 0; tile < ntc; ++tile) {
                u32x4 pp[2][2];
#pragma unroll
                for (int mt = 0; mt < 2; ++mt)
#pragma unroll
                    for (int sI = 0; sI < 2; ++sI) pp[mt][sI] = stash[((tile * 2 + mt) * 2 + sI) * 64];
#pragma unroll
                for (int mt = 0; mt < 2; ++mt) {
                    float v[16];
#pragma unroll
                    for (int sI = 0; sI < 2; ++sI)
#pragma unroll
                        for (int e = 0; e < 4; ++e) { v[8 * sI + 2 * e] = bflo(pp[mt][sI][e]); v[8 * sI + 2 * e + 1] = bfhi(pp[mt][sI][e]); }
#pragma unroll
                    for (int q = 0; q < 4; ++q) { float s4 = ((v[4 * q] + v[4 * q + 1]) + (v[4 * q + 2] + v[4 * q + 3])) * il_c, s3 = v[4 * q + 3] * il_c;
                        s4 += xor1(s4); s4 += xor2(s4); s3 += xor1(s3); s3 += xor2(s3);
                        const int n = 16 * tile + 8 * mt + 2 * q + X.hh;
                        if ((X.r & 3) == 0) { __hip_atomic_fetch_add(imp + n, s4, __ATOMIC_RELAXED, __HIP_MEMORY_SCOPE_WORKGROUP); if (n < 63) __hip_atomic_fetch_add(imp + n + 1, s3, __ATOMIC_RELAXED, __HIP_MEMORY_SCOPE_WORKGROUP); } }
                }
            }
        }
        {
            LDS_WAIT();
            const LAS float* impw = (const LAS float*)(L + N_IMP) + X.w * 8 * 64;
            const int n = lane, cur = X.qblk;
            unsigned long long wor = 0ull;
#pragma unroll 1
            for (int q = 0; q < 8; ++q) {
                const float imp = impw[q * 64 + n];
                const bool forced = (n == 0) || (n == cur) || (n == cur - 1);
                unsigned key = forced ? 0x7fffffc0u : (__builtin_bit_cast(unsigned, imp) & 0x7fffffc0u);
                if (n > cur) key = 0u;
                key |= (unsigned)(63 - n);
                unsigned T = 0u;
#pragma unroll
                for (int bit = 30; bit >= 0; --bit) { const unsigned cand = T | (1u << bit); T = __popcll(__ballot(key >= cand)) >= 16 ? cand : T; }
                const unsigned long long mk = __ballot(n <= cur && key >= T);
                wor |= mk;
                if ((X.r >> 2) == q) { X.mlo = (unsigned)mk; X.mhi = (unsigned)(mk >> 32); }
            }
            if (lane == 0) __hip_atomic_fetch_or((LAS unsigned long long*)(L + N_UNI), wor, __ATOMIC_RELAXED, __HIP_MEMORY_SCOPE_WORKGROUP);
        }
        __syncthreads();
        const unsigned long long uni = *(const LAS unsigned long long*)(L + N_UNI);
        float l_s = 0.f;
        nsa_pass<BR_SEL, true, true, false, true, false, true>(X, qf, oacc, l_s, 1.f, 0, X.qblk, uni);
        const int wlo = X.qblk >= 8 ? X.qblk - 8 : 0;
        nsa_dma<BR_WIN, true>(X, wlo, 0);
        l_s += __shfl_xor(l_s, 32);
        NSA_FOLD(l_s > 0.f ? NSA_GATE(1) / l_s : 0.f, false, false);
        float l_w = 0.f;
        nsa_pass<BR_WIN, true, true, false, true, false, true>(X, qf, oacc, l_w, 1.f, wlo, X.qblk, ~0ull);
        l_w += __shfl_xor(l_w, 32);
        NSA_FOLD(l_w > 0.f ? NSA_GATE(2) / l_w : 0.f, false, true);
#undef NSA_FOLD
#undef NSA_GATE
        const bool odd = X.r & 1;
#pragma unroll
        for (int i = 0; i < 16; i += 2) { const int c32 = 8 * (i >> 2) + 4 * X.hh + (i & 3);
            unsigned char* op = (unsigned char*)HB + (X.bat + X.t0 + 8 * X.w + (c32 >> 2)) * DM + (4 * X.g + (c32 & 3) + (odd ? 1 : 0)) * 128 + (X.r & ~1);
#pragma unroll
            for (int nt = 0; nt < 4; ++nt) { const float a = oacc[nt][i] * F8_SX, b = oacc[nt][i + 1] * F8_SX; const float rcv = xor1(odd ? a : b);
                *(unsigned short*)(op + 32 * nt) = odd ? pk2_fp8(rcv, b) : pk2_fp8(a, rcv); } }
    }
}

constexpr int N_PHASES = 18;
__global__ void __launch_bounds__(NTHR, 2) mk_fwd(Args args) {
    extern __shared__ __attribute__((aligned(16))) unsigned char lds[];
    Frame F;
    F.lds = (LAS unsigned char*)lds;
    F.MISC = (volatile LAS unsigned*)(F.lds + MISC_OFF);
    F.tid = threadIdx.x; F.lane = F.tid & 63; F.wave = __builtin_amdgcn_readfirstlane(F.tid >> 6);
    F.G = gridDim.x; F.bid = blockIdx.x;
    F.ws = args.ws; F.out = args.out; F.ctl = (gu32*)(args.ws + WS_CTL);
    if (F.tid < 64) F.MISC[F.tid] = 0u;
    __syncthreads();
    const int lo = args.ph_lo, hi = args.ph_hi;
    XcdBarrier bar; bar.bar = (unsigned*)(F.ctl + CW_BAR); bar.x = 0; bar.st = nullptr;
    if (hi - lo > 1) bar = xcd_barrier_post((unsigned*)(F.ctl + CW_BAR), F.MISC + 8);
#ifndef PHMASK
#define PHMASK 0xffffffffu
#endif
#define IN(k) (((PHMASK >> (k)) & 1u) && lo <= (k) && (k) < hi)
#ifndef REPMASK
#define REPMASK 0u
#endif
#define RUNS(k) (1 + (int)((REPMASK >> (k)) & 1u))
#define SEAM(k) do { if (IN(k) && IN((k) + 1)) xcd_barrier(bar); } while (0)
    if (IN(0)) { p_wmax(F, args); xcd_barrier(bar); for (int rp = 0; rp < RUNS(0); ++rp) p_prologue(F, args); } SEAM(0);
    if (IN(1)) for (int rp = 0; rp < RUNS(1); ++rp) {
        pg8::StaticOrder S; S.init(F.ws + WS_HB, F.ws + WS_WIE, MTOK, LDE, DM / 2, F.G, F.bid);
        pg8::EpiI8S E{(bf16*)(F.ws + WS_U), LDE, (const float*)(F.ws + WS_RS), (const unsigned*)(F.ctl + CW_WMAX), F.ws + WS_IQK8};
        pg8::gemm_phase<pg8::EpiI8S, pg8::StaticOrder, true, 2>(F.lds, DM / 2, S, E);
    } SEAM(1);
    if (IN(2)) { p_ssd1(F, args); xcd_barrier(bar); p_ssd2(F); xcd_barrier(bar); p_ssd3(F); } SEAM(2);
    if (IN(3)) { for (int rp = 0; rp < RUNS(3); ++rp) p_dsa(F, args); } SEAM(3);
    if (IN(4)) {
        pg8::StaticOrder S; S.init(F.ws + WS_HB, F.ws + WS_WOE, MTOK, DM, DM / 2, F.G, F.bid);
        pg8::EpiResXB E{args.in[0], nullptr, (bf16*)(F.ws + WS_XB), F.ws + WS_XB8, 1.f / (F8_SX * F8_SW)};
        pg8::gemm_phase<pg8::EpiResXB, pg8::StaticOrder, true, true>(F.lds, DM / 2, S, E);
    } SEAM(4);
    if (IN(5)) { p_norm_route<0>(F, (const bf16*)(F.ws + WS_XB), 0); } SEAM(5);
    if (IN(6)) { p_moe_gu(F, 0);
#if (REPMASK >> 6) & 1
        p_moe_gu(F, 0);
#endif
    } SEAM(6);
    if (IN(7)) { p_moe_down<false>(F, 0, 0); } SEAM(7);
    if (IN(8)) { p_moe_down<false>(F, 0, 1); } SEAM(8);
    if (IN(9)) { for (int rp = 0; rp < RUNS(9); ++rp) p_norm_route<1>(F, (const bf16*)(F.ws + WS_XB), 0); } SEAM(9);
    if (IN(10)) {
        pg8::StaticOrder S; S.init(F.ws + WS_HB, F.ws + WS_WIO, MTOK, LDO, DM / 2, F.G, F.bid);
        pg8::EpiI8S E{(bf16*)(F.ws + WS_U), LDO, (const float*)(F.ws + WS_RS), (const unsigned*)(F.ctl + CW_WMAX + 1), nullptr};
        pg8::gemm_phase<pg8::EpiI8S, pg8::StaticOrder, true, 2>(F.lds, DM / 2, S, E);
    } SEAM(10);
    if (IN(11)) { p_compress(F, args); } SEAM(11);
    if (IN(12)) { p_nsa(F, args);
#if (REPMASK >> 12) & 1
        p_nsa(F, args);
#endif
    } SEAM(12);
    if (IN(13)) {
        pg8::StaticOrder S; S.init(F.ws + WS_HB, F.ws + WS_WOO, MTOK, DM, DM / 2, F.G, F.bid);
        pg8::EpiResXB E{nullptr, (const bf16*)(F.ws + WS_XB), (bf16*)(F.ws + WS_XB), F.ws + WS_XB8, 1.f / (F8_SX * F8_SW)};
        pg8::gemm_phase<pg8::EpiResXB, pg8::StaticOrder, true, true>(F.lds, DM / 2, S, E);
    } SEAM(13);
    if (IN(14)) { p_norm_route<0>(F, (const bf16*)(F.ws + WS_XB), 1); } SEAM(14);
    if (IN(15)) { p_moe_gu(F, 1); } SEAM(15);
    if (IN(16)) { p_moe_down<false>(F, 1, 0); } SEAM(16);
    if (IN(17)) { p_moe_down<true>(F, 1, 1); }
#undef IN
#undef SEAM
}

extern "C" void kernel_launch(void* const* d_in, const int* in_sizes, int n_in, void* d_out, int out_size, void* d_ws, size_t ws_size, hipStream_t stream) {
    static int grid = 0;
    if (grid == 0) {
        if (n_in != 31 || ws_size < WS_END) { fprintf(stderr, "kernel_launch: unexpected n_in %d / ws %zu\n", n_in, ws_size); grid = -1; return; }
        int dev = 0, cus = 0;
        if (hipGetDevice(&dev) != hipSuccess || hipDeviceGetAttribute(&cus, hipDeviceAttributeMultiprocessorCount, dev) != hipSuccess) { grid = -1; return; }
        if (hipFuncSetAttribute((const void*)mk_fwd, hipFuncAttributeMaxDynamicSharedMemorySize, LDS_BYTES) != hipSuccess) { fprintf(stderr, "kernel_launch: hipFuncSetAttribute failed\n"); grid = -1; return; }
        grid = cus;
    }
    if (grid < 0) return;
    (void)hipMemsetAsync((char*)d_ws + WS_CTL, 0, CTL_ZERO_BYTES, stream);
    Args a{};
    for (int i = 0; i < 31; ++i) a.in[i] = (const float*)d_in[i];
    a.out = (float*)d_out; a.ws = (unsigned char*)d_ws; a.rep = (REP_PART || REP_PHASE >= 0) ? 2 : 1; a.pad = 0; a.rep = 2; a.pad = 0;
#if defined(MK_PER_PHASE)
    for (int p = 0; p < N_PHASES; ++p) { a.ph_lo = p; a.ph_hi = p + 1; hipLaunchKernelGGL(mk_fwd, dim3(grid), dim3(NTHR), LDS_BYTES, stream, a); }
#else
    a.ph_lo = 0; a.ph_hi = N_PHASES; hipLaunchKernelGGL(mk_fwd, dim3(grid), dim3(NTHR), LDS_BYTES, stream, a);
#endif
}
```

```cpp
#include <hip/hip_runtime.h>
#include <cstdio>
#include <cstdint>

#define GAS __attribute__((address_space(1)))
#define LAS __attribute__((address_space(3)))
typedef unsigned short bf16;
typedef short bf16x8 __attribute__((ext_vector_type(8)));
typedef float f32x4 __attribute__((ext_vector_type(4)));
typedef float f32x2 __attribute__((ext_vector_type(2)));
typedef float f32x16 __attribute__((ext_vector_type(16)));
typedef unsigned u32x4 __attribute__((ext_vector_type(4)));
typedef unsigned u32x2 __attribute__((ext_vector_type(2)));
typedef GAS unsigned gu32;
#define RLX_AGENT __ATOMIC_RELAXED, __HIP_MEMORY_SCOPE_AGENT
#define LDS_WAIT() asm volatile("s_waitcnt lgkmcnt(0)" ::: "memory")
#define VM_WAIT() asm volatile("s_waitcnt vmcnt(0)" ::: "memory")

constexpr int NB = 16, SEQ = 4096, DM = 1024, MTOK = NB * SEQ;
constexpr float NORM_EPS = 1e-6f;
constexpr int LDE = 2560;
constexpr int EZ = 0, EXS = 512, EBB = 1024, ECC = 1280, EQ = 1536, EK = 2048, EV = 2112, EIQ = 2176, EIK = 2432, EDT = 2496, EIW = 2504;
constexpr int LDO = 2560;
constexpr int OQ = 0, OKC = 1024, OVC = 1280, OKS = 1536, OVS = 1792, OKW = 2048, OVW = 2304;
constexpr int NWAVES = 8, NTHR = 512;

constexpr size_t MiB = 1u << 20;
constexpr size_t WS_CTL = 0, CTL_ZERO_BYTES = 128 * 1024;
constexpr size_t WS_WIE = 1 * MiB, WS_WOE = 6 * MiB, WS_WIO = 8 * MiB, WS_WOO = 13 * MiB;
constexpr size_t WS_W1K = 15 * MiB, WS_W1V = 16 * MiB, WS_W2 = 17 * MiB, WS_WR = 18 * MiB;
constexpr size_t WS_WGL = WS_WR + 256 * 1024;
constexpr size_t WS_TOK = 19 * MiB;
constexpr size_t WS_GL = 20 * MiB;
constexpr size_t WS_KCMP = 26 * MiB, WS_VCMP = 28 * MiB;
constexpr size_t WS_LIST = 32 * MiB;
constexpr size_t WS_WGU = 48 * MiB;
constexpr size_t WS_WD = 176 * MiB;
constexpr size_t WS_HB = 240 * MiB;
constexpr size_t WS_U = 368 * MiB;
constexpr size_t WS_LISTW = 720 * MiB;
constexpr size_t WS_XB = 736 * MiB;
constexpr size_t WS_PARK = 864 * MiB;
constexpr size_t WS_CC = 880 * MiB;
constexpr size_t WS_AC = 912 * MiB;
constexpr size_t WS_XB8 = 368 * MiB;
constexpr size_t WS_H8 = 432 * MiB;
constexpr size_t WS_LISTR = 916 * MiB;
constexpr size_t WS_RS = 932 * MiB;
constexpr size_t WS_STASH = 933 * MiB;
constexpr size_t WS_IQK8 = 965 * MiB;
constexpr size_t WS_K8 = 985 * MiB;
constexpr size_t WS_END = 989 * MiB;
constexpr int CW_TMO = 0, CW_CODE = 1, CW_WMAX = 16, CW_BAR = 4096, CW_CNT = 8192;

constexpr int RING_BYTES = 131072;
constexpr int LDS_BYTES = 147456;
constexpr int MISC_OFF = LDS_BYTES - 256;
constexpr int MOE_OFF = LDS_BYTES - 2048;

__device__ __forceinline__ unsigned f2bf(float f) { unsigned u = __builtin_bit_cast(unsigned, f); return (u + 0x7fffu + ((u >> 16) & 1u)) >> 16; }
typedef __bf16 bf16x2_t __attribute__((ext_vector_type(2)));
constexpr float F8_SX = 8.f, F8_SH = 8.f, F8_SW = 64.f;
__device__ __forceinline__ unsigned pk4_fp8(float a, float b, float c, float d) {
    a = __builtin_amdgcn_fmed3f(a, -448.f, 448.f); b = __builtin_amdgcn_fmed3f(b, -448.f, 448.f); c = __builtin_amdgcn_fmed3f(c, -448.f, 448.f); d = __builtin_amdgcn_fmed3f(d, -448.f, 448.f);
    int w = __builtin_amdgcn_cvt_pk_fp8_f32(a, b, 0, false); w = __builtin_amdgcn_cvt_pk_fp8_f32(c, d, w, true); return (unsigned)w; }
__device__ __forceinline__ unsigned pk4_i8(float a, float b, float c, float d) {
    const int ia = __float2int_rn(__builtin_amdgcn_fmed3f(a, -127.f, 127.f)), ib = __float2int_rn(__builtin_amdgcn_fmed3f(b, -127.f, 127.f)),
              ic = __float2int_rn(__builtin_amdgcn_fmed3f(c, -127.f, 127.f)), id = __float2int_rn(__builtin_amdgcn_fmed3f(d, -127.f, 127.f));
    return (unsigned)(ia & 255) | ((unsigned)(ib & 255) << 8) | ((unsigned)(ic & 255) << 16) | ((unsigned)id << 24); }
__device__ __forceinline__ unsigned pk4_i8m(float a, float b, float c, float d) {
    const unsigned ua = __builtin_bit_cast(unsigned, a + 12582912.f), ub = __builtin_bit_cast(unsigned, b + 12582912.f), uc = __builtin_bit_cast(unsigned, c + 12582912.f), ud = __builtin_bit_cast(unsigned, d + 12582912.f);
    return (ua & 255u) | ((ub & 255u) << 8) | ((uc & 255u) << 16) | (ud << 24); }
__device__ __forceinline__ unsigned short pk2_fp8(float a, float b) { a = __builtin_amdgcn_fmed3f(a, -448.f, 448.f); b = __builtin_amdgcn_fmed3f(b, -448.f, 448.f); return (unsigned short)__builtin_amdgcn_cvt_pk_fp8_f32(a, b, 0, false); }
__device__ __forceinline__ unsigned pk2(float lo, float hi) { const f32x2 v = {lo, hi}; const bf16x2_t b = __builtin_convertvector(v, bf16x2_t); return __builtin_bit_cast(unsigned, b); }
__device__ __forceinline__ unsigned short f2bfh(float f) { return (unsigned short)(pk2(f, f) & 0xffffu); }
__device__ __forceinline__ float bf2f(unsigned short b) { return __builtin_bit_cast(float, ((unsigned)b) << 16); }
__device__ __forceinline__ float bflo(unsigned w) { return __builtin_bit_cast(float, w << 16); }
__device__ __forceinline__ float bfhi(unsigned w) { return __builtin_bit_cast(float, w & 0xffff0000u); }
__device__ __forceinline__ float siluf(float v) { return v * __builtin_amdgcn_rcpf(1.f + __builtin_amdgcn_exp2f(-1.44269504f * v)); }

#define XB_TMO      128
#define XB_XCNT(j)  (256  + 64 * (j))
#define XB_XSUB(j)  (1280 + 64 * (j))
#define XB_XGEN(j)  (2304 + 64 * (j))
#define XB_TOP      3328
#define XB_TOPGEN   3392
#define XCD_BAR_WORDS 3456
#define XB_SPIN_CAP (1u << 20)
__device__ __forceinline__ unsigned xb_ld(unsigned* p)              { return __hip_atomic_load(p, __ATOMIC_RELAXED, __HIP_MEMORY_SCOPE_AGENT); }
__device__ __forceinline__ unsigned xb_add(unsigned* p, unsigned v) { return __hip_atomic_fetch_add(p, v, __ATOMIC_RELAXED, __HIP_MEMORY_SCOPE_AGENT); }
__device__ __forceinline__ unsigned xb_xcc_id() { return (unsigned)__builtin_amdgcn_s_getreg((3 << 11) | 20) & 0xFu; }
#define XB_SPIN(cond, bar) do { unsigned _sp = 0; while (cond) { __builtin_amdgcn_s_sleep(1); \
    if ((++_sp & 255u) == 0u) { if (xb_ld(&(bar)[XB_TMO])) break; if (_sp > XB_SPIN_CAP) { atomicAdd(&(bar)[XB_TMO], 1u); break; } } } } while (0)
struct XcdBarrier { unsigned* bar; unsigned x; volatile LAS unsigned* st; };
__device__ __forceinline__ XcdBarrier xcd_barrier_post(unsigned* bar, volatile LAS unsigned* st) {
    XcdBarrier b; b.bar = bar; b.x = xb_xcc_id(); b.st = st;
    if (threadIdx.x == 0) (void)xb_add(&bar[XB_XCNT(b.x)], 1u);
    return b;
}
__device__ __forceinline__ void xcd_barrier_complete(unsigned* bar, unsigned x, unsigned& nloc, unsigned& nx) {
    const unsigned G = gridDim.x * gridDim.y * gridDim.z;
    unsigned sum, cnt, mine, sp = 0u;
    for (;;) {
        sum = 0u; cnt = 0u; mine = 0u;
#pragma unroll
        for (unsigned j = 0; j < 16; ++j) { const unsigned c = xb_ld(&bar[XB_XCNT(j)]); sum += c; cnt += (c > 0u) ? 1u : 0u; mine = (j == x) ? c : mine; }
        if (sum == G) break;
        __builtin_amdgcn_s_sleep(1);
        if ((++sp & 255u) == 0u) { if (xb_ld(&bar[XB_TMO])) break; if (sp > XB_SPIN_CAP) { atomicAdd(&bar[XB_TMO], 1u); break; } }
    }
    nloc = mine > 0u ? mine : 1u; nx = cnt > 0u ? cnt : 1u;
}
__device__ __forceinline__ void xcd_barrier(const XcdBarrier& b) {
    asm volatile("s_waitcnt vmcnt(0)" ::: "memory");
    __syncthreads();
    if (threadIdx.x == 0) {
        unsigned* bar = b.bar;
        __builtin_amdgcn_s_waitcnt(0);
        unsigned nloc = b.st[0], nx = b.st[1];
        if (nloc == 0u) { xcd_barrier_complete(bar, b.x, nloc, nx); b.st[0] = nloc; b.st[1] = nx; }
        const unsigned old = xb_add(&bar[XB_XSUB(b.x)], 1u);
        const unsigned gen = old / nloc;
        if (old + 1u == (gen + 1u) * nloc) {
            __builtin_amdgcn_fence(__ATOMIC_RELEASE, "agent");
            asm volatile("s_waitcnt vmcnt(0)" ::: "memory");
            const unsigned og = xb_add(&bar[XB_TOP], 1u);
            const unsigned tg = og / nx;
            if (og + 1u == (tg + 1u) * nx) xb_add(&bar[XB_TOPGEN], 1u);
            else XB_SPIN(xb_ld(&bar[XB_TOPGEN]) == tg, bar);
            __builtin_amdgcn_fence(__ATOMIC_ACQUIRE, "agent");
            xb_add(&bar[XB_XGEN(b.x)], 1u);
            asm volatile("s_waitcnt vmcnt(0)" ::: "memory");
        } else {
            XB_SPIN(xb_ld(&bar[XB_XGEN(b.x)]) == gen, bar);
            __builtin_amdgcn_fence(__ATOMIC_ACQUIRE, "agent");
            asm volatile("s_waitcnt vmcnt(0)" ::: "memory");
        }
    }
    __syncthreads();
}

namespace pg8 {
constexpr int BM = 256, BK = 64, HALF = 128, HTB = HALF * BK * 2, STAGE_BYTES = 8 * HTB, NXCD = 8, WGM = 8;
__host__ __device__ __forceinline__ int lds_byte(int r, int c) { const int st = (r >> 4) * 2 + (c >> 5), rr = r & 15, cc = c & 31, ob = rr * 64 + cc * 2; return st * 1024 + (ob ^ (((ob >> 9) & 1) << 5)); }
__host__ __device__ __forceinline__ void stage_rc(int b, int& R, int& C) { const int st = b / 1024, sb = b % 1024, swz = sb ^ (((sb >> 9) & 1) << 5); R = (st >> 1) * 16 + swz / 64; C = (st & 1) * 32 + (swz % 64) / 2; }
__host__ __device__ __forceinline__ int perm32(int rho) { const int n = rho >> 4, i = rho & 15; return 8 * (i >> 2) + 4 * n + (i & 3); }
__device__ __forceinline__ unsigned cvt_pk_bf16(float lo, float hi) { unsigned r; asm volatile("v_cvt_pk_bf16_f32 %0, %1, %2" : "=v"(r) : "v"(lo), "v"(hi)); return r; }

struct Unit { const char* A; const char* B; int pm, pn, aux; };

struct StaticOrder {
    const char* A; const char* Bt; int K, nM, nN, nwg, G, c;
    __device__ void init(const void* A_, const void* Bt_, int M, int N, int K_, int G_, int c_) { A = (const char*)A_; Bt = (const char*)Bt_; K = K_; nM = M / BM; nN = N / BM; nwg = nM * nN; G = G_; c = c_; }
    __device__ __forceinline__ bool next(int i, Unit& u) const {
        const long L = (long)i * G + c; if (L >= nwg) return false;
        int wgid = (int)L; { const int q = nwg / NXCD, r = nwg % NXCD, xcd = wgid % NXCD, off = wgid / NXCD; wgid = (xcd < r ? xcd * (q + 1) : r * (q + 1) + (xcd - r) * q) + off; }
        const int nig = WGM * nN, gid = wgid / nig, fm = gid * WGM, gsz = (nM - fm) < WGM ? (nM - fm) : WGM;
        u.pm = fm + ((wgid % nig) % gsz); u.pn = (wgid % nig) / gsz; u.aux = 0;
        u.A = A + (size_t)u.pm * BM * K * 2; u.B = Bt + (size_t)u.pn * BM * K * 2; return true;
    }
    __device__ __forceinline__ unsigned arow(const Unit&, int r) const { return (unsigned)(r * K) * 2u; }
};

typedef int i32x4 __attribute__((ext_vector_type(4)));
typedef int i32x8 __attribute__((ext_vector_type(8)));
template <class Epi, class Sched, bool ALIGN_EPI, int MODE = 0>
__device__ __forceinline__ void gemm_phase(LAS unsigned char* lds, const int K, const Sched& S, const Epi& E) {
    constexpr bool F8 = MODE == 1;
    const int tid = threadIdx.x, wid = __builtin_amdgcn_readfirstlane(tid >> 6), lane = tid & 63, wr = wid >> 2, wc = wid & 3, fr = lane & 15, fq = lane >> 4;
    const int nt = K / BK;
    int RA[2], CA[2]; unsigned voffB[2];
#pragma unroll
    for (int i = 0; i < 2; ++i) { int R, C; stage_rc(tid * 16 + i * 8192, R, C); const int Rb = Epi::PERM ? ((R & ~31) + perm32(R & 31)) : R;
        RA[i] = R; CA[i] = C; voffB[i] = (unsigned)(Rb * K + C) * 2u; }
    const size_t kstep = (size_t)(BK * 2);
    const size_t hstep = (size_t)HALF * K * 2;
    const unsigned ldsw = (unsigned)wid * 1024u;
    const int aoff = lds_byte(wr * 64 + fr, fq * 8), boff = lds_byte(wc * 32 + fr, fq * 8);
#define PG8_SA(b, h) (((b) * 2 + (h)) * HTB)
#define PG8_SB(b, h) ((4 + (b) * 2 + (h)) * HTB)
#define PG8_STAGE(bufoff, gbase, voff) do { _Pragma("unroll") for (int _i = 0; _i < 2; ++_i) \
        __builtin_amdgcn_global_load_lds((const unsigned*)((const char*)(gbase) + (voff)[_i]), (LAS unsigned*)(lds + (bufoff) + ldsw + _i * 8192), 16, 0, 0); } while (0)
#define PG8_LDA(dst, b, h) do { _Pragma("unroll") for (int m = 0; m < 4; ++m) _Pragma("unroll") for (int k = 0; k < 2; ++k) dst[m][k] = *(const LAS bf16x8*)(lds + PG8_SA(b, h) + aoff + m * 2048 + k * 1024); } while (0)
#define PG8_LDB(dst, b, h) do { _Pragma("unroll") for (int n = 0; n < 2; ++n) _Pragma("unroll") for (int k = 0; k < 2; ++k) dst[n][k] = *(const LAS bf16x8*)(lds + PG8_SB(b, h) + boff + n * 2048 + k * 1024); } while (0)
#define PG8_MMA(ai, bj, At, Bt) do { __builtin_amdgcn_s_setprio(1); _Pragma("unroll") for (int m = 0; m < 4; ++m) _Pragma("unroll") for (int n = 0; n < 2; ++n) { \
        if constexpr (F8) { const i32x8 _b = __builtin_shufflevector(__builtin_bit_cast(i32x4, Bt[n][0]), __builtin_bit_cast(i32x4, Bt[n][1]), 0, 1, 2, 3, 4, 5, 6, 7), \
                                        _a = __builtin_shufflevector(__builtin_bit_cast(i32x4, At[m][0]), __builtin_bit_cast(i32x4, At[m][1]), 0, 1, 2, 3, 4, 5, 6, 7); \
            asm volatile("v_mfma_scale_f32_16x16x128_f8f6f4 %0, %1, %2, %0, %3, %3 op_sel_hi:[0,0,0]" : "+v"(acc[ai][bj][m][n]) : "v"(_b), "v"(_a), "v"(f8sc)); } \
        else if constexpr (MODE == 2) { _Pragma("unroll") for (int k = 0; k < 2; ++k) acc[ai][bj][m][n] = __builtin_bit_cast(f32x4, __builtin_amdgcn_mfma_i32_16x16x64_i8(__builtin_bit_cast(i32x4, Bt[n][k]), __builtin_bit_cast(i32x4, At[m][k]), __builtin_bit_cast(i32x4, acc[ai][bj][m][n]), 0, 0, 0)); } \
        else { _Pragma("unroll") for (int k = 0; k < 2; ++k) acc[ai][bj][m][n] = __builtin_amdgcn_mfma_f32_16x16x32_bf16(Bt[n][k], At[m][k], acc[ai][bj][m][n], 0, 0, 0); } } \
        __builtin_amdgcn_s_setprio(0); } while (0)
#define PG8_WAIT_V(n) asm volatile("s_waitcnt vmcnt(" #n ")" ::: "memory")
#define PG8_WAIT_L(n) asm volatile("s_waitcnt lgkmcnt(" #n ")" ::: "memory")
#define PG8_BAR __builtin_amdgcn_s_barrier()
#define PG8_SCHED __builtin_amdgcn_sched_barrier(0)
    const int f8sc = 0x7f7f7f7f;
    Unit cur, nxt; int ui = 0;
    if (!S.next(0, cur)) return;
    typename Epi::State est; E.pre(est, cur, wr, fr);
    f32x4 acc[2][2][4][2];
#pragma unroll
    for (int a = 0; a < 2; ++a)
#pragma unroll
        for (int b = 0; b < 2; ++b)
#pragma unroll
            for (int m = 0; m < 4; ++m)
#pragma unroll
                for (int n = 0; n < 2; ++n) acc[a][b][m][n] = (f32x4){0.f, 0.f, 0.f, 0.f};
#define PG8_ACC_FENCE() do { if constexpr (F8) { _Pragma("unroll") for (int a = 0; a < 2; ++a) _Pragma("unroll") for (int b = 0; b < 2; ++b) _Pragma("unroll") for (int m = 0; m < 4; ++m) _Pragma("unroll") for (int n = 0; n < 2; ++n) \
        asm volatile("" : "+v"(acc[a][b][m][n])); asm volatile("s_nop 3" ::: "memory"); } } while (0)
    PG8_ACC_FENCE();
    bf16x8 At[4][2], B0[2][2], B1[2][2];
    unsigned vA0[2], vA1[2], nA0[2], nA1[2];
#pragma unroll
    for (int i = 0; i < 2; ++i) { vA0[i] = S.arow(cur, RA[i]) + CA[i] * 2u; vA1[i] = S.arow(cur, HALF + RA[i]) + CA[i] * 2u; nA0[i] = vA0[i]; nA1[i] = vA1[i]; }
    const char* cA = cur.A; const char* cB = cur.B;
    PG8_STAGE(PG8_SB(0, 0), cB, voffB); PG8_STAGE(PG8_SB(0, 1), cB + hstep, voffB); PG8_STAGE(PG8_SA(0, 0), cA, vA0); PG8_STAGE(PG8_SA(0, 1), cA, vA1);
    if (wr == 1) PG8_BAR;
    PG8_WAIT_V(2); PG8_BAR;
    PG8_STAGE(PG8_SB(1, 0), cB + kstep, voffB); PG8_STAGE(PG8_SA(1, 0), cA + kstep, vA0); PG8_STAGE(PG8_SB(1, 1), cB + hstep + kstep, voffB);
    PG8_WAIT_V(6); PG8_BAR;
    for (;;) {
        const bool has_next = S.next(ui + 1, nxt);
        const char* nA = has_next ? nxt.A : cA; const char* nB = has_next ? nxt.B : cB;
        if (has_next) {
#pragma unroll
            for (int i = 0; i < 2; ++i) { nA0[i] = S.arow(nxt, RA[i]) + CA[i] * 2u; nA1[i] = S.arow(nxt, HALF + RA[i]) + CA[i] * 2u; }
        }
        for (int t = 0; t < nt; t += 2) {
            const bool last = (t == nt - 2);
            const char* a1 = cA + (size_t)(t + 1) * kstep;
            const char* a2 = last ? nA : cA + (size_t)(t + 2) * kstep; const char* b2 = last ? nB : cB + (size_t)(t + 2) * kstep;
            const char* a3 = a2 + kstep; const char* b3 = b2 + kstep;
            unsigned w0[2], w1[2];
#pragma unroll
            for (int i = 0; i < 2; ++i) { w0[i] = last ? nA0[i] : vA0[i]; w1[i] = last ? nA1[i] : vA1[i]; }
            PG8_LDB(B0, 0, 0); PG8_LDB(B1, 0, 1); PG8_SCHED; PG8_LDA(At, 0, 0); PG8_STAGE(PG8_SA(1, 1), a1, vA1);
            PG8_WAIT_V(8); PG8_WAIT_L(0); PG8_BAR; PG8_MMA(0, 0, At, B0); PG8_MMA(0, 1, At, B1); PG8_BAR; PG8_SCHED;
            PG8_LDA(At, 0, 1); PG8_STAGE(PG8_SB(0, 0), b2, voffB); PG8_STAGE(PG8_SB(0, 1), b2 + hstep, voffB); PG8_STAGE(PG8_SA(0, 0), a2, w0);
            PG8_WAIT_V(8); PG8_WAIT_L(0); PG8_BAR; PG8_MMA(1, 0, At, B0); PG8_MMA(1, 1, At, B1); PG8_BAR; PG8_SCHED;
            PG8_LDB(B0, 1, 0); PG8_LDB(B1, 1, 1); PG8_SCHED; PG8_LDA(At, 1, 0); PG8_STAGE(PG8_SA(0, 1), a2, w1);
            PG8_WAIT_V(8); PG8_WAIT_L(0); PG8_BAR; PG8_MMA(0, 0, At, B0); PG8_MMA(0, 1, At, B1); PG8_BAR; PG8_SCHED;
            PG8_LDA(At, 1, 1); PG8_STAGE(PG8_SB(1, 0), b3, voffB); PG8_STAGE(PG8_SB(1, 1), b3 + hstep, voffB); PG8_STAGE(PG8_SA(1, 0), a3, w0);
            PG8_WAIT_V(8); PG8_WAIT_L(0); PG8_BAR; PG8_MMA(1, 0, At, B0); PG8_MMA(1, 1, At, B1); PG8_BAR; PG8_SCHED;
        }
        if constexpr (ALIGN_EPI) { if (wr == 0) PG8_BAR; }
        if constexpr (F8) { asm volatile("s_nop 15\n\ts_nop 15\n\ts_nop 7" ::: "memory"); __builtin_amdgcn_sched_barrier(0); }
        E(acc, cur, wr, wc, fr, fq, est);
        if (!has_next) break;
        E.pre(est, nxt, wr, fr);
#pragma unroll
        for (int a = 0; a < 2; ++a)
#pragma unroll
            for (int b = 0; b < 2; ++b)
#pragma unroll
                for (int m = 0; m < 4; ++m)
#pragma unroll
                    for (int n = 0; n < 2; ++n) acc[a][b][m][n] = (f32x4){0.f, 0.f, 0.f, 0.f};
        PG8_ACC_FENCE();
        cur = nxt; cA = nA; cB = nB; ++ui;
#pragma unroll
        for (int i = 0; i < 2; ++i) { vA0[i] = nA0[i]; vA1[i] = nA1[i]; }
        if constexpr (ALIGN_EPI) { if (wr == 1) PG8_BAR; }
    }
    PG8_WAIT_V(0);
    if constexpr (!ALIGN_EPI) { if (wr == 0) PG8_BAR; }
    PG8_BAR;
#undef PG8_SA
#undef PG8_ACC_FENCE
#undef PG8_SB
#undef PG8_STAGE
#undef PG8_LDA
#undef PG8_LDB
#undef PG8_MMA
#undef PG8_WAIT_V
#undef PG8_WAIT_L
#undef PG8_BAR
#undef PG8_SCHED
}

struct EpiBf16 {
    static constexpr bool PERM = true;
    bf16* O; int ldc;
    struct State {}; __device__ __forceinline__ void pre(State&, const Unit&, int, int) const {}
    __device__ __forceinline__ void operator()(const f32x4 (&acc)[2][2][4][2], const Unit& u, int wr, int wc, int fr, int fq, const State&) const {
        const int row0 = u.pm * BM + wr * 64 + fr; const int col0 = u.pn * BM + wc * 32 + 8 * fq;
#pragma unroll
        for (int ai = 0; ai < 2; ++ai)
#pragma unroll
            for (int m = 0; m < 4; ++m) { bf16* rowp = O + (size_t)(row0 + ai * HALF + m * 16) * ldc + col0;
#pragma unroll
                for (int bj = 0; bj < 2; ++bj) { const f32x4 v0 = acc[ai][bj][m][0], v1 = acc[ai][bj][m][1];
                    u32x4 w; w.x = cvt_pk_bf16(v0[0], v0[1]); w.y = cvt_pk_bf16(v0[2], v0[3]); w.z = cvt_pk_bf16(v1[0], v1[1]); w.w = cvt_pk_bf16(v1[2], v1[3]);
                    *(u32x4*)(rowp + bj * HALF) = w; } }
    }
};
struct EpiBf16S {
    static constexpr bool PERM = true;
    bf16* O; int ldc; const float* rs;
    struct State { float rsr[2][4]; };
    __device__ __forceinline__ void pre(State& st, const Unit& u, int wr, int fr) const {
        const int row0 = u.pm * BM + wr * 64 + fr;
#pragma unroll
        for (int ai = 0; ai < 2; ++ai)
#pragma unroll
            for (int m = 0; m < 4; ++m) st.rsr[ai][m] = rs[row0 + ai * HALF + m * 16];
    }
    __device__ __forceinline__ void operator()(const f32x4 (&acc)[2][2][4][2], const Unit& u, int wr, int wc, int fr, int fq, const State& st) const {
        const int row0 = u.pm * BM + wr * 64 + fr; const int col0 = u.pn * BM + wc * 32 + 8 * fq;
        const float (&rsr)[2][4] = st.rsr;
#pragma unroll
        for (int ai = 0; ai < 2; ++ai)
#pragma unroll
            for (int m = 0; m < 4; ++m) { bf16* rowp = O + (size_t)(row0 + ai * HALF + m * 16) * ldc + col0; const float r = rsr[ai][m];
#pragma unroll
                for (int bj = 0; bj < 2; ++bj) { const f32x4 v0 = acc[ai][bj][m][0] * r, v1 = acc[ai][bj][m][1] * r;
                    u32x4 w; w.x = cvt_pk_bf16(v0[0], v0[1]); w.y = cvt_pk_bf16(v0[2], v0[3]); w.z = cvt_pk_bf16(v1[0], v1[1]); w.w = cvt_pk_bf16(v1[2], v1[3]);
                    *(u32x4*)(rowp + bj * HALF) = w; } }
    }
};
struct EpiI8S {
    static constexpr bool PERM = true;
    bf16* O; int ldc; const float* f; const unsigned* wmaxbits; unsigned char* iqk8;
    struct State { float rsr[2][4]; };
    __device__ __forceinline__ void pre(State& st, const Unit& u, int wr, int fr) const {
        const int row0 = u.pm * BM + wr * 64 + fr;
        const float sw = __builtin_bit_cast(float, __hip_atomic_load(wmaxbits, __ATOMIC_RELAXED, __HIP_MEMORY_SCOPE_AGENT)) * (1.f / 127.f);
#pragma unroll
        for (int ai = 0; ai < 2; ++ai)
#pragma unroll
            for (int m = 0; m < 4; ++m) st.rsr[ai][m] = f[row0 + ai * HALF + m * 16] * sw;
    }
    __device__ __forceinline__ void operator()(const f32x4 (&acc)[2][2][4][2], const Unit& u, int wr, int wc, int fr, int fq, const State& st) const {
        const int row0 = u.pm * BM + wr * 64 + fr; const int col0 = u.pn * BM + wc * 32 + 8 * fq;
#pragma unroll
        for (int ai = 0; ai < 2; ++ai)
#pragma unroll
            for (int m = 0; m < 4; ++m) { bf16* rowp = O + (size_t)(row0 + ai * HALF + m * 16) * ldc + col0; const float r = st.rsr[ai][m];
#pragma unroll
                for (int bj = 0; bj < 2; ++bj) { const i32x4 i0 = __builtin_bit_cast(i32x4, acc[ai][bj][m][0]), i1 = __builtin_bit_cast(i32x4, acc[ai][bj][m][1]);
                    const int col = col0 + bj * HALF;
                    if (iqk8 && col >= 2176 && col < 2496) { const float r8 = r * 8.f;
                        *(u32x2*)(iqk8 + (size_t)(row0 + ai * HALF + m * 16) * 320 + (col - 2176)) = (u32x2){pk4_fp8((float)i0[0] * r8, (float)i0[1] * r8, (float)i0[2] * r8, (float)i0[3] * r8), pk4_fp8((float)i1[0] * r8, (float)i1[1] * r8, (float)i1[2] * r8, (float)i1[3] * r8)}; }
                    else { u32x4 w; w.x = cvt_pk_bf16((float)i0[0] * r, (float)i0[1] * r); w.y = cvt_pk_bf16((float)i0[2] * r, (float)i0[3] * r); w.z = cvt_pk_bf16((float)i1[0] * r, (float)i1[1] * r); w.w = cvt_pk_bf16((float)i1[2] * r, (float)i1[3] * r);
                        *(u32x4*)(rowp + bj * HALF) = w; } } }
    }
};
struct EpiResF32 {
    static constexpr bool PERM = false;
    const float* base; float* out; int ldc;
    struct State {}; __device__ __forceinline__ void pre(State&, const Unit&, int, int) const {}
    __device__ __forceinline__ void operator()(const f32x4 (&acc)[2][2][4][2], const Unit& u, int wr, int wc, int fr, int fq, const State&) const {
        const int row0 = u.pm * BM + wr * 64 + fr, col0 = u.pn * BM + wc * 32 + 4 * fq;
#pragma unroll
        for (int ai = 0; ai < 2; ++ai)
#pragma unroll
            for (int m = 0; m < 4; ++m) { const size_t off = (size_t)(row0 + ai * HALF + m * 16) * ldc + col0;
#pragma unroll
                for (int bj = 0; bj < 2; ++bj)
#pragma unroll
                    for (int n = 0; n < 2; ++n) { const f32x4 bs = *(const f32x4*)(base + off + bj * HALF + n * 16); *(f32x4*)(out + off + bj * HALF + n * 16) = bs + acc[ai][bj][m][n]; } }
    }
};

struct EpiResXB {
    static constexpr bool PERM = true;
    const float* srcf; const bf16* srcb; bf16* xb; unsigned char* xb8; float ascale;
    struct State {}; __device__ __forceinline__ void pre(State&, const Unit&, int, int) const {}
    __device__ __forceinline__ void operator()(const f32x4 (&acc)[2][2][4][2], const Unit& u, int wr, int wc, int fr, int fq, const State&) const {
        const int row0 = u.pm * BM + wr * 64 + fr, col0 = u.pn * BM + wc * 32 + 8 * fq;
#pragma unroll
        for (int ai = 0; ai < 2; ++ai)
#pragma unroll
            for (int m = 0; m < 4; ++m) { const size_t off = (size_t)(row0 + ai * HALF + m * 16) * DM + col0;
#pragma unroll
                for (int bj = 0; bj < 2; ++bj) { f32x4 a0, a1;
                    if (srcf) { a0 = *(const f32x4*)(srcf + off + bj * HALF); a1 = *(const f32x4*)(srcf + off + bj * HALF + 4); }
                    else { const u32x4 v = *(const u32x4*)(srcb + off + bj * HALF); a0 = (f32x4){bflo(v.x), bfhi(v.x), bflo(v.y), bfhi(v.y)}; a1 = (f32x4){bflo(v.z), bfhi(v.z), bflo(v.w), bfhi(v.w)}; }
                    a0 += acc[ai][bj][m][0] * ascale; a1 += acc[ai][bj][m][1] * ascale;
                    *(u32x4*)(xb + off + bj * HALF) = (u32x4){pk2(a0[0], a0[1]), pk2(a0[2], a0[3]), pk2(a1[0], a1[1]), pk2(a1[2], a1[3])};
                    a0 *= F8_SX; a1 *= F8_SX;
                    *(u32x2*)(xb8 + off + bj * HALF) = (u32x2){pk4_fp8(a0[0], a0[1], a0[2], a0[3]), pk4_fp8(a1[0], a1[1], a1[2], a1[3])}; } }
    }
};

struct MoeOrder {
    const char* Abase; const char* Bbase; size_t bstride; int K, G, c, tile_lo, tile_hi; const LAS int* ptile; const LAS int* cntv; const int* list; bool gather;
    __device__ __forceinline__ bool next(int i, Unit& u) const {
        const int NT = tile_hi - tile_lo; int tile, pn;
        if ((G & 7) == 0 && G >= 32) {
            const int x = c & 7, sl = c >> 3, per = G >> 3, TPX = (NT + 7) >> 3;
            const int lu = i * per + sl, lt = lu >> 2; pn = lu & 3;
            tile = tile_lo + x * TPX + lt;
            if (lt >= TPX || tile >= tile_hi) return false;
        } else {
            const long Lq = (long)i * G + c; if (Lq >= (long)NT * 4) return false;
            tile = tile_lo + (int)(Lq >> 2); pn = (int)(Lq & 3);
        }
        int e = 0;
#pragma unroll
        for (int st = 32; st >= 1; st >>= 1) { const int k = e + st; if (k < 64 && tile >= __builtin_amdgcn_readfirstlane(ptile[k])) e = k; }
        const int j = tile - __builtin_amdgcn_readfirstlane(ptile[e]);
        u.pm = tile; u.pn = pn; u.aux = e | (j << 6);
        u.A = gather ? Abase : Abase + (size_t)tile * BM * K * 2; u.B = Bbase + (size_t)(e & 31) * bstride + (size_t)pn * BM * K * 2; return true;
    }
    __device__ __forceinline__ unsigned arow(const Unit& u, int r) const {
        if (!gather) return (unsigned)(r * K) * 2u;
        const int e = u.aux & 63, pos = (u.aux >> 6) * 256 + r; const int cn = cntv[e];
        const int tok = pos < cn ? list[(size_t)e * 65536 + pos] : 0;
        return (unsigned)tok * (unsigned)(K * 2);
    }
};
struct EpiSwiGLU {
    static constexpr bool PERM = true;
    unsigned char* H; const float* rl; const LAS int* cntv;
    struct State { float rsr[2][4]; };
    __device__ __forceinline__ void pre(State& st, const Unit& u, int wr, int fr) const {
        const int e = u.aux & 63, j = u.aux >> 6; const int cn = cntv[e];
#pragma unroll
        for (int ai = 0; ai < 2; ++ai)
#pragma unroll
            for (int m = 0; m < 4; ++m) { const int pos = j * 256 + ai * HALF + wr * 64 + m * 16 + fr; st.rsr[ai][m] = rl[(size_t)e * 65536 + (pos < cn ? pos : 0)]; }
    }
    __device__ __forceinline__ void operator()(const f32x4 (&acc)[2][2][4][2], const Unit& u, int wr, int wc, int fr, int fq, const State& st) const {
        const int row0 = u.pm * BM + wr * 64 + fr; const int col0 = u.pn * 128 + wc * 32 + 8 * fq;
        const float (&rsr)[2][4] = st.rsr;
#pragma unroll
        for (int ai = 0; ai < 2; ++ai)
#pragma unroll
            for (int m = 0; m < 4; ++m) { unsigned char* rowp = H + (size_t)(row0 + ai * HALF + m * 16) * 512 + col0;
                const float rs = rsr[ai][m] * (1.f / (F8_SX * F8_SW));
                const f32x4 g0 = acc[ai][0][m][0] * rs, g1 = acc[ai][0][m][1] * rs, u0 = acc[ai][1][m][0] * rs, u1 = acc[ai][1][m][1] * rs;
                float h[8];
#pragma unroll
                for (int q = 0; q < 4; ++q) { h[q] = g0[q] * __builtin_amdgcn_rcpf(1.f + __builtin_amdgcn_exp2f(-1.44269504f * g0[q])) * u0[q]; h[4 + q] = g1[q] * __builtin_amdgcn_rcpf(1.f + __builtin_amdgcn_exp2f(-1.44269504f * g1[q])) * u1[q]; }
                *(u32x2*)rowp = (u32x2){pk4_fp8(h[0] * F8_SH, h[1] * F8_SH, h[2] * F8_SH, h[3] * F8_SH), pk4_fp8(h[4] * F8_SH, h[5] * F8_SH, h[6] * F8_SH, h[7] * F8_SH)}; }
    }
};
template <bool FINAL> struct EpiScatter {
    static constexpr bool PERM = true;
    bf16* xb; float* out; const int* list; const float* wl; const LAS int* cntv;
    struct State { int tok[2][4]; float wg[2][4]; };
    __device__ __forceinline__ void pre(State& st, const Unit& u, int wr, int fr) const {
        const int e = u.aux & 63, j = u.aux >> 6; const int cn = cntv[e];
#pragma unroll
        for (int ai = 0; ai < 2; ++ai)
#pragma unroll
            for (int m = 0; m < 4; ++m) { const int pos = j * 256 + ai * HALF + wr * 64 + m * 16 + fr; const int pc = pos < cn ? pos : 0;
                st.tok[ai][m] = list[(size_t)e * 65536 + pc]; st.wg[ai][m] = wl[(size_t)e * 65536 + pc] * (1.f / (F8_SH * F8_SW)); }
    }
    __device__ __forceinline__ void operator()(const f32x4 (&acc)[2][2][4][2], const Unit& u, int wr, int wc, int fr, int fq, const State& st) const {
        const int e = u.aux & 63, j = u.aux >> 6; const int cn = cntv[e];
        const int col0 = u.pn * BM + wc * 32 + 8 * fq;
        const int (&tok)[2][4] = st.tok; const float (&wg)[2][4] = st.wg; bool ok[2][4];
#pragma unroll
        for (int ai = 0; ai < 2; ++ai)
#pragma unroll
            for (int m = 0; m < 4; ++m) ok[ai][m] = j * 256 + ai * HALF + wr * 64 + m * 16 + fr < cn;
#pragma unroll
        for (int ai = 0; ai < 2; ++ai) {
            u32x4 v[4][2];
#pragma unroll
            for (int m = 0; m < 4; ++m)
#pragma unroll
                for (int bj = 0; bj < 2; ++bj) v[m][bj] = *(const u32x4*)(xb + (size_t)tok[ai][m] * DM + col0 + bj * HALF);
#pragma unroll
            for (int m = 0; m < 4; ++m) { const size_t off = (size_t)tok[ai][m] * DM + col0;
#pragma unroll
                for (int bj = 0; bj < 2; ++bj) { const u32x4 x = v[m][bj];
                    const f32x4 a0 = (f32x4){bflo(x.x), bfhi(x.x), bflo(x.y), bfhi(x.y)} + wg[ai][m] * acc[ai][bj][m][0], a1 = (f32x4){bflo(x.z), bfhi(x.z), bflo(x.w), bfhi(x.w)} + wg[ai][m] * acc[ai][bj][m][1];
                    if (ok[ai][m]) {
                        if (FINAL) { *(f32x4*)(out + off + bj * HALF) = a0; *(f32x4*)(out + off + bj * HALF + 4) = a1; }
                        else *(u32x4*)(xb + off + bj * HALF) = (u32x4){pk2(a0[0], a0[1]), pk2(a0[2], a0[3]), pk2(a1[0], a1[1]), pk2(a1[2], a1[3])}; } } }
        }
    }
};
}

struct Frame {
    LAS unsigned char* lds;
    volatile LAS unsigned* MISC;
    gu32* ctl;
    int tid, lane, wave, G, bid;
    float* out; unsigned char* ws;
};
struct Args { const float* in[31]; float* out; unsigned char* ws; int ph_lo, ph_hi, rep, pad; };
#ifndef REP_PART
#define REP_PART 0
#endif
#ifndef REP_PHASE
#define REP_PHASE -1
#endif
#define NREP(k) ((REP_PHASE == (k)) ? args.rep : 1)
__device__ __forceinline__ float wave_sum(float v) {
#pragma unroll
    for (int o = 1; o < 64; o <<= 1) v += __shfl_xor(v, o);
    return v;
}

template <class Map, int F8OUT = 0>
__device__ __forceinline__ void transpose_item(const float* W, int K, int pitch, int col0, int ncols, bf16* WT, LAS float* scr, int item, int lane, Map dmap, const float* gk = nullptr, float oscale = 1.f) {
    const int nblk = (ncols + 63) / 64, kb = item / nblk, nb = item % nblk, k0 = 64 * kb, n0 = 64 * nb;
    const int nn = n0 + lane;
    float v[64];
#pragma unroll
    for (int kk = 0; kk < 64; ++kk) v[kk] = (nn < ncols) ? W[(size_t)(k0 + kk) * pitch + col0 + nn] : 0.f;
#pragma unroll
    for (int kk = 0; kk < 64; ++kk) scr[kk * 65 + lane] = gk ? v[kk] * gk[k0 + kk] : v[kk];
    LDS_WAIT(); asm volatile("" ::: "memory");
    const int c = lane & 7;
#pragma unroll
    for (int j = 0; j < 8; ++j) { const int n = (lane >> 3) + 8 * j; const LAS float* s = scr + (8 * c) * 65 + n;
        if (F8OUT == 2) { const u32x2 o8 = (u32x2){pk4_i8(s[0 * 65] * oscale, s[1 * 65] * oscale, s[2 * 65] * oscale, s[3 * 65] * oscale), pk4_i8(s[4 * 65] * oscale, s[5 * 65] * oscale, s[6 * 65] * oscale, s[7 * 65] * oscale)};
            if (n0 + n < ncols) *(u32x2*)((unsigned char*)WT + (size_t)dmap(n0 + n) * K + k0 + 8 * c) = o8; }
        else if (F8OUT == 1) { const u32x2 o8 = (u32x2){pk4_fp8(s[0 * 65] * F8_SW, s[1 * 65] * F8_SW, s[2 * 65] * F8_SW, s[3 * 65] * F8_SW), pk4_fp8(s[4 * 65] * F8_SW, s[5 * 65] * F8_SW, s[6 * 65] * F8_SW, s[7 * 65] * F8_SW)};
            if (n0 + n < ncols) *(u32x2*)((unsigned char*)WT + (size_t)dmap(n0 + n) * K + k0 + 8 * c) = o8; }
        else { u32x4 o; o.x = pk2(s[0 * 65], s[1 * 65]); o.y = pk2(s[2 * 65], s[3 * 65]); o.z = pk2(s[4 * 65], s[5 * 65]); o.w = pk2(s[6 * 65], s[7 * 65]);
            if (n0 + n < ncols) *(u32x4*)(WT + (size_t)dmap(n0 + n) * K + k0 + 8 * c) = o; } }
    LDS_WAIT(); asm volatile("" ::: "memory");
}
struct MapId { int off; __device__ int operator()(int n) const { return n + off; } };
struct MapEven { __device__ int operator()(int c) const {
    if (c < 1536) return c; if (c < 1544) return EDT + (c - 1536); if (c < 2056) return EQ + (c - 1544); if (c < 2120) return EK + (c - 2056);
    if (c < 2184) return EV + (c - 2120); if (c < 2440) return EIQ + (c - 2184); if (c < 2504) return EIK + (c - 2440); return EIW + (c - 2504); } };
struct MapGU { int half; __device__ int operator()(int n) const { return 256 * (n >> 7) + 128 * half + (n & 127); } };

__device__ __forceinline__ void rms_row_to_bf16(const float* xrow, const float* gain, bf16* orow, int lane) {
    const f32x4* xr = (const f32x4*)xrow + lane; const f32x4* gr = (const f32x4*)gain + lane;
    f32x4 v[4]; float s = 0.f;
#pragma unroll
    for (int j = 0; j < 4; ++j) { v[j] = xr[64 * j]; s += (v[j].x * v[j].x + v[j].y * v[j].y) + (v[j].z * v[j].z + v[j].w * v[j].w); }
    const float rs = 1.f / sqrtf(wave_sum(s) * (1.f / DM) + NORM_EPS);
    unsigned long long* o8 = (unsigned long long*)orow + lane;
#pragma unroll
    for (int j = 0; j < 4; ++j) { const f32x4 g = gr[64 * j]; o8[64 * j] = (unsigned long long)pk2(v[j].x * rs * g.x, v[j].y * rs * g.y) | ((unsigned long long)pk2(v[j].z * rs * g.z, v[j].w * rs * g.w) << 32); }
}

template <int NR> __device__ __forceinline__ void rms_rows_to_bf16(const float* xrow0, size_t xstride, const float* gain, bf16* orow0, size_t ostride, int lane) {
    f32x4 v[NR][4]; float s[NR];
#pragma unroll
    for (int q = 0; q < NR; ++q) { const f32x4* xr = (const f32x4*)(xrow0 + q * xstride) + lane;
#pragma unroll
        for (int j = 0; j < 4; ++j) v[q][j] = xr[64 * j]; }
#pragma unroll
    for (int q = 0; q < NR; ++q) { s[q] = 0.f;
#pragma unroll
        for (int j = 0; j < 4; ++j) s[q] += (v[q][j].x * v[q][j].x + v[q][j].y * v[q][j].y) + (v[q][j].z * v[q][j].z + v[q][j].w * v[q][j].w); }
#pragma unroll
    for (int o = 1; o < 64; o <<= 1) {
#pragma unroll
        for (int q = 0; q < NR; ++q) s[q] += __shfl_xor(s[q], o); }
    const f32x4* gr = (const f32x4*)gain + lane;
#pragma unroll
    for (int q = 0; q < NR; ++q) { const float rs = 1.f / sqrtf(s[q] * (1.f / DM) + NORM_EPS); unsigned long long* o8 = (unsigned long long*)(orow0 + q * ostride) + lane;
#pragma unroll
        for (int j = 0; j < 4; ++j) { const f32x4 g = gr[64 * j]; o8[64 * j] = (unsigned long long)pk2(v[q][j].x * rs * g.x, v[q][j].y * rs * g.y) | ((unsigned long long)pk2(v[q][j].z * rs * g.z, v[q][j].w * rs * g.w) << 32); } }
}
template <int NR> __device__ __forceinline__ void rows_to_i8(const float* xrow0, size_t xstride, unsigned char* orow0, size_t ostride, float* f0, size_t fstride, int lane) {
    f32x4 v[NR][4]; float s[NR], mx[NR];
#pragma unroll
    for (int q = 0; q < NR; ++q) { const f32x4* xr = (const f32x4*)(xrow0 + q * xstride) + lane;
#pragma unroll
        for (int j = 0; j < 4; ++j) v[q][j] = xr[64 * j]; }
#pragma unroll
    for (int q = 0; q < NR; ++q) { s[q] = 0.f; mx[q] = 0.f;
#pragma unroll
        for (int j = 0; j < 4; ++j) { s[q] += (v[q][j].x * v[q][j].x + v[q][j].y * v[q][j].y) + (v[q][j].z * v[q][j].z + v[q][j].w * v[q][j].w);
            mx[q] = fmaxf(fmaxf(mx[q], fmaxf(fabsf(v[q][j].x), fabsf(v[q][j].y))), fmaxf(fabsf(v[q][j].z), fabsf(v[q][j].w))); } }
#pragma unroll
    for (int o = 1; o < 64; o <<= 1) {
#pragma unroll
        for (int q = 0; q < NR; ++q) { s[q] += __shfl_xor(s[q], o); mx[q] = fmaxf(mx[q], __shfl_xor(mx[q], o)); } }
#pragma unroll
    for (int q = 0; q < NR; ++q) { unsigned* o4 = (unsigned*)(orow0 + q * ostride) + lane;
        const float inv = mx[q] > 0.f ? 127.f / mx[q] : 0.f;
        if (lane == 0) f0[q * fstride] = (mx[q] * (1.f / 127.f)) / sqrtf(s[q] * (1.f / DM) + NORM_EPS);
#pragma unroll
        for (int j = 0; j < 4; ++j) o4[64 * j] = pk4_i8(v[q][j].x * inv, v[q][j].y * inv, v[q][j].z * inv, v[q][j].w * inv); }
}
template <int NR> __device__ __forceinline__ void rms_rowsb_to_bf16(const bf16* xrow0, const float* gain, bf16* orow0, int lane) {
    u32x2 raw[NR][4]; float s[NR];
#pragma unroll
    for (int q = 0; q < NR; ++q) { const u32x2* xr = (const u32x2*)(xrow0 + (size_t)q * DM) + lane;
#pragma unroll
        for (int j = 0; j < 4; ++j) raw[q][j] = xr[64 * j]; }
#pragma unroll
    for (int q = 0; q < NR; ++q) { s[q] = 0.f;
#pragma unroll
        for (int j = 0; j < 4; ++j) { const float a = bflo(raw[q][j].x), b = bfhi(raw[q][j].x), c = bflo(raw[q][j].y), d = bfhi(raw[q][j].y); s[q] += (a * a + b * b) + (c * c + d * d); } }
#pragma unroll
    for (int o = 1; o < 64; o <<= 1) {
#pragma unroll
        for (int q = 0; q < NR; ++q) s[q] += __shfl_xor(s[q], o); }
    const f32x4* gr = (const f32x4*)gain + lane;
#pragma unroll
    for (int q = 0; q < NR; ++q) { const float rs = 1.f / sqrtf(s[q] * (1.f / DM) + NORM_EPS); unsigned long long* o8 = (unsigned long long*)(orow0 + (size_t)q * DM) + lane;
#pragma unroll
        for (int j = 0; j < 4; ++j) { const f32x4 g = gr[64 * j];
            o8[64 * j] = (unsigned long long)pk2(bflo(raw[q][j].x) * rs * g.x, bfhi(raw[q][j].x) * rs * g.y) | ((unsigned long long)pk2(bflo(raw[q][j].y) * rs * g.z, bfhi(raw[q][j].y) * rs * g.w) << 32); } }
}
__device__ __forceinline__ void rms_rowb_to_bf16(const bf16* xrow, const float* gain, bf16* orow, int lane) {
    const u32x2* xr = (const u32x2*)xrow + lane; const f32x4* gr = (const f32x4*)gain + lane;
    f32x4 v[4]; float s = 0.f;
#pragma unroll
    for (int j = 0; j < 4; ++j) { const u32x2 q = xr[64 * j]; v[j] = (f32x4){bflo(q.x), bfhi(q.x), bflo(q.y), bfhi(q.y)}; s += (v[j].x * v[j].x + v[j].y * v[j].y) + (v[j].z * v[j].z + v[j].w * v[j].w); }
    const float rs = 1.f / sqrtf(wave_sum(s) * (1.f / DM) + NORM_EPS);
    unsigned long long* o8 = (unsigned long long*)orow + lane;
#pragma unroll
    for (int j = 0; j < 4; ++j) { const f32x4 g = gr[64 * j]; o8[64 * j] = (unsigned long long)pk2(v[j].x * rs * g.x, v[j].y * rs * g.y) | ((unsigned long long)pk2(v[j].z * rs * g.z, v[j].w * rs * g.w) << 32); }
}
__device__ __forceinline__ void p_wmax(Frame& F, const Args& A) {
    const int gt = F.bid * NTHR + F.tid, NT_ = F.G * NTHR;
    { const f32x4* W = (const f32x4*)A.in[4]; const float* g = A.in[2];
      float m = 0.f;
#pragma unroll 8
      for (int v = gt; v < 1024 * 627; v += NT_) { const int k = v / 627; const f32x4 w = W[v]; const float gk = fabsf(g[k]);
          m = fmaxf(m, fmaxf(fmaxf(fabsf(w.x), fabsf(w.y)), fmaxf(fabsf(w.z), fabsf(w.w))) * gk); }
#pragma unroll
      for (int o = 1; o < 64; o <<= 1) m = fmaxf(m, __shfl_xor(m, o));
      if (F.lane == 0) __hip_atomic_fetch_max((unsigned*)(F.ctl + CW_WMAX), __builtin_bit_cast(unsigned, m), __ATOMIC_RELAXED, __HIP_MEMORY_SCOPE_AGENT); }
    { const f32x4* W1 = (const f32x4*)A.in[14]; const float* g1 = A.in[2] + DM;
      float m1 = 0.f;
#pragma unroll 8
      for (int v = gt; v < 1024 * 640; v += NT_) { const int k = v / 640, c = v - k * 640; const f32x4 w = W1[(size_t)k * 646 + c]; const float gk = fabsf(g1[k]);
          m1 = fmaxf(m1, fmaxf(fmaxf(fabsf(w.x), fabsf(w.y)), fmaxf(fabsf(w.z), fabsf(w.w))) * gk); }
#pragma unroll
      for (int o = 1; o < 64; o <<= 1) m1 = fmaxf(m1, __shfl_xor(m1, o));
      if (F.lane == 0) __hip_atomic_fetch_max((unsigned*)(F.ctl + CW_WMAX + 1), __builtin_bit_cast(unsigned, m1), __ATOMIC_RELAXED, __HIP_MEMORY_SCOPE_AGENT); }
}
__device__ __forceinline__ void p_prologue(Frame& F, const Args& A) {
    LAS float* scr = (LAS float*)(F.lds + F.wave * 17408);
    const int gw = F.bid * NWAVES + F.wave, NGW = F.G * NWAVES;
    bf16* Wie = (bf16*)(F.ws + WS_WIE); bf16* Woe = (bf16*)(F.ws + WS_WOE);
    constexpr int I_IE = 16 * 40, I_OE = 16 * 16;
    const float wmaxv = __builtin_bit_cast(float, __hip_atomic_load((unsigned*)(F.ctl + CW_WMAX), __ATOMIC_RELAXED, __HIP_MEMORY_SCOPE_AGENT));
    const float wq = wmaxv > 0.f ? 127.f / wmaxv : 0.f;
    const float wmaxv1 = __builtin_bit_cast(float, __hip_atomic_load((unsigned*)(F.ctl + CW_WMAX + 1), __ATOMIC_RELAXED, __HIP_MEMORY_SCOPE_AGENT));
    const float wq1 = wmaxv1 > 0.f ? 127.f / wmaxv1 : 0.f;
    for (int it = gw; it < I_IE + I_OE; it += NGW) {
        if (it < I_IE) transpose_item<MapEven, 2>(A.in[4], 1024, 2508, 0, 2508, Wie, scr, it, F.lane, MapEven(), A.in[2], wq);
        else transpose_item<MapId, 1>(A.in[13], 1024, 1024, 0, 1024, Woe, scr, it - I_IE, F.lane, MapId{0});
    }
    {
        bf16* Wgu = (bf16*)(F.ws + WS_WGU); bf16* Wd = (bf16*)(F.ws + WS_WD); bf16* WR = (bf16*)(F.ws + WS_WR);
        (void)Wgu; (void)Wd;
        for (int it = gw; it < 2 * 5 * 16; it += NGW) { const int l = it / 80, r = it % 80, q = r / 16, kb = r % 16;
            if (q == 0) transpose_item(A.in[26] + (size_t)l * 1024 * 4, 1024, 4, 0, 4, WR + (size_t)l * 48 * 1024, scr, kb, F.lane, MapId{0}, A.in[3] + l * DM);
            else transpose_item(A.in[27] + (size_t)(l * 4 + q - 1) * 1024 * 8, 1024, 8, 0, 8, WR + (size_t)l * 48 * 1024, scr, kb, F.lane, MapId{4 + 8 * (q - 1)}, A.in[3] + l * DM); }
        for (int i = gw * 64 + F.lane; i < 2 * 12 * 1024 / 8; i += NGW * 64) { const int l = i / (12 * 128), o = i % (12 * 128); *(u32x4*)(WR + (size_t)l * 48 * 1024 + 36 * 1024 + (size_t)o * 8) = (u32x4){0u, 0u, 0u, 0u}; }
    }
    {
        bf16* Wio = (bf16*)(F.ws + WS_WIO); bf16* Woo = (bf16*)(F.ws + WS_WOO); bf16* WGL = (bf16*)(F.ws + WS_WGL);
        bf16* W1K = (bf16*)(F.ws + WS_W1K); bf16* W1V = (bf16*)(F.ws + WS_W1V); bf16* W2 = (bf16*)(F.ws + WS_W2);
        constexpr int J0 = 16 * 40, J1 = J0 + 16, J2 = J1 + 16 * 16, J3 = J2 + 64 * 2, J4 = J3 + 64 * 2, J5 = J4 + 2 * 2, J6 = J5 + 2 * 2;
        for (int it = gw; it < J6; it += NGW) {
            if (it < J0) transpose_item<MapId, 2>(A.in[14], 1024, 2584, 0, 2560, Wio, scr, it, F.lane, MapId{0}, A.in[2] + DM, wq1);
            else if (it < J1) transpose_item(A.in[14], 1024, 2584, 2560, 24, WGL, scr, it - J0, F.lane, MapId{0}, A.in[2] + DM);
            else if (it < J2) transpose_item<MapId, 1>(A.in[25], 1024, 1024, 0, 1024, Woo, scr, it - J1, F.lane, MapId{0});
            else if (it < J3) transpose_item(A.in[21], 4096, 128, 0, 128, W1K, scr, it - J2, F.lane, MapId{0});
            else if (it < J4) transpose_item(A.in[23], 4096, 128, 0, 128, W1V, scr, it - J3, F.lane, MapId{0});
            else if (it < J5) transpose_item(A.in[22], 128, 128, 0, 128, W2, scr, it - J4, F.lane, MapId{0});
            else transpose_item(A.in[24], 128, 128, 0, 128, W2 + 128 * 128, scr, it - J5, F.lane, MapId{0});
        }
        for (int i = gw * 64 + F.lane; i < 8 * 1024 / 8; i += NGW * 64) *(u32x4*)(WGL + 24 * 1024 + (size_t)i * 8) = (u32x4){0u, 0u, 0u, 0u};
    }
    for (int i = gw * 64 + F.lane; i < 52 * 1024 / 16; i += NGW * 64) *((u32x4*)((unsigned char*)Wie + (size_t)2508 * 1024) + i) = (u32x4){0u, 0u, 0u, 0u};
    bf16* HB = (bf16*)(F.ws + WS_HB);
    { unsigned char* X8 = (unsigned char*)HB; float* FR = (float*)(F.ws + WS_RS);
      for (int m = gw; m < MTOK; m += 4 * NGW) rows_to_i8<4>(A.in[0] + (size_t)m * DM, (size_t)NGW * DM, X8 + (size_t)m * DM, (size_t)NGW * DM, FR + m, (size_t)NGW, F.lane); }
}

constexpr int SP = 136;
constexpr int L_CS = 0, L_BS = 34816, L_BT = 69632, L_XT = 104448, L_XS = 113152, L_ST = 121856, L_AC = 139264, L_DT = 139776, L_CW = 140288;
__device__ __forceinline__ bf16x8 lds_frag(LAS unsigned char* base, int row, int col) { return *(const LAS bf16x8*)(base + (row * SP + col) * 2); }

constexpr int S_CS = 0, S_BS = 34816, S_BT = 69632, S_XT = 104448, S_XS = 121856, S_AC = 139264, S_DT = 141312;
__device__ __forceinline__ void p_ssd1(Frame& F, const Args& A) {
    bf16* U = (bf16*)(F.ws + WS_U); bf16* YD = (bf16*)(F.ws + WS_HB); bf16* CS = (bf16*)(F.ws + WS_XB); bf16* CC = (bf16*)(F.ws + WS_CC); float* AC = (float*)(F.ws + WS_AC);
    const int w = F.wave;
    { const int tid = F.tid;
    for (int r0 = F.bid * 64; r0 < MTOK; r0 += F.G * 64) {
        const int row = r0 + (tid >> 3), c8 = (tid & 7) * 8;
        bf16* p = U + (size_t)row * LDE + EK + c8;
        const u32x4 v = *(const u32x4*)p; float f[8] = {bflo(v.x), bfhi(v.x), bflo(v.y), bfhi(v.y), bflo(v.z), bfhi(v.z), bflo(v.w), bfhi(v.w)};
        float s = 0.f;
#pragma unroll
        for (int j = 0; j < 8; ++j) s += f[j] * f[j];
        s += __shfl_xor(s, 1); s += __shfl_xor(s, 2); s += __shfl_xor(s, 4);
        const float rs = 1.f / sqrtf(s * (1.f / 64.f) + NORM_EPS); const float* g = A.in[12] + c8;
        const float r8 = rs * 8.f;
        *(u32x2*)(F.ws + WS_K8 + (size_t)row * 64 + c8) = (u32x2){pk4_fp8(f[0] * r8 * g[0], f[1] * r8 * g[1], f[2] * r8 * g[2], f[3] * r8 * g[3]), pk4_fp8(f[4] * r8 * g[4], f[5] * r8 * g[5], f[6] * r8 * g[6], f[7] * r8 * g[7])};
    } }
    LAS unsigned char* L = F.lds;
    LAS float* acum = (LAS float*)(L + S_AC); LAS float* dtv = (LAS float*)(L + S_DT);
    const float* conv_w = A.in[5]; const float* conv_b = A.in[6];
    for (int unit = F.bid; unit < 1024; unit += F.G) {
        int tid = F.tid, lane = F.lane; asm volatile("" : "+v"(tid), "+v"(lane));
        const int b = unit >> 6, c = (unit >> 1) & 31, g = unit & 1;
        const size_t rowbase = (size_t)b * SEQ + (size_t)c * 128;
        __syncthreads();
        {
            const int hq = tid >> 7, t = tid & 127, h = 4 * g + hq;
            const float dr = bf2f(U[(rowbase + t) * LDE + EDT + h]) + A.in[7][h];
            const float dt = dr > 20.f ? dr : log1pf(__expf(dr));
            float sc = dt * (-__expf(A.in[8][h]));
#pragma unroll
            for (int o = 1; o < 64; o <<= 1) { const float x = __shfl_up(sc, o); if (lane >= o) sc += x; }
            dtv[tid] = dt; acum[tid] = sc;
        }
        {
            const int cg = tid & 15, rr = tid >> 4;
#pragma unroll 1
            for (int T = 0; T < 2; ++T) {
                const int ch0 = (T == 0 ? 512 : 768) + g * 128 + 8 * cg;
                u32x4 raw[7];
#pragma unroll
                for (int j = 0; j < 7; ++j) { const int tl = 4 * rr - 3 + j; raw[j] = (u32x4){0u, 0u, 0u, 0u};
                    if (c > 0 || tl >= 0) raw[j] = *(const u32x4*)(U + (size_t)((long)rowbase + tl) * LDE + 512 + ch0); }
                LAS unsigned char* dst = L + (T == 0 ? S_BS : S_CS);
                unsigned opk[4][4];
#pragma unroll
                for (int e2 = 0; e2 < 4; ++e2) {
                    const float* wp = conv_w + ch0 + 2 * e2;
                    const f32x2 w0 = *(const f32x2*)wp, w1 = *(const f32x2*)(wp + 1024), w2 = *(const f32x2*)(wp + 2048), w3 = *(const f32x2*)(wp + 3072), bb = *(const f32x2*)(conv_b + ch0 + 2 * e2);
                    float lo[7], hi[7];
#pragma unroll
                    for (int j = 0; j < 7; ++j) { lo[j] = bflo(raw[j][e2]); hi[j] = bfhi(raw[j][e2]); }
                    float ol[4], oh[4];
#pragma unroll
                    for (int q = 0; q < 4; ++q) { ol[q] = siluf(bb.x + w0.x * lo[q] + w1.x * lo[q + 1] + w2.x * lo[q + 2] + w3.x * lo[q + 3]);
                                                  oh[q] = siluf(bb.y + w0.y * hi[q] + w1.y * hi[q + 1] + w2.y * hi[q + 2] + w3.y * hi[q + 3]); opk[q][e2] = pk2(ol[q], oh[q]); }
                    if (T == 0) {
                        *(LAS u32x2*)(L + S_BT + ((8 * cg + 2 * e2) * SP + 4 * rr) * 2) = (u32x2){pk2(ol[0], ol[1]), pk2(ol[2], ol[3])};
                        *(LAS u32x2*)(L + S_BT + ((8 * cg + 2 * e2 + 1) * SP + 4 * rr) * 2) = (u32x2){pk2(oh[0], oh[1]), pk2(oh[2], oh[3])};
                    }
                }
#pragma unroll
                for (int q = 0; q < 4; ++q) { const u32x4 pk = (u32x4){opk[q][0], opk[q][1], opk[q][2], opk[q][3]};
                    *(LAS u32x4*)(dst + ((4 * rr + q) * SP + 8 * cg) * 2) = pk;
                    if (T == 1) *(u32x4*)(CC + ((size_t)((b * 32 + c) * 2 + g) * 128 + 4 * rr + q) * 128 + 8 * cg) = pk; }
            }
        }
        __syncthreads();
        if (w & 1) acum[tid] += acum[tid - lane - 1];
        __syncthreads();
        AC[(rowbase + (tid & 127)) * 8 + 4 * g + (tid >> 7)] = acum[tid];
        const int mt = w >> 1, nh = w & 1, r = lane & 31, hh = lane >> 5;
        f32x16 cb[2];
#pragma unroll
        for (int j = 0; j < 2; ++j) {
            cb[j] = (f32x16){0.f, 0.f, 0.f, 0.f, 0.f, 0.f, 0.f, 0.f, 0.f, 0.f, 0.f, 0.f, 0.f, 0.f, 0.f, 0.f};
            const int s0 = 64 * nh + 32 * j;
            if (s0 <= 32 * mt + 31) {
#pragma unroll
                for (int ks = 0; ks < 8; ++ks) cb[j] = __builtin_amdgcn_mfma_f32_32x32x16_bf16(lds_frag(L + S_BS, s0 + r, 16 * ks + 8 * hh), lds_frag(L + S_CS, 32 * mt + r, 16 * ks + 8 * hh), cb[j], 0, 0, 0);
            }
        }
        __syncthreads();
#pragma unroll 1
        for (int hq = 0; hq < 4; ++hq) {
            const int h = 4 * g + hq;
            int tidq = F.tid, laneq = F.lane; asm volatile("" : "+v"(tidq), "+v"(laneq));
            const int r = laneq & 31, hh = laneq >> 5;
            const LAS float* ac = acum + hq * 128; const LAS float* dv = dtv + hq * 128;
            {
                const int cgx = tidq & 15, rr = tidq >> 4;
                const float* wp = conv_w + h * 64 + 4 * cgx; const float* bp = conv_b + h * 64 + 4 * cgx;
                const float aend = ac[127];
                u32x2 raw[7];
#pragma unroll
                for (int j = 0; j < 7; ++j) { const int tl = 4 * rr - 3 + j; raw[j] = (u32x2){0u, 0u};
                    if (c > 0 || tl >= 0) raw[j] = *(const u32x2*)(U + (size_t)((long)rowbase + tl) * LDE + EXS + h * 64 + 4 * cgx); }
                const f32x4 a4 = *(const LAS f32x4*)(ac + 4 * rr), d4 = *(const LAS f32x4*)(dv + 4 * rr);
                float sc[4];
#pragma unroll
                for (int q = 0; q < 4; ++q) sc[q] = d4[q] * __expf(aend - a4[q]);
                const f32x4 w0 = *(const f32x4*)wp, w1 = *(const f32x4*)(wp + 1024), w2 = *(const f32x4*)(wp + 2048), w3 = *(const f32x4*)(wp + 3072), bb = *(const f32x4*)bp;
#pragma unroll
                for (int ch = 0; ch < 4; ++ch) { float rv[7];
#pragma unroll
                    for (int j = 0; j < 7; ++j) rv[j] = (ch & 1) ? bfhi(raw[j][ch >> 1]) : bflo(raw[j][ch >> 1]);
                    float xv[4];
#pragma unroll
                    for (int q = 0; q < 4; ++q) xv[q] = siluf(bb[ch] + w0[ch] * rv[q] + w1[ch] * rv[q + 1] + w2[ch] * rv[q + 2] + w3[ch] * rv[q + 3]);
                    *(LAS u32x2*)(L + S_XT + ((4 * cgx + ch) * SP + 4 * rr) * 2) = (u32x2){pk2(xv[0], xv[1]), pk2(xv[2], xv[3])};
                    *(LAS u32x2*)(L + S_XS + ((4 * cgx + ch) * SP + 4 * rr) * 2) = (u32x2){pk2(xv[0] * sc[0], xv[1] * sc[1]), pk2(xv[2] * sc[2], xv[3] * sc[3])}; }
            }
            const float dskh = A.in[9][h];
#pragma unroll
            for (int j = 0; j < 2; ++j) { const int s0 = 64 * nh + 32 * j;
                if (s0 <= 32 * mt + 31) {
                    const int t = 32 * mt + r; const float at = ac[t];
#pragma unroll
                    for (int q = 0; q < 4; ++q) { const int sb = s0 + 8 * q + 4 * hh;
                        const f32x4 a4 = *(const LAS f32x4*)(ac + sb), d4 = *(const LAS f32x4*)(dv + sb);
                        float v[4];
#pragma unroll
                        for (int e = 0; e < 4; ++e) { const int sI = sb + e; v[e] = (sI <= t) ? cb[j][4 * q + e] * __expf(at - a4[e]) * d4[e] : 0.f;
                            if (sI == t) v[e] += dskh; }
                        *(LAS u32x2*)(L + S_BS + (t * SP + sb) * 2) = (u32x2){pk2(v[0], v[1]), pk2(v[2], v[3])}; }
                } }
            __syncthreads();
            {
                const int nt = w & 1;
                f32x16 yd = {0.f, 0.f, 0.f, 0.f, 0.f, 0.f, 0.f, 0.f, 0.f, 0.f, 0.f, 0.f, 0.f, 0.f, 0.f, 0.f}, cs = yd;
                for (int ks = 0; ks < 2 * (mt + 1); ++ks) yd = __builtin_amdgcn_mfma_f32_32x32x16_bf16(lds_frag(L + S_XT, 32 * nt + r, 16 * ks + 8 * hh), lds_frag(L + S_BS, 32 * mt + r, 16 * ks + 8 * hh), yd, 0, 0, 0);
                const int mp = w >> 2, nn = w & 3;
#pragma unroll
                for (int ks = 0; ks < 8; ++ks) cs = __builtin_amdgcn_mfma_f32_32x32x16_bf16(lds_frag(L + S_BT, 32 * nn + r, 16 * ks + 8 * hh), lds_frag(L + S_XS, 32 * mp + r, 16 * ks + 8 * hh), cs, 0, 0, 0);
                bf16* yp = YD + (rowbase + 32 * mt + r) * 512 + h * 64 + 32 * nt + 4 * hh;
                bf16* csp = CS + ((size_t)((b * 32 + c) * 8 + h) * 64 + 32 * mp + r) * 128 + 32 * nn + 4 * hh;
#pragma unroll
                for (int q = 0; q < 4; ++q) { *(u32x2*)(yp + 8 * q) = (u32x2){pk2(yd[4 * q], yd[4 * q + 1]), pk2(yd[4 * q + 2], yd[4 * q + 3])};
                                              *(u32x2*)(csp + 8 * q) = (u32x2){pk2(cs[4 * q], cs[4 * q + 1]), pk2(cs[4 * q + 2], cs[4 * q + 3])}; }
            }
            __syncthreads();
        }
    }
}
__device__ __forceinline__ void p_ssd2(Frame& F) {
    const bf16* CS = (const bf16*)(F.ws + WS_XB); bf16* SI = (bf16*)(F.ws + WS_XB + 64 * MiB); const float* AC = (const float*)(F.ws + WS_AC);
    LAS float* decs = (LAS float*)F.lds;
    for (int st = F.bid; st < 256; st += F.G) {
        const int b = st >> 4, h = (st >> 1) & 7, ph = st & 1;
        const int e0 = F.tid * 8, p = 32 * ph + (e0 >> 7), n = e0 & 127;
        __syncthreads();
        if (F.tid < 32) decs[F.tid] = __expf(AC[((size_t)b * SEQ + F.tid * 128 + 127) * 8 + h]);
        float stt[8] = {0.f, 0.f, 0.f, 0.f, 0.f, 0.f, 0.f, 0.f};
        const size_t off0 = ((size_t)(b * 32 * 8 + h) * 64 + p) * 128 + n, cstep = (size_t)8 * 64 * 128;
        u32x4 ring[4];
#pragma unroll
        for (int k = 0; k < 4; ++k) ring[k] = *(const u32x4*)(CS + off0 + (size_t)k * cstep);
        __syncthreads();
#pragma unroll 1
        for (int c4 = 0; c4 < 32; c4 += 4) {
#pragma unroll
            for (int k = 0; k < 4; ++k) { const int c = c4 + k;
                const u32x4 cur = ring[k];
                if (c + 4 < 32) ring[k] = *(const u32x4*)(CS + off0 + (size_t)(c + 4) * cstep);
                *(u32x4*)(SI + off0 + (size_t)c * cstep) = (u32x4){pk2(stt[0], stt[1]), pk2(stt[2], stt[3]), pk2(stt[4], stt[5]), pk2(stt[6], stt[7])};
                const float dec = decs[c];
                stt[0] = stt[0] * dec + bflo(cur.x); stt[1] = stt[1] * dec + bfhi(cur.x); stt[2] = stt[2] * dec + bflo(cur.y); stt[3] = stt[3] * dec + bfhi(cur.y);
                stt[4] = stt[4] * dec + bflo(cur.z); stt[5] = stt[5] * dec + bfhi(cur.z); stt[6] = stt[6] * dec + bflo(cur.w); stt[7] = stt[7] * dec + bfhi(cur.w); }
        }
    }
}
__device__ __forceinline__ void p_ssd3(Frame& F) {
    bf16* U = (bf16*)(F.ws + WS_U); const bf16* YD = (const bf16*)(F.ws + WS_HB); const bf16* SI = (const bf16*)(F.ws + WS_XB + 64 * MiB); const bf16* CC = (const bf16*)(F.ws + WS_CC); const float* AC = (const float*)(F.ws + WS_AC);
    const int w = F.wave;
    for (int unit = F.bid; unit < 2048; unit += F.G) {
        int lane = F.lane; asm volatile("" : "+v"(lane));
        const int b = unit >> 7, c = (unit >> 2) & 31, hp = unit & 3;
        const int h = 2 * hp + (w >> 2), g = h >> 2, tt = w & 3, r = lane & 31, hh = lane >> 5;
        const size_t row = (size_t)b * SEQ + (size_t)c * 128 + 32 * tt + r;
        const bf16* sp = SI + ((size_t)((b * 32 + c) * 8 + h) * 64 + r) * 128 + 8 * hh;
        const bf16* cp = CC + ((size_t)((b * 32 + c) * 2 + g) * 128 + 32 * tt + r) * 128 + 8 * hh;
        bf16x8 s0[8], s1[8], cf[8];
#pragma unroll
        for (int ks = 0; ks < 8; ++ks) { s0[ks] = *(const bf16x8*)(sp + 16 * ks); s1[ks] = *(const bf16x8*)(sp + 32 * 128 + 16 * ks); cf[ks] = *(const bf16x8*)(cp + 16 * ks); }
        const float ea = __expf(AC[row * 8 + h]);
        const bf16* yp = YD + row * 512 + h * 64 + 4 * hh; bf16* zp = U + row * LDE + EZ + h * 64 + 4 * hh;
        u32x2 yv[8], zv[8];
#pragma unroll
        for (int k = 0; k < 8; ++k) { yv[k] = *(const u32x2*)(yp + 32 * (k >> 2) + 8 * (k & 3)); zv[k] = *(const u32x2*)(zp + 32 * (k >> 2) + 8 * (k & 3)); }
        f32x16 a0 = {0.f, 0.f, 0.f, 0.f, 0.f, 0.f, 0.f, 0.f, 0.f, 0.f, 0.f, 0.f, 0.f, 0.f, 0.f, 0.f}, a1 = a0;
#pragma unroll
        for (int ks = 0; ks < 8; ++ks) { a0 = __builtin_amdgcn_mfma_f32_32x32x16_bf16(s0[ks], cf[ks], a0, 0, 0, 0); a1 = __builtin_amdgcn_mfma_f32_32x32x16_bf16(s1[ks], cf[ks], a1, 0, 0, 0); }
#pragma unroll
        for (int k = 0; k < 8; ++k) { const int q = k & 3;
            const float o0 = (k < 4 ? a0[4 * q] : a1[4 * q]), o1 = (k < 4 ? a0[4 * q + 1] : a1[4 * q + 1]), o2 = (k < 4 ? a0[4 * q + 2] : a1[4 * q + 2]), o3 = (k < 4 ? a0[4 * q + 3] : a1[4 * q + 3]);
            const float y0 = bflo(yv[k].x) + ea * o0, y1 = bfhi(yv[k].x) + ea * o1, y2 = bflo(yv[k].y) + ea * o2, y3 = bfhi(yv[k].y) + ea * o3;
            const float z0 = bflo(zv[k].x), z1 = bfhi(zv[k].x), z2 = bflo(zv[k].y), z3 = bfhi(zv[k].y);
            *(u32x2*)(zp + 32 * (k >> 2) + 8 * q) = (u32x2){pk2(y0 * siluf(z0), y1 * siluf(z1)), pk2(y2 * siluf(z2), y3 * siluf(z3))}; }
    }
}

typedef short s16x4 __attribute__((ext_vector_type(4)));
__device__ __forceinline__ s16x4 lds_tr16(LAS unsigned char* p) { return __builtin_bit_cast(s16x4, __builtin_amdgcn_ds_read_tr16_b64_v4i16((LAS s16x4*)p)); }
__device__ __forceinline__ int t5_bucket_dev(int d) {
    if (d < 16) return d;
    const int v = 16 + (int)(log((double)d / 16.0) / log(8.0) * 16.0);
    return v < 31 ? v : 31;
}
constexpr int D_QSL = 16896, D_QH = 8704, D_SEL = 135168, D_LUT = 139264, D_DMY = 143360, VP = 72;
__device__ __forceinline__ int key16(float f) { const int iv = __builtin_bit_cast(int, f); const unsigned u = (unsigned)iv ^ ((unsigned)(iv >> 31) | 0x80000000u); return (int)(u >> 16); }
__device__ __forceinline__ unsigned long long mask_ge(int v, int x) { unsigned long long m; asm("v_cmp_ge_i32_e64 %0, %1, %2" : "=s"(m) : "v"(v), "s"(x)); return m; }
__device__ __forceinline__ unsigned long long mask_gt(int v, int x) { unsigned long long m; asm("v_cmp_gt_i32_e64 %0, %1, %2" : "=s"(m) : "v"(v), "s"(x)); return m; }
__device__ __forceinline__ int count_ge8(int a0, int a1, int a2, int a3, int a4, int a5, int a6, int a7, int x) {
    unsigned long long m0, m1, m2, m3, m4, m5, m6, m7;
    asm("v_cmp_ge_i32_e64 %0, %8, %16\n\tv_cmp_ge_i32_e64 %1, %9, %16\n\tv_cmp_ge_i32_e64 %2, %10, %16\n\tv_cmp_ge_i32_e64 %3, %11, %16\n\t"
        "v_cmp_ge_i32_e64 %4, %12, %16\n\tv_cmp_ge_i32_e64 %5, %13, %16\n\tv_cmp_ge_i32_e64 %6, %14, %16\n\tv_cmp_ge_i32_e64 %7, %15, %16"
        : "=&s"(m0), "=&s"(m1), "=&s"(m2), "=&s"(m3), "=&s"(m4), "=&s"(m5), "=&s"(m6), "=&s"(m7)
        : "v"(a0), "v"(a1), "v"(a2), "v"(a3), "v"(a4), "v"(a5), "v"(a6), "v"(a7), "s"(x));
    return (__popcll(m0) + __popcll(m1)) + (__popcll(m2) + __popcll(m3)) + ((__popcll(m4) + __popcll(m5)) + (__popcll(m6) + __popcll(m7)));
}
__device__ __forceinline__ void masks_ge8(int a0, int a1, int a2, int a3, int a4, int a5, int a6, int a7, int x, unsigned long long (&m)[8]) {
    asm("v_cmp_ge_i32_e64 %0, %8, %16\n\tv_cmp_ge_i32_e64 %1, %9, %16\n\tv_cmp_ge_i32_e64 %2, %10, %16\n\tv_cmp_ge_i32_e64 %3, %11, %16\n\t"
        "v_cmp_ge_i32_e64 %4, %12, %16\n\tv_cmp_ge_i32_e64 %5, %13, %16\n\tv_cmp_ge_i32_e64 %6, %14, %16\n\tv_cmp_ge_i32_e64 %7, %15, %16"
        : "=&s"(m[0]), "=&s"(m[1]), "=&s"(m[2]), "=&s"(m[3]), "=&s"(m[4]), "=&s"(m[5]), "=&s"(m[6]), "=&s"(m[7])
        : "v"(a0), "v"(a1), "v"(a2), "v"(a3), "v"(a4), "v"(a5), "v"(a6), "v"(a7), "s"(x));
}
__device__ __forceinline__ void masks_eq8(int a0, int a1, int a2, int a3, int a4, int a5, int a6, int a7, int x, unsigned long long (&m)[8]) {
    asm("v_cmp_eq_i32_e64 %0, %8, %16\n\tv_cmp_eq_i32_e64 %1, %9, %16\n\tv_cmp_eq_i32_e64 %2, %10, %16\n\tv_cmp_eq_i32_e64 %3, %11, %16\n\t"
        "v_cmp_eq_i32_e64 %4, %12, %16\n\tv_cmp_eq_i32_e64 %5, %13, %16\n\tv_cmp_eq_i32_e64 %6, %14, %16\n\tv_cmp_eq_i32_e64 %7, %15, %16"
        : "=&s"(m[0]), "=&s"(m[1]), "=&s"(m[2]), "=&s"(m[3]), "=&s"(m[4]), "=&s"(m[5]), "=&s"(m[6]), "=&s"(m[7])
        : "v"(a0), "v"(a1), "v"(a2), "v"(a3), "v"(a4), "v"(a5), "v"(a6), "v"(a7), "s"(x));
}
__device__ __forceinline__ int sel_mask(int a, int b, unsigned long long m) { int r; asm("v_cndmask_b32_e64 %0, %1, %2, %3" : "=v"(r) : "v"(a), "v"(b), "s"(m)); return r; }
__device__ __forceinline__ float xor1(float v) { return __builtin_bit_cast(float, __builtin_amdgcn_update_dpp(0, __builtin_bit_cast(int, v), 0xB1, 0xF, 0xF, false)); }
__device__ __forceinline__ float xor2(float v) { return __builtin_bit_cast(float, __builtin_amdgcn_update_dpp(0, __builtin_bit_cast(int, v), 0x4E, 0xF, 0xF, false)); }
typedef __bf16 bf16v2 __attribute__((ext_vector_type(2)));
__device__ __forceinline__ float dot2ones(unsigned pk, float acc) { return __builtin_amdgcn_fdot2_f32_bf16(__builtin_bit_cast(bf16v2, pk), __builtin_bit_cast(bf16v2, 0x3f803f80u), acc, false); }
__device__ __forceinline__ int okey(float f) { const int iv = __builtin_bit_cast(int, f); return iv ^ ((iv >> 31) & 0x7fffffff); }

struct MoeConv { const float* src; unsigned char* dst; int pitch; int gk; bool on; };
__device__ __forceinline__ MoeConv moe_conv_issue(const Args& A, unsigned char* ws, int id, int lane, float (&v)[32]) {
    MoeConv c; c.on = id < 64 * 768; c.src = nullptr; c.dst = nullptr; c.pitch = 0; c.gk = -1;
    if (c.on) {
        const int le = id / 768, r = id % 768;
        int K, k0, n; const float* W; unsigned char* WT;
        if (r < 512) { const int half = r >> 8, q = r & 255, kb = q >> 3, nb = q & 7; K = 1024; c.pitch = 512; k0 = 32 * kb; n = 64 * nb + lane; c.gk = (le >> 5) * DM + k0;
            W = (half ? A.in[29] : A.in[28]) + (size_t)le * 1024 * 512; WT = ws + WS_WGU + (size_t)le * 1024 * 1024 + (size_t)(256 * (n >> 7) + 128 * half + (n & 127)) * K + k0; }
        else { const int q = r - 512, kb = q >> 4, nb = q & 15; K = 512; c.pitch = 1024; k0 = 32 * kb; n = 64 * nb + lane;
            W = A.in[30] + (size_t)le * 512 * 1024; WT = ws + WS_WD + (size_t)le * 1024 * 512 + (size_t)n * K + k0; }
        c.src = W + (size_t)k0 * c.pitch + n; c.dst = WT;
#pragma unroll
        for (int kk = 0; kk < 32; ++kk) v[kk] = c.src[(size_t)kk * c.pitch];
    }
    return c;
}
__device__ __forceinline__ void moe_conv_finish(const Args& A, const MoeConv& c, const float (&v)[32]) {
    if (c.on) {
        const int gk = __builtin_amdgcn_readfirstlane(c.gk);
        if (gk >= 0) { const float* g = A.in[3] + gk;
#pragma unroll
            for (int q = 0; q < 2; ++q) { u32x4 o;
#pragma unroll
                for (int e = 0; e < 4; ++e) { const int k = 16 * q + 4 * e; o[e] = pk4_fp8(v[k] * g[k] * F8_SW, v[k + 1] * g[k + 1] * F8_SW, v[k + 2] * g[k + 2] * F8_SW, v[k + 3] * g[k + 3] * F8_SW); }
                *(u32x4*)(c.dst + 16 * q) = o; }
        } else {
#pragma unroll
            for (int q = 0; q < 2; ++q) { u32x4 o;
#pragma unroll
                for (int e = 0; e < 4; ++e) { const int k = 16 * q + 4 * e; o[e] = pk4_fp8(v[k] * F8_SW, v[k + 1] * F8_SW, v[k + 2] * F8_SW, v[k + 3] * F8_SW); }
                *(u32x4*)(c.dst + 16 * q) = o; }
        }
    }
}
__device__ __forceinline__ void p_dsa(Frame& F, const Args& A) {
    bf16* U = (bf16*)(F.ws + WS_U); bf16* HB = (bf16*)(F.ws + WS_HB);
    const int w = F.wave;
    const float* ng = A.in[10];
    LAS unsigned char* L = F.lds;
    LAS float* LUT = (LAS float*)(L + D_LUT);
    for (int i = F.tid; i < 1024; i += NTHR) LUT[i] = A.in[1][t5_bucket_dev(i >> 3) * 8 + (i & 7)] * 1.44269504f;
    __syncthreads();
    for (int blk = F.bid; blk < MTOK / 8; blk += F.G) {
        int lane = F.lane; asm volatile("" : "+v"(lane));
        const int kr = blk >> 8, cc = blk & 255, b = kr >> 1, tb = (kr & 1) ? 511 - cc : cc, t0 = tb * 8;
        const size_t bat = (size_t)b * SEQ, rowb = bat + t0;
        {
            LAS u32x4* hz = (LAS u32x4*)(L + (F.tid >> 6) * D_QSL + D_QH) + (F.tid & 63) * 8;
#pragma unroll
            for (int i = 0; i < 8; ++i) hz[i] = (u32x4){0u, 0u, 0u, 0u};
            const int njz = (t0 + 8 + 63) >> 6, c4lo = (njz - 1) >> 2, c4hi = 4 * ((njz + 15) >> 4);
            LAS u32x2* kz = (LAS u32x2*)(L + (F.tid >> 6) * D_QSL + (F.tid & 63) * 136);
            for (int c4 = c4lo; c4 < c4hi; ++c4) kz[c4] = (u32x2){0u, 0u};
        }
        __syncthreads();
        float cvv[32]; const MoeConv cvi = moe_conv_issue(A, F.ws, blk * NWAVES + w, lane, cvv);
        const u32x4 zrow = *(const u32x4*)(U + (rowb + w) * LDE + EZ + 8 * lane);
        u32x4 qraw[2];
#pragma unroll
        for (int ks = 0; ks < 2; ++ks) { qraw[ks] = (u32x4){0u, 0u, 0u, 0u}; if ((lane & 15) < 8) qraw[ks] = *(const u32x4*)(U + (rowb + w) * LDE + EQ + (lane & 15) * 64 + 16 * (lane >> 4) + 8 * ks); }
        {
            typedef long i64x2 __attribute__((ext_vector_type(2)));
            const int r = lane & 31, hh = lane >> 5;
            const unsigned char* Q8 = F.ws + WS_IQK8;
            i64x2 qa[2];
            { const i64x2* qp = (const i64x2*)(Q8 + (rowb + (r >> 2)) * 320 + (r & 3) * 64 + 32 * hh); qa[0] = qp[0]; qa[1] = qp[1]; }
            float wv[4][4];
#pragma unroll
            for (int q = 0; q < 4; ++q) { const u32x2 ww = *(const u32x2*)(U + (rowb + 2 * q + hh) * LDE + EIW); wv[q][0] = bflo(ww.x); wv[q][1] = bfhi(ww.x); wv[q][2] = bflo(ww.y); wv[q][3] = bfhi(ww.y); }
            const int ntile = (t0 + 8 + 31) >> 5;
            for (int tb = w; tb < ntile; tb += 8 * NWAVES) {
                i64x2 kf[8][2];
#pragma unroll
                for (int u8 = 0; u8 < 8; ++u8) { const int tl = tb + 8 * u8 < 128 ? tb + 8 * u8 : 127; const int key = 32 * tl + r;
                    const i64x2* kp = (const i64x2*)(Q8 + (bat + key) * 320 + 256 + 32 * hh); kf[u8][0] = kp[0]; kf[u8][1] = kp[1]; }
#pragma unroll
                for (int u8 = 0; u8 < 8; ++u8) {
                    const int tile = tb + 8 * u8;
                    f32x16 acc = {0.f, 0.f, 0.f, 0.f, 0.f, 0.f, 0.f, 0.f, 0.f, 0.f, 0.f, 0.f, 0.f, 0.f, 0.f, 0.f};
                    acc = __builtin_amdgcn_mfma_f32_32x32x16_fp8_fp8(qa[0].x, kf[u8][0].x, acc, 0, 0, 0);
                    acc = __builtin_amdgcn_mfma_f32_32x32x16_fp8_fp8(qa[0].y, kf[u8][0].y, acc, 0, 0, 0);
                    acc = __builtin_amdgcn_mfma_f32_32x32x16_fp8_fp8(qa[1].x, kf[u8][1].x, acc, 0, 0, 0);
                    acc = __builtin_amdgcn_mfma_f32_32x32x16_fp8_fp8(qa[1].y, kf[u8][1].y, acc, 0, 0, 0);
                    if (tile < ntile) {
#pragma unroll
                        for (int q = 0; q < 4; ++q) {
                            const float sc = wv[q][0] * fmaxf(acc[4 * q], 0.f) + wv[q][1] * fmaxf(acc[4 * q + 1], 0.f) + wv[q][2] * fmaxf(acc[4 * q + 2], 0.f) + wv[q][3] * fmaxf(acc[4 * q + 3], 0.f);
                            const int tq = 2 * q + hh, key = 32 * tile + r, k16 = key16(sc + 0.f);
                            const bool live = key <= t0 + tq;
                            *(LAS unsigned short*)(L + tq * D_QSL + (key & 63) * 136 + (key >> 6) * 2) = (unsigned short)(live ? k16 : 0);
                            if (live) __hip_atomic_fetch_add((LAS unsigned*)(L + tq * D_QSL + D_QH) + (k16 >> 5), (unsigned)(((k16 >> 4) & 1) * 0xffff + 1), __ATOMIC_RELAXED, __HIP_MEMORY_SCOPE_WORKGROUP);
                        }
                    }
                }
            }
        }
        {
            const size_t row = rowb + w;
            const u32x4 v = zrow;
            float f[8] = {bflo(v.x), bfhi(v.x), bflo(v.y), bfhi(v.y), bflo(v.z), bfhi(v.z), bflo(v.w), bfhi(v.w)};
            float s = 0.f;
#pragma unroll
            for (int j = 0; j < 8; ++j) s += f[j] * f[j];
#pragma unroll
            for (int o = 1; o < 32; o <<= 1) s += __shfl_xor(s, o);
            const float rs = 1.f / sqrtf(s * (1.f / 256.f) + NORM_EPS); const float* g = ng + 8 * lane;
            const float r8 = rs * F8_SX;
            *(u32x2*)((unsigned char*)HB + row * DM + 8 * lane) = (u32x2){pk4_fp8(f[0] * r8 * g[0], f[1] * r8 * g[1], f[2] * r8 * g[2], f[3] * r8 * g[3]), pk4_fp8(f[4] * r8 * g[4], f[5] * r8 * g[5], f[6] * r8 * g[6], f[7] * r8 * g[7])};
        }
        __syncthreads();
        const int t = t0 + w, n = t + 1;
        LAS unsigned short* sel = (LAS unsigned short*)(L + D_SEL) + w * 256;
        const int cnt = n < 256 ? n : 256;
        if (n <= 256) {
#pragma unroll
            for (int i = 0; i < 4; ++i) { const int s = lane + 64 * i; sel[s] = (unsigned short)(s < n ? s : 0); }
        } else {
            const int nj = (t0 + 8 + 63) >> 6;
            const LAS unsigned char* myrow = L + w * D_QSL + lane * 136;
            int v[64];
#pragma unroll
            for (int jb = 0; jb < 4; ++jb) {
                if (16 * jb < nj) {
#pragma unroll
                    for (int g4q = 0; g4q < 4; ++g4q) { const u32x2 kk = *(const LAS u32x2*)(myrow + 32 * jb + 8 * g4q);
                        const int j0 = 16 * jb + 4 * g4q;
                        v[j0] = (int)(kk.x & 0xffffu); v[j0 + 1] = (int)(kk.x >> 16); v[j0 + 2] = (int)(kk.y & 0xffffu); v[j0 + 3] = (int)(kk.y >> 16); }
                } else {
#pragma unroll
                    for (int jj = 0; jj < 16; ++jj) v[16 * jb + jj] = -1;
                }
            }
            int bstar, ca, cb;
            {
                const LAS u32x4* hw = (const LAS u32x4*)(L + w * D_QSL + D_QH) + lane * 8;
                unsigned hv[32];
#pragma unroll
                for (int i = 0; i < 8; ++i) { const u32x4 x = hw[i]; hv[4 * i] = x.x; hv[4 * i + 1] = x.y; hv[4 * i + 2] = x.z; hv[4 * i + 3] = x.w; }
                unsigned ssum = 0u;
#pragma unroll
                for (int k = 0; k < 32; ++k) ssum += hv[k];
                const int sum = (int)(ssum & 0xffffu) + (int)(ssum >> 16);
                int suf = sum;
#pragma unroll
                for (int o = 1; o < 64; o <<= 1) { const int x = __shfl_down(suf, o); if (lane + o < 64) suf += x; }
                const int above = suf - sum;
                const unsigned long long bm = __ballot(above < 256 && suf >= 256);
                const int Ls = __builtin_amdgcn_readfirstlane((int)__builtin_ctzll(bm | 0x8000000000000000ull));
                const int aboveLs = __builtin_amdgcn_readlane(above, Ls);
                const unsigned hwv = ((const LAS unsigned*)(L + w * D_QSL + D_QH))[Ls * 32 + (lane & 31)];
                const int cw = (int)(hwv >> 16) + (int)(hwv & 0xffffu);
                int sfx = cw;
#pragma unroll
                for (int o = 1; o < 32; o <<= 1) { const int x = __shfl_down(sfx, o); if ((lane & 31) + o < 32) sfx += x; }
                const int rb = aboveLs + sfx - cw;
                const unsigned long long hb = __ballot(rb < 256 && rb + cw >= 256);
                const int wsel = __builtin_amdgcn_readfirstlane((int)__builtin_ctzll(hb | 0x8000000000000000ull)) & 31;
                const int wrun = __builtin_amdgcn_readlane(rb, wsel); const unsigned wval = (unsigned)__builtin_amdgcn_readlane((int)hwv, wsel);
                const int c1 = (int)(wval >> 16), c0 = (int)(wval & 0xffffu);
                const bool inhi = wrun + c1 >= 256;
                bstar = 64 * Ls + 2 * wsel + (inhi ? 1 : 0); ca = inhi ? wrun : wrun + c1; cb = inhi ? c1 : c0;
            }
            int lo = bstar * 16, hi = lo + 15, clo = ca + cb, chi = ca, it = 0;
            while (lo < hi) {
                const int span = hi - lo;
                int step = (it & 1) ? ((span + 1) >> 1) : (int)((float)(span + 1) * (((float)(clo - 256) + 0.5f) / (float)(clo - chi)));
                step = step < 1 ? 1 : (step > span ? span : step);
                const int mid = lo + step;
                int c = 0;
#pragma unroll
                for (int jb = 0; jb < 4; ++jb) if (16 * jb < nj) {
#pragma unroll
                    for (int jj = 0; jj < 16; jj += 8) { const int j0 = 16 * jb + jj; c += count_ge8(v[j0], v[j0 + 1], v[j0 + 2], v[j0 + 3], v[j0 + 4], v[j0 + 5], v[j0 + 6], v[j0 + 7], mid); } }
                ++it;
                if (c == 256) { lo = mid; clo = 256; break; }
                if (c > 256) { lo = mid; clo = c; } else { hi = mid - 1; chi = c; }
            }
            const int T = lo;
            LAS unsigned short* dummy = (LAS unsigned short*)(L + D_DMY) + w * 64 + lane;
            const bool all_ge = clo == 256;
            const int Tg = all_ge ? T : T + 1;
            {
                int obase = 0;
#pragma unroll
                for (int jb = 0; jb < 4; ++jb) if (16 * jb < nj) {
#pragma unroll
                    for (int jj = 0; jj < 16; jj += 8) { const int j0 = 16 * jb + jj; unsigned long long m[8];
                        masks_ge8(v[j0], v[j0 + 1], v[j0 + 2], v[j0 + 3], v[j0 + 4], v[j0 + 5], v[j0 + 6], v[j0 + 7], Tg, m);
#pragma unroll
                        for (int e = 0; e < 8; ++e) {
                            const int pos = (int)__builtin_amdgcn_mbcnt_hi((unsigned)(m[e] >> 32), __builtin_amdgcn_mbcnt_lo((unsigned)m[e], (unsigned)obase));
                            LAS unsigned short* dst = (LAS unsigned short*)(unsigned)sel_mask((int)(unsigned)(__SIZE_TYPE__)dummy, (int)(unsigned)(__SIZE_TYPE__)(sel + pos), m[e]);
                            *dst = (unsigned short)(lane + 64 * (j0 + e));
                            obase += __popcll(m[e]); } } }
            }
            if (!all_ge) {
                const int need_eq = 256 - chi; int ebase = 0;
#pragma unroll
                for (int jb = 0; jb < 4; ++jb) if (16 * jb < nj && ebase < need_eq) {
#pragma unroll
                    for (int jj = 0; jj < 16; jj += 8) { const int j0 = 16 * jb + jj; unsigned long long m[8];
                        masks_eq8(v[j0], v[j0 + 1], v[j0 + 2], v[j0 + 3], v[j0 + 4], v[j0 + 5], v[j0 + 6], v[j0 + 7], T, m);
#pragma unroll
                        for (int e = 0; e < 8; ++e) {
                            const int erank = (int)__builtin_amdgcn_mbcnt_hi((unsigned)(m[e] >> 32), __builtin_amdgcn_mbcnt_lo((unsigned)m[e], (unsigned)ebase));
                            LAS unsigned short* cand = (LAS unsigned short*)(unsigned)sel_mask((int)(unsigned)(__SIZE_TYPE__)dummy, (int)(unsigned)(__SIZE_TYPE__)(sel + chi + erank), m[e]);
                            LAS unsigned short* dst = erank < need_eq ? cand : dummy;
                            *dst = (unsigned short)(lane + 64 * (j0 + e));
                            ebase += __popcll(m[e]); } } }
            }
        }
        {
            const int hd = lane & 15, g4 = lane >> 4;
            const size_t row = rowb + w;
            long qb[2];
            {
                float qf[2][8]; float ss = 0.f;
#pragma unroll
                for (int ks = 0; ks < 2; ++ks) { const u32x4 qq = qraw[ks];
                    qf[ks][0] = bflo(qq.x); qf[ks][1] = bfhi(qq.x); qf[ks][2] = bflo(qq.y); qf[ks][3] = bfhi(qq.y); qf[ks][4] = bflo(qq.z); qf[ks][5] = bfhi(qq.z); qf[ks][6] = bflo(qq.w); qf[ks][7] = bfhi(qq.w);
#pragma unroll
                    for (int j = 0; j < 8; ++j) ss += qf[ks][j] * qf[ks][j]; }
                ss += __shfl_xor(ss, 16); ss += __shfl_xor(ss, 32);
                const float rs = (0.125f * 1.44269504f) / sqrtf(ss * (1.f / 64.f) + NORM_EPS);
#pragma unroll
                for (int ks = 0; ks < 2; ++ks) { const float* gq = A.in[11] + 16 * g4 + 8 * ks; const float r32 = rs * 32.f;
                    const u32x2 pk = (u32x2){pk4_fp8(qf[ks][0] * r32 * gq[0], qf[ks][1] * r32 * gq[1], qf[ks][2] * r32 * gq[2], qf[ks][3] * r32 * gq[3]),
                                             pk4_fp8(qf[ks][4] * r32 * gq[4], qf[ks][5] * r32 * gq[5], qf[ks][6] * r32 * gq[6], qf[ks][7] * r32 * gq[7])};
                    qb[ks] = __builtin_bit_cast(long, pk); }
            }
            float lg[16][4]; float mx = -3.0e38f;
            const int vsl = lane >> 3, vpart = lane & 7;
            u32x4 vr[2][8];
#define DSA_QK_BODY(FULL_) do { \
_Pragma("unroll") \
            for (int hb = 0; hb < 2; ++hb) { \
                typedef long i64x2 __attribute__((ext_vector_type(2))); \
                i64x2 ka[8]; \
_Pragma("unroll") \
                for (int T8 = 0; T8 < 8; ++T8) { const int sm = sel[16 * (8 * hb + T8) + hd]; ka[T8] = *(const i64x2*)(F.ws + WS_K8 + (bat + sm) * 64 + 16 * g4); } \
_Pragma("unroll") \
                for (int e = 0; e < 8; ++e) { const int sm = sel[64 * hb + 8 * e + vsl]; vr[hb][e] = *(const u32x4*)(U + (bat + sm) * LDE + EV + 8 * vpart); } \
_Pragma("unroll") \
                for (int T8 = 0; T8 < 8; ++T8) { const int T = 8 * hb + T8; \
                    f32x4 acc = {0.f, 0.f, 0.f, 0.f}; \
                    acc = __builtin_amdgcn_mfma_f32_16x16x32_fp8_fp8(ka[T8].x, qb[0], acc, 0, 0, 0); \
                    acc = __builtin_amdgcn_mfma_f32_16x16x32_fp8_fp8(ka[T8].y, qb[1], acc, 0, 0, 0); \
                    const u32x2 sl = *(const LAS u32x2*)(sel + 16 * T + 4 * g4); \
                    const int s4[4] = {(int)(sl.x & 0xffffu), (int)(sl.x >> 16), (int)(sl.y & 0xffffu), (int)(sl.y >> 16)}; \
_Pragma("unroll") \
                    for (int i = 0; i < 4; ++i) { int dist = t - s4[i]; dist = dist < 0 ? 0 : (dist > 127 ? 127 : dist); \
                        const float bia = LUT[dist * 8 + (hd & 7)]; \
                        lg[T][i] = ((FULL_) || (16 * T + 4 * g4 + i) < cnt) ? acc[i] * (1.f / 256.f) + bia : -3.0e38f; mx = fmaxf(mx, lg[T][i]); } \
                } \
            } \
            } while (0)
            if (cnt == 256) DSA_QK_BODY(true); else DSA_QK_BODY(false);
#undef DSA_QK_BODY
            mx = fmaxf(mx, __shfl_xor(mx, 16)); mx = fmaxf(mx, __shfl_xor(mx, 32));
            float sum = 0.f;
#pragma unroll
            for (int T = 0; T < 16; ++T) {
#pragma unroll
                for (int i = 0; i < 4; ++i) { const float p = __builtin_amdgcn_exp2f(lg[T][i] - mx); lg[T][i] = p; sum += p; }
                if ((T & 3) == 3) __builtin_amdgcn_sched_barrier(0); }
            sum += __shfl_xor(sum, 16); sum += __shfl_xor(sum, 32);
            const float inv = 1.f / fmaxf(sum, 1e-30f);
            f32x4 oacc[4];
#pragma unroll
            for (int dt = 0; dt < 4; ++dt) oacc[dt] = (f32x4){0.f, 0.f, 0.f, 0.f};
            LAS unsigned char* Vl = L + w * D_QSL;
#pragma unroll
            for (int ch = 0; ch < 4; ++ch) {
                LDS_WAIT();
#pragma unroll
                for (int e = 0; e < 8; ++e) *(LAS u32x4*)(Vl + ((8 * e + vsl) * VP + 8 * vpart) * 2) = vr[ch & 1][e];
                if (ch + 2 < 4) {
#pragma unroll
                    for (int e = 0; e < 8; ++e) { const int sm = sel[64 * (ch + 2) + 8 * e + vsl]; vr[ch & 1][e] = *(const u32x4*)(U + (bat + sm) * LDE + EV + 8 * vpart); }
                }
                LDS_WAIT();
#pragma unroll
                for (int kk = 0; kk < 2; ++kk) {
                    const int T0 = 2 * (2 * ch + kk);
                    u32x4 pp; pp.x = pk2(lg[T0][0] * inv, lg[T0][1] * inv); pp.y = pk2(lg[T0][2] * inv, lg[T0][3] * inv); pp.z = pk2(lg[T0 + 1][0] * inv, lg[T0 + 1][1] * inv); pp.w = pk2(lg[T0 + 1][2] * inv, lg[T0 + 1][3] * inv);
                    const bf16x8 pf = __builtin_bit_cast(bf16x8, pp);
                    const int qq = (lane & 15) >> 2, p4 = lane & 3;
#pragma unroll
                    for (int dt = 0; dt < 4; ++dt) {
                        const s16x4 b0 = lds_tr16(Vl + ((32 * kk + 4 * g4 + qq) * VP + 16 * dt + 4 * p4) * 2);
                        const s16x4 b1 = lds_tr16(Vl + ((32 * kk + 16 + 4 * g4 + qq) * VP + 16 * dt + 4 * p4) * 2);
                        bf16x8 bfg; bfg[0] = b0[0]; bfg[1] = b0[1]; bfg[2] = b0[2]; bfg[3] = b0[3]; bfg[4] = b1[0]; bfg[5] = b1[1]; bfg[6] = b1[2]; bfg[7] = b1[3];
                        oacc[dt] = __builtin_amdgcn_mfma_f32_16x16x32_bf16(pf, bfg, oacc[dt], 0, 0, 0);
                    }
                }
            }
            {
                const bool odd = hd & 1;
#pragma unroll
                for (int i = 0; i < 4; i += 2)
#pragma unroll
                    for (int dt = 0; dt < 4; ++dt) { const float a = oacc[dt][i], b = oacc[dt][i + 1]; const float rcv = xor1(odd ? a : b);
                        if (g4 < 2) *(unsigned short*)((unsigned char*)HB + row * DM + 512 + (4 * g4 + i + (odd ? 1 : 0)) * 64 + 16 * dt + (hd & ~1)) = odd ? pk2_fp8(rcv * F8_SX, b * F8_SX) : pk2_fp8(a * F8_SX, rcv * F8_SX); }
            }
        }
        moe_conv_finish(A, cvi, cvv);
        __syncthreads();
    }
}

constexpr int NR_WP = 2064, NR_WOFF = 45056;
template <int MODE> __device__ __forceinline__ void p_norm_route(Frame& F, const bf16* xin, int layer) {
    constexpr int NT = MODE == 0 ? 3 : 2;
    const bf16* WR = MODE == 0 ? (const bf16*)(F.ws + WS_WR) + (size_t)layer * 48 * 1024 : (const bf16*)(F.ws + WS_WGL);
    float* GL = (float*)(F.ws + WS_GL); float* RS = (float*)(F.ws + WS_RS);
    int* list = (int*)(F.ws + WS_LIST); float* wl = (float*)(F.ws + WS_LISTW); float* rl = (float*)(F.ws + WS_LISTR);
    LAS unsigned char* L = F.lds;
    LAS float* lgt = (LAS float*)L + F.wave * (16 * 48);
    LAS int* cntl = (LAS int*)(L + 32768); LAS int* basel = (LAS int*)(L + 33024);
    LAS int* ri_e = (LAS int*)(L + 34816); LAS int* ri_p = (LAS int*)(L + 36864); LAS float* ri_w = (LAS float*)(L + 38912); LAS float* ri_r = (LAS float*)(L + 40960);
    const int w = F.wave;
    for (int i = F.tid; i < NT * 16 * 128; i += NTHR) { const int r = i >> 7, c = i & 127; *(LAS u32x4*)(L + NR_WOFF + r * NR_WP + c * 16) = *(const u32x4*)(WR + (size_t)r * DM + c * 8); }
    for (int base = F.bid * 256; base < MTOK; base += F.G * 256) {
        int lane = F.lane; asm volatile("" : "+v"(lane));
        if (F.tid < 64) cntl[F.tid] = 0;
        __syncthreads();
        const int n16 = lane & 15, g4 = lane >> 4;
        const int R00 = base + w * 32;
        bf16x8 a[16];
        const bf16* ar = xin + (size_t)(R00 + n16) * DM + 8 * g4;
#pragma unroll
        for (int kk = 0; kk < 16; ++kk) a[kk] = *(const bf16x8*)(ar + 32 * kk);
        float mxh[2] = {0.f, 0.f};
#pragma unroll
        for (int half = 0; half < 2; ++half) {
            const int R0 = R00 + half * 16;
            f32x4 acc[NT];
#pragma unroll
            for (int nt = 0; nt < NT; ++nt) acc[nt] = (f32x4){0.f, 0.f, 0.f, 0.f};
            float ss = 0.f; unsigned short __attribute__((ext_vector_type(2))) mpk = {0, 0};
#pragma unroll
            for (int kk = 0; kk < 32; ++kk) {
                const bf16x8 av = a[kk & 15];
                { const int sn = half * 32 + kk + 16; if (sn < 64) a[kk & 15] = *(const bf16x8*)(ar + (size_t)(sn >> 5) * 16 * DM + 32 * (sn & 31)); }
#pragma unroll
                for (int nt = 0; nt < NT; ++nt) { const bf16x8 bb = *(const LAS bf16x8*)(L + NR_WOFF + (16 * nt + n16) * NR_WP + 64 * kk + 16 * g4);
                    acc[nt] = __builtin_amdgcn_mfma_f32_16x16x32_bf16(av, bb, acc[nt], 0, 0, 0); }
                const u32x4 q = __builtin_bit_cast(u32x4, av);
                { const float e0 = bflo(q.x), e1 = bfhi(q.x), e2 = bflo(q.y), e3 = bfhi(q.y), e4 = bflo(q.z), e5 = bfhi(q.z), e6 = bflo(q.w), e7 = bfhi(q.w);
                  ss += ((e0 * e0 + e1 * e1) + (e2 * e2 + e3 * e3)) + ((e4 * e4 + e5 * e5) + (e6 * e6 + e7 * e7));
                  if constexpr (MODE == 1) { typedef unsigned short u16x2 __attribute__((ext_vector_type(2)));
                    mpk = __builtin_elementwise_max(mpk, __builtin_bit_cast(u16x2, q.x & 0x7fff7fffu)); mpk = __builtin_elementwise_max(mpk, __builtin_bit_cast(u16x2, q.y & 0x7fff7fffu));
                    mpk = __builtin_elementwise_max(mpk, __builtin_bit_cast(u16x2, q.z & 0x7fff7fffu)); mpk = __builtin_elementwise_max(mpk, __builtin_bit_cast(u16x2, q.w & 0x7fff7fffu)); } }
                if ((kk & 3) == 3) __builtin_amdgcn_sched_barrier(0);
            }
            ss += __shfl_xor(ss, 16); ss += __shfl_xor(ss, 32);
            const float rsv = 1.f / sqrtf(ss * (1.f / DM) + NORM_EPS);
            float rsr[4];
#pragma unroll
            for (int i = 0; i < 4; ++i) rsr[i] = __shfl(rsv, 4 * g4 + i);
            if constexpr (MODE == 1) {
#pragma unroll
                for (int nt = 0; nt < NT; ++nt)
#pragma unroll
                    for (int i = 0; i < 4; ++i) if (16 * nt + n16 < 24) GL[(size_t)(R0 + 4 * g4 + i) * 24 + 16 * nt + n16] = acc[nt][i] * rsr[i];
                float mxl = bf2f((bf16)(mpk.x > mpk.y ? mpk.x : mpk.y));
                mxl = fmaxf(mxl, __shfl_xor(mxl, 16)); mxl = fmaxf(mxl, __shfl_xor(mxl, 32));
                if (lane < 16) RS[R0 + lane] = (mxl * (1.f / 127.f)) * rsv;
                mxh[half] = mxl;
            } else {
#pragma unroll
            for (int nt = 0; nt < NT; ++nt)
#pragma unroll
                for (int i = 0; i < 4; ++i) lgt[(4 * g4 + i) * 48 + 16 * nt + n16] = acc[nt][i] * rsr[i];
            LDS_WAIT();
            if (lane < 16) {
                const LAS float* lr = lgt + lane * 48;
                int gs = 0; float gm = lr[0];
#pragma unroll
                for (int j = 1; j < 4; ++j) if (lr[j] > gm) { gm = lr[j]; gs = j; }
                float gsum = 0.f;
#pragma unroll
                for (int j = 0; j < 4; ++j) gsum += __expf(lr[j] - gm);
                const float gw = 1.f / gsum;
                const LAS float* er = lr + 4 + 8 * gs;
                int i0 = 0; float m0 = er[0];
#pragma unroll
                for (int j = 1; j < 8; ++j) if (er[j] > m0) { m0 = er[j]; i0 = j; }
                int i1 = -1; float m1 = -3.0e38f;
#pragma unroll
                for (int j = 0; j < 8; ++j) if (j != i0 && er[j] > m1) { m1 = er[j]; i1 = j; }
                const float w0 = 1.f / (1.f + __expf(m1 - m0));
                const int e0 = gs * 8 + i0, e1 = 32 + gs * 8 + i1;
                const int rs = (w * 32 + half * 16 + lane) * 2;
                ri_e[rs] = e0; ri_p[rs] = __hip_atomic_fetch_add(cntl + e0, 1, __ATOMIC_RELAXED, __HIP_MEMORY_SCOPE_WORKGROUP); ri_w[rs] = w0 * gw;
                ri_e[rs + 1] = e1; ri_p[rs + 1] = __hip_atomic_fetch_add(cntl + e1, 1, __ATOMIC_RELAXED, __HIP_MEMORY_SCOPE_WORKGROUP); ri_w[rs + 1] = (1.f - w0) * gw;
                ri_r[rs >> 1] = rsv;
            }
            LDS_WAIT();
            }
        }
        if constexpr (MODE == 1) {
            unsigned char* X8o = F.ws + WS_HB;
#pragma unroll 4
            for (int i = 0; i < 32; ++i) { int ln = F.lane; asm volatile("" : "+v"(ln));
                const float msrc = i < 16 ? mxh[0] : mxh[1];
                const float mi = __builtin_bit_cast(float, __builtin_amdgcn_readlane(__builtin_bit_cast(int, msrc), i & 15)); const float inv = mi > 0.f ? 127.f / mi : 0.f;
                const u32x4* src = (const u32x4*)(xin + (size_t)(R00 + i) * DM) + 2 * ln; const u32x4 p0 = src[0], p1 = src[1];
                u32x4 o; o.x = pk4_i8m(bflo(p0.x) * inv, bfhi(p0.x) * inv, bflo(p0.y) * inv, bfhi(p0.y) * inv); o.y = pk4_i8m(bflo(p0.z) * inv, bfhi(p0.z) * inv, bflo(p0.w) * inv, bfhi(p0.w) * inv);
                o.z = pk4_i8m(bflo(p1.x) * inv, bfhi(p1.x) * inv, bflo(p1.y) * inv, bfhi(p1.y) * inv); o.w = pk4_i8m(bflo(p1.z) * inv, bfhi(p1.z) * inv, bflo(p1.w) * inv, bfhi(p1.w) * inv);
                *(u32x4*)(X8o + (size_t)(R00 + i) * DM + 16 * ln) = o; }
            continue;
        }
        __syncthreads();
        if (F.tid < 64) { const int c = cntl[F.tid]; basel[F.tid] = c ? (int)__hip_atomic_fetch_add((unsigned*)(F.ctl + CW_CNT + layer * 4096 + 64 * F.tid), (unsigned)c, RLX_AGENT) : 0; }
        __syncthreads();
        { const int rs = F.tid, e = ri_e[rs], pos = basel[e] + ri_p[rs];
          list[(size_t)e * 65536 + pos] = base + (rs >> 1); wl[(size_t)e * 65536 + pos] = ri_w[rs]; rl[(size_t)e * 65536 + pos] = ri_r[rs >> 1]; }
        __syncthreads();
    }
    __syncthreads();
}
__device__ __forceinline__ void moe_tables(Frame& F, int layer) {
    LAS int* ptile = (LAS int*)(F.lds + MOE_OFF); LAS int* cntv = ptile + 128;
    __syncthreads();
    if (F.tid < 64) {
        const int c = (int)__hip_atomic_load((unsigned*)(F.ctl + CW_CNT + layer * 4096 + 64 * F.tid), RLX_AGENT);
        cntv[F.tid] = c;
        int nt = (c + 255) >> 8, incl = nt;
#pragma unroll
        for (int o = 1; o < 64; o <<= 1) { const int t = __shfl_up(incl, o); if (F.lane >= o) incl += t; }
        ptile[F.tid] = incl - nt; if (F.tid == 63) ptile[64] = incl;
    }
    __syncthreads();
}
__device__ __forceinline__ void p_moe_gu(Frame& F, int layer) {
    moe_tables(F, layer);
    const LAS int* ptile = (const LAS int*)(F.lds + MOE_OFF); const LAS int* cntv = ptile + 128;
    pg8::MoeOrder S{(const char*)(F.ws + WS_XB8), (const char*)(F.ws + WS_WGU) + (size_t)layer * 32 * 1024 * 1024, (size_t)1024 * 1024, 512, F.G, F.bid, 0, ptile[64], ptile, cntv, (const int*)(F.ws + WS_LIST), true};
    pg8::EpiSwiGLU E{F.ws + WS_H8, (const float*)(F.ws + WS_LISTR), cntv};
    pg8::gemm_phase<pg8::EpiSwiGLU, pg8::MoeOrder, true, true>(F.lds, 512, S, E);
}
template <bool FINAL> __device__ __forceinline__ void p_moe_down(Frame& F, int layer, int slot) {
    moe_tables(F, layer);
    const LAS int* ptile = (const LAS int*)(F.lds + MOE_OFF); const LAS int* cntv = ptile + 128;
    pg8::MoeOrder S{(const char*)(F.ws + WS_H8), (const char*)(F.ws + WS_WD) + (size_t)layer * 32 * 1024 * 512, (size_t)1024 * 512, 256, F.G, F.bid, ptile[32 * slot], ptile[32 * slot + 32], ptile, cntv, (const int*)(F.ws + WS_LIST), false};
    pg8::EpiScatter<FINAL> E{(bf16*)(F.ws + WS_XB), F.out, (const int*)(F.ws + WS_LIST), (const float*)(F.ws + WS_LISTW), cntv};
    pg8::gemm_phase<pg8::EpiScatter<FINAL>, pg8::MoeOrder, true, true>(F.lds, 256, S, E);
}

__device__ __forceinline__ void p_compress(Frame& F, const Args& A) {
    bf16* U = (bf16*)(F.ws + WS_U);
    LAS unsigned char* L = F.lds;
    const int w = F.wave;
    {
        const int tid = F.tid, sub = tid & 15;
        for (int v0 = F.bid * 32; v0 < MTOK * 4; v0 += F.G * 32) {
            const int vec = v0 + (tid >> 4), row = vec >> 2, wh = vec & 3;
            bf16* p = U + (size_t)row * LDO + ((wh >> 1) ? OKW : OKS) + (wh & 1) * 128 + 8 * sub;
            const float* g = ((wh >> 1) ? A.in[18] : A.in[17]) + 8 * sub;
            const u32x4 v = *(const u32x4*)p; float f[8] = {bflo(v.x), bfhi(v.x), bflo(v.y), bfhi(v.y), bflo(v.z), bfhi(v.z), bflo(v.w), bfhi(v.w)};
            float s = 0.f;
#pragma unroll
            for (int j = 0; j < 8; ++j) s += f[j] * f[j];
            s += __shfl_xor(s, 1); s += __shfl_xor(s, 2); s += __shfl_xor(s, 4); s += __shfl_xor(s, 8);
            const float rs = 1.f / sqrtf(s * (1.f / 128.f) + NORM_EPS);
            u32x4 o; o.x = pk2(f[0] * rs * g[0], f[1] * rs * g[1]); o.y = pk2(f[2] * rs * g[2], f[3] * rs * g[3]); o.z = pk2(f[4] * rs * g[4], f[5] * rs * g[5]); o.w = pk2(f[6] * rs * g[6], f[7] * rs * g[7]);
            *(u32x4*)p = o;
        }
    }
    constexpr int C_A = 0, C_B = 17408, C_H = 52224, C_S = 69632;
    for (int unit = F.bid; unit < 256; unit += F.G) {
        int tid = F.tid, lane = F.lane; asm volatile("" : "+v"(tid), "+v"(lane));
        const int T = unit >> 7, b = (unit >> 3) & 15, g = (unit >> 2) & 1, cb = unit & 3;
        const int col = (T ? OVC : OKC) + g * 128;
        const float* pos = T ? A.in[20] : A.in[19];
        const bf16* w1t = (const bf16*)(F.ws + (T ? WS_W1V : WS_W1K)); const bf16* w2t = (const bf16*)(F.ws + WS_W2) + T * 128 * 128;
        const int wm = w >> 2, wn = w & 3, r = lane & 31, hh = lane >> 5;
        f32x16 acc = {0.f, 0.f, 0.f, 0.f, 0.f, 0.f, 0.f, 0.f, 0.f, 0.f, 0.f, 0.f, 0.f, 0.f, 0.f, 0.f};
        u32x4 va[2], vb[4]; f32x4 vp[2][2];
#define CMP_LOAD(l_) do { \
            _Pragma("unroll") for (int e = 0; e < 2; ++e) { const int q = tid + 512 * e, c = q >> 4, part = q & 15; const int tok = 16 * (64 * cb + c) + (l_); \
                va[e] = (u32x4){0u, 0u, 0u, 0u}; if (tok < SEQ) va[e] = *(const u32x4*)(U + ((size_t)b * SEQ + tok) * LDO + col + 8 * part); \
                vp[e][0] = *(const f32x4*)(pos + (l_) * 128 + 8 * part); vp[e][1] = *(const f32x4*)(pos + (l_) * 128 + 8 * part + 4); } \
            _Pragma("unroll") for (int e = 0; e < 4; ++e) { const int q = tid + 512 * e, j = q >> 4, part = q & 15; vb[e] = *(const u32x4*)(w1t + (size_t)j * 4096 + (l_) * 128 + 8 * part); } } while (0)
        CMP_LOAD(0);
#pragma unroll 1
        for (int l = 0; l < 32; ++l) {
            __syncthreads();
#pragma unroll
            for (int e = 0; e < 2; ++e) { const int q = tid + 512 * e, c = q >> 4, part = q & 15;
                const u32x4 v = va[e]; const f32x4 p0 = vp[e][0], p1 = vp[e][1];
                u32x4 o; o.x = pk2(bflo(v.x) + p0.x, bfhi(v.x) + p0.y); o.y = pk2(bflo(v.y) + p0.z, bfhi(v.y) + p0.w); o.z = pk2(bflo(v.z) + p1.x, bfhi(v.z) + p1.y); o.w = pk2(bflo(v.w) + p1.z, bfhi(v.w) + p1.w);
                *(LAS u32x4*)(L + C_A + (c * SP + 8 * part) * 2) = o; }
#pragma unroll
            for (int e = 0; e < 4; ++e) { const int q = tid + 512 * e, j = q >> 4, part = q & 15;
                *(LAS u32x4*)(L + C_B + (j * SP + 8 * part) * 2) = vb[e]; }
            { const int ln = l + 1 < 32 ? l + 1 : 31; CMP_LOAD(ln); }
            __syncthreads();
#pragma unroll
            for (int ks = 0; ks < 8; ++ks) {
                const bf16x8 af = lds_frag(L + C_A, 32 * wm + r, 16 * ks + 8 * hh), bfg = lds_frag(L + C_B, 32 * wn + r, 16 * ks + 8 * hh);
                acc = __builtin_amdgcn_mfma_f32_32x32x16_bf16(af, bfg, acc, 0, 0, 0);
            }
        }
#undef CMP_LOAD
#pragma unroll
        for (int i = 0; i < 16; ++i) { const int c = 32 * wm + 8 * (i >> 2) + 4 * hh + (i & 3);
            *(LAS bf16*)(L + C_H + (c * SP + 32 * wn + r) * 2) = (bf16)f2bfh(siluf(acc[i])); }
        __syncthreads();
        f32x16 a2 = {0.f, 0.f, 0.f, 0.f, 0.f, 0.f, 0.f, 0.f, 0.f, 0.f, 0.f, 0.f, 0.f, 0.f, 0.f, 0.f};
#pragma unroll
        for (int ks = 0; ks < 8; ++ks) {
            const bf16x8 af = lds_frag(L + C_H, 32 * wm + r, 16 * ks + 8 * hh), bfg = *(const bf16x8*)(w2t + (size_t)(32 * wn + r) * 128 + 16 * ks + 8 * hh);
            a2 = __builtin_amdgcn_mfma_f32_32x32x16_bf16(af, bfg, a2, 0, 0, 0);
        }
        float rsv[16];
        if (T == 0) {
            LAS float* st = (LAS float*)(L + C_S);
#pragma unroll
            for (int i = 0; i < 16; ++i) { float q = a2[i] * a2[i];
                q += __shfl_xor(q, 1); q += __shfl_xor(q, 2); q += __shfl_xor(q, 4); q += __shfl_xor(q, 8); q += __shfl_xor(q, 16);
                if (r == 0) st[(32 * wm + 8 * (i >> 2) + 4 * hh + (i & 3)) * 4 + wn] = q; }
            __syncthreads();
#pragma unroll
            for (int i = 0; i < 16; ++i) { const f32x4 q = *(const LAS f32x4*)(st + (32 * wm + 8 * (i >> 2) + 4 * hh + (i & 3)) * 4);
                rsv[i] = A.in[16][32 * wn + r] / sqrtf((q.x + q.y + q.z + q.w) * (1.f / 128.f) + NORM_EPS); }
        } else {
#pragma unroll
            for (int i = 0; i < 16; ++i) rsv[i] = 1.f;
        }
        bf16* dst = (bf16*)(F.ws + (T ? WS_VCMP : WS_KCMP));
#pragma unroll
        for (int i = 0; i < 16; ++i) { const int c = 64 * cb + 32 * wm + 8 * (i >> 2) + 4 * hh + (i & 3);
            dst[(((size_t)b * 256 + c) * 2 + g) * 128 + 32 * wn + r] = (bf16)f2bfh(a2[i] * rsv[i]); }
    }
}

constexpr int N_STG = 32768;
constexpr int N_K = 0, N_V = 16384, N_LUT = 3 * N_STG, N_IMP = N_LUT + 4096, N_FAC = N_IMP + 16384, N_MSK = N_FAC + 1024, N_UNI = N_MSK + 512, N_CST = N_UNI + 64, N_LUT2 = N_CST + 64;
constexpr float LOG2E = 1.44269504f;
enum { BR_CMP = 0, BR_SEL = 1, BR_WIN = 2 };
struct NsaCtx {
    LAS unsigned char* L; const bf16* U; const bf16* KC; const bf16* VC;
    int tid, lane, w, r, hh, b, g, qblk, t0, t, head; size_t bat;
    float mrow, cfar; unsigned mlo, mhi;
};
__device__ __forceinline__ void glds16(const void* gsrc, unsigned lds_dst) { unsigned keep;
    asm volatile("s_mov_b32 %0, m0\n\ts_mov_b32 m0, %2\n\ts_nop 0\n\tglobal_load_lds_dwordx4 %1, off\n\ts_mov_b32 m0, %0" : "=&s"(keep) : "v"(gsrc), "s"(lds_dst) : "memory"); }
#define NSA_BAR() do { asm volatile("" ::: "memory"); __builtin_amdgcn_s_barrier(); asm volatile("" ::: "memory"); } while (0)
template <int BR, bool PV>
__device__ __forceinline__ void nsa_dma(const NsaCtx& X, int tl, int st) {
    LAS unsigned char* L = X.L; const int lane = X.lane;
#pragma unroll
    for (int e = 0; e < 2; ++e) { const int pidx = e * 8 + X.w, row = pidx * 4 + (lane >> 4), ch = (lane & 15) ^ (((lane >> 4) << 2) | (X.w & 3));
        const bf16* kp; const bf16* vp;
        if (BR == BR_CMP) { const size_t o = (((size_t)X.b * 256 + 64 * tl + row) * 2 + X.g) * 128 + 8 * ch; kp = X.KC + o; vp = X.VC + o; }
        else { const size_t o = (X.bat + 64 * tl + row) * LDO + X.g * 128 + 8 * ch; kp = X.U + o + (BR == BR_SEL ? OKS : OKW); vp = X.U + o + (BR == BR_SEL ? OVS : OVW); }
        const unsigned ld = (unsigned)__builtin_amdgcn_readfirstlane((int)(unsigned)(__SIZE_TYPE__)(L + st * N_STG + N_K + pidx * 1024));
        glds16(kp, ld); if (PV) glds16(vp, ld + N_V); }
}
template <int BR, bool SUM, bool PV, bool IMP, bool UNITFAC = false, bool STASH = false, bool PRE0 = false>
__device__ __forceinline__ void nsa_pass(const NsaCtx& X, const bf16x8 (&qf)[8], f32x16 (&oacc)[4], float& lsum, const float colfac, const int tlo, const int thi, const unsigned long long tmask, u32x4* stash = nullptr) {
    LAS unsigned char* L = X.L; const int r = X.r, hh = X.hh, lane = X.lane;
    const LAS float* LUT = (const LAS float*)(L + N_LUT);
    auto dma = [&](int tl, int st) { nsa_dma<BR, PV>(X, tl, st); };
    auto nextt = [&](int tl) { ++tl; while (tl <= thi && !((tmask >> tl) & 1ull)) ++tl; return tl; };
    int tile = nextt(tlo - 1);
    if (tile > thi) return;
    asm volatile("s_waitcnt vmcnt(0)" ::: "memory");
    int nxt = nextt(tile);
    int nn = nxt <= thi ? nextt(nxt) : nxt;
    if (!PRE0) dma(tile, 0);
    if (nxt <= thi) dma(nxt, 1);
    int cur = 0;
    const bool gB = X.w >= 4;
    const int kswz = ((r & 3) << 2) | ((r >> 2) & 3);
#define NSA_WAIT_KEEP(has_newer) do { if (has_newer) { if (PV) asm volatile("s_waitcnt vmcnt(4)" ::: "memory"); else asm volatile("s_waitcnt vmcnt(2)" ::: "memory"); } else asm volatile("s_waitcnt vmcnt(0)" ::: "memory"); } while (0)
#define NSA_LDK(dst, stg, mt_, k0, k1) do { _Pragma("unroll") for (int ks = (k0); ks < (k1); ++ks) dst[ks - (k0)] = *(const LAS bf16x8*)(L + (stg) * N_STG + N_K + (32 * (mt_) + r) * 256 + 16 * ((2 * ks + hh) ^ kswz)); } while (0)
    NSA_WAIT_KEEP(nxt <= thi); NSA_BAR();
    bf16x8 kpre[2];
    NSA_LDK(kpre, 0, 0, 0, 2);
    if (gB) NSA_BAR();
    while (tile <= thi) {
        const int st2 = cur >= 1 ? cur - 1 : 2;
        const int st1 = cur == 2 ? 0 : cur + 1;
        if (gB) asm volatile("s_waitcnt vmcnt(0)" ::: "memory");
        NSA_BAR();
        if (gB && nn <= thi) dma(nn, st2);
        LAS unsigned char* Ls = L + cur * N_STG;
        const int maxpos = BR == BR_CMP ? 16 * (64 * tile + 63) + 31 : 64 * tile + 63, minpos = BR == BR_CMP ? 16 * (64 * tile) + 31 : 64 * tile;
        const bool farpos = X.t0 - maxpos >= 113, inwin = BR != BR_WIN || (X.t0 + 63 - minpos < 512);
        const bool far = farpos && inwin;
        bool selb = true; if (BR == BR_SEL) selb = (tile < 32 ? (X.mlo >> tile) : (X.mhi >> (tile - 32))) & 1u;
        const bool wsk = BR == BR_SEL && __ballot(selb) == 0ull;
        bf16x8 pa[2][2];
        if (!wsk) {
            bf16x8 kf0[6], kf1[8];
            NSA_LDK(kf0, cur, 0, 2, 8); NSA_LDK(kf1, cur, 1, 0, 8);
            asm volatile("" ::: "memory");
            f32x16 sacc[2];
#pragma unroll
            for (int mt = 0; mt < 2; ++mt) sacc[mt] = (f32x16){0.f, 0.f, 0.f, 0.f, 0.f, 0.f, 0.f, 0.f, 0.f, 0.f, 0.f, 0.f, 0.f, 0.f, 0.f, 0.f};
#pragma unroll
            for (int ks = 0; ks < 2; ++ks) sacc[0] = __builtin_amdgcn_mfma_f32_32x32x16_bf16(kpre[ks], qf[ks], sacc[0], 0, 0, 0);
#pragma unroll
            for (int ks = 2; ks < 8; ++ks) sacc[0] = __builtin_amdgcn_mfma_f32_32x32x16_bf16(kf0[ks - 2], qf[ks], sacc[0], 0, 0, 0);
#pragma unroll
            for (int ks = 0; ks < 8; ++ks) sacc[1] = __builtin_amdgcn_mfma_f32_32x32x16_bf16(kf1[ks], qf[ks], sacc[1], 0, 0, 0);
            const float cf = (BR == BR_SEL && !selb) ? -1.0e30f : X.cfar;
#pragma unroll
            for (int mt = 0; mt < 2; ++mt) {
                if (far) {
#pragma unroll
                    for (int i = 0; i < 16; ++i) { const float p = __builtin_amdgcn_exp2f(sacc[mt][i] + cf);
                        if (SUM && !PV) lsum += p; sacc[mt][i] = UNITFAC ? p : p * colfac; }
                } else if (BR == BR_CMP) {
#pragma unroll
                    for (int i = 0; i < 16; ++i) { const int kidx = 32 * mt + 8 * (i >> 2) + 4 * hh + (i & 3);
                        const int dist = X.t - (16 * (64 * tile + kidx) + 31); const bool ok = dist >= 0;
                        const int dc = dist < 0 ? 0 : (dist > 127 ? 127 : dist);
                        const float bia = LUT[dc * 8 + X.head];
                        const float ev = __builtin_amdgcn_exp2f(sacc[mt][i] + bia - X.mrow);
                        const float p = ok ? ev : 0.f;
                        if (SUM && !PV) lsum += p;
                        sacc[mt][i] = UNITFAC ? p : p * colfac; }
                } else if (BR == BR_WIN && farpos) {
                    const int dq = X.t - 64 * tile - 4 * hh;
#pragma unroll
                    for (int i = 0; i < 16; ++i) { const int koff = 32 * mt + 8 * (i >> 2) + (i & 3);
                        const float ev = __builtin_amdgcn_exp2f(sacc[mt][i] + X.cfar);
                        const float p = dq < 512 + koff ? ev : 0.f;
                        if (SUM && !PV) lsum += p;
                        sacc[mt][i] = UNITFAC ? p : p * colfac; }
                } else if (tile < X.qblk) {
                    const int dq = X.t - 64 * tile - 4 * hh;
                    const LAS float* lbm = (const LAS float*)(L + N_LUT2) + X.head * 384 + 64 + dq - 63;
                    const float mr = (BR == BR_SEL && !selb) ? 1.0e30f : X.mrow;
#pragma unroll
                    for (int i = 0; i < 16; ++i) { const int koff = 32 * mt + 8 * (i >> 2) + (i & 3);
                        const float p = __builtin_amdgcn_exp2f(sacc[mt][i] + lbm[63 - koff] - mr);
                        if (SUM && !PV) lsum += p;
                        sacc[mt][i] = UNITFAC ? p : p * colfac; }
                } else {
                    int dq = X.t - 64 * tile - 4 * hh;
                    const LAS float* lbm = (const LAS float*)(L + N_LUT2) + X.head * 384 + 64 + dq - 63;
                    if (BR == BR_SEL && !selb) dq = -1;
#pragma unroll
                    for (int i = 0; i < 16; ++i) { const int koff = 32 * mt + 8 * (i >> 2) + (i & 3);
                        const float ev = __builtin_amdgcn_exp2f(sacc[mt][i] + lbm[63 - koff] - X.mrow);
                        const float p = dq >= koff ? ev : 0.f;
                        if (SUM && !PV) lsum += p;
                        sacc[mt][i] = UNITFAC ? p : p * colfac; }
                }
                if (IMP) {
                    LAS float* imp = (LAS float*)(L + N_IMP) + (X.w * 8 + (r >> 2)) * 64;
#pragma unroll
                    for (int q = 0; q < 4; ++q) { float s4 = (sacc[mt][4 * q] + sacc[mt][4 * q + 1]) + (sacc[mt][4 * q + 2] + sacc[mt][4 * q + 3]), s3 = sacc[mt][4 * q + 3];
                        s4 += xor1(s4); s4 += xor2(s4); s3 += xor1(s3); s3 += xor2(s3);
                        const int n = 16 * tile + 8 * mt + 2 * q + hh;
                        if ((r & 3) == 0) { __hip_atomic_fetch_add(imp + n, s4, __ATOMIC_RELAXED, __HIP_MEMORY_SCOPE_WORKGROUP); if (n < 63) __hip_atomic_fetch_add(imp + n + 1, s3, __ATOMIC_RELAXED, __HIP_MEMORY_SCOPE_WORKGROUP); } }
                }
                if (PV) {
#pragma unroll
                    for (int sI = 0; sI < 2; ++sI) { u32x4 pp; pp.x = pk2(sacc[mt][8 * sI], sacc[mt][8 * sI + 1]); pp.y = pk2(sacc[mt][8 * sI + 2], sacc[mt][8 * sI + 3]); pp.z = pk2(sacc[mt][8 * sI + 4], sacc[mt][8 * sI + 5]); pp.w = pk2(sacc[mt][8 * sI + 6], sacc[mt][8 * sI + 7]);
                        if (STASH) stash[((tile * 2 + mt) * 2 + sI) * 64] = pp;
                        if (SUM) { lsum = dot2ones(pp.x, lsum); lsum = dot2ones(pp.y, lsum); lsum = dot2ones(pp.z, lsum); lsum = dot2ones(pp.w, lsum); }
                        pa[mt][sI] = __builtin_bit_cast(bf16x8, pp); }
                }
            }
        } else {
#pragma unroll
            for (int mt = 0; mt < 2; ++mt)
#pragma unroll
                for (int sI = 0; sI < 2; ++sI) pa[mt][sI] = (bf16x8){0, 0, 0, 0, 0, 0, 0, 0};
        }
        const int q4 = (lane & 15) >> 2, k2 = 2 * ((lane >> 4) & 1) + ((lane & 3) >> 1), sub8 = 8 * (lane & 1);
        s16x4 vb[2][8];
#define NSA_LDV(g, dst) do { const int _row0 = 16 * (g) + 4 * hh + q4; _Pragma("unroll") for (int nt = 0; nt < 4; ++nt) { \
            dst[2 * nt] = lds_tr16(Ls + N_V + _row0 * 256 + 64 * (nt ^ q4) + 16 * (k2 ^ hh) + sub8); \
            dst[2 * nt + 1] = lds_tr16(Ls + N_V + (_row0 + 8) * 256 + 64 * (nt ^ q4) + 16 * (k2 ^ (hh + 2)) + sub8); } } while (0)
        if (!gB) asm volatile("s_waitcnt vmcnt(0)" ::: "memory");
        NSA_BAR();
        if (!gB && nn <= thi) dma(nn, st2);
        if (PV) {
            NSA_LDV(0, vb[0]);
#pragma unroll
            for (int g = 0; g < 4; ++g) {
                if (g == 0) NSA_LDV(1, vb[1]); else if (g == 1) NSA_LDV(2, vb[0]); else if (g == 2) NSA_LDV(3, vb[1]);
                asm volatile("" ::: "memory");
#pragma unroll
                for (int nt = 0; nt < 4; ++nt) { const s16x4 b0 = vb[g & 1][2 * nt], b1 = vb[g & 1][2 * nt + 1];
                    bf16x8 bfg; bfg[0] = b0[0]; bfg[1] = b0[1]; bfg[2] = b0[2]; bfg[3] = b0[3]; bfg[4] = b1[0]; bfg[5] = b1[1]; bfg[6] = b1[2]; bfg[7] = b1[3];
                    oacc[nt] = __builtin_amdgcn_mfma_f32_32x32x16_bf16(pa[g >> 1][g & 1], bfg, oacc[nt], 0, 0, 0); }
            }
        }
#undef NSA_LDV
        if (nxt <= thi) NSA_LDK(kpre, st1, 0, 0, 2);
        tile = nxt; nxt = nn; nn = nn <= thi ? nextt(nn) : nn;
        cur = cur == 2 ? 0 : cur + 1;
    }
#undef NSA_WAIT_KEEP
#undef NSA_LDK
    if (!gB) NSA_BAR();
    __syncthreads();
}

__device__ __forceinline__ void p_nsa(Frame& F, const Args& A) {
    const bf16* U = (const bf16*)(F.ws + WS_U); bf16* HB = (bf16*)(F.ws + WS_HB); const float* GL = (const float*)(F.ws + WS_GL);
    LAS unsigned char* L = F.lds;
    LAS float* LUT = (LAS float*)(L + N_LUT); LAS float* cst = (LAS float*)(L + N_CST);
    for (int i = F.tid; i < 1024; i += NTHR) LUT[i] = A.in[1][t5_bucket_dev(i >> 3) * 8 + (i & 7)] * LOG2E;
    if (F.wave == 0) {
        float gm = 0.f, bm = 0.f;
        for (int i = F.lane; i < 128; i += 64) gm = fmaxf(gm, fmaxf(fabsf(A.in[16][i]), fmaxf(fabsf(A.in[17][i]), fabsf(A.in[18][i]))));
        for (int i = F.lane; i < 256; i += 64) bm = fmaxf(bm, fabsf(A.in[1][i]));
#pragma unroll
        for (int o = 1; o < 64; o <<= 1) { gm = fmaxf(gm, __shfl_xor(gm, o)); bm = fmaxf(bm, __shfl_xor(bm, o)); }
        if (F.lane == 0) { cst[0] = gm * 11.3137085f; cst[1] = bm * LOG2E; }
    }
    __syncthreads();
    for (int i = F.tid; i < 8 * 384; i += NTHR) { const int h = i / 384, dd = i % 384 - 64; const int d = dd < 0 ? 0 : (dd > 127 ? 127 : dd); ((LAS float*)(L + N_LUT2))[i] = LUT[d * 8 + h]; }
    __syncthreads();
    const float kmax = cst[0], bmax = cst[1];
    for (int ui = F.bid; ui < 2048; ui += F.G) {
        NsaCtx X; X.L = L; X.U = U; X.KC = (const bf16*)(F.ws + WS_KCMP); X.VC = (const bf16*)(F.ws + WS_VCMP);
        int tid = F.tid, lane = F.lane; asm volatile("" : "+v"(tid), "+v"(lane));
        X.tid = tid; X.lane = lane; X.w = F.wave; X.r = lane & 31; X.hh = lane >> 5;
        const int kr = ui >> 8, cc = ui & 255, bg = (cc & 7) * 4 + (kr >> 1), sl = cc >> 3;
        X.b = bg >> 1; X.g = bg & 1; X.qblk = (kr & 1) ? 63 - sl : sl; X.t0 = 64 * X.qblk; X.bat = (size_t)X.b * SEQ;
        const int tq = X.r >> 2, hd = X.r & 3; X.t = X.t0 + 8 * X.w + tq; X.head = 4 * X.g + hd;
        const size_t row = X.bat + X.t;
        if (tid == 0) { unsigned z = 0u; asm volatile("" : "+v"(z)); *(LAS u32x2*)(L + N_UNI) = (u32x2){z, z}; }
        for (int i = tid; i < 4096; i += NTHR) ((LAS float*)(L + N_IMP))[i] = 0.f;
        bf16x8 qf[8]; float qn2 = 0.f;
        {
            u32x4 qr[8]; float ss = 0.f;
#pragma unroll
            for (int ks = 0; ks < 8; ++ks) { qr[ks] = *(const u32x4*)(U + row * LDO + OQ + X.head * 128 + 16 * ks + 8 * X.hh);
#pragma unroll
                for (int e = 0; e < 4; ++e) { const float a = bflo(qr[ks][e]), c = bfhi(qr[ks][e]); ss += a * a + c * c; } }
            ss += __shfl_xor(ss, 32);
            const float rs = 1.f / sqrtf(ss * (1.f / 128.f) + NORM_EPS);
#pragma unroll
            for (int ks = 0; ks < 8; ++ks) { const float* gq = A.in[15] + 16 * ks + 8 * X.hh; u32x4 pk;
#pragma unroll
                for (int e = 0; e < 4; ++e) { const float a = bflo(qr[ks][e]) * rs * gq[2 * e], c = bfhi(qr[ks][e]) * rs * gq[2 * e + 1]; qn2 += a * a + c * c; pk[e] = pk2(a * (0.0883883476f * LOG2E), c * (0.0883883476f * LOG2E)); }
                qf[ks] = __builtin_bit_cast(bf16x8, pk); }
            qn2 += __shfl_xor(qn2, 32);
        }
        X.mrow = sqrtf(qn2) * (0.0883883476f * LOG2E) * kmax + bmax;
        X.cfar = LUT[127 * 8 + X.head] - X.mrow;
        X.mlo = 0u; X.mhi = 0u;
        const float gl3[3] = {GL[row * 24 + X.head], GL[row * 24 + 8 + X.head], GL[row * 24 + 16 + X.head]};
#define NSA_GATE(k_) (1.f / (1.f + __expf(-gl3[(k_)])))
        f32x16 oacc[4];
#pragma unroll
        for (int nt = 0; nt < 4; ++nt) oacc[nt] = (f32x16){0.f, 0.f, 0.f, 0.f, 0.f, 0.f, 0.f, 0.f, 0.f, 0.f, 0.f, 0.f, 0.f, 0.f, 0.f, 0.f};
        const int ntc = ((4 * X.qblk + 2) >> 6) + 1;
#define NSA_FOLD(fcol, FIRST, LAST) do { int _pl = F.lane; asm volatile("" : "+v"(_pl)); u32x4* park = (u32x4*)(F.ws + WS_PARK) + ((size_t)(F.bid * NWAVES + X.w) * 64 + _pl) * 8; \
            LAS float* _fac = (LAS float*)(L + N_FAC) + X.w * 32; LDS_WAIT(); if (lane < 32) _fac[lane] = (fcol); LDS_WAIT(); \
            if (!(FIRST)) { asm volatile("s_waitcnt vmcnt(0)" ::: "memory"); __builtin_amdgcn_fence(__ATOMIC_ACQUIRE, "agent"); } \
            _Pragma("unroll") for (int nt = 0; nt < 4; ++nt) { u32x4 _p0 = (u32x4){0u, 0u, 0u, 0u}, _p1 = _p0; if (!(FIRST)) { _p0 = park[2 * nt]; _p1 = park[2 * nt + 1]; } \
                _Pragma("unroll") for (int q = 0; q < 4; ++q) { const f32x4 _fr = *(const LAS f32x4*)(_fac + 8 * q + 4 * X.hh); const unsigned _wa = q < 2 ? _p0[2 * q] : _p1[2 * q - 4], _wb = q < 2 ? _p0[2 * q + 1] : _p1[2 * q - 3]; \
                    float _a = oacc[nt][4 * q] * _fr.x, _b = oacc[nt][4 * q + 1] * _fr.y, _c = oacc[nt][4 * q + 2] * _fr.z, _d = oacc[nt][4 * q + 3] * _fr.w; \
                    if (!(FIRST)) { _a += bflo(_wa); _b += bfhi(_wa); _c += bflo(_wb); _d += bfhi(_wb); } \
                    oacc[nt][4 * q] = _a; oacc[nt][4 * q + 1] = _b; oacc[nt][4 * q + 2] = _c; oacc[nt][4 * q + 3] = _d; } \
                if (!(LAST)) { park[2 * nt] = (u32x4){pk2(oacc[nt][0], oacc[nt][1]), pk2(oacc[nt][2], oacc[nt][3]), pk2(oacc[nt][4], oacc[nt][5]), pk2(oacc[nt][6], oacc[nt][7])}; \
                               park[2 * nt + 1] = (u32x4){pk2(oacc[nt][8], oacc[nt][9]), pk2(oacc[nt][10], oacc[nt][11]), pk2(oacc[nt][12], oacc[nt][13]), pk2(oacc[nt][14], oacc[nt][15])}; \
                               oacc[nt] = (f32x16){0.f, 0.f, 0.f, 0.f, 0.f, 0.f, 0.f, 0.f, 0.f, 0.f, 0.f, 0.f, 0.f, 0.f, 0.f, 0.f}; } } } while (0)
        float l_c = 0.f;
        u32x4* stash = (u32x4*)(F.ws + WS_STASH) + (size_t)(F.bid * NWAVES + X.w) * (16 * 64) + lane;
        nsa_pass<BR_CMP, true, true, false, true, true>(X, qf, oacc, l_c, 1.f, 0, ntc - 1, ~0ull, stash);
        nsa_dma<BR_SEL, true>(X, 0, 0);
        l_c += __shfl_xor(l_c, 32);
        const float il_c = l_c > 0.f ? 1.f / l_c : 0.f;
        NSA_FOLD(NSA_GATE(0) * il_c, true, false);
        {
            asm volatile("s_waitcnt vmcnt(0)" ::: "memory"); __builtin_amdgcn_fence(__ATOMIC_ACQUIRE, "agent");
            LAS float* imp = (LAS float*)(L + N_IMP) + (X.w * 8 + (X.r >> 2)) * 64;
#pragma unroll 1
            for (int tile = 0; tile < ntc; ++tile) {
                u32x4 pp[2][2];
#pragma unroll
                for (int mt = 0; mt < 2; ++mt)
#pragma unroll
                    for (int sI = 0; sI < 2; ++sI) pp[mt][sI] = stash[((tile * 2 + mt) * 2 + sI) * 64];
#pragma unroll
                for (int mt = 0; mt < 2; ++mt) {
                    float v[16];
#pragma unroll
                    for (int sI = 0; sI < 2; ++sI)
#pragma unroll
                        for (int e = 0; e < 4; ++e) { v[8 * sI + 2 * e] = bflo(pp[mt][sI][e]); v[8 * sI + 2 * e + 1] = bfhi(pp[mt][sI][e]); }
#pragma unroll
                    for (int q = 0; q < 4; ++q) { float s4 = ((v[4 * q] + v[4 * q + 1]) + (v[4 * q + 2] + v[4 * q + 3])) * il_c, s3 = v[4 * q + 3] * il_c;
                        s4 += xor1(s4); s4 += xor2(s4); s3 += xor1(s3); s3 += xor2(s3);
                        const int n = 16 * tile + 8 * mt + 2 * q + X.hh;
                        if ((X.r & 3) == 0) { __hip_atomic_fetch_add(imp + n, s4, __ATOMIC_RELAXED, __HIP_MEMORY_SCOPE_WORKGROUP); if (n < 63) __hip_atomic_fetch_add(imp + n + 1, s3, __ATOMIC_RELAXED, __HIP_MEMORY_SCOPE_WORKGROUP); } }
                }
            }
        }
        {
            LDS_WAIT();
            const LAS float* impw = (const LAS float*)(L + N_IMP) + X.w * 8 * 64;
            const int n = lane, cur = X.qblk;
            unsigned long long wor = 0ull;
#pragma unroll 1
            for (int q = 0; q < 8; ++q) {
                const float imp = impw[q * 64 + n];
                const bool forced = (n == 0) || (n == cur) || (n == cur - 1);
                unsigned key = forced ? 0x7fffffc0u : (__builtin_bit_cast(unsigned, imp) & 0x7fffffc0u);
                if (n > cur) key = 0u;
                key |= (unsigned)(63 - n);
                unsigned T = 0u;
#pragma unroll
                for (int bit = 30; bit >= 0; --bit) { const unsigned cand = T | (1u << bit); T = __popcll(__ballot(key >= cand)) >= 16 ? cand : T; }
                const unsigned long long mk = __ballot(n <= cur && key >= T);
                wor |= mk;
                if ((X.r >> 2) == q) { X.mlo = (unsigned)mk; X.mhi = (unsigned)(mk >> 32); }
            }
            if (lane == 0) __hip_atomic_fetch_or((LAS unsigned long long*)(L + N_UNI), wor, __ATOMIC_RELAXED, __HIP_MEMORY_SCOPE_WORKGROUP);
        }
        __syncthreads();
        const unsigned long long uni = *(const LAS unsigned long long*)(L + N_UNI);
        float l_s = 0.f;
        nsa_pass<BR_SEL, true, true, false, true, false, true>(X, qf, oacc, l_s, 1.f, 0, X.qblk, uni);
        const int wlo = X.qblk >= 8 ? X.qblk - 8 : 0;
        nsa_dma<BR_WIN, true>(X, wlo, 0);
        l_s += __shfl_xor(l_s, 32);
        NSA_FOLD(l_s > 0.f ? NSA_GATE(1) / l_s : 0.f, false, false);
        float l_w = 0.f;
        nsa_pass<BR_WIN, true, true, false, true, false, true>(X, qf, oacc, l_w, 1.f, wlo, X.qblk, ~0ull);
        l_w += __shfl_xor(l_w, 32);
        NSA_FOLD(l_w > 0.f ? NSA_GATE(2) / l_w : 0.f, false, true);
#undef NSA_FOLD
#undef NSA_GATE
        const bool odd = X.r & 1;
#pragma unroll
        for (int i = 0; i < 16; i += 2) { const int c32 = 8 * (i >> 2) + 4 * X.hh + (i & 3);
            unsigned char* op = (unsigned char*)HB + (X.bat + X.t0 + 8 * X.w + (c32 >> 2)) * DM + (4 * X.g + (c32 & 3) + (odd ? 1 : 0)) * 128 + (X.r & ~1);
#pragma unroll
            for (int nt = 0; nt < 4; ++nt) { const float a = oacc[nt][i] * F8_SX, b = oacc[nt][i + 1] * F8_SX; const float rcv = xor1(odd ? a : b);
                *(unsigned short*)(op + 32 * nt) = odd ? pk2_fp8(rcv, b) : pk2_fp8(a, rcv); } }
    }
}

constexpr int N_PHASES = 18;
__global__ void __launch_bounds__(NTHR, 2) mk_fwd(Args args) {
    extern __shared__ __attribute__((aligned(16))) unsigned char lds[];
    Frame F;
    F.lds = (LAS unsigned char*)lds;
    F.MISC = (volatile LAS unsigned*)(F.lds + MISC_OFF);
    F.tid = threadIdx.x; F.lane = F.tid & 63; F.wave = __builtin_amdgcn_readfirstlane(F.tid >> 6);
    F.G = gridDim.x; F.bid = blockIdx.x;
    F.ws = args.ws; F.out = args.out; F.ctl = (gu32*)(args.ws + WS_CTL);
    if (F.tid < 64) F.MISC[F.tid] = 0u;
    __syncthreads();
    const int lo = args.ph_lo, hi = args.ph_hi;
    XcdBarrier bar; bar.bar = (unsigned*)(F.ctl + CW_BAR); bar.x = 0; bar.st = nullptr;
    if (hi - lo > 1) bar = xcd_barrier_post((unsigned*)(F.ctl + CW_BAR), F.MISC + 8);
#ifndef PHMASK
#define PHMASK 0xffffffffu
#endif
#define IN(k) (((PHMASK >> (k)) & 1u) && lo <= (k) && (k) < hi)
#ifndef REPMASK
#define REPMASK 0u
#endif
#define RUNS(k) (1 + (int)((REPMASK >> (k)) & 1u))
#define SEAM(k) do { if (IN(k) && IN((k) + 1)) xcd_barrier(bar); } while (0)
    if (IN(0)) { p_wmax(F, args); xcd_barrier(bar); for (int rp = 0; rp < RUNS(0); ++rp) p_prologue(F, args); } SEAM(0);
    if (IN(1)) for (int rp = 0; rp < RUNS(1); ++rp) {
        pg8::StaticOrder S; S.init(F.ws + WS_HB, F.ws + WS_WIE, MTOK, LDE, DM / 2, F.G, F.bid);
        pg8::EpiI8S E{(bf16*)(F.ws + WS_U), LDE, (const float*)(F.ws + WS_RS), (const unsigned*)(F.ctl + CW_WMAX), F.ws + WS_IQK8};
        pg8::gemm_phase<pg8::EpiI8S, pg8::StaticOrder, true, 2>(F.lds, DM / 2, S, E);
    } SEAM(1);
    if (IN(2)) { p_ssd1(F, args); xcd_barrier(bar); p_ssd2(F); xcd_barrier(bar); p_ssd3(F); } SEAM(2);
    if (IN(3)) { for (int rp = 0; rp < RUNS(3); ++rp) p_dsa(F, args); } SEAM(3);
    if (IN(4)) {
        pg8::StaticOrder S; S.init(F.ws + WS_HB, F.ws + WS_WOE, MTOK, DM, DM / 2, F.G, F.bid);
        pg8::EpiResXB E{args.in[0], nullptr, (bf16*)(F.ws + WS_XB), F.ws + WS_XB8, 1.f / (F8_SX * F8_SW)};
        pg8::gemm_phase<pg8::EpiResXB, pg8::StaticOrder, true, true>(F.lds, DM / 2, S, E);
    } SEAM(4);
    if (IN(5)) { p_norm_route<0>(F, (const bf16*)(F.ws + WS_XB), 0); } SEAM(5);
    if (IN(6)) { p_moe_gu(F, 0);
#if (REPMASK >> 6) & 1
        p_moe_gu(F, 0);
#endif
    } SEAM(6);
    if (IN(7)) { p_moe_down<false>(F, 0, 0); } SEAM(7);
    if (IN(8)) { p_moe_down<false>(F, 0, 1); } SEAM(8);
    if (IN(9)) { for (int rp = 0; rp < RUNS(9); ++rp) p_norm_route<1>(F, (const bf16*)(F.ws + WS_XB), 0); } SEAM(9);
    if (IN(10)) {
        pg8::StaticOrder S; S.init(F.ws + WS_HB, F.ws + WS_WIO, MTOK, LDO, DM / 2, F.G, F.bid);
        pg8::EpiI8S E{(bf16*)(F.ws + WS_U), LDO, (const float*)(F.ws + WS_RS), (const unsigned*)(F.ctl + CW_WMAX + 1), nullptr};
        pg8::gemm_phase<pg8::EpiI8S, pg8::StaticOrder, true, 2>(F.lds, DM / 2, S, E);
    } SEAM(10);
    if (IN(11)) { p_compress(F, args); } SEAM(11);
    if (IN(12)) { p_nsa(F, args);
#if (REPMASK >> 12) & 1
        p_nsa(F, args);
#endif
    } SEAM(12);
    if (IN(13)) {
        pg8::StaticOrder S; S.init(F.ws + WS_HB, F.ws + WS_WOO, MTOK, DM, DM / 2, F.G, F.bid);
        pg8::EpiResXB E{nullptr, (const bf16*)(F.ws + WS_XB), (bf16*)(F.ws + WS_XB), F.ws + WS_XB8, 1.f / (F8_SX * F8_SW)};
        pg8::gemm_phase<pg8::EpiResXB, pg8::StaticOrder, true, true>(F.lds, DM / 2, S, E);
    } SEAM(13);
    if (IN(14)) { p_norm_route<0>(F, (const bf16*)(F.ws + WS_XB), 1); } SEAM(14);
    if (IN(15)) { p_moe_gu(F, 1); } SEAM(15);
    if (IN(16)) { p_moe_down<false>(F, 1, 0); } SEAM(16);
    if (IN(17)) { p_moe_down<true>(F, 1, 1); }
#undef IN
#undef SEAM
}

extern "C" void kernel_launch(void* const* d_in, const int* in_sizes, int n_in, void* d_out, int out_size, void* d_ws, size_t ws_size, hipStream_t stream) {
    static int grid = 0;
    if (grid == 0) {
        if (n_in != 31 || ws_size < WS_END) { fprintf(stderr, "kernel_launch: unexpected n_in %d / ws %zu\n", n_in, ws_size); grid = -1; return; }
        int dev = 0, cus = 0;
        if (hipGetDevice(&dev) != hipSuccess || hipDeviceGetAttribute(&cus, hipDeviceAttributeMultiprocessorCount, dev) != hipSuccess) { grid = -1; return; }
        if (hipFuncSetAttribute((const void*)mk_fwd, hipFuncAttributeMaxDynamicSharedMemorySize, LDS_BYTES) != hipSuccess) { fprintf(stderr, "kernel_launch: hipFuncSetAttribute failed\n"); grid = -1; return; }
        grid = cus;
    }
    if (grid < 0) return;
    (void)hipMemsetAsync((char*)d_ws + WS_CTL, 0, CTL_ZERO_BYTES, stream);
    Args a{};
    for (int i = 0; i < 31; ++i) a.in[i] = (const float*)d_in[i];
    a.out = (float*)d_out; a.ws = (unsigned char*)d_ws; a.rep = (REP_PART || REP_PHASE >= 0) ? 2 : 1; a.pad = 0; a.rep = 2; a.pad = 0;
#if defined(MK_PER_PHASE)
    for (int p = 0; p < N_PHASES; ++p) { a.ph_lo = p; a.ph_hi = p + 1; hipLaunchKernelGGL(mk_fwd, dim3(grid), dim3(NTHR), LDS_BYTES, stream, a); }
#else
    a.ph_lo = 0; a.ph_hi = N_PHASES; hipLaunchKernelGGL(mk_fwd, dim3(grid), dim3(NTHR), LDS_BYTES, stream, a);
#endif
}
```

```cpp
#include <hip/hip_runtime.h>
#include <cstdio>
#include <cstdint>

#define GAS __attribute__((address_space(1)))
#define LAS __attribute__((address_space(3)))
typedef unsigned short bf16;
typedef short bf16x8 __attribute__((ext_vector_type(8)));
typedef float f32x4 __attribute__((ext_vector_type(4)));
typedef float f32x2 __attribute__((ext_vector_type(2)));
typedef float f32x16 __attribute__((ext_vector_type(16)));
typedef unsigned u32x4 __attribute__((ext_vector_type(4)));
typedef unsigned u32x2 __attribute__((ext_vector_type(2)));
typedef GAS unsigned gu32;
#define RLX_AGENT __ATOMIC_RELAXED, __HIP_MEMORY_SCOPE_AGENT
#define LDS_WAIT() asm volatile("s_waitcnt lgkmcnt(0)" ::: "memory")
#define VM_WAIT() asm volatile("s_waitcnt vmcnt(0)" ::: "memory")

constexpr int NB = 16, SEQ = 4096, DM = 1024, MTOK = NB * SEQ;
constexpr float NORM_EPS = 1e-6f;
constexpr int LDE = 2560;
constexpr int EZ = 0, EXS = 512, EBB = 1024, ECC = 1280, EQ = 1536, EK = 2048, EV = 2112, EIQ = 2176, EIK = 2432, EDT = 2496, EIW = 2504;
constexpr int LDO = 2560;
constexpr int OQ = 0, OKC = 1024, OVC = 1280, OKS = 1536, OVS = 1792, OKW = 2048, OVW = 2304;
constexpr int NWAVES = 8, NTHR = 512;

constexpr size_t MiB = 1u << 20;
constexpr size_t WS_CTL = 0, CTL_ZERO_BYTES = 128 * 1024;
constexpr size_t WS_WIE = 1 * MiB, WS_WOE = 6 * MiB, WS_WIO = 8 * MiB, WS_WOO = 13 * MiB;
constexpr size_t WS_W1K = 15 * MiB, WS_W1V = 16 * MiB, WS_W2 = 17 * MiB, WS_WR = 18 * MiB;
constexpr size_t WS_WGL = WS_WR + 256 * 1024;
constexpr size_t WS_TOK = 19 * MiB;
constexpr size_t WS_GL = 20 * MiB;
constexpr size_t WS_KCMP = 26 * MiB, WS_VCMP = 28 * MiB;
constexpr size_t WS_LIST = 32 * MiB;
constexpr size_t WS_WGU = 48 * MiB;
constexpr size_t WS_WD = 176 * MiB;
constexpr size_t WS_HB = 240 * MiB;
constexpr size_t WS_U = 368 * MiB;
constexpr size_t WS_LISTW = 720 * MiB;
constexpr size_t WS_XB = 736 * MiB;
constexpr size_t WS_PARK = 864 * MiB;
constexpr size_t WS_CC = 880 * MiB;
constexpr size_t WS_AC = 912 * MiB;
constexpr size_t WS_XB8 = 368 * MiB;
constexpr size_t WS_H8 = 432 * MiB;
constexpr size_t WS_LISTR = 916 * MiB;
constexpr size_t WS_RS = 932 * MiB;
constexpr size_t WS_STASH = 933 * MiB;
constexpr size_t WS_IQK8 = 965 * MiB;
constexpr size_t WS_K8 = 985 * MiB;
constexpr size_t WS_END = 989 * MiB;
constexpr int CW_TMO = 0, CW_CODE = 1, CW_WMAX = 16, CW_BAR = 4096, CW_CNT = 8192;

constexpr int RING_BYTES = 131072;
constexpr int LDS_BYTES = 147456;
constexpr int MISC_OFF = LDS_BYTES - 256;
constexpr int MOE_OFF = LDS_BYTES - 2048;

__device__ __forceinline__ unsigned f2bf(float f) { unsigned u = __builtin_bit_cast(unsigned, f); return (u + 0x7fffu + ((u >> 16) & 1u)) >> 16; }
typedef __bf16 bf16x2_t __attribute__((ext_vector_type(2)));
constexpr float F8_SX = 8.f, F8_SH = 8.f, F8_SW = 64.f;
__device__ __forceinline__ unsigned pk4_fp8(float a, float b, float c, float d) {
    a = __builtin_amdgcn_fmed3f(a, -448.f, 448.f); b = __builtin_amdgcn_fmed3f(b, -448.f, 448.f); c = __builtin_amdgcn_fmed3f(c, -448.f, 448.f); d = __builtin_amdgcn_fmed3f(d, -448.f, 448.f);
    int w = __builtin_amdgcn_cvt_pk_fp8_f32(a, b, 0, false); w = __builtin_amdgcn_cvt_pk_fp8_f32(c, d, w, true); return (unsigned)w; }
__device__ __forceinline__ unsigned pk4_i8(float a, float b, float c, float d) {
    const int ia = __float2int_rn(__builtin_amdgcn_fmed3f(a, -127.f, 127.f)), ib = __float2int_rn(__builtin_amdgcn_fmed3f(b, -127.f, 127.f)),
              ic = __float2int_rn(__builtin_amdgcn_fmed3f(c, -127.f, 127.f)), id = __float2int_rn(__builtin_amdgcn_fmed3f(d, -127.f, 127.f));
    return (unsigned)(ia & 255) | ((unsigned)(ib & 255) << 8) | ((unsigned)(ic & 255) << 16) | ((unsigned)id << 24); }
__device__ __forceinline__ unsigned pk4_i8m(float a, float b, float c, float d) {
    const unsigned ua = __builtin_bit_cast(unsigned, a + 12582912.f), ub = __builtin_bit_cast(unsigned, b + 12582912.f), uc = __builtin_bit_cast(unsigned, c + 12582912.f), ud = __builtin_bit_cast(unsigned, d + 12582912.f);
    return (ua & 255u) | ((ub & 255u) << 8) | ((uc & 255u) << 16) | (ud << 24); }
__device__ __forceinline__ unsigned short pk2_fp8(float a, float b) { a = __builtin_amdgcn_fmed3f(a, -448.f, 448.f); b = __builtin_amdgcn_fmed3f(b, -448.f, 448.f); return (unsigned short)__builtin_amdgcn_cvt_pk_fp8_f32(a, b, 0, false); }
__device__ __forceinline__ unsigned pk2(float lo, float hi) { const f32x2 v = {lo, hi}; const bf16x2_t b = __builtin_convertvector(v, bf16x2_t); return __builtin_bit_cast(unsigned, b); }
__device__ __forceinline__ unsigned short f2bfh(float f) { return (unsigned short)(pk2(f, f) & 0xffffu); }
__device__ __forceinline__ float bf2f(unsigned short b) { return __builtin_bit_cast(float, ((unsigned)b) << 16); }
__device__ __forceinline__ float bflo(unsigned w) { return __builtin_bit_cast(float, w << 16); }
__device__ __forceinline__ float bfhi(unsigned w) { return __builtin_bit_cast(float, w & 0xffff0000u); }
__device__ __forceinline__ float siluf(float v) { return v * __builtin_amdgcn_rcpf(1.f + __builtin_amdgcn_exp2f(-1.44269504f * v)); }

#define XB_TMO      128
#define XB_XCNT(j)  (256  + 64 * (j))
#define XB_XSUB(j)  (1280 + 64 * (j))
#define XB_XGEN(j)  (2304 + 64 * (j))
#define XB_TOP      3328
#define XB_TOPGEN   3392
#define XCD_BAR_WORDS 3456
#define XB_SPIN_CAP (1u << 20)
__device__ __forceinline__ unsigned xb_ld(unsigned* p)              { return __hip_atomic_load(p, __ATOMIC_RELAXED, __HIP_MEMORY_SCOPE_AGENT); }
__device__ __forceinline__ unsigned xb_add(unsigned* p, unsigned v) { return __hip_atomic_fetch_add(p, v, __ATOMIC_RELAXED, __HIP_MEMORY_SCOPE_AGENT); }
__device__ __forceinline__ unsigned xb_xcc_id() { return (unsigned)__builtin_amdgcn_s_getreg((3 << 11) | 20) & 0xFu; }
#define XB_SPIN(cond, bar) do { unsigned _sp = 0; while (cond) { __builtin_amdgcn_s_sleep(1); \
    if ((++_sp & 255u) == 0u) { if (xb_ld(&(bar)[XB_TMO])) break; if (_sp > XB_SPIN_CAP) { atomicAdd(&(bar)[XB_TMO], 1u); break; } } } } while (0)
struct XcdBarrier { unsigned* bar; unsigned x; volatile LAS unsigned* st; };
__device__ __forceinline__ XcdBarrier xcd_barrier_post(unsigned* bar, volatile LAS unsigned* st) {
    XcdBarrier b; b.bar = bar; b.x = xb_xcc_id(); b.st = st;
    if (threadIdx.x == 0) (void)xb_add(&bar[XB_XCNT(b.x)], 1u);
    return b;
}
__device__ __forceinline__ void xcd_barrier_complete(unsigned* bar, unsigned x, unsigned& nloc, unsigned& nx) {
    const unsigned G = gridDim.x * gridDim.y * gridDim.z;
    unsigned sum, cnt, mine, sp = 0u;
    for (;;) {
        sum = 0u; cnt = 0u; mine = 0u;
#pragma unroll
        for (unsigned j = 0; j < 16; ++j) { const unsigned c = xb_ld(&bar[XB_XCNT(j)]); sum += c; cnt += (c > 0u) ? 1u : 0u; mine = (j == x) ? c : mine; }
        if (sum == G) break;
        __builtin_amdgcn_s_sleep(1);
        if ((++sp & 255u) == 0u) { if (xb_ld(&bar[XB_TMO])) break; if (sp > XB_SPIN_CAP) { atomicAdd(&bar[XB_TMO], 1u); break; } }
    }
    nloc = mine > 0u ? mine : 1u; nx = cnt > 0u ? cnt : 1u;
}
__device__ __forceinline__ void xcd_barrier(const XcdBarrier& b) {
    asm volatile("s_waitcnt vmcnt(0)" ::: "memory");
    __syncthreads();
    if (threadIdx.x == 0) {
        unsigned* bar = b.bar;
        __builtin_amdgcn_s_waitcnt(0);
        unsigned nloc = b.st[0], nx = b.st[1];
        if (nloc == 0u) { xcd_barrier_complete(bar, b.x, nloc, nx); b.st[0] = nloc; b.st[1] = nx; }
        const unsigned old = xb_add(&bar[XB_XSUB(b.x)], 1u);
        const unsigned gen = old / nloc;
        if (old + 1u == (gen + 1u) * nloc) {
            __builtin_amdgcn_fence(__ATOMIC_RELEASE, "agent");
            asm volatile("s_waitcnt vmcnt(0)" ::: "memory");
            const unsigned og = xb_add(&bar[XB_TOP], 1u);
            const unsigned tg = og / nx;
            if (og + 1u == (tg + 1u) * nx) xb_add(&bar[XB_TOPGEN], 1u);
            else XB_SPIN(xb_ld(&bar[XB_TOPGEN]) == tg, bar);
            __builtin_amdgcn_fence(__ATOMIC_ACQUIRE, "agent");
            xb_add(&bar[XB_XGEN(b.x)], 1u);
            asm volatile("s_waitcnt vmcnt(0)" ::: "memory");
        } else {
            XB_SPIN(xb_ld(&bar[XB_XGEN(b.x)]) == gen, bar);
            __builtin_amdgcn_fence(__ATOMIC_ACQUIRE, "agent");
            asm volatile("s_waitcnt vmcnt(0)" ::: "memory");
        }
    }
    __syncthreads();
}

namespace pg8 {
constexpr int BM = 256, BK = 64, HALF = 128, HTB = HALF * BK * 2, STAGE_BYTES = 8 * HTB, NXCD = 8, WGM = 8;
__host__ __device__ __forceinline__ int lds_byte(int r, int c) { const int st = (r >> 4) * 2 + (c >> 5), rr = r & 15, cc = c & 31, ob = rr * 64 + cc * 2; return st * 1024 + (ob ^ (((ob >> 9) & 1) << 5)); }
__host__ __device__ __forceinline__ void stage_rc(int b, int& R, int& C) { const int st = b / 1024, sb = b % 1024, swz = sb ^ (((sb >> 9) & 1) << 5); R = (st >> 1) * 16 + swz / 64; C = (st & 1) * 32 + (swz % 64) / 2; }
__host__ __device__ __forceinline__ int perm32(int rho) { const int n = rho >> 4, i = rho & 15; return 8 * (i >> 2) + 4 * n + (i & 3); }
__device__ __forceinline__ unsigned cvt_pk_bf16(float lo, float hi) { unsigned r; asm volatile("v_cvt_pk_bf16_f32 %0, %1, %2" : "=v"(r) : "v"(lo), "v"(hi)); return r; }

struct Unit { const char* A; const char* B; int pm, pn, aux; };

struct StaticOrder {
    const char* A; const char* Bt; int K, nM, nN, nwg, G, c;
    __device__ void init(const void* A_, const void* Bt_, int M, int N, int K_, int G_, int c_) { A = (const char*)A_; Bt = (const char*)Bt_; K = K_; nM = M / BM; nN = N / BM; nwg = nM * nN; G = G_; c = c_; }
    __device__ __forceinline__ bool next(int i, Unit& u) const {
        const long L = (long)i * G + c; if (L >= nwg) return false;
        int wgid = (int)L; { const int q = nwg / NXCD, r = nwg % NXCD, xcd = wgid % NXCD, off = wgid / NXCD; wgid = (xcd < r ? xcd * (q + 1) : r * (q + 1) + (xcd - r) * q) + off; }
        const int nig = WGM * nN, gid = wgid / nig, fm = gid * WGM, gsz = (nM - fm) < WGM ? (nM - fm) : WGM;
        u.pm = fm + ((wgid % nig) % gsz); u.pn = (wgid % nig) / gsz; u.aux = 0;
        u.A = A + (size_t)u.pm * BM * K * 2; u.B = Bt + (size_t)u.pn * BM * K * 2; return true;
    }
    __device__ __forceinline__ unsigned arow(const Unit&, int r) const { return (unsigned)(r * K) * 2u; }
};

typedef int i32x4 __attribute__((ext_vector_type(4)));
typedef int i32x8 __attribute__((ext_vector_type(8)));
template <class Epi, class Sched, bool ALIGN_EPI, int MODE = 0>
__device__ __forceinline__ void gemm_phase(LAS unsigned char* lds, const int K, const Sched& S, const Epi& E) {
    constexpr bool F8 = MODE == 1;
    const int tid = threadIdx.x, wid = __builtin_amdgcn_readfirstlane(tid >> 6), lane = tid & 63, wr = wid >> 2, wc = wid & 3, fr = lane & 15, fq = lane >> 4;
    const int nt = K / BK;
    int RA[2], CA[2]; unsigned voffB[2];
#pragma unroll
    for (int i = 0; i < 2; ++i) { int R, C; stage_rc(tid * 16 + i * 8192, R, C); const int Rb = Epi::PERM ? ((R & ~31) + perm32(R & 31)) : R;
        RA[i] = R; CA[i] = C; voffB[i] = (unsigned)(Rb * K + C) * 2u; }
    const size_t kstep = (size_t)(BK * 2);
    const size_t hstep = (size_t)HALF * K * 2;
    const unsigned ldsw = (unsigned)wid * 1024u;
    const int aoff = lds_byte(wr * 64 + fr, fq * 8), boff = lds_byte(wc * 32 + fr, fq * 8);
#define PG8_SA(b, h) (((b) * 2 + (h)) * HTB)
#define PG8_SB(b, h) ((4 + (b) * 2 + (h)) * HTB)
#define PG8_STAGE(bufoff, gbase, voff) do { _Pragma("unroll") for (int _i = 0; _i < 2; ++_i) \
        __builtin_amdgcn_global_load_lds((const unsigned*)((const char*)(gbase) + (voff)[_i]), (LAS unsigned*)(lds + (bufoff) + ldsw + _i * 8192), 16, 0, 0); } while (0)
#define PG8_LDA(dst, b, h) do { _Pragma("unroll") for (int m = 0; m < 4; ++m) _Pragma("unroll") for (int k = 0; k < 2; ++k) dst[m][k] = *(const LAS bf16x8*)(lds + PG8_SA(b, h) + aoff + m * 2048 + k * 1024); } while (0)
#define PG8_LDB(dst, b, h) do { _Pragma("unroll") for (int n = 0; n < 2; ++n) _Pragma("unroll") for (int k = 0; k < 2; ++k) dst[n][k] = *(const LAS bf16x8*)(lds + PG8_SB(b, h) + boff + n * 2048 + k * 1024); } while (0)
#define PG8_MMA(ai, bj, At, Bt) do { __builtin_amdgcn_s_setprio(1); _Pragma("unroll") for (int m = 0; m < 4; ++m) _Pragma("unroll") for (int n = 0; n < 2; ++n) { \
        if constexpr (F8) { const i32x8 _b = __builtin_shufflevector(__builtin_bit_cast(i32x4, Bt[n][0]), __builtin_bit_cast(i32x4, Bt[n][1]), 0, 1, 2, 3, 4, 5, 6, 7), \
                                        _a = __builtin_shufflevector(__builtin_bit_cast(i32x4, At[m][0]), __builtin_bit_cast(i32x4, At[m][1]), 0, 1, 2, 3, 4, 5, 6, 7); \
            asm volatile("v_mfma_scale_f32_16x16x128_f8f6f4 %0, %1, %2, %0, %3, %3 op_sel_hi:[0,0,0]" : "+v"(acc[ai][bj][m][n]) : "v"(_b), "v"(_a), "v"(f8sc)); } \
        else if constexpr (MODE == 2) { _Pragma("unroll") for (int k = 0; k < 2; ++k) acc[ai][bj][m][n] = __builtin_bit_cast(f32x4, __builtin_amdgcn_mfma_i32_16x16x64_i8(__builtin_bit_cast(i32x4, Bt[n][k]), __builtin_bit_cast(i32x4, At[m][k]), __builtin_bit_cast(i32x4, acc[ai][bj][m][n]), 0, 0, 0)); } \
        else { _Pragma("unroll") for (int k = 0; k < 2; ++k) acc[ai][bj][m][n] = __builtin_amdgcn_mfma_f32_16x16x32_bf16(Bt[n][k], At[m][k], acc[ai][bj][m][n], 0, 0, 0); } } \
        __builtin_amdgcn_s_setprio(0); } while (0)
#define PG8_WAIT_V(n) asm volatile("s_waitcnt vmcnt(" #n ")" ::: "memory")
#define PG8_WAIT_L(n) asm volatile("s_waitcnt lgkmcnt(" #n ")" ::: "memory")
#define PG8_BAR __builtin_amdgcn_s_barrier()
#define PG8_SCHED __builtin_amdgcn_sched_barrier(0)
    const int f8sc = 0x7f7f7f7f;
    Unit cur, nxt; int ui = 0;
    if (!S.next(0, cur)) return;
    typename Epi::State est; E.pre(est, cur, wr, fr);
    f32x4 acc[2][2][4][2];
#pragma unroll
    for (int a = 0; a < 2; ++a)
#pragma unroll
        for (int b = 0; b < 2; ++b)
#pragma unroll
            for (int m = 0; m < 4; ++m)
#pragma unroll
                for (int n = 0; n < 2; ++n) acc[a][b][m][n] = (f32x4){0.f, 0.f, 0.f, 0.f};
#define PG8_ACC_FENCE() do { if constexpr (F8) { _Pragma("unroll") for (int a = 0; a < 2; ++a) _Pragma("unroll") for (int b = 0; b < 2; ++b) _Pragma("unroll") for (int m = 0; m < 4; ++m) _Pragma("unroll") for (int n = 0; n < 2; ++n) \
        asm volatile("" : "+v"(acc[a][b][m][n])); asm volatile("s_nop 3" ::: "memory"); } } while (0)
    PG8_ACC_FENCE();
    bf16x8 At[4][2], B0[2][2], B1[2][2];
    unsigned vA0[2], vA1[2], nA0[2], nA1[2];
#pragma unroll
    for (int i = 0; i < 2; ++i) { vA0[i] = S.arow(cur, RA[i]) + CA[i] * 2u; vA1[i] = S.arow(cur, HALF + RA[i]) + CA[i] * 2u; nA0[i] = vA0[i]; nA1[i] = vA1[i]; }
    const char* cA = cur.A; const char* cB = cur.B;
    PG8_STAGE(PG8_SB(0, 0), cB, voffB); PG8_STAGE(PG8_SB(0, 1), cB + hstep, voffB); PG8_STAGE(PG8_SA(0, 0), cA, vA0); PG8_STAGE(PG8_SA(0, 1), cA, vA1);
    if (wr == 1) PG8_BAR;
    PG8_WAIT_V(2); PG8_BAR;
    PG8_STAGE(PG8_SB(1, 0), cB + kstep, voffB); PG8_STAGE(PG8_SA(1, 0), cA + kstep, vA0); PG8_STAGE(PG8_SB(1, 1), cB + hstep + kstep, voffB);
    PG8_WAIT_V(6); PG8_BAR;
    for (;;) {
        const bool has_next = S.next(ui + 1, nxt);
        const char* nA = has_next ? nxt.A : cA; const char* nB = has_next ? nxt.B : cB;
        if (has_next) {
#pragma unroll
            for (int i = 0; i < 2; ++i) { nA0[i] = S.arow(nxt, RA[i]) + CA[i] * 2u; nA1[i] = S.arow(nxt, HALF + RA[i]) + CA[i] * 2u; }
        }
        for (int t = 0; t < nt; t += 2) {
            const bool last = (t == nt - 2);
            const char* a1 = cA + (size_t)(t + 1) * kstep;
            const char* a2 = last ? nA : cA + (size_t)(t + 2) * kstep; const char* b2 = last ? nB : cB + (size_t)(t + 2) * kstep;
            const char* a3 = a2 + kstep; const char* b3 = b2 + kstep;
            unsigned w0[2], w1[2];
#pragma unroll
            for (int i = 0; i < 2; ++i) { w0[i] = last ? nA0[i] : vA0[i]; w1[i] = last ? nA1[i] : vA1[i]; }
            PG8_LDB(B0, 0, 0); PG8_LDB(B1, 0, 1); PG8_SCHED; PG8_LDA(At, 0, 0); PG8_STAGE(PG8_SA(1, 1), a1, vA1);
            PG8_WAIT_V(8); PG8_WAIT_L(0); PG8_BAR; PG8_MMA(0, 0, At, B0); PG8_MMA(0, 1, At, B1); PG8_BAR; PG8_SCHED;
            PG8_LDA(At, 0, 1); PG8_STAGE(PG8_SB(0, 0), b2, voffB); PG8_STAGE(PG8_SB(0, 1), b2 + hstep, voffB); PG8_STAGE(PG8_SA(0, 0), a2, w0);
            PG8_WAIT_V(8); PG8_WAIT_L(0); PG8_BAR; PG8_MMA(1, 0, At, B0); PG8_MMA(1, 1, At, B1); PG8_BAR; PG8_SCHED;
            PG8_LDB(B0, 1, 0); PG8_LDB(B1, 1, 1); PG8_SCHED; PG8_LDA(At, 1, 0); PG8_STAGE(PG8_SA(0, 1), a2, w1);
            PG8_WAIT_V(8); PG8_WAIT_L(0); PG8_BAR; PG8_MMA(0, 0, At, B0); PG8_MMA(0, 1, At, B1); PG8_BAR; PG8_SCHED;
            PG8_LDA(At, 1, 1); PG8_STAGE(PG8_SB(1, 0), b3, voffB); PG8_STAGE(PG8_SB(1, 1), b3 + hstep, voffB); PG8_STAGE(PG8_SA(1, 0), a3, w0);
            PG8_WAIT_V(8); PG8_WAIT_L(0); PG8_BAR; PG8_MMA(1, 0, At, B0); PG8_MMA(1, 1, At, B1); PG8_BAR; PG8_SCHED;
        }
        if constexpr (ALIGN_EPI) { if (wr == 0) PG8_BAR; }
        if constexpr (F8) { asm volatile("s_nop 15\n\ts_nop 15\n\ts_nop 7" ::: "memory"); __builtin_amdgcn_sched_barrier(0); }
        E(acc, cur, wr, wc, fr, fq, est);
        if (!has_next) break;
        E.pre(est, nxt, wr, fr);
#pragma unroll
        for (int a = 0; a < 2; ++a)
#pragma unroll
            for (int b = 0; b < 2; ++b)
#pragma unroll
                for (int m = 0; m < 4; ++m)
#pragma unroll
                    for (int n = 0; n < 2; ++n) acc[a][b][m][n] = (f32x4){0.f, 0.f, 0.f, 0.f};
        PG8_ACC_FENCE();
        cur = nxt; cA = nA; cB = nB; ++ui;
#pragma unroll
        for (int i = 0; i < 2; ++i) { vA0[i] = nA0[i]; vA1[i] = nA1[i]; }
        if constexpr (ALIGN_EPI) { if (wr == 1) PG8_BAR; }
    }
    PG8_WAIT_V(0);
    if constexpr (!ALIGN_EPI) { if (wr == 0) PG8_BAR; }
    PG8_BAR;
#undef PG8_SA
#undef PG8_ACC_FENCE
#undef PG8_SB
#undef PG8_STAGE
#undef PG8_LDA
#undef PG8_LDB
#undef PG8_MMA
#undef PG8_WAIT_V
#undef PG8_WAIT_L
#undef PG8_BAR
#undef PG8_SCHED
}

struct EpiBf16 {
    static constexpr bool PERM = true;
    bf16* O; int ldc;
    struct State {}; __device__ __forceinline__ void pre(State&, const Unit&, int, int) const {}
    __device__ __forceinline__ void operator()(const f32x4 (&acc)[2][2][4][2], const Unit& u, int wr, int wc, int fr, int fq, const State&) const {
        const int row0 = u.pm * BM + wr * 64 + fr; const int col0 = u.pn * BM + wc * 32 + 8 * fq;
#pragma unroll
        for (int ai = 0; ai < 2; ++ai)
#pragma unroll
            for (int m = 0; m < 4; ++m) { bf16* rowp = O + (size_t)(row0 + ai * HALF + m * 16) * ldc + col0;
#pragma unroll
                for (int bj = 0; bj < 2; ++bj) { const f32x4 v0 = acc[ai][bj][m][0], v1 = acc[ai][bj][m][1];
                    u32x4 w; w.x = cvt_pk_bf16(v0[0], v0[1]); w.y = cvt_pk_bf16(v0[2], v0[3]); w.z = cvt_pk_bf16(v1[0], v1[1]); w.w = cvt_pk_bf16(v1[2], v1[3]);
                    *(u32x4*)(rowp + bj * HALF) = w; } }
    }
};
struct EpiBf16S {
    static constexpr bool PERM = true;
    bf16* O; int ldc; const float* rs;
    struct State { float rsr[2][4]; };
    __device__ __forceinline__ void pre(State& st, const Unit& u, int wr, int fr) const {
        const int row0 = u.pm * BM + wr * 64 + fr;
#pragma unroll
        for (int ai = 0; ai < 2; ++ai)
#pragma unroll
            for (int m = 0; m < 4; ++m) st.rsr[ai][m] = rs[row0 + ai * HALF + m * 16];
    }
    __device__ __forceinline__ void operator()(const f32x4 (&acc)[2][2][4][2], const Unit& u, int wr, int wc, int fr, int fq, const State& st) const {
        const int row0 = u.pm * BM + wr * 64 + fr; const int col0 = u.pn * BM + wc * 32 + 8 * fq;
        const float (&rsr)[2][4] = st.rsr;
#pragma unroll
        for (int ai = 0; ai < 2; ++ai)
#pragma unroll
            for (int m = 0; m < 4; ++m) { bf16* rowp = O + (size_t)(row0 + ai * HALF + m * 16) * ldc + col0; const float r = rsr[ai][m];
#pragma unroll
                for (int bj = 0; bj < 2; ++bj) { const f32x4 v0 = acc[ai][bj][m][0] * r, v1 = acc[ai][bj][m][1] * r;
                    u32x4 w; w.x = cvt_pk_bf16(v0[0], v0[1]); w.y = cvt_pk_bf16(v0[2], v0[3]); w.z = cvt_pk_bf16(v1[0], v1[1]); w.w = cvt_pk_bf16(v1[2], v1[3]);
                    *(u32x4*)(rowp + bj * HALF) = w; } }
    }
};
struct EpiI8S {
    static constexpr bool PERM = true;
    bf16* O; int ldc; const float* f; const unsigned* wmaxbits; unsigned char* iqk8;
    struct State { float rsr[2][4]; };
    __device__ __forceinline__ void pre(State& st, const Unit& u, int wr, int fr) const {
        const int row0 = u.pm * BM + wr * 64 + fr;
        const float sw = __builtin_bit_cast(float, __hip_atomic_load(wmaxbits, __ATOMIC_RELAXED, __HIP_MEMORY_SCOPE_AGENT)) * (1.f / 127.f);
#pragma unroll
        for (int ai = 0; ai < 2; ++ai)
#pragma unroll
            for (int m = 0; m < 4; ++m) st.rsr[ai][m] = f[row0 + ai * HALF + m * 16] * sw;
    }
    __device__ __forceinline__ void operator()(const f32x4 (&acc)[2][2][4][2], const Unit& u, int wr, int wc, int fr, int fq, const State& st) const {
        const int row0 = u.pm * BM + wr * 64 + fr; const int col0 = u.pn * BM + wc * 32 + 8 * fq;
#pragma unroll
        for (int ai = 0; ai < 2; ++ai)
#pragma unroll
            for (int m = 0; m < 4; ++m) { bf16* rowp = O + (size_t)(row0 + ai * HALF + m * 16) * ldc + col0; const float r = st.rsr[ai][m];
#pragma unroll
                for (int bj = 0; bj < 2; ++bj) { const i32x4 i0 = __builtin_bit_cast(i32x4, acc[ai][bj][m][0]), i1 = __builtin_bit_cast(i32x4, acc[ai][bj][m][1]);
                    const int col = col0 + bj * HALF;
                    if (iqk8 && col >= 2176 && col < 2496) { const float r8 = r * 8.f;
                        *(u32x2*)(iqk8 + (size_t)(row0 + ai * HALF + m * 16) * 320 + (col - 2176)) = (u32x2){pk4_fp8((float)i0[0] * r8, (float)i0[1] * r8, (float)i0[2] * r8, (float)i0[3] * r8), pk4_fp8((float)i1[0] * r8, (float)i1[1] * r8, (float)i1[2] * r8, (float)i1[3] * r8)}; }
                    else { u32x4 w; w.x = cvt_pk_bf16((float)i0[0] * r, (float)i0[1] * r); w.y = cvt_pk_bf16((float)i0[2] * r, (float)i0[3] * r); w.z = cvt_pk_bf16((float)i1[0] * r, (float)i1[1] * r); w.w = cvt_pk_bf16((float)i1[2] * r, (float)i1[3] * r);
                        *(u32x4*)(rowp + bj * HALF) = w; } } }
    }
};
struct EpiResF32 {
    static constexpr bool PERM = false;
    const float* base; float* out; int ldc;
    struct State {}; __device__ __forceinline__ void pre(State&, const Unit&, int, int) const {}
    __device__ __forceinline__ void operator()(const f32x4 (&acc)[2][2][4][2], const Unit& u, int wr, int wc, int fr, int fq, const State&) const {
        const int row0 = u.pm * BM + wr * 64 + fr, col0 = u.pn * BM + wc * 32 + 4 * fq;
#pragma unroll
        for (int ai = 0; ai < 2; ++ai)
#pragma unroll
            for (int m = 0; m < 4; ++m) { const size_t off = (size_t)(row0 + ai * HALF + m * 16) * ldc + col0;
#pragma unroll
                for (int bj = 0; bj < 2; ++bj)
#pragma unroll
                    for (int n = 0; n < 2; ++n) { const f32x4 bs = *(const f32x4*)(base + off + bj * HALF + n * 16); *(f32x4*)(out + off + bj * HALF + n * 16) = bs + acc[ai][bj][m][n]; } }
    }
};

struct EpiResXB {
    static constexpr bool PERM = true;
    const float* srcf; const bf16* srcb; bf16* xb; unsigned char* xb8; float ascale;
    struct State {}; __device__ __forceinline__ void pre(State&, const Unit&, int, int) const {}
    __device__ __forceinline__ void operator()(const f32x4 (&acc)[2][2][4][2], const Unit& u, int wr, int wc, int fr, int fq, const State&) const {
        const int row0 = u.pm * BM + wr * 64 + fr, col0 = u.pn * BM + wc * 32 + 8 * fq;
#pragma unroll
        for (int ai = 0; ai < 2; ++ai)
#pragma unroll
            for (int m = 0; m < 4; ++m) { const size_t off = (size_t)(row0 + ai * HALF + m * 16) * DM + col0;
#pragma unroll
                for (int bj = 0; bj < 2; ++bj) { f32x4 a0, a1;
                    if (srcf) { a0 = *(const f32x4*)(srcf + off + bj * HALF); a1 = *(const f32x4*)(srcf + off + bj * HALF + 4); }
                    else { const u32x4 v = *(const u32x4*)(srcb + off + bj * HALF); a0 = (f32x4){bflo(v.x), bfhi(v.x), bflo(v.y), bfhi(v.y)}; a1 = (f32x4){bflo(v.z), bfhi(v.z), bflo(v.w), bfhi(v.w)}; }
                    a0 += acc[ai][bj][m][0] * ascale; a1 += acc[ai][bj][m][1] * ascale;
                    *(u32x4*)(xb + off + bj * HALF) = (u32x4){pk2(a0[0], a0[1]), pk2(a0[2], a0[3]), pk2(a1[0], a1[1]), pk2(a1[2], a1[3])};
                    a0 *= F8_SX; a1 *= F8_SX;
                    *(u32x2*)(xb8 + off + bj * HALF) = (u32x2){pk4_fp8(a0[0], a0[1], a0[2], a0[3]), pk4_fp8(a1[0], a1[1], a1[2], a1[3])}; } }
    }
};

struct MoeOrder {
    const char* Abase; const char* Bbase; size_t bstride; int K, G, c, tile_lo, tile_hi; const LAS int* ptile; const LAS int* cntv; const int* list; bool gather;
    __device__ __forceinline__ bool next(int i, Unit& u) const {
        const int NT = tile_hi - tile_lo; int tile, pn;
        if ((G & 7) == 0 && G >= 32) {
            const int x = c & 7, sl = c >> 3, per = G >> 3, TPX = (NT + 7) >> 3;
            const int lu = i * per + sl, lt = lu >> 2; pn = lu & 3;
            tile = tile_lo + x * TPX + lt;
            if (lt >= TPX || tile >= tile_hi) return false;
        } else {
            const long Lq = (long)i * G + c; if (Lq >= (long)NT * 4) return false;
            tile = tile_lo + (int)(Lq >> 2); pn = (int)(Lq & 3);
        }
        int e = 0;
#pragma unroll
        for (int st = 32; st >= 1; st >>= 1) { const int k = e + st; if (k < 64 && tile >= __builtin_amdgcn_readfirstlane(ptile[k])) e = k; }
        const int j = tile - __builtin_amdgcn_readfirstlane(ptile[e]);
        u.pm = tile; u.pn = pn; u.aux = e | (j << 6);
        u.A = gather ? Abase : Abase + (size_t)tile * BM * K * 2; u.B = Bbase + (size_t)(e & 31) * bstride + (size_t)pn * BM * K * 2; return true;
    }
    __device__ __forceinline__ unsigned arow(const Unit& u, int r) const {
        if (!gather) return (unsigned)(r * K) * 2u;
        const int e = u.aux & 63, pos = (u.aux >> 6) * 256 + r; const int cn = cntv[e];
        const int tok = pos < cn ? list[(size_t)e * 65536 + pos] : 0;
        return (unsigned)tok * (unsigned)(K * 2);
    }
};
struct EpiSwiGLU {
    static constexpr bool PERM = true;
    unsigned char* H; const float* rl; const LAS int* cntv;
    struct State { float rsr[2][4]; };
    __device__ __forceinline__ void pre(State& st, const Unit& u, int wr, int fr) const {
        const int e = u.aux & 63, j = u.aux >> 6; const int cn = cntv[e];
#pragma unroll
        for (int ai = 0; ai < 2; ++ai)
#pragma unroll
            for (int m = 0; m < 4; ++m) { const int pos = j * 256 + ai * HALF + wr * 64 + m * 16 + fr; st.rsr[ai][m] = rl[(size_t)e * 65536 + (pos < cn ? pos : 0)]; }
    }
    __device__ __forceinline__ void operator()(const f32x4 (&acc)[2][2][4][2], const Unit& u, int wr, int wc, int fr, int fq, const State& st) const {
        const int row0 = u.pm * BM + wr * 64 + fr; const int col0 = u.pn * 128 + wc * 32 + 8 * fq;
        const float (&rsr)[2][4] = st.rsr;
#pragma unroll
        for (int ai = 0; ai < 2; ++ai)
#pragma unroll
            for (int m = 0; m < 4; ++m) { unsigned char* rowp = H + (size_t)(row0 + ai * HALF + m * 16) * 512 + col0;
                const float rs = rsr[ai][m] * (1.f / (F8_SX * F8_SW));
                const f32x4 g0 = acc[ai][0][m][0] * rs, g1 = acc[ai][0][m][1] * rs, u0 = acc[ai][1][m][0] * rs, u1 = acc[ai][1][m][1] * rs;
                float h[8];
#pragma unroll
                for (int q = 0; q < 4; ++q) { h[q] = g0[q] * __builtin_amdgcn_rcpf(1.f + __builtin_amdgcn_exp2f(-1.44269504f * g0[q])) * u0[q]; h[4 + q] = g1[q] * __builtin_amdgcn_rcpf(1.f + __builtin_amdgcn_exp2f(-1.44269504f * g1[q])) * u1[q]; }
                *(u32x2*)rowp = (u32x2){pk4_fp8(h[0] * F8_SH, h[1] * F8_SH, h[2] * F8_SH, h[3] * F8_SH), pk4_fp8(h[4] * F8_SH, h[5] * F8_SH, h[6] * F8_SH, h[7] * F8_SH)}; }
    }
};
template <bool FINAL> struct EpiScatter {
    static constexpr bool PERM = true;
    bf16* xb; float* out; const int* list; const float* wl; const LAS int* cntv;
    struct State { int tok[2][4]; float wg[2][4]; };
    __device__ __forceinline__ void pre(State& st, const Unit& u, int wr, int fr) const {
        const int e = u.aux & 63, j = u.aux >> 6; const int cn = cntv[e];
#pragma unroll
        for (int ai = 0; ai < 2; ++ai)
#pragma unroll
            for (int m = 0; m < 4; ++m) { const int pos = j * 256 + ai * HALF + wr * 64 + m * 16 + fr; const int pc = pos < cn ? pos : 0;
                st.tok[ai][m] = list[(size_t)e * 65536 + pc]; st.wg[ai][m] = wl[(size_t)e * 65536 + pc] * (1.f / (F8_SH * F8_SW)); }
    }
    __device__ __forceinline__ void operator()(const f32x4 (&acc)[2][2][4][2], const Unit& u, int wr, int wc, int fr, int fq, const State& st) const {
        const int e = u.aux & 63, j = u.aux >> 6; const int cn = cntv[e];
        const int col0 = u.pn * BM + wc * 32 + 8 * fq;
        const int (&tok)[2][4] = st.tok; const float (&wg)[2][4] = st.wg; bool ok[2][4];
#pragma unroll
        for (int ai = 0; ai < 2; ++ai)
#pragma unroll
            for (int m = 0; m < 4; ++m) ok[ai][m] = j * 256 + ai * HALF + wr * 64 + m * 16 + fr < cn;
#pragma unroll
        for (int ai = 0; ai < 2; ++ai) {
            u32x4 v[4][2];
#pragma unroll
            for (int m = 0; m < 4; ++m)
#pragma unroll
                for (int bj = 0; bj < 2; ++bj) v[m][bj] = *(const u32x4*)(xb + (size_t)tok[ai][m] * DM + col0 + bj * HALF);
#pragma unroll
            for (int m = 0; m < 4; ++m) { const size_t off = (size_t)tok[ai][m] * DM + col0;
#pragma unroll
                for (int bj = 0; bj < 2; ++bj) { const u32x4 x = v[m][bj];
                    const f32x4 a0 = (f32x4){bflo(x.x), bfhi(x.x), bflo(x.y), bfhi(x.y)} + wg[ai][m] * acc[ai][bj][m][0], a1 = (f32x4){bflo(x.z), bfhi(x.z), bflo(x.w), bfhi(x.w)} + wg[ai][m] * acc[ai][bj][m][1];
                    if (ok[ai][m]) {
                        if (FINAL) { *(f32x4*)(out + off + bj * HALF) = a0; *(f32x4*)(out + off + bj * HALF + 4) = a1; }
                        else *(u32x4*)(xb + off + bj * HALF) = (u32x4){pk2(a0[0], a0[1]), pk2(a0[2], a0[3]), pk2(a1[0], a1[1]), pk2(a1[2], a1[3])}; } } }
        }
    }
};
}

struct Frame {
    LAS unsigned char* lds;
    volatile LAS unsigned* MISC;
    gu32* ctl;
    int tid, lane, wave, G, bid;
    float* out; unsigned char* ws;
};
struct Args { const float* in[31]; float* out; unsigned char* ws; int ph_lo, ph_hi, rep, pad; };
#ifndef REP_PART
#define REP_PART 0
#endif
#ifndef REP_PHASE
#define REP_PHASE -1
#endif
#define NREP(k) ((REP_PHASE == (k)) ? args.rep : 1)
__device__ __forceinline__ float wave_sum(float v) {
#pragma unroll
    for (int o = 1; o < 64; o <<= 1) v += __shfl_xor(v, o);
    return v;
}

template <class Map, int F8OUT = 0>
__device__ __forceinline__ void transpose_item(const float* W, int K, int pitch, int col0, int ncols, bf16* WT, LAS float* scr, int item, int lane, Map dmap, const float* gk = nullptr, float oscale = 1.f) {
    const int nblk = (ncols + 63) / 64, kb = item / nblk, nb = item % nblk, k0 = 64 * kb, n0 = 64 * nb;
    const int nn = n0 + lane;
    float v[64];
#pragma unroll
    for (int kk = 0; kk < 64; ++kk) v[kk] = (nn < ncols) ? W[(size_t)(k0 + kk) * pitch + col0 + nn] : 0.f;
#pragma unroll
    for (int kk = 0; kk < 64; ++kk) scr[kk * 65 + lane] = gk ? v[kk] * gk[k0 + kk] : v[kk];
    LDS_WAIT(); asm volatile("" ::: "memory");
    const int c = lane & 7;
#pragma unroll
    for (int j = 0; j < 8; ++j) { const int n = (lane >> 3) + 8 * j; const LAS float* s = scr + (8 * c) * 65 + n;
        if (F8OUT == 2) { const u32x2 o8 = (u32x2){pk4_i8(s[0 * 65] * oscale, s[1 * 65] * oscale, s[2 * 65] * oscale, s[3 * 65] * oscale), pk4_i8(s[4 * 65] * oscale, s[5 * 65] * oscale, s[6 * 65] * oscale, s[7 * 65] * oscale)};
            if (n0 + n < ncols) *(u32x2*)((unsigned char*)WT + (size_t)dmap(n0 + n) * K + k0 + 8 * c) = o8; }
        else if (F8OUT == 1) { const u32x2 o8 = (u32x2){pk4_fp8(s[0 * 65] * F8_SW, s[1 * 65] * F8_SW, s[2 * 65] * F8_SW, s[3 * 65] * F8_SW), pk4_fp8(s[4 * 65] * F8_SW, s[5 * 65] * F8_SW, s[6 * 65] * F8_SW, s[7 * 65] * F8_SW)};
            if (n0 + n < ncols) *(u32x2*)((unsigned char*)WT + (size_t)dmap(n0 + n) * K + k0 + 8 * c) = o8; }
        else { u32x4 o; o.x = pk2(s[0 * 65], s[1 * 65]); o.y = pk2(s[2 * 65], s[3 * 65]); o.z = pk2(s[4 * 65], s[5 * 65]); o.w = pk2(s[6 * 65], s[7 * 65]);
            if (n0 + n < ncols) *(u32x4*)(WT + (size_t)dmap(n0 + n) * K + k0 + 8 * c) = o; } }
    LDS_WAIT(); asm volatile("" ::: "memory");
}
struct MapId { int off; __device__ int operator()(int n) const { return n + off; } };
struct MapEven { __device__ int operator()(int c) const {
    if (c < 1536) return c; if (c < 1544) return EDT + (c - 1536); if (c < 2056) return EQ + (c - 1544); if (c < 2120) return EK + (c - 2056);
    if (c < 2184) return EV + (c - 2120); if (c < 2440) return EIQ + (c - 2184); if (c < 2504) return EIK + (c - 2440); return EIW + (c - 2504); } };
struct MapGU { int half; __device__ int operator()(int n) const { return 256 * (n >> 7) + 128 * half + (n & 127); } };

__device__ __forceinline__ void rms_row_to_bf16(const float* xrow, const float* gain, bf16* orow, int lane) {
    const f32x4* xr = (const f32x4*)xrow + lane; const f32x4* gr = (const f32x4*)gain + lane;
    f32x4 v[4]; float s = 0.f;
#pragma unroll
    for (int j = 0; j < 4; ++j) { v[j] = xr[64 * j]; s += (v[j].x * v[j].x + v[j].y * v[j].y) + (v[j].z * v[j].z + v[j].w * v[j].w); }
    const float rs = 1.f / sqrtf(wave_sum(s) * (1.f / DM) + NORM_EPS);
    unsigned long long* o8 = (unsigned long long*)orow + lane;
#pragma unroll
    for (int j = 0; j < 4; ++j) { const f32x4 g = gr[64 * j]; o8[64 * j] = (unsigned long long)pk2(v[j].x * rs * g.x, v[j].y * rs * g.y) | ((unsigned long long)pk2(v[j].z * rs * g.z, v[j].w * rs * g.w) << 32); }
}

template <int NR> __device__ __forceinline__ void rms_rows_to_bf16(const float* xrow0, size_t xstride, const float* gain, bf16* orow0, size_t ostride, int lane) {
    f32x4 v[NR][4]; float s[NR];
#pragma unroll
    for (int q = 0; q < NR; ++q) { const f32x4* xr = (const f32x4*)(xrow0 + q * xstride) + lane;
#pragma unroll
        for (int j = 0; j < 4; ++j) v[q][j] = xr[64 * j]; }
#pragma unroll
    for (int q = 0; q < NR; ++q) { s[q] = 0.f;
#pragma unroll
        for (int j = 0; j < 4; ++j) s[q] += (v[q][j].x * v[q][j].x + v[q][j].y * v[q][j].y) + (v[q][j].z * v[q][j].z + v[q][j].w * v[q][j].w); }
#pragma unroll
    for (int o = 1; o < 64; o <<= 1) {
#pragma unroll
        for (int q = 0; q < NR; ++q) s[q] += __shfl_xor(s[q], o); }
    const f32x4* gr = (const f32x4*)gain + lane;
#pragma unroll
    for (int q = 0; q < NR; ++q) { const float rs = 1.f / sqrtf(s[q] * (1.f / DM) + NORM_EPS); unsigned long long* o8 = (unsigned long long*)(orow0 + q * ostride) + lane;
#pragma unroll
        for (int j = 0; j < 4; ++j) { const f32x4 g = gr[64 * j]; o8[64 * j] = (unsigned long long)pk2(v[q][j].x * rs * g.x, v[q][j].y * rs * g.y) | ((unsigned long long)pk2(v[q][j].z * rs * g.z, v[q][j].w * rs * g.w) << 32); } }
}
template <int NR> __device__ __forceinline__ void rows_to_i8(const float* xrow0, size_t xstride, unsigned char* orow0, size_t ostride, float* f0, size_t fstride, int lane) {
    f32x4 v[NR][4]; float s[NR], mx[NR];
#pragma unroll
    for (int q = 0; q < NR; ++q) { const f32x4* xr = (const f32x4*)(xrow0 + q * xstride) + lane;
#pragma unroll
        for (int j = 0; j < 4; ++j) v[q][j] = xr[64 * j]; }
#pragma unroll
    for (int q = 0; q < NR; ++q) { s[q] = 0.f; mx[q] = 0.f;
#pragma unroll
        for (int j = 0; j < 4; ++j) { s[q] += (v[q][j].x * v[q][j].x + v[q][j].y * v[q][j].y) + (v[q][j].z * v[q][j].z + v[q][j].w * v[q][j].w);
            mx[q] = fmaxf(fmaxf(mx[q], fmaxf(fabsf(v[q][j].x), fabsf(v[q][j].y))), fmaxf(fabsf(v[q][j].z), fabsf(v[q][j].w))); } }
#pragma unroll
    for (int o = 1; o < 64; o <<= 1) {
#pragma unroll
        for (int q = 0; q < NR; ++q) { s[q] += __shfl_xor(s[q], o); mx[q] = fmaxf(mx[q], __shfl_xor(mx[q], o)); } }
#pragma unroll
    for (int q = 0; q < NR; ++q) { unsigned* o4 = (unsigned*)(orow0 + q * ostride) + lane;
        const float inv = mx[q] > 0.f ? 127.f / mx[q] : 0.f;
        if (lane == 0) f0[q * fstride] = (mx[q] * (1.f / 127.f)) / sqrtf(s[q] * (1.f / DM) + NORM_EPS);
#pragma unroll
        for (int j = 0; j < 4; ++j) o4[64 * j] = pk4_i8(v[q][j].x * inv, v[q][j].y * inv, v[q][j].z * inv, v[q][j].w * inv); }
}
template <int NR> __device__ __forceinline__ void rms_rowsb_to_bf16(const bf16* xrow0, const float* gain, bf16* orow0, int lane) {
    u32x2 raw[NR][4]; float s[NR];
#pragma unroll
    for (int q = 0; q < NR; ++q) { const u32x2* xr = (const u32x2*)(xrow0 + (size_t)q * DM) + lane;
#pragma unroll
        for (int j = 0; j < 4; ++j) raw[q][j] = xr[64 * j]; }
#pragma unroll
    for (int q = 0; q < NR; ++q) { s[q] = 0.f;
#pragma unroll
        for (int j = 0; j < 4; ++j) { const float a = bflo(raw[q][j].x), b = bfhi(raw[q][j].x), c = bflo(raw[q][j].y), d = bfhi(raw[q][j].y); s[q] += (a * a + b * b) + (c * c + d * d); } }
#pragma unroll
    for (int o = 1; o < 64; o <<= 1) {
#pragma unroll
        for (int q = 0; q < NR; ++q) s[q] += __shfl_xor(s[q], o); }
    const f32x4* gr = (const f32x4*)gain + lane;
#pragma unroll
    for (int q = 0; q < NR; ++q) { const float rs = 1.f / sqrtf(s[q] * (1.f / DM) + NORM_EPS); unsigned long long* o8 = (unsigned long long*)(orow0 + (size_t)q * DM) + lane;
#pragma unroll
        for (int j = 0; j < 4; ++j) { const f32x4 g = gr[64 * j];
            o8[64 * j] = (unsigned long long)pk2(bflo(raw[q][j].x) * rs * g.x, bfhi(raw[q][j].x) * rs * g.y) | ((unsigned long long)pk2(bflo(raw[q][j].y) * rs * g.z, bfhi(raw[q][j].y) * rs * g.w) << 32); } }
}
__device__ __forceinline__ void rms_rowb_to_bf16(const bf16* xrow, const float* gain, bf16* orow, int lane) {
    const u32x2* xr = (const u32x2*)xrow + lane; const f32x4* gr = (const f32x4*)gain + lane;
    f32x4 v[4]; float s = 0.f;
#pragma unroll
    for (int j = 0; j < 4; ++j) { const u32x2 q = xr[64 * j]; v[j] = (f32x4){bflo(q.x), bfhi(q.x), bflo(q.y), bfhi(q.y)}; s += (v[j].x * v[j].x + v[j].y * v[j].y) + (v[j].z * v[j].z + v[j].w * v[j].w); }
    const float rs = 1.f / sqrtf(wave_sum(s) * (1.f / DM) + NORM_EPS);
    unsigned long long* o8 = (unsigned long long*)orow + lane;
#pragma unroll
    for (int j = 0; j < 4; ++j) { const f32x4 g = gr[64 * j]; o8[64 * j] = (unsigned long long)pk2(v[j].x * rs * g.x, v[j].y * rs * g.y) | ((unsigned long long)pk2(v[j].z * rs * g.z, v[j].w * rs * g.w) << 32); }
}
__device__ __forceinline__ void p_wmax(Frame& F, const Args& A) {
    const int gt = F.bid * NTHR + F.tid, NT_ = F.G * NTHR;
    { const f32x4* W = (const f32x4*)A.in[4]; const float* g = A.in[2];
      float m = 0.f;
#pragma unroll 8
      for (int v = gt; v < 1024 * 627; v += NT_) { const int k = v / 627; const f32x4 w = W[v]; const float gk = fabsf(g[k]);
          m = fmaxf(m, fmaxf(fmaxf(fabsf(w.x), fabsf(w.y)), fmaxf(fabsf(w.z), fabsf(w.w))) * gk); }
#pragma unroll
      for (int o = 1; o < 64; o <<= 1) m = fmaxf(m, __shfl_xor(m, o));
      if (F.lane == 0) __hip_atomic_fetch_max((unsigned*)(F.ctl + CW_WMAX), __builtin_bit_cast(unsigned, m), __ATOMIC_RELAXED, __HIP_MEMORY_SCOPE_AGENT); }
    { const f32x4* W1 = (const f32x4*)A.in[14]; const float* g1 = A.in[2] + DM;
      float m1 = 0.f;
#pragma unroll 8
      for (int v = gt; v < 1024 * 640; v += NT_) { const int k = v / 640, c = v - k * 640; const f32x4 w = W1[(size_t)k * 646 + c]; const float gk = fabsf(g1[k]);
          m1 = fmaxf(m1, fmaxf(fmaxf(fabsf(w.x), fabsf(w.y)), fmaxf(fabsf(w.z), fabsf(w.w))) * gk); }
#pragma unroll
      for (int o = 1; o < 64; o <<= 1) m1 = fmaxf(m1, __shfl_xor(m1, o));
      if (F.lane == 0) __hip_atomic_fetch_max((unsigned*)(F.ctl + CW_WMAX + 1), __builtin_bit_cast(unsigned, m1), __ATOMIC_RELAXED, __HIP_MEMORY_SCOPE_AGENT); }
}
__device__ __forceinline__ void p_prologue(Frame& F, const Args& A) {
    LAS float* scr = (LAS float*)(F.lds + F.wave * 17408);
    const int gw = F.bid * NWAVES + F.wave, NGW = F.G * NWAVES;
    bf16* Wie = (bf16*)(F.ws + WS_WIE); bf16* Woe = (bf16*)(F.ws + WS_WOE);
    constexpr int I_IE = 16 * 40, I_OE = 16 * 16;
    const float wmaxv = __builtin_bit_cast(float, __hip_atomic_load((unsigned*)(F.ctl + CW_WMAX), __ATOMIC_RELAXED, __HIP_MEMORY_SCOPE_AGENT));
    const float wq = wmaxv > 0.f ? 127.f / wmaxv : 0.f;
    const float wmaxv1 = __builtin_bit_cast(float, __hip_atomic_load((unsigned*)(F.ctl + CW_WMAX + 1), __ATOMIC_RELAXED, __HIP_MEMORY_SCOPE_AGENT));
    const float wq1 = wmaxv1 > 0.f ? 127.f / wmaxv1 : 0.f;
    for (int it = gw; it < I_IE + I_OE; it += NGW) {
        if (it < I_IE) transpose_item<MapEven, 2>(A.in[4], 1024, 2508, 0, 2508, Wie, scr, it, F.lane, MapEven(), A.in[2], wq);
        else transpose_item<MapId, 1>(A.in[13], 1024, 1024, 0, 1024, Woe, scr, it - I_IE, F.lane, MapId{0});
    }
    {
        bf16* Wgu = (bf16*)(F.ws + WS_WGU); bf16* Wd = (bf16*)(F.ws + WS_WD); bf16* WR = (bf16*)(F.ws + WS_WR);
        (void)Wgu; (void)Wd;
        for (int it = gw; it < 2 * 5 * 16; it += NGW) { const int l = it / 80, r = it % 80, q = r / 16, kb = r % 16;
            if (q == 0) transpose_item(A.in[26] + (size_t)l * 1024 * 4, 1024, 4, 0, 4, WR + (size_t)l * 48 * 1024, scr, kb, F.lane, MapId{0}, A.in[3] + l * DM);
            else transpose_item(A.in[27] + (size_t)(l * 4 + q - 1) * 1024 * 8, 1024, 8, 0, 8, WR + (size_t)l * 48 * 1024, scr, kb, F.lane, MapId{4 + 8 * (q - 1)}, A.in[3] + l * DM); }
        for (int i = gw * 64 + F.lane; i < 2 * 12 * 1024 / 8; i += NGW * 64) { const int l = i / (12 * 128), o = i % (12 * 128); *(u32x4*)(WR + (size_t)l * 48 * 1024 + 36 * 1024 + (size_t)o * 8) = (u32x4){0u, 0u, 0u, 0u}; }
    }
    {
        bf16* Wio = (bf16*)(F.ws + WS_WIO); bf16* Woo = (bf16*)(F.ws + WS_WOO); bf16* WGL = (bf16*)(F.ws + WS_WGL);
        bf16* W1K = (bf16*)(F.ws + WS_W1K); bf16* W1V = (bf16*)(F.ws + WS_W1V); bf16* W2 = (bf16*)(F.ws + WS_W2);
        constexpr int J0 = 16 * 40, J1 = J0 + 16, J2 = J1 + 16 * 16, J3 = J2 + 64 * 2, J4 = J3 + 64 * 2, J5 = J4 + 2 * 2, J6 = J5 + 2 * 2;
        for (int it = gw; it < J6; it += NGW) {
            if (it < J0) transpose_item<MapId, 2>(A.in[14], 1024, 2584, 0, 2560, Wio, scr, it, F.lane, MapId{0}, A.in[2] + DM, wq1);
            else if (it < J1) transpose_item(A.in[14], 1024, 2584, 2560, 24, WGL, scr, it - J0, F.lane, MapId{0}, A.in[2] + DM);
            else if (it < J2) transpose_item<MapId, 1>(A.in[25], 1024, 1024, 0, 1024, Woo, scr, it - J1, F.lane, MapId{0});
            else if (it < J3) transpose_item(A.in[21], 4096, 128, 0, 128, W1K, scr, it - J2, F.lane, MapId{0});
            else if (it < J4) transpose_item(A.in[23], 4096, 128, 0, 128, W1V, scr, it - J3, F.lane, MapId{0});
            else if (it < J5) transpose_item(A.in[22], 128, 128, 0, 128, W2, scr, it - J4, F.lane, MapId{0});
            else transpose_item(A.in[24], 128, 128, 0, 128, W2 + 128 * 128, scr, it - J5, F.lane, MapId{0});
        }
        for (int i = gw * 64 + F.lane; i < 8 * 1024 / 8; i += NGW * 64) *(u32x4*)(WGL + 24 * 1024 + (size_t)i * 8) = (u32x4){0u, 0u, 0u, 0u};
    }
    for (int i = gw * 64 + F.lane; i < 52 * 1024 / 16; i += NGW * 64) *((u32x4*)((unsigned char*)Wie + (size_t)2508 * 1024) + i) = (u32x4){0u, 0u, 0u, 0u};
    bf16* HB = (bf16*)(F.ws + WS_HB);
    { unsigned char* X8 = (unsigned char*)HB; float* FR = (float*)(F.ws + WS_RS);
      for (int m = gw; m < MTOK; m += 4 * NGW) rows_to_i8<4>(A.in[0] + (size_t)m * DM, (size_t)NGW * DM, X8 + (size_t)m * DM, (size_t)NGW * DM, FR + m, (size_t)NGW, F.lane); }
}

constexpr int SP = 136;
constexpr int L_CS = 0, L_BS = 34816, L_BT = 69632, L_XT = 104448, L_XS = 113152, L_ST = 121856, L_AC = 139264, L_DT = 139776, L_CW = 140288;
__device__ __forceinline__ bf16x8 lds_frag(LAS unsigned char* base, int row, int col) { return *(const LAS bf16x8*)(base + (row * SP + col) * 2); }

constexpr int S_CS = 0, S_BS = 34816, S_BT = 69632, S_XT = 104448, S_XS = 121856, S_AC = 139264, S_DT = 141312;
__device__ __forceinline__ void p_ssd1(Frame& F, const Args& A) {
    bf16* U = (bf16*)(F.ws + WS_U); bf16* YD = (bf16*)(F.ws + WS_HB); bf16* CS = (bf16*)(F.ws + WS_XB); bf16* CC = (bf16*)(F.ws + WS_CC); float* AC = (float*)(F.ws + WS_AC);
    const int w = F.wave;
    { const int tid = F.tid;
#pragma unroll 4
    for (int r0 = F.bid * 64; r0 < MTOK; r0 += F.G * 64) {
        const int row = r0 + (tid >> 3), c8 = (tid & 7) * 8;
        bf16* p = U + (size_t)row * LDE + EK + c8;
        const u32x4 v = *(const u32x4*)p; float f[8] = {bflo(v.x), bfhi(v.x), bflo(v.y), bfhi(v.y), bflo(v.z), bfhi(v.z), bflo(v.w), bfhi(v.w)};
        float s = 0.f;
#pragma unroll
        for (int j = 0; j < 8; ++j) s += f[j] * f[j];
        s += __shfl_xor(s, 1); s += __shfl_xor(s, 2); s += __shfl_xor(s, 4);
        const float rs = 1.f / sqrtf(s * (1.f / 64.f) + NORM_EPS); const float* g = A.in[12] + c8;
        const float r8 = rs * 8.f;
        *(u32x2*)(F.ws + WS_K8 + (size_t)row * 64 + c8) = (u32x2){pk4_fp8(f[0] * r8 * g[0], f[1] * r8 * g[1], f[2] * r8 * g[2], f[3] * r8 * g[3]), pk4_fp8(f[4] * r8 * g[4], f[5] * r8 * g[5], f[6] * r8 * g[6], f[7] * r8 * g[7])};
    } }
    LAS unsigned char* L = F.lds;
    LAS float* acum = (LAS float*)(L + S_AC); LAS float* dtv = (LAS float*)(L + S_DT);
    const float* conv_w = A.in[5]; const float* conv_b = A.in[6];
    for (int unit = F.bid; unit < 1024; unit += F.G) {
        int tid = F.tid, lane = F.lane; asm volatile("" : "+v"(tid), "+v"(lane));
        const int b = unit >> 6, c = (unit >> 1) & 31, g = unit & 1;
        const size_t rowbase = (size_t)b * SEQ + (size_t)c * 128;
        __syncthreads();
        {
            const int hq = tid >> 7, t = tid & 127, h = 4 * g + hq;
            const float dr = bf2f(U[(rowbase + t) * LDE + EDT + h]) + A.in[7][h];
            const float dt = dr > 20.f ? dr : log1pf(__expf(dr));
            float sc = dt * (-__expf(A.in[8][h]));
#pragma unroll
            for (int o = 1; o < 64; o <<= 1) { const float x = __shfl_up(sc, o); if (lane >= o) sc += x; }
            dtv[tid] = dt; acum[tid] = sc;
        }
        {
            const int cg = tid & 15, rr = tid >> 4;
#pragma unroll 1
            for (int T = 0; T < 2; ++T) {
                const int ch0 = (T == 0 ? 512 : 768) + g * 128 + 8 * cg;
                u32x4 raw[7];
#pragma unroll
                for (int j = 0; j < 7; ++j) { const int tl = 4 * rr - 3 + j; raw[j] = (u32x4){0u, 0u, 0u, 0u};
                    if (c > 0 || tl >= 0) raw[j] = *(const u32x4*)(U + (size_t)((long)rowbase + tl) * LDE + 512 + ch0); }
                LAS unsigned char* dst = L + (T == 0 ? S_BS : S_CS);
                unsigned opk[4][4];
#pragma unroll
                for (int e2 = 0; e2 < 4; ++e2) {
                    const float* wp = conv_w + ch0 + 2 * e2;
                    const f32x2 w0 = *(const f32x2*)wp, w1 = *(const f32x2*)(wp + 1024), w2 = *(const f32x2*)(wp + 2048), w3 = *(const f32x2*)(wp + 3072), bb = *(const f32x2*)(conv_b + ch0 + 2 * e2);
                    float lo[7], hi[7];
#pragma unroll
                    for (int j = 0; j < 7; ++j) { lo[j] = bflo(raw[j][e2]); hi[j] = bfhi(raw[j][e2]); }
                    float ol[4], oh[4];
#pragma unroll
                    for (int q = 0; q < 4; ++q) { ol[q] = siluf(bb.x + w0.x * lo[q] + w1.x * lo[q + 1] + w2.x * lo[q + 2] + w3.x * lo[q + 3]);
                                                  oh[q] = siluf(bb.y + w0.y * hi[q] + w1.y * hi[q + 1] + w2.y * hi[q + 2] + w3.y * hi[q + 3]); opk[q][e2] = pk2(ol[q], oh[q]); }
                    if (T == 0) {
                        *(LAS u32x2*)(L + S_BT + ((8 * cg + 2 * e2) * SP + 4 * rr) * 2) = (u32x2){pk2(ol[0], ol[1]), pk2(ol[2], ol[3])};
                        *(LAS u32x2*)(L + S_BT + ((8 * cg + 2 * e2 + 1) * SP + 4 * rr) * 2) = (u32x2){pk2(oh[0], oh[1]), pk2(oh[2], oh[3])};
                    }
                }
#pragma unroll
                for (int q = 0; q < 4; ++q) { const u32x4 pk = (u32x4){opk[q][0], opk[q][1], opk[q][2], opk[q][3]};
                    *(LAS u32x4*)(dst + ((4 * rr + q) * SP + 8 * cg) * 2) = pk;
                    if (T == 1) *(u32x4*)(CC + ((size_t)((b * 32 + c) * 2 + g) * 128 + 4 * rr + q) * 128 + 8 * cg) = pk; }
            }
        }
        __syncthreads();
        if (w & 1) acum[tid] += acum[tid - lane - 1];
        __syncthreads();
        AC[(rowbase + (tid & 127)) * 8 + 4 * g + (tid >> 7)] = acum[tid];
        const int mt = w >> 1, nh = w & 1, r = lane & 31, hh = lane >> 5;
        f32x16 cb[2];
#pragma unroll
        for (int j = 0; j < 2; ++j) {
            cb[j] = (f32x16){0.f, 0.f, 0.f, 0.f, 0.f, 0.f, 0.f, 0.f, 0.f, 0.f, 0.f, 0.f, 0.f, 0.f, 0.f, 0.f};
            const int s0 = 64 * nh + 32 * j;
            if (s0 <= 32 * mt + 31) {
#pragma unroll
                for (int ks = 0; ks < 8; ++ks) cb[j] = __builtin_amdgcn_mfma_f32_32x32x16_bf16(lds_frag(L + S_BS, s0 + r, 16 * ks + 8 * hh), lds_frag(L + S_CS, 32 * mt + r, 16 * ks + 8 * hh), cb[j], 0, 0, 0);
            }
        }
        __syncthreads();
#pragma unroll 1
        for (int hq = 0; hq < 4; ++hq) {
            const int h = 4 * g + hq;
            int tidq = F.tid, laneq = F.lane; asm volatile("" : "+v"(tidq), "+v"(laneq));
            const int r = laneq & 31, hh = laneq >> 5;
            const LAS float* ac = acum + hq * 128; const LAS float* dv = dtv + hq * 128;
            {
                const int cgx = tidq & 15, rr = tidq >> 4;
                const float* wp = conv_w + h * 64 + 4 * cgx; const float* bp = conv_b + h * 64 + 4 * cgx;
                const float aend = ac[127];
                u32x2 raw[7];
#pragma unroll
                for (int j = 0; j < 7; ++j) { const int tl = 4 * rr - 3 + j; raw[j] = (u32x2){0u, 0u};
                    if (c > 0 || tl >= 0) raw[j] = *(const u32x2*)(U + (size_t)((long)rowbase + tl) * LDE + EXS + h * 64 + 4 * cgx); }
                const f32x4 a4 = *(const LAS f32x4*)(ac + 4 * rr), d4 = *(const LAS f32x4*)(dv + 4 * rr);
                float sc[4];
#pragma unroll
                for (int q = 0; q < 4; ++q) sc[q] = d4[q] * __expf(aend - a4[q]);
                const f32x4 w0 = *(const f32x4*)wp, w1 = *(const f32x4*)(wp + 1024), w2 = *(const f32x4*)(wp + 2048), w3 = *(const f32x4*)(wp + 3072), bb = *(const f32x4*)bp;
#pragma unroll
                for (int ch = 0; ch < 4; ++ch) { float rv[7];
#pragma unroll
                    for (int j = 0; j < 7; ++j) rv[j] = (ch & 1) ? bfhi(raw[j][ch >> 1]) : bflo(raw[j][ch >> 1]);
                    float xv[4];
#pragma unroll
                    for (int q = 0; q < 4; ++q) xv[q] = siluf(bb[ch] + w0[ch] * rv[q] + w1[ch] * rv[q + 1] + w2[ch] * rv[q + 2] + w3[ch] * rv[q + 3]);
                    *(LAS u32x2*)(L + S_XT + ((4 * cgx + ch) * SP + 4 * rr) * 2) = (u32x2){pk2(xv[0], xv[1]), pk2(xv[2], xv[3])};
                    *(LAS u32x2*)(L + S_XS + ((4 * cgx + ch) * SP + 4 * rr) * 2) = (u32x2){pk2(xv[0] * sc[0], xv[1] * sc[1]), pk2(xv[2] * sc[2], xv[3] * sc[3])}; }
            }
            const float dskh = A.in[9][h];
#pragma unroll
            for (int j = 0; j < 2; ++j) { const int s0 = 64 * nh + 32 * j;
                if (s0 <= 32 * mt + 31) {
                    const int t = 32 * mt + r; const float at = ac[t];
#pragma unroll
                    for (int q = 0; q < 4; ++q) { const int sb = s0 + 8 * q + 4 * hh;
                        const f32x4 a4 = *(const LAS f32x4*)(ac + sb), d4 = *(const LAS f32x4*)(dv + sb);
                        float v[4];
#pragma unroll
                        for (int e = 0; e < 4; ++e) { const int sI = sb + e; v[e] = (sI <= t) ? cb[j][4 * q + e] * __expf(at - a4[e]) * d4[e] : 0.f;
                            if (sI == t) v[e] += dskh; }
                        *(LAS u32x2*)(L + S_BS + (t * SP + sb) * 2) = (u32x2){pk2(v[0], v[1]), pk2(v[2], v[3])}; }
                } }
            __syncthreads();
            {
                const int nt = w & 1;
                f32x16 yd = {0.f, 0.f, 0.f, 0.f, 0.f, 0.f, 0.f, 0.f, 0.f, 0.f, 0.f, 0.f, 0.f, 0.f, 0.f, 0.f}, cs = yd;
                for (int ks = 0; ks < 2 * (mt + 1); ++ks) yd = __builtin_amdgcn_mfma_f32_32x32x16_bf16(lds_frag(L + S_XT, 32 * nt + r, 16 * ks + 8 * hh), lds_frag(L + S_BS, 32 * mt + r, 16 * ks + 8 * hh), yd, 0, 0, 0);
                const int mp = w >> 2, nn = w & 3;
#pragma unroll
                for (int ks = 0; ks < 8; ++ks) cs = __builtin_amdgcn_mfma_f32_32x32x16_bf16(lds_frag(L + S_BT, 32 * nn + r, 16 * ks + 8 * hh), lds_frag(L + S_XS, 32 * mp + r, 16 * ks + 8 * hh), cs, 0, 0, 0);
                bf16* yp = YD + (rowbase + 32 * mt + r) * 512 + h * 64 + 32 * nt + 4 * hh;
                bf16* csp = CS + ((size_t)((b * 32 + c) * 8 + h) * 64 + 32 * mp + r) * 128 + 32 * nn + 4 * hh;
#pragma unroll
                for (int q = 0; q < 4; ++q) { *(u32x2*)(yp + 8 * q) = (u32x2){pk2(yd[4 * q], yd[4 * q + 1]), pk2(yd[4 * q + 2], yd[4 * q + 3])};
                                              *(u32x2*)(csp + 8 * q) = (u32x2){pk2(cs[4 * q], cs[4 * q + 1]), pk2(cs[4 * q + 2], cs[4 * q + 3])}; }
            }
            __syncthreads();
        }
    }
}
__device__ __forceinline__ void p_ssd2(Frame& F) {
    const bf16* CS = (const bf16*)(F.ws + WS_XB); bf16* SI = (bf16*)(F.ws + WS_XB + 64 * MiB); const float* AC = (const float*)(F.ws + WS_AC);
    LAS float* decs = (LAS float*)F.lds;
    for (int st = F.bid; st < 256; st += F.G) {
        const int b = st >> 4, h = (st >> 1) & 7, ph = st & 1;
        const int e0 = F.tid * 8, p = 32 * ph + (e0 >> 7), n = e0 & 127;
        __syncthreads();
        if (F.tid < 32) decs[F.tid] = __expf(AC[((size_t)b * SEQ + F.tid * 128 + 127) * 8 + h]);
        float stt[8] = {0.f, 0.f, 0.f, 0.f, 0.f, 0.f, 0.f, 0.f};
        const size_t off0 = ((size_t)(b * 32 * 8 + h) * 64 + p) * 128 + n, cstep = (size_t)8 * 64 * 128;
        u32x4 ring[4];
#pragma unroll
        for (int k = 0; k < 4; ++k) ring[k] = *(const u32x4*)(CS + off0 + (size_t)k * cstep);
        __syncthreads();
#pragma unroll 1
        for (int c4 = 0; c4 < 32; c4 += 4) {
#pragma unroll
            for (int k = 0; k < 4; ++k) { const int c = c4 + k;
                const u32x4 cur = ring[k];
                if (c + 4 < 32) ring[k] = *(const u32x4*)(CS + off0 + (size_t)(c + 4) * cstep);
                *(u32x4*)(SI + off0 + (size_t)c * cstep) = (u32x4){pk2(stt[0], stt[1]), pk2(stt[2], stt[3]), pk2(stt[4], stt[5]), pk2(stt[6], stt[7])};
                const float dec = decs[c];
                stt[0] = stt[0] * dec + bflo(cur.x); stt[1] = stt[1] * dec + bfhi(cur.x); stt[2] = stt[2] * dec + bflo(cur.y); stt[3] = stt[3] * dec + bfhi(cur.y);
                stt[4] = stt[4] * dec + bflo(cur.z); stt[5] = stt[5] * dec + bfhi(cur.z); stt[6] = stt[6] * dec + bflo(cur.w); stt[7] = stt[7] * dec + bfhi(cur.w); }
        }
    }
}
__device__ __forceinline__ void p_ssd3(Frame& F) {
    bf16* U = (bf16*)(F.ws + WS_U); const bf16* YD = (const bf16*)(F.ws + WS_HB); const bf16* SI = (const bf16*)(F.ws + WS_XB + 64 * MiB); const bf16* CC = (const bf16*)(F.ws + WS_CC); const float* AC = (const float*)(F.ws + WS_AC);
    const int w = F.wave;
    for (int unit = F.bid; unit < 2048; unit += F.G) {
        int lane = F.lane; asm volatile("" : "+v"(lane));
        const int b = unit >> 7, c = (unit >> 2) & 31, hp = unit & 3;
        const int h = 2 * hp + (w >> 2), g = h >> 2, tt = w & 3, r = lane & 31, hh = lane >> 5;
        const size_t row = (size_t)b * SEQ + (size_t)c * 128 + 32 * tt + r;
        const bf16* sp = SI + ((size_t)((b * 32 + c) * 8 + h) * 64 + r) * 128 + 8 * hh;
        const bf16* cp = CC + ((size_t)((b * 32 + c) * 2 + g) * 128 + 32 * tt + r) * 128 + 8 * hh;
        bf16x8 s0[8], s1[8], cf[8];
#pragma unroll
        for (int ks = 0; ks < 8; ++ks) { s0[ks] = *(const bf16x8*)(sp + 16 * ks); s1[ks] = *(const bf16x8*)(sp + 32 * 128 + 16 * ks); cf[ks] = *(const bf16x8*)(cp + 16 * ks); }
        const float ea = __expf(AC[row * 8 + h]);
        const bf16* yp = YD + row * 512 + h * 64 + 4 * hh; bf16* zp = U + row * LDE + EZ + h * 64 + 4 * hh;
        u32x2 yv[8], zv[8];
#pragma unroll
        for (int k = 0; k < 8; ++k) { yv[k] = *(const u32x2*)(yp + 32 * (k >> 2) + 8 * (k & 3)); zv[k] = *(const u32x2*)(zp + 32 * (k >> 2) + 8 * (k & 3)); }
        f32x16 a0 = {0.f, 0.f, 0.f, 0.f, 0.f, 0.f, 0.f, 0.f, 0.f, 0.f, 0.f, 0.f, 0.f, 0.f, 0.f, 0.f}, a1 = a0;
#pragma unroll
        for (int ks = 0; ks < 8; ++ks) { a0 = __builtin_amdgcn_mfma_f32_32x32x16_bf16(s0[ks], cf[ks], a0, 0, 0, 0); a1 = __builtin_amdgcn_mfma_f32_32x32x16_bf16(s1[ks], cf[ks], a1, 0, 0, 0); }
#pragma unroll
        for (int k = 0; k < 8; ++k) { const int q = k & 3;
            const float o0 = (k < 4 ? a0[4 * q] : a1[4 * q]), o1 = (k < 4 ? a0[4 * q + 1] : a1[4 * q + 1]), o2 = (k < 4 ? a0[4 * q + 2] : a1[4 * q + 2]), o3 = (k < 4 ? a0[4 * q + 3] : a1[4 * q + 3]);
            const float y0 = bflo(yv[k].x) + ea * o0, y1 = bfhi(yv[k].x) + ea * o1, y2 = bflo(yv[k].y) + ea * o2, y3 = bfhi(yv[k].y) + ea * o3;
            const float z0 = bflo(zv[k].x), z1 = bfhi(zv[k].x), z2 = bflo(zv[k].y), z3 = bfhi(zv[k].y);
            *(u32x2*)(zp + 32 * (k >> 2) + 8 * q) = (u32x2){pk2(y0 * siluf(z0), y1 * siluf(z1)), pk2(y2 * siluf(z2), y3 * siluf(z3))}; }
    }
}

typedef short s16x4 __attribute__((ext_vector_type(4)));
__device__ __forceinline__ s16x4 lds_tr16(LAS unsigned char* p) { return __builtin_bit_cast(s16x4, __builtin_amdgcn_ds_read_tr16_b64_v4i16((LAS s16x4*)p)); }
__device__ __forceinline__ int t5_bucket_dev(int d) {
    if (d < 16) return d;
    const int v = 16 + (int)(log((double)d / 16.0) / log(8.0) * 16.0);
    return v < 31 ? v : 31;
}
constexpr int D_QSL = 16896, D_QH = 8704, D_SEL = 135168, D_LUT = 139264, D_DMY = 143360, VP = 72;
__device__ __forceinline__ int key16(float f) { const int iv = __builtin_bit_cast(int, f); const unsigned u = (unsigned)iv ^ ((unsigned)(iv >> 31) | 0x80000000u); return (int)(u >> 16); }
__device__ __forceinline__ unsigned long long mask_ge(int v, int x) { unsigned long long m; asm("v_cmp_ge_i32_e64 %0, %1, %2" : "=s"(m) : "v"(v), "s"(x)); return m; }
__device__ __forceinline__ unsigned long long mask_gt(int v, int x) { unsigned long long m; asm("v_cmp_gt_i32_e64 %0, %1, %2" : "=s"(m) : "v"(v), "s"(x)); return m; }
__device__ __forceinline__ int count_ge8(int a0, int a1, int a2, int a3, int a4, int a5, int a6, int a7, int x) {
    unsigned long long m0, m1, m2, m3, m4, m5, m6, m7;
    asm("v_cmp_ge_i32_e64 %0, %8, %16\n\tv_cmp_ge_i32_e64 %1, %9, %16\n\tv_cmp_ge_i32_e64 %2, %10, %16\n\tv_cmp_ge_i32_e64 %3, %11, %16\n\t"
        "v_cmp_ge_i32_e64 %4, %12, %16\n\tv_cmp_ge_i32_e64 %5, %13, %16\n\tv_cmp_ge_i32_e64 %6, %14, %16\n\tv_cmp_ge_i32_e64 %7, %15, %16"
        : "=&s"(m0), "=&s"(m1), "=&s"(m2), "=&s"(m3), "=&s"(m4), "=&s"(m5), "=&s"(m6), "=&s"(m7)
        : "v"(a0), "v"(a1), "v"(a2), "v"(a3), "v"(a4), "v"(a5), "v"(a6), "v"(a7), "s"(x));
    return (__popcll(m0) + __popcll(m1)) + (__popcll(m2) + __popcll(m3)) + ((__popcll(m4) + __popcll(m5)) + (__popcll(m6) + __popcll(m7)));
}
__device__ __forceinline__ void masks_ge8(int a0, int a1, int a2, int a3, int a4, int a5, int a6, int a7, int x, unsigned long long (&m)[8]) {
    asm("v_cmp_ge_i32_e64 %0, %8, %16\n\tv_cmp_ge_i32_e64 %1, %9, %16\n\tv_cmp_ge_i32_e64 %2, %10, %16\n\tv_cmp_ge_i32_e64 %3, %11, %16\n\t"
        "v_cmp_ge_i32_e64 %4, %12, %16\n\tv_cmp_ge_i32_e64 %5, %13, %16\n\tv_cmp_ge_i32_e64 %6, %14, %16\n\tv_cmp_ge_i32_e64 %7, %15, %16"
        : "=&s"(m[0]), "=&s"(m[1]), "=&s"(m[2]), "=&s"(m[3]), "=&s"(m[4]), "=&s"(m[5]), "=&s"(m[6]), "=&s"(m[7])
        : "v"(a0), "v"(a1), "v"(a2), "v"(a3), "v"(a4), "v"(a5), "v"(a6), "v"(a7), "s"(x));
}
__device__ __forceinline__ void masks_eq8(int a0, int a1, int a2, int a3, int a4, int a5, int a6, int a7, int x, unsigned long long (&m)[8]) {
    asm("v_cmp_eq_i32_e64 %0, %8, %16\n\tv_cmp_eq_i32_e64 %1, %9, %16\n\tv_cmp_eq_i32_e64 %2, %10, %16\n\tv_cmp_eq_i32_e64 %3, %11, %16\n\t"
        "v_cmp_eq_i32_e64 %4, %12, %16\n\tv_cmp_eq_i32_e64 %5, %13, %16\n\tv_cmp_eq_i32_e64 %6, %14, %16\n\tv_cmp_eq_i32_e64 %7, %15, %16"
        : "=&s"(m[0]), "=&s"(m[1]), "=&s"(m[2]), "=&s"(m[3]), "=&s"(m[4]), "=&s"(m[5]), "=&s"(m[6]), "=&s"(m[7])
        : "v"(a0), "v"(a1), "v"(a2), "v"(a3), "v"(a4), "v"(a5), "v"(a6), "v"(a7), "s"(x));
}
__device__ __forceinline__ int sel_mask(int a, int b, unsigned long long m) { int r; asm("v_cndmask_b32_e64 %0, %1, %2, %3" : "=v"(r) : "v"(a), "v"(b), "s"(m)); return r; }
__device__ __forceinline__ float xor1(float v) { return __builtin_bit_cast(float, __builtin_amdgcn_update_dpp(0, __builtin_bit_cast(int, v), 0xB1, 0xF, 0xF, false)); }
__device__ __forceinline__ float xor2(float v) { return __builtin_bit_cast(float, __builtin_amdgcn_update_dpp(0, __builtin_bit_cast(int, v), 0x4E, 0xF, 0xF, false)); }
typedef __bf16 bf16v2 __attribute__((ext_vector_type(2)));
__device__ __forceinline__ float dot2ones(unsigned pk, float acc) { return __builtin_amdgcn_fdot2_f32_bf16(__builtin_bit_cast(bf16v2, pk), __builtin_bit_cast(bf16v2, 0x3f803f80u), acc, false); }
__device__ __forceinline__ int okey(float f) { const int iv = __builtin_bit_cast(int, f); return iv ^ ((iv >> 31) & 0x7fffffff); }

struct MoeConv { const float* src; unsigned char* dst; int pitch; int gk; bool on; };
__device__ __forceinline__ MoeConv moe_conv_issue(const Args& A, unsigned char* ws, int id, int lane, float (&v)[32]) {
    MoeConv c; c.on = id < 64 * 768; c.src = nullptr; c.dst = nullptr; c.pitch = 0; c.gk = -1;
    if (c.on) {
        const int le = id / 768, r = id % 768;
        int K, k0, n; const float* W; unsigned char* WT;
        if (r < 512) { const int half = r >> 8, q = r & 255, kb = q >> 3, nb = q & 7; K = 1024; c.pitch = 512; k0 = 32 * kb; n = 64 * nb + lane; c.gk = (le >> 5) * DM + k0;
            W = (half ? A.in[29] : A.in[28]) + (size_t)le * 1024 * 512; WT = ws + WS_WGU + (size_t)le * 1024 * 1024 + (size_t)(256 * (n >> 7) + 128 * half + (n & 127)) * K + k0; }
        else { const int q = r - 512, kb = q >> 4, nb = q & 15; K = 512; c.pitch = 1024; k0 = 32 * kb; n = 64 * nb + lane;
            W = A.in[30] + (size_t)le * 512 * 1024; WT = ws + WS_WD + (size_t)le * 1024 * 512 + (size_t)n * K + k0; }
        c.src = W + (size_t)k0 * c.pitch + n; c.dst = WT;
#pragma unroll
        for (int kk = 0; kk < 32; ++kk) v[kk] = c.src[(size_t)kk * c.pitch];
    }
    return c;
}
__device__ __forceinline__ void moe_conv_finish(const Args& A, const MoeConv& c, const float (&v)[32]) {
    if (c.on) {
        const int gk = __builtin_amdgcn_readfirstlane(c.gk);
        if (gk >= 0) { const float* g = A.in[3] + gk;
#pragma unroll
            for (int q = 0; q < 2; ++q) { u32x4 o;
#pragma unroll
                for (int e = 0; e < 4; ++e) { const int k = 16 * q + 4 * e; o[e] = pk4_fp8(v[k] * g[k] * F8_SW, v[k + 1] * g[k + 1] * F8_SW, v[k + 2] * g[k + 2] * F8_SW, v[k + 3] * g[k + 3] * F8_SW); }
                *(u32x4*)(c.dst + 16 * q) = o; }
        } else {
#pragma unroll
            for (int q = 0; q < 2; ++q) { u32x4 o;
#pragma unroll
                for (int e = 0; e < 4; ++e) { const int k = 16 * q + 4 * e; o[e] = pk4_fp8(v[k] * F8_SW, v[k + 1] * F8_SW, v[k + 2] * F8_SW, v[k + 3] * F8_SW); }
                *(u32x4*)(c.dst + 16 * q) = o; }
        }
    }
}
__device__ __forceinline__ void p_dsa(Frame& F, const Args& A) {
    bf16* U = (bf16*)(F.ws + WS_U); bf16* HB = (bf16*)(F.ws + WS_HB);
    const int w = F.wave;
    const float* ng = A.in[10];
    LAS unsigned char* L = F.lds;
    LAS float* LUT = (LAS float*)(L + D_LUT);
    for (int i = F.tid; i < 1024; i += NTHR) LUT[i] = A.in[1][t5_bucket_dev(i >> 3) * 8 + (i & 7)] * 1.44269504f;
    __syncthreads();
    for (int blk = F.bid; blk < MTOK / 8; blk += F.G) {
        int lane = F.lane; asm volatile("" : "+v"(lane));
        const int kr = blk >> 8, cc = blk & 255, b = kr >> 1, tb = (kr & 1) ? 511 - cc : cc, t0 = tb * 8;
        const size_t bat = (size_t)b * SEQ, rowb = bat + t0;
        {
            LAS u32x4* hz = (LAS u32x4*)(L + (F.tid >> 6) * D_QSL + D_QH) + (F.tid & 63) * 8;
#pragma unroll
            for (int i = 0; i < 8; ++i) hz[i] = (u32x4){0u, 0u, 0u, 0u};
            const int njz = (t0 + 8 + 63) >> 6, c4lo = (njz - 1) >> 2, c4hi = 4 * ((njz + 15) >> 4);
            LAS u32x2* kz = (LAS u32x2*)(L + (F.tid >> 6) * D_QSL + (F.tid & 63) * 136);
            for (int c4 = c4lo; c4 < c4hi; ++c4) kz[c4] = (u32x2){0u, 0u};
        }
        __syncthreads();
        float cvv[32]; const MoeConv cvi = moe_conv_issue(A, F.ws, blk * NWAVES + w, lane, cvv);
        const u32x4 zrow = *(const u32x4*)(U + (rowb + w) * LDE + EZ + 8 * lane);
        u32x4 qraw[2];
#pragma unroll
        for (int ks = 0; ks < 2; ++ks) { qraw[ks] = (u32x4){0u, 0u, 0u, 0u}; if ((lane & 15) < 8) qraw[ks] = *(const u32x4*)(U + (rowb + w) * LDE + EQ + (lane & 15) * 64 + 16 * (lane >> 4) + 8 * ks); }
        {
            typedef long i64x2 __attribute__((ext_vector_type(2)));
            const int r = lane & 31, hh = lane >> 5;
            const unsigned char* Q8 = F.ws + WS_IQK8;
            i64x2 qa[2];
            { const i64x2* qp = (const i64x2*)(Q8 + (rowb + (r >> 2)) * 320 + (r & 3) * 64 + 32 * hh); qa[0] = qp[0]; qa[1] = qp[1]; }
            float wv[4][4];
#pragma unroll
            for (int q = 0; q < 4; ++q) { const u32x2 ww = *(const u32x2*)(U + (rowb + 2 * q + hh) * LDE + EIW); wv[q][0] = bflo(ww.x); wv[q][1] = bfhi(ww.x); wv[q][2] = bflo(ww.y); wv[q][3] = bfhi(ww.y); }
            const int ntile = (t0 + 8 + 31) >> 5;
            for (int tb = w; tb < ntile; tb += 8 * NWAVES) {
                i64x2 kf[8][2];
#pragma unroll
                for (int u8 = 0; u8 < 8; ++u8) { const int tl = tb + 8 * u8 < 128 ? tb + 8 * u8 : 127; const int key = 32 * tl + r;
                    const i64x2* kp = (const i64x2*)(Q8 + (bat + key) * 320 + 256 + 32 * hh); kf[u8][0] = kp[0]; kf[u8][1] = kp[1]; }
#pragma unroll
                for (int u8 = 0; u8 < 8; ++u8) {
                    const int tile = tb + 8 * u8;
                    f32x16 acc = {0.f, 0.f, 0.f, 0.f, 0.f, 0.f, 0.f, 0.f, 0.f, 0.f, 0.f, 0.f, 0.f, 0.f, 0.f, 0.f};
                    acc = __builtin_amdgcn_mfma_f32_32x32x16_fp8_fp8(qa[0].x, kf[u8][0].x, acc, 0, 0, 0);
                    acc = __builtin_amdgcn_mfma_f32_32x32x16_fp8_fp8(qa[0].y, kf[u8][0].y, acc, 0, 0, 0);
                    acc = __builtin_amdgcn_mfma_f32_32x32x16_fp8_fp8(qa[1].x, kf[u8][1].x, acc, 0, 0, 0);
                    acc = __builtin_amdgcn_mfma_f32_32x32x16_fp8_fp8(qa[1].y, kf[u8][1].y, acc, 0, 0, 0);
                    if (tile < ntile) {
#pragma unroll
                        for (int q = 0; q < 4; ++q) {
                            const float sc = wv[q][0] * fmaxf(acc[4 * q], 0.f) + wv[q][1] * fmaxf(acc[4 * q + 1], 0.f) + wv[q][2] * fmaxf(acc[4 * q + 2], 0.f) + wv[q][3] * fmaxf(acc[4 * q + 3], 0.f);
                            const int tq = 2 * q + hh, key = 32 * tile + r, k16 = key16(sc + 0.f);
                            const bool live = key <= t0 + tq;
                            *(LAS unsigned short*)(L + tq * D_QSL + (key & 63) * 136 + (key >> 6) * 2) = (unsigned short)(live ? k16 : 0);
                            if (live) __hip_atomic_fetch_add((LAS unsigned*)(L + tq * D_QSL + D_QH) + (k16 >> 5), (unsigned)(((k16 >> 4) & 1) * 0xffff + 1), __ATOMIC_RELAXED, __HIP_MEMORY_SCOPE_WORKGROUP);
                        }
                    }
                }
            }
        }
        {
            const size_t row = rowb + w;
            const u32x4 v = zrow;
            float f[8] = {bflo(v.x), bfhi(v.x), bflo(v.y), bfhi(v.y), bflo(v.z), bfhi(v.z), bflo(v.w), bfhi(v.w)};
            float s = 0.f;
#pragma unroll
            for (int j = 0; j < 8; ++j) s += f[j] * f[j];
#pragma unroll
            for (int o = 1; o < 32; o <<= 1) s += __shfl_xor(s, o);
            const float rs = 1.f / sqrtf(s * (1.f / 256.f) + NORM_EPS); const float* g = ng + 8 * lane;
            const float r8 = rs * F8_SX;
            *(u32x2*)((unsigned char*)HB + row * DM + 8 * lane) = (u32x2){pk4_fp8(f[0] * r8 * g[0], f[1] * r8 * g[1], f[2] * r8 * g[2], f[3] * r8 * g[3]), pk4_fp8(f[4] * r8 * g[4], f[5] * r8 * g[5], f[6] * r8 * g[6], f[7] * r8 * g[7])};
        }
        __syncthreads();
        const int t = t0 + w, n = t + 1;
        LAS unsigned short* sel = (LAS unsigned short*)(L + D_SEL) + w * 256;
        const int cnt = n < 256 ? n : 256;
        if (n <= 256) {
#pragma unroll
            for (int i = 0; i < 4; ++i) { const int s = lane + 64 * i; sel[s] = (unsigned short)(s < n ? s : 0); }
        } else {
            const int nj = (t0 + 8 + 63) >> 6;
            const LAS unsigned char* myrow = L + w * D_QSL + lane * 136;
            int v[64];
#pragma unroll
            for (int jb = 0; jb < 4; ++jb) {
                if (16 * jb < nj) {
#pragma unroll
                    for (int g4q = 0; g4q < 4; ++g4q) { const u32x2 kk = *(const LAS u32x2*)(myrow + 32 * jb + 8 * g4q);
                        const int j0 = 16 * jb + 4 * g4q;
                        v[j0] = (int)(kk.x & 0xffffu); v[j0 + 1] = (int)(kk.x >> 16); v[j0 + 2] = (int)(kk.y & 0xffffu); v[j0 + 3] = (int)(kk.y >> 16); }
                } else {
#pragma unroll
                    for (int jj = 0; jj < 16; ++jj) v[16 * jb + jj] = -1;
                }
            }
            int bstar, ca, cb;
            {
                const LAS u32x4* hw = (const LAS u32x4*)(L + w * D_QSL + D_QH) + lane * 8;
                unsigned hv[32];
#pragma unroll
                for (int i = 0; i < 8; ++i) { const u32x4 x = hw[i]; hv[4 * i] = x.x; hv[4 * i + 1] = x.y; hv[4 * i + 2] = x.z; hv[4 * i + 3] = x.w; }
                unsigned ssum = 0u;
#pragma unroll
                for (int k = 0; k < 32; ++k) ssum += hv[k];
                const int sum = (int)(ssum & 0xffffu) + (int)(ssum >> 16);
                int suf = sum;
#pragma unroll
                for (int o = 1; o < 64; o <<= 1) { const int x = __shfl_down(suf, o); if (lane + o < 64) suf += x; }
                const int above = suf - sum;
                const unsigned long long bm = __ballot(above < 256 && suf >= 256);
                const int Ls = __builtin_amdgcn_readfirstlane((int)__builtin_ctzll(bm | 0x8000000000000000ull));
                const int aboveLs = __builtin_amdgcn_readlane(above, Ls);
                const unsigned hwv = ((const LAS unsigned*)(L + w * D_QSL + D_QH))[Ls * 32 + (lane & 31)];
                const int cw = (int)(hwv >> 16) + (int)(hwv & 0xffffu);
                int sfx = cw;
#pragma unroll
                for (int o = 1; o < 32; o <<= 1) { const int x = __shfl_down(sfx, o); if ((lane & 31) + o < 32) sfx += x; }
                const int rb = aboveLs + sfx - cw;
                const unsigned long long hb = __ballot(rb < 256 && rb + cw >= 256);
                const int wsel = __builtin_amdgcn_readfirstlane((int)__builtin_ctzll(hb | 0x8000000000000000ull)) & 31;
                const int wrun = __builtin_amdgcn_readlane(rb, wsel); const unsigned wval = (unsigned)__builtin_amdgcn_readlane((int)hwv, wsel);
                const int c1 = (int)(wval >> 16), c0 = (int)(wval & 0xffffu);
                const bool inhi = wrun + c1 >= 256;
                bstar = 64 * Ls + 2 * wsel + (inhi ? 1 : 0); ca = inhi ? wrun : wrun + c1; cb = inhi ? c1 : c0;
            }
            int lo = bstar * 16, hi = lo + 15, clo = ca + cb, chi = ca, it = 0;
            while (lo < hi) {
                const int span = hi - lo;
                int step = (it & 1) ? ((span + 1) >> 1) : (int)((float)(span + 1) * (((float)(clo - 256) + 0.5f) / (float)(clo - chi)));
                step = step < 1 ? 1 : (step > span ? span : step);
                const int mid = lo + step;
                int c = 0;
#pragma unroll
                for (int jb = 0; jb < 4; ++jb) if (16 * jb < nj) {
#pragma unroll
                    for (int jj = 0; jj < 16; jj += 8) { const int j0 = 16 * jb + jj; c += count_ge8(v[j0], v[j0 + 1], v[j0 + 2], v[j0 + 3], v[j0 + 4], v[j0 + 5], v[j0 + 6], v[j0 + 7], mid); } }
                ++it;
                if (c == 256) { lo = mid; clo = 256; break; }
                if (c > 256) { lo = mid; clo = c; } else { hi = mid - 1; chi = c; }
            }
            const int T = lo;
            LAS unsigned short* dummy = (LAS unsigned short*)(L + D_DMY) + w * 64 + lane;
            const bool all_ge = clo == 256;
            const int Tg = all_ge ? T : T + 1;
            {
                int obase = 0;
#pragma unroll
                for (int jb = 0; jb < 4; ++jb) if (16 * jb < nj) {
#pragma unroll
                    for (int jj = 0; jj < 16; jj += 8) { const int j0 = 16 * jb + jj; unsigned long long m[8];
                        masks_ge8(v[j0], v[j0 + 1], v[j0 + 2], v[j0 + 3], v[j0 + 4], v[j0 + 5], v[j0 + 6], v[j0 + 7], Tg, m);
#pragma unroll
                        for (int e = 0; e < 8; ++e) {
                            const int pos = (int)__builtin_amdgcn_mbcnt_hi((unsigned)(m[e] >> 32), __builtin_amdgcn_mbcnt_lo((unsigned)m[e], (unsigned)obase));
                            LAS unsigned short* dst = (LAS unsigned short*)(unsigned)sel_mask((int)(unsigned)(__SIZE_TYPE__)dummy, (int)(unsigned)(__SIZE_TYPE__)(sel + pos), m[e]);
                            *dst = (unsigned short)(lane + 64 * (j0 + e));
                            obase += __popcll(m[e]); } } }
            }
            if (!all_ge) {
                const int need_eq = 256 - chi; int ebase = 0;
#pragma unroll
                for (int jb = 0; jb < 4; ++jb) if (16 * jb < nj && ebase < need_eq) {
#pragma unroll
                    for (int jj = 0; jj < 16; jj += 8) { const int j0 = 16 * jb + jj; unsigned long long m[8];
                        masks_eq8(v[j0], v[j0 + 1], v[j0 + 2], v[j0 + 3], v[j0 + 4], v[j0 + 5], v[j0 + 6], v[j0 + 7], T, m);
#pragma unroll
                        for (int e = 0; e < 8; ++e) {
                            const int erank = (int)__builtin_amdgcn_mbcnt_hi((unsigned)(m[e] >> 32), __builtin_amdgcn_mbcnt_lo((unsigned)m[e], (unsigned)ebase));
                            LAS unsigned short* cand = (LAS unsigned short*)(unsigned)sel_mask((int)(unsigned)(__SIZE_TYPE__)dummy, (int)(unsigned)(__SIZE_TYPE__)(sel + chi + erank), m[e]);
                            LAS unsigned short* dst = erank < need_eq ? cand : dummy;
                            *dst = (unsigned short)(lane + 64 * (j0 + e));
                            ebase += __popcll(m[e]); } } }
            }
        }
        {
            const int hd = lane & 15, g4 = lane >> 4;
            const size_t row = rowb + w;
            long qb[2];
            {
                float qf[2][8]; float ss = 0.f;
#pragma unroll
                for (int ks = 0; ks < 2; ++ks) { const u32x4 qq = qraw[ks];
                    qf[ks][0] = bflo(qq.x); qf[ks][1] = bfhi(qq.x); qf[ks][2] = bflo(qq.y); qf[ks][3] = bfhi(qq.y); qf[ks][4] = bflo(qq.z); qf[ks][5] = bfhi(qq.z); qf[ks][6] = bflo(qq.w); qf[ks][7] = bfhi(qq.w);
#pragma unroll
                    for (int j = 0; j < 8; ++j) ss += qf[ks][j] * qf[ks][j]; }
                ss += __shfl_xor(ss, 16); ss += __shfl_xor(ss, 32);
                const float rs = (0.125f * 1.44269504f) / sqrtf(ss * (1.f / 64.f) + NORM_EPS);
#pragma unroll
                for (int ks = 0; ks < 2; ++ks) { const float* gq = A.in[11] + 16 * g4 + 8 * ks; const float r32 = rs * 32.f;
                    const u32x2 pk = (u32x2){pk4_fp8(qf[ks][0] * r32 * gq[0], qf[ks][1] * r32 * gq[1], qf[ks][2] * r32 * gq[2], qf[ks][3] * r32 * gq[3]),
                                             pk4_fp8(qf[ks][4] * r32 * gq[4], qf[ks][5] * r32 * gq[5], qf[ks][6] * r32 * gq[6], qf[ks][7] * r32 * gq[7])};
                    qb[ks] = __builtin_bit_cast(long, pk); }
            }
            float lg[16][4]; float mx = -3.0e38f;
            const int vsl = lane >> 3, vpart = lane & 7;
            u32x4 vr[2][8];
#define DSA_QK_BODY(FULL_) do { \
_Pragma("unroll") \
            for (int hb = 0; hb < 2; ++hb) { \
                typedef long i64x2 __attribute__((ext_vector_type(2))); \
                i64x2 ka[8]; \
_Pragma("unroll") \
                for (int T8 = 0; T8 < 8; ++T8) { const int sm = sel[16 * (8 * hb + T8) + hd]; ka[T8] = *(const i64x2*)(F.ws + WS_K8 + (bat + sm) * 64 + 16 * g4); } \
_Pragma("unroll") \
                for (int e = 0; e < 8; ++e) { const int sm = sel[64 * hb + 8 * e + vsl]; vr[hb][e] = *(const u32x4*)(U + (bat + sm) * LDE + EV + 8 * vpart); } \
_Pragma("unroll") \
                for (int T8 = 0; T8 < 8; ++T8) { const int T = 8 * hb + T8; \
                    f32x4 acc = {0.f, 0.f, 0.f, 0.f}; \
                    acc = __builtin_amdgcn_mfma_f32_16x16x32_fp8_fp8(ka[T8].x, qb[0], acc, 0, 0, 0); \
                    acc = __builtin_amdgcn_mfma_f32_16x16x32_fp8_fp8(ka[T8].y, qb[1], acc, 0, 0, 0); \
                    const u32x2 sl = *(const LAS u32x2*)(sel + 16 * T + 4 * g4); \
                    const int s4[4] = {(int)(sl.x & 0xffffu), (int)(sl.x >> 16), (int)(sl.y & 0xffffu), (int)(sl.y >> 16)}; \
_Pragma("unroll") \
                    for (int i = 0; i < 4; ++i) { int dist = t - s4[i]; dist = dist < 0 ? 0 : (dist > 127 ? 127 : dist); \
                        const float bia = LUT[dist * 8 + (hd & 7)]; \
                        lg[T][i] = ((FULL_) || (16 * T + 4 * g4 + i) < cnt) ? acc[i] * (1.f / 256.f) + bia : -3.0e38f; mx = fmaxf(mx, lg[T][i]); } \
                } \
            } \
            } while (0)
            if (cnt == 256) DSA_QK_BODY(true); else DSA_QK_BODY(false);
#undef DSA_QK_BODY
            mx = fmaxf(mx, __shfl_xor(mx, 16)); mx = fmaxf(mx, __shfl_xor(mx, 32));
            float sum = 0.f;
#pragma unroll
            for (int T = 0; T < 16; ++T) {
#pragma unroll
                for (int i = 0; i < 4; ++i) { const float p = __builtin_amdgcn_exp2f(lg[T][i] - mx); lg[T][i] = p; sum += p; }
                if ((T & 3) == 3) __builtin_amdgcn_sched_barrier(0); }
            sum += __shfl_xor(sum, 16); sum += __shfl_xor(sum, 32);
            const float inv = 1.f / fmaxf(sum, 1e-30f);
            f32x4 oacc[4];
#pragma unroll
            for (int dt = 0; dt < 4; ++dt) oacc[dt] = (f32x4){0.f, 0.f, 0.f, 0.f};
            LAS unsigned char* Vl = L + w * D_QSL;
#pragma unroll
            for (int ch = 0; ch < 4; ++ch) {
                LDS_WAIT();
#pragma unroll
                for (int e = 0; e < 8; ++e) *(LAS u32x4*)(Vl + ((8 * e + vsl) * VP + 8 * vpart) * 2) = vr[ch & 1][e];
                if (ch + 2 < 4) {
#pragma unroll
                    for (int e = 0; e < 8; ++e) { const int sm = sel[64 * (ch + 2) + 8 * e + vsl]; vr[ch & 1][e] = *(const u32x4*)(U + (bat + sm) * LDE + EV + 8 * vpart); }
                }
                LDS_WAIT();
#pragma unroll
                for (int kk = 0; kk < 2; ++kk) {
                    const int T0 = 2 * (2 * ch + kk);
                    u32x4 pp; pp.x = pk2(lg[T0][0] * inv, lg[T0][1] * inv); pp.y = pk2(lg[T0][2] * inv, lg[T0][3] * inv); pp.z = pk2(lg[T0 + 1][0] * inv, lg[T0 + 1][1] * inv); pp.w = pk2(lg[T0 + 1][2] * inv, lg[T0 + 1][3] * inv);
                    const bf16x8 pf = __builtin_bit_cast(bf16x8, pp);
                    const int qq = (lane & 15) >> 2, p4 = lane & 3;
#pragma unroll
                    for (int dt = 0; dt < 4; ++dt) {
                        const s16x4 b0 = lds_tr16(Vl + ((32 * kk + 4 * g4 + qq) * VP + 16 * dt + 4 * p4) * 2);
                        const s16x4 b1 = lds_tr16(Vl + ((32 * kk + 16 + 4 * g4 + qq) * VP + 16 * dt + 4 * p4) * 2);
                        bf16x8 bfg; bfg[0] = b0[0]; bfg[1] = b0[1]; bfg[2] = b0[2]; bfg[3] = b0[3]; bfg[4] = b1[0]; bfg[5] = b1[1]; bfg[6] = b1[2]; bfg[7] = b1[3];
                        oacc[dt] = __builtin_amdgcn_mfma_f32_16x16x32_bf16(pf, bfg, oacc[dt], 0, 0, 0);
                    }
                }
            }
            {
                const bool odd = hd & 1;
#pragma unroll
                for (int i = 0; i < 4; i += 2)
#pragma unroll
                    for (int dt = 0; dt < 4; ++dt) { const float a = oacc[dt][i], b = oacc[dt][i + 1]; const float rcv = xor1(odd ? a : b);
                        if (g4 < 2) *(unsigned short*)((unsigned char*)HB + row * DM + 512 + (4 * g4 + i + (odd ? 1 : 0)) * 64 + 16 * dt + (hd & ~1)) = odd ? pk2_fp8(rcv * F8_SX, b * F8_SX) : pk2_fp8(a * F8_SX, rcv * F8_SX); }
            }
        }
        moe_conv_finish(A, cvi, cvv);
        __syncthreads();
    }
}

constexpr int NR_WP = 2064, NR_WOFF = 45056;
template <int MODE> __device__ __forceinline__ void p_norm_route(Frame& F, const bf16* xin, int layer) {
    constexpr int NT = MODE == 0 ? 3 : 2;
    const bf16* WR = MODE == 0 ? (const bf16*)(F.ws + WS_WR) + (size_t)layer * 48 * 1024 : (const bf16*)(F.ws + WS_WGL);
    float* GL = (float*)(F.ws + WS_GL); float* RS = (float*)(F.ws + WS_RS);
    int* list = (int*)(F.ws + WS_LIST); float* wl = (float*)(F.ws + WS_LISTW); float* rl = (float*)(F.ws + WS_LISTR);
    LAS unsigned char* L = F.lds;
    LAS float* lgt = (LAS float*)L + F.wave * (16 * 48);
    LAS int* cntl = (LAS int*)(L + 32768); LAS int* basel = (LAS int*)(L + 33024);
    LAS int* ri_e = (LAS int*)(L + 34816); LAS int* ri_p = (LAS int*)(L + 36864); LAS float* ri_w = (LAS float*)(L + 38912); LAS float* ri_r = (LAS float*)(L + 40960);
    const int w = F.wave;
    for (int i = F.tid; i < NT * 16 * 128; i += NTHR) { const int r = i >> 7, c = i & 127; *(LAS u32x4*)(L + NR_WOFF + r * NR_WP + c * 16) = *(const u32x4*)(WR + (size_t)r * DM + c * 8); }
    for (int base = F.bid * 256; base < MTOK; base += F.G * 256) {
        int lane = F.lane; asm volatile("" : "+v"(lane));
        if (F.tid < 64) cntl[F.tid] = 0;
        __syncthreads();
        const int n16 = lane & 15, g4 = lane >> 4;
        const int R00 = base + w * 32;
        bf16x8 a[16];
        const bf16* ar = xin + (size_t)(R00 + n16) * DM + 8 * g4;
#pragma unroll
        for (int kk = 0; kk < 16; ++kk) a[kk] = *(const bf16x8*)(ar + 32 * kk);
        float mxh[2] = {0.f, 0.f};
#pragma unroll
        for (int half = 0; half < 2; ++half) {
            const int R0 = R00 + half * 16;
            f32x4 acc[NT];
#pragma unroll
            for (int nt = 0; nt < NT; ++nt) acc[nt] = (f32x4){0.f, 0.f, 0.f, 0.f};
            float ss = 0.f; unsigned short __attribute__((ext_vector_type(2))) mpk = {0, 0};
#pragma unroll
            for (int kk = 0; kk < 32; ++kk) {
                const bf16x8 av = a[kk & 15];
                { const int sn = half * 32 + kk + 16; if (sn < 64) a[kk & 15] = *(const bf16x8*)(ar + (size_t)(sn >> 5) * 16 * DM + 32 * (sn & 31)); }
#pragma unroll
                for (int nt = 0; nt < NT; ++nt) { const bf16x8 bb = *(const LAS bf16x8*)(L + NR_WOFF + (16 * nt + n16) * NR_WP + 64 * kk + 16 * g4);
                    acc[nt] = __builtin_amdgcn_mfma_f32_16x16x32_bf16(av, bb, acc[nt], 0, 0, 0); }
                const u32x4 q = __builtin_bit_cast(u32x4, av);
                { const float e0 = bflo(q.x), e1 = bfhi(q.x), e2 = bflo(q.y), e3 = bfhi(q.y), e4 = bflo(q.z), e5 = bfhi(q.z), e6 = bflo(q.w), e7 = bfhi(q.w);
                  ss += ((e0 * e0 + e1 * e1) + (e2 * e2 + e3 * e3)) + ((e4 * e4 + e5 * e5) + (e6 * e6 + e7 * e7));
                  if constexpr (MODE == 1) { typedef unsigned short u16x2 __attribute__((ext_vector_type(2)));
                    mpk = __builtin_elementwise_max(mpk, __builtin_bit_cast(u16x2, q.x & 0x7fff7fffu)); mpk = __builtin_elementwise_max(mpk, __builtin_bit_cast(u16x2, q.y & 0x7fff7fffu));
                    mpk = __builtin_elementwise_max(mpk, __builtin_bit_cast(u16x2, q.z & 0x7fff7fffu)); mpk = __builtin_elementwise_max(mpk, __builtin_bit_cast(u16x2, q.w & 0x7fff7fffu)); } }
                if ((kk & 3) == 3) __builtin_amdgcn_sched_barrier(0);
            }
            ss += __shfl_xor(ss, 16); ss += __shfl_xor(ss, 32);
            const float rsv = 1.f / sqrtf(ss * (1.f / DM) + NORM_EPS);
            float rsr[4];
#pragma unroll
            for (int i = 0; i < 4; ++i) rsr[i] = __shfl(rsv, 4 * g4 + i);
            if constexpr (MODE == 1) {
#pragma unroll
                for (int nt = 0; nt < NT; ++nt)
#pragma unroll
                    for (int i = 0; i < 4; ++i) if (16 * nt + n16 < 24) GL[(size_t)(R0 + 4 * g4 + i) * 24 + 16 * nt + n16] = acc[nt][i] * rsr[i];
                float mxl = bf2f((bf16)(mpk.x > mpk.y ? mpk.x : mpk.y));
                mxl = fmaxf(mxl, __shfl_xor(mxl, 16)); mxl = fmaxf(mxl, __shfl_xor(mxl, 32));
                if (lane < 16) RS[R0 + lane] = (mxl * (1.f / 127.f)) * rsv;
                mxh[half] = mxl;
            } else {
#pragma unroll
            for (int nt = 0; nt < NT; ++nt)
#pragma unroll
                for (int i = 0; i < 4; ++i) lgt[(4 * g4 + i) * 48 + 16 * nt + n16] = acc[nt][i] * rsr[i];
            LDS_WAIT();
            if (lane < 16) {
                const LAS float* lr = lgt + lane * 48;
                int gs = 0; float gm = lr[0];
#pragma unroll
                for (int j = 1; j < 4; ++j) if (lr[j] > gm) { gm = lr[j]; gs = j; }
                float gsum = 0.f;
#pragma unroll
                for (int j = 0; j < 4; ++j) gsum += __expf(lr[j] - gm);
                const float gw = 1.f / gsum;
                const LAS float* er = lr + 4 + 8 * gs;
                int i0 = 0; float m0 = er[0];
#pragma unroll
                for (int j = 1; j < 8; ++j) if (er[j] > m0) { m0 = er[j]; i0 = j; }
                int i1 = -1; float m1 = -3.0e38f;
#pragma unroll
                for (int j = 0; j < 8; ++j) if (j != i0 && er[j] > m1) { m1 = er[j]; i1 = j; }
                const float w0 = 1.f / (1.f + __expf(m1 - m0));
                const int e0 = gs * 8 + i0, e1 = 32 + gs * 8 + i1;
                const int rs = (w * 32 + half * 16 + lane) * 2;
                ri_e[rs] = e0; ri_p[rs] = __hip_atomic_fetch_add(cntl + e0, 1, __ATOMIC_RELAXED, __HIP_MEMORY_SCOPE_WORKGROUP); ri_w[rs] = w0 * gw;
                ri_e[rs + 1] = e1; ri_p[rs + 1] = __hip_atomic_fetch_add(cntl + e1, 1, __ATOMIC_RELAXED, __HIP_MEMORY_SCOPE_WORKGROUP); ri_w[rs + 1] = (1.f - w0) * gw;
                ri_r[rs >> 1] = rsv;
            }
            LDS_WAIT();
            }
        }
        if constexpr (MODE == 1) {
            unsigned char* X8o = F.ws + WS_HB;
#pragma unroll 4
            for (int i = 0; i < 32; ++i) { int ln = F.lane; asm volatile("" : "+v"(ln));
                const float msrc = i < 16 ? mxh[0] : mxh[1];
                const float mi = __builtin_bit_cast(float, __builtin_amdgcn_readlane(__builtin_bit_cast(int, msrc), i & 15)); const float inv = mi > 0.f ? 127.f / mi : 0.f;
                const u32x4* src = (const u32x4*)(xin + (size_t)(R00 + i) * DM) + 2 * ln; const u32x4 p0 = src[0], p1 = src[1];
                u32x4 o; o.x = pk4_i8m(bflo(p0.x) * inv, bfhi(p0.x) * inv, bflo(p0.y) * inv, bfhi(p0.y) * inv); o.y = pk4_i8m(bflo(p0.z) * inv, bfhi(p0.z) * inv, bflo(p0.w) * inv, bfhi(p0.w) * inv);
                o.z = pk4_i8m(bflo(p1.x) * inv, bfhi(p1.x) * inv, bflo(p1.y) * inv, bfhi(p1.y) * inv); o.w = pk4_i8m(bflo(p1.z) * inv, bfhi(p1.z) * inv, bflo(p1.w) * inv, bfhi(p1.w) * inv);
                *(u32x4*)(X8o + (size_t)(R00 + i) * DM + 16 * ln) = o; }
            continue;
        }
        __syncthreads();
        if (F.tid < 64) { const int c = cntl[F.tid]; basel[F.tid] = c ? (int)__hip_atomic_fetch_add((unsigned*)(F.ctl + CW_CNT + layer * 4096 + 64 * F.tid), (unsigned)c, RLX_AGENT) : 0; }
        __syncthreads();
        { const int rs = F.tid, e = ri_e[rs], pos = basel[e] + ri_p[rs];
          list[(size_t)e * 65536 + pos] = base + (rs >> 1); wl[(size_t)e * 65536 + pos] = ri_w[rs]; rl[(size_t)e * 65536 + pos] = ri_r[rs >> 1]; }
        __syncthreads();
    }
    __syncthreads();
}
__device__ __forceinline__ void moe_tables(Frame& F, int layer) {
    LAS int* ptile = (LAS int*)(F.lds + MOE_OFF); LAS int* cntv = ptile + 128;
    __syncthreads();
    if (F.tid < 64) {
        const int c = (int)__hip_atomic_load((unsigned*)(F.ctl + CW_CNT + layer * 4096 + 64 * F.tid), RLX_AGENT);
        cntv[F.tid] = c;
        int nt = (c + 255) >> 8, incl = nt;
#pragma unroll
        for (int o = 1; o < 64; o <<= 1) { const int t = __shfl_up(incl, o); if (F.lane >= o) incl += t; }
        ptile[F.tid] = incl - nt; if (F.tid == 63) ptile[64] = incl;
    }
    __syncthreads();
}
__device__ __forceinline__ void p_moe_gu(Frame& F, int layer) {
    moe_tables(F, layer);
    const LAS int* ptile = (const LAS int*)(F.lds + MOE_OFF); const LAS int* cntv = ptile + 128;
    pg8::MoeOrder S{(const char*)(F.ws + WS_XB8), (const char*)(F.ws + WS_WGU) + (size_t)layer * 32 * 1024 * 1024, (size_t)1024 * 1024, 512, F.G, F.bid, 0, ptile[64], ptile, cntv, (const int*)(F.ws + WS_LIST), true};
    pg8::EpiSwiGLU E{F.ws + WS_H8, (const float*)(F.ws + WS_LISTR), cntv};
    pg8::gemm_phase<pg8::EpiSwiGLU, pg8::MoeOrder, true, true>(F.lds, 512, S, E);
}
template <bool FINAL> __device__ __forceinline__ void p_moe_down(Frame& F, int layer, int slot) {
    moe_tables(F, layer);
    const LAS int* ptile = (const LAS int*)(F.lds + MOE_OFF); const LAS int* cntv = ptile + 128;
    pg8::MoeOrder S{(const char*)(F.ws + WS_H8), (const char*)(F.ws + WS_WD) + (size_t)layer * 32 * 1024 * 512, (size_t)1024 * 512, 256, F.G, F.bid, ptile[32 * slot], ptile[32 * slot + 32], ptile, cntv, (const int*)(F.ws + WS_LIST), false};
    pg8::EpiScatter<FINAL> E{(bf16*)(F.ws + WS_XB), F.out, (const int*)(F.ws + WS_LIST), (const float*)(F.ws + WS_LISTW), cntv};
    pg8::gemm_phase<pg8::EpiScatter<FINAL>, pg8::MoeOrder, true, true>(F.lds, 256, S, E);
}

__device__ __forceinline__ void p_compress(Frame& F, const Args& A) {
    bf16* U = (bf16*)(F.ws + WS_U);
    LAS unsigned char* L = F.lds;
    const int w = F.wave;
    {
        const int tid = F.tid, sub = tid & 15;
        for (int v0 = F.bid * 32; v0 < MTOK * 4; v0 += F.G * 32 * 8) {
            u32x4 vv[8];
#pragma unroll
            for (int e = 0; e < 8; ++e) { const int vec = v0 + e * F.G * 32 + (tid >> 4), row = vec >> 2, wh = vec & 3; vv[e] = (u32x4){0u, 0u, 0u, 0u};
                if (vec < MTOK * 4) vv[e] = *(const u32x4*)(U + (size_t)row * LDO + ((wh >> 1) ? OKW : OKS) + (wh & 1) * 128 + 8 * sub); }
#pragma unroll
            for (int e = 0; e < 8; ++e) { const int vec = v0 + e * F.G * 32 + (tid >> 4), row = vec >> 2, wh = vec & 3;
                bf16* p = U + (size_t)row * LDO + ((wh >> 1) ? OKW : OKS) + (wh & 1) * 128 + 8 * sub;
                const float* g = ((wh >> 1) ? A.in[18] : A.in[17]) + 8 * sub;
                const u32x4 v = vv[e]; float f[8] = {bflo(v.x), bfhi(v.x), bflo(v.y), bfhi(v.y), bflo(v.z), bfhi(v.z), bflo(v.w), bfhi(v.w)};
                float s = 0.f;
#pragma unroll
                for (int j = 0; j < 8; ++j) s += f[j] * f[j];
                s += __shfl_xor(s, 1); s += __shfl_xor(s, 2); s += __shfl_xor(s, 4); s += __shfl_xor(s, 8);
                const float rs = 1.f / sqrtf(s * (1.f / 128.f) + NORM_EPS);
                u32x4 o; o.x = pk2(f[0] * rs * g[0], f[1] * rs * g[1]); o.y = pk2(f[2] * rs * g[2], f[3] * rs * g[3]); o.z = pk2(f[4] * rs * g[4], f[5] * rs * g[5]); o.w = pk2(f[6] * rs * g[6], f[7] * rs * g[7]);
                if (vec < MTOK * 4) *(u32x4*)p = o; }
        }
    }
    constexpr int C_A = 0, C_B = 17408, C_H = 52224, C_S = 69632;
    for (int unit = F.bid; unit < 256; unit += F.G) {
        int tid = F.tid, lane = F.lane; asm volatile("" : "+v"(tid), "+v"(lane));
        const int T = unit >> 7, b = (unit >> 3) & 15, g = (unit >> 2) & 1, cb = unit & 3;
        const int col = (T ? OVC : OKC) + g * 128;
        const float* pos = T ? A.in[20] : A.in[19];
        const bf16* w1t = (const bf16*)(F.ws + (T ? WS_W1V : WS_W1K)); const bf16* w2t = (const bf16*)(F.ws + WS_W2) + T * 128 * 128;
        const int wm = w >> 2, wn = w & 3, r = lane & 31, hh = lane >> 5;
        f32x16 acc = {0.f, 0.f, 0.f, 0.f, 0.f, 0.f, 0.f, 0.f, 0.f, 0.f, 0.f, 0.f, 0.f, 0.f, 0.f, 0.f};
        u32x4 va[2], vb[4]; f32x4 vp[2][2];
#define CMP_LOAD(l_) do { \
            _Pragma("unroll") for (int e = 0; e < 2; ++e) { const int q = tid + 512 * e, c = q >> 4, part = q & 15; const int tok = 16 * (64 * cb + c) + (l_); \
                va[e] = (u32x4){0u, 0u, 0u, 0u}; if (tok < SEQ) va[e] = *(const u32x4*)(U + ((size_t)b * SEQ + tok) * LDO + col + 8 * part); \
                vp[e][0] = *(const f32x4*)(pos + (l_) * 128 + 8 * part); vp[e][1] = *(const f32x4*)(pos + (l_) * 128 + 8 * part + 4); } \
            _Pragma("unroll") for (int e = 0; e < 4; ++e) { const int q = tid + 512 * e, j = q >> 4, part = q & 15; vb[e] = *(const u32x4*)(w1t + (size_t)j * 4096 + (l_) * 128 + 8 * part); } } while (0)
        CMP_LOAD(0);
#pragma unroll 1
        for (int l = 0; l < 32; ++l) {
            __syncthreads();
#pragma unroll
            for (int e = 0; e < 2; ++e) { const int q = tid + 512 * e, c = q >> 4, part = q & 15;
                const u32x4 v = va[e]; const f32x4 p0 = vp[e][0], p1 = vp[e][1];
                u32x4 o; o.x = pk2(bflo(v.x) + p0.x, bfhi(v.x) + p0.y); o.y = pk2(bflo(v.y) + p0.z, bfhi(v.y) + p0.w); o.z = pk2(bflo(v.z) + p1.x, bfhi(v.z) + p1.y); o.w = pk2(bflo(v.w) + p1.z, bfhi(v.w) + p1.w);
                *(LAS u32x4*)(L + C_A + (c * SP + 8 * part) * 2) = o; }
#pragma unroll
            for (int e = 0; e < 4; ++e) { const int q = tid + 512 * e, j = q >> 4, part = q & 15;
                *(LAS u32x4*)(L + C_B + (j * SP + 8 * part) * 2) = vb[e]; }
            { const int ln = l + 1 < 32 ? l + 1 : 31; CMP_LOAD(ln); }
            __syncthreads();
#pragma unroll
            for (int ks = 0; ks < 8; ++ks) {
                const bf16x8 af = lds_frag(L + C_A, 32 * wm + r, 16 * ks + 8 * hh), bfg = lds_frag(L + C_B, 32 * wn + r, 16 * ks + 8 * hh);
                acc = __builtin_amdgcn_mfma_f32_32x32x16_bf16(af, bfg, acc, 0, 0, 0);
            }
        }
#undef CMP_LOAD
#pragma unroll
        for (int i = 0; i < 16; ++i) { const int c = 32 * wm + 8 * (i >> 2) + 4 * hh + (i & 3);
            *(LAS bf16*)(L + C_H + (c * SP + 32 * wn + r) * 2) = (bf16)f2bfh(siluf(acc[i])); }
        __syncthreads();
        f32x16 a2 = {0.f, 0.f, 0.f, 0.f, 0.f, 0.f, 0.f, 0.f, 0.f, 0.f, 0.f, 0.f, 0.f, 0.f, 0.f, 0.f};
#pragma unroll
        for (int ks = 0; ks < 8; ++ks) {
            const bf16x8 af = lds_frag(L + C_H, 32 * wm + r, 16 * ks + 8 * hh), bfg = *(const bf16x8*)(w2t + (size_t)(32 * wn + r) * 128 + 16 * ks + 8 * hh);
            a2 = __builtin_amdgcn_mfma_f32_32x32x16_bf16(af, bfg, a2, 0, 0, 0);
        }
        float rsv[16];
        if (T == 0) {
            LAS float* st = (LAS float*)(L + C_S);
#pragma unroll
            for (int i = 0; i < 16; ++i) { float q = a2[i] * a2[i];
                q += __shfl_xor(q, 1); q += __shfl_xor(q, 2); q += __shfl_xor(q, 4); q += __shfl_xor(q, 8); q += __shfl_xor(q, 16);
                if (r == 0) st[(32 * wm + 8 * (i >> 2) + 4 * hh + (i & 3)) * 4 + wn] = q; }
            __syncthreads();
#pragma unroll
            for (int i = 0; i < 16; ++i) { const f32x4 q = *(const LAS f32x4*)(st + (32 * wm + 8 * (i >> 2) + 4 * hh + (i & 3)) * 4);
                rsv[i] = A.in[16][32 * wn + r] / sqrtf((q.x + q.y + q.z + q.w) * (1.f / 128.f) + NORM_EPS); }
        } else {
#pragma unroll
            for (int i = 0; i < 16; ++i) rsv[i] = 1.f;
        }
        bf16* dst = (bf16*)(F.ws + (T ? WS_VCMP : WS_KCMP));
#pragma unroll
        for (int i = 0; i < 16; ++i) { const int c = 64 * cb + 32 * wm + 8 * (i >> 2) + 4 * hh + (i & 3);
            dst[(((size_t)b * 256 + c) * 2 + g) * 128 + 32 * wn + r] = (bf16)f2bfh(a2[i] * rsv[i]); }
    }
}

constexpr int N_STG = 32768;
constexpr int N_K = 0, N_V = 16384, N_LUT = 3 * N_STG, N_IMP = N_LUT + 4096, N_FAC = N_IMP + 16384, N_MSK = N_FAC + 1024, N_UNI = N_MSK + 512, N_CST = N_UNI + 64, N_LUT2 = N_CST + 64;
constexpr float LOG2E = 1.44269504f;
enum { BR_CMP = 0, BR_SEL = 1, BR_WIN = 2 };
struct NsaCtx {
    LAS unsigned char* L; const bf16* U; const bf16* KC; const bf16* VC;
    int tid, lane, w, r, hh, b, g, qblk, t0, t, head; size_t bat;
    float mrow, cfar; unsigned mlo, mhi;
};
__device__ __forceinline__ void glds16(const void* gsrc, unsigned lds_dst) { unsigned keep;
    asm volatile("s_mov_b32 %0, m0\n\ts_mov_b32 m0, %2\n\ts_nop 0\n\tglobal_load_lds_dwordx4 %1, off\n\ts_mov_b32 m0, %0" : "=&s"(keep) : "v"(gsrc), "s"(lds_dst) : "memory"); }
#define NSA_BAR() do { asm volatile("" ::: "memory"); __builtin_amdgcn_s_barrier(); asm volatile("" ::: "memory"); } while (0)
template <int BR, bool PV>
__device__ __forceinline__ void nsa_dma(const NsaCtx& X, int tl, int st) {
    LAS unsigned char* L = X.L; const int lane = X.lane;
#pragma unroll
    for (int e = 0; e < 2; ++e) { const int pidx = e * 8 + X.w, row = pidx * 4 + (lane >> 4), ch = (lane & 15) ^ (((lane >> 4) << 2) | (X.w & 3));
        const bf16* kp; const bf16* vp;
        if (BR == BR_CMP) { const size_t o = (((size_t)X.b * 256 + 64 * tl + row) * 2 + X.g) * 128 + 8 * ch; kp = X.KC + o; vp = X.VC + o; }
        else { const size_t o = (X.bat + 64 * tl + row) * LDO + X.g * 128 + 8 * ch; kp = X.U + o + (BR == BR_SEL ? OKS : OKW); vp = X.U + o + (BR == BR_SEL ? OVS : OVW); }
        const unsigned ld = (unsigned)__builtin_amdgcn_readfirstlane((int)(unsigned)(__SIZE_TYPE__)(L + st * N_STG + N_K + pidx * 1024));
        glds16(kp, ld); if (PV) glds16(vp, ld + N_V); }
}
template <int BR, bool SUM, bool PV, bool IMP, bool UNITFAC = false, bool STASH = false, bool PRE0 = false>
__device__ __forceinline__ void nsa_pass(const NsaCtx& X, const bf16x8 (&qf)[8], f32x16 (&oacc)[4], float& lsum, const float colfac, const int tlo, const int thi, const unsigned long long tmask, u32x4* stash = nullptr) {
    LAS unsigned char* L = X.L; const int r = X.r, hh = X.hh, lane = X.lane;
    const LAS float* LUT = (const LAS float*)(L + N_LUT);
    auto dma = [&](int tl, int st) { nsa_dma<BR, PV>(X, tl, st); };
    auto nextt = [&](int tl) { ++tl; while (tl <= thi && !((tmask >> tl) & 1ull)) ++tl; return tl; };
    int tile = nextt(tlo - 1);
    if (tile > thi) return;
    asm volatile("s_waitcnt vmcnt(0)" ::: "memory");
    int nxt = nextt(tile);
    int nn = nxt <= thi ? nextt(nxt) : nxt;
    if (!PRE0) dma(tile, 0);
    if (nxt <= thi) dma(nxt, 1);
    int cur = 0;
    const bool gB = X.w >= 4;
    const int kswz = ((r & 3) << 2) | ((r >> 2) & 3);
#define NSA_WAIT_KEEP(has_newer) do { if (has_newer) { if (PV) asm volatile("s_waitcnt vmcnt(4)" ::: "memory"); else asm volatile("s_waitcnt vmcnt(2)" ::: "memory"); } else asm volatile("s_waitcnt vmcnt(0)" ::: "memory"); } while (0)
#define NSA_LDK(dst, stg, mt_, k0, k1) do { _Pragma("unroll") for (int ks = (k0); ks < (k1); ++ks) dst[ks - (k0)] = *(const LAS bf16x8*)(L + (stg) * N_STG + N_K + (32 * (mt_) + r) * 256 + 16 * ((2 * ks + hh) ^ kswz)); } while (0)
    NSA_WAIT_KEEP(nxt <= thi); NSA_BAR();
    bf16x8 kpre[2];
    NSA_LDK(kpre, 0, 0, 0, 2);
    if (gB) NSA_BAR();
    while (tile <= thi) {
        const int st2 = cur >= 1 ? cur - 1 : 2;
        const int st1 = cur == 2 ? 0 : cur + 1;
        if (gB) asm volatile("s_waitcnt vmcnt(0)" ::: "memory");
        NSA_BAR();
        if (gB && nn <= thi) dma(nn, st2);
        LAS unsigned char* Ls = L + cur * N_STG;
        const int maxpos = BR == BR_CMP ? 16 * (64 * tile + 63) + 31 : 64 * tile + 63, minpos = BR == BR_CMP ? 16 * (64 * tile) + 31 : 64 * tile;
        const bool farpos = X.t0 - maxpos >= 113, inwin = BR != BR_WIN || (X.t0 + 63 - minpos < 512);
        const bool far = farpos && inwin;
        bool selb = true; if (BR == BR_SEL) selb = (tile < 32 ? (X.mlo >> tile) : (X.mhi >> (tile - 32))) & 1u;
        const bool wsk = BR == BR_SEL && __ballot(selb) == 0ull;
        bf16x8 pa[2][2];
        if (!wsk) {
            bf16x8 kf0[6], kf1[8];
            NSA_LDK(kf0, cur, 0, 2, 8); NSA_LDK(kf1, cur, 1, 0, 8);
            asm volatile("" ::: "memory");
            f32x16 sacc[2];
#pragma unroll
            for (int mt = 0; mt < 2; ++mt) sacc[mt] = (f32x16){0.f, 0.f, 0.f, 0.f, 0.f, 0.f, 0.f, 0.f, 0.f, 0.f, 0.f, 0.f, 0.f, 0.f, 0.f, 0.f};
#pragma unroll
            for (int ks = 0; ks < 2; ++ks) sacc[0] = __builtin_amdgcn_mfma_f32_32x32x16_bf16(kpre[ks], qf[ks], sacc[0], 0, 0, 0);
#pragma unroll
            for (int ks = 2; ks < 8; ++ks) sacc[0] = __builtin_amdgcn_mfma_f32_32x32x16_bf16(kf0[ks - 2], qf[ks], sacc[0], 0, 0, 0);
#pragma unroll
            for (int ks = 0; ks < 8; ++ks) sacc[1] = __builtin_amdgcn_mfma_f32_32x32x16_bf16(kf1[ks], qf[ks], sacc[1], 0, 0, 0);
            const float cf = (BR == BR_SEL && !selb) ? -1.0e30f : X.cfar;
#pragma unroll
            for (int mt = 0; mt < 2; ++mt) {
                if (far) {
#pragma unroll
                    for (int i = 0; i < 16; ++i) { const float p = __builtin_amdgcn_exp2f(sacc[mt][i] + cf);
                        if (SUM && !PV) lsum += p; sacc[mt][i] = UNITFAC ? p : p * colfac; }
                } else if (BR == BR_CMP) {
#pragma unroll
                    for (int i = 0; i < 16; ++i) { const int kidx = 32 * mt + 8 * (i >> 2) + 4 * hh + (i & 3);
                        const int dist = X.t - (16 * (64 * tile + kidx) + 31); const bool ok = dist >= 0;
                        const int dc = dist < 0 ? 0 : (dist > 127 ? 127 : dist);
                        const float bia = LUT[dc * 8 + X.head];
                        const float ev = __builtin_amdgcn_exp2f(sacc[mt][i] + bia - X.mrow);
                        const float p = ok ? ev : 0.f;
                        if (SUM && !PV) lsum += p;
                        sacc[mt][i] = UNITFAC ? p : p * colfac; }
                } else if (BR == BR_WIN && farpos) {
                    const int dq = X.t - 64 * tile - 4 * hh;
#pragma unroll
                    for (int i = 0; i < 16; ++i) { const int koff = 32 * mt + 8 * (i >> 2) + (i & 3);
                        const float ev = __builtin_amdgcn_exp2f(sacc[mt][i] + X.cfar);
                        const float p = dq < 512 + koff ? ev : 0.f;
                        if (SUM && !PV) lsum += p;
                        sacc[mt][i] = UNITFAC ? p : p * colfac; }
                } else if (tile < X.qblk) {
                    const int dq = X.t - 64 * tile - 4 * hh;
                    const LAS float* lbm = (const LAS float*)(L + N_LUT2) + X.head * 384 + 64 + dq - 63;
                    const float mr = (BR == BR_SEL && !selb) ? 1.0e30f : X.mrow;
#pragma unroll
                    for (int i = 0; i < 16; ++i) { const int koff = 32 * mt + 8 * (i >> 2) + (i & 3);
                        const float p = __builtin_amdgcn_exp2f(sacc[mt][i] + lbm[63 - koff] - mr);
                        if (SUM && !PV) lsum += p;
                        sacc[mt][i] = UNITFAC ? p : p * colfac; }
                } else {
                    int dq = X.t - 64 * tile - 4 * hh;
                    const LAS float* lbm = (const LAS float*)(L + N_LUT2) + X.head * 384 + 64 + dq - 63;
                    if (BR == BR_SEL && !selb) dq = -1;
#pragma unroll
                    for (int i = 0; i < 16; ++i) { const int koff = 32 * mt + 8 * (i >> 2) + (i & 3);
                        const float ev = __builtin_amdgcn_exp2f(sacc[mt][i] + lbm[63 - koff] - X.mrow);
                        const float p = dq >= koff ? ev : 0.f;
                        if (SUM && !PV) lsum += p;
                        sacc[mt][i] = UNITFAC ? p : p * colfac; }
                }
                if (IMP) {
                    LAS float* imp = (LAS float*)(L + N_IMP) + (X.w * 8 + (r >> 2)) * 64;
#pragma unroll
                    for (int q = 0; q < 4; ++q) { float s4 = (sacc[mt][4 * q] + sacc[mt][4 * q + 1]) + (sacc[mt][4 * q + 2] + sacc[mt][4 * q + 3]), s3 = sacc[mt][4 * q + 3];
                        s4 += xor1(s4); s4 += xor2(s4); s3 += xor1(s3); s3 += xor2(s3);
                        const int n = 16 * tile + 8 * mt + 2 * q + hh;
                        if ((r & 3) == 0) { __hip_atomic_fetch_add(imp + n, s4, __ATOMIC_RELAXED, __HIP_MEMORY_SCOPE_WORKGROUP); if (n < 63) __hip_atomic_fetch_add(imp + n + 1, s3, __ATOMIC_RELAXED, __HIP_MEMORY_SCOPE_WORKGROUP); } }
                }
                if (PV) {
#pragma unroll
                    for (int sI = 0; sI < 2; ++sI) { u32x4 pp; pp.x = pk2(sacc[mt][8 * sI], sacc[mt][8 * sI + 1]); pp.y = pk2(sacc[mt][8 * sI + 2], sacc[mt][8 * sI + 3]); pp.z = pk2(sacc[mt][8 * sI + 4], sacc[mt][8 * sI + 5]); pp.w = pk2(sacc[mt][8 * sI + 6], sacc[mt][8 * sI + 7]);
                        if (STASH) stash[((tile * 2 + mt) * 2 + sI) * 64] = pp;
                        if (SUM) { lsum = dot2ones(pp.x, lsum); lsum = dot2ones(pp.y, lsum); lsum = dot2ones(pp.z, lsum); lsum = dot2ones(pp.w, lsum); }
                        pa[mt][sI] = __builtin_bit_cast(bf16x8, pp); }
                }
            }
        } else {
#pragma unroll
            for (int mt = 0; mt < 2; ++mt)
#pragma unroll
                for (int sI = 0; sI < 2; ++sI) pa[mt][sI] = (bf16x8){0, 0, 0, 0, 0, 0, 0, 0};
        }
        const int q4 = (lane & 15) >> 2, k2 = 2 * ((lane >> 4) & 1) + ((lane & 3) >> 1), sub8 = 8 * (lane & 1);
        s16x4 vb[2][8];
#define NSA_LDV(g, dst) do { const int _row0 = 16 * (g) + 4 * hh + q4; _Pragma("unroll") for (int nt = 0; nt < 4; ++nt) { \
            dst[2 * nt] = lds_tr16(Ls + N_V + _row0 * 256 + 64 * (nt ^ q4) + 16 * (k2 ^ hh) + sub8); \
            dst[2 * nt + 1] = lds_tr16(Ls + N_V + (_row0 + 8) * 256 + 64 * (nt ^ q4) + 16 * (k2 ^ (hh + 2)) + sub8); } } while (0)
        if (!gB) asm volatile("s_waitcnt vmcnt(0)" ::: "memory");
        NSA_BAR();
        if (!gB && nn <= thi) dma(nn, st2);
        if (PV) {
            NSA_LDV(0, vb[0]);
#pragma unroll
            for (int g = 0; g < 4; ++g) {
                if (g == 0) NSA_LDV(1, vb[1]); else if (g == 1) NSA_LDV(2, vb[0]); else if (g == 2) NSA_LDV(3, vb[1]);
                asm volatile("" ::: "memory");
#pragma unroll
                for (int nt = 0; nt < 4; ++nt) { const s16x4 b0 = vb[g & 1][2 * nt], b1 = vb[g & 1][2 * nt + 1];
                    bf16x8 bfg; bfg[0] = b0[0]; bfg[1] = b0[1]; bfg[2] = b0[2]; bfg[3] = b0[3]; bfg[4] = b1[0]; bfg[5] = b1[1]; bfg[6] = b1[2]; bfg[7] = b1[3];
                    oacc[nt] = __builtin_amdgcn_mfma_f32_32x32x16_bf16(pa[g >> 1][g & 1], bfg, oacc[nt], 0, 0, 0); }
            }
        }
#undef NSA_LDV
        if (nxt <= thi) NSA_LDK(kpre, st1, 0, 0, 2);
        tile = nxt; nxt = nn; nn = nn <= thi ? nextt(nn) : nn;
        cur = cur == 2 ? 0 : cur + 1;
    }
#undef NSA_WAIT_KEEP
#undef NSA_LDK
    if (!gB) NSA_BAR();
    __syncthreads();
}

__device__ __forceinline__ void p_nsa(Frame& F, const Args& A) {
    const bf16* U = (const bf16*)(F.ws + WS_U); bf16* HB = (bf16*)(F.ws + WS_HB); const float* GL = (const float*)(F.ws + WS_GL);
    LAS unsigned char* L = F.lds;
    LAS float* LUT = (LAS float*)(L + N_LUT); LAS float* cst = (LAS float*)(L + N_CST);
    for (int i = F.tid; i < 1024; i += NTHR) LUT[i] = A.in[1][t5_bucket_dev(i >> 3) * 8 + (i & 7)] * LOG2E;
    if (F.wave == 0) {
        float gm = 0.f, bm = 0.f;
        for (int i = F.lane; i < 128; i += 64) gm = fmaxf(gm, fmaxf(fabsf(A.in[16][i]), fmaxf(fabsf(A.in[17][i]), fabsf(A.in[18][i]))));
        for (int i = F.lane; i < 256; i += 64) bm = fmaxf(bm, fabsf(A.in[1][i]));
#pragma unroll
        for (int o = 1; o < 64; o <<= 1) { gm = fmaxf(gm, __shfl_xor(gm, o)); bm = fmaxf(bm, __shfl_xor(bm, o)); }
        if (F.lane == 0) { cst[0] = gm * 11.3137085f; cst[1] = bm * LOG2E; }
    }
    __syncthreads();
    for (int i = F.tid; i < 8 * 384; i += NTHR) { const int h = i / 384, dd = i % 384 - 64; const int d = dd < 0 ? 0 : (dd > 127 ? 127 : dd); ((LAS float*)(L + N_LUT2))[i] = LUT[d * 8 + h]; }
    __syncthreads();
    const float kmax = cst[0], bmax = cst[1];
    for (int ui = F.bid; ui < 2048; ui += F.G) {
        NsaCtx X; X.L = L; X.U = U; X.KC = (const bf16*)(F.ws + WS_KCMP); X.VC = (const bf16*)(F.ws + WS_VCMP);
        int tid = F.tid, lane = F.lane; asm volatile("" : "+v"(tid), "+v"(lane));
        X.tid = tid; X.lane = lane; X.w = F.wave; X.r = lane & 31; X.hh = lane >> 5;
        const int kr = ui >> 8, cc = ui & 255, bg = (cc & 7) * 4 + (kr >> 1), sl = cc >> 3;
        X.b = bg >> 1; X.g = bg & 1; X.qblk = (kr & 1) ? 63 - sl : sl; X.t0 = 64 * X.qblk; X.bat = (size_t)X.b * SEQ;
        const int tq = X.r >> 2, hd = X.r & 3; X.t = X.t0 + 8 * X.w + tq; X.head = 4 * X.g + hd;
        const size_t row = X.bat + X.t;
        if (tid == 0) { unsigned z = 0u; asm volatile("" : "+v"(z)); *(LAS u32x2*)(L + N_UNI) = (u32x2){z, z}; }
        for (int i = tid; i < 4096; i += NTHR) ((LAS float*)(L + N_IMP))[i] = 0.f;
        bf16x8 qf[8]; float qn2 = 0.f;
        {
            u32x4 qr[8]; float ss = 0.f;
#pragma unroll
            for (int ks = 0; ks < 8; ++ks) { qr[ks] = *(const u32x4*)(U + row * LDO + OQ + X.head * 128 + 16 * ks + 8 * X.hh);
#pragma unroll
                for (int e = 0; e < 4; ++e) { const float a = bflo(qr[ks][e]), c = bfhi(qr[ks][e]); ss += a * a + c * c; } }
            ss += __shfl_xor(ss, 32);
            const float rs = 1.f / sqrtf(ss * (1.f / 128.f) + NORM_EPS);
#pragma unroll
            for (int ks = 0; ks < 8; ++ks) { const float* gq = A.in[15] + 16 * ks + 8 * X.hh; u32x4 pk;
#pragma unroll
                for (int e = 0; e < 4; ++e) { const float a = bflo(qr[ks][e]) * rs * gq[2 * e], c = bfhi(qr[ks][e]) * rs * gq[2 * e + 1]; qn2 += a * a + c * c; pk[e] = pk2(a * (0.0883883476f * LOG2E), c * (0.0883883476f * LOG2E)); }
                qf[ks] = __builtin_bit_cast(bf16x8, pk); }
            qn2 += __shfl_xor(qn2, 32);
        }
        X.mrow = sqrtf(qn2) * (0.0883883476f * LOG2E) * kmax + bmax;
        X.cfar = LUT[127 * 8 + X.head] - X.mrow;
        X.mlo = 0u; X.mhi = 0u;
        const float gl3[3] = {GL[row * 24 + X.head], GL[row * 24 + 8 + X.head], GL[row * 24 + 16 + X.head]};
#define NSA_GATE(k_) (1.f / (1.f + __expf(-gl3[(k_)])))
        f32x16 oacc[4];
#pragma unroll
        for (int nt = 0; nt < 4; ++nt) oacc[nt] = (f32x16){0.f, 0.f, 0.f, 0.f, 0.f, 0.f, 0.f, 0.f, 0.f, 0.f, 0.f, 0.f, 0.f, 0.f, 0.f, 0.f};
        const int ntc = ((4 * X.qblk + 2) >> 6) + 1;
#define NSA_FOLD(fcol, FIRST, LAST) do { int _pl = F.lane; asm volatile("" : "+v"(_pl)); u32x4* park = (u32x4*)(F.ws + WS_PARK) + ((size_t)(F.bid * NWAVES + X.w) * 64 + _pl) * 8; \
            LAS float* _fac = (LAS float*)(L + N_FAC) + X.w * 32; LDS_WAIT(); if (lane < 32) _fac[lane] = (fcol); LDS_WAIT(); \
            if (!(FIRST)) { asm volatile("s_waitcnt vmcnt(0)" ::: "memory"); __builtin_amdgcn_fence(__ATOMIC_ACQUIRE, "agent"); } \
            _Pragma("unroll") for (int nt = 0; nt < 4; ++nt) { u32x4 _p0 = (u32x4){0u, 0u, 0u, 0u}, _p1 = _p0; if (!(FIRST)) { _p0 = park[2 * nt]; _p1 = park[2 * nt + 1]; } \
                _Pragma("unroll") for (int q = 0; q < 4; ++q) { const f32x4 _fr = *(const LAS f32x4*)(_fac + 8 * q + 4 * X.hh); const unsigned _wa = q < 2 ? _p0[2 * q] : _p1[2 * q - 4], _wb = q < 2 ? _p0[2 * q + 1] : _p1[2 * q - 3]; \
                    float _a = oacc[nt][4 * q] * _fr.x, _b = oacc[nt][4 * q + 1] * _fr.y, _c = oacc[nt][4 * q + 2] * _fr.z, _d = oacc[nt][4 * q + 3] * _fr.w; \
                    if (!(FIRST)) { _a += bflo(_wa); _b += bfhi(_wa); _c += bflo(_wb); _d += bfhi(_wb); } \
                    oacc[nt][4 * q] = _a; oacc[nt][4 * q + 1] = _b; oacc[nt][4 * q + 2] = _c; oacc[nt][4 * q + 3] = _d; } \
                if (!(LAST)) { park[2 * nt] = (u32x4){pk2(oacc[nt][0], oacc[nt][1]), pk2(oacc[nt][2], oacc[nt][3]), pk2(oacc[nt][4], oacc[nt][5]), pk2(oacc[nt][6], oacc[nt][7])}; \
                               park[2 * nt + 1] = (u32x4){pk2(oacc[nt][8], oacc[nt][9]), pk2(oacc[nt][10], oacc[nt][11]), pk2(oacc[nt][12], oacc[nt][13]), pk2(oacc[nt][14], oacc[nt][15])}; \
                               oacc[nt] = (f32x16){0.f, 0.f, 0.f, 0.f, 0.f, 0.f, 0.f, 0.f, 0.f, 0.f, 0.f, 0.f, 0.f, 0.f, 0.f, 0.f}; } } } while (0)
        float l_c = 0.f;
        u32x4* stash = (u32x4*)(F.ws + WS_STASH) + (size_t)(F.bid * NWAVES + X.w) * (16 * 64) + lane;
        nsa_pass<BR_CMP, true, true, false, true, true>(X, qf, oacc, l_c, 1.f, 0, ntc - 1, ~0ull, stash);
        nsa_dma<BR_SEL, true>(X, 0, 0);
        l_c += __shfl_xor(l_c, 32);
        const float il_c = l_c > 0.f ? 1.f / l_c : 0.f;
        NSA_FOLD(NSA_GATE(0) * il_c, true, false);
        {
            asm volatile("s_waitcnt vmcnt(0)" ::: "memory"); __builtin_amdgcn_fence(__ATOMIC_ACQUIRE, "agent");
            LAS float* imp = (LAS float*)(L + N_IMP) + (X.w * 8 + (X.r >> 2)) * 64;
#pragma unroll 1
            for (int tile = 0; tile < ntc; ++tile) {
                u32x4 pp[2][2];
#pragma unroll
                for (int mt = 0; mt < 2; ++mt)
#pragma unroll
                    for (int sI = 0; sI < 2; ++sI) pp[mt][sI] = stash[((tile * 2 + mt) * 2 + sI) * 64];
#pragma unroll
                for (int mt = 0; mt < 2; ++mt) {
                    float v[16];
#pragma unroll
                    for (int sI = 0; sI < 2; ++sI)
#pragma unroll
                        for (int e = 0; e < 4; ++e) { v[8 * sI + 2 * e] = bflo(pp[mt][sI][e]); v[8 * sI + 2 * e + 1] = bfhi(pp[mt][sI][e]); }
#pragma unroll
                    for (int q = 0; q < 4; ++q) { float s4 = ((v[4 * q] + v[4 * q + 1]) + (v[4 * q + 2] + v[4 * q + 3])) * il_c, s3 = v[4 * q + 3] * il_c;
                        s4 += xor1(s4); s4 += xor2(s4); s3 += xor1(s3); s3 += xor2(s3);
                        const int n = 16 * tile + 8 * mt + 2 * q + X.hh;
                        if ((X.r & 3) == 0) { __hip_atomic_fetch_add(imp + n, s4, __ATOMIC_RELAXED, __HIP_MEMORY_SCOPE_WORKGROUP); if (n < 63) __hip_atomic_fetch_add(imp + n + 1, s3, __ATOMIC_RELAXED, __HIP_MEMORY_SCOPE_WORKGROUP); } }
                }
            }
        }
        {
            LDS_WAIT();
            const LAS float* impw = (const LAS float*)(L + N_IMP) + X.w * 8 * 64;
            const int n = lane, cur = X.qblk;
            unsigned long long wor = 0ull;
#pragma unroll 1
            for (int q = 0; q < 8; ++q) {
                const float imp = impw[q * 64 + n];
                const bool forced = (n == 0) || (n == cur) || (n == cur - 1);
                unsigned key = forced ? 0x7fffffc0u : (__builtin_bit_cast(unsigned, imp) & 0x7fffffc0u);
                if (n > cur) key = 0u;
                key |= (unsigned)(63 - n);
                unsigned T = 0u;
#pragma unroll
                for (int bit = 30; bit >= 0; --bit) { const unsigned cand = T | (1u << bit); T = __popcll(__ballot(key >= cand)) >= 16 ? cand : T; }
                const unsigned long long mk = __ballot(n <= cur && key >= T);
                wor |= mk;
                if ((X.r >> 2) == q) { X.mlo = (unsigned)mk; X.mhi = (unsigned)(mk >> 32); }
            }
            if (lane == 0) __hip_atomic_fetch_or((LAS unsigned long long*)(L + N_UNI), wor, __ATOMIC_RELAXED, __HIP_MEMORY_SCOPE_WORKGROUP);
        }
        __syncthreads();
        const unsigned long long uni = *(const LAS unsigned long long*)(L + N_UNI);
        float l_s = 0.f;
        nsa_pass<BR_SEL, true, true, false, true, false, true>(X, qf, oacc, l_s, 1.f, 0, X.qblk, uni);
        const int wlo = X.qblk >= 8 ? X.qblk - 8 : 0;
        nsa_dma<BR_WIN, true>(X, wlo, 0);
        l_s += __shfl_xor(l_s, 32);
        NSA_FOLD(l_s > 0.f ? NSA_GATE(1) / l_s : 0.f, false, false);
        float l_w = 0.f;
        nsa_pass<BR_WIN, true, true, false, true, false, true>(X, qf, oacc, l_w, 1.f, wlo, X.qblk, ~0ull);
        l_w += __shfl_xor(l_w, 32);
        NSA_FOLD(l_w > 0.f ? NSA_GATE(2) / l_w : 0.f, false, true);
#undef NSA_FOLD
#undef NSA_GATE
        const bool odd = X.r & 1;
#pragma unroll
        for (int i = 0; i < 16; i += 2) { const int c32 = 8 * (i >> 2) + 4 * X.hh + (i & 3);
            unsigned char* op = (unsigned char*)HB + (X.bat + X.t0 + 8 * X.w + (c32 >> 2)) * DM + (4 * X.g + (c32 & 3) + (odd ? 1 : 0)) * 128 + (X.r & ~1);
#pragma unroll
            for (int nt = 0; nt < 4; ++nt) { const float a = oacc[nt][i] * F8_SX, b = oacc[nt][i + 1] * F8_SX; const float rcv = xor1(odd ? a : b);
                *(unsigned short*)(op + 32 * nt) = odd ? pk2_fp8(rcv, b) : pk2_fp8(a, rcv); } }
    }
}

constexpr int N_PHASES = 18;
__global__ void __launch_bounds__(NTHR, 2) mk_fwd(Args args) {
    extern __shared__ __attribute__((aligned(16))) unsigned char lds[];
    Frame F;
    F.lds = (LAS unsigned char*)lds;
    F.MISC = (volatile LAS unsigned*)(F.lds + MISC_OFF);
    F.tid = threadIdx.x; F.lane = F.tid & 63; F.wave = __builtin_amdgcn_readfirstlane(F.tid >> 6);
    F.G = gridDim.x; F.bid = blockIdx.x;
    F.ws = args.ws; F.out = args.out; F.ctl = (gu32*)(args.ws + WS_CTL);
    if (F.tid < 64) F.MISC[F.tid] = 0u;
    __syncthreads();
    const int lo = args.ph_lo, hi = args.ph_hi;
    XcdBarrier bar; bar.bar = (unsigned*)(F.ctl + CW_BAR); bar.x = 0; bar.st = nullptr;
    if (hi - lo > 1) bar = xcd_barrier_post((unsigned*)(F.ctl + CW_BAR), F.MISC + 8);
#ifndef PHMASK
#define PHMASK 0xffffffffu
#endif
#define IN(k) (((PHMASK >> (k)) & 1u) && lo <= (k) && (k) < hi)
#ifndef REPMASK
#define REPMASK 0u
#endif
#define RUNS(k) (1 + (int)((REPMASK >> (k)) & 1u))
#define SEAM(k) do { if (IN(k) && IN((k) + 1)) xcd_barrier(bar); } while (0)
    if (IN(0)) { p_wmax(F, args); xcd_barrier(bar); for (int rp = 0; rp < RUNS(0); ++rp) p_prologue(F, args); } SEAM(0);
    if (IN(1)) for (int rp = 0; rp < RUNS(1); ++rp) {
        pg8::StaticOrder S; S.init(F.ws + WS_HB, F.ws + WS_WIE, MTOK, LDE, DM / 2, F.G, F.bid);
        pg8::EpiI8S E{(bf16*)(F.ws + WS_U), LDE, (const float*)(F.ws + WS_RS), (const unsigned*)(F.ctl + CW_WMAX), F.ws + WS_IQK8};
        pg8::gemm_phase<pg8::EpiI8S, pg8::StaticOrder, true, 2>(F.lds, DM / 2, S, E);
    } SEAM(1);
    if (IN(2)) { p_ssd1(F, args); xcd_barrier(bar); p_ssd2(F); xcd_barrier(bar); p_ssd3(F); } SEAM(2);
    if (IN(3)) { for (int rp = 0; rp < RUNS(3); ++rp) p_dsa(F, args); } SEAM(3);
    if (IN(4)) {
        pg8::StaticOrder S; S.init(F.ws + WS_HB, F.ws + WS_WOE, MTOK, DM, DM / 2, F.G, F.bid);
        pg8::EpiResXB E{args.in[0], nullptr, (bf16*)(F.ws + WS_XB), F.ws + WS_XB8, 1.f / (F8_SX * F8_SW)};
        pg8::gemm_phase<pg8::EpiResXB, pg8::StaticOrder, true, true>(F.lds, DM / 2, S, E);
    } SEAM(4);
    if (IN(5)) { p_norm_route<0>(F, (const bf16*)(F.ws + WS_XB), 0); } SEAM(5);
    if (IN(6)) { p_moe_gu(F, 0);
#if (REPMASK >> 6) & 1
        p_moe_gu(F, 0);
#endif
    } SEAM(6);
    if (IN(7)) { p_moe_down<false>(F, 0, 0); } SEAM(7);
    if (IN(8)) { p_moe_down<false>(F, 0, 1); } SEAM(8);
    if (IN(9)) { for (int rp = 0; rp < RUNS(9); ++rp) p_norm_route<1>(F, (const bf16*)(F.ws + WS_XB), 0); } SEAM(9);
    if (IN(10)) {
        pg8::StaticOrder S; S.init(F.ws + WS_HB, F.ws + WS_WIO, MTOK, LDO, DM / 2, F.G, F.bid);
        pg8::EpiI8S E{(bf16*)(F.ws + WS_U), LDO, (const float*)(F.ws + WS_RS), (const unsigned*)(F.ctl + CW_WMAX + 1), nullptr};
        pg8::gemm_phase<pg8::EpiI8S, pg8::StaticOrder, true, 2>(F.lds, DM / 2, S, E);
    } SEAM(10);
    if (IN(11)) { p_compress(F, args); } SEAM(11);
    if (IN(12)) { p_nsa(F, args);
#if (REPMASK >> 12) & 1
        p_nsa(F, args);
#endif
    } SEAM(12);
    if (IN(13)) {
        pg8::StaticOrder S; S.init(F.ws + WS_HB, F.ws + WS_WOO, MTOK, DM, DM / 2, F.G, F.bid);
        pg8::EpiResXB E{nullptr, (const bf16*)(F.ws + WS_XB), (bf16*)(F.ws + WS_XB), F.ws + WS_XB8, 1.f / (F8_SX * F8_SW)};
        pg8::gemm_phase<pg8::EpiResXB, pg8::StaticOrder, true, true>(F.lds, DM / 2, S, E);
    } SEAM(13);
    if (IN(14)) { p_norm_route<0>(F, (const bf16*)(F.ws + WS_XB), 1); } SEAM(14);
    if (IN(15)) { p_moe_gu(F, 1); } SEAM(15);
    if (IN(16)) { p_moe_down<false>(F, 1, 0); } SEAM(16);
    if (IN(17)) { p_moe_down<true>(F, 1, 1); }
#undef IN
#undef SEAM
}

extern "C" void kernel_launch(void* const* d_in, const int* in_sizes, int n_in, void* d_out, int out_size, void* d_ws, size_t ws_size, hipStream_t stream) {
    static int grid = 0;
    if (grid == 0) {
        if (n_in != 31 || ws_size < WS_END) { fprintf(stderr, "kernel_launch: unexpected n_in %d / ws %zu\n", n_in, ws_size); grid = -1; return; }
        int dev = 0, cus = 0;
        if (hipGetDevice(&dev) != hipSuccess || hipDeviceGetAttribute(&cus, hipDeviceAttributeMultiprocessorCount, dev) != hipSuccess) { grid = -1; return; }
        if (hipFuncSetAttribute((const void*)mk_fwd, hipFuncAttributeMaxDynamicSharedMemorySize, LDS_BYTES) != hipSuccess) { fprintf(stderr, "kernel_launch: hipFuncSetAttribute failed\n"); grid = -1; return; }
        grid = cus;
    }
    if (grid < 0) return;
    (void)hipMemsetAsync((char*)d_ws + WS_CTL, 0, CTL_ZERO_BYTES, stream);
    Args a{};
    for (int i = 0; i < 31; ++i) a.in[i] = (const float*)d_in[i];
    a.out = (float*)d_out; a.ws = (unsigned char*)d_ws; a.rep = (REP_PART || REP_PHASE >= 0) ? 2 : 1; a.pad = 0; a.rep = 2; a.pad = 0;
#if defined(MK_PER_PHASE)
    for (int p = 0; p < N_PHASES; ++p) { a.ph_lo = p; a.ph_hi = p + 1; hipLaunchKernelGGL(mk_fwd, dim3(grid), dim3(NTHR), LDS_BYTES, stream, a); }
#else
    a.ph_lo = 0; a.ph_hi = N_PHASES; hipLaunchKernelGGL(mk_fwd, dim3(grid), dim3(NTHR), LDS_BYTES, stream, a);
#endif
}
```
